# Optimizing an MI355X kernel written in HIP

```python
import math
import jax, jax.numpy as jnp
from jax import lax
import numpy as np


D_MODEL = 1024
BATCH = 8
SEQ = 2048
DEPTH = 1
DEC_BATCH = 128
DEC_SEQ = 4
PAST_LEN = 16384
PAGE_SIZE = 128

D_SSM = D_MODEL
SSM_HEAD_DIM = 64
SSM_HEADS = D_SSM // SSM_HEAD_DIM
SSM_GROUPS = 2
SSM_STATE = 128
SSM_CONV = 4
SSM_CHUNK = 128
D_XBC = D_SSM + 2 * SSM_GROUPS * SSM_STATE
D_POOL = D_MODEL
POOL_WINDOWS = (2, 4, 8, 16)
POOL_GROUPS = len(POOL_WINDOWS)
POOL_GROUP_DIM = D_POOL // POOL_GROUPS
POOL_HIST = max(POOL_WINDOWS) - 1
D_MIX = D_SSM + D_POOL
D_IN_PROJ = D_SSM + D_XBC + SSM_HEADS + D_POOL
N_MEM = 256
MEM_HEADS = 4
MEM_HEAD_DIM = D_MODEL // MEM_HEADS
D_FF = 2816
FFN_CONV = 3
EPS = 1e-6

kernel_name = 'ssd_multiscale_pool_hybrid_decoder_step'


def rmsnorm(x, g):
    xf = x.astype(jnp.float32)
    y = xf * lax.rsqrt(jnp.mean(xf * xf, axis=-1, keepdims=True) + EPS)
    return (y * g.astype(jnp.float32)).astype(x.dtype)


def gated_group_rmsnorm(y, z, g):
    shp = y.shape
    t = (y * jax.nn.silu(z)).astype(jnp.float32).reshape(shp[:-1] + (SSM_GROUPS, shp[-1] // SSM_GROUPS))
    t = t * lax.rsqrt(jnp.mean(t * t, axis=-1, keepdims=True) + EPS)
    return (t.reshape(shp) * g.astype(jnp.float32)).astype(y.dtype)


def causal_dwconv(prev, x, w, b):
    width = w.shape[0]
    seqlen = x.shape[1]
    ext = jnp.concatenate([prev, x], axis=1)
    y = b + sum(ext[:, k:k + seqlen] * w[k] for k in range(width))
    return y, ext[:, ext.shape[1] - (width - 1):]


def ssd_chunked(x, dt, a, b_in, c_in, h0):
    bsz, seqlen, n_heads, hd = x.shape
    n_groups, n_state = b_in.shape[2], b_in.shape[3]
    rep = n_heads // n_groups
    q = min(SSM_CHUNK, seqlen)
    nc = -(-seqlen // q)
    pad = nc * q - seqlen
    f32 = jnp.float32

    def chunked(t):
        t = jnp.pad(t.astype(f32), [(0, 0), (0, pad)] + [(0, 0)] * (t.ndim - 2))
        return t.reshape((bsz, nc, q) + t.shape[2:])

    xdt = chunked(x * dt[..., None]).reshape(bsz, nc, q, n_groups, rep, hd)
    da = chunked(dt * a).reshape(bsz, nc, q, n_groups, rep)
    bc = chunked(b_in)
    cc = chunked(c_in)
    acs = jnp.cumsum(da, axis=2)
    seg = acs[:, :, :, None] - acs[:, :, None, :]
    causal = jnp.tril(jnp.ones((q, q), dtype=bool))[None, None, :, :, None, None]
    decay = jnp.where(causal, jnp.exp(jnp.where(causal, seg, 0.0)), 0.0)
    cb = jnp.einsum('bclgn,bcsgn->bclsg', cc, bc)
    y_diag = jnp.einsum('bclsg,bclsgr,bcsgrp->bclgrp', cb, decay, xdt)
    decay_end = jnp.exp(acs[:, :, -1:] - acs)
    chunk_states = jnp.einsum('bcsgn,bcsgr,bcsgrp->bcgrpn', bc, decay_end, xdt)
    chunk_decay = jnp.exp(acs[:, :, -1])

    def step(h, inp):
        s, dcy = inp
        return h * dcy[..., None, None] + s, h

    h_init = h0.astype(f32).reshape(bsz, n_groups, rep, hd, n_state)
    h_final, h_prev = lax.scan(step, h_init, (jnp.moveaxis(chunk_states, 1, 0), jnp.moveaxis(chunk_decay, 1, 0)))
    h_prev = jnp.moveaxis(h_prev, 0, 1)
    y_off = jnp.einsum('bclgn,bcgrpn,bclgr->bclgrp', cc, h_prev, jnp.exp(acs))
    y = (y_diag + y_off).reshape(bsz, nc * q, n_heads, hd)[:, :seqlen]
    return y.astype(x.dtype), h_final.reshape(bsz, n_heads, hd, n_state).astype(h0.dtype)


def multiscale_pool(prev, v, start):
    seqlen = v.shape[1]
    ext = jnp.concatenate([prev, v], axis=1)
    cs = jnp.pad(jnp.cumsum(ext.astype(jnp.float32), axis=1), [(0, 0), (1, 0), (0, 0)])
    pos = start + jnp.arange(seqlen)
    e = POOL_HIST + 1
    outs = []
    for gi, w in enumerate(POOL_WINDOWS):
        lo, hi = gi * POOL_GROUP_DIM, (gi + 1) * POOL_GROUP_DIM
        win = cs[:, e:e + seqlen, lo:hi] - cs[:, e - w:e - w + seqlen, lo:hi]
        cnt = jnp.minimum(pos + 1, w).astype(jnp.float32)[None, :, None]
        outs.append(win / cnt)
    pooled = jnp.concatenate(outs, axis=-1) - v.astype(jnp.float32)
    return pooled.astype(v.dtype), ext[:, ext.shape[1] - POOL_HIST:]


def memory_kv(mem, norm_memkv, w_mk, w_mv):
    bsz = mem.shape[0]
    hm = rmsnorm(mem, norm_memkv)
    k = (hm @ w_mk).reshape(bsz, N_MEM, MEM_HEADS, MEM_HEAD_DIM)
    v = (hm @ w_mv).reshape(bsz, N_MEM, MEM_HEADS, MEM_HEAD_DIM)
    return k, v


def hybrid_layer(x, mem_k, mem_v, ssm_h, conv_buf, pool_buf, ffn_buf, start,
                 norm_mix, w_in, ssm_conv_w, ssm_conv_b, ssm_dt_bias, ssm_a_log, ssm_d, ssm_norm,
                 w_pool, pool_scale, w_out, norm_mem, w_mq, w_mo,
                 norm_ffn, w_up, ffn_conv_w, ffn_conv_b, w_down):
    bsz, seqlen, _ = x.shape
    f32 = jnp.float32
    h = rmsnorm(x, norm_mix)
    proj = h @ w_in
    z, xbc, dt_raw, v_pool = jnp.split(proj, [D_SSM, D_SSM + D_XBC, D_SSM + D_XBC + SSM_HEADS], axis=-1)
    xbc, conv_new = causal_dwconv(conv_buf, xbc, ssm_conv_w, ssm_conv_b)
    xbc = jax.nn.silu(xbc)
    xs, b_ssm, c_ssm = jnp.split(xbc, [D_SSM, D_SSM + SSM_GROUPS * SSM_STATE], axis=-1)
    xs = xs.reshape(bsz, seqlen, SSM_HEADS, SSM_HEAD_DIM)
    dt = jax.nn.softplus((dt_raw + ssm_dt_bias).astype(f32))
    a = -jnp.exp(ssm_a_log.astype(f32))
    y, ssm_new = ssd_chunked(xs, dt, a,
                             b_ssm.reshape(bsz, seqlen, SSM_GROUPS, SSM_STATE),
                             c_ssm.reshape(bsz, seqlen, SSM_GROUPS, SSM_STATE), ssm_h)
    y = y + xs * ssm_d[:, None]
    y = gated_group_rmsnorm(y.reshape(bsz, seqlen, D_SSM), z, ssm_norm)
    pooled, pool_new = multiscale_pool(pool_buf, v_pool, start)
    pooled = jnp.einsum('blgc,gcd->blgd', pooled.reshape(bsz, seqlen, POOL_GROUPS, POOL_GROUP_DIM), w_pool)
    pooled = pooled.reshape(bsz, seqlen, D_POOL) * pool_scale
    x = x + jnp.concatenate([y, pooled], axis=-1) @ w_out
    h = rmsnorm(x, norm_mem)
    qm = (h @ w_mq).reshape(bsz, seqlen, MEM_HEADS, MEM_HEAD_DIM)
    s = jnp.einsum('blhd,bmhd->bhlm', qm, mem_k).astype(f32) * (MEM_HEAD_DIM ** -0.5)
    pr = jax.nn.softmax(s, axis=-1).astype(x.dtype)
    o = jnp.einsum('bhlm,bmhd->blhd', pr, mem_v).reshape(bsz, seqlen, D_MODEL)
    x = x + o @ w_mo
    h = rmsnorm(x, norm_ffn)
    u = h @ w_up
    u, ffn_new = causal_dwconv(ffn_buf, u, ffn_conv_w, ffn_conv_b)
    g, val = jnp.split(u, [D_FF], axis=-1)
    x = x + (jax.nn.silu(g) * val) @ w_down
    return x, ssm_new, conv_new, pool_new, ffn_new


def setup_inputs(seed: int = 0) -> dict:
    key = jax.random.key(seed)
    ks = iter(jax.random.split(key, 48))
    f32 = jnp.float32

    def nrm(shape, scale):
        return jax.random.normal(next(ks), shape, f32) * scale

    def gain(shape):
        return 1.0 + nrm(shape, 0.02)

    dt0 = jnp.exp(jax.random.uniform(next(ks), (DEPTH, SSM_HEADS), f32)
                  * (math.log(0.1) - math.log(0.001)) + math.log(0.001))
    dt_bias = dt0 + jnp.log(-jnp.expm1(-dt0))
    a_log = jnp.log(jax.random.uniform(next(ks), (DEPTH, SSM_HEADS), f32, 1.0, 16.0))
    return {
        'x_prompt': nrm((BATCH, SEQ, D_MODEL), 1.0),
        'x_sample': nrm((DEC_BATCH, DEC_SEQ, D_MODEL), 1.0),
        'mem_prompt': nrm((BATCH, N_MEM, D_MODEL), 1.0),
        'state_ssm': nrm((DEPTH, DEC_BATCH, SSM_HEADS, SSM_HEAD_DIM, SSM_STATE), 0.1),
        'state_ssm_conv': nrm((DEPTH, DEC_BATCH, SSM_CONV - 1, D_XBC), 1.0),
        'state_pool': nrm((DEPTH, DEC_BATCH, POOL_HIST, D_POOL), 1.0),
        'state_ffn_conv': nrm((DEPTH, DEC_BATCH, FFN_CONV - 1, 2 * D_FF), 1.0),
        'cache_mem_k': nrm((DEPTH, DEC_BATCH, N_MEM, MEM_HEADS, MEM_HEAD_DIM), 1.0),
        'cache_mem_v': nrm((DEPTH, DEC_BATCH, N_MEM, MEM_HEADS, MEM_HEAD_DIM), 1.0),
        'norm_mix': gain((DEPTH, D_MODEL)),
        'w_in': nrm((DEPTH, D_MODEL, D_IN_PROJ), D_MODEL ** -0.5),
        'ssm_conv_w': nrm((DEPTH, SSM_CONV, D_XBC), 0.5),
        'ssm_conv_b': nrm((DEPTH, D_XBC), 0.02),
        'ssm_dt_bias': dt_bias,
        'ssm_a_log': a_log,
        'ssm_d': 1.0 + nrm((DEPTH, SSM_HEADS), 0.1),
        'ssm_norm': gain((DEPTH, D_SSM)),
        'w_pool': nrm((DEPTH, POOL_GROUPS, POOL_GROUP_DIM, POOL_GROUP_DIM), POOL_GROUP_DIM ** -0.5),
        'pool_scale': 1.0 + nrm((DEPTH, D_POOL), 0.1),
        'w_out': nrm((DEPTH, D_MIX, D_MODEL), D_MIX ** -0.5),
        'norm_mem': gain((DEPTH, D_MODEL)),
        'norm_memkv': gain((DEPTH, D_MODEL)),
        'w_mq': nrm((DEPTH, D_MODEL, D_MODEL), D_MODEL ** -0.5),
        'w_mk': nrm((DEPTH, D_MODEL, D_MODEL), D_MODEL ** -0.5),
        'w_mv': nrm((DEPTH, D_MODEL, D_MODEL), D_MODEL ** -0.5),
        'w_mo': nrm((DEPTH, D_MODEL, D_MODEL), D_MODEL ** -0.5),
        'norm_ffn': gain((DEPTH, D_MODEL)),
        'w_up': nrm((DEPTH, D_MODEL, 2 * D_FF), D_MODEL ** -0.5),
        'ffn_conv_w': nrm((DEPTH, FFN_CONV, 2 * D_FF), 0.5),
        'ffn_conv_b': nrm((DEPTH, 2 * D_FF), 0.02),
        'w_down': nrm((DEPTH, D_FF, D_MODEL), D_FF ** -0.5),
        'final_norm': gain((D_MODEL,)),
    }


def reference(x_prompt, x_sample, mem_prompt, state_ssm, state_ssm_conv, state_pool, state_ffn_conv,
              cache_mem_k, cache_mem_v,
              norm_mix, w_in, ssm_conv_w, ssm_conv_b, ssm_dt_bias, ssm_a_log, ssm_d, ssm_norm,
              w_pool, pool_scale, w_out, norm_mem, norm_memkv, w_mq, w_mk, w_mv, w_mo,
              norm_ffn, w_up, ffn_conv_w, ffn_conv_b, w_down, final_norm):
    layer_params = [norm_mix, w_in, ssm_conv_w, ssm_conv_b, ssm_dt_bias, ssm_a_log, ssm_d, ssm_norm,
                    w_pool, pool_scale, w_out, norm_mem, w_mq, w_mo,
                    norm_ffn, w_up, ffn_conv_w, ffn_conv_b, w_down]
    dtp = x_prompt.dtype
    hp, hs = x_prompt, x_sample
    ssm_p, ssm_s, conv_p, conv_s, pool_p, pool_s, ffn_p, ffn_s, mk_p, mv_p = ([] for _ in range(10))
    for i in range(DEPTH):
        lp = [p[i] for p in layer_params]
        mem_k, mem_v = memory_kv(mem_prompt, norm_memkv[i], w_mk[i], w_mv[i])
        hp, s1, s2, s3, s4 = hybrid_layer(
            hp, mem_k, mem_v,
            jnp.zeros((BATCH, SSM_HEADS, SSM_HEAD_DIM, SSM_STATE), dtp),
            jnp.zeros((BATCH, SSM_CONV - 1, D_XBC), dtp),
            jnp.zeros((BATCH, POOL_HIST, D_POOL), dtp),
            jnp.zeros((BATCH, FFN_CONV - 1, 2 * D_FF), dtp),
            0, *lp)
        ssm_p.append(s1); conv_p.append(s2); pool_p.append(s3); ffn_p.append(s4)
        mk_p.append(mem_k); mv_p.append(mem_v)
        hs, t1, t2, t3, t4 = hybrid_layer(
            hs, cache_mem_k[i], cache_mem_v[i], state_ssm[i], state_ssm_conv[i], state_pool[i],
            state_ffn_conv[i], PAST_LEN, *lp)
        ssm_s.append(t1); conv_s.append(t2); pool_s.append(t3); ffn_s.append(t4)
    y_prompt = rmsnorm(hp, final_norm)
    y_sample = rmsnorm(hs, final_norm)
    return (y_prompt, y_sample,
            jnp.stack(ssm_p), jnp.stack(ssm_s),
            jnp.stack(conv_p), jnp.stack(conv_s),
            jnp.stack(pool_p), jnp.stack(pool_s),
            jnp.stack(ffn_p), jnp.stack(ffn_s),
            jnp.stack(mk_p), jnp.stack(mv_p))
```

```cpp
#include <hip/hip_runtime.h>
#include <hip/hip_cooperative_groups.h>
#include <cstdio>
namespace cg = cooperative_groups;

typedef unsigned short bf16_t;
typedef short bf16x8 __attribute__((ext_vector_type(8)));
typedef short s16x4 __attribute__((ext_vector_type(4)));
typedef float f32x4 __attribute__((ext_vector_type(4)));
typedef unsigned u32x4 __attribute__((ext_vector_type(4)));
typedef unsigned u32x2 __attribute__((ext_vector_type(2)));
#define LDSB __attribute__((address_space(3)))

constexpr int TP = 16384, TS = 512, TT = TP + TS;
constexpr int NTHR = 512;
constexpr int LDS_BYTES = 139264;
constexpr float EPS = 1e-6f;
#ifndef PHASE_MASK
#define PHASE_MASK 0xFFFF
#endif

constexpr size_t O_YP = 0;
constexpr size_t O_YS = O_YP + (size_t)TP * 1024;
constexpr size_t O_SSMP = O_YS + (size_t)TS * 1024;
constexpr size_t O_SSMS = O_SSMP + (size_t)8 * 16 * 64 * 128;
constexpr size_t O_CONVP = O_SSMS + (size_t)128 * 16 * 64 * 128;
constexpr size_t O_CONVS = O_CONVP + (size_t)8 * 3 * 1536;
constexpr size_t O_POOLP = O_CONVS + (size_t)128 * 3 * 1536;
constexpr size_t O_POOLS = O_POOLP + (size_t)8 * 15 * 1024;
constexpr size_t O_FFNP = O_POOLS + (size_t)128 * 15 * 1024;
constexpr size_t O_FFNS = O_FFNP + (size_t)8 * 2 * 5632;
constexpr size_t O_MK = O_FFNS + (size_t)128 * 2 * 5632;
constexpr size_t O_MV = O_MK + (size_t)8 * 256 * 1024;

constexpr size_t W_WIN = 0;
constexpr size_t W_WPOOL = W_WIN + (size_t)3584 * 1024 * 2;
constexpr size_t W_WOUT = W_WPOOL + (size_t)4 * 256 * 256 * 2;
constexpr size_t W_WMQ = W_WOUT + (size_t)1024 * 2048 * 2;
constexpr size_t W_WMK = W_WMQ + (size_t)1024 * 1024 * 2;
constexpr size_t W_WMV = W_WMK + (size_t)1024 * 1024 * 2;
constexpr size_t W_WMO = W_WMV + (size_t)1024 * 1024 * 2;
constexpr size_t W_WUP = W_WMO + (size_t)1024 * 1024 * 2;
constexpr size_t W_WDOWN = W_WUP + (size_t)5632 * 1024 * 2;
constexpr size_t W_H = W_WDOWN + (size_t)1024 * 2816 * 2;
constexpr size_t W_HM = W_H + (size_t)TT * 1024 * 2;
constexpr size_t W_KB = W_HM + (size_t)2048 * 1024 * 2;
constexpr size_t W_VT = W_KB + (size_t)2048 * 1024 * 2;
constexpr size_t W_DT = W_VT + (size_t)2048 * 1024 * 2;
constexpr size_t W_XRES = W_DT + (size_t)TT * 16 * 4;
constexpr size_t W_ARENA = W_XRES + (size_t)TT * 1024 * 4;
constexpr size_t W_Z = W_ARENA;
constexpr size_t W_PROJ2 = W_Z + (size_t)TT * 1024 * 2;
constexpr size_t W_XACT = W_PROJ2 + (size_t)TT * 2560 * 2;
constexpr size_t W_POOLED = W_XACT + (size_t)TT * 1536 * 2;
constexpr size_t W_Y = W_POOLED + (size_t)TT * 1024 * 2;
constexpr size_t W_MIX = W_Y + (size_t)TT * 1024 * 2;
constexpr size_t W_END_A = W_MIX + (size_t)TT * 2048 * 2;
constexpr size_t W_Q = W_PROJ2;
constexpr size_t W_P = W_Q + (size_t)TT * 1024 * 2;
constexpr size_t W_O = W_P + (size_t)TP * 1024 * 2;
constexpr size_t W_U = W_ARENA;
constexpr size_t W_ACT = W_U + (size_t)TT * 5632 * 2;
constexpr size_t W_END_C = W_ACT + (size_t)TT * 2816 * 2;
static_assert(W_O + (size_t)TT * 1024 * 2 <= W_POOLED, "era B overflow");
static_assert(W_END_C <= W_END_A, "era C overflow");

struct Params {
    const float *x_prompt, *x_sample, *mem_prompt, *state_ssm, *state_conv, *state_pool, *state_ffn, *cache_k, *cache_v;
    const float *norm_mix, *w_in, *conv_w, *conv_b, *dt_bias, *a_log, *ssm_d, *ssm_norm, *w_pool, *pool_scale, *w_out;
    const float *norm_mem, *norm_memkv, *w_mq, *w_mk, *w_mv, *w_mo, *norm_ffn, *w_up, *ffn_w, *ffn_b, *w_down, *final_norm;
    float* out;
    char* ws;
    int ph_lo, ph_hi;
};

typedef const __attribute__((address_space(4))) Params* PP;

__device__ __forceinline__ unsigned pk2(float lo, float hi) { unsigned r; asm("v_cvt_pk_bf16_f32 %0, %1, %2" : "=v"(r) : "v"(lo), "v"(hi)); return r; }
__device__ __forceinline__ bf16_t f2bf(float f) { return (bf16_t)(pk2(f, 0.f) & 0xffffu); }
__device__ __forceinline__ float bf2f(bf16_t b) { return __uint_as_float(((unsigned)b) << 16); }
__device__ __forceinline__ float bflo(unsigned u) { return __uint_as_float(u << 16); }
__device__ __forceinline__ float bfhi(unsigned u) { return __uint_as_float(u & 0xffff0000u); }
__device__ __forceinline__ void unpack8(u32x4 v, float (&f)[8]) {
    f[0] = bflo(v.x); f[1] = bfhi(v.x); f[2] = bflo(v.y); f[3] = bfhi(v.y); f[4] = bflo(v.z); f[5] = bfhi(v.z); f[6] = bflo(v.w); f[7] = bfhi(v.w);
}
__device__ __forceinline__ u32x4 pack8(const float (&f)[8]) { u32x4 r; r.x = pk2(f[0], f[1]); r.y = pk2(f[2], f[3]); r.z = pk2(f[4], f[5]); r.w = pk2(f[6], f[7]); return r; }
__device__ __forceinline__ float wave_sum(float v) {
#pragma unroll
    for (int o = 1; o < 64; o <<= 1) v += __shfl_xor(v, o);
    return v;
}
__device__ __forceinline__ float wave_max(float v) {
#pragma unroll
    for (int o = 1; o < 64; o <<= 1) v = fmaxf(v, __shfl_xor(v, o));
    return v;
}
__device__ __forceinline__ float silu_f(float x) { return x / (1.0f + __expf(-x)); }

constexpr int HTB = 128 * 64 * 2;
__device__ __forceinline__ int lds_byte(int r, int c) { const int st = (r >> 4) * 2 + (c >> 5), rr = r & 15, cc = c & 31, ob = rr * 64 + cc * 2; return st * 1024 + (ob ^ (((ob >> 9) & 1) << 5)); }
__device__ __forceinline__ void stage_rc(int b, int& R, int& C) { const int st = b / 1024, sb = b % 1024, swz = sb ^ (((sb >> 9) & 1) << 5); R = (st >> 1) * 16 + swz / 64; C = (st & 1) * 32 + (swz % 64) / 2; }

enum { E_PROJ = 0, E_MEMKV, E_POOL, E_OUT, E_Q, E_QK, E_PV, E_MO, E_UP, E_DOWN };

template <int EK>
__device__ __forceinline__ void epi_apply(PP P, int row, int col, f32x4 v) {
    char* ws = P->ws;
    if constexpr (EK == E_PROJ) {
        u32x2 o; o.x = pk2(v[0], v[1]); o.y = pk2(v[2], v[3]);
        if (col < 1024) *(u32x2*)((bf16_t*)(ws + W_Z) + (size_t)row * 1024 + col) = o;
        else *(u32x2*)((bf16_t*)(ws + W_PROJ2) + (size_t)row * 2560 + (col - 1024)) = o;
    } else if constexpr (EK == E_MEMKV) {
        if (col < 1024) {
            *(f32x4*)(P->out + O_MK + (size_t)row * 1024 + col) = v;
            u32x2 o; o.x = pk2(v[0], v[1]); o.y = pk2(v[2], v[3]);
            *(u32x2*)((bf16_t*)(ws + W_KB) + (size_t)row * 1024 + col) = o;
        } else {
            const int c = col - 1024;
            *(f32x4*)(P->out + O_MV + (size_t)row * 1024 + c) = v;
            const int b = row >> 8, m = row & 255, hh = c >> 8, d = c & 255;
            bf16_t* vt = (bf16_t*)(ws + W_VT) + ((size_t)(b * 4 + hh) * 256 + d) * 256 + m;
#pragma unroll
            for (int j = 0; j < 4; ++j) vt[j * 256] = f2bf(v[j]);
        }
    } else if constexpr (EK == E_POOL) {
        const f32x4 sc = *(const f32x4*)(P->pool_scale + col);
        u32x2 o; o.x = pk2(v[0] * sc[0], v[1] * sc[1]); o.y = pk2(v[2] * sc[2], v[3] * sc[3]);
        *(u32x2*)((bf16_t*)(ws + W_MIX) + (size_t)row * 2048 + 1024 + col) = o;
    } else if constexpr (EK == E_OUT) {
        const float* xin = row < TP ? P->x_prompt + (size_t)row * 1024 : P->x_sample + (size_t)(row - TP) * 1024;
        const f32x4 x = *(const f32x4*)(xin + col);
        *(f32x4*)((float*)(ws + W_XRES) + (size_t)row * 1024 + col) = x + v;
    } else if constexpr (EK == E_Q) {
        u32x2 o; o.x = pk2(v[0] * 0.0625f, v[1] * 0.0625f); o.y = pk2(v[2] * 0.0625f, v[3] * 0.0625f);
        *(u32x2*)((bf16_t*)(ws + W_Q) + (size_t)row * 1024 + col) = o;
    } else if constexpr (EK == E_PV) {
        u32x2 o; o.x = pk2(v[0], v[1]); o.y = pk2(v[2], v[3]);
        *(u32x2*)((bf16_t*)(ws + W_O) + (size_t)row * 1024 + col) = o;
    } else if constexpr (EK == E_MO || EK == E_DOWN) {
        float* xr = (float*)(ws + W_XRES) + (size_t)row * 1024 + col;
        *(f32x4*)xr = *(const f32x4*)xr + v;
    } else if constexpr (EK == E_UP) {
        u32x2 o; o.x = pk2(v[0], v[1]); o.y = pk2(v[2], v[3]);
        *(u32x2*)((bf16_t*)(ws + W_U) + (size_t)row * 5632 + col) = o;
    }
}
__device__ __forceinline__ void epi_apply_rt(PP P, int ekind, int row, int col, f32x4 v) {
    switch (ekind) {
    case E_PROJ: epi_apply<E_PROJ>(P, row, col, v); break;
    case E_POOL: epi_apply<E_POOL>(P, row, col, v); break;
    case E_OUT: epi_apply<E_OUT>(P, row, col, v); break;
    case E_Q: epi_apply<E_Q>(P, row, col, v); break;
    case E_MO: epi_apply<E_MO>(P, row, col, v); break;
    case E_UP: epi_apply<E_UP>(P, row, col, v); break;
    default: epi_apply<E_DOWN>(P, row, col, v); break;
    }
}
template <int EK>
__device__ __forceinline__ void epi_loop(PP P, const f32x4 (&acc)[2][2][4][2], int rbase, int cbase) {
#pragma unroll
    for (int ai = 0; ai < 2; ++ai)
#pragma unroll
        for (int m = 0; m < 4; ++m)
#pragma unroll
            for (int bj = 0; bj < 2; ++bj)
#pragma unroll
                for (int n = 0; n < 2; ++n) epi_apply<EK>(P, rbase + ai * 128 + m * 16, cbase + bj * 128 + n * 16, acc[ai][bj][m][n]);
}

struct PhaseCfg { const char* A; const char* B; int lda, ldb, K, nbig, nsmall, ncol64, ekind; };
__device__ __forceinline__ PhaseCfg phase_cfg(PP P, int gp) {
    const char* ws = P->ws; PhaseCfg c;
    switch (gp) {
    case 1:  c.A = ws + W_H;      c.B = ws + W_WIN;   c.lda = 1024; c.ldb = 1024; c.K = 1024; c.nbig = 64 * 14 + 64; c.nsmall = 16 * 56; c.ncol64 = 56; c.ekind = E_PROJ; break;
    case 3:  c.A = ws + W_POOLED; c.B = ws + W_WPOOL; c.lda = 1024; c.ldb = 256;  c.K = 256;  c.nbig = 256; c.nsmall = 256; c.ncol64 = 16; c.ekind = E_POOL; break;
    case 5:  c.A = ws + W_MIX;    c.B = ws + W_WOUT;  c.lda = 2048; c.ldb = 2048; c.K = 2048; c.nbig = 256; c.nsmall = 256; c.ncol64 = 16; c.ekind = E_OUT; break;
    case 7:  c.A = ws + W_H;      c.B = ws + W_WMQ;   c.lda = 1024; c.ldb = 1024; c.K = 1024; c.nbig = 256; c.nsmall = 256; c.ncol64 = 16; c.ekind = E_Q; break;
    case 8:  c.A = ws + W_Q;      c.B = ws + W_KB;    c.lda = 1024; c.ldb = 1024; c.K = 256;  c.nbig = 256; c.nsmall = 0;   c.ncol64 = 16; c.ekind = E_QK; break;
    case 9:  c.A = ws + W_P;      c.B = ws + W_VT;    c.lda = 1024; c.ldb = 256;  c.K = 256;  c.nbig = 256; c.nsmall = 0;   c.ncol64 = 16; c.ekind = E_PV; break;
    case 10: c.A = ws + W_O;      c.B = ws + W_WMO;   c.lda = 1024; c.ldb = 1024; c.K = 1024; c.nbig = 256; c.nsmall = 256; c.ncol64 = 16; c.ekind = E_MO; break;
    case 12: c.A = ws + W_H;      c.B = ws + W_WUP;   c.lda = 1024; c.ldb = 1024; c.K = 1024; c.nbig = 64 * 22; c.nsmall = 16 * 88; c.ncol64 = 88; c.ekind = E_UP; break;
    default: c.A = ws + W_ACT;    c.B = ws + W_WDOWN; c.lda = 2816; c.ldb = 2816; c.K = 2816; c.nbig = 256; c.nsmall = 256; c.ncol64 = 16; c.ekind = E_DOWN; break;
    }
    return c;
}
struct UnitD { const char* A; const char* B; int row0, col0, ekind; };
__device__ __forceinline__ UnitD unit_decode(PP P, const PhaseCfg& c, int gp, int u) {
    UnitD d; d.ekind = c.ekind;
    int pm, pn;
    switch (gp) {
    case 1:
        if (u < 896) { pm = u / 14; pn = u % 14; d.A = c.A + (size_t)pm * 256 * 2048; d.B = c.B + (size_t)pn * 256 * 2048; }
        else { const int v = u - 896; pm = v >> 3; pn = v & 7; d.A = P->ws + W_HM + (size_t)pm * 256 * 2048; d.B = P->ws + W_WMK + (size_t)pn * 256 * 2048; d.ekind = E_MEMKV; }
        break;
    case 3: pm = u >> 2; pn = u & 3; d.A = c.A + (size_t)pm * 256 * 2048 + pn * 512; d.B = c.B + (size_t)pn * 131072; break;
    case 8: pm = u >> 2; pn = u & 3; d.A = c.A + (size_t)pm * 256 * 2048 + pn * 512; d.B = c.B + (size_t)(pm >> 3) * 256 * 2048 + pn * 512; break;
    case 9: pm = u >> 2; pn = u & 3; d.A = c.A + (size_t)pm * 256 * 2048 + pn * 512; d.B = c.B + (size_t)((pm >> 3) * 4 + pn) * 131072; break;
    case 12: pm = u / 22; pn = u % 22; d.A = c.A + (size_t)pm * 256 * 2048; d.B = c.B + (size_t)pn * 256 * 2048; break;
    default: pm = u >> 2; pn = u & 3; d.A = c.A + (size_t)pm * 256 * c.lda * 2; d.B = c.B + (size_t)pn * 256 * c.ldb * 2; break;
    }
    d.row0 = pm * 256; d.col0 = pn * 256;
    return d;
}

__device__ __forceinline__ void gemm_phase(PP P, int gp, char* shm_g, int lb, int nblk, const int tid) {
    LDSB unsigned char* lds = (LDSB unsigned char*)shm_g;
    const int wid = __builtin_amdgcn_readfirstlane(tid >> 6), lane = tid & 63, wr = wid >> 2, wc = wid & 3, fr = lane & 15, fq = lane >> 4;
    const PhaseCfg cfg = phase_cfg(P, gp);
    const int K = cfg.K, nt = K / 64;
    unsigned voffA, voffB;
    { int R, C; stage_rc(tid * 16, R, C); voffA = (unsigned)(R * cfg.lda + C) * 2u; voffB = (unsigned)(R * cfg.ldb + C) * 2u; }
    const size_t qstepvoffA = (size_t)64 * cfg.lda * 2, qstepvoffB = (size_t)64 * cfg.ldb * 2;
    const size_t kstep = 128;
    const size_t hstepA = (size_t)128 * cfg.lda * 2, hstepB = (size_t)128 * cfg.ldb * 2;
    const unsigned ldsw = (unsigned)wid * 1024u;
    const int aoff = lds_byte(wr * 64 + fr, fq * 8), boff = lds_byte(wc * 32 + fr, fq * 8);
    const bool chain = (cfg.ekind != E_QK);
#define G_SA(b, h) (((b) * 2 + (h)) * HTB)
#define G_SB(b, h) ((4 + (b) * 2 + (h)) * HTB)
#define G_STAGE(bufoff, gbase, voff) do { \
        __builtin_amdgcn_global_load_lds((const unsigned*)((const char*)(gbase) + (voff)), (LDSB unsigned*)(lds + (bufoff) + ldsw), 16, 0, 0); \
        __builtin_amdgcn_global_load_lds((const unsigned*)((const char*)(gbase) + qstep##voff + (voff)), (LDSB unsigned*)(lds + (bufoff) + ldsw + 8192), 16, 0, 0); } while (0)
#define G_LDA(dst, b, h) do { _Pragma("unroll") for (int m = 0; m < 4; ++m) _Pragma("unroll") for (int k = 0; k < 2; ++k) dst[m][k] = *(const LDSB bf16x8*)(lds + G_SA(b, h) + aoff + m * 2048 + k * 1024); } while (0)
#define G_LDB(dst, b, h) do { _Pragma("unroll") for (int n = 0; n < 2; ++n) _Pragma("unroll") for (int k = 0; k < 2; ++k) dst[n][k] = *(const LDSB bf16x8*)(lds + G_SB(b, h) + boff + n * 2048 + k * 1024); } while (0)
#define G_MMA(ai, bj, Af, Bf) do { __builtin_amdgcn_s_setprio(1); _Pragma("unroll") for (int m = 0; m < 4; ++m) _Pragma("unroll") for (int n = 0; n < 2; ++n) _Pragma("unroll") for (int k = 0; k < 2; ++k) \
        acc[ai][bj][m][n] = __builtin_amdgcn_mfma_f32_16x16x32_bf16(Bf[n][k], Af[m][k], acc[ai][bj][m][n], 0, 0, 0); __builtin_amdgcn_s_setprio(0); } while (0)
#define G_WAIT_V(n) asm volatile("s_waitcnt vmcnt(" #n ")" ::: "memory")
#define G_WAIT_L(n) asm volatile("s_waitcnt lgkmcnt(" #n ")" ::: "memory")
#define G_BAR __builtin_amdgcn_s_barrier()
#define G_SCHED __builtin_amdgcn_sched_barrier(0)
    int u = lb;
    while (u < cfg.nbig) {
        UnitD cur = unit_decode(P, cfg, gp, u);
        f32x4 acc[2][2][4][2];
#pragma unroll
        for (int a = 0; a < 2; ++a)
#pragma unroll
            for (int b = 0; b < 2; ++b)
#pragma unroll
                for (int m = 0; m < 4; ++m)
#pragma unroll
                    for (int n = 0; n < 2; ++n) acc[a][b][m][n] = (f32x4){0.f, 0.f, 0.f, 0.f};
        bf16x8 At[4][2], B0[2][2], B1[2][2];
        const char* cA = cur.A; const char* cB = cur.B;
        G_STAGE(G_SB(0, 0), cB, voffB); G_STAGE(G_SA(0, 0), cA, voffA); G_STAGE(G_SB(0, 1), cB + hstepB, voffB); G_STAGE(G_SA(0, 1), cA + hstepA, voffA);
        if (wr == 1) G_BAR;
        G_WAIT_V(4); G_BAR;
        G_STAGE(G_SB(1, 0), cB + kstep, voffB); G_STAGE(G_SA(1, 0), cA + kstep, voffA); G_STAGE(G_SB(1, 1), cB + hstepB + kstep, voffB);
        G_WAIT_V(6); G_BAR;
        for (;;) {
            const bool has_next = chain && (u + nblk < cfg.nbig);
            UnitD nxt = cur;
            if (has_next) nxt = unit_decode(P, cfg, gp, u + nblk);
            const char* nA = nxt.A; const char* nB = nxt.B;
            for (int t = 0; t < nt; t += 2) {
                const bool last = (t == nt - 2);
                const char* a1 = cA + (size_t)(t + 1) * kstep;
                const char* a2 = last ? nA : cA + (size_t)(t + 2) * kstep; const char* b2 = last ? nB : cB + (size_t)(t + 2) * kstep;
                const char* a3 = a2 + kstep; const char* b3 = b2 + kstep;
                G_LDB(B0, 0, 0); G_SCHED; G_LDA(At, 0, 0); G_STAGE(G_SA(1, 1), a1 + hstepA, voffA);
                G_WAIT_L(8); G_BAR; G_WAIT_L(0); G_MMA(0, 0, At, B0); G_BAR; G_SCHED;
                G_LDB(B1, 0, 1); G_STAGE(G_SB(0, 0), b2, voffB);
                G_BAR; G_WAIT_L(0); G_MMA(0, 1, At, B1); G_BAR;
                G_LDA(At, 0, 1); G_STAGE(G_SA(0, 0), a2, voffA);
                G_BAR; G_WAIT_L(0); G_MMA(1, 0, At, B0); G_BAR; G_SCHED;
                G_STAGE(G_SB(0, 1), b2 + hstepB, voffB);
                G_WAIT_V(6); G_BAR; G_MMA(1, 1, At, B1); G_BAR;
                G_LDB(B0, 1, 0); G_SCHED; G_LDA(At, 1, 0); G_STAGE(G_SA(0, 1), a2 + hstepA, voffA);
                G_WAIT_L(8); G_BAR; G_WAIT_L(0); G_MMA(0, 0, At, B0); G_BAR; G_SCHED;
                G_LDB(B1, 1, 1); G_STAGE(G_SB(1, 0), b3, voffB);
                G_BAR; G_WAIT_L(0); G_MMA(0, 1, At, B1); G_BAR;
                G_LDA(At, 1, 1); G_STAGE(G_SA(1, 0), a3, voffA);
                G_BAR; G_WAIT_L(0); G_MMA(1, 0, At, B0); G_BAR; G_SCHED;
                G_STAGE(G_SB(1, 1), b3 + hstepB, voffB);
                G_WAIT_V(6); G_BAR; G_MMA(1, 1, At, B1); G_BAR;
            }
            if (chain) {
                const int rbase = cur.row0 + wr * 64 + fr, cbase = cur.col0 + wc * 32 + fq * 4;
                switch (cur.ekind) {
                case E_PROJ: epi_loop<E_PROJ>(P, acc, rbase, cbase); break;
                case E_MEMKV: epi_loop<E_MEMKV>(P, acc, rbase, cbase); break;
                case E_POOL: epi_loop<E_POOL>(P, acc, rbase, cbase); break;
                case E_OUT: epi_loop<E_OUT>(P, acc, rbase, cbase); break;
                case E_Q: epi_loop<E_Q>(P, acc, rbase, cbase); break;
                case E_PV: epi_loop<E_PV>(P, acc, rbase, cbase); break;
                case E_MO: epi_loop<E_MO>(P, acc, rbase, cbase); break;
                case E_UP: epi_loop<E_UP>(P, acc, rbase, cbase); break;
                default: epi_loop<E_DOWN>(P, acc, rbase, cbase); break;
                }
            }
            if (!has_next) break;
#pragma unroll
            for (int a = 0; a < 2; ++a)
#pragma unroll
                for (int b = 0; b < 2; ++b)
#pragma unroll
                    for (int m = 0; m < 4; ++m)
#pragma unroll
                        for (int n = 0; n < 2; ++n) acc[a][b][m][n] = (f32x4){0.f, 0.f, 0.f, 0.f};
            cur = nxt; cA = nA; cB = nB; u += nblk;
        }
        G_WAIT_V(0);
        if (wr == 0) G_BAR;
        G_BAR;
        if (!chain) {
            float* redm = (float*)(shm_g + 131072);
            float* reds = (float*)(shm_g + 135168);
#pragma unroll
            for (int ai = 0; ai < 2; ++ai)
#pragma unroll
                for (int m = 0; m < 4; ++m) {
                    float t = -3.0e38f;
#pragma unroll
                    for (int bj = 0; bj < 2; ++bj)
#pragma unroll
                        for (int n = 0; n < 2; ++n)
#pragma unroll
                            for (int j = 0; j < 4; ++j) t = fmaxf(t, acc[ai][bj][m][n][j]);
                    t = fmaxf(t, __shfl_xor(t, 16)); t = fmaxf(t, __shfl_xor(t, 32));
                    if (fq == 0) redm[(ai * 128 + wr * 64 + m * 16 + fr) * 4 + wc] = t;
                }
            __syncthreads();
#pragma unroll
            for (int ai = 0; ai < 2; ++ai)
#pragma unroll
                for (int m = 0; m < 4; ++m) {
                    const f32x4 r = *(const f32x4*)(redm + (ai * 128 + wr * 64 + m * 16 + fr) * 4);
                    const float M = fmaxf(fmaxf(r[0], r[1]), fmaxf(r[2], r[3]));
                    float s = 0.f;
#pragma unroll
                    for (int bj = 0; bj < 2; ++bj)
#pragma unroll
                        for (int n = 0; n < 2; ++n)
#pragma unroll
                            for (int j = 0; j < 4; ++j) { const float e = __expf(acc[ai][bj][m][n][j] - M); acc[ai][bj][m][n][j] = e; s += e; }
                    s += __shfl_xor(s, 16); s += __shfl_xor(s, 32);
                    if (fq == 0) reds[(ai * 128 + wr * 64 + m * 16 + fr) * 4 + wc] = s;
                }
            __syncthreads();
#pragma unroll
            for (int ai = 0; ai < 2; ++ai)
#pragma unroll
                for (int m = 0; m < 4; ++m) {
                    const int rl = ai * 128 + wr * 64 + m * 16 + fr;
                    const f32x4 r = *(const f32x4*)(reds + rl * 4);
                    const float inv = 1.0f / ((r[0] + r[1]) + (r[2] + r[3]));
                    bf16_t* prow = (bf16_t*)(P->ws + W_P) + (size_t)(cur.row0 + rl) * 1024 + cur.col0;
#pragma unroll
                    for (int bj = 0; bj < 2; ++bj)
#pragma unroll
                        for (int n = 0; n < 2; ++n) {
                            const f32x4 v = acc[ai][bj][m][n];
                            u32x2 o; o.x = pk2(v[0] * inv, v[1] * inv); o.y = pk2(v[2] * inv, v[3] * inv);
                            *(u32x2*)(prow + bj * 128 + wc * 32 + n * 16 + fq * 4) = o;
                        }
                }
            __syncthreads();
        }
        u += nblk;
    }
#undef G_SA
#undef G_SB
#undef G_STAGE
#undef G_LDA
#undef G_LDB
#undef G_MMA
    const int rot = cfg.nbig % nblk;
    for (int s0 = (lb - rot + nblk) % nblk; s0 < cfg.nsmall; s0 += nblk) {
        const int pr = s0 / cfg.ncol64, pc = s0 % cfg.ncol64;
        const int row0 = TP + pr * 32, col0 = pc * 64;
        const bf16_t* Ab = (const bf16_t*)cfg.A + (size_t)row0 * cfg.lda;
        const bf16_t* Bb;
        if (gp == 3) { const int g = pc >> 2; Ab += g * 256; Bb = (const bf16_t*)cfg.B + (size_t)g * 65536 + (size_t)(col0 - g * 256) * 256; }
        else Bb = (const bf16_t*)cfg.B + (size_t)col0 * cfg.ldb;
        const int kw = K >> 3, nks = kw >> 5;
        f32x4 acc[2][4];
#pragma unroll
        for (int mi = 0; mi < 2; ++mi)
#pragma unroll
            for (int ni = 0; ni < 4; ++ni) acc[mi][ni] = (f32x4){0.f, 0.f, 0.f, 0.f};
        const bf16_t* ap = Ab + (size_t)fr * cfg.lda + wid * kw + fq * 8;
        const bf16_t* bp = Bb + (size_t)fr * cfg.ldb + wid * kw + fq * 8;
        for (int ks = 0; ks < nks; ++ks) {
            bf16x8 a[2], b[4];
#pragma unroll
            for (int mi = 0; mi < 2; ++mi) a[mi] = *(const bf16x8*)(ap + (size_t)mi * 16 * cfg.lda + ks * 32);
#pragma unroll
            for (int ni = 0; ni < 4; ++ni) b[ni] = *(const bf16x8*)(bp + (size_t)ni * 16 * cfg.ldb + ks * 32);
#pragma unroll
            for (int mi = 0; mi < 2; ++mi)
#pragma unroll
                for (int ni = 0; ni < 4; ++ni) acc[mi][ni] = __builtin_amdgcn_mfma_f32_16x16x32_bf16(b[ni], a[mi], acc[mi][ni], 0, 0, 0);
        }
        float* red = (float*)shm_g;
#pragma unroll
        for (int mi = 0; mi < 2; ++mi)
#pragma unroll
            for (int ni = 0; ni < 4; ++ni) *(f32x4*)(red + wid * 2048 + (mi * 16 + fr) * 64 + ni * 16 + fq * 4) = acc[mi][ni];
        __syncthreads();
        {
            const int r = tid >> 4, c = (tid & 15) * 4;
            f32x4 v = *(const f32x4*)(red + r * 64 + c);
#pragma unroll
            for (int w = 1; w < 8; ++w) v += *(const f32x4*)(red + w * 2048 + r * 64 + c);
            epi_apply_rt(P, cfg.ekind, row0 + r, col0 + c, v);
        }
        __syncthreads();
    }
}

__device__ __forceinline__ void tr_tile(const float* __restrict__ src, int ld_src, bf16_t* __restrict__ dst, int ld_dst, int k0, int n0s, int n0d, float* tile, const int tid) {
    { const int kr = tid >> 4, nc = (tid & 15) * 4;
#pragma unroll
      for (int i = 0; i < 2; ++i) { const int k = kr + i * 32; const f32x4 v = *(const f32x4*)(src + (size_t)(k0 + k) * ld_src + n0s + nc);
          tile[k * 65 + nc + 0] = v[0]; tile[k * 65 + nc + 1] = v[1]; tile[k * 65 + nc + 2] = v[2]; tile[k * 65 + nc + 3] = v[3]; } }
    __syncthreads();
    { const int n = tid >> 3, k8 = (tid & 7) * 8; float f[8];
#pragma unroll
      for (int e = 0; e < 8; ++e) f[e] = tile[(k8 + e) * 65 + n];
      *(u32x4*)(dst + (size_t)(n0d + n) * ld_dst + k0 + k8) = pack8(f); }
    __syncthreads();
}

__device__ __forceinline__ void phase_prep(PP P, char* shm, int blk, int nblk, const int tid) {
    const int wid = tid >> 6, lane = tid & 63;
    float* tile = (float*)shm;
    float* wdt = (float*)(shm + 32768);
    for (int i = tid; i < 1024 * 16; i += NTHR) { const int k = i >> 4, hd = i & 15; wdt[hd * 1024 + k] = P->w_in[(size_t)k * 3600 + 2560 + hd]; }
    __syncthreads();
    char* ws = P->ws;
    for (int it = blk; it < TT / 8 + 2048 / 8; it += nblk) {
        const bool ismem = it >= TT / 8;
        const int row = (ismem ? it - TT / 8 : it) * 8 + wid;
        const float* xr = ismem ? P->mem_prompt + (size_t)row * 1024 : (row < TP ? P->x_prompt + (size_t)row * 1024 : P->x_sample + (size_t)(row - TP) * 1024);
        const float* gg = ismem ? P->norm_memkv : P->norm_mix;
        bf16_t* orow = (bf16_t*)(ws + (ismem ? W_HM : W_H)) + (size_t)row * 1024;
        f32x4 xv[4]; float ss = 0.f;
#pragma unroll
        for (int j = 0; j < 4; ++j) { xv[j] = *(const f32x4*)(xr + j * 256 + lane * 4); ss += xv[j][0] * xv[j][0] + xv[j][1] * xv[j][1] + xv[j][2] * xv[j][2] + xv[j][3] * xv[j][3]; }
        ss = wave_sum(ss);
        const float rstd = rsqrtf(ss * (1.0f / 1024.0f) + EPS);
#pragma unroll
        for (int j = 0; j < 4; ++j) { const f32x4 g4 = *(const f32x4*)(gg + j * 256 + lane * 4); xv[j] = xv[j] * rstd * g4;
            u32x2 o; o.x = pk2(xv[j][0], xv[j][1]); o.y = pk2(xv[j][2], xv[j][3]); *(u32x2*)(orow + j * 256 + lane * 4) = o; }
        if (!ismem) {
            float mine = 0.f;
#pragma unroll
            for (int hd = 0; hd < 16; ++hd) {
                float acc = 0.f;
#pragma unroll
                for (int j = 0; j < 4; ++j) { const f32x4 w4 = *(const f32x4*)(wdt + hd * 1024 + j * 256 + lane * 4); acc += xv[j][0] * w4[0] + xv[j][1] * w4[1] + xv[j][2] * w4[2] + xv[j][3] * w4[3]; }
                acc = wave_sum(acc);
                if (lane == hd) mine = acc;
            }
            if (lane < 16) { const float x = mine + P->dt_bias[lane]; const float sp = x > 20.f ? x : log1pf(expf(x)); ((float*)(ws + W_DT))[(size_t)row * 16 + lane] = sp; }
        }
    }
    __syncthreads();
    for (int it = blk; it < 4608; it += nblk) {
        int i = it;
        if (i < 896) { const int kt = i / 56, ntl = i % 56; const int n0d = ntl * 64; const int n0s = n0d < 2560 ? n0d : n0d + 16; tr_tile(P->w_in, 3600, (bf16_t*)(ws + W_WIN), 1024, kt * 64, n0s, n0d, tile, tid); continue; }
        i -= 896;
        if (i < 64) { const int g = i >> 4, kt = (i >> 2) & 3, ntl = i & 3; tr_tile(P->w_pool + (size_t)g * 65536, 256, (bf16_t*)(ws + W_WPOOL) + (size_t)g * 65536, 256, kt * 64, ntl * 64, ntl * 64, tile, tid); continue; }
        i -= 64;
        if (i < 512) { const int kt = i >> 4, ntl = i & 15; tr_tile(P->w_out, 1024, (bf16_t*)(ws + W_WOUT), 2048, kt * 64, ntl * 64, ntl * 64, tile, tid); continue; }
        i -= 512;
        if (i < 1024) { const int wsel = i >> 8, r = i & 255, kt = r >> 4, ntl = r & 15;
            const float* src = wsel == 0 ? P->w_mq : wsel == 1 ? P->w_mk : wsel == 2 ? P->w_mv : P->w_mo;
            bf16_t* dst = (bf16_t*)(ws + (wsel == 0 ? W_WMQ : wsel == 1 ? W_WMK : wsel == 2 ? W_WMV : W_WMO));
            tr_tile(src, 1024, dst, 1024, kt * 64, ntl * 64, ntl * 64, tile, tid); continue; }
        i -= 1024;
        if (i < 1408) { const int kt = i / 88, ntl = i % 88; tr_tile(P->w_up, 5632, (bf16_t*)(ws + W_WUP), 1024, kt * 64, ntl * 64, ntl * 64, tile, tid); continue; }
        i -= 1408;
        { const int kt = i >> 4, ntl = i & 15; tr_tile(P->w_down, 1024, (bf16_t*)(ws + W_WDOWN), 2816, kt * 64, ntl * 64, ntl * 64, tile, tid); }
    }
}

__device__ __forceinline__ u32x4 ld8(const bf16_t* p) { return *(const u32x4*)p; }

__device__ __forceinline__ void phase_convpool(PP P, int gtid, int nthreads) {
    char* ws = P->ws;
    const bf16_t* proj2 = (const bf16_t*)(ws + W_PROJ2);
    bf16_t* xact = (bf16_t*)(ws + W_XACT);
    bf16_t* pooled = (bf16_t*)(ws + W_POOLED);
    for (int idx = gtid; idx < 1152 * 320; idx += nthreads) {
        const int run = idx / 320, cg = idx % 320;
        const bool samp = run >= 1024;
        int t0, len, bidx, tl0;
        if (!samp) { t0 = run * 16; len = 16; bidx = t0 >> 11; tl0 = t0 & 2047; } else { bidx = run - 1024; t0 = TP + bidx * 4; len = 4; tl0 = 0; }
        if (cg < 192) {
            const int c0 = cg * 8;
            float w0[8], w1[8], w2[8], w3[8], bs[8], h0[8], h1[8], h2[8];
#pragma unroll
            for (int e = 0; e < 8; ++e) { w0[e] = P->conv_w[c0 + e]; w1[e] = P->conv_w[1536 + c0 + e]; w2[e] = P->conv_w[3072 + c0 + e]; w3[e] = P->conv_w[4608 + c0 + e]; bs[e] = P->conv_b[c0 + e]; }
            if (samp) {
#pragma unroll
                for (int e = 0; e < 8; ++e) { h0[e] = P->state_conv[(size_t)(bidx * 3 + 0) * 1536 + c0 + e]; h1[e] = P->state_conv[(size_t)(bidx * 3 + 1) * 1536 + c0 + e]; h2[e] = P->state_conv[(size_t)(bidx * 3 + 2) * 1536 + c0 + e]; }
            } else if (tl0 > 0) {
                unpack8(ld8(proj2 + (size_t)(t0 - 3) * 2560 + c0), h0); unpack8(ld8(proj2 + (size_t)(t0 - 2) * 2560 + c0), h1); unpack8(ld8(proj2 + (size_t)(t0 - 1) * 2560 + c0), h2);
            } else {
#pragma unroll
                for (int e = 0; e < 8; ++e) { h0[e] = 0.f; h1[e] = 0.f; h2[e] = 0.f; }
            }
#pragma unroll 4
            for (int j = 0; j < len; ++j) {
                float x3[8], y[8]; unpack8(ld8(proj2 + (size_t)(t0 + j) * 2560 + c0), x3);
#pragma unroll
                for (int e = 0; e < 8; ++e) { const float v = bs[e] + w0[e] * h0[e] + w1[e] * h1[e] + w2[e] * h2[e] + w3[e] * x3[e]; y[e] = silu_f(v); }
                *(u32x4*)(xact + (size_t)(t0 + j) * 1536 + c0) = pack8(y);
                if (samp) { if (j >= 1) { float* o = P->out + O_CONVS + (size_t)(bidx * 3 + j - 1) * 1536 + c0;
#pragma unroll
                        for (int e = 0; e < 8; ++e) o[e] = x3[e]; } }
                else { const int tl = tl0 + j; if (tl >= 2045) { float* o = P->out + O_CONVP + (size_t)(bidx * 3 + tl - 2045) * 1536 + c0;
#pragma unroll
                        for (int e = 0; e < 8; ++e) o[e] = x3[e]; } }
#pragma unroll
                for (int e = 0; e < 8; ++e) { h0[e] = h1[e]; h1[e] = h2[e]; h2[e] = x3[e]; }
            }
        } else {
            const int c0 = (cg - 192) * 8; const int win = 2 << (c0 >> 8);
            const bf16_t* vp = proj2 + 1536 + c0;
            const float* prev = P->state_pool + (size_t)bidx * 15 * 1024 + c0;
            float sum[8];
#pragma unroll
            for (int e = 0; e < 8; ++e) sum[e] = 0.f;
            if (samp) {
                for (int jj = 1; jj < win; ++jj) {
#pragma unroll
                    for (int e = 0; e < 8; ++e) sum[e] += prev[(size_t)(15 - jj) * 1024 + e]; }
                float* o = P->out + O_POOLS + (size_t)bidx * 15 * 1024 + c0;
                for (int i = 0; i < 11; ++i) {
#pragma unroll
                    for (int e = 0; e < 8; ++e) o[(size_t)i * 1024 + e] = prev[(size_t)(i + 4) * 1024 + e]; }
            } else if (tl0 > 0) {
                for (int jj = 1; jj < win; ++jj) { float v[8]; unpack8(ld8(vp + (size_t)(t0 - jj) * 2560), v);
#pragma unroll
                    for (int e = 0; e < 8; ++e) sum[e] += v[e]; }
            }
            for (int j = 0; j < len; ++j) {
                float v[8], o8[8]; unpack8(ld8(vp + (size_t)(t0 + j) * 2560), v);
                const int tl = tl0 + j;
                const float inv = 1.0f / (float)(samp ? win : (tl + 1 < win ? tl + 1 : win));
#pragma unroll
                for (int e = 0; e < 8; ++e) { sum[e] += v[e]; o8[e] = sum[e] * inv - v[e]; }
                *(u32x4*)(pooled + (size_t)(t0 + j) * 1024 + c0) = pack8(o8);
                const int to = j - win + 1;
                if (samp) {
                    if (to >= 0) { float q[8]; unpack8(ld8(vp + (size_t)(t0 + to) * 2560), q);
#pragma unroll
                        for (int e = 0; e < 8; ++e) sum[e] -= q[e]; }
                    else {
#pragma unroll
                        for (int e = 0; e < 8; ++e) sum[e] -= prev[(size_t)(15 + to) * 1024 + e]; }
                    float* o = P->out + O_POOLS + (size_t)(bidx * 15 + 11 + j) * 1024 + c0;
#pragma unroll
                    for (int e = 0; e < 8; ++e) o[e] = v[e];
                } else {
                    if (tl0 + to >= 0) { float q[8]; unpack8(ld8(vp + (size_t)(t0 + to) * 2560), q);
#pragma unroll
                        for (int e = 0; e < 8; ++e) sum[e] -= q[e]; }
                    if (tl >= 2033) { float* o = P->out + O_POOLP + (size_t)(bidx * 15 + tl - 2033) * 1024 + c0;
#pragma unroll
                        for (int e = 0; e < 8; ++e) o[e] = v[e]; }
                }
            }
        }
    }
}

constexpr int CS_STR = 136;
constexpr int X_STR = 40;
__device__ __forceinline__ s16x4 tr_read(const bf16_t* p) { return __builtin_bit_cast(s16x4, __builtin_amdgcn_ds_read_tr16_b64_v4i16((LDSB s16x4*)p)); }

__device__ __forceinline__ void ssd_prompt(PP P, int item, char* shm, const int tid) {
    const int w = tid >> 6, lane = tid & 63, fr = lane & 15, fq = lane >> 4;
    const int b = item >> 5, hd = (item >> 1) & 15, ph = item & 1, g = hd >> 3;
    const float a = -expf(P->a_log[hd]);
    const float Dh = P->ssm_d[hd];
    char* ws = P->ws;
    const bf16_t* xact = (const bf16_t*)(ws + W_XACT);
    const float* dtb = (const float*)(ws + W_DT);
    bf16_t* ybuf = (bf16_t*)(ws + W_Y);
    bf16_t* Cs = (bf16_t*)(shm);
    bf16_t* Bs = (bf16_t*)(shm + 34816);
    bf16_t* Gs = (bf16_t*)(shm + 69632);
    bf16_t* Xd = (bf16_t*)(shm + 104448);
    bf16_t* X2 = (bf16_t*)(shm + 104448 + 10240);
    bf16_t* Hs = (bf16_t*)(shm + 124928);
    float* acs = (float*)(shm + 133632);
    float* dts = (float*)(shm + 134144);
    f32x4 Hacc[2];
    Hacc[0] = (f32x4){0.f, 0.f, 0.f, 0.f}; Hacc[1] = (f32x4){0.f, 0.f, 0.f, 0.f};
    const int q4 = fr >> 2, p4 = fr & 3;
    for (int c = 0; c < 16; ++c) {
        const int t0 = b * 2048 + c * 128;
        if (w == 0) {
            const float d0 = dtb[(size_t)(t0 + 2 * lane) * 16 + hd], d1 = dtb[(size_t)(t0 + 2 * lane + 1) * 16 + hd];
            const float s = (d0 + d1) * a; float v = s;
#pragma unroll
            for (int off = 1; off < 64; off <<= 1) { const float t = __shfl_up(v, off); if (lane >= off) v += t; }
            const float excl = v - s;
            acs[2 * lane] = excl + d0 * a; acs[2 * lane + 1] = v; dts[2 * lane] = d0; dts[2 * lane + 1] = d1;
        }
#pragma unroll
        for (int pt = 0; pt < 2; ++pt)
#pragma unroll
            for (int j = 0; j < 4; ++j) Hs[(pt * 16 + fq * 4 + j) * CS_STR + w * 16 + fr] = f2bf(Hacc[pt][j]);
#pragma unroll
        for (int i = 0; i < 4; ++i) {
            const int q = tid + i * 512, s = q >> 4, n8 = (q & 15) * 8;
            const bf16_t* src = xact + (size_t)(t0 + s) * 1536 + g * 128 + n8;
            *(u32x4*)(Cs + s * CS_STR + n8) = *(const u32x4*)(src + 1280);
            *(u32x4*)(Bs + s * CS_STR + n8) = *(const u32x4*)(src + 1024);
        }
        __syncthreads();
        {
            const int s = tid >> 2, p8 = (tid & 3) * 8;
            float x[8], xa[8], xb[8]; unpack8(ld8(xact + (size_t)(t0 + s) * 1536 + hd * 64 + ph * 32 + p8), x);
            const float dtv = dts[s], dec = __expf(acs[127] - acs[s]) * dtv;
#pragma unroll
            for (int e = 0; e < 8; ++e) { xa[e] = x[e] * dtv; xb[e] = x[e] * dec; }
            *(u32x4*)(Xd + s * X_STR + p8) = pack8(xa);
            *(u32x4*)(X2 + s * X_STR + p8) = pack8(xb);
        }
        bf16x8 Cf[4];
#pragma unroll
        for (int kk = 0; kk < 4; ++kk) Cf[kk] = *(const bf16x8*)(Cs + (w * 16 + fr) * CS_STR + kk * 32 + fq * 8);
        const int nst = (w | 1) + 1;
#pragma unroll
        for (int st = 0; st < 8; ++st) {
            if (st < nst) {
                f32x4 ga = (f32x4){0.f, 0.f, 0.f, 0.f};
#pragma unroll
                for (int kk = 0; kk < 4; ++kk) { const bf16x8 Bf = *(const bf16x8*)(Bs + (st * 16 + fr) * CS_STR + kk * 32 + fq * 8); ga = __builtin_amdgcn_mfma_f32_16x16x32_bf16(Cf[kk], Bf, ga, 0, 0, 0); }
                const int s = st * 16 + fr; const float as = acs[s];
#pragma unroll
                for (int j = 0; j < 4; ++j) { const int l = w * 16 + fq * 4 + j; const float val = (s <= l) ? ga[j] * __expf(acs[l] - as) : 0.f; Gs[l * CS_STR + s] = f2bf(val); }
            }
        }
        __syncthreads();
        {
            f32x4 Yd[2], Yo[2];
            Yd[0] = Yd[1] = Yo[0] = Yo[1] = (f32x4){0.f, 0.f, 0.f, 0.f};
            const int nkk = (w >> 1) + 1;
#pragma unroll
            for (int kk = 0; kk < 4; ++kk) {
                if (kk < nkk) {
                    const bf16x8 Gf = *(const bf16x8*)(Gs + (w * 16 + fr) * CS_STR + kk * 32 + fq * 8);
#pragma unroll
                    for (int pt = 0; pt < 2; ++pt) {
                        const bf16_t* base = Xd + (kk * 32 + fq * 8 + q4) * X_STR + pt * 16 + p4 * 4;
                        bf16x8 Xf; Xf.lo = tr_read(base); Xf.hi = tr_read(base + 4 * X_STR);
                        Yd[pt] = __builtin_amdgcn_mfma_f32_16x16x32_bf16(Gf, Xf, Yd[pt], 0, 0, 0);
                    }
                }
            }
#pragma unroll
            for (int kk = 0; kk < 4; ++kk)
#pragma unroll
                for (int pt = 0; pt < 2; ++pt) { const bf16x8 Hf = *(const bf16x8*)(Hs + (pt * 16 + fr) * CS_STR + kk * 32 + fq * 8); Yo[pt] = __builtin_amdgcn_mfma_f32_16x16x32_bf16(Cf[kk], Hf, Yo[pt], 0, 0, 0); }
#pragma unroll
            for (int j = 0; j < 4; ++j) {
                const int l = w * 16 + fq * 4 + j; const float el = __expf(acs[l]);
#pragma unroll
                for (int pt = 0; pt < 2; ++pt) {
                    const int pcol = hd * 64 + ph * 32 + pt * 16 + fr;
                    const float xr = bf2f(xact[(size_t)(t0 + l) * 1536 + pcol]);
                    ybuf[(size_t)(t0 + l) * 1024 + pcol] = f2bf(Yd[pt][j] + el * Yo[pt][j] + Dh * xr);
                }
            }
        }
        {
            const float dc = __expf(acs[127]);
            Hacc[0] *= dc; Hacc[1] *= dc;
#pragma unroll
            for (int kk = 0; kk < 4; ++kk) {
                const bf16_t* bb = Bs + (kk * 32 + fq * 8 + q4) * CS_STR + w * 16 + p4 * 4;
                bf16x8 Bf; Bf.lo = tr_read(bb); Bf.hi = tr_read(bb + 4 * CS_STR);
#pragma unroll
                for (int pt = 0; pt < 2; ++pt) {
                    const bf16_t* xb = X2 + (kk * 32 + fq * 8 + q4) * X_STR + pt * 16 + p4 * 4;
                    bf16x8 Xf; Xf.lo = tr_read(xb); Xf.hi = tr_read(xb + 4 * X_STR);
                    Hacc[pt] = __builtin_amdgcn_mfma_f32_16x16x32_bf16(Xf, Bf, Hacc[pt], 0, 0, 0);
                }
            }
        }
        __syncthreads();
    }
    float* so = P->out + O_SSMP + ((size_t)(b * 16 + hd) * 64 + ph * 32) * 128;
#pragma unroll
    for (int pt = 0; pt < 2; ++pt)
#pragma unroll
        for (int j = 0; j < 4; ++j) so[(size_t)(pt * 16 + fq * 4 + j) * 128 + w * 16 + fr] = Hacc[pt][j];
}

__device__ __forceinline__ void ssd_sample(PP P, int item, const int tid) {
    const int b = item >> 4, hd = item & 15, g = hd >> 3;
    const int p = tid >> 3, n0 = (tid & 7) * 16;
    const float a = -expf(P->a_log[hd]);
    const float Dh = P->ssm_d[hd];
    char* ws = P->ws;
    const bf16_t* xact = (const bf16_t*)(ws + W_XACT);
    const float* dtb = (const float*)(ws + W_DT);
    bf16_t* ybuf = (bf16_t*)(ws + W_Y);
    const size_t sidx = ((size_t)(b * 16 + hd) * 64 + p) * 128 + n0;
    float h[16];
#pragma unroll
    for (int i = 0; i < 4; ++i) { const f32x4 v = *(const f32x4*)(P->state_ssm + sidx + i * 4); h[i * 4] = v[0]; h[i * 4 + 1] = v[1]; h[i * 4 + 2] = v[2]; h[i * 4 + 3] = v[3]; }
#pragma unroll
    for (int i = 0; i < 4; ++i) {
        const int t = TP + b * 4 + i;
        const float xv = bf2f(xact[(size_t)t * 1536 + hd * 64 + p]);
        const float dtv = dtb[(size_t)t * 16 + hd];
        const float dA = __expf(dtv * a), dx = dtv * xv;
        float Bv[16], Cv[16];
        { float t8[8]; unpack8(ld8(xact + (size_t)t * 1536 + 1024 + g * 128 + n0), t8);
#pragma unroll
          for (int e = 0; e < 8; ++e) Bv[e] = t8[e];
          unpack8(ld8(xact + (size_t)t * 1536 + 1024 + g * 128 + n0 + 8), t8);
#pragma unroll
          for (int e = 0; e < 8; ++e) Bv[8 + e] = t8[e];
          unpack8(ld8(xact + (size_t)t * 1536 + 1280 + g * 128 + n0), t8);
#pragma unroll
          for (int e = 0; e < 8; ++e) Cv[e] = t8[e];
          unpack8(ld8(xact + (size_t)t * 1536 + 1280 + g * 128 + n0 + 8), t8);
#pragma unroll
          for (int e = 0; e < 8; ++e) Cv[8 + e] = t8[e]; }
        float part = 0.f;
#pragma unroll
        for (int e = 0; e < 16; ++e) { h[e] = h[e] * dA + dx * Bv[e]; part += h[e] * Cv[e]; }
        part += __shfl_xor(part, 1); part += __shfl_xor(part, 2); part += __shfl_xor(part, 4);
        if ((tid & 7) == 0) ybuf[(size_t)t * 1024 + hd * 64 + p] = f2bf(part + Dh * xv);
    }
    float* so = P->out + O_SSMS + sidx;
#pragma unroll
    for (int i = 0; i < 4; ++i) *(f32x4*)(so + i * 4) = (f32x4){h[i * 4], h[i * 4 + 1], h[i * 4 + 2], h[i * 4 + 3]};
}

__device__ __forceinline__ void phase_gatednorm(PP P, int gw, int nw, const int tid) {
    const int lane = tid & 63;
    char* ws = P->ws;
    const bf16_t* ybuf = (const bf16_t*)(ws + W_Y); const bf16_t* zbuf = (const bf16_t*)(ws + W_Z);
    bf16_t* mix = (bf16_t*)(ws + W_MIX);
    for (int row = gw; row < TT; row += nw) {
        float t[4][4]; float ss0 = 0.f, ss1 = 0.f;
#pragma unroll
        for (int j = 0; j < 4; ++j) {
            const u32x2 yv = *(const u32x2*)(ybuf + (size_t)row * 1024 + j * 256 + lane * 4);
            const u32x2 zv = *(const u32x2*)(zbuf + (size_t)row * 1024 + j * 256 + lane * 4);
            const float y0 = bflo(yv.x), y1 = bfhi(yv.x), y2 = bflo(yv.y), y3 = bfhi(yv.y);
            const float z0 = bflo(zv.x), z1 = bfhi(zv.x), z2 = bflo(zv.y), z3 = bfhi(zv.y);
            t[j][0] = y0 * silu_f(z0); t[j][1] = y1 * silu_f(z1); t[j][2] = y2 * silu_f(z2); t[j][3] = y3 * silu_f(z3);
            const float q = t[j][0] * t[j][0] + t[j][1] * t[j][1] + t[j][2] * t[j][2] + t[j][3] * t[j][3];
            if (j < 2) ss0 += q; else ss1 += q;
        }
        ss0 = wave_sum(ss0); ss1 = wave_sum(ss1);
        const float r0 = rsqrtf(ss0 * (1.0f / 512.0f) + EPS), r1 = rsqrtf(ss1 * (1.0f / 512.0f) + EPS);
#pragma unroll
        for (int j = 0; j < 4; ++j) {
            const float r = j < 2 ? r0 : r1;
            const f32x4 g4 = *(const f32x4*)(P->ssm_norm + j * 256 + lane * 4);
            u32x2 o; o.x = pk2(t[j][0] * r * g4[0], t[j][1] * r * g4[1]); o.y = pk2(t[j][2] * r * g4[2], t[j][3] * r * g4[3]);
            *(u32x2*)(mix + (size_t)row * 2048 + j * 256 + lane * 4) = o;
        }
    }
}

__device__ __forceinline__ void phase_norm(PP P, const float* gain, bool final_out, int gw, int nw, const int tid) {
    const int lane = tid & 63;
    char* ws = P->ws;
    const float* xres = (const float*)(ws + W_XRES);
    for (int row = gw; row < TT; row += nw) {
        f32x4 xv[4]; float ss = 0.f;
#pragma unroll
        for (int j = 0; j < 4; ++j) { xv[j] = *(const f32x4*)(xres + (size_t)row * 1024 + j * 256 + lane * 4); ss += xv[j][0] * xv[j][0] + xv[j][1] * xv[j][1] + xv[j][2] * xv[j][2] + xv[j][3] * xv[j][3]; }
        ss = wave_sum(ss);
        const float rstd = rsqrtf(ss * (1.0f / 1024.0f) + EPS);
#pragma unroll
        for (int j = 0; j < 4; ++j) {
            const f32x4 g4 = *(const f32x4*)(gain + j * 256 + lane * 4);
            const f32x4 y = xv[j] * rstd * g4;
            if (final_out) *(f32x4*)(P->out + O_YP + (size_t)row * 1024 + j * 256 + lane * 4) = y;
            else { u32x2 o; o.x = pk2(y[0], y[1]); o.y = pk2(y[2], y[3]); *(u32x2*)((bf16_t*)(ws + W_H) + (size_t)row * 1024 + j * 256 + lane * 4) = o; }
        }
    }
}

__device__ __forceinline__ void attn_sample(PP P, int item, char* shm, const int tid) {
    const int w = tid >> 6, lane = tid & 63, fr = lane & 15, fq = lane >> 4;
    const int b = item >> 2, hh = item & 3;
    char* ws = P->ws;
    const bf16_t* qb = (const bf16_t*)(ws + W_Q);
    float* sc = (float*)shm;
    float* part = (float*)(shm + 4096);
    bf16x8 qf[8];
#pragma unroll
    for (int kk = 0; kk < 8; ++kk) {
        bf16x8 z = {0, 0, 0, 0, 0, 0, 0, 0};
        if (fr < 4) z = *(const bf16x8*)(qb + (size_t)(TP + b * 4 + fr) * 1024 + hh * 256 + kk * 32 + fq * 8);
        qf[kk] = z;
    }
#pragma unroll
    for (int mt = 0; mt < 2; ++mt) {
        const int key = w * 32 + mt * 16 + fr;
        const float* kp = P->cache_k + ((size_t)(b * 256 + key) * 4 + hh) * 256 + fq * 8;
        f32x4 acc = (f32x4){0.f, 0.f, 0.f, 0.f};
#pragma unroll
        for (int kk = 0; kk < 8; ++kk) {
            const f32x4 k0 = *(const f32x4*)(kp + kk * 32), k1 = *(const f32x4*)(kp + kk * 32 + 4);
            u32x4 pk; pk.x = pk2(k0[0], k0[1]); pk.y = pk2(k0[2], k0[3]); pk.z = pk2(k1[0], k1[1]); pk.w = pk2(k1[2], k1[3]);
            acc = __builtin_amdgcn_mfma_f32_16x16x32_bf16(qf[kk], __builtin_bit_cast(bf16x8, pk), acc, 0, 0, 0);
        }
        if (fq == 0) {
#pragma unroll
            for (int j = 0; j < 4; ++j) sc[j * 256 + w * 32 + mt * 16 + fr] = acc[j];
        }
    }
    __syncthreads();
    if (w < 4) {
        f32x4 s = *(const f32x4*)(sc + w * 256 + lane * 4);
        float m = fmaxf(fmaxf(s[0], s[1]), fmaxf(s[2], s[3])); m = wave_max(m);
        s[0] = __expf(s[0] - m); s[1] = __expf(s[1] - m); s[2] = __expf(s[2] - m); s[3] = __expf(s[3] - m);
        float su = (s[0] + s[1]) + (s[2] + s[3]); su = wave_sum(su);
        const float inv = 1.0f / su;
        *(f32x4*)(sc + w * 256 + lane * 4) = s * inv;
    }
    __syncthreads();
    {
        f32x4 o[4];
#pragma unroll
        for (int i = 0; i < 4; ++i) o[i] = (f32x4){0.f, 0.f, 0.f, 0.f};
        const float* vp = P->cache_v + ((size_t)(b * 256 + w * 32) * 4 + hh) * 256 + lane * 4;
#pragma unroll 8
        for (int mm = 0; mm < 32; ++mm) {
            const f32x4 v = *(const f32x4*)(vp + (size_t)mm * 1024);
#pragma unroll
            for (int i = 0; i < 4; ++i) o[i] += sc[i * 256 + w * 32 + mm] * v;
        }
#pragma unroll
        for (int i = 0; i < 4; ++i) *(f32x4*)(part + (w * 4 + i) * 256 + lane * 4) = o[i];
    }
    __syncthreads();
    {
        const int i = tid >> 7, d2 = (tid & 127) * 2;
        float s0 = 0.f, s1 = 0.f;
#pragma unroll
        for (int ww = 0; ww < 8; ++ww) { s0 += part[(ww * 4 + i) * 256 + d2]; s1 += part[(ww * 4 + i) * 256 + d2 + 1]; }
        *(unsigned*)((bf16_t*)(ws + W_O) + (size_t)(TP + b * 4 + i) * 1024 + hh * 256 + d2) = pk2(s0, s1);
    }
    __syncthreads();
}

__device__ __forceinline__ void phase_ffnconv(PP P, int gtid, int nthreads) {
    char* ws = P->ws;
    const bf16_t* u = (const bf16_t*)(ws + W_U);
    bf16_t* act = (bf16_t*)(ws + W_ACT);
    for (int idx = gtid; idx < 1152 * 352; idx += nthreads) {
        const int run = idx / 352, cg = idx % 352;
        const bool samp = run >= 1024;
        int t0, len, bidx, tl0;
        if (!samp) { t0 = run * 16; len = 16; bidx = t0 >> 11; tl0 = t0 & 2047; } else { bidx = run - 1024; t0 = TP + bidx * 4; len = 4; tl0 = 0; }
        const int cgc = cg * 8, cvc = 2816 + cg * 8;
        float wg0[8], wg1[8], wg2[8], wv0[8], wv1[8], wv2[8], bg[8], bv[8], hg0[8], hg1[8], hv0[8], hv1[8];
#pragma unroll
        for (int e = 0; e < 8; ++e) {
            wg0[e] = P->ffn_w[cgc + e]; wg1[e] = P->ffn_w[5632 + cgc + e]; wg2[e] = P->ffn_w[11264 + cgc + e];
            wv0[e] = P->ffn_w[cvc + e]; wv1[e] = P->ffn_w[5632 + cvc + e]; wv2[e] = P->ffn_w[11264 + cvc + e];
            bg[e] = P->ffn_b[cgc + e]; bv[e] = P->ffn_b[cvc + e];
        }
        if (samp) {
#pragma unroll
            for (int e = 0; e < 8; ++e) {
                hg0[e] = P->state_ffn[(size_t)(bidx * 2 + 0) * 5632 + cgc + e]; hg1[e] = P->state_ffn[(size_t)(bidx * 2 + 1) * 5632 + cgc + e];
                hv0[e] = P->state_ffn[(size_t)(bidx * 2 + 0) * 5632 + cvc + e]; hv1[e] = P->state_ffn[(size_t)(bidx * 2 + 1) * 5632 + cvc + e];
            }
        } else if (tl0 > 0) {
            unpack8(ld8(u + (size_t)(t0 - 2) * 5632 + cgc), hg0); unpack8(ld8(u + (size_t)(t0 - 1) * 5632 + cgc), hg1);
            unpack8(ld8(u + (size_t)(t0 - 2) * 5632 + cvc), hv0); unpack8(ld8(u + (size_t)(t0 - 1) * 5632 + cvc), hv1);
        } else {
#pragma unroll
            for (int e = 0; e < 8; ++e) { hg0[e] = 0.f; hg1[e] = 0.f; hv0[e] = 0.f; hv1[e] = 0.f; }
        }
#pragma unroll 4
        for (int j = 0; j < len; ++j) {
            float ug[8], uv[8], o8[8];
            unpack8(ld8(u + (size_t)(t0 + j) * 5632 + cgc), ug); unpack8(ld8(u + (size_t)(t0 + j) * 5632 + cvc), uv);
#pragma unroll
            for (int e = 0; e < 8; ++e) {
                const float gc = bg[e] + wg0[e] * hg0[e] + wg1[e] * hg1[e] + wg2[e] * ug[e];
                const float vc = bv[e] + wv0[e] * hv0[e] + wv1[e] * hv1[e] + wv2[e] * uv[e];
                o8[e] = silu_f(gc) * vc;
            }
            *(u32x4*)(act + (size_t)(t0 + j) * 2816 + cgc) = pack8(o8);
            float* o = nullptr;
            if (samp) { if (j >= 2) o = P->out + O_FFNS + (size_t)(bidx * 2 + j - 2) * 5632; }
            else { const int tl = tl0 + j; if (tl >= 2046) o = P->out + O_FFNP + (size_t)(bidx * 2 + tl - 2046) * 5632; }
            if (o) {
#pragma unroll
                for (int e = 0; e < 8; ++e) { o[cgc + e] = ug[e]; o[cvc + e] = uv[e]; }
            }
#pragma unroll
            for (int e = 0; e < 8; ++e) { hg0[e] = hg1[e]; hg1[e] = ug[e]; hv0[e] = hv1[e]; hv1[e] = uv[e]; }
        }
    }
}

extern __shared__ __attribute__((aligned(16))) char smem[];

__global__ void __launch_bounds__(NTHR) hybrid_fwd(Params Pin) {
    cg::grid_group grid = cg::this_grid();
    char* shm = smem;
    const int nblk = gridDim.x;
    for (int ph = Pin.ph_lo; ph < Pin.ph_hi; ++ph) {
        int tid = threadIdx.x, blk = blockIdx.x;
        asm volatile("" : "+v"(tid));
        asm volatile("" : "+s"(blk));
        PP P = (PP)__builtin_amdgcn_kernarg_segment_ptr();
        asm volatile("" : "+s"(P));
        const int lb = (blk & 7) * (nblk >> 3) + (blk >> 3);
        const int gtid = blk * NTHR + tid, nthreads = nblk * NTHR;
        const int gw = blk * 8 + (tid >> 6), nw = nblk * 8;
        switch (ph) {
#if PHASE_MASK & 1
        case 0: phase_prep(P, shm, blk, nblk, tid); break;
#endif
#if PHASE_MASK & 4
        case 2: phase_convpool(P, gtid, nthreads); break;
#endif
#if PHASE_MASK & 8
        case 3:
            for (int it = blk; it < 256; it += nblk) ssd_prompt(P, it, shm, tid);
            for (int it = blk; it < 2048; it += nblk) ssd_sample(P, it, tid);
            break;
#endif
#if PHASE_MASK & 16
        case 4: phase_gatednorm(P, gw, nw, tid); break;
#endif
#if PHASE_MASK & 64
        case 6: phase_norm(P, P->norm_mem, false, gw, nw, tid); break;
        case 11: phase_norm(P, P->norm_ffn, false, gw, nw, tid); break;
        case 15: phase_norm(P, P->final_norm, true, gw, nw, tid); break;
#endif
#if PHASE_MASK & 8192
        case 13: phase_ffnconv(P, gtid, nthreads); break;
#endif
        default: break;
        }
#if PHASE_MASK & 2
        if (ph == 1 || ph == 3 || ph == 5 || ph == 7 || ph == 8 || ph == 9 || ph == 10 || ph == 12 || ph == 14) gemm_phase(P, ph, shm, lb, nblk, tid);
#endif
#if PHASE_MASK & 256
        if (ph == 8) { for (int it = blk; it < 512; it += nblk) attn_sample(P, it, shm, tid); }
#endif
        if (ph + 1 < Pin.ph_hi) grid.sync();
    }
}

extern "C" void kernel_launch(void* const* d_in, const int* in_sizes, int n_in, void* d_out, int out_size, void* d_ws, size_t ws_size, hipStream_t stream) {
    static int grid_blocks = 0;
    if (!grid_blocks) {
        int dev = 0, cus = 0, per_cu = 0;
        hipGetDevice(&dev);
        hipDeviceGetAttribute(&cus, hipDeviceAttributeMultiprocessorCount, dev);
        hipFuncSetAttribute((const void*)hybrid_fwd, hipFuncAttributeMaxDynamicSharedMemorySize, LDS_BYTES);
        hipOccupancyMaxActiveBlocksPerMultiprocessor(&per_cu, hybrid_fwd, NTHR, LDS_BYTES);
        if (per_cu < 1) per_cu = 1;
        grid_blocks = cus * 1;
        grid_blocks &= ~7;
        if (grid_blocks < 8) grid_blocks = 8;
    }
    Params p{};
    const float* const* in = (const float* const*)d_in;
    p.x_prompt = in[0]; p.x_sample = in[1]; p.mem_prompt = in[2]; p.state_ssm = in[3]; p.state_conv = in[4]; p.state_pool = in[5]; p.state_ffn = in[6];
    p.cache_k = in[7]; p.cache_v = in[8]; p.norm_mix = in[9]; p.w_in = in[10]; p.conv_w = in[11]; p.conv_b = in[12]; p.dt_bias = in[13]; p.a_log = in[14];
    p.ssm_d = in[15]; p.ssm_norm = in[16]; p.w_pool = in[17]; p.pool_scale = in[18]; p.w_out = in[19]; p.norm_mem = in[20]; p.norm_memkv = in[21];
    p.w_mq = in[22]; p.w_mk = in[23]; p.w_mv = in[24]; p.w_mo = in[25]; p.norm_ffn = in[26]; p.w_up = in[27]; p.ffn_w = in[28]; p.ffn_b = in[29];
    p.w_down = in[30]; p.final_norm = in[31];
    p.out = (float*)d_out; p.ws = (char*)d_ws; p.ph_lo = 0; p.ph_hi = 16;
    void* args[] = {&p};
    hipError_t e = hipLaunchCooperativeKernel((const void*)hybrid_fwd, dim3(grid_blocks), dim3(NTHR), args, LDS_BYTES, stream);
    if (e != hipSuccess) fprintf(stderr, "cooperative launch failed: %s (grid %d)\n", hipGetErrorString(e), grid_blocks);
}
```

```cpp
#include <hip/hip_runtime.h>
#include <hip/hip_cooperative_groups.h>
#include <cstdio>
namespace cg = cooperative_groups;

typedef unsigned short bf16_t;
typedef short bf16x8 __attribute__((ext_vector_type(8)));
typedef short s16x4 __attribute__((ext_vector_type(4)));
typedef float f32x4 __attribute__((ext_vector_type(4)));
typedef unsigned u32x4 __attribute__((ext_vector_type(4)));
typedef unsigned u32x2 __attribute__((ext_vector_type(2)));
#define LDSB __attribute__((address_space(3)))

constexpr int TP = 16384, TS = 512, TT = TP + TS;
constexpr int NTHR = 512;
constexpr int LDS_BYTES = 139264 + 256;
constexpr float EPS = 1e-6f;
#ifndef PHASE_MASK
#define PHASE_MASK 0xFFFF
#endif
#ifndef REPEAT_MASK
#define REPEAT_MASK 0
#endif
#ifndef EXTRA_SYNCS
#define EXTRA_SYNCS 0
#endif

constexpr size_t O_YP = 0;
constexpr size_t O_YS = O_YP + (size_t)TP * 1024;
constexpr size_t O_SSMP = O_YS + (size_t)TS * 1024;
constexpr size_t O_SSMS = O_SSMP + (size_t)8 * 16 * 64 * 128;
constexpr size_t O_CONVP = O_SSMS + (size_t)128 * 16 * 64 * 128;
constexpr size_t O_CONVS = O_CONVP + (size_t)8 * 3 * 1536;
constexpr size_t O_POOLP = O_CONVS + (size_t)128 * 3 * 1536;
constexpr size_t O_POOLS = O_POOLP + (size_t)8 * 15 * 1024;
constexpr size_t O_FFNP = O_POOLS + (size_t)128 * 15 * 1024;
constexpr size_t O_FFNS = O_FFNP + (size_t)8 * 2 * 5632;
constexpr size_t O_MK = O_FFNS + (size_t)128 * 2 * 5632;
constexpr size_t O_MV = O_MK + (size_t)8 * 256 * 1024;

constexpr size_t W_WIN = 0;
constexpr size_t W_WPOOL = W_WIN + (size_t)3584 * 1024 * 2;
constexpr size_t W_WOUT = W_WPOOL + (size_t)4 * 256 * 256 * 2;
constexpr size_t W_WMQ = W_WOUT + (size_t)1024 * 2048 * 2;
constexpr size_t W_WMK = W_WMQ + (size_t)1024 * 1024 * 2;
constexpr size_t W_WMV = W_WMK + (size_t)1024 * 1024 * 2;
constexpr size_t W_WMO = W_WMV + (size_t)1024 * 1024 * 2;
constexpr size_t W_WUP = W_WMO + (size_t)1024 * 1024 * 2;
constexpr size_t W_WDOWN = W_WUP + (size_t)5632 * 1024 * 2;
constexpr size_t W_H = W_WDOWN + (size_t)1024 * 2816 * 2;
constexpr size_t W_HM = W_H + (size_t)TT * 1024 * 2;
constexpr size_t W_KB = W_HM + (size_t)2048 * 1024 * 2;
constexpr size_t W_VT = W_KB + (size_t)2048 * 1024 * 2;
constexpr size_t W_DT = W_VT + (size_t)2048 * 1024 * 2;
constexpr size_t W_XRES = W_DT + (size_t)TT * 16 * 4;
constexpr size_t W_ARENA = W_XRES + (size_t)TT * 1024 * 4;
constexpr size_t W_Z = W_ARENA;
constexpr size_t W_PROJ2 = W_Z + (size_t)TT * 1024 * 2;
constexpr size_t W_XACT = W_PROJ2 + (size_t)TT * 2560 * 2;
constexpr size_t W_POOLED = W_XACT + (size_t)TT * 1536 * 2;
constexpr size_t W_Y = W_POOLED + (size_t)TT * 1024 * 2;
constexpr size_t W_MIX = W_Y + (size_t)TT * 1024 * 2;
constexpr size_t W_END_A = W_MIX + (size_t)TT * 2048 * 2;
constexpr size_t W_Q = W_PROJ2;
constexpr size_t W_P = W_Q + (size_t)TT * 1024 * 2;
constexpr size_t W_O = W_P + (size_t)TP * 1024 * 2;
constexpr size_t W_U = W_ARENA;
constexpr size_t W_ACT = W_U + (size_t)TT * 5632 * 2;
constexpr size_t W_END_C = W_ACT + (size_t)TT * 2816 * 2;
constexpr size_t W_BAR = W_END_A;
constexpr size_t W_TOTAL = W_BAR + 16384;
static_assert(W_O + (size_t)TT * 1024 * 2 <= W_POOLED, "era B overflow");
static_assert(W_END_C <= W_END_A, "era C overflow");

struct Params {
    const float *x_prompt, *x_sample, *mem_prompt, *state_ssm, *state_conv, *state_pool, *state_ffn, *cache_k, *cache_v;
    const float *norm_mix, *w_in, *conv_w, *conv_b, *dt_bias, *a_log, *ssm_d, *ssm_norm, *w_pool, *pool_scale, *w_out;
    const float *norm_mem, *norm_memkv, *w_mq, *w_mk, *w_mv, *w_mo, *norm_ffn, *w_up, *ffn_w, *ffn_b, *w_down, *final_norm;
    float* out;
    char* ws;
    int ph_lo, ph_hi;
};

typedef const __attribute__((address_space(4))) Params* PP;

__device__ __forceinline__ unsigned pk2(float lo, float hi) { unsigned r; asm("v_cvt_pk_bf16_f32 %0, %1, %2" : "=v"(r) : "v"(lo), "v"(hi)); return r; }
__device__ __forceinline__ bf16_t f2bf(float f) { return (bf16_t)(pk2(f, 0.f) & 0xffffu); }
__device__ __forceinline__ float bf2f(bf16_t b) { return __uint_as_float(((unsigned)b) << 16); }
__device__ __forceinline__ float bflo(unsigned u) { return __uint_as_float(u << 16); }
__device__ __forceinline__ float bfhi(unsigned u) { return __uint_as_float(u & 0xffff0000u); }
__device__ __forceinline__ void unpack8(u32x4 v, float (&f)[8]) {
    f[0] = bflo(v.x); f[1] = bfhi(v.x); f[2] = bflo(v.y); f[3] = bfhi(v.y); f[4] = bflo(v.z); f[5] = bfhi(v.z); f[6] = bflo(v.w); f[7] = bfhi(v.w);
}
__device__ __forceinline__ u32x4 pack8(const float (&f)[8]) { u32x4 r; r.x = pk2(f[0], f[1]); r.y = pk2(f[2], f[3]); r.z = pk2(f[4], f[5]); r.w = pk2(f[6], f[7]); return r; }
__device__ __forceinline__ float wave_sum(float v) {
#pragma unroll
    for (int o = 1; o < 64; o <<= 1) v += __shfl_xor(v, o);
    return v;
}
__device__ __forceinline__ float wave_max(float v) {
#pragma unroll
    for (int o = 1; o < 64; o <<= 1) v = fmaxf(v, __shfl_xor(v, o));
    return v;
}
__device__ __forceinline__ float silu_f(float x) { return x / (1.0f + __expf(-x)); }

constexpr int HTB = 128 * 64 * 2;
__device__ __forceinline__ int lds_byte(int r, int c) { const int st = (r >> 4) * 2 + (c >> 5), rr = r & 15, cc = c & 31, ob = rr * 64 + cc * 2; return st * 1024 + (ob ^ (((ob >> 9) & 1) << 5)); }
__device__ __forceinline__ void stage_rc(int b, int& R, int& C) { const int st = b / 1024, sb = b % 1024, swz = sb ^ (((sb >> 9) & 1) << 5); R = (st >> 1) * 16 + swz / 64; C = (st & 1) * 32 + (swz % 64) / 2; }

enum { E_PROJ = 0, E_MEMKV, E_POOL, E_OUT, E_Q, E_QK, E_PV, E_MO, E_UP, E_DOWN };

template <int EK>
__device__ __forceinline__ void epi_apply(PP P, int row, int col, f32x4 v) {
    char* ws = P->ws;
    if constexpr (EK == E_PROJ) {
        u32x2 o; o.x = pk2(v[0], v[1]); o.y = pk2(v[2], v[3]);
        if (col < 1024) *(u32x2*)((bf16_t*)(ws + W_Z) + (size_t)row * 1024 + col) = o;
        else *(u32x2*)((bf16_t*)(ws + W_PROJ2) + (size_t)row * 2560 + (col - 1024)) = o;
    } else if constexpr (EK == E_MEMKV) {
        if (col < 1024) {
            *(f32x4*)(P->out + O_MK + (size_t)row * 1024 + col) = v;
            u32x2 o; o.x = pk2(v[0], v[1]); o.y = pk2(v[2], v[3]);
            *(u32x2*)((bf16_t*)(ws + W_KB) + (size_t)row * 1024 + col) = o;
        } else {
            const int c = col - 1024;
            *(f32x4*)(P->out + O_MV + (size_t)row * 1024 + c) = v;
            const int b = row >> 8, m = row & 255, hh = c >> 8, d = c & 255;
            bf16_t* vt = (bf16_t*)(ws + W_VT) + ((size_t)(b * 4 + hh) * 256 + d) * 256 + m;
#pragma unroll
            for (int j = 0; j < 4; ++j) vt[j * 256] = f2bf(v[j]);
        }
    } else if constexpr (EK == E_POOL) {
        const f32x4 sc = *(const f32x4*)(P->pool_scale + col);
        u32x2 o; o.x = pk2(v[0] * sc[0], v[1] * sc[1]); o.y = pk2(v[2] * sc[2], v[3] * sc[3]);
        *(u32x2*)((bf16_t*)(ws + W_MIX) + (size_t)row * 2048 + 1024 + col) = o;
    } else if constexpr (EK == E_OUT) {
        const float* xin = row < TP ? P->x_prompt + (size_t)row * 1024 : P->x_sample + (size_t)(row - TP) * 1024;
        const f32x4 x = *(const f32x4*)(xin + col);
        *(f32x4*)((float*)(ws + W_XRES) + (size_t)row * 1024 + col) = x + v;
    } else if constexpr (EK == E_Q) {
        u32x2 o; o.x = pk2(v[0] * 0.0625f, v[1] * 0.0625f); o.y = pk2(v[2] * 0.0625f, v[3] * 0.0625f);
        *(u32x2*)((bf16_t*)(ws + W_Q) + (size_t)row * 1024 + col) = o;
    } else if constexpr (EK == E_PV) {
        u32x2 o; o.x = pk2(v[0], v[1]); o.y = pk2(v[2], v[3]);
        *(u32x2*)((bf16_t*)(ws + W_O) + (size_t)row * 1024 + col) = o;
    } else if constexpr (EK == E_MO || EK == E_DOWN) {
        float* xr = (float*)(ws + W_XRES) + (size_t)row * 1024 + col;
        *(f32x4*)xr = *(const f32x4*)xr + v;
    } else if constexpr (EK == E_UP) {
        u32x2 o; o.x = pk2(v[0], v[1]); o.y = pk2(v[2], v[3]);
        *(u32x2*)((bf16_t*)(ws + W_U) + (size_t)row * 5632 + col) = o;
    }
}
__device__ __forceinline__ void epi_apply_rt(PP P, int ekind, int row, int col, f32x4 v) {
    switch (ekind) {
    case E_PROJ: epi_apply<E_PROJ>(P, row, col, v); break;
    case E_POOL: epi_apply<E_POOL>(P, row, col, v); break;
    case E_OUT: epi_apply<E_OUT>(P, row, col, v); break;
    case E_Q: epi_apply<E_Q>(P, row, col, v); break;
    case E_MO: epi_apply<E_MO>(P, row, col, v); break;
    case E_UP: epi_apply<E_UP>(P, row, col, v); break;
    default: epi_apply<E_DOWN>(P, row, col, v); break;
    }
}
template <int EK>
__device__ __forceinline__ void epi_loop(PP P, const f32x4 (&acc)[2][2][4][2], int rbase, int cbase) {
#pragma unroll
    for (int ai = 0; ai < 2; ++ai)
#pragma unroll
        for (int m = 0; m < 4; ++m)
#pragma unroll
            for (int bj = 0; bj < 2; ++bj)
#pragma unroll
                for (int n = 0; n < 2; ++n) epi_apply<EK>(P, rbase + ai * 128 + m * 16, cbase + bj * 128 + n * 16, acc[ai][bj][m][n]);
}

struct PhaseCfg { const char* A; const char* B; int lda, ldb, K, nbig, nsmall, ncol64, ekind; };
__device__ __forceinline__ PhaseCfg phase_cfg(PP P, int gp) {
    const char* ws = P->ws; PhaseCfg c;
    switch (gp) {
    case 1:  c.A = ws + W_H;      c.B = ws + W_WIN;   c.lda = 1024; c.ldb = 1024; c.K = 1024; c.nbig = 64 * 14 + 64; c.nsmall = 16 * 56; c.ncol64 = 56; c.ekind = E_PROJ; break;
    case 3:  c.A = ws + W_POOLED; c.B = ws + W_WPOOL; c.lda = 1024; c.ldb = 256;  c.K = 256;  c.nbig = 256; c.nsmall = 256; c.ncol64 = 16; c.ekind = E_POOL; break;
    case 5:  c.A = ws + W_MIX;    c.B = ws + W_WOUT;  c.lda = 2048; c.ldb = 2048; c.K = 2048; c.nbig = 256; c.nsmall = 256; c.ncol64 = 16; c.ekind = E_OUT; break;
    case 7:  c.A = ws + W_H;      c.B = ws + W_WMQ;   c.lda = 1024; c.ldb = 1024; c.K = 1024; c.nbig = 256; c.nsmall = 256; c.ncol64 = 16; c.ekind = E_Q; break;
    case 8:  c.A = ws + W_Q;      c.B = ws + W_KB;    c.lda = 1024; c.ldb = 1024; c.K = 256;  c.nbig = 256; c.nsmall = 0;   c.ncol64 = 16; c.ekind = E_QK; break;
    case 9:  c.A = ws + W_P;      c.B = ws + W_VT;    c.lda = 1024; c.ldb = 256;  c.K = 256;  c.nbig = 256; c.nsmall = 0;   c.ncol64 = 16; c.ekind = E_PV; break;
    case 10: c.A = ws + W_O;      c.B = ws + W_WMO;   c.lda = 1024; c.ldb = 1024; c.K = 1024; c.nbig = 256; c.nsmall = 256; c.ncol64 = 16; c.ekind = E_MO; break;
    case 12: c.A = ws + W_H;      c.B = ws + W_WUP;   c.lda = 1024; c.ldb = 1024; c.K = 1024; c.nbig = 64 * 22; c.nsmall = 16 * 88; c.ncol64 = 88; c.ekind = E_UP; break;
    default: c.A = ws + W_ACT;    c.B = ws + W_WDOWN; c.lda = 2816; c.ldb = 2816; c.K = 2816; c.nbig = 256; c.nsmall = 256; c.ncol64 = 16; c.ekind = E_DOWN; break;
    }
    return c;
}
struct UnitD { const char* A; const char* B; int row0, col0, ekind; };
__device__ __forceinline__ UnitD unit_decode(PP P, const PhaseCfg& c, int gp, int u) {
    UnitD d; d.ekind = c.ekind;
    int pm, pn;
    switch (gp) {
    case 1:
        if (u < 896) { pm = u / 14; pn = u % 14; d.A = c.A + (size_t)pm * 256 * 2048; d.B = c.B + (size_t)pn * 256 * 2048; }
        else { const int v = u - 896; pm = v >> 3; pn = v & 7; d.A = P->ws + W_HM + (size_t)pm * 256 * 2048; d.B = P->ws + W_WMK + (size_t)pn * 256 * 2048; d.ekind = E_MEMKV; }
        break;
    case 3: pm = u >> 2; pn = u & 3; d.A = c.A + (size_t)pm * 256 * 2048 + pn * 512; d.B = c.B + (size_t)pn * 131072; break;
    case 8: pm = u >> 2; pn = u & 3; d.A = c.A + (size_t)pm * 256 * 2048 + pn * 512; d.B = c.B + (size_t)(pm >> 3) * 256 * 2048 + pn * 512; break;
    case 9: pm = u >> 2; pn = u & 3; d.A = c.A + (size_t)pm * 256 * 2048 + pn * 512; d.B = c.B + (size_t)((pm >> 3) * 4 + pn) * 131072; break;
    case 12: pm = u / 22; pn = u % 22; d.A = c.A + (size_t)pm * 256 * 2048; d.B = c.B + (size_t)pn * 256 * 2048; break;
    default: pm = u >> 2; pn = u & 3; d.A = c.A + (size_t)pm * 256 * c.lda * 2; d.B = c.B + (size_t)pn * 256 * c.ldb * 2; break;
    }
    d.row0 = pm * 256; d.col0 = pn * 256;
    return d;
}

__device__ __forceinline__ void gemm_phase(PP P, int gp, char* shm_g, int lb, int nblk, const int tid) {
    LDSB unsigned char* lds = (LDSB unsigned char*)shm_g;
    const int wid = __builtin_amdgcn_readfirstlane(tid >> 6), lane = tid & 63, wr = wid >> 2, wc = wid & 3, fr = lane & 15, fq = lane >> 4;
    const PhaseCfg cfg = phase_cfg(P, gp);
    const int K = cfg.K, nt = K / 64;
    unsigned voffA, voffB;
    { int R, C; stage_rc(tid * 16, R, C); voffA = (unsigned)(R * cfg.lda + C) * 2u; voffB = (unsigned)(R * cfg.ldb + C) * 2u; }
    const size_t qstepvoffA = (size_t)64 * cfg.lda * 2, qstepvoffB = (size_t)64 * cfg.ldb * 2;
    const size_t kstep = 128;
    const size_t hstepA = (size_t)128 * cfg.lda * 2, hstepB = (size_t)128 * cfg.ldb * 2;
    const unsigned ldsw = (unsigned)wid * 1024u;
    const int aoff = lds_byte(wr * 64 + fr, fq * 8), boff = lds_byte(wc * 32 + fr, fq * 8);
    const bool chain = (cfg.ekind != E_QK);
#define G_SA(b, h) (((b) * 2 + (h)) * HTB)
#define G_SB(b, h) ((4 + (b) * 2 + (h)) * HTB)
#define G_STAGE(bufoff, gbase, voff) do { \
        __builtin_amdgcn_global_load_lds((const unsigned*)((const char*)(gbase) + (voff)), (LDSB unsigned*)(lds + (bufoff) + ldsw), 16, 0, 0); \
        __builtin_amdgcn_global_load_lds((const unsigned*)((const char*)(gbase) + qstep##voff + (voff)), (LDSB unsigned*)(lds + (bufoff) + ldsw + 8192), 16, 0, 0); } while (0)
#define G_LDA(dst, b, h) do { _Pragma("unroll") for (int m = 0; m < 4; ++m) _Pragma("unroll") for (int k = 0; k < 2; ++k) dst[m][k] = *(const LDSB bf16x8*)(lds + G_SA(b, h) + aoff + m * 2048 + k * 1024); } while (0)
#define G_LDB(dst, b, h) do { _Pragma("unroll") for (int n = 0; n < 2; ++n) _Pragma("unroll") for (int k = 0; k < 2; ++k) dst[n][k] = *(const LDSB bf16x8*)(lds + G_SB(b, h) + boff + n * 2048 + k * 1024); } while (0)
#define G_MMA(ai, bj, Af, Bf) do { __builtin_amdgcn_s_setprio(1); _Pragma("unroll") for (int m = 0; m < 4; ++m) _Pragma("unroll") for (int n = 0; n < 2; ++n) _Pragma("unroll") for (int k = 0; k < 2; ++k) \
        acc[ai][bj][m][n] = __builtin_amdgcn_mfma_f32_16x16x32_bf16(Bf[n][k], Af[m][k], acc[ai][bj][m][n], 0, 0, 0); __builtin_amdgcn_s_setprio(0); } while (0)
#define G_WAIT_V(n) asm volatile("s_waitcnt vmcnt(" #n ")" ::: "memory")
#define G_WAIT_L(n) asm volatile("s_waitcnt lgkmcnt(" #n ")" ::: "memory")
#define G_BAR __builtin_amdgcn_s_barrier()
#define G_SCHED __builtin_amdgcn_sched_barrier(0)
    int u = lb;
    while (u < cfg.nbig) {
        UnitD cur = unit_decode(P, cfg, gp, u);
        f32x4 acc[2][2][4][2];
#pragma unroll
        for (int a = 0; a < 2; ++a)
#pragma unroll
            for (int b = 0; b < 2; ++b)
#pragma unroll
                for (int m = 0; m < 4; ++m)
#pragma unroll
                    for (int n = 0; n < 2; ++n) acc[a][b][m][n] = (f32x4){0.f, 0.f, 0.f, 0.f};
        bf16x8 At[4][2], B0[2][2], B1[2][2];
        const char* cA = cur.A; const char* cB = cur.B;
        G_STAGE(G_SB(0, 0), cB, voffB); G_STAGE(G_SA(0, 0), cA, voffA); G_STAGE(G_SB(0, 1), cB + hstepB, voffB); G_STAGE(G_SA(0, 1), cA + hstepA, voffA);
        if (wr == 1) G_BAR;
        G_WAIT_V(4); G_BAR;
        G_STAGE(G_SB(1, 0), cB + kstep, voffB); G_STAGE(G_SA(1, 0), cA + kstep, voffA); G_STAGE(G_SB(1, 1), cB + hstepB + kstep, voffB);
        G_WAIT_V(6); G_BAR;
        for (;;) {
            const bool has_next = chain && (u + nblk < cfg.nbig);
            UnitD nxt = cur;
            if (has_next) nxt = unit_decode(P, cfg, gp, u + nblk);
            const char* nA = nxt.A; const char* nB = nxt.B;
            for (int t = 0; t < nt; t += 2) {
                const bool last = (t == nt - 2);
                const char* a1 = cA + (size_t)(t + 1) * kstep;
                const char* a2 = last ? nA : cA + (size_t)(t + 2) * kstep; const char* b2 = last ? nB : cB + (size_t)(t + 2) * kstep;
                const char* a3 = a2 + kstep; const char* b3 = b2 + kstep;
                G_LDB(B0, 0, 0); G_SCHED; G_LDA(At, 0, 0); G_STAGE(G_SA(1, 1), a1 + hstepA, voffA);
                G_WAIT_L(8); G_BAR; G_WAIT_L(0); G_MMA(0, 0, At, B0); G_BAR; G_SCHED;
                G_LDB(B1, 0, 1); G_STAGE(G_SB(0, 0), b2, voffB);
                G_BAR; G_WAIT_L(0); G_MMA(0, 1, At, B1); G_BAR;
                G_LDA(At, 0, 1); G_STAGE(G_SA(0, 0), a2, voffA);
                G_BAR; G_WAIT_L(0); G_MMA(1, 0, At, B0); G_BAR; G_SCHED;
                G_STAGE(G_SB(0, 1), b2 + hstepB, voffB);
                G_WAIT_V(6); G_BAR; G_MMA(1, 1, At, B1); G_BAR;
                G_LDB(B0, 1, 0); G_SCHED; G_LDA(At, 1, 0); G_STAGE(G_SA(0, 1), a2 + hstepA, voffA);
                G_WAIT_L(8); G_BAR; G_WAIT_L(0); G_MMA(0, 0, At, B0); G_BAR; G_SCHED;
                G_LDB(B1, 1, 1); G_STAGE(G_SB(1, 0), b3, voffB);
                G_BAR; G_WAIT_L(0); G_MMA(0, 1, At, B1); G_BAR;
                G_LDA(At, 1, 1); G_STAGE(G_SA(1, 0), a3, voffA);
                G_BAR; G_WAIT_L(0); G_MMA(1, 0, At, B0); G_BAR; G_SCHED;
                G_STAGE(G_SB(1, 1), b3 + hstepB, voffB);
                G_WAIT_V(6); G_BAR; G_MMA(1, 1, At, B1); G_BAR;
            }
            if (chain) {
                const int rbase = cur.row0 + wr * 64 + fr, cbase = cur.col0 + wc * 32 + fq * 4;
                switch (cur.ekind) {
                case E_PROJ: epi_loop<E_PROJ>(P, acc, rbase, cbase); break;
                case E_MEMKV: epi_loop<E_MEMKV>(P, acc, rbase, cbase); break;
                case E_POOL: epi_loop<E_POOL>(P, acc, rbase, cbase); break;
                case E_OUT: epi_loop<E_OUT>(P, acc, rbase, cbase); break;
                case E_Q: epi_loop<E_Q>(P, acc, rbase, cbase); break;
                case E_PV: epi_loop<E_PV>(P, acc, rbase, cbase); break;
                case E_MO: epi_loop<E_MO>(P, acc, rbase, cbase); break;
                case E_UP: epi_loop<E_UP>(P, acc, rbase, cbase); break;
                default: epi_loop<E_DOWN>(P, acc, rbase, cbase); break;
                }
            }
            if (!has_next) break;
#pragma unroll
            for (int a = 0; a < 2; ++a)
#pragma unroll
                for (int b = 0; b < 2; ++b)
#pragma unroll
                    for (int m = 0; m < 4; ++m)
#pragma unroll
                        for (int n = 0; n < 2; ++n) acc[a][b][m][n] = (f32x4){0.f, 0.f, 0.f, 0.f};
            cur = nxt; cA = nA; cB = nB; u += nblk;
        }
        G_WAIT_V(0);
        if (wr == 0) G_BAR;
        G_BAR;
        if (!chain) {
            float* redm = (float*)(shm_g + 131072);
            float* reds = (float*)(shm_g + 135168);
#pragma unroll
            for (int ai = 0; ai < 2; ++ai)
#pragma unroll
                for (int m = 0; m < 4; ++m) {
                    float t = -3.0e38f;
#pragma unroll
                    for (int bj = 0; bj < 2; ++bj)
#pragma unroll
                        for (int n = 0; n < 2; ++n)
#pragma unroll
                            for (int j = 0; j < 4; ++j) t = fmaxf(t, acc[ai][bj][m][n][j]);
                    t = fmaxf(t, __shfl_xor(t, 16)); t = fmaxf(t, __shfl_xor(t, 32));
                    if (fq == 0) redm[(ai * 128 + wr * 64 + m * 16 + fr) * 4 + wc] = t;
                }
            __syncthreads();
#pragma unroll
            for (int ai = 0; ai < 2; ++ai)
#pragma unroll
                for (int m = 0; m < 4; ++m) {
                    const f32x4 r = *(const f32x4*)(redm + (ai * 128 + wr * 64 + m * 16 + fr) * 4);
                    const float M = fmaxf(fmaxf(r[0], r[1]), fmaxf(r[2], r[3]));
                    float s = 0.f;
#pragma unroll
                    for (int bj = 0; bj < 2; ++bj)
#pragma unroll
                        for (int n = 0; n < 2; ++n)
#pragma unroll
                            for (int j = 0; j < 4; ++j) { const float e = __expf(acc[ai][bj][m][n][j] - M); acc[ai][bj][m][n][j] = e; s += e; }
                    s += __shfl_xor(s, 16); s += __shfl_xor(s, 32);
                    if (fq == 0) reds[(ai * 128 + wr * 64 + m * 16 + fr) * 4 + wc] = s;
                }
            __syncthreads();
#pragma unroll
            for (int ai = 0; ai < 2; ++ai)
#pragma unroll
                for (int m = 0; m < 4; ++m) {
                    const int rl = ai * 128 + wr * 64 + m * 16 + fr;
                    const f32x4 r = *(const f32x4*)(reds + rl * 4);
                    const float inv = 1.0f / ((r[0] + r[1]) + (r[2] + r[3]));
                    bf16_t* prow = (bf16_t*)(P->ws + W_P) + (size_t)(cur.row0 + rl) * 1024 + cur.col0;
#pragma unroll
                    for (int bj = 0; bj < 2; ++bj)
#pragma unroll
                        for (int n = 0; n < 2; ++n) {
                            const f32x4 v = acc[ai][bj][m][n];
                            u32x2 o; o.x = pk2(v[0] * inv, v[1] * inv); o.y = pk2(v[2] * inv, v[3] * inv);
                            *(u32x2*)(prow + bj * 128 + wc * 32 + n * 16 + fq * 4) = o;
                        }
                }
            __syncthreads();
        }
        u += nblk;
    }
#undef G_SA
#undef G_SB
#undef G_STAGE
#undef G_LDA
#undef G_LDB
#undef G_MMA
    const int rot = cfg.nbig % nblk;
    for (int s0 = (lb - rot + nblk) % nblk; s0 < cfg.nsmall; s0 += nblk) {
        const int pr = s0 / cfg.ncol64, pc = s0 % cfg.ncol64;
        const int row0 = TP + pr * 32, col0 = pc * 64;
        const bf16_t* Ab = (const bf16_t*)cfg.A + (size_t)row0 * cfg.lda;
        const bf16_t* Bb;
        if (gp == 3) { const int g = pc >> 2; Ab += g * 256; Bb = (const bf16_t*)cfg.B + (size_t)g * 65536 + (size_t)(col0 - g * 256) * 256; }
        else Bb = (const bf16_t*)cfg.B + (size_t)col0 * cfg.ldb;
        const int kw = K >> 3, nks = kw >> 5;
        f32x4 acc[2][4];
#pragma unroll
        for (int mi = 0; mi < 2; ++mi)
#pragma unroll
            for (int ni = 0; ni < 4; ++ni) acc[mi][ni] = (f32x4){0.f, 0.f, 0.f, 0.f};
        const bf16_t* ap = Ab + (size_t)fr * cfg.lda + wid * kw + fq * 8;
        const bf16_t* bp = Bb + (size_t)fr * cfg.ldb + wid * kw + fq * 8;
        for (int ks = 0; ks < nks; ++ks) {
            bf16x8 a[2], b[4];
#pragma unroll
            for (int mi = 0; mi < 2; ++mi) a[mi] = *(const bf16x8*)(ap + (size_t)mi * 16 * cfg.lda + ks * 32);
#pragma unroll
            for (int ni = 0; ni < 4; ++ni) b[ni] = *(const bf16x8*)(bp + (size_t)ni * 16 * cfg.ldb + ks * 32);
#pragma unroll
            for (int mi = 0; mi < 2; ++mi)
#pragma unroll
                for (int ni = 0; ni < 4; ++ni) acc[mi][ni] = __builtin_amdgcn_mfma_f32_16x16x32_bf16(b[ni], a[mi], acc[mi][ni], 0, 0, 0);
        }
        float* red = (float*)shm_g;
#pragma unroll
        for (int mi = 0; mi < 2; ++mi)
#pragma unroll
            for (int ni = 0; ni < 4; ++ni) *(f32x4*)(red + wid * 2048 + (mi * 16 + fr) * 64 + ni * 16 + fq * 4) = acc[mi][ni];
        __syncthreads();
        {
            const int r = tid >> 4, c = (tid & 15) * 4;
            f32x4 v = *(const f32x4*)(red + r * 64 + c);
#pragma unroll
            for (int w = 1; w < 8; ++w) v += *(const f32x4*)(red + w * 2048 + r * 64 + c);
            epi_apply_rt(P, cfg.ekind, row0 + r, col0 + c, v);
        }
        __syncthreads();
    }
}

__device__ __forceinline__ void tr_tile(const float* __restrict__ src, int ld_src, bf16_t* __restrict__ dst, int ld_dst, int k0, int n0s, int n0d, float* tile, const int tid) {
    { const int kr = tid >> 4, nc = (tid & 15) * 4;
#pragma unroll
      for (int i = 0; i < 2; ++i) { const int k = kr + i * 32; const f32x4 v = *(const f32x4*)(src + (size_t)(k0 + k) * ld_src + n0s + nc);
          tile[k * 65 + nc + 0] = v[0]; tile[k * 65 + nc + 1] = v[1]; tile[k * 65 + nc + 2] = v[2]; tile[k * 65 + nc + 3] = v[3]; } }
    __syncthreads();
    { const int n = tid >> 3, k8 = (tid & 7) * 8; float f[8];
#pragma unroll
      for (int e = 0; e < 8; ++e) f[e] = tile[(k8 + e) * 65 + n];
      *(u32x4*)(dst + (size_t)(n0d + n) * ld_dst + k0 + k8) = pack8(f); }
    __syncthreads();
}

__device__ __forceinline__ void phase_prep(PP P, char* shm, int blk, int nblk, const int tid) {
    const int wid = tid >> 6, lane = tid & 63;
    float* tile = (float*)shm;
    float* wdt = (float*)(shm + 32768);
    for (int i = tid; i < 1024 * 16; i += NTHR) { const int k = i >> 4, hd = i & 15; wdt[hd * 1024 + k] = P->w_in[(size_t)k * 3600 + 2560 + hd]; }
    __syncthreads();
    char* ws = P->ws;
    for (int it = blk; it < TT / 8 + 2048 / 8; it += nblk) {
        const bool ismem = it >= TT / 8;
        const int row = (ismem ? it - TT / 8 : it) * 8 + wid;
        const float* xr = ismem ? P->mem_prompt + (size_t)row * 1024 : (row < TP ? P->x_prompt + (size_t)row * 1024 : P->x_sample + (size_t)(row - TP) * 1024);
        const float* gg = ismem ? P->norm_memkv : P->norm_mix;
        bf16_t* orow = (bf16_t*)(ws + (ismem ? W_HM : W_H)) + (size_t)row * 1024;
        f32x4 xv[4]; float ss = 0.f;
#pragma unroll
        for (int j = 0; j < 4; ++j) { xv[j] = *(const f32x4*)(xr + j * 256 + lane * 4); ss += xv[j][0] * xv[j][0] + xv[j][1] * xv[j][1] + xv[j][2] * xv[j][2] + xv[j][3] * xv[j][3]; }
        ss = wave_sum(ss);
        const float rstd = rsqrtf(ss * (1.0f / 1024.0f) + EPS);
#pragma unroll
        for (int j = 0; j < 4; ++j) { const f32x4 g4 = *(const f32x4*)(gg + j * 256 + lane * 4); xv[j] = xv[j] * rstd * g4;
            u32x2 o; o.x = pk2(xv[j][0], xv[j][1]); o.y = pk2(xv[j][2], xv[j][3]); *(u32x2*)(orow + j * 256 + lane * 4) = o; }
        if (!ismem) {
            float mine = 0.f;
#pragma unroll
            for (int hd = 0; hd < 16; ++hd) {
                float acc = 0.f;
#pragma unroll
                for (int j = 0; j < 4; ++j) { const f32x4 w4 = *(const f32x4*)(wdt + hd * 1024 + j * 256 + lane * 4); acc += xv[j][0] * w4[0] + xv[j][1] * w4[1] + xv[j][2] * w4[2] + xv[j][3] * w4[3]; }
                acc = wave_sum(acc);
                if (lane == hd) mine = acc;
            }
            if (lane < 16) { const float x = mine + P->dt_bias[lane]; const float sp = x > 20.f ? x : log1pf(expf(x)); ((float*)(ws + W_DT))[(size_t)row * 16 + lane] = sp; }
        }
    }
    __syncthreads();
    for (int it = blk; it < 4608; it += nblk) {
        int i = it;
        if (i < 896) { const int kt = i / 56, ntl = i % 56; const int n0d = ntl * 64; const int n0s = n0d < 2560 ? n0d : n0d + 16; tr_tile(P->w_in, 3600, (bf16_t*)(ws + W_WIN), 1024, kt * 64, n0s, n0d, tile, tid); continue; }
        i -= 896;
        if (i < 64) { const int g = i >> 4, kt = (i >> 2) & 3, ntl = i & 3; tr_tile(P->w_pool + (size_t)g * 65536, 256, (bf16_t*)(ws + W_WPOOL) + (size_t)g * 65536, 256, kt * 64, ntl * 64, ntl * 64, tile, tid); continue; }
        i -= 64;
        if (i < 512) { const int kt = i >> 4, ntl = i & 15; tr_tile(P->w_out, 1024, (bf16_t*)(ws + W_WOUT), 2048, kt * 64, ntl * 64, ntl * 64, tile, tid); continue; }
        i -= 512;
        if (i < 1024) { const int wsel = i >> 8, r = i & 255, kt = r >> 4, ntl = r & 15;
            const float* src = wsel == 0 ? P->w_mq : wsel == 1 ? P->w_mk : wsel == 2 ? P->w_mv : P->w_mo;
            bf16_t* dst = (bf16_t*)(ws + (wsel == 0 ? W_WMQ : wsel == 1 ? W_WMK : wsel == 2 ? W_WMV : W_WMO));
            tr_tile(src, 1024, dst, 1024, kt * 64, ntl * 64, ntl * 64, tile, tid); continue; }
        i -= 1024;
        if (i < 1408) { const int kt = i / 88, ntl = i % 88; tr_tile(P->w_up, 5632, (bf16_t*)(ws + W_WUP), 1024, kt * 64, ntl * 64, ntl * 64, tile, tid); continue; }
        i -= 1408;
        { const int kt = i >> 4, ntl = i & 15; tr_tile(P->w_down, 1024, (bf16_t*)(ws + W_WDOWN), 2816, kt * 64, ntl * 64, ntl * 64, tile, tid); }
    }
}

__device__ __forceinline__ u32x4 ld8(const bf16_t* p) { return *(const u32x4*)p; }

__device__ __forceinline__ void phase_convpool(PP P, int gtid, int nthreads) {
    char* ws = P->ws;
    const bf16_t* proj2 = (const bf16_t*)(ws + W_PROJ2);
    bf16_t* xact = (bf16_t*)(ws + W_XACT);
    bf16_t* pooled = (bf16_t*)(ws + W_POOLED);
    for (int idx = gtid; idx < 1152 * 320; idx += nthreads) {
        const int run = idx / 320, cg = idx % 320;
        const bool samp = run >= 1024;
        int t0, len, bidx, tl0;
        if (!samp) { t0 = run * 16; len = 16; bidx = t0 >> 11; tl0 = t0 & 2047; } else { bidx = run - 1024; t0 = TP + bidx * 4; len = 4; tl0 = 0; }
        if (cg < 192) {
            const int c0 = cg * 8;
            float w0[8], w1[8], w2[8], w3[8], bs[8], h0[8], h1[8], h2[8];
#pragma unroll
            for (int e = 0; e < 8; ++e) { w0[e] = P->conv_w[c0 + e]; w1[e] = P->conv_w[1536 + c0 + e]; w2[e] = P->conv_w[3072 + c0 + e]; w3[e] = P->conv_w[4608 + c0 + e]; bs[e] = P->conv_b[c0 + e]; }
            if (samp) {
#pragma unroll
                for (int e = 0; e < 8; ++e) { h0[e] = P->state_conv[(size_t)(bidx * 3 + 0) * 1536 + c0 + e]; h1[e] = P->state_conv[(size_t)(bidx * 3 + 1) * 1536 + c0 + e]; h2[e] = P->state_conv[(size_t)(bidx * 3 + 2) * 1536 + c0 + e]; }
            } else if (tl0 > 0) {
                unpack8(ld8(proj2 + (size_t)(t0 - 3) * 2560 + c0), h0); unpack8(ld8(proj2 + (size_t)(t0 - 2) * 2560 + c0), h1); unpack8(ld8(proj2 + (size_t)(t0 - 1) * 2560 + c0), h2);
            } else {
#pragma unroll
                for (int e = 0; e < 8; ++e) { h0[e] = 0.f; h1[e] = 0.f; h2[e] = 0.f; }
            }
#pragma unroll 4
            for (int j = 0; j < len; ++j) {
                float x3[8], y[8]; unpack8(ld8(proj2 + (size_t)(t0 + j) * 2560 + c0), x3);
#pragma unroll
                for (int e = 0; e < 8; ++e) { const float v = bs[e] + w0[e] * h0[e] + w1[e] * h1[e] + w2[e] * h2[e] + w3[e] * x3[e]; y[e] = silu_f(v); }
                *(u32x4*)(xact + (size_t)(t0 + j) * 1536 + c0) = pack8(y);
                if (samp) { if (j >= 1) { float* o = P->out + O_CONVS + (size_t)(bidx * 3 + j - 1) * 1536 + c0;
#pragma unroll
                        for (int e = 0; e < 8; ++e) o[e] = x3[e]; } }
                else { const int tl = tl0 + j; if (tl >= 2045) { float* o = P->out + O_CONVP + (size_t)(bidx * 3 + tl - 2045) * 1536 + c0;
#pragma unroll
                        for (int e = 0; e < 8; ++e) o[e] = x3[e]; } }
#pragma unroll
                for (int e = 0; e < 8; ++e) { h0[e] = h1[e]; h1[e] = h2[e]; h2[e] = x3[e]; }
            }
        } else {
            const int c0 = (cg - 192) * 8; const int win = 2 << (c0 >> 8);
            const bf16_t* vp = proj2 + 1536 + c0;
            const float* prev = P->state_pool + (size_t)bidx * 15 * 1024 + c0;
            float sum[8];
#pragma unroll
            for (int e = 0; e < 8; ++e) sum[e] = 0.f;
            if (samp) {
                for (int jj = 1; jj < win; ++jj) {
#pragma unroll
                    for (int e = 0; e < 8; ++e) sum[e] += prev[(size_t)(15 - jj) * 1024 + e]; }
                float* o = P->out + O_POOLS + (size_t)bidx * 15 * 1024 + c0;
                for (int i = 0; i < 11; ++i) {
#pragma unroll
                    for (int e = 0; e < 8; ++e) o[(size_t)i * 1024 + e] = prev[(size_t)(i + 4) * 1024 + e]; }
            } else if (tl0 > 0) {
                for (int jj = 1; jj < win; ++jj) { float v[8]; unpack8(ld8(vp + (size_t)(t0 - jj) * 2560), v);
#pragma unroll
                    for (int e = 0; e < 8; ++e) sum[e] += v[e]; }
            }
            for (int j = 0; j < len; ++j) {
                float v[8], o8[8]; unpack8(ld8(vp + (size_t)(t0 + j) * 2560), v);
                const int tl = tl0 + j;
                const float inv = 1.0f / (float)(samp ? win : (tl + 1 < win ? tl + 1 : win));
#pragma unroll
                for (int e = 0; e < 8; ++e) { sum[e] += v[e]; o8[e] = sum[e] * inv - v[e]; }
                *(u32x4*)(pooled + (size_t)(t0 + j) * 1024 + c0) = pack8(o8);
                const int to = j - win + 1;
                if (samp) {
                    if (to >= 0) { float q[8]; unpack8(ld8(vp + (size_t)(t0 + to) * 2560), q);
#pragma unroll
                        for (int e = 0; e < 8; ++e) sum[e] -= q[e]; }
                    else {
#pragma unroll
                        for (int e = 0; e < 8; ++e) sum[e] -= prev[(size_t)(15 + to) * 1024 + e]; }
                    float* o = P->out + O_POOLS + (size_t)(bidx * 15 + 11 + j) * 1024 + c0;
#pragma unroll
                    for (int e = 0; e < 8; ++e) o[e] = v[e];
                } else {
                    if (tl0 + to >= 0) { float q[8]; unpack8(ld8(vp + (size_t)(t0 + to) * 2560), q);
#pragma unroll
                        for (int e = 0; e < 8; ++e) sum[e] -= q[e]; }
                    if (tl >= 2033) { float* o = P->out + O_POOLP + (size_t)(bidx * 15 + tl - 2033) * 1024 + c0;
#pragma unroll
                        for (int e = 0; e < 8; ++e) o[e] = v[e]; }
                }
            }
        }
    }
}

constexpr int CS_STR = 136;
constexpr int X_STR = 40;
__device__ __forceinline__ s16x4 tr_read(const bf16_t* p) { return __builtin_bit_cast(s16x4, __builtin_amdgcn_ds_read_tr16_b64_v4i16((LDSB s16x4*)p)); }

__device__ __forceinline__ void ssd_prompt(PP P, int item, char* shm, const int tid) {
    const int w = tid >> 6, lane = tid & 63, fr = lane & 15, fq = lane >> 4;
    const int b = item >> 5, hd = (item >> 1) & 15, ph = item & 1, g = hd >> 3;
    const float a = -expf(P->a_log[hd]);
    const float Dh = P->ssm_d[hd];
    char* ws = P->ws;
    const bf16_t* xact = (const bf16_t*)(ws + W_XACT);
    const float* dtb = (const float*)(ws + W_DT);
    bf16_t* ybuf = (bf16_t*)(ws + W_Y);
    bf16_t* Cs = (bf16_t*)(shm);
    bf16_t* Bs = (bf16_t*)(shm + 34816);
    bf16_t* Gs = (bf16_t*)(shm + 69632);
    bf16_t* Xd = (bf16_t*)(shm + 104448);
    bf16_t* X2 = (bf16_t*)(shm + 104448 + 10240);
    bf16_t* Hs = (bf16_t*)(shm + 124928);
    float* acs = (float*)(shm + 133632);
    float* dts = (float*)(shm + 134144);
    f32x4 Hacc[2];
    Hacc[0] = (f32x4){0.f, 0.f, 0.f, 0.f}; Hacc[1] = (f32x4){0.f, 0.f, 0.f, 0.f};
    const int q4 = fr >> 2, p4 = fr & 3;
    for (int c = 0; c < 16; ++c) {
        const int t0 = b * 2048 + c * 128;
        if (w == 0) {
            const float d0 = dtb[(size_t)(t0 + 2 * lane) * 16 + hd], d1 = dtb[(size_t)(t0 + 2 * lane + 1) * 16 + hd];
            const float s = (d0 + d1) * a; float v = s;
#pragma unroll
            for (int off = 1; off < 64; off <<= 1) { const float t = __shfl_up(v, off); if (lane >= off) v += t; }
            const float excl = v - s;
            acs[2 * lane] = excl + d0 * a; acs[2 * lane + 1] = v; dts[2 * lane] = d0; dts[2 * lane + 1] = d1;
        }
#pragma unroll
        for (int pt = 0; pt < 2; ++pt)
#pragma unroll
            for (int j = 0; j < 4; ++j) Hs[(pt * 16 + fq * 4 + j) * CS_STR + w * 16 + fr] = f2bf(Hacc[pt][j]);
#pragma unroll
        for (int i = 0; i < 4; ++i) {
            const int q = tid + i * 512, s = q >> 4, n8 = (q & 15) * 8;
            const bf16_t* src = xact + (size_t)(t0 + s) * 1536 + g * 128 + n8;
            *(u32x4*)(Cs + s * CS_STR + n8) = *(const u32x4*)(src + 1280);
            *(u32x4*)(Bs + s * CS_STR + n8) = *(const u32x4*)(src + 1024);
        }
        __syncthreads();
        {
            const int s = tid >> 2, p8 = (tid & 3) * 8;
            float x[8], xa[8], xb[8]; unpack8(ld8(xact + (size_t)(t0 + s) * 1536 + hd * 64 + ph * 32 + p8), x);
            const float dtv = dts[s], dec = __expf(acs[127] - acs[s]) * dtv;
#pragma unroll
            for (int e = 0; e < 8; ++e) { xa[e] = x[e] * dtv; xb[e] = x[e] * dec; }
            *(u32x4*)(Xd + s * X_STR + p8) = pack8(xa);
            *(u32x4*)(X2 + s * X_STR + p8) = pack8(xb);
        }
        bf16x8 Cf[4];
#pragma unroll
        for (int kk = 0; kk < 4; ++kk) Cf[kk] = *(const bf16x8*)(Cs + (w * 16 + fr) * CS_STR + kk * 32 + fq * 8);
        const int nst = (w | 1) + 1;
#pragma unroll
        for (int st = 0; st < 8; ++st) {
            if (st < nst) {
                f32x4 ga = (f32x4){0.f, 0.f, 0.f, 0.f};
#pragma unroll
                for (int kk = 0; kk < 4; ++kk) { const bf16x8 Bf = *(const bf16x8*)(Bs + (st * 16 + fr) * CS_STR + kk * 32 + fq * 8); ga = __builtin_amdgcn_mfma_f32_16x16x32_bf16(Cf[kk], Bf, ga, 0, 0, 0); }
                const int s = st * 16 + fr; const float as = acs[s];
#pragma unroll
                for (int j = 0; j < 4; ++j) { const int l = w * 16 + fq * 4 + j; const float val = (s <= l) ? ga[j] * __expf(acs[l] - as) : 0.f; Gs[l * CS_STR + s] = f2bf(val); }
            }
        }
        __syncthreads();
        {
            f32x4 Yd[2], Yo[2];
            Yd[0] = Yd[1] = Yo[0] = Yo[1] = (f32x4){0.f, 0.f, 0.f, 0.f};
            const int nkk = (w >> 1) + 1;
#pragma unroll
            for (int kk = 0; kk < 4; ++kk) {
                if (kk < nkk) {
                    const bf16x8 Gf = *(const bf16x8*)(Gs + (w * 16 + fr) * CS_STR + kk * 32 + fq * 8);
#pragma unroll
                    for (int pt = 0; pt < 2; ++pt) {
                        const bf16_t* base = Xd + (kk * 32 + fq * 8 + q4) * X_STR + pt * 16 + p4 * 4;
                        bf16x8 Xf; Xf.lo = tr_read(base); Xf.hi = tr_read(base + 4 * X_STR);
                        Yd[pt] = __builtin_amdgcn_mfma_f32_16x16x32_bf16(Gf, Xf, Yd[pt], 0, 0, 0);
                    }
                }
            }
#pragma unroll
            for (int kk = 0; kk < 4; ++kk)
#pragma unroll
                for (int pt = 0; pt < 2; ++pt) { const bf16x8 Hf = *(const bf16x8*)(Hs + (pt * 16 + fr) * CS_STR + kk * 32 + fq * 8); Yo[pt] = __builtin_amdgcn_mfma_f32_16x16x32_bf16(Cf[kk], Hf, Yo[pt], 0, 0, 0); }
#pragma unroll
            for (int j = 0; j < 4; ++j) {
                const int l = w * 16 + fq * 4 + j; const float el = __expf(acs[l]);
#pragma unroll
                for (int pt = 0; pt < 2; ++pt) {
                    const int pcol = hd * 64 + ph * 32 + pt * 16 + fr;
                    const float xr = bf2f(xact[(size_t)(t0 + l) * 1536 + pcol]);
                    ybuf[(size_t)(t0 + l) * 1024 + pcol] = f2bf(Yd[pt][j] + el * Yo[pt][j] + Dh * xr);
                }
            }
        }
        {
            const float dc = __expf(acs[127]);
            Hacc[0] *= dc; Hacc[1] *= dc;
#pragma unroll
            for (int kk = 0; kk < 4; ++kk) {
                const bf16_t* bb = Bs + (kk * 32 + fq * 8 + q4) * CS_STR + w * 16 + p4 * 4;
                bf16x8 Bf; Bf.lo = tr_read(bb); Bf.hi = tr_read(bb + 4 * CS_STR);
#pragma unroll
                for (int pt = 0; pt < 2; ++pt) {
                    const bf16_t* xb = X2 + (kk * 32 + fq * 8 + q4) * X_STR + pt * 16 + p4 * 4;
                    bf16x8 Xf; Xf.lo = tr_read(xb); Xf.hi = tr_read(xb + 4 * X_STR);
                    Hacc[pt] = __builtin_amdgcn_mfma_f32_16x16x32_bf16(Xf, Bf, Hacc[pt], 0, 0, 0);
                }
            }
        }
        __syncthreads();
    }
    float* so = P->out + O_SSMP + ((size_t)(b * 16 + hd) * 64 + ph * 32) * 128;
#pragma unroll
    for (int pt = 0; pt < 2; ++pt)
#pragma unroll
        for (int j = 0; j < 4; ++j) so[(size_t)(pt * 16 + fq * 4 + j) * 128 + w * 16 + fr] = Hacc[pt][j];
}

__device__ __forceinline__ void ssd_sample(PP P, int item, const int tid) {
    const int b = item >> 4, hd = item & 15, g = hd >> 3;
    const int p = tid >> 3, n0 = (tid & 7) * 16;
    const float a = -expf(P->a_log[hd]);
    const float Dh = P->ssm_d[hd];
    char* ws = P->ws;
    const bf16_t* xact = (const bf16_t*)(ws + W_XACT);
    const float* dtb = (const float*)(ws + W_DT);
    bf16_t* ybuf = (bf16_t*)(ws + W_Y);
    const size_t sidx = ((size_t)(b * 16 + hd) * 64 + p) * 128 + n0;
    float h[16];
#pragma unroll
    for (int i = 0; i < 4; ++i) { const f32x4 v = *(const f32x4*)(P->state_ssm + sidx + i * 4); h[i * 4] = v[0]; h[i * 4 + 1] = v[1]; h[i * 4 + 2] = v[2]; h[i * 4 + 3] = v[3]; }
#pragma unroll
    for (int i = 0; i < 4; ++i) {
        const int t = TP + b * 4 + i;
        const float xv = bf2f(xact[(size_t)t * 1536 + hd * 64 + p]);
        const float dtv = dtb[(size_t)t * 16 + hd];
        const float dA = __expf(dtv * a), dx = dtv * xv;
        float Bv[16], Cv[16];
        { float t8[8]; unpack8(ld8(xact + (size_t)t * 1536 + 1024 + g * 128 + n0), t8);
#pragma unroll
          for (int e = 0; e < 8; ++e) Bv[e] = t8[e];
          unpack8(ld8(xact + (size_t)t * 1536 + 1024 + g * 128 + n0 + 8), t8);
#pragma unroll
          for (int e = 0; e < 8; ++e) Bv[8 + e] = t8[e];
          unpack8(ld8(xact + (size_t)t * 1536 + 1280 + g * 128 + n0), t8);
#pragma unroll
          for (int e = 0; e < 8; ++e) Cv[e] = t8[e];
          unpack8(ld8(xact + (size_t)t * 1536 + 1280 + g * 128 + n0 + 8), t8);
#pragma unroll
          for (int e = 0; e < 8; ++e) Cv[8 + e] = t8[e]; }
        float part = 0.f;
#pragma unroll
        for (int e = 0; e < 16; ++e) { h[e] = h[e] * dA + dx * Bv[e]; part += h[e] * Cv[e]; }
        part += __shfl_xor(part, 1); part += __shfl_xor(part, 2); part += __shfl_xor(part, 4);
        if ((tid & 7) == 0) ybuf[(size_t)t * 1024 + hd * 64 + p] = f2bf(part + Dh * xv);
    }
    float* so = P->out + O_SSMS + sidx;
#pragma unroll
    for (int i = 0; i < 4; ++i) *(f32x4*)(so + i * 4) = (f32x4){h[i * 4], h[i * 4 + 1], h[i * 4 + 2], h[i * 4 + 3]};
}

__device__ __forceinline__ void phase_gatednorm(PP P, int gw, int nw, const int tid) {
    const int lane = tid & 63;
    char* ws = P->ws;
    const bf16_t* ybuf = (const bf16_t*)(ws + W_Y); const bf16_t* zbuf = (const bf16_t*)(ws + W_Z);
    bf16_t* mix = (bf16_t*)(ws + W_MIX);
    for (int row = gw; row < TT; row += nw) {
        float t[4][4]; float ss0 = 0.f, ss1 = 0.f;
#pragma unroll
        for (int j = 0; j < 4; ++j) {
            const u32x2 yv = *(const u32x2*)(ybuf + (size_t)row * 1024 + j * 256 + lane * 4);
            const u32x2 zv = *(const u32x2*)(zbuf + (size_t)row * 1024 + j * 256 + lane * 4);
            const float y0 = bflo(yv.x), y1 = bfhi(yv.x), y2 = bflo(yv.y), y3 = bfhi(yv.y);
            const float z0 = bflo(zv.x), z1 = bfhi(zv.x), z2 = bflo(zv.y), z3 = bfhi(zv.y);
            t[j][0] = y0 * silu_f(z0); t[j][1] = y1 * silu_f(z1); t[j][2] = y2 * silu_f(z2); t[j][3] = y3 * silu_f(z3);
            const float q = t[j][0] * t[j][0] + t[j][1] * t[j][1] + t[j][2] * t[j][2] + t[j][3] * t[j][3];
            if (j < 2) ss0 += q; else ss1 += q;
        }
        ss0 = wave_sum(ss0); ss1 = wave_sum(ss1);
        const float r0 = rsqrtf(ss0 * (1.0f / 512.0f) + EPS), r1 = rsqrtf(ss1 * (1.0f / 512.0f) + EPS);
#pragma unroll
        for (int j = 0; j < 4; ++j) {
            const float r = j < 2 ? r0 : r1;
            const f32x4 g4 = *(const f32x4*)(P->ssm_norm + j * 256 + lane * 4);
            u32x2 o; o.x = pk2(t[j][0] * r * g4[0], t[j][1] * r * g4[1]); o.y = pk2(t[j][2] * r * g4[2], t[j][3] * r * g4[3]);
            *(u32x2*)(mix + (size_t)row * 2048 + j * 256 + lane * 4) = o;
        }
    }
}

__device__ __forceinline__ void phase_norm(PP P, const float* gain, bool final_out, int gw, int nw, const int tid) {
    const int lane = tid & 63;
    char* ws = P->ws;
    const float* xres = (const float*)(ws + W_XRES);
    for (int row = gw; row < TT; row += nw) {
        f32x4 xv[4]; float ss = 0.f;
#pragma unroll
        for (int j = 0; j < 4; ++j) { xv[j] = *(const f32x4*)(xres + (size_t)row * 1024 + j * 256 + lane * 4); ss += xv[j][0] * xv[j][0] + xv[j][1] * xv[j][1] + xv[j][2] * xv[j][2] + xv[j][3] * xv[j][3]; }
        ss = wave_sum(ss);
        const float rstd = rsqrtf(ss * (1.0f / 1024.0f) + EPS);
#pragma unroll
        for (int j = 0; j < 4; ++j) {
            const f32x4 g4 = *(const f32x4*)(gain + j * 256 + lane * 4);
            const f32x4 y = xv[j] * rstd * g4;
            if (final_out) *(f32x4*)(P->out + O_YP + (size_t)row * 1024 + j * 256 + lane * 4) = y;
            else { u32x2 o; o.x = pk2(y[0], y[1]); o.y = pk2(y[2], y[3]); *(u32x2*)((bf16_t*)(ws + W_H) + (size_t)row * 1024 + j * 256 + lane * 4) = o; }
        }
    }
}

__device__ __forceinline__ void attn_sample(PP P, int item, char* shm, const int tid) {
    const int w = tid >> 6, lane = tid & 63, fr = lane & 15, fq = lane >> 4;
    const int b = item >> 2, hh = item & 3;
    char* ws = P->ws;
    const bf16_t* qb = (const bf16_t*)(ws + W_Q);
    float* sc = (float*)shm;
    float* part = (float*)(shm + 4096);
    bf16x8 qf[8];
#pragma unroll
    for (int kk = 0; kk < 8; ++kk) {
        bf16x8 z = {0, 0, 0, 0, 0, 0, 0, 0};
        if (fr < 4) z = *(const bf16x8*)(qb + (size_t)(TP + b * 4 + fr) * 1024 + hh * 256 + kk * 32 + fq * 8);
        qf[kk] = z;
    }
#pragma unroll
    for (int mt = 0; mt < 2; ++mt) {
        const int key = w * 32 + mt * 16 + fr;
        const float* kp = P->cache_k + ((size_t)(b * 256 + key) * 4 + hh) * 256 + fq * 8;
        f32x4 acc = (f32x4){0.f, 0.f, 0.f, 0.f};
#pragma unroll
        for (int kk = 0; kk < 8; ++kk) {
            const f32x4 k0 = *(const f32x4*)(kp + kk * 32), k1 = *(const f32x4*)(kp + kk * 32 + 4);
            u32x4 pk; pk.x = pk2(k0[0], k0[1]); pk.y = pk2(k0[2], k0[3]); pk.z = pk2(k1[0], k1[1]); pk.w = pk2(k1[2], k1[3]);
            acc = __builtin_amdgcn_mfma_f32_16x16x32_bf16(qf[kk], __builtin_bit_cast(bf16x8, pk), acc, 0, 0, 0);
        }
        if (fq == 0) {
#pragma unroll
            for (int j = 0; j < 4; ++j) sc[j * 256 + w * 32 + mt * 16 + fr] = acc[j];
        }
    }
    __syncthreads();
    if (w < 4) {
        f32x4 s = *(const f32x4*)(sc + w * 256 + lane * 4);
        float m = fmaxf(fmaxf(s[0], s[1]), fmaxf(s[2], s[3])); m = wave_max(m);
        s[0] = __expf(s[0] - m); s[1] = __expf(s[1] - m); s[2] = __expf(s[2] - m); s[3] = __expf(s[3] - m);
        float su = (s[0] + s[1]) + (s[2] + s[3]); su = wave_sum(su);
        const float inv = 1.0f / su;
        *(f32x4*)(sc + w * 256 + lane * 4) = s * inv;
    }
    __syncthreads();
    {
        f32x4 o[4];
#pragma unroll
        for (int i = 0; i < 4; ++i) o[i] = (f32x4){0.f, 0.f, 0.f, 0.f};
        const float* vp = P->cache_v + ((size_t)(b * 256 + w * 32) * 4 + hh) * 256 + lane * 4;
#pragma unroll 8
        for (int mm = 0; mm < 32; ++mm) {
            const f32x4 v = *(const f32x4*)(vp + (size_t)mm * 1024);
#pragma unroll
            for (int i = 0; i < 4; ++i) o[i] += sc[i * 256 + w * 32 + mm] * v;
        }
#pragma unroll
        for (int i = 0; i < 4; ++i) *(f32x4*)(part + (w * 4 + i) * 256 + lane * 4) = o[i];
    }
    __syncthreads();
    {
        const int i = tid >> 7, d2 = (tid & 127) * 2;
        float s0 = 0.f, s1 = 0.f;
#pragma unroll
        for (int ww = 0; ww < 8; ++ww) { s0 += part[(ww * 4 + i) * 256 + d2]; s1 += part[(ww * 4 + i) * 256 + d2 + 1]; }
        *(unsigned*)((bf16_t*)(ws + W_O) + (size_t)(TP + b * 4 + i) * 1024 + hh * 256 + d2) = pk2(s0, s1);
    }
    __syncthreads();
}

__device__ __forceinline__ void phase_ffnconv(PP P, int gtid, int nthreads) {
    char* ws = P->ws;
    const bf16_t* u = (const bf16_t*)(ws + W_U);
    bf16_t* act = (bf16_t*)(ws + W_ACT);
    for (int idx = gtid; idx < 1152 * 352; idx += nthreads) {
        const int run = idx / 352, cg = idx % 352;
        const bool samp = run >= 1024;
        int t0, len, bidx, tl0;
        if (!samp) { t0 = run * 16; len = 16; bidx = t0 >> 11; tl0 = t0 & 2047; } else { bidx = run - 1024; t0 = TP + bidx * 4; len = 4; tl0 = 0; }
        const int cgc = cg * 8, cvc = 2816 + cg * 8;
        float wg0[8], wg1[8], wg2[8], wv0[8], wv1[8], wv2[8], bg[8], bv[8], hg0[8], hg1[8], hv0[8], hv1[8];
#pragma unroll
        for (int e = 0; e < 8; ++e) {
            wg0[e] = P->ffn_w[cgc + e]; wg1[e] = P->ffn_w[5632 + cgc + e]; wg2[e] = P->ffn_w[11264 + cgc + e];
            wv0[e] = P->ffn_w[cvc + e]; wv1[e] = P->ffn_w[5632 + cvc + e]; wv2[e] = P->ffn_w[11264 + cvc + e];
            bg[e] = P->ffn_b[cgc + e]; bv[e] = P->ffn_b[cvc + e];
        }
        if (samp) {
#pragma unroll
            for (int e = 0; e < 8; ++e) {
                hg0[e] = P->state_ffn[(size_t)(bidx * 2 + 0) * 5632 + cgc + e]; hg1[e] = P->state_ffn[(size_t)(bidx * 2 + 1) * 5632 + cgc + e];
                hv0[e] = P->state_ffn[(size_t)(bidx * 2 + 0) * 5632 + cvc + e]; hv1[e] = P->state_ffn[(size_t)(bidx * 2 + 1) * 5632 + cvc + e];
            }
        } else if (tl0 > 0) {
            unpack8(ld8(u + (size_t)(t0 - 2) * 5632 + cgc), hg0); unpack8(ld8(u + (size_t)(t0 - 1) * 5632 + cgc), hg1);
            unpack8(ld8(u + (size_t)(t0 - 2) * 5632 + cvc), hv0); unpack8(ld8(u + (size_t)(t0 - 1) * 5632 + cvc), hv1);
        } else {
#pragma unroll
            for (int e = 0; e < 8; ++e) { hg0[e] = 0.f; hg1[e] = 0.f; hv0[e] = 0.f; hv1[e] = 0.f; }
        }
#pragma unroll 4
        for (int j = 0; j < len; ++j) {
            float ug[8], uv[8], o8[8];
            unpack8(ld8(u + (size_t)(t0 + j) * 5632 + cgc), ug); unpack8(ld8(u + (size_t)(t0 + j) * 5632 + cvc), uv);
#pragma unroll
            for (int e = 0; e < 8; ++e) {
                const float gc = bg[e] + wg0[e] * hg0[e] + wg1[e] * hg1[e] + wg2[e] * ug[e];
                const float vc = bv[e] + wv0[e] * hv0[e] + wv1[e] * hv1[e] + wv2[e] * uv[e];
                o8[e] = silu_f(gc) * vc;
            }
            *(u32x4*)(act + (size_t)(t0 + j) * 2816 + cgc) = pack8(o8);
            float* o = nullptr;
            if (samp) { if (j >= 2) o = P->out + O_FFNS + (size_t)(bidx * 2 + j - 2) * 5632; }
            else { const int tl = tl0 + j; if (tl >= 2046) o = P->out + O_FFNP + (size_t)(bidx * 2 + tl - 2046) * 5632; }
            if (o) {
#pragma unroll
                for (int e = 0; e < 8; ++e) { o[cgc + e] = ug[e]; o[cvc + e] = uv[e]; }
            }
#pragma unroll
            for (int e = 0; e < 8; ++e) { hg0[e] = hg1[e]; hg1[e] = ug[e]; hv0[e] = hv1[e]; hv1[e] = uv[e]; }
        }
    }
}

#define XB_TMO      128
#define XB_XCNT(j)  (256  + 64 * (j))
#define XB_XSUB(j)  (1280 + 64 * (j))
#define XB_XGEN(j)  (2304 + 64 * (j))
#define XB_TOP      3328
#define XB_TOPGEN   3392
#define XCD_BAR_WORDS 3456
#define XB_SPIN_CAP (1u << 18)
__device__ __forceinline__ unsigned xb_ld(unsigned* p)              { return __hip_atomic_load(p, __ATOMIC_RELAXED, __HIP_MEMORY_SCOPE_AGENT); }
__device__ __forceinline__ unsigned xb_add(unsigned* p, unsigned v) { return __hip_atomic_fetch_add(p, v, __ATOMIC_RELAXED, __HIP_MEMORY_SCOPE_AGENT); }
__device__ __forceinline__ unsigned xb_xcc_id() { return (unsigned)__builtin_amdgcn_s_getreg((3 << 11) | 20) & 0xFu; }
#define XB_SPIN(cond, bar) do { unsigned _sp = 0; while (cond) { __builtin_amdgcn_s_sleep(1); \
    if ((++_sp & 255u) == 0u) { if (xb_ld(&(bar)[XB_TMO])) break; if (_sp > XB_SPIN_CAP) { atomicAdd(&(bar)[XB_TMO], 1u); break; } } } } while (0)
__device__ __forceinline__ void xcd_barrier_complete(unsigned* bar, unsigned x, unsigned& nloc, unsigned& nx) {
    const unsigned G = gridDim.x;
    unsigned sum, cnt, mine, sp = 0u;
    for (;;) {
        sum = 0u; cnt = 0u; mine = 0u;
#pragma unroll
        for (unsigned j = 0; j < 16; ++j) { const unsigned c = xb_ld(&bar[XB_XCNT(j)]); sum += c; cnt += (c > 0u) ? 1u : 0u; mine = (j == x) ? c : mine; }
        if (sum == G) break;
        __builtin_amdgcn_s_sleep(1);
        if ((++sp & 255u) == 0u) { if (xb_ld(&bar[XB_TMO])) break; if (sp > XB_SPIN_CAP) { atomicAdd(&bar[XB_TMO], 1u); break; } }
    }
    nloc = mine > 0u ? mine : 1u; nx = cnt > 0u ? cnt : 1u;
}
__device__ __forceinline__ void xcd_barrier(unsigned* bar, volatile LDSB unsigned* st, const int tid) {
    asm volatile("s_waitcnt vmcnt(0)" ::: "memory");
    __syncthreads();
    if (tid == 0) {
        const unsigned x = xb_xcc_id();
        __builtin_amdgcn_s_waitcnt(0);
        unsigned nloc = st[0], nx = st[1];
        if (nloc == 0u) { xcd_barrier_complete(bar, x, nloc, nx); st[0] = nloc; st[1] = nx; }
        const unsigned old = xb_add(&bar[XB_XSUB(x)], 1u);
        const unsigned gen = old / nloc;
        if (old + 1u == (gen + 1u) * nloc) {
            __builtin_amdgcn_fence(__ATOMIC_RELEASE, "agent");
            asm volatile("s_waitcnt vmcnt(0)" ::: "memory");
            const unsigned og = xb_add(&bar[XB_TOP], 1u);
            const unsigned tg = og / nx;
            if (og + 1u == (tg + 1u) * nx) xb_add(&bar[XB_TOPGEN], 1u);
            else XB_SPIN(xb_ld(&bar[XB_TOPGEN]) == tg, bar);
            __builtin_amdgcn_fence(__ATOMIC_ACQUIRE, "agent");
            xb_add(&bar[XB_XGEN(x)], 1u);
            asm volatile("s_waitcnt vmcnt(0)" ::: "memory");
        } else {
            XB_SPIN(xb_ld(&bar[XB_XGEN(x)]) == gen, bar);
            __builtin_amdgcn_fence(__ATOMIC_ACQUIRE, "agent");
            asm volatile("s_waitcnt vmcnt(0)" ::: "memory");
        }
    }
    __syncthreads();
}

extern __shared__ __attribute__((aligned(16))) char smem[];

__global__ void __launch_bounds__(NTHR) hybrid_fwd(Params Pin) {
    cg::grid_group grid = cg::this_grid();
    char* shm = smem;
    const int nblk = gridDim.x;
    volatile LDSB unsigned* bst = (volatile LDSB unsigned*)(smem + 139264);
    if (threadIdx.x == 0) { bst[0] = 0u; bst[1] = 0u; (void)xb_add((unsigned*)(Pin.ws + W_BAR) + XB_XCNT(xb_xcc_id()), 1u); }
    __syncthreads();
    for (int ph = Pin.ph_lo; ph < Pin.ph_hi; ++ph) {
        const int reps = ((REPEAT_MASK >> ph) & 1) ? 2 : 1;
        for (int rep = 0; rep < reps; ++rep) {
        if (rep > 0) xcd_barrier((unsigned*)(Pin.ws + W_BAR), bst, threadIdx.x);
        int tid = threadIdx.x, blk = blockIdx.x;
        asm volatile("" : "+v"(tid));
        asm volatile("" : "+s"(blk));
        PP P = (PP)__builtin_amdgcn_kernarg_segment_ptr();
        asm volatile("" : "+s"(P));
        const int lb = (blk & 7) * (nblk >> 3) + (blk >> 3);
        const int gtid = blk * NTHR + tid, nthreads = nblk * NTHR;
        const int gw = blk * 8 + (tid >> 6), nw = nblk * 8;
        switch (ph) {
#if PHASE_MASK & 1
        case 0: phase_prep(P, shm, blk, nblk, tid); break;
#endif
#if PHASE_MASK & 4
        case 2: phase_convpool(P, gtid, nthreads); break;
#endif
#if PHASE_MASK & 8
        case 3:
            for (int it = blk; it < 256; it += nblk) ssd_prompt(P, it, shm, tid);
            for (int it = blk; it < 2048; it += nblk) ssd_sample(P, it, tid);
            break;
#endif
#if PHASE_MASK & 16
        case 4: phase_gatednorm(P, gw, nw, tid); break;
#endif
#if PHASE_MASK & 64
        case 6: phase_norm(P, P->norm_mem, false, gw, nw, tid); break;
        case 11: phase_norm(P, P->norm_ffn, false, gw, nw, tid); break;
        case 15: phase_norm(P, P->final_norm, true, gw, nw, tid); break;
#endif
#if PHASE_MASK & 8192
        case 13: phase_ffnconv(P, gtid, nthreads); break;
#endif
        default: break;
        }
#if PHASE_MASK & 2
        if (ph == 1 || ph == 3 || ph == 5 || ph == 7 || ph == 8 || ph == 9 || ph == 10 || ph == 12 || ph == 14) gemm_phase(P, ph, shm, lb, nblk, tid);
#endif
#if PHASE_MASK & 256
        if (ph == 8) { for (int it = blk; it < 512; it += nblk) attn_sample(P, it, shm, tid); }
#endif
        }
        if (ph + 1 < Pin.ph_hi) { if (ph == 0) grid.sync(); else xcd_barrier((unsigned*)(Pin.ws + W_BAR), bst, threadIdx.x); }
        if (EXTRA_SYNCS && ph == 0) { for (int i = 0; i < EXTRA_SYNCS; ++i) xcd_barrier((unsigned*)(Pin.ws + W_BAR), bst, threadIdx.x); }
    }
}

extern "C" void kernel_launch(void* const* d_in, const int* in_sizes, int n_in, void* d_out, int out_size, void* d_ws, size_t ws_size, hipStream_t stream) {
    static int grid_blocks = 0;
    if (!grid_blocks) {
        int dev = 0, cus = 0, per_cu = 0;
        hipGetDevice(&dev);
        hipDeviceGetAttribute(&cus, hipDeviceAttributeMultiprocessorCount, dev);
        hipFuncSetAttribute((const void*)hybrid_fwd, hipFuncAttributeMaxDynamicSharedMemorySize, LDS_BYTES);
        hipOccupancyMaxActiveBlocksPerMultiprocessor(&per_cu, hybrid_fwd, NTHR, LDS_BYTES);
        if (per_cu < 1) per_cu = 1;
        grid_blocks = cus * 1;
        grid_blocks &= ~7;
        if (grid_blocks < 8) grid_blocks = 8;
    }
    Params p{};
    const float* const* in = (const float* const*)d_in;
    p.x_prompt = in[0]; p.x_sample = in[1]; p.mem_prompt = in[2]; p.state_ssm = in[3]; p.state_conv = in[4]; p.state_pool = in[5]; p.state_ffn = in[6];
    p.cache_k = in[7]; p.cache_v = in[8]; p.norm_mix = in[9]; p.w_in = in[10]; p.conv_w = in[11]; p.conv_b = in[12]; p.dt_bias = in[13]; p.a_log = in[14];
    p.ssm_d = in[15]; p.ssm_norm = in[16]; p.w_pool = in[17]; p.pool_scale = in[18]; p.w_out = in[19]; p.norm_mem = in[20]; p.norm_memkv = in[21];
    p.w_mq = in[22]; p.w_mk = in[23]; p.w_mv = in[24]; p.w_mo = in[25]; p.norm_ffn = in[26]; p.w_up = in[27]; p.ffn_w = in[28]; p.ffn_b = in[29];
    p.w_down = in[30]; p.final_norm = in[31];
    p.out = (float*)d_out; p.ws = (char*)d_ws; p.ph_lo = 0; p.ph_hi = 16;
    hipMemsetAsync((char*)d_ws + W_BAR, 0, 16384, stream);
    void* args[] = {&p};
    hipError_t e = hipLaunchCooperativeKernel((const void*)hybrid_fwd, dim3(grid_blocks), dim3(NTHR), args, LDS_BYTES, stream);
    if (e != hipSuccess) fprintf(stderr, "cooperative launch failed: %s (grid %d)\n", hipGetErrorString(e), grid_blocks);
}
```

```cpp
#include <hip/hip_runtime.h>
#include <hip/hip_cooperative_groups.h>
#include <cstdio>
namespace cg = cooperative_groups;

typedef unsigned short bf16_t;
typedef short bf16x8 __attribute__((ext_vector_type(8)));
typedef short s16x4 __attribute__((ext_vector_type(4)));
typedef float f32x4 __attribute__((ext_vector_type(4)));
typedef unsigned u32x4 __attribute__((ext_vector_type(4)));
typedef unsigned u32x2 __attribute__((ext_vector_type(2)));
#define LDSB __attribute__((address_space(3)))

constexpr int TP = 16384, TS = 512, TT = TP + TS;
constexpr int NTHR = 512;
constexpr int LDS_BYTES = 139264 + 256;
constexpr float EPS = 1e-6f;
#ifndef PHASE_MASK
#define PHASE_MASK 0xFFFF
#endif
#ifndef REPEAT_MASK
#define REPEAT_MASK 0
#endif
#ifndef EXTRA_SYNCS
#define EXTRA_SYNCS 0
#endif

constexpr size_t O_YP = 0;
constexpr size_t O_YS = O_YP + (size_t)TP * 1024;
constexpr size_t O_SSMP = O_YS + (size_t)TS * 1024;
constexpr size_t O_SSMS = O_SSMP + (size_t)8 * 16 * 64 * 128;
constexpr size_t O_CONVP = O_SSMS + (size_t)128 * 16 * 64 * 128;
constexpr size_t O_CONVS = O_CONVP + (size_t)8 * 3 * 1536;
constexpr size_t O_POOLP = O_CONVS + (size_t)128 * 3 * 1536;
constexpr size_t O_POOLS = O_POOLP + (size_t)8 * 15 * 1024;
constexpr size_t O_FFNP = O_POOLS + (size_t)128 * 15 * 1024;
constexpr size_t O_FFNS = O_FFNP + (size_t)8 * 2 * 5632;
constexpr size_t O_MK = O_FFNS + (size_t)128 * 2 * 5632;
constexpr size_t O_MV = O_MK + (size_t)8 * 256 * 1024;

constexpr size_t W_WIN = 0;
constexpr size_t W_WPOOL = W_WIN + (size_t)3584 * 1024 * 2;
constexpr size_t W_WOUT = W_WPOOL + (size_t)4 * 256 * 256 * 2;
constexpr size_t W_WMQ = W_WOUT + (size_t)1024 * 2048 * 2;
constexpr size_t W_WMK = W_WMQ + (size_t)1024 * 1024 * 2;
constexpr size_t W_WMV = W_WMK + (size_t)1024 * 1024 * 2;
constexpr size_t W_WMO = W_WMV + (size_t)1024 * 1024 * 2;
constexpr size_t W_WUP = W_WMO + (size_t)1024 * 1024 * 2;
constexpr size_t W_WDOWN = W_WUP + (size_t)5632 * 1024 * 2;
constexpr size_t W_H = W_WDOWN + (size_t)1024 * 2816 * 2;
constexpr size_t W_HM = W_H + (size_t)TT * 1024 * 2;
constexpr size_t W_KB = W_HM + (size_t)2048 * 1024 * 2;
constexpr size_t W_VT = W_KB + (size_t)2048 * 1024 * 2;
constexpr size_t W_DT = W_VT + (size_t)2048 * 1024 * 2;
constexpr size_t W_XRES = W_DT + (size_t)TT * 16 * 4;
constexpr size_t W_ARENA = W_XRES + (size_t)TT * 1024 * 4;
constexpr size_t W_Z = W_ARENA;
constexpr size_t W_PROJ2 = W_Z + (size_t)TT * 1024 * 2;
constexpr size_t W_XACT = W_PROJ2 + (size_t)TT * 2560 * 2;
constexpr size_t W_POOLED = W_XACT + (size_t)TT * 1536 * 2;
constexpr size_t W_Y = W_POOLED + (size_t)TT * 1024 * 2;
constexpr size_t W_MIX = W_Y + (size_t)TT * 1024 * 2;
constexpr size_t W_END_A = W_MIX + (size_t)TT * 2048 * 2;
constexpr size_t W_Q = W_PROJ2;
constexpr size_t W_P = W_Q + (size_t)TT * 1024 * 2;
constexpr size_t W_O = W_P + (size_t)TP * 1024 * 2;
constexpr size_t W_U = W_ARENA;
constexpr size_t W_ACT = W_U + (size_t)TT * 5632 * 2;
constexpr size_t W_END_C = W_ACT + (size_t)TT * 2816 * 2;
constexpr size_t W_BAR = W_END_A;
constexpr size_t W_TOTAL = W_BAR + 16384;
static_assert(W_O + (size_t)TT * 1024 * 2 <= W_POOLED, "era B overflow");
static_assert(W_END_C <= W_END_A, "era C overflow");

struct Params {
    const float *x_prompt, *x_sample, *mem_prompt, *state_ssm, *state_conv, *state_pool, *state_ffn, *cache_k, *cache_v;
    const float *norm_mix, *w_in, *conv_w, *conv_b, *dt_bias, *a_log, *ssm_d, *ssm_norm, *w_pool, *pool_scale, *w_out;
    const float *norm_mem, *norm_memkv, *w_mq, *w_mk, *w_mv, *w_mo, *norm_ffn, *w_up, *ffn_w, *ffn_b, *w_down, *final_norm;
    float* out;
    char* ws;
    int ph_lo, ph_hi;
};

typedef const __attribute__((address_space(4))) Params* PP;

__device__ __forceinline__ unsigned pk2(float lo, float hi) { unsigned r; asm("v_cvt_pk_bf16_f32 %0, %1, %2" : "=v"(r) : "v"(lo), "v"(hi)); return r; }
__device__ __forceinline__ bf16_t f2bf(float f) { return (bf16_t)(pk2(f, 0.f) & 0xffffu); }
__device__ __forceinline__ float bf2f(bf16_t b) { return __uint_as_float(((unsigned)b) << 16); }
__device__ __forceinline__ float bflo(unsigned u) { return __uint_as_float(u << 16); }
__device__ __forceinline__ float bfhi(unsigned u) { return __uint_as_float(u & 0xffff0000u); }
__device__ __forceinline__ void unpack8(u32x4 v, float (&f)[8]) {
    f[0] = bflo(v.x); f[1] = bfhi(v.x); f[2] = bflo(v.y); f[3] = bfhi(v.y); f[4] = bflo(v.z); f[5] = bfhi(v.z); f[6] = bflo(v.w); f[7] = bfhi(v.w);
}
__device__ __forceinline__ u32x4 pack8(const float (&f)[8]) { u32x4 r; r.x = pk2(f[0], f[1]); r.y = pk2(f[2], f[3]); r.z = pk2(f[4], f[5]); r.w = pk2(f[6], f[7]); return r; }
__device__ __forceinline__ float wave_sum(float v) {
#pragma unroll
    for (int o = 1; o < 64; o <<= 1) v += __shfl_xor(v, o);
    return v;
}
__device__ __forceinline__ float wave_max(float v) {
#pragma unroll
    for (int o = 1; o < 64; o <<= 1) v = fmaxf(v, __shfl_xor(v, o));
    return v;
}
__device__ __forceinline__ float silu_f(float x) { return x / (1.0f + __expf(-x)); }

constexpr int HTB = 128 * 64 * 2;
__device__ __forceinline__ int lds_byte(int r, int c) { const int st = (r >> 4) * 2 + (c >> 5), rr = r & 15, cc = c & 31, ob = rr * 64 + cc * 2; return st * 1024 + (ob ^ (((ob >> 9) & 1) << 5)); }
__device__ __forceinline__ void stage_rc(int b, int& R, int& C) { const int st = b / 1024, sb = b % 1024, swz = sb ^ (((sb >> 9) & 1) << 5); R = (st >> 1) * 16 + swz / 64; C = (st & 1) * 32 + (swz % 64) / 2; }

enum { E_PROJ = 0, E_MEMKV, E_POOL, E_OUT, E_Q, E_QK, E_PV, E_MO, E_UP, E_DOWN };

template <int EK>
__device__ __forceinline__ void epi_apply(PP P, int row, int col, f32x4 v) {
    char* ws = P->ws;
    if constexpr (EK == E_PROJ) {
        u32x2 o; o.x = pk2(v[0], v[1]); o.y = pk2(v[2], v[3]);
        if (col < 1024) *(u32x2*)((bf16_t*)(ws + W_Z) + (size_t)row * 1024 + col) = o;
        else *(u32x2*)((bf16_t*)(ws + W_PROJ2) + (size_t)row * 2560 + (col - 1024)) = o;
    } else if constexpr (EK == E_MEMKV) {
        if (col < 1024) {
            *(f32x4*)(P->out + O_MK + (size_t)row * 1024 + col) = v;
            u32x2 o; o.x = pk2(v[0], v[1]); o.y = pk2(v[2], v[3]);
            *(u32x2*)((bf16_t*)(ws + W_KB) + (size_t)row * 1024 + col) = o;
        } else {
            const int c = col - 1024;
            *(f32x4*)(P->out + O_MV + (size_t)row * 1024 + c) = v;
            const int b = row >> 8, m = row & 255, hh = c >> 8, d = c & 255;
            bf16_t* vt = (bf16_t*)(ws + W_VT) + ((size_t)(b * 4 + hh) * 256 + d) * 256 + m;
#pragma unroll
            for (int j = 0; j < 4; ++j) vt[j * 256] = f2bf(v[j]);
        }
    } else if constexpr (EK == E_POOL) {
        const f32x4 sc = *(const f32x4*)(P->pool_scale + col);
        u32x2 o; o.x = pk2(v[0] * sc[0], v[1] * sc[1]); o.y = pk2(v[2] * sc[2], v[3] * sc[3]);
        *(u32x2*)((bf16_t*)(ws + W_MIX) + (size_t)row * 2048 + 1024 + col) = o;
    } else if constexpr (EK == E_OUT) {
        const float* xin = row < TP ? P->x_prompt + (size_t)row * 1024 : P->x_sample + (size_t)(row - TP) * 1024;
        const f32x4 x = *(const f32x4*)(xin + col);
        *(f32x4*)((float*)(ws + W_XRES) + (size_t)row * 1024 + col) = x + v;
    } else if constexpr (EK == E_Q) {
        u32x2 o; o.x = pk2(v[0] * 0.0625f, v[1] * 0.0625f); o.y = pk2(v[2] * 0.0625f, v[3] * 0.0625f);
        *(u32x2*)((bf16_t*)(ws + W_Q) + (size_t)row * 1024 + col) = o;
    } else if constexpr (EK == E_PV) {
        u32x2 o; o.x = pk2(v[0], v[1]); o.y = pk2(v[2], v[3]);
        *(u32x2*)((bf16_t*)(ws + W_O) + (size_t)row * 1024 + col) = o;
    } else if constexpr (EK == E_MO || EK == E_DOWN) {
        float* xr = (float*)(ws + W_XRES) + (size_t)row * 1024 + col;
        *(f32x4*)xr = *(const f32x4*)xr + v;
    } else if constexpr (EK == E_UP) {
        u32x2 o; o.x = pk2(v[0], v[1]); o.y = pk2(v[2], v[3]);
        *(u32x2*)((bf16_t*)(ws + W_U) + (size_t)row * 5632 + col) = o;
    }
}
__device__ __forceinline__ void epi_apply_rt(PP P, int ekind, int row, int col, f32x4 v) {
    switch (ekind) {
    case E_PROJ: epi_apply<E_PROJ>(P, row, col, v); break;
    case E_POOL: epi_apply<E_POOL>(P, row, col, v); break;
    case E_OUT: epi_apply<E_OUT>(P, row, col, v); break;
    case E_Q: epi_apply<E_Q>(P, row, col, v); break;
    case E_MO: epi_apply<E_MO>(P, row, col, v); break;
    case E_UP: epi_apply<E_UP>(P, row, col, v); break;
    default: epi_apply<E_DOWN>(P, row, col, v); break;
    }
}
template <int EK>
__device__ __forceinline__ void epi_loop(PP P, const f32x4 (&acc)[2][2][4][2], int rbase, int cbase) {
#pragma unroll
    for (int ai = 0; ai < 2; ++ai)
#pragma unroll
        for (int m = 0; m < 4; ++m)
#pragma unroll
            for (int bj = 0; bj < 2; ++bj)
#pragma unroll
                for (int n = 0; n < 2; ++n) epi_apply<EK>(P, rbase + ai * 128 + m * 16, cbase + bj * 128 + n * 16, acc[ai][bj][m][n]);
}

struct PhaseCfg { const char* A; const char* B; int lda, ldb, K, nbig, nsmall, ncol64, ekind; };
__device__ __forceinline__ PhaseCfg phase_cfg(PP P, int gp) {
    const char* ws = P->ws; PhaseCfg c;
    switch (gp) {
    case 1:  c.A = ws + W_H;      c.B = ws + W_WIN;   c.lda = 1024; c.ldb = 1024; c.K = 1024; c.nbig = 66 * 14 + 64; c.nsmall = 0; c.ncol64 = 56; c.ekind = E_PROJ; break;
    case 3:  c.A = ws + W_POOLED; c.B = ws + W_WPOOL; c.lda = 1024; c.ldb = 256;  c.K = 256;  c.nbig = 256; c.nsmall = 256; c.ncol64 = 16; c.ekind = E_POOL; break;
    case 5:  c.A = ws + W_MIX;    c.B = ws + W_WOUT;  c.lda = 2048; c.ldb = 2048; c.K = 2048; c.nbig = 256; c.nsmall = 256; c.ncol64 = 16; c.ekind = E_OUT; break;
    case 7:  c.A = ws + W_H;      c.B = ws + W_WMQ;   c.lda = 1024; c.ldb = 1024; c.K = 1024; c.nbig = 256; c.nsmall = 256; c.ncol64 = 16; c.ekind = E_Q; break;
    case 8:  c.A = ws + W_Q;      c.B = ws + W_KB;    c.lda = 1024; c.ldb = 1024; c.K = 256;  c.nbig = 256; c.nsmall = 0;   c.ncol64 = 16; c.ekind = E_QK; break;
    case 9:  c.A = ws + W_P;      c.B = ws + W_VT;    c.lda = 1024; c.ldb = 256;  c.K = 256;  c.nbig = 256; c.nsmall = 0;   c.ncol64 = 16; c.ekind = E_PV; break;
    case 10: c.A = ws + W_O;      c.B = ws + W_WMO;   c.lda = 1024; c.ldb = 1024; c.K = 1024; c.nbig = 256; c.nsmall = 256; c.ncol64 = 16; c.ekind = E_MO; break;
    case 12: c.A = ws + W_H;      c.B = ws + W_WUP;   c.lda = 1024; c.ldb = 1024; c.K = 1024; c.nbig = 66 * 22; c.nsmall = 0; c.ncol64 = 88; c.ekind = E_UP; break;
    default: c.A = ws + W_ACT;    c.B = ws + W_WDOWN; c.lda = 2816; c.ldb = 2816; c.K = 2816; c.nbig = 256; c.nsmall = 256; c.ncol64 = 16; c.ekind = E_DOWN; break;
    }
    return c;
}
struct UnitD { const char* A; const char* B; int row0, col0, ekind; };
__device__ __forceinline__ void map_unit(int L, int nM, int nN, int& pm, int& pn) {
    const int nwg = nM * nN, q = nwg >> 3, r = nwg & 7, xcd = L & 7, off = L >> 3;
    const int wgid = (xcd < r ? xcd * (q + 1) : r * (q + 1) + (xcd - r) * q) + off;
    const int nig = 8 * nN, gid = wgid / nig, fm = gid * 8, gsz = (nM - fm) < 8 ? (nM - fm) : 8;
    const int w = wgid - gid * nig;
    pm = fm + w % gsz; pn = w / gsz;
}
__device__ __forceinline__ UnitD unit_decode(PP P, const PhaseCfg& c, int gp, int L) {
    UnitD d; d.ekind = c.ekind;
    int pm, pn;
    switch (gp) {
    case 1:
        if (L < 924) { map_unit(L, 66, 14, pm, pn); d.A = c.A + (size_t)pm * 256 * 2048; d.B = c.B + (size_t)pn * 256 * 2048; }
        else { map_unit(L - 924, 8, 8, pm, pn); d.A = P->ws + W_HM + (size_t)pm * 256 * 2048; d.B = P->ws + W_WMK + (size_t)pn * 256 * 2048; d.ekind = E_MEMKV; }
        break;
    case 3: map_unit(L, 64, 4, pm, pn); d.A = c.A + (size_t)pm * 256 * 2048 + pn * 512; d.B = c.B + (size_t)pn * 131072; break;
    case 8: map_unit(L, 64, 4, pm, pn); d.A = c.A + (size_t)pm * 256 * 2048 + pn * 512; d.B = c.B + (size_t)(pm >> 3) * 256 * 2048 + pn * 512; break;
    case 9: map_unit(L, 64, 4, pm, pn); d.A = c.A + (size_t)pm * 256 * 2048 + pn * 512; d.B = c.B + (size_t)((pm >> 3) * 4 + pn) * 131072; break;
    case 12: map_unit(L, 66, 22, pm, pn); d.A = c.A + (size_t)pm * 256 * 2048; d.B = c.B + (size_t)pn * 256 * 2048; break;
    default: map_unit(L, 64, 4, pm, pn); d.A = c.A + (size_t)pm * 256 * c.lda * 2; d.B = c.B + (size_t)pn * 256 * c.ldb * 2; break;
    }
    d.row0 = pm * 256; d.col0 = pn * 256;
    return d;
}

__device__ __forceinline__ void gemm_phase(PP P, int gp, char* shm_g, int lb, int blk, int nblk, const int tid) {
    LDSB unsigned char* lds = (LDSB unsigned char*)shm_g;
    const int wid = __builtin_amdgcn_readfirstlane(tid >> 6), lane = tid & 63, wr = wid >> 2, wc = wid & 3, fr = lane & 15, fq = lane >> 4;
    const PhaseCfg cfg = phase_cfg(P, gp);
    const int K = cfg.K, nt = K / 64;
    unsigned voffA, voffB;
    { int R, C; stage_rc(tid * 16, R, C); voffA = (unsigned)(R * cfg.lda + C) * 2u; voffB = (unsigned)(R * cfg.ldb + C) * 2u; }
    const size_t qstepvoffA = (size_t)64 * cfg.lda * 2, qstepvoffB = (size_t)64 * cfg.ldb * 2;
    const size_t kstep = 128;
    const size_t hstepA = (size_t)128 * cfg.lda * 2, hstepB = (size_t)128 * cfg.ldb * 2;
    const unsigned ldsw = (unsigned)wid * 1024u;
    const int aoff = lds_byte(wr * 64 + fr, fq * 8), boff = lds_byte(wc * 32 + fr, fq * 8);
    const bool chain = (cfg.ekind != E_QK);
#define G_SA(b, h) (((b) * 2 + (h)) * HTB)
#define G_SB(b, h) ((4 + (b) * 2 + (h)) * HTB)
#define G_STAGE(bufoff, gbase, voff) do { \
        __builtin_amdgcn_global_load_lds((const unsigned*)((const char*)(gbase) + (voff)), (LDSB unsigned*)(lds + (bufoff) + ldsw), 16, 0, 0); \
        __builtin_amdgcn_global_load_lds((const unsigned*)((const char*)(gbase) + qstep##voff + (voff)), (LDSB unsigned*)(lds + (bufoff) + ldsw + 8192), 16, 0, 0); } while (0)
#define G_LDA(dst, b, h) do { _Pragma("unroll") for (int m = 0; m < 4; ++m) _Pragma("unroll") for (int k = 0; k < 2; ++k) dst[m][k] = *(const LDSB bf16x8*)(lds + G_SA(b, h) + aoff + m * 2048 + k * 1024); } while (0)
#define G_LDB(dst, b, h) do { _Pragma("unroll") for (int n = 0; n < 2; ++n) _Pragma("unroll") for (int k = 0; k < 2; ++k) dst[n][k] = *(const LDSB bf16x8*)(lds + G_SB(b, h) + boff + n * 2048 + k * 1024); } while (0)
#define G_MMA(ai, bj, Af, Bf) do { __builtin_amdgcn_s_setprio(1); _Pragma("unroll") for (int m = 0; m < 4; ++m) _Pragma("unroll") for (int n = 0; n < 2; ++n) _Pragma("unroll") for (int k = 0; k < 2; ++k) \
        acc[ai][bj][m][n] = __builtin_amdgcn_mfma_f32_16x16x32_bf16(Bf[n][k], Af[m][k], acc[ai][bj][m][n], 0, 0, 0); __builtin_amdgcn_s_setprio(0); } while (0)
#define G_WAIT_V(n) asm volatile("s_waitcnt vmcnt(" #n ")" ::: "memory")
#define G_WAIT_L(n) asm volatile("s_waitcnt lgkmcnt(" #n ")" ::: "memory")
#define G_BAR __builtin_amdgcn_s_barrier()
#define G_SCHED __builtin_amdgcn_sched_barrier(0)
    int u = blk;
    while (u < cfg.nbig) {
        UnitD cur = unit_decode(P, cfg, gp, u);
        f32x4 acc[2][2][4][2];
#pragma unroll
        for (int a = 0; a < 2; ++a)
#pragma unroll
            for (int b = 0; b < 2; ++b)
#pragma unroll
                for (int m = 0; m < 4; ++m)
#pragma unroll
                    for (int n = 0; n < 2; ++n) acc[a][b][m][n] = (f32x4){0.f, 0.f, 0.f, 0.f};
        bf16x8 At[4][2], B0[2][2], B1[2][2];
        const char* cA = cur.A; const char* cB = cur.B;
        G_STAGE(G_SB(0, 0), cB, voffB); G_STAGE(G_SA(0, 0), cA, voffA); G_STAGE(G_SB(0, 1), cB + hstepB, voffB); G_STAGE(G_SA(0, 1), cA + hstepA, voffA);
        if (wr == 1) G_BAR;
        G_WAIT_V(4); G_BAR;
        G_STAGE(G_SB(1, 0), cB + kstep, voffB); G_STAGE(G_SA(1, 0), cA + kstep, voffA); G_STAGE(G_SB(1, 1), cB + hstepB + kstep, voffB);
        G_WAIT_V(6); G_BAR;
        for (;;) {
            const bool has_next = chain && (u + nblk < cfg.nbig);
            UnitD nxt = cur;
            if (has_next) nxt = unit_decode(P, cfg, gp, u + nblk);
            const char* nA = nxt.A; const char* nB = nxt.B;
            for (int t = 0; t < nt; t += 2) {
                const bool last = (t == nt - 2);
                const char* a1 = cA + (size_t)(t + 1) * kstep;
                const char* a2 = last ? nA : cA + (size_t)(t + 2) * kstep; const char* b2 = last ? nB : cB + (size_t)(t + 2) * kstep;
                const char* a3 = a2 + kstep; const char* b3 = b2 + kstep;
                G_LDB(B0, 0, 0); G_SCHED; G_LDA(At, 0, 0); G_STAGE(G_SA(1, 1), a1 + hstepA, voffA);
                G_WAIT_L(8); G_BAR; G_WAIT_L(0); G_MMA(0, 0, At, B0); G_BAR; G_SCHED;
                G_LDB(B1, 0, 1); G_STAGE(G_SB(0, 0), b2, voffB);
                G_BAR; G_WAIT_L(0); G_MMA(0, 1, At, B1); G_BAR;
                G_LDA(At, 0, 1); G_STAGE(G_SA(0, 0), a2, voffA);
                G_BAR; G_WAIT_L(0); G_MMA(1, 0, At, B0); G_BAR; G_SCHED;
                G_STAGE(G_SB(0, 1), b2 + hstepB, voffB);
                G_WAIT_V(6); G_BAR; G_MMA(1, 1, At, B1); G_BAR;
                G_LDB(B0, 1, 0); G_SCHED; G_LDA(At, 1, 0); G_STAGE(G_SA(0, 1), a2 + hstepA, voffA);
                G_WAIT_L(8); G_BAR; G_WAIT_L(0); G_MMA(0, 0, At, B0); G_BAR; G_SCHED;
                G_LDB(B1, 1, 1); G_STAGE(G_SB(1, 0), b3, voffB);
                G_BAR; G_WAIT_L(0); G_MMA(0, 1, At, B1); G_BAR;
                G_LDA(At, 1, 1); G_STAGE(G_SA(1, 0), a3, voffA);
                G_BAR; G_WAIT_L(0); G_MMA(1, 0, At, B0); G_BAR; G_SCHED;
                G_STAGE(G_SB(1, 1), b3 + hstepB, voffB);
                G_WAIT_V(6); G_BAR; G_MMA(1, 1, At, B1); G_BAR;
            }
            if (chain) {
                const int rbase = cur.row0 + wr * 64 + fr, cbase = cur.col0 + wc * 32 + fq * 4;
                switch (cur.ekind) {
                case E_PROJ: epi_loop<E_PROJ>(P, acc, rbase, cbase); break;
                case E_MEMKV: epi_loop<E_MEMKV>(P, acc, rbase, cbase); break;
                case E_POOL: epi_loop<E_POOL>(P, acc, rbase, cbase); break;
                case E_OUT: epi_loop<E_OUT>(P, acc, rbase, cbase); break;
                case E_Q: epi_loop<E_Q>(P, acc, rbase, cbase); break;
                case E_PV: epi_loop<E_PV>(P, acc, rbase, cbase); break;
                case E_MO: epi_loop<E_MO>(P, acc, rbase, cbase); break;
                case E_UP: epi_loop<E_UP>(P, acc, rbase, cbase); break;
                default: epi_loop<E_DOWN>(P, acc, rbase, cbase); break;
                }
            }
            if (!has_next) break;
#pragma unroll
            for (int a = 0; a < 2; ++a)
#pragma unroll
                for (int b = 0; b < 2; ++b)
#pragma unroll
                    for (int m = 0; m < 4; ++m)
#pragma unroll
                        for (int n = 0; n < 2; ++n) acc[a][b][m][n] = (f32x4){0.f, 0.f, 0.f, 0.f};
            cur = nxt; cA = nA; cB = nB; u += nblk;
        }
        G_WAIT_V(0);
        if (wr == 0) G_BAR;
        G_BAR;
        if (!chain) {
            float* redm = (float*)(shm_g + 131072);
            float* reds = (float*)(shm_g + 135168);
#pragma unroll
            for (int ai = 0; ai < 2; ++ai)
#pragma unroll
                for (int m = 0; m < 4; ++m) {
                    float t = -3.0e38f;
#pragma unroll
                    for (int bj = 0; bj < 2; ++bj)
#pragma unroll
                        for (int n = 0; n < 2; ++n)
#pragma unroll
                            for (int j = 0; j < 4; ++j) t = fmaxf(t, acc[ai][bj][m][n][j]);
                    t = fmaxf(t, __shfl_xor(t, 16)); t = fmaxf(t, __shfl_xor(t, 32));
                    if (fq == 0) redm[(ai * 128 + wr * 64 + m * 16 + fr) * 4 + wc] = t;
                }
            __syncthreads();
#pragma unroll
            for (int ai = 0; ai < 2; ++ai)
#pragma unroll
                for (int m = 0; m < 4; ++m) {
                    const f32x4 r = *(const f32x4*)(redm + (ai * 128 + wr * 64 + m * 16 + fr) * 4);
                    const float M = fmaxf(fmaxf(r[0], r[1]), fmaxf(r[2], r[3]));
                    float s = 0.f;
#pragma unroll
                    for (int bj = 0; bj < 2; ++bj)
#pragma unroll
                        for (int n = 0; n < 2; ++n)
#pragma unroll
                            for (int j = 0; j < 4; ++j) { const float e = __expf(acc[ai][bj][m][n][j] - M); acc[ai][bj][m][n][j] = e; s += e; }
                    s += __shfl_xor(s, 16); s += __shfl_xor(s, 32);
                    if (fq == 0) reds[(ai * 128 + wr * 64 + m * 16 + fr) * 4 + wc] = s;
                }
            __syncthreads();
#pragma unroll
            for (int ai = 0; ai < 2; ++ai)
#pragma unroll
                for (int m = 0; m < 4; ++m) {
                    const int rl = ai * 128 + wr * 64 + m * 16 + fr;
                    const f32x4 r = *(const f32x4*)(reds + rl * 4);
                    const float inv = 1.0f / ((r[0] + r[1]) + (r[2] + r[3]));
                    bf16_t* prow = (bf16_t*)(P->ws + W_P) + (size_t)(cur.row0 + rl) * 1024 + cur.col0;
#pragma unroll
                    for (int bj = 0; bj < 2; ++bj)
#pragma unroll
                        for (int n = 0; n < 2; ++n) {
                            const f32x4 v = acc[ai][bj][m][n];
                            u32x2 o; o.x = pk2(v[0] * inv, v[1] * inv); o.y = pk2(v[2] * inv, v[3] * inv);
                            *(u32x2*)(prow + bj * 128 + wc * 32 + n * 16 + fq * 4) = o;
                        }
                }
            __syncthreads();
        }
        u += nblk;
    }
#undef G_SA
#undef G_SB
#undef G_STAGE
#undef G_LDA
#undef G_LDB
#undef G_MMA
    const int rot = cfg.nbig % nblk;
    for (int s0 = (lb - rot + nblk) % nblk; s0 < cfg.nsmall; s0 += nblk) {
        const int pr = s0 / cfg.ncol64, pc = s0 % cfg.ncol64;
        const int row0 = TP + pr * 32, col0 = pc * 64;
        const bf16_t* Ab = (const bf16_t*)cfg.A + (size_t)row0 * cfg.lda;
        const bf16_t* Bb;
        if (gp == 3) { const int g = pc >> 2; Ab += g * 256; Bb = (const bf16_t*)cfg.B + (size_t)g * 65536 + (size_t)(col0 - g * 256) * 256; }
        else Bb = (const bf16_t*)cfg.B + (size_t)col0 * cfg.ldb;
        const int kw = K >> 3, nks = kw >> 5;
        f32x4 acc[2][4];
#pragma unroll
        for (int mi = 0; mi < 2; ++mi)
#pragma unroll
            for (int ni = 0; ni < 4; ++ni) acc[mi][ni] = (f32x4){0.f, 0.f, 0.f, 0.f};
        const bf16_t* ap = Ab + (size_t)fr * cfg.lda + wid * kw + fq * 8;
        const bf16_t* bp = Bb + (size_t)fr * cfg.ldb + wid * kw + fq * 8;
        for (int ks = 0; ks < nks; ++ks) {
            bf16x8 a[2], b[4];
#pragma unroll
            for (int mi = 0; mi < 2; ++mi) a[mi] = *(const bf16x8*)(ap + (size_t)mi * 16 * cfg.lda + ks * 32);
#pragma unroll
            for (int ni = 0; ni < 4; ++ni) b[ni] = *(const bf16x8*)(bp + (size_t)ni * 16 * cfg.ldb + ks * 32);
#pragma unroll
            for (int mi = 0; mi < 2; ++mi)
#pragma unroll
                for (int ni = 0; ni < 4; ++ni) acc[mi][ni] = __builtin_amdgcn_mfma_f32_16x16x32_bf16(b[ni], a[mi], acc[mi][ni], 0, 0, 0);
        }
        float* red = (float*)shm_g;
#pragma unroll
        for (int mi = 0; mi < 2; ++mi)
#pragma unroll
            for (int ni = 0; ni < 4; ++ni) *(f32x4*)(red + wid * 2048 + (mi * 16 + fr) * 64 + ni * 16 + fq * 4) = acc[mi][ni];
        __syncthreads();
        {
            const int r = tid >> 4, c = (tid & 15) * 4;
            f32x4 v = *(const f32x4*)(red + r * 64 + c);
#pragma unroll
            for (int w = 1; w < 8; ++w) v += *(const f32x4*)(red + w * 2048 + r * 64 + c);
            epi_apply_rt(P, cfg.ekind, row0 + r, col0 + c, v);
        }
        __syncthreads();
    }
}

__device__ __forceinline__ void tr_tile(const float* __restrict__ src, int ld_src, bf16_t* __restrict__ dst, int ld_dst, int k0, int n0s, int n0d, float* tile, const int tid) {
    { const int kr = tid >> 4, nc = (tid & 15) * 4;
#pragma unroll
      for (int i = 0; i < 2; ++i) { const int k = kr + i * 32; const f32x4 v = *(const f32x4*)(src + (size_t)(k0 + k) * ld_src + n0s + nc);
          tile[k * 65 + nc + 0] = v[0]; tile[k * 65 + nc + 1] = v[1]; tile[k * 65 + nc + 2] = v[2]; tile[k * 65 + nc + 3] = v[3]; } }
    __syncthreads();
    { const int n = tid >> 3, k8 = (tid & 7) * 8; float f[8];
#pragma unroll
      for (int e = 0; e < 8; ++e) f[e] = tile[(k8 + e) * 65 + n];
      *(u32x4*)(dst + (size_t)(n0d + n) * ld_dst + k0 + k8) = pack8(f); }
    __syncthreads();
}

__device__ __forceinline__ void phase_prep(PP P, char* shm, int blk, int nblk, const int tid) {
    const int wid = tid >> 6, lane = tid & 63;
    float* tile = (float*)shm;
    float* wdt = (float*)(shm + 32768);
    for (int i = tid; i < 1024 * 16; i += NTHR) { const int k = i >> 4, hd = i & 15; wdt[hd * 1024 + k] = P->w_in[(size_t)k * 3600 + 2560 + hd]; }
    __syncthreads();
    char* ws = P->ws;
    for (int it = blk; it < TT / 8 + 2048 / 8; it += nblk) {
        const bool ismem = it >= TT / 8;
        const int row = (ismem ? it - TT / 8 : it) * 8 + wid;
        const float* xr = ismem ? P->mem_prompt + (size_t)row * 1024 : (row < TP ? P->x_prompt + (size_t)row * 1024 : P->x_sample + (size_t)(row - TP) * 1024);
        const float* gg = ismem ? P->norm_memkv : P->norm_mix;
        bf16_t* orow = (bf16_t*)(ws + (ismem ? W_HM : W_H)) + (size_t)row * 1024;
        f32x4 xv[4]; float ss = 0.f;
#pragma unroll
        for (int j = 0; j < 4; ++j) { xv[j] = *(const f32x4*)(xr + j * 256 + lane * 4); ss += xv[j][0] * xv[j][0] + xv[j][1] * xv[j][1] + xv[j][2] * xv[j][2] + xv[j][3] * xv[j][3]; }
        ss = wave_sum(ss);
        const float rstd = rsqrtf(ss * (1.0f / 1024.0f) + EPS);
#pragma unroll
        for (int j = 0; j < 4; ++j) { const f32x4 g4 = *(const f32x4*)(gg + j * 256 + lane * 4); xv[j] = xv[j] * rstd * g4;
            u32x2 o; o.x = pk2(xv[j][0], xv[j][1]); o.y = pk2(xv[j][2], xv[j][3]); *(u32x2*)(orow + j * 256 + lane * 4) = o; }
        if (!ismem) {
            float mine = 0.f;
#pragma unroll
            for (int hd = 0; hd < 16; ++hd) {
                float acc = 0.f;
#pragma unroll
                for (int j = 0; j < 4; ++j) { const f32x4 w4 = *(const f32x4*)(wdt + hd * 1024 + j * 256 + lane * 4); acc += xv[j][0] * w4[0] + xv[j][1] * w4[1] + xv[j][2] * w4[2] + xv[j][3] * w4[3]; }
                acc = wave_sum(acc);
                if (lane == hd) mine = acc;
            }
            if (lane < 16) { const float x = mine + P->dt_bias[lane]; const float sp = x > 20.f ? x : log1pf(expf(x)); ((float*)(ws + W_DT))[(size_t)row * 16 + lane] = sp; }
        }
    }
    __syncthreads();
    for (int it = blk; it < 4608; it += nblk) {
        int i = it;
        if (i < 896) { const int kt = i / 56, ntl = i % 56; const int n0d = ntl * 64; const int n0s = n0d < 2560 ? n0d : n0d + 16; tr_tile(P->w_in, 3600, (bf16_t*)(ws + W_WIN), 1024, kt * 64, n0s, n0d, tile, tid); continue; }
        i -= 896;
        if (i < 64) { const int g = i >> 4, kt = (i >> 2) & 3, ntl = i & 3; tr_tile(P->w_pool + (size_t)g * 65536, 256, (bf16_t*)(ws + W_WPOOL) + (size_t)g * 65536, 256, kt * 64, ntl * 64, ntl * 64, tile, tid); continue; }
        i -= 64;
        if (i < 512) { const int kt = i >> 4, ntl = i & 15; tr_tile(P->w_out, 1024, (bf16_t*)(ws + W_WOUT), 2048, kt * 64, ntl * 64, ntl * 64, tile, tid); continue; }
        i -= 512;
        if (i < 1024) { const int wsel = i >> 8, r = i & 255, kt = r >> 4, ntl = r & 15;
            const float* src = wsel == 0 ? P->w_mq : wsel == 1 ? P->w_mk : wsel == 2 ? P->w_mv : P->w_mo;
            bf16_t* dst = (bf16_t*)(ws + (wsel == 0 ? W_WMQ : wsel == 1 ? W_WMK : wsel == 2 ? W_WMV : W_WMO));
            tr_tile(src, 1024, dst, 1024, kt * 64, ntl * 64, ntl * 64, tile, tid); continue; }
        i -= 1024;
        if (i < 1408) { const int kt = i / 88, ntl = i % 88; tr_tile(P->w_up, 5632, (bf16_t*)(ws + W_WUP), 1024, kt * 64, ntl * 64, ntl * 64, tile, tid); continue; }
        i -= 1408;
        { const int kt = i >> 4, ntl = i & 15; tr_tile(P->w_down, 1024, (bf16_t*)(ws + W_WDOWN), 2816, kt * 64, ntl * 64, ntl * 64, tile, tid); }
    }
}

__device__ __forceinline__ u32x4 ld8(const bf16_t* p) { return *(const u32x4*)p; }

__device__ __forceinline__ void phase_convpool(PP P, int gtid, int nthreads) {
    char* ws = P->ws;
    const bf16_t* proj2 = (const bf16_t*)(ws + W_PROJ2);
    bf16_t* xact = (bf16_t*)(ws + W_XACT);
    bf16_t* pooled = (bf16_t*)(ws + W_POOLED);
    for (int idx = gtid; idx < 1152 * 320; idx += nthreads) {
        const int run = idx / 320, cg = idx % 320;
        const bool samp = run >= 1024;
        int t0, len, bidx, tl0;
        if (!samp) { t0 = run * 16; len = 16; bidx = t0 >> 11; tl0 = t0 & 2047; } else { bidx = run - 1024; t0 = TP + bidx * 4; len = 4; tl0 = 0; }
        if (cg < 192) {
            const int c0 = cg * 8;
            float w0[8], w1[8], w2[8], w3[8], bs[8], h0[8], h1[8], h2[8];
#pragma unroll
            for (int e = 0; e < 8; ++e) { w0[e] = P->conv_w[c0 + e]; w1[e] = P->conv_w[1536 + c0 + e]; w2[e] = P->conv_w[3072 + c0 + e]; w3[e] = P->conv_w[4608 + c0 + e]; bs[e] = P->conv_b[c0 + e]; }
            if (samp) {
#pragma unroll
                for (int e = 0; e < 8; ++e) { h0[e] = P->state_conv[(size_t)(bidx * 3 + 0) * 1536 + c0 + e]; h1[e] = P->state_conv[(size_t)(bidx * 3 + 1) * 1536 + c0 + e]; h2[e] = P->state_conv[(size_t)(bidx * 3 + 2) * 1536 + c0 + e]; }
            } else if (tl0 > 0) {
                unpack8(ld8(proj2 + (size_t)(t0 - 3) * 2560 + c0), h0); unpack8(ld8(proj2 + (size_t)(t0 - 2) * 2560 + c0), h1); unpack8(ld8(proj2 + (size_t)(t0 - 1) * 2560 + c0), h2);
            } else {
#pragma unroll
                for (int e = 0; e < 8; ++e) { h0[e] = 0.f; h1[e] = 0.f; h2[e] = 0.f; }
            }
#pragma unroll 4
            for (int j = 0; j < len; ++j) {
                float x3[8], y[8]; unpack8(ld8(proj2 + (size_t)(t0 + j) * 2560 + c0), x3);
#pragma unroll
                for (int e = 0; e < 8; ++e) { const float v = bs[e] + w0[e] * h0[e] + w1[e] * h1[e] + w2[e] * h2[e] + w3[e] * x3[e]; y[e] = silu_f(v); }
                *(u32x4*)(xact + (size_t)(t0 + j) * 1536 + c0) = pack8(y);
                if (samp) { if (j >= 1) { float* o = P->out + O_CONVS + (size_t)(bidx * 3 + j - 1) * 1536 + c0;
#pragma unroll
                        for (int e = 0; e < 8; ++e) o[e] = x3[e]; } }
                else { const int tl = tl0 + j; if (tl >= 2045) { float* o = P->out + O_CONVP + (size_t)(bidx * 3 + tl - 2045) * 1536 + c0;
#pragma unroll
                        for (int e = 0; e < 8; ++e) o[e] = x3[e]; } }
#pragma unroll
                for (int e = 0; e < 8; ++e) { h0[e] = h1[e]; h1[e] = h2[e]; h2[e] = x3[e]; }
            }
        } else {
            const int c0 = (cg - 192) * 8; const int win = 2 << (c0 >> 8);
            const bf16_t* vp = proj2 + 1536 + c0;
            const float* prev = P->state_pool + (size_t)bidx * 15 * 1024 + c0;
            float sum[8];
#pragma unroll
            for (int e = 0; e < 8; ++e) sum[e] = 0.f;
            if (samp) {
                for (int jj = 1; jj < win; ++jj) {
#pragma unroll
                    for (int e = 0; e < 8; ++e) sum[e] += prev[(size_t)(15 - jj) * 1024 + e]; }
                float* o = P->out + O_POOLS + (size_t)bidx * 15 * 1024 + c0;
                for (int i = 0; i < 11; ++i) {
#pragma unroll
                    for (int e = 0; e < 8; ++e) o[(size_t)i * 1024 + e] = prev[(size_t)(i + 4) * 1024 + e]; }
            } else if (tl0 > 0) {
                for (int jj = 1; jj < win; ++jj) { float v[8]; unpack8(ld8(vp + (size_t)(t0 - jj) * 2560), v);
#pragma unroll
                    for (int e = 0; e < 8; ++e) sum[e] += v[e]; }
            }
            for (int j = 0; j < len; ++j) {
                float v[8], o8[8]; unpack8(ld8(vp + (size_t)(t0 + j) * 2560), v);
                const int tl = tl0 + j;
                const float inv = 1.0f / (float)(samp ? win : (tl + 1 < win ? tl + 1 : win));
#pragma unroll
                for (int e = 0; e < 8; ++e) { sum[e] += v[e]; o8[e] = sum[e] * inv - v[e]; }
                *(u32x4*)(pooled + (size_t)(t0 + j) * 1024 + c0) = pack8(o8);
                const int to = j - win + 1;
                if (samp) {
                    if (to >= 0) { float q[8]; unpack8(ld8(vp + (size_t)(t0 + to) * 2560), q);
#pragma unroll
                        for (int e = 0; e < 8; ++e) sum[e] -= q[e]; }
                    else {
#pragma unroll
                        for (int e = 0; e < 8; ++e) sum[e] -= prev[(size_t)(15 + to) * 1024 + e]; }
                    float* o = P->out + O_POOLS + (size_t)(bidx * 15 + 11 + j) * 1024 + c0;
#pragma unroll
                    for (int e = 0; e < 8; ++e) o[e] = v[e];
                } else {
                    if (tl0 + to >= 0) { float q[8]; unpack8(ld8(vp + (size_t)(t0 + to) * 2560), q);
#pragma unroll
                        for (int e = 0; e < 8; ++e) sum[e] -= q[e]; }
                    if (tl >= 2033) { float* o = P->out + O_POOLP + (size_t)(bidx * 15 + tl - 2033) * 1024 + c0;
#pragma unroll
                        for (int e = 0; e < 8; ++e) o[e] = v[e]; }
                }
            }
        }
    }
}

constexpr int CS_STR = 136;
constexpr int X_STR = 40;
__device__ __forceinline__ s16x4 tr_read(const bf16_t* p) { return __builtin_bit_cast(s16x4, __builtin_amdgcn_ds_read_tr16_b64_v4i16((LDSB s16x4*)p)); }

__device__ __forceinline__ void ssd_prompt(PP P, int item, char* shm, const int tid) {
    const int w = tid >> 6, lane = tid & 63, fr = lane & 15, fq = lane >> 4;
    const int b = item >> 5, hd = (item >> 1) & 15, ph = item & 1, g = hd >> 3;
    const float a = -expf(P->a_log[hd]);
    const float Dh = P->ssm_d[hd];
    char* ws = P->ws;
    const bf16_t* xact = (const bf16_t*)(ws + W_XACT);
    const float* dtb = (const float*)(ws + W_DT);
    bf16_t* ybuf = (bf16_t*)(ws + W_Y);
    bf16_t* Cs = (bf16_t*)(shm);
    bf16_t* Bs = (bf16_t*)(shm + 34816);
    bf16_t* Gs = (bf16_t*)(shm + 69632);
    bf16_t* Xd = (bf16_t*)(shm + 104448);
    bf16_t* X2 = (bf16_t*)(shm + 104448 + 10240);
    bf16_t* Hs = (bf16_t*)(shm + 124928);
    float* acs = (float*)(shm + 133632);
    float* dts = (float*)(shm + 134144);
    f32x4 Hacc[2];
    Hacc[0] = (f32x4){0.f, 0.f, 0.f, 0.f}; Hacc[1] = (f32x4){0.f, 0.f, 0.f, 0.f};
    const int q4 = fr >> 2, p4 = fr & 3;
    for (int c = 0; c < 16; ++c) {
        const int t0 = b * 2048 + c * 128;
        if (w == 0) {
            const float d0 = dtb[(size_t)(t0 + 2 * lane) * 16 + hd], d1 = dtb[(size_t)(t0 + 2 * lane + 1) * 16 + hd];
            const float s = (d0 + d1) * a; float v = s;
#pragma unroll
            for (int off = 1; off < 64; off <<= 1) { const float t = __shfl_up(v, off); if (lane >= off) v += t; }
            const float excl = v - s;
            acs[2 * lane] = excl + d0 * a; acs[2 * lane + 1] = v; dts[2 * lane] = d0; dts[2 * lane + 1] = d1;
        }
#pragma unroll
        for (int pt = 0; pt < 2; ++pt)
#pragma unroll
            for (int j = 0; j < 4; ++j) Hs[(pt * 16 + fq * 4 + j) * CS_STR + w * 16 + fr] = f2bf(Hacc[pt][j]);
#pragma unroll
        for (int i = 0; i < 4; ++i) {
            const int q = tid + i * 512, s = q >> 4, n8 = (q & 15) * 8;
            const bf16_t* src = xact + (size_t)(t0 + s) * 1536 + g * 128 + n8;
            *(u32x4*)(Cs + s * CS_STR + n8) = *(const u32x4*)(src + 1280);
            *(u32x4*)(Bs + s * CS_STR + n8) = *(const u32x4*)(src + 1024);
        }
        __syncthreads();
        {
            const int s = tid >> 2, p8 = (tid & 3) * 8;
            float x[8], xa[8], xb[8]; unpack8(ld8(xact + (size_t)(t0 + s) * 1536 + hd * 64 + ph * 32 + p8), x);
            const float dtv = dts[s], dec = __expf(acs[127] - acs[s]) * dtv;
#pragma unroll
            for (int e = 0; e < 8; ++e) { xa[e] = x[e] * dtv; xb[e] = x[e] * dec; }
            *(u32x4*)(Xd + s * X_STR + p8) = pack8(xa);
            *(u32x4*)(X2 + s * X_STR + p8) = pack8(xb);
        }
        bf16x8 Cf[4];
#pragma unroll
        for (int kk = 0; kk < 4; ++kk) Cf[kk] = *(const bf16x8*)(Cs + (w * 16 + fr) * CS_STR + kk * 32 + fq * 8);
        const int nst = (w | 1) + 1;
#pragma unroll
        for (int st = 0; st < 8; ++st) {
            if (st < nst) {
                f32x4 ga = (f32x4){0.f, 0.f, 0.f, 0.f};
#pragma unroll
                for (int kk = 0; kk < 4; ++kk) { const bf16x8 Bf = *(const bf16x8*)(Bs + (st * 16 + fr) * CS_STR + kk * 32 + fq * 8); ga = __builtin_amdgcn_mfma_f32_16x16x32_bf16(Cf[kk], Bf, ga, 0, 0, 0); }
                const int s = st * 16 + fr; const float as = acs[s];
#pragma unroll
                for (int j = 0; j < 4; ++j) { const int l = w * 16 + fq * 4 + j; const float val = (s <= l) ? ga[j] * __expf(acs[l] - as) : 0.f; Gs[l * CS_STR + s] = f2bf(val); }
            }
        }
        __syncthreads();
        {
            f32x4 Yd[2], Yo[2];
            Yd[0] = Yd[1] = Yo[0] = Yo[1] = (f32x4){0.f, 0.f, 0.f, 0.f};
            const int nkk = (w >> 1) + 1;
#pragma unroll
            for (int kk = 0; kk < 4; ++kk) {
                if (kk < nkk) {
                    const bf16x8 Gf = *(const bf16x8*)(Gs + (w * 16 + fr) * CS_STR + kk * 32 + fq * 8);
#pragma unroll
                    for (int pt = 0; pt < 2; ++pt) {
                        const bf16_t* base = Xd + (kk * 32 + fq * 8 + q4) * X_STR + pt * 16 + p4 * 4;
                        bf16x8 Xf; Xf.lo = tr_read(base); Xf.hi = tr_read(base + 4 * X_STR);
                        Yd[pt] = __builtin_amdgcn_mfma_f32_16x16x32_bf16(Gf, Xf, Yd[pt], 0, 0, 0);
                    }
                }
            }
#pragma unroll
            for (int kk = 0; kk < 4; ++kk)
#pragma unroll
                for (int pt = 0; pt < 2; ++pt) { const bf16x8 Hf = *(const bf16x8*)(Hs + (pt * 16 + fr) * CS_STR + kk * 32 + fq * 8); Yo[pt] = __builtin_amdgcn_mfma_f32_16x16x32_bf16(Cf[kk], Hf, Yo[pt], 0, 0, 0); }
#pragma unroll
            for (int j = 0; j < 4; ++j) {
                const int l = w * 16 + fq * 4 + j; const float el = __expf(acs[l]);
#pragma unroll
                for (int pt = 0; pt < 2; ++pt) {
                    const int pcol = hd * 64 + ph * 32 + pt * 16 + fr;
                    const float xr = bf2f(xact[(size_t)(t0 + l) * 1536 + pcol]);
                    ybuf[(size_t)(t0 + l) * 1024 + pcol] = f2bf(Yd[pt][j] + el * Yo[pt][j] + Dh * xr);
                }
            }
        }
        {
            const float dc = __expf(acs[127]);
            Hacc[0] *= dc; Hacc[1] *= dc;
#pragma unroll
            for (int kk = 0; kk < 4; ++kk) {
                const bf16_t* bb = Bs + (kk * 32 + fq * 8 + q4) * CS_STR + w * 16 + p4 * 4;
                bf16x8 Bf; Bf.lo = tr_read(bb); Bf.hi = tr_read(bb + 4 * CS_STR);
#pragma unroll
                for (int pt = 0; pt < 2; ++pt) {
                    const bf16_t* xb = X2 + (kk * 32 + fq * 8 + q4) * X_STR + pt * 16 + p4 * 4;
                    bf16x8 Xf; Xf.lo = tr_read(xb); Xf.hi = tr_read(xb + 4 * X_STR);
                    Hacc[pt] = __builtin_amdgcn_mfma_f32_16x16x32_bf16(Xf, Bf, Hacc[pt], 0, 0, 0);
                }
            }
        }
        __syncthreads();
    }
    float* so = P->out + O_SSMP + ((size_t)(b * 16 + hd) * 64 + ph * 32) * 128;
#pragma unroll
    for (int pt = 0; pt < 2; ++pt)
#pragma unroll
        for (int j = 0; j < 4; ++j) so[(size_t)(pt * 16 + fq * 4 + j) * 128 + w * 16 + fr] = Hacc[pt][j];
}

__device__ __forceinline__ void ssd_sample(PP P, int item, const int tid) {
    const int b = item >> 4, hd = item & 15, g = hd >> 3;
    const int p = tid >> 3, n0 = (tid & 7) * 16;
    const float a = -expf(P->a_log[hd]);
    const float Dh = P->ssm_d[hd];
    char* ws = P->ws;
    const bf16_t* xact = (const bf16_t*)(ws + W_XACT);
    const float* dtb = (const float*)(ws + W_DT);
    bf16_t* ybuf = (bf16_t*)(ws + W_Y);
    const size_t sidx = ((size_t)(b * 16 + hd) * 64 + p) * 128 + n0;
    float h[16];
#pragma unroll
    for (int i = 0; i < 4; ++i) { const f32x4 v = *(const f32x4*)(P->state_ssm + sidx + i * 4); h[i * 4] = v[0]; h[i * 4 + 1] = v[1]; h[i * 4 + 2] = v[2]; h[i * 4 + 3] = v[3]; }
#pragma unroll
    for (int i = 0; i < 4; ++i) {
        const int t = TP + b * 4 + i;
        const float xv = bf2f(xact[(size_t)t * 1536 + hd * 64 + p]);
        const float dtv = dtb[(size_t)t * 16 + hd];
        const float dA = __expf(dtv * a), dx = dtv * xv;
        float Bv[16], Cv[16];
        { float t8[8]; unpack8(ld8(xact + (size_t)t * 1536 + 1024 + g * 128 + n0), t8);
#pragma unroll
          for (int e = 0; e < 8; ++e) Bv[e] = t8[e];
          unpack8(ld8(xact + (size_t)t * 1536 + 1024 + g * 128 + n0 + 8), t8);
#pragma unroll
          for (int e = 0; e < 8; ++e) Bv[8 + e] = t8[e];
          unpack8(ld8(xact + (size_t)t * 1536 + 1280 + g * 128 + n0), t8);
#pragma unroll
          for (int e = 0; e < 8; ++e) Cv[e] = t8[e];
          unpack8(ld8(xact + (size_t)t * 1536 + 1280 + g * 128 + n0 + 8), t8);
#pragma unroll
          for (int e = 0; e < 8; ++e) Cv[8 + e] = t8[e]; }
        float part = 0.f;
#pragma unroll
        for (int e = 0; e < 16; ++e) { h[e] = h[e] * dA + dx * Bv[e]; part += h[e] * Cv[e]; }
        part += __shfl_xor(part, 1); part += __shfl_xor(part, 2); part += __shfl_xor(part, 4);
        if ((tid & 7) == 0) ybuf[(size_t)t * 1024 + hd * 64 + p] = f2bf(part + Dh * xv);
    }
    float* so = P->out + O_SSMS + sidx;
#pragma unroll
    for (int i = 0; i < 4; ++i) *(f32x4*)(so + i * 4) = (f32x4){h[i * 4], h[i * 4 + 1], h[i * 4 + 2], h[i * 4 + 3]};
}

__device__ __forceinline__ void phase_gatednorm(PP P, int gw, int nw, const int tid) {
    const int lane = tid & 63;
    char* ws = P->ws;
    const bf16_t* ybuf = (const bf16_t*)(ws + W_Y); const bf16_t* zbuf = (const bf16_t*)(ws + W_Z);
    bf16_t* mix = (bf16_t*)(ws + W_MIX);
    for (int row = gw; row < TT; row += nw) {
        float t[4][4]; float ss0 = 0.f, ss1 = 0.f;
#pragma unroll
        for (int j = 0; j < 4; ++j) {
            const u32x2 yv = *(const u32x2*)(ybuf + (size_t)row * 1024 + j * 256 + lane * 4);
            const u32x2 zv = *(const u32x2*)(zbuf + (size_t)row * 1024 + j * 256 + lane * 4);
            const float y0 = bflo(yv.x), y1 = bfhi(yv.x), y2 = bflo(yv.y), y3 = bfhi(yv.y);
            const float z0 = bflo(zv.x), z1 = bfhi(zv.x), z2 = bflo(zv.y), z3 = bfhi(zv.y);
            t[j][0] = y0 * silu_f(z0); t[j][1] = y1 * silu_f(z1); t[j][2] = y2 * silu_f(z2); t[j][3] = y3 * silu_f(z3);
            const float q = t[j][0] * t[j][0] + t[j][1] * t[j][1] + t[j][2] * t[j][2] + t[j][3] * t[j][3];
            if (j < 2) ss0 += q; else ss1 += q;
        }
        ss0 = wave_sum(ss0); ss1 = wave_sum(ss1);
        const float r0 = rsqrtf(ss0 * (1.0f / 512.0f) + EPS), r1 = rsqrtf(ss1 * (1.0f / 512.0f) + EPS);
#pragma unroll
        for (int j = 0; j < 4; ++j) {
            const float r = j < 2 ? r0 : r1;
            const f32x4 g4 = *(const f32x4*)(P->ssm_norm + j * 256 + lane * 4);
            u32x2 o; o.x = pk2(t[j][0] * r * g4[0], t[j][1] * r * g4[1]); o.y = pk2(t[j][2] * r * g4[2], t[j][3] * r * g4[3]);
            *(u32x2*)(mix + (size_t)row * 2048 + j * 256 + lane * 4) = o;
        }
    }
}

__device__ __forceinline__ void phase_norm(PP P, const float* gain, bool final_out, int gw, int nw, const int tid) {
    const int lane = tid & 63;
    char* ws = P->ws;
    const float* xres = (const float*)(ws + W_XRES);
    for (int row = gw; row < TT; row += nw) {
        f32x4 xv[4]; float ss = 0.f;
#pragma unroll
        for (int j = 0; j < 4; ++j) { xv[j] = *(const f32x4*)(xres + (size_t)row * 1024 + j * 256 + lane * 4); ss += xv[j][0] * xv[j][0] + xv[j][1] * xv[j][1] + xv[j][2] * xv[j][2] + xv[j][3] * xv[j][3]; }
        ss = wave_sum(ss);
        const float rstd = rsqrtf(ss * (1.0f / 1024.0f) + EPS);
#pragma unroll
        for (int j = 0; j < 4; ++j) {
            const f32x4 g4 = *(const f32x4*)(gain + j * 256 + lane * 4);
            const f32x4 y = xv[j] * rstd * g4;
            if (final_out) *(f32x4*)(P->out + O_YP + (size_t)row * 1024 + j * 256 + lane * 4) = y;
            else { u32x2 o; o.x = pk2(y[0], y[1]); o.y = pk2(y[2], y[3]); *(u32x2*)((bf16_t*)(ws + W_H) + (size_t)row * 1024 + j * 256 + lane * 4) = o; }
        }
    }
}

__device__ __forceinline__ void attn_sample(PP P, int item, char* shm, const int tid) {
    const int w = tid >> 6, lane = tid & 63, fr = lane & 15, fq = lane >> 4;
    const int b = item >> 2, hh = item & 3;
    char* ws = P->ws;
    const bf16_t* qb = (const bf16_t*)(ws + W_Q);
    float* sc = (float*)shm;
    float* part = (float*)(shm + 4096);
    bf16x8 qf[8];
#pragma unroll
    for (int kk = 0; kk < 8; ++kk) {
        bf16x8 z = {0, 0, 0, 0, 0, 0, 0, 0};
        if (fr < 4) z = *(const bf16x8*)(qb + (size_t)(TP + b * 4 + fr) * 1024 + hh * 256 + kk * 32 + fq * 8);
        qf[kk] = z;
    }
#pragma unroll
    for (int mt = 0; mt < 2; ++mt) {
        const int key = w * 32 + mt * 16 + fr;
        const float* kp = P->cache_k + ((size_t)(b * 256 + key) * 4 + hh) * 256 + fq * 8;
        f32x4 acc = (f32x4){0.f, 0.f, 0.f, 0.f};
#pragma unroll
        for (int kk = 0; kk < 8; ++kk) {
            const f32x4 k0 = *(const f32x4*)(kp + kk * 32), k1 = *(const f32x4*)(kp + kk * 32 + 4);
            u32x4 pk; pk.x = pk2(k0[0], k0[1]); pk.y = pk2(k0[2], k0[3]); pk.z = pk2(k1[0], k1[1]); pk.w = pk2(k1[2], k1[3]);
            acc = __builtin_amdgcn_mfma_f32_16x16x32_bf16(qf[kk], __builtin_bit_cast(bf16x8, pk), acc, 0, 0, 0);
        }
        if (fq == 0) {
#pragma unroll
            for (int j = 0; j < 4; ++j) sc[j * 256 + w * 32 + mt * 16 + fr] = acc[j];
        }
    }
    __syncthreads();
    if (w < 4) {
        f32x4 s = *(const f32x4*)(sc + w * 256 + lane * 4);
        float m = fmaxf(fmaxf(s[0], s[1]), fmaxf(s[2], s[3])); m = wave_max(m);
        s[0] = __expf(s[0] - m); s[1] = __expf(s[1] - m); s[2] = __expf(s[2] - m); s[3] = __expf(s[3] - m);
        float su = (s[0] + s[1]) + (s[2] + s[3]); su = wave_sum(su);
        const float inv = 1.0f / su;
        *(f32x4*)(sc + w * 256 + lane * 4) = s * inv;
    }
    __syncthreads();
    {
        f32x4 o[4];
#pragma unroll
        for (int i = 0; i < 4; ++i) o[i] = (f32x4){0.f, 0.f, 0.f, 0.f};
        const float* vp = P->cache_v + ((size_t)(b * 256 + w * 32) * 4 + hh) * 256 + lane * 4;
#pragma unroll 8
        for (int mm = 0; mm < 32; ++mm) {
            const f32x4 v = *(const f32x4*)(vp + (size_t)mm * 1024);
#pragma unroll
            for (int i = 0; i < 4; ++i) o[i] += sc[i * 256 + w * 32 + mm] * v;
        }
#pragma unroll
        for (int i = 0; i < 4; ++i) *(f32x4*)(part + (w * 4 + i) * 256 + lane * 4) = o[i];
    }
    __syncthreads();
    {
        const int i = tid >> 7, d2 = (tid & 127) * 2;
        float s0 = 0.f, s1 = 0.f;
#pragma unroll
        for (int ww = 0; ww < 8; ++ww) { s0 += part[(ww * 4 + i) * 256 + d2]; s1 += part[(ww * 4 + i) * 256 + d2 + 1]; }
        *(unsigned*)((bf16_t*)(ws + W_O) + (size_t)(TP + b * 4 + i) * 1024 + hh * 256 + d2) = pk2(s0, s1);
    }
    __syncthreads();
}

__device__ __forceinline__ void phase_ffnconv(PP P, int gtid, int nthreads) {
    char* ws = P->ws;
    const bf16_t* u = (const bf16_t*)(ws + W_U);
    bf16_t* act = (bf16_t*)(ws + W_ACT);
    for (int idx = gtid; idx < 1152 * 352; idx += nthreads) {
        const int run = idx / 352, cg = idx % 352;
        const bool samp = run >= 1024;
        int t0, len, bidx, tl0;
        if (!samp) { t0 = run * 16; len = 16; bidx = t0 >> 11; tl0 = t0 & 2047; } else { bidx = run - 1024; t0 = TP + bidx * 4; len = 4; tl0 = 0; }
        const int cgc = cg * 8, cvc = 2816 + cg * 8;
        float wg0[8], wg1[8], wg2[8], wv0[8], wv1[8], wv2[8], bg[8], bv[8], hg0[8], hg1[8], hv0[8], hv1[8];
#pragma unroll
        for (int e = 0; e < 8; ++e) {
            wg0[e] = P->ffn_w[cgc + e]; wg1[e] = P->ffn_w[5632 + cgc + e]; wg2[e] = P->ffn_w[11264 + cgc + e];
            wv0[e] = P->ffn_w[cvc + e]; wv1[e] = P->ffn_w[5632 + cvc + e]; wv2[e] = P->ffn_w[11264 + cvc + e];
            bg[e] = P->ffn_b[cgc + e]; bv[e] = P->ffn_b[cvc + e];
        }
        if (samp) {
#pragma unroll
            for (int e = 0; e < 8; ++e) {
                hg0[e] = P->state_ffn[(size_t)(bidx * 2 + 0) * 5632 + cgc + e]; hg1[e] = P->state_ffn[(size_t)(bidx * 2 + 1) * 5632 + cgc + e];
                hv0[e] = P->state_ffn[(size_t)(bidx * 2 + 0) * 5632 + cvc + e]; hv1[e] = P->state_ffn[(size_t)(bidx * 2 + 1) * 5632 + cvc + e];
            }
        } else if (tl0 > 0) {
            unpack8(ld8(u + (size_t)(t0 - 2) * 5632 + cgc), hg0); unpack8(ld8(u + (size_t)(t0 - 1) * 5632 + cgc), hg1);
            unpack8(ld8(u + (size_t)(t0 - 2) * 5632 + cvc), hv0); unpack8(ld8(u + (size_t)(t0 - 1) * 5632 + cvc), hv1);
        } else {
#pragma unroll
            for (int e = 0; e < 8; ++e) { hg0[e] = 0.f; hg1[e] = 0.f; hv0[e] = 0.f; hv1[e] = 0.f; }
        }
#pragma unroll 4
        for (int j = 0; j < len; ++j) {
            float ug[8], uv[8], o8[8];
            unpack8(ld8(u + (size_t)(t0 + j) * 5632 + cgc), ug); unpack8(ld8(u + (size_t)(t0 + j) * 5632 + cvc), uv);
#pragma unroll
            for (int e = 0; e < 8; ++e) {
                const float gc = bg[e] + wg0[e] * hg0[e] + wg1[e] * hg1[e] + wg2[e] * ug[e];
                const float vc = bv[e] + wv0[e] * hv0[e] + wv1[e] * hv1[e] + wv2[e] * uv[e];
                o8[e] = silu_f(gc) * vc;
            }
            *(u32x4*)(act + (size_t)(t0 + j) * 2816 + cgc) = pack8(o8);
            float* o = nullptr;
            if (samp) { if (j >= 2) o = P->out + O_FFNS + (size_t)(bidx * 2 + j - 2) * 5632; }
            else { const int tl = tl0 + j; if (tl >= 2046) o = P->out + O_FFNP + (size_t)(bidx * 2 + tl - 2046) * 5632; }
            if (o) {
#pragma unroll
                for (int e = 0; e < 8; ++e) { o[cgc + e] = ug[e]; o[cvc + e] = uv[e]; }
            }
#pragma unroll
            for (int e = 0; e < 8; ++e) { hg0[e] = hg1[e]; hg1[e] = ug[e]; hv0[e] = hv1[e]; hv1[e] = uv[e]; }
        }
    }
}

#define XB_TMO      128
#define XB_XCNT(j)  (256  + 64 * (j))
#define XB_XSUB(j)  (1280 + 64 * (j))
#define XB_XGEN(j)  (2304 + 64 * (j))
#define XB_TOP      3328
#define XB_TOPGEN   3392
#define XCD_BAR_WORDS 3456
#define XB_SPIN_CAP (1u << 18)
__device__ __forceinline__ unsigned xb_ld(unsigned* p)              { return __hip_atomic_load(p, __ATOMIC_RELAXED, __HIP_MEMORY_SCOPE_AGENT); }
__device__ __forceinline__ unsigned xb_add(unsigned* p, unsigned v) { return __hip_atomic_fetch_add(p, v, __ATOMIC_RELAXED, __HIP_MEMORY_SCOPE_AGENT); }
__device__ __forceinline__ unsigned xb_xcc_id() { return (unsigned)__builtin_amdgcn_s_getreg((3 << 11) | 20) & 0xFu; }
#define XB_SPIN(cond, bar) do { unsigned _sp = 0; while (cond) { __builtin_amdgcn_s_sleep(1); \
    if ((++_sp & 255u) == 0u) { if (xb_ld(&(bar)[XB_TMO])) break; if (_sp > XB_SPIN_CAP) { atomicAdd(&(bar)[XB_TMO], 1u); break; } } } } while (0)
__device__ __forceinline__ void xcd_barrier_complete(unsigned* bar, unsigned x, unsigned& nloc, unsigned& nx) {
    const unsigned G = gridDim.x;
    unsigned sum, cnt, mine, sp = 0u;
    for (;;) {
        sum = 0u; cnt = 0u; mine = 0u;
#pragma unroll
        for (unsigned j = 0; j < 16; ++j) { const unsigned c = xb_ld(&bar[XB_XCNT(j)]); sum += c; cnt += (c > 0u) ? 1u : 0u; mine = (j == x) ? c : mine; }
        if (sum == G) break;
        __builtin_amdgcn_s_sleep(1);
        if ((++sp & 255u) == 0u) { if (xb_ld(&bar[XB_TMO])) break; if (sp > XB_SPIN_CAP) { atomicAdd(&bar[XB_TMO], 1u); break; } }
    }
    nloc = mine > 0u ? mine : 1u; nx = cnt > 0u ? cnt : 1u;
}
__device__ __forceinline__ void xcd_barrier(unsigned* bar, volatile LDSB unsigned* st, const int tid) {
    asm volatile("s_waitcnt vmcnt(0)" ::: "memory");
    __syncthreads();
    if (tid == 0) {
        const unsigned x = xb_xcc_id();
        __builtin_amdgcn_s_waitcnt(0);
        unsigned nloc = st[0], nx = st[1];
        if (nloc == 0u) { xcd_barrier_complete(bar, x, nloc, nx); st[0] = nloc; st[1] = nx; }
        const unsigned old = xb_add(&bar[XB_XSUB(x)], 1u);
        const unsigned gen = old / nloc;
        if (old + 1u == (gen + 1u) * nloc) {
            __builtin_amdgcn_fence(__ATOMIC_RELEASE, "agent");
            asm volatile("s_waitcnt vmcnt(0)" ::: "memory");
            const unsigned og = xb_add(&bar[XB_TOP], 1u);
            const unsigned tg = og / nx;
            if (og + 1u == (tg + 1u) * nx) xb_add(&bar[XB_TOPGEN], 1u);
            else XB_SPIN(xb_ld(&bar[XB_TOPGEN]) == tg, bar);
            __builtin_amdgcn_fence(__ATOMIC_ACQUIRE, "agent");
            xb_add(&bar[XB_XGEN(x)], 1u);
            asm volatile("s_waitcnt vmcnt(0)" ::: "memory");
        } else {
            XB_SPIN(xb_ld(&bar[XB_XGEN(x)]) == gen, bar);
            __builtin_amdgcn_fence(__ATOMIC_ACQUIRE, "agent");
            asm volatile("s_waitcnt vmcnt(0)" ::: "memory");
        }
    }
    __syncthreads();
}

extern __shared__ __attribute__((aligned(16))) char smem[];

__global__ void __launch_bounds__(NTHR) hybrid_fwd(Params Pin) {
    cg::grid_group grid = cg::this_grid();
    char* shm = smem;
    const int nblk = gridDim.x;
    volatile LDSB unsigned* bst = (volatile LDSB unsigned*)(smem + 139264);
    if (threadIdx.x == 0) { bst[0] = 0u; bst[1] = 0u; (void)xb_add((unsigned*)(Pin.ws + W_BAR) + XB_XCNT(xb_xcc_id()), 1u); }
    __syncthreads();
    for (int ph = Pin.ph_lo; ph < Pin.ph_hi; ++ph) {
        const int reps = ((REPEAT_MASK >> ph) & 1) ? 2 : 1;
        for (int rep = 0; rep < reps; ++rep) {
        if (rep > 0) xcd_barrier((unsigned*)(Pin.ws + W_BAR), bst, threadIdx.x);
        int tid = threadIdx.x, blk = blockIdx.x;
        asm volatile("" : "+v"(tid));
        asm volatile("" : "+s"(blk));
        PP P = (PP)__builtin_amdgcn_kernarg_segment_ptr();
        asm volatile("" : "+s"(P));
        const int lb = (blk & 7) * (nblk >> 3) + (blk >> 3);
        const int gtid = blk * NTHR + tid, nthreads = nblk * NTHR;
        const int gw = blk * 8 + (tid >> 6), nw = nblk * 8;
        switch (ph) {
#if PHASE_MASK & 1
        case 0: phase_prep(P, shm, blk, nblk, tid); break;
#endif
#if PHASE_MASK & 4
        case 2: phase_convpool(P, gtid, nthreads); break;
#endif
#if PHASE_MASK & 8
        case 3:
            for (int it = blk; it < 256; it += nblk) ssd_prompt(P, it, shm, tid);
            for (int it = blk; it < 2048; it += nblk) ssd_sample(P, it, tid);
            break;
#endif
#if PHASE_MASK & 16
        case 4: phase_gatednorm(P, gw, nw, tid); break;
#endif
#if PHASE_MASK & 64
        case 6: phase_norm(P, P->norm_mem, false, gw, nw, tid); break;
        case 11: phase_norm(P, P->norm_ffn, false, gw, nw, tid); break;
        case 15: phase_norm(P, P->final_norm, true, gw, nw, tid); break;
#endif
#if PHASE_MASK & 8192
        case 13: phase_ffnconv(P, gtid, nthreads); break;
#endif
        default: break;
        }
#if PHASE_MASK & 2
        if (ph == 1 || ph == 3 || ph == 5 || ph == 7 || ph == 8 || ph == 9 || ph == 10 || ph == 12 || ph == 14) gemm_phase(P, ph, shm, lb, blk, nblk, tid);
#endif
#if PHASE_MASK & 256
        if (ph == 8) { for (int it = blk; it < 512; it += nblk) attn_sample(P, it, shm, tid); }
#endif
        }
        if (ph + 1 < Pin.ph_hi) { if (ph == 0) grid.sync(); else xcd_barrier((unsigned*)(Pin.ws + W_BAR), bst, threadIdx.x); }
        if (EXTRA_SYNCS && ph == 0) { for (int i = 0; i < EXTRA_SYNCS; ++i) xcd_barrier((unsigned*)(Pin.ws + W_BAR), bst, threadIdx.x); }
    }
}

extern "C" void kernel_launch(void* const* d_in, const int* in_sizes, int n_in, void* d_out, int out_size, void* d_ws, size_t ws_size, hipStream_t stream) {
    static int grid_blocks = 0;
    if (!grid_blocks) {
        int dev = 0, cus = 0, per_cu = 0;
        hipGetDevice(&dev);
        hipDeviceGetAttribute(&cus, hipDeviceAttributeMultiprocessorCount, dev);
        hipFuncSetAttribute((const void*)hybrid_fwd, hipFuncAttributeMaxDynamicSharedMemorySize, LDS_BYTES);
        hipOccupancyMaxActiveBlocksPerMultiprocessor(&per_cu, hybrid_fwd, NTHR, LDS_BYTES);
        if (per_cu < 1) per_cu = 1;
        grid_blocks = cus * 1;
        grid_blocks &= ~7;
        if (grid_blocks < 8) grid_blocks = 8;
    }
    Params p{};
    const float* const* in = (const float* const*)d_in;
    p.x_prompt = in[0]; p.x_sample = in[1]; p.mem_prompt = in[2]; p.state_ssm = in[3]; p.state_conv = in[4]; p.state_pool = in[5]; p.state_ffn = in[6];
    p.cache_k = in[7]; p.cache_v = in[8]; p.norm_mix = in[9]; p.w_in = in[10]; p.conv_w = in[11]; p.conv_b = in[12]; p.dt_bias = in[13]; p.a_log = in[14];
    p.ssm_d = in[15]; p.ssm_norm = in[16]; p.w_pool = in[17]; p.pool_scale = in[18]; p.w_out = in[19]; p.norm_mem = in[20]; p.norm_memkv = in[21];
    p.w_mq = in[22]; p.w_mk = in[23]; p.w_mv = in[24]; p.w_mo = in[25]; p.norm_ffn = in[26]; p.w_up = in[27]; p.ffn_w = in[28]; p.ffn_b = in[29];
    p.w_down = in[30]; p.final_norm = in[31];
    p.out = (float*)d_out; p.ws = (char*)d_ws; p.ph_lo = 0; p.ph_hi = 16;
    hipMemsetAsync((char*)d_ws + W_BAR, 0, 16384, stream);
    void* args[] = {&p};
    hipError_t e = hipLaunchCooperativeKernel((const void*)hybrid_fwd, dim3(grid_blocks), dim3(NTHR), args, LDS_BYTES, stream);
    if (e != hipSuccess) fprintf(stderr, "cooperative launch failed: %s (grid %d)\n", hipGetErrorString(e), grid_blocks);
}
```

```cpp
#include <hip/hip_runtime.h>
#include <hip/hip_cooperative_groups.h>
#include <cstdio>
namespace cg = cooperative_groups;

typedef unsigned short bf16_t;
typedef short bf16x8 __attribute__((ext_vector_type(8)));
typedef short s16x4 __attribute__((ext_vector_type(4)));
typedef float f32x4 __attribute__((ext_vector_type(4)));
typedef unsigned u32x4 __attribute__((ext_vector_type(4)));
typedef unsigned u32x2 __attribute__((ext_vector_type(2)));
#define LDSB __attribute__((address_space(3)))

constexpr int TP = 16384, TS = 512, TT = TP + TS;
constexpr int NTHR = 512;
constexpr int LDS_BYTES = 139264 + 256;
constexpr float EPS = 1e-6f;
#ifndef PHASE_MASK
#define PHASE_MASK 0xFFFF
#endif
#ifndef REPEAT_MASK
#define REPEAT_MASK 0
#endif
#ifndef PROBE3
#define PROBE3 0
#endif
#ifndef EXTRA_SYNCS
#define EXTRA_SYNCS 0
#endif

constexpr size_t O_YP = 0;
constexpr size_t O_YS = O_YP + (size_t)TP * 1024;
constexpr size_t O_SSMP = O_YS + (size_t)TS * 1024;
constexpr size_t O_SSMS = O_SSMP + (size_t)8 * 16 * 64 * 128;
constexpr size_t O_CONVP = O_SSMS + (size_t)128 * 16 * 64 * 128;
constexpr size_t O_CONVS = O_CONVP + (size_t)8 * 3 * 1536;
constexpr size_t O_POOLP = O_CONVS + (size_t)128 * 3 * 1536;
constexpr size_t O_POOLS = O_POOLP + (size_t)8 * 15 * 1024;
constexpr size_t O_FFNP = O_POOLS + (size_t)128 * 15 * 1024;
constexpr size_t O_FFNS = O_FFNP + (size_t)8 * 2 * 5632;
constexpr size_t O_MK = O_FFNS + (size_t)128 * 2 * 5632;
constexpr size_t O_MV = O_MK + (size_t)8 * 256 * 1024;

constexpr size_t W_WIN = 0;
constexpr size_t W_WPOOL = W_WIN + (size_t)3584 * 1024 * 2;
constexpr size_t W_WOUT = W_WPOOL + (size_t)4 * 256 * 256 * 2;
constexpr size_t W_WMQ = W_WOUT + (size_t)1024 * 2048 * 2;
constexpr size_t W_WMK = W_WMQ + (size_t)1024 * 1024 * 2;
constexpr size_t W_WMV = W_WMK + (size_t)1024 * 1024 * 2;
constexpr size_t W_WMO = W_WMV + (size_t)1024 * 1024 * 2;
constexpr size_t W_WUP = W_WMO + (size_t)1024 * 1024 * 2;
constexpr size_t W_WDOWN = W_WUP + (size_t)5632 * 1024 * 2;
constexpr size_t W_H = W_WDOWN + (size_t)1024 * 2816 * 2;
constexpr size_t W_HM = W_H + (size_t)TT * 1024 * 2;
constexpr size_t W_KB = W_HM + (size_t)2048 * 1024 * 2;
constexpr size_t W_VT = W_KB + (size_t)2048 * 1024 * 2;
constexpr size_t W_DT = W_VT + (size_t)2048 * 1024 * 2;
constexpr size_t W_XRES = W_DT + (size_t)TT * 16 * 4;
constexpr size_t W_ARENA = W_XRES + (size_t)TT * 1024 * 4;
constexpr size_t W_Z = W_ARENA;
constexpr size_t W_PROJ2 = W_Z + (size_t)TT * 1024 * 2;
constexpr size_t W_XACT = W_PROJ2 + (size_t)TT * 2560 * 2;
constexpr size_t W_POOLED = W_XACT + (size_t)TT * 1536 * 2;
constexpr size_t W_Y = W_POOLED + (size_t)TT * 1024 * 2;
constexpr size_t W_MIX = W_Y + (size_t)TT * 1024 * 2;
constexpr size_t W_END_A = W_MIX + (size_t)TT * 2048 * 2;
constexpr size_t W_Q = W_PROJ2;
constexpr size_t W_P = W_Q + (size_t)TT * 1024 * 2;
constexpr size_t W_O = W_P + (size_t)TP * 1024 * 2;
constexpr size_t W_U = W_ARENA;
constexpr size_t W_ACT = W_U + (size_t)TT * 5632 * 2;
constexpr size_t W_END_C = W_ACT + (size_t)TT * 2816 * 2;
constexpr size_t W_BAR = W_END_A;
constexpr size_t W_SS1 = W_BAR + 16384;
constexpr size_t W_SS2 = W_SS1 + (size_t)TT * 4;
constexpr size_t W_TOTAL = W_SS2 + (size_t)TT * 4;
static_assert(W_O + (size_t)TT * 1024 * 2 <= W_POOLED, "era B overflow");
static_assert(W_END_C <= W_END_A, "era C overflow");

struct Params {
    const float *x_prompt, *x_sample, *mem_prompt, *state_ssm, *state_conv, *state_pool, *state_ffn, *cache_k, *cache_v;
    const float *norm_mix, *w_in, *conv_w, *conv_b, *dt_bias, *a_log, *ssm_d, *ssm_norm, *w_pool, *pool_scale, *w_out;
    const float *norm_mem, *norm_memkv, *w_mq, *w_mk, *w_mv, *w_mo, *norm_ffn, *w_up, *ffn_w, *ffn_b, *w_down, *final_norm;
    float* out;
    char* ws;
    int ph_lo, ph_hi;
};

typedef const __attribute__((address_space(4))) Params* PP;

__device__ __forceinline__ unsigned pk2(float lo, float hi) { unsigned r; asm("v_cvt_pk_bf16_f32 %0, %1, %2" : "=v"(r) : "v"(lo), "v"(hi)); return r; }
__device__ __forceinline__ bf16_t f2bf(float f) { return (bf16_t)(pk2(f, 0.f) & 0xffffu); }
__device__ __forceinline__ float bf2f(bf16_t b) { return __uint_as_float(((unsigned)b) << 16); }
__device__ __forceinline__ float bflo(unsigned u) { return __uint_as_float(u << 16); }
__device__ __forceinline__ float bfhi(unsigned u) { return __uint_as_float(u & 0xffff0000u); }
__device__ __forceinline__ void unpack8(u32x4 v, float (&f)[8]) {
    f[0] = bflo(v.x); f[1] = bfhi(v.x); f[2] = bflo(v.y); f[3] = bfhi(v.y); f[4] = bflo(v.z); f[5] = bfhi(v.z); f[6] = bflo(v.w); f[7] = bfhi(v.w);
}
__device__ __forceinline__ u32x4 pack8(const float (&f)[8]) { u32x4 r; r.x = pk2(f[0], f[1]); r.y = pk2(f[2], f[3]); r.z = pk2(f[4], f[5]); r.w = pk2(f[6], f[7]); return r; }
__device__ __forceinline__ float wave_sum(float v) {
#pragma unroll
    for (int o = 1; o < 64; o <<= 1) v += __shfl_xor(v, o);
    return v;
}
__device__ __forceinline__ float wave_max(float v) {
#pragma unroll
    for (int o = 1; o < 64; o <<= 1) v = fmaxf(v, __shfl_xor(v, o));
    return v;
}
__device__ __forceinline__ float silu_f(float x) { return x / (1.0f + __expf(-x)); }

constexpr int HTB = 128 * 64 * 2;
__device__ __forceinline__ int lds_byte(int r, int c) { const int st = (r >> 4) * 2 + (c >> 5), rr = r & 15, cc = c & 31, ob = rr * 64 + cc * 2; return st * 1024 + (ob ^ (((ob >> 9) & 1) << 5)); }
__device__ __forceinline__ void stage_rc(int b, int& R, int& C) { const int st = b / 1024, sb = b % 1024, swz = sb ^ (((sb >> 9) & 1) << 5); R = (st >> 1) * 16 + swz / 64; C = (st & 1) * 32 + (swz % 64) / 2; }

enum { E_PROJ = 0, E_MEMKV, E_POOL, E_OUT, E_Q, E_QK, E_PV, E_MO, E_UP, E_DOWN };

template <int EK>
__device__ __forceinline__ float epi_apply(PP P, int row, int col, f32x4 v) {
    char* ws = P->ws;
    if constexpr (EK == E_PROJ) {
        u32x2 o; o.x = pk2(v[0], v[1]); o.y = pk2(v[2], v[3]);
        if (col < 1024) *(u32x2*)((bf16_t*)(ws + W_Z) + (size_t)row * 1024 + col) = o;
        else *(u32x2*)((bf16_t*)(ws + W_PROJ2) + (size_t)row * 2560 + (col - 1024)) = o;
    } else if constexpr (EK == E_MEMKV) {
        if (col < 1024) {
            *(f32x4*)(P->out + O_MK + (size_t)row * 1024 + col) = v;
            u32x2 o; o.x = pk2(v[0], v[1]); o.y = pk2(v[2], v[3]);
            *(u32x2*)((bf16_t*)(ws + W_KB) + (size_t)row * 1024 + col) = o;
        } else {
            const int c = col - 1024;
            *(f32x4*)(P->out + O_MV + (size_t)row * 1024 + c) = v;
            const int b = row >> 8, m = row & 255, hh = c >> 8, d = c & 255;
            bf16_t* vt = (bf16_t*)(ws + W_VT) + ((size_t)(b * 4 + hh) * 256 + d) * 256 + m;
#pragma unroll
            for (int j = 0; j < 4; ++j) vt[j * 256] = f2bf(v[j]);
        }
    } else if constexpr (EK == E_POOL) {
        const f32x4 sc = *(const f32x4*)(P->pool_scale + col);
        u32x2 o; o.x = pk2(v[0] * sc[0], v[1] * sc[1]); o.y = pk2(v[2] * sc[2], v[3] * sc[3]);
        *(u32x2*)((bf16_t*)(ws + W_MIX) + (size_t)row * 2048 + 1024 + col) = o;
    } else if constexpr (EK == E_OUT) {
        const float* xin = row < TP ? P->x_prompt + (size_t)row * 1024 : P->x_sample + (size_t)(row - TP) * 1024;
        const f32x4 x = *(const f32x4*)(xin + col) + v;
        *(f32x4*)((float*)(ws + W_XRES) + (size_t)row * 1024 + col) = x;
        u32x2 o; o.x = pk2(x[0], x[1]); o.y = pk2(x[2], x[3]);
        *(u32x2*)((bf16_t*)(ws + W_H) + (size_t)row * 1024 + col) = o;
        return (x[0] * x[0] + x[1] * x[1]) + (x[2] * x[2] + x[3] * x[3]);
    } else if constexpr (EK == E_Q) {
        u32x2 o; o.x = pk2(v[0], v[1]); o.y = pk2(v[2], v[3]);
        *(u32x2*)((bf16_t*)(ws + W_Q) + (size_t)row * 1024 + col) = o;
    } else if constexpr (EK == E_PV) {
        u32x2 o; o.x = pk2(v[0], v[1]); o.y = pk2(v[2], v[3]);
        *(u32x2*)((bf16_t*)(ws + W_O) + (size_t)row * 1024 + col) = o;
    } else if constexpr (EK == E_MO) {
        float* xr = (float*)(ws + W_XRES) + (size_t)row * 1024 + col;
        const f32x4 x = *(const f32x4*)xr + v;
        *(f32x4*)xr = x;
        u32x2 o; o.x = pk2(x[0], x[1]); o.y = pk2(x[2], x[3]);
        *(u32x2*)((bf16_t*)(ws + W_H) + (size_t)row * 1024 + col) = o;
        return (x[0] * x[0] + x[1] * x[1]) + (x[2] * x[2] + x[3] * x[3]);
    } else if constexpr (EK == E_DOWN) {
        float* xr = (float*)(ws + W_XRES) + (size_t)row * 1024 + col;
        *(f32x4*)xr = *(const f32x4*)xr + v;
    } else if constexpr (EK == E_UP) {
        u32x2 o; o.x = pk2(v[0], v[1]); o.y = pk2(v[2], v[3]);
        *(u32x2*)((bf16_t*)(ws + W_U) + (size_t)row * 5632 + col) = o;
    }
    return 0.f;
}
template <int EK>
__device__ __forceinline__ float epi_rowscale(PP P, int row) {
    if constexpr (EK == E_Q) return rsqrtf(((const float*)(P->ws + W_SS1))[row] * (1.0f / 1024.0f) + EPS) * 0.0625f;
    else if constexpr (EK == E_UP) return rsqrtf(((const float*)(P->ws + W_SS2))[row] * (1.0f / 1024.0f) + EPS);
    else return 1.0f;
}
__device__ __forceinline__ float epi_apply_rt(PP P, int ekind, int row, int col, f32x4 v) {
    switch (ekind) {
    case E_POOL: return epi_apply<E_POOL>(P, row, col, v);
    case E_OUT: return epi_apply<E_OUT>(P, row, col, v);
    case E_Q: return epi_apply<E_Q>(P, row, col, v * epi_rowscale<E_Q>(P, row));
    case E_MO: return epi_apply<E_MO>(P, row, col, v);
    default: return epi_apply<E_DOWN>(P, row, col, v);
    }
}
template <int EK>
__device__ __forceinline__ void epi_loop(PP P, const f32x4 (&acc)[2][2][4][2], int rbase, int cbase, int fq) {
#pragma unroll
    for (int ai = 0; ai < 2; ++ai)
#pragma unroll
        for (int m = 0; m < 4; ++m) {
            const int row = rbase + ai * 128 + m * 16;
            const float rs = epi_rowscale<EK>(P, row);
            float ss = 0.f;
#pragma unroll
            for (int bj = 0; bj < 2; ++bj)
#pragma unroll
                for (int n = 0; n < 2; ++n) {
                    if constexpr (EK == E_Q || EK == E_UP) ss += epi_apply<EK>(P, row, cbase + bj * 128 + n * 16, acc[ai][bj][m][n] * rs);
                    else ss += epi_apply<EK>(P, row, cbase + bj * 128 + n * 16, acc[ai][bj][m][n]);
                }
            if constexpr (EK == E_OUT || EK == E_MO) {
                ss += __shfl_xor(ss, 16); ss += __shfl_xor(ss, 32);
                if (fq == 0) unsafeAtomicAdd((float*)(P->ws + (EK == E_OUT ? W_SS1 : W_SS2)) + row, ss);
            }
        }
}

struct PhaseCfg { const char* A; const char* B; int lda, ldb, K, nbig, nsmall, ncol64, ekind; };
__device__ __forceinline__ PhaseCfg phase_cfg(PP P, int gp) {
    const char* ws = P->ws; PhaseCfg c;
    switch (gp) {
    case 1:  c.A = ws + W_H;      c.B = ws + W_WIN;   c.lda = 1024; c.ldb = 1024; c.K = 1024; c.nbig = 66 * 14 + 64; c.nsmall = 0; c.ncol64 = 56; c.ekind = E_PROJ; break;
    case 3:  c.A = ws + W_POOLED; c.B = ws + W_WPOOL; c.lda = 1024; c.ldb = 256;  c.K = 256;  c.nbig = 256; c.nsmall = 256; c.ncol64 = 16; c.ekind = E_POOL; break;
    case 5:  c.A = ws + W_MIX;    c.B = ws + W_WOUT;  c.lda = 2048; c.ldb = 2048; c.K = 2048; c.nbig = 256; c.nsmall = 256; c.ncol64 = 16; c.ekind = E_OUT; break;
    case 7:  c.A = ws + W_H;      c.B = ws + W_WMQ;   c.lda = 1024; c.ldb = 1024; c.K = 1024; c.nbig = 256; c.nsmall = 256; c.ncol64 = 16; c.ekind = E_Q; break;
    case 8:  c.A = ws + W_Q;      c.B = ws + W_KB;    c.lda = 1024; c.ldb = 1024; c.K = 256;  c.nbig = 256; c.nsmall = 0;   c.ncol64 = 16; c.ekind = E_QK; break;
    case 9:  c.A = ws + W_P;      c.B = ws + W_VT;    c.lda = 1024; c.ldb = 256;  c.K = 256;  c.nbig = 256; c.nsmall = 0;   c.ncol64 = 16; c.ekind = E_PV; break;
    case 10: c.A = ws + W_O;      c.B = ws + W_WMO;   c.lda = 1024; c.ldb = 1024; c.K = 1024; c.nbig = 256; c.nsmall = 256; c.ncol64 = 16; c.ekind = E_MO; break;
    case 12: c.A = ws + W_H;      c.B = ws + W_WUP;   c.lda = 1024; c.ldb = 1024; c.K = 1024; c.nbig = 66 * 22; c.nsmall = 0; c.ncol64 = 88; c.ekind = E_UP; break;
    default: c.A = ws + W_ACT;    c.B = ws + W_WDOWN; c.lda = 2816; c.ldb = 2816; c.K = 2816; c.nbig = 256; c.nsmall = 256; c.ncol64 = 16; c.ekind = E_DOWN; break;
    }
    return c;
}
struct UnitD { const char* A; const char* B; int row0, col0, ekind; };
__device__ __forceinline__ void map_unit(int L, int nM, int nN, int& pm, int& pn) {
    const int nwg = nM * nN, q = nwg >> 3, r = nwg & 7, xcd = L & 7, off = L >> 3;
    const int wgid = (xcd < r ? xcd * (q + 1) : r * (q + 1) + (xcd - r) * q) + off;
    const int nig = 8 * nN, gid = wgid / nig, fm = gid * 8, gsz = (nM - fm) < 8 ? (nM - fm) : 8;
    const int w = wgid - gid * nig;
    pm = fm + w % gsz; pn = w / gsz;
}
__device__ __forceinline__ UnitD unit_decode(PP P, const PhaseCfg& c, int gp, int L) {
    UnitD d; d.ekind = c.ekind;
    int pm, pn;
    switch (gp) {
    case 1:
        if (L < 924) { map_unit(L, 66, 14, pm, pn); d.A = c.A + (size_t)pm * 256 * 2048; d.B = c.B + (size_t)pn * 256 * 2048; }
        else { map_unit(L - 924, 8, 8, pm, pn); d.A = P->ws + W_HM + (size_t)pm * 256 * 2048; d.B = P->ws + W_WMK + (size_t)pn * 256 * 2048; d.ekind = E_MEMKV; }
        break;
    case 3: map_unit(L, 64, 4, pm, pn); d.A = c.A + (size_t)pm * 256 * 2048 + pn * 512; d.B = c.B + (size_t)pn * 131072; break;
    case 8: map_unit(L, 64, 4, pm, pn); d.A = c.A + (size_t)pm * 256 * 2048 + pn * 512; d.B = c.B + (size_t)(pm >> 3) * 256 * 2048 + pn * 512; break;
    case 9: map_unit(L, 64, 4, pm, pn); d.A = c.A + (size_t)pm * 256 * 2048 + pn * 512; d.B = c.B + (size_t)((pm >> 3) * 4 + pn) * 131072; break;
    case 12: map_unit(L, 66, 22, pm, pn); d.A = c.A + (size_t)pm * 256 * 2048; d.B = c.B + (size_t)pn * 256 * 2048; break;
    default: map_unit(L, 64, 4, pm, pn); d.A = c.A + (size_t)pm * 256 * c.lda * 2; d.B = c.B + (size_t)pn * 256 * c.ldb * 2; break;
    }
    d.row0 = pm * 256; d.col0 = pn * 256;
    return d;
}

__device__ __forceinline__ void gemm_phase(PP P, int gp, char* shm_g, int lb, int blk, int nblk, const int tid) {
    LDSB unsigned char* lds = (LDSB unsigned char*)shm_g;
    const int wid = __builtin_amdgcn_readfirstlane(tid >> 6), lane = tid & 63, wr = wid >> 2, wc = wid & 3, fr = lane & 15, fq = lane >> 4;
    const PhaseCfg cfg = phase_cfg(P, gp);
    const int K = cfg.K, nt = K / 64;
    unsigned voffA, voffB;
    { int R, C; stage_rc(tid * 16, R, C); voffA = (unsigned)(R * cfg.lda + C) * 2u; voffB = (unsigned)(R * cfg.ldb + C) * 2u; }
    const size_t qstepvoffA = (size_t)64 * cfg.lda * 2, qstepvoffB = (size_t)64 * cfg.ldb * 2;
    const size_t kstep = 128;
    const size_t hstepA = (size_t)128 * cfg.lda * 2, hstepB = (size_t)128 * cfg.ldb * 2;
    const unsigned ldsw = (unsigned)wid * 1024u;
    const int aoff = lds_byte(wr * 64 + fr, fq * 8), boff = lds_byte(wc * 32 + fr, fq * 8);
    const bool chain = (cfg.ekind != E_QK);
#define G_SA(b, h) (((b) * 2 + (h)) * HTB)
#define G_SB(b, h) ((4 + (b) * 2 + (h)) * HTB)
#define G_STAGE(bufoff, gbase, voff) do { \
        __builtin_amdgcn_global_load_lds((const unsigned*)((const char*)(gbase) + (voff)), (LDSB unsigned*)(lds + (bufoff) + ldsw), 16, 0, 0); \
        __builtin_amdgcn_global_load_lds((const unsigned*)((const char*)(gbase) + qstep##voff + (voff)), (LDSB unsigned*)(lds + (bufoff) + ldsw + 8192), 16, 0, 0); } while (0)
#define G_LDA(dst, b, h) do { _Pragma("unroll") for (int m = 0; m < 4; ++m) _Pragma("unroll") for (int k = 0; k < 2; ++k) dst[m][k] = *(const LDSB bf16x8*)(lds + G_SA(b, h) + aoff + m * 2048 + k * 1024); } while (0)
#define G_LDB(dst, b, h) do { _Pragma("unroll") for (int n = 0; n < 2; ++n) _Pragma("unroll") for (int k = 0; k < 2; ++k) dst[n][k] = *(const LDSB bf16x8*)(lds + G_SB(b, h) + boff + n * 2048 + k * 1024); } while (0)
#define G_MMA(ai, bj, Af, Bf) do { __builtin_amdgcn_s_setprio(1); _Pragma("unroll") for (int m = 0; m < 4; ++m) _Pragma("unroll") for (int n = 0; n < 2; ++n) _Pragma("unroll") for (int k = 0; k < 2; ++k) \
        acc[ai][bj][m][n] = __builtin_amdgcn_mfma_f32_16x16x32_bf16(Bf[n][k], Af[m][k], acc[ai][bj][m][n], 0, 0, 0); __builtin_amdgcn_s_setprio(0); } while (0)
#define G_WAIT_V(n) asm volatile("s_waitcnt vmcnt(" #n ")" ::: "memory")
#define G_WAIT_L(n) asm volatile("s_waitcnt lgkmcnt(" #n ")" ::: "memory")
#define G_BAR __builtin_amdgcn_s_barrier()
#define G_SCHED __builtin_amdgcn_sched_barrier(0)
    int u = blk;
    while (u < cfg.nbig) {
        UnitD cur = unit_decode(P, cfg, gp, u);
        f32x4 acc[2][2][4][2];
#pragma unroll
        for (int a = 0; a < 2; ++a)
#pragma unroll
            for (int b = 0; b < 2; ++b)
#pragma unroll
                for (int m = 0; m < 4; ++m)
#pragma unroll
                    for (int n = 0; n < 2; ++n) acc[a][b][m][n] = (f32x4){0.f, 0.f, 0.f, 0.f};
        bf16x8 At[4][2], B0[2][2], B1[2][2];
        const char* cA = cur.A; const char* cB = cur.B;
        G_STAGE(G_SB(0, 0), cB, voffB); G_STAGE(G_SA(0, 0), cA, voffA); G_STAGE(G_SB(0, 1), cB + hstepB, voffB); G_STAGE(G_SA(0, 1), cA + hstepA, voffA);
        if (wr == 1) G_BAR;
        G_WAIT_V(4); G_BAR;
        G_STAGE(G_SB(1, 0), cB + kstep, voffB); G_STAGE(G_SA(1, 0), cA + kstep, voffA); G_STAGE(G_SB(1, 1), cB + hstepB + kstep, voffB);
        G_WAIT_V(6); G_BAR;
        for (;;) {
            const bool has_next = chain && (u + nblk < cfg.nbig);
            UnitD nxt = cur;
            if (has_next) nxt = unit_decode(P, cfg, gp, u + nblk);
            const char* nA = nxt.A; const char* nB = nxt.B;
            for (int t = 0; t < nt; t += 2) {
                const bool last = (t == nt - 2);
                const char* a1 = cA + (size_t)(t + 1) * kstep;
                const char* a2 = last ? nA : cA + (size_t)(t + 2) * kstep; const char* b2 = last ? nB : cB + (size_t)(t + 2) * kstep;
                const char* a3 = a2 + kstep; const char* b3 = b2 + kstep;
                G_LDB(B0, 0, 0); G_SCHED; G_LDA(At, 0, 0); G_STAGE(G_SA(1, 1), a1 + hstepA, voffA);
                G_WAIT_L(8); G_BAR; G_WAIT_L(0); G_MMA(0, 0, At, B0); G_BAR; G_SCHED;
                G_LDB(B1, 0, 1); G_STAGE(G_SB(0, 0), b2, voffB);
                G_BAR; G_WAIT_L(0); G_MMA(0, 1, At, B1); G_BAR;
                G_LDA(At, 0, 1); G_STAGE(G_SA(0, 0), a2, voffA);
                G_BAR; G_WAIT_L(0); G_MMA(1, 0, At, B0); G_BAR; G_SCHED;
                G_STAGE(G_SB(0, 1), b2 + hstepB, voffB);
                G_WAIT_V(6); G_BAR; G_MMA(1, 1, At, B1); G_BAR;
                G_LDB(B0, 1, 0); G_SCHED; G_LDA(At, 1, 0); G_STAGE(G_SA(0, 1), a2 + hstepA, voffA);
                G_WAIT_L(8); G_BAR; G_WAIT_L(0); G_MMA(0, 0, At, B0); G_BAR; G_SCHED;
                G_LDB(B1, 1, 1); G_STAGE(G_SB(1, 0), b3, voffB);
                G_BAR; G_WAIT_L(0); G_MMA(0, 1, At, B1); G_BAR;
                G_LDA(At, 1, 1); G_STAGE(G_SA(1, 0), a3, voffA);
                G_BAR; G_WAIT_L(0); G_MMA(1, 0, At, B0); G_BAR; G_SCHED;
                G_STAGE(G_SB(1, 1), b3 + hstepB, voffB);
                G_WAIT_V(6); G_BAR; G_MMA(1, 1, At, B1); G_BAR;
            }
            if (chain) {
                const int rbase = cur.row0 + wr * 64 + fr, cbase = cur.col0 + wc * 32 + fq * 4;
                switch (cur.ekind) {
                case E_PROJ: epi_loop<E_PROJ>(P, acc, rbase, cbase, fq); break;
                case E_MEMKV: epi_loop<E_MEMKV>(P, acc, rbase, cbase, fq); break;
                case E_POOL: epi_loop<E_POOL>(P, acc, rbase, cbase, fq); break;
                case E_OUT: epi_loop<E_OUT>(P, acc, rbase, cbase, fq); break;
                case E_Q: epi_loop<E_Q>(P, acc, rbase, cbase, fq); break;
                case E_PV: epi_loop<E_PV>(P, acc, rbase, cbase, fq); break;
                case E_MO: epi_loop<E_MO>(P, acc, rbase, cbase, fq); break;
                case E_UP: epi_loop<E_UP>(P, acc, rbase, cbase, fq); break;
                default: epi_loop<E_DOWN>(P, acc, rbase, cbase, fq); break;
                }
            }
            if (!has_next) break;
#pragma unroll
            for (int a = 0; a < 2; ++a)
#pragma unroll
                for (int b = 0; b < 2; ++b)
#pragma unroll
                    for (int m = 0; m < 4; ++m)
#pragma unroll
                        for (int n = 0; n < 2; ++n) acc[a][b][m][n] = (f32x4){0.f, 0.f, 0.f, 0.f};
            cur = nxt; cA = nA; cB = nB; u += nblk;
        }
        G_WAIT_V(0);
        if (wr == 0) G_BAR;
        G_BAR;
        if (!chain) {
            float* redm = (float*)(shm_g + 131072);
            float* reds = (float*)(shm_g + 135168);
#pragma unroll
            for (int ai = 0; ai < 2; ++ai)
#pragma unroll
                for (int m = 0; m < 4; ++m) {
                    float t = -3.0e38f;
#pragma unroll
                    for (int bj = 0; bj < 2; ++bj)
#pragma unroll
                        for (int n = 0; n < 2; ++n)
#pragma unroll
                            for (int j = 0; j < 4; ++j) t = fmaxf(t, acc[ai][bj][m][n][j]);
                    t = fmaxf(t, __shfl_xor(t, 16)); t = fmaxf(t, __shfl_xor(t, 32));
                    if (fq == 0) redm[(ai * 128 + wr * 64 + m * 16 + fr) * 4 + wc] = t;
                }
            __syncthreads();
#pragma unroll
            for (int ai = 0; ai < 2; ++ai)
#pragma unroll
                for (int m = 0; m < 4; ++m) {
                    const f32x4 r = *(const f32x4*)(redm + (ai * 128 + wr * 64 + m * 16 + fr) * 4);
                    const float M = fmaxf(fmaxf(r[0], r[1]), fmaxf(r[2], r[3]));
                    float s = 0.f;
#pragma unroll
                    for (int bj = 0; bj < 2; ++bj)
#pragma unroll
                        for (int n = 0; n < 2; ++n)
#pragma unroll
                            for (int j = 0; j < 4; ++j) { const float e = __expf(acc[ai][bj][m][n][j] - M); acc[ai][bj][m][n][j] = e; s += e; }
                    s += __shfl_xor(s, 16); s += __shfl_xor(s, 32);
                    if (fq == 0) reds[(ai * 128 + wr * 64 + m * 16 + fr) * 4 + wc] = s;
                }
            __syncthreads();
#pragma unroll
            for (int ai = 0; ai < 2; ++ai)
#pragma unroll
                for (int m = 0; m < 4; ++m) {
                    const int rl = ai * 128 + wr * 64 + m * 16 + fr;
                    const f32x4 r = *(const f32x4*)(reds + rl * 4);
                    const float inv = 1.0f / ((r[0] + r[1]) + (r[2] + r[3]));
                    bf16_t* prow = (bf16_t*)(P->ws + W_P) + (size_t)(cur.row0 + rl) * 1024 + cur.col0;
#pragma unroll
                    for (int bj = 0; bj < 2; ++bj)
#pragma unroll
                        for (int n = 0; n < 2; ++n) {
                            const f32x4 v = acc[ai][bj][m][n];
                            u32x2 o; o.x = pk2(v[0] * inv, v[1] * inv); o.y = pk2(v[2] * inv, v[3] * inv);
                            *(u32x2*)(prow + bj * 128 + wc * 32 + n * 16 + fq * 4) = o;
                        }
                }
            __syncthreads();
        }
        u += nblk;
    }
#undef G_SA
#undef G_SB
#undef G_STAGE
#undef G_LDA
#undef G_LDB
#undef G_MMA
    const int rot = cfg.nbig % nblk;
    for (int s0 = (lb - rot + nblk) % nblk; s0 < cfg.nsmall; s0 += nblk) {
        const int pr = s0 / cfg.ncol64, pc = s0 % cfg.ncol64;
        const int row0 = TP + pr * 32, col0 = pc * 64;
        const bf16_t* Ab = (const bf16_t*)cfg.A + (size_t)row0 * cfg.lda;
        const bf16_t* Bb;
        if (gp == 3) { const int g = pc >> 2; Ab += g * 256; Bb = (const bf16_t*)cfg.B + (size_t)g * 65536 + (size_t)(col0 - g * 256) * 256; }
        else Bb = (const bf16_t*)cfg.B + (size_t)col0 * cfg.ldb;
        const int kw = K >> 3, nks = kw >> 5;
        f32x4 acc[2][4];
#pragma unroll
        for (int mi = 0; mi < 2; ++mi)
#pragma unroll
            for (int ni = 0; ni < 4; ++ni) acc[mi][ni] = (f32x4){0.f, 0.f, 0.f, 0.f};
        const bf16_t* ap = Ab + (size_t)fr * cfg.lda + wid * kw + fq * 8;
        const bf16_t* bp = Bb + (size_t)fr * cfg.ldb + wid * kw + fq * 8;
        for (int ks = 0; ks < nks; ++ks) {
            bf16x8 a[2], b[4];
#pragma unroll
            for (int mi = 0; mi < 2; ++mi) a[mi] = *(const bf16x8*)(ap + (size_t)mi * 16 * cfg.lda + ks * 32);
#pragma unroll
            for (int ni = 0; ni < 4; ++ni) b[ni] = *(const bf16x8*)(bp + (size_t)ni * 16 * cfg.ldb + ks * 32);
#pragma unroll
            for (int mi = 0; mi < 2; ++mi)
#pragma unroll
                for (int ni = 0; ni < 4; ++ni) acc[mi][ni] = __builtin_amdgcn_mfma_f32_16x16x32_bf16(b[ni], a[mi], acc[mi][ni], 0, 0, 0);
        }
        float* red = (float*)shm_g;
#pragma unroll
        for (int mi = 0; mi < 2; ++mi)
#pragma unroll
            for (int ni = 0; ni < 4; ++ni) *(f32x4*)(red + wid * 2048 + (mi * 16 + fr) * 64 + ni * 16 + fq * 4) = acc[mi][ni];
        __syncthreads();
        {
            const int r = tid >> 4, c = (tid & 15) * 4;
            f32x4 v = *(const f32x4*)(red + r * 64 + c);
#pragma unroll
            for (int w = 1; w < 8; ++w) v += *(const f32x4*)(red + w * 2048 + r * 64 + c);
            float ss = epi_apply_rt(P, cfg.ekind, row0 + r, col0 + c, v);
            if (cfg.ekind == E_OUT || cfg.ekind == E_MO) {
                ss += __shfl_xor(ss, 1); ss += __shfl_xor(ss, 2); ss += __shfl_xor(ss, 4); ss += __shfl_xor(ss, 8);
                if ((tid & 15) == 0) unsafeAtomicAdd((float*)(P->ws + (cfg.ekind == E_OUT ? W_SS1 : W_SS2)) + row0 + r, ss);
            }
        }
        __syncthreads();
    }
}

__device__ __forceinline__ void tr_tile(const float* __restrict__ src, int ld_src, bf16_t* __restrict__ dst, int ld_dst, int k0, int n0s, int n0d, float* tile, const int tid, const float* __restrict__ gain = nullptr) {
    { const int kr = tid >> 4, nc = (tid & 15) * 4;
#pragma unroll
      for (int i = 0; i < 2; ++i) { const int k = kr + i * 32; f32x4 v = *(const f32x4*)(src + (size_t)(k0 + k) * ld_src + n0s + nc); if (gain) v *= gain[k0 + k];
          tile[k * 65 + nc + 0] = v[0]; tile[k * 65 + nc + 1] = v[1]; tile[k * 65 + nc + 2] = v[2]; tile[k * 65 + nc + 3] = v[3]; } }
    __syncthreads();
    { const int n = tid >> 3, k8 = (tid & 7) * 8; float f[8];
#pragma unroll
      for (int e = 0; e < 8; ++e) f[e] = tile[(k8 + e) * 65 + n];
      *(u32x4*)(dst + (size_t)(n0d + n) * ld_dst + k0 + k8) = pack8(f); }
    __syncthreads();
}

__device__ __forceinline__ void phase_prep(PP P, char* shm, int blk, int nblk, const int tid) {
    const int wid = tid >> 6, lane = tid & 63;
    float* tile = (float*)shm;
    float* wdt = (float*)(shm + 32768);
    for (int i = blk * NTHR + tid; i < 2 * TT; i += nblk * NTHR) ((float*)(P->ws + W_SS1))[i] = 0.f;
    for (int i = tid; i < 1024 * 16; i += NTHR) { const int k = i >> 4, hd = i & 15; wdt[hd * 1024 + k] = P->w_in[(size_t)k * 3600 + 2560 + hd]; }
    __syncthreads();
    char* ws = P->ws;
    for (int it = blk; it < TT / 8 + 2048 / 8; it += nblk) {
        const bool ismem = it >= TT / 8;
        const int row = (ismem ? it - TT / 8 : it) * 8 + wid;
        const float* xr = ismem ? P->mem_prompt + (size_t)row * 1024 : (row < TP ? P->x_prompt + (size_t)row * 1024 : P->x_sample + (size_t)(row - TP) * 1024);
        const float* gg = ismem ? P->norm_memkv : P->norm_mix;
        bf16_t* orow = (bf16_t*)(ws + (ismem ? W_HM : W_H)) + (size_t)row * 1024;
        f32x4 xv[4]; float ss = 0.f;
#pragma unroll
        for (int j = 0; j < 4; ++j) { xv[j] = *(const f32x4*)(xr + j * 256 + lane * 4); ss += xv[j][0] * xv[j][0] + xv[j][1] * xv[j][1] + xv[j][2] * xv[j][2] + xv[j][3] * xv[j][3]; }
        ss = wave_sum(ss);
        const float rstd = rsqrtf(ss * (1.0f / 1024.0f) + EPS);
#pragma unroll
        for (int j = 0; j < 4; ++j) { const f32x4 g4 = *(const f32x4*)(gg + j * 256 + lane * 4); xv[j] = xv[j] * rstd * g4;
            u32x2 o; o.x = pk2(xv[j][0], xv[j][1]); o.y = pk2(xv[j][2], xv[j][3]); *(u32x2*)(orow + j * 256 + lane * 4) = o; }
        if (!ismem) {
            float mine = 0.f;
#pragma unroll
            for (int hd = 0; hd < 16; ++hd) {
                float acc = 0.f;
#pragma unroll
                for (int j = 0; j < 4; ++j) { const f32x4 w4 = *(const f32x4*)(wdt + hd * 1024 + j * 256 + lane * 4); acc += xv[j][0] * w4[0] + xv[j][1] * w4[1] + xv[j][2] * w4[2] + xv[j][3] * w4[3]; }
                acc = wave_sum(acc);
                if (lane == hd) mine = acc;
            }
            if (lane < 16) { const float x = mine + P->dt_bias[lane]; const float ey = __expf(-fabsf(x)); const float l1p = ey < 0.03f ? ey * (1.0f - ey * (0.5f - ey * (0.33333333f - 0.25f * ey))) : __logf(1.0f + ey); const float sp = fmaxf(x, 0.f) + l1p; ((float*)(ws + W_DT))[(size_t)row * 16 + lane] = sp; }
        }
    }
    __syncthreads();
    for (int it = blk; it < 4608; it += nblk) {
        int i = it;
        if (i < 896) { const int kt = i / 56, ntl = i % 56; const int n0d = ntl * 64; const int n0s = n0d < 2560 ? n0d : n0d + 16; tr_tile(P->w_in, 3600, (bf16_t*)(ws + W_WIN), 1024, kt * 64, n0s, n0d, tile, tid); continue; }
        i -= 896;
        if (i < 64) { const int g = i >> 4, kt = (i >> 2) & 3, ntl = i & 3; tr_tile(P->w_pool + (size_t)g * 65536, 256, (bf16_t*)(ws + W_WPOOL) + (size_t)g * 65536, 256, kt * 64, ntl * 64, ntl * 64, tile, tid); continue; }
        i -= 64;
        if (i < 512) { const int kt = i >> 4, ntl = i & 15; tr_tile(P->w_out, 1024, (bf16_t*)(ws + W_WOUT), 2048, kt * 64, ntl * 64, ntl * 64, tile, tid); continue; }
        i -= 512;
        if (i < 1024) { const int wsel = i >> 8, r = i & 255, kt = r >> 4, ntl = r & 15;
            const float* src = wsel == 0 ? P->w_mq : wsel == 1 ? P->w_mk : wsel == 2 ? P->w_mv : P->w_mo;
            bf16_t* dst = (bf16_t*)(ws + (wsel == 0 ? W_WMQ : wsel == 1 ? W_WMK : wsel == 2 ? W_WMV : W_WMO));
            tr_tile(src, 1024, dst, 1024, kt * 64, ntl * 64, ntl * 64, tile, tid, wsel == 0 ? P->norm_mem : nullptr); continue; }
        i -= 1024;
        if (i < 1408) { const int kt = i / 88, ntl = i % 88; tr_tile(P->w_up, 5632, (bf16_t*)(ws + W_WUP), 1024, kt * 64, ntl * 64, ntl * 64, tile, tid, P->norm_ffn); continue; }
        i -= 1408;
        { const int kt = i >> 4, ntl = i & 15; tr_tile(P->w_down, 1024, (bf16_t*)(ws + W_WDOWN), 2816, kt * 64, ntl * 64, ntl * 64, tile, tid); }
    }
}

__device__ __forceinline__ u32x4 ld8(const bf16_t* p) { return *(const u32x4*)p; }

__device__ __forceinline__ void phase_convpool(PP P, int gtid, int nthreads) {
    char* ws = P->ws;
    const bf16_t* proj2 = (const bf16_t*)(ws + W_PROJ2);
    bf16_t* xact = (bf16_t*)(ws + W_XACT);
    bf16_t* pooled = (bf16_t*)(ws + W_POOLED);
    for (int idx = gtid; idx < 1152 * 320; idx += nthreads) {
        const int run = idx / 320, cg = idx % 320;
        const bool samp = run >= 1024;
        int t0, len, bidx, tl0;
        if (!samp) { t0 = run * 16; len = 16; bidx = t0 >> 11; tl0 = t0 & 2047; } else { bidx = run - 1024; t0 = TP + bidx * 4; len = 4; tl0 = 0; }
        if (cg < 192) {
            const int c0 = cg * 8;
            float w0[8], w1[8], w2[8], w3[8], bs[8], h0[8], h1[8], h2[8];
#pragma unroll
            for (int e = 0; e < 8; ++e) { w0[e] = P->conv_w[c0 + e]; w1[e] = P->conv_w[1536 + c0 + e]; w2[e] = P->conv_w[3072 + c0 + e]; w3[e] = P->conv_w[4608 + c0 + e]; bs[e] = P->conv_b[c0 + e]; }
            if (samp) {
#pragma unroll
                for (int e = 0; e < 8; ++e) { h0[e] = P->state_conv[(size_t)(bidx * 3 + 0) * 1536 + c0 + e]; h1[e] = P->state_conv[(size_t)(bidx * 3 + 1) * 1536 + c0 + e]; h2[e] = P->state_conv[(size_t)(bidx * 3 + 2) * 1536 + c0 + e]; }
            } else if (tl0 > 0) {
                unpack8(ld8(proj2 + (size_t)(t0 - 3) * 2560 + c0), h0); unpack8(ld8(proj2 + (size_t)(t0 - 2) * 2560 + c0), h1); unpack8(ld8(proj2 + (size_t)(t0 - 1) * 2560 + c0), h2);
            } else {
#pragma unroll
                for (int e = 0; e < 8; ++e) { h0[e] = 0.f; h1[e] = 0.f; h2[e] = 0.f; }
            }
#pragma unroll 4
            for (int j = 0; j < len; ++j) {
                float x3[8], y[8]; unpack8(ld8(proj2 + (size_t)(t0 + j) * 2560 + c0), x3);
#pragma unroll
                for (int e = 0; e < 8; ++e) { const float v = bs[e] + w0[e] * h0[e] + w1[e] * h1[e] + w2[e] * h2[e] + w3[e] * x3[e]; y[e] = silu_f(v); }
                *(u32x4*)(xact + (size_t)(t0 + j) * 1536 + c0) = pack8(y);
                if (samp) { if (j >= 1) { float* o = P->out + O_CONVS + (size_t)(bidx * 3 + j - 1) * 1536 + c0;
#pragma unroll
                        for (int e = 0; e < 8; ++e) o[e] = x3[e]; } }
                else { const int tl = tl0 + j; if (tl >= 2045) { float* o = P->out + O_CONVP + (size_t)(bidx * 3 + tl - 2045) * 1536 + c0;
#pragma unroll
                        for (int e = 0; e < 8; ++e) o[e] = x3[e]; } }
#pragma unroll
                for (int e = 0; e < 8; ++e) { h0[e] = h1[e]; h1[e] = h2[e]; h2[e] = x3[e]; }
            }
        } else {
            const int c0 = (cg - 192) * 8; const int win = 2 << (c0 >> 8);
            const bf16_t* vp = proj2 + 1536 + c0;
            const float* prev = P->state_pool + (size_t)bidx * 15 * 1024 + c0;
            float sum[8];
#pragma unroll
            for (int e = 0; e < 8; ++e) sum[e] = 0.f;
            if (samp) {
                for (int jj = 1; jj < win; ++jj) {
#pragma unroll
                    for (int e = 0; e < 8; ++e) sum[e] += prev[(size_t)(15 - jj) * 1024 + e]; }
                float* o = P->out + O_POOLS + (size_t)bidx * 15 * 1024 + c0;
                for (int i = 0; i < 11; ++i) {
#pragma unroll
                    for (int e = 0; e < 8; ++e) o[(size_t)i * 1024 + e] = prev[(size_t)(i + 4) * 1024 + e]; }
            } else if (tl0 > 0) {
                for (int jj = 1; jj < win; ++jj) { float v[8]; unpack8(ld8(vp + (size_t)(t0 - jj) * 2560), v);
#pragma unroll
                    for (int e = 0; e < 8; ++e) sum[e] += v[e]; }
            }
            for (int j = 0; j < len; ++j) {
                float v[8], o8[8]; unpack8(ld8(vp + (size_t)(t0 + j) * 2560), v);
                const int tl = tl0 + j;
                const float inv = 1.0f / (float)(samp ? win : (tl + 1 < win ? tl + 1 : win));
#pragma unroll
                for (int e = 0; e < 8; ++e) { sum[e] += v[e]; o8[e] = sum[e] * inv - v[e]; }
                *(u32x4*)(pooled + (size_t)(t0 + j) * 1024 + c0) = pack8(o8);
                const int to = j - win + 1;
                if (samp) {
                    if (to >= 0) { float q[8]; unpack8(ld8(vp + (size_t)(t0 + to) * 2560), q);
#pragma unroll
                        for (int e = 0; e < 8; ++e) sum[e] -= q[e]; }
                    else {
#pragma unroll
                        for (int e = 0; e < 8; ++e) sum[e] -= prev[(size_t)(15 + to) * 1024 + e]; }
                    float* o = P->out + O_POOLS + (size_t)(bidx * 15 + 11 + j) * 1024 + c0;
#pragma unroll
                    for (int e = 0; e < 8; ++e) o[e] = v[e];
                } else {
                    if (tl0 + to >= 0) { float q[8]; unpack8(ld8(vp + (size_t)(t0 + to) * 2560), q);
#pragma unroll
                        for (int e = 0; e < 8; ++e) sum[e] -= q[e]; }
                    if (tl >= 2033) { float* o = P->out + O_POOLP + (size_t)(bidx * 15 + tl - 2033) * 1024 + c0;
#pragma unroll
                        for (int e = 0; e < 8; ++e) o[e] = v[e]; }
                }
            }
        }
    }
}

constexpr int CS_STR = 136;
constexpr int X_STR = 40;
__device__ __forceinline__ s16x4 tr_read(const bf16_t* p) { return __builtin_bit_cast(s16x4, __builtin_amdgcn_ds_read_tr16_b64_v4i16((LDSB s16x4*)p)); }

#define LDS_BARRIER() asm volatile("s_waitcnt lgkmcnt(0)\n\ts_barrier" ::: "memory")
__device__ __forceinline__ void ssd_prompt(PP P, int item, char* shm, const int tid) {
    const int w = tid >> 6, lane = tid & 63, fr = lane & 15, fq = lane >> 4;
    const int b = item >> 5, hd = (item >> 1) & 15, ph = item & 1, g = hd >> 3;
    const float a = -expf(P->a_log[hd]);
    const float Dh = P->ssm_d[hd];
    char* ws = P->ws;
    const bf16_t* xact = (const bf16_t*)(ws + W_XACT);
    const float* dtb = (const float*)(ws + W_DT);
    bf16_t* ybuf = (bf16_t*)(ws + W_Y);
    bf16_t* Cs = (bf16_t*)(shm);
    bf16_t* Bs = (bf16_t*)(shm + 34816);
    bf16_t* Gs = (bf16_t*)(shm + 69632);
    bf16_t* Xd = (bf16_t*)(shm + 104448);
    bf16_t* X2 = (bf16_t*)(shm + 104448 + 10240);
    bf16_t* Hs = (bf16_t*)(shm + 124928);
    float* acs = (float*)(shm + 133632);
    float* dts = (float*)(shm + 134144);
    f32x4 Hacc[2];
    Hacc[0] = (f32x4){0.f, 0.f, 0.f, 0.f}; Hacc[1] = (f32x4){0.f, 0.f, 0.f, 0.f};
    const int q4 = fr >> 2, p4 = fr & 3;
    u32x4 pc[4], pb[4], px; float pd0, pd1;
    const int ls = tid >> 4, ln8 = (tid & 15) * 8;
    const int xs = tid >> 2, xp8 = (tid & 3) * 8;
#define SSD_PREFETCH(cc) do { const int _t0 = b * 2048 + (cc) * 128; \
        _Pragma("unroll") for (int i = 0; i < 4; ++i) { const bf16_t* src = xact + (size_t)(_t0 + ls + i * 32) * 1536 + g * 128 + ln8; pc[i] = *(const u32x4*)(src + 1280); pb[i] = *(const u32x4*)(src + 1024); } \
        px = *(const u32x4*)(xact + (size_t)(_t0 + xs) * 1536 + hd * 64 + ph * 32 + xp8); \
        pd0 = dtb[(size_t)(_t0 + 2 * lane) * 16 + hd]; pd1 = dtb[(size_t)(_t0 + 2 * lane + 1) * 16 + hd]; } while (0)
    SSD_PREFETCH(0);
    for (int c = 0; c < 16; ++c) {
        const int t0 = b * 2048 + c * 128;
        if (w == 0) {
            const float d0 = pd0, d1 = pd1;
            const float s = (d0 + d1) * a; float v = s;
#pragma unroll
            for (int off = 1; off < 64; off <<= 1) { const float t = __shfl_up(v, off); if (lane >= off) v += t; }
            const float excl = v - s;
            acs[2 * lane] = excl + d0 * a; acs[2 * lane + 1] = v; dts[2 * lane] = d0; dts[2 * lane + 1] = d1;
        }
#pragma unroll
        for (int pt = 0; pt < 2; ++pt)
#pragma unroll
            for (int j = 0; j < 4; ++j) Hs[(pt * 16 + fq * 4 + j) * CS_STR + w * 16 + fr] = f2bf(Hacc[pt][j]);
#pragma unroll
        for (int i = 0; i < 4; ++i) { *(u32x4*)(Cs + (ls + i * 32) * CS_STR + ln8) = pc[i]; *(u32x4*)(Bs + (ls + i * 32) * CS_STR + ln8) = pb[i]; }
        LDS_BARRIER();
        {
            float x[8], xa[8], xb[8]; unpack8(px, x);
            const float dtv = dts[xs], dec = __expf(acs[127] - acs[xs]) * dtv;
#pragma unroll
            for (int e = 0; e < 8; ++e) { xa[e] = x[e] * dtv; xb[e] = x[e] * dec; }
            *(u32x4*)(Xd + xs * X_STR + xp8) = pack8(xa);
            *(u32x4*)(X2 + xs * X_STR + xp8) = pack8(xb);
        }
        if (c < 15) SSD_PREFETCH(c + 1);
        bf16x8 Cf[4];
#pragma unroll
        for (int kk = 0; kk < 4; ++kk) Cf[kk] = *(const bf16x8*)(Cs + (w * 16 + fr) * CS_STR + kk * 32 + fq * 8);
        const int nst = (w | 1) + 1;
#pragma unroll
        for (int st = 0; st < 8; ++st) {
            if (st < nst) {
                f32x4 ga = (f32x4){0.f, 0.f, 0.f, 0.f};
#pragma unroll
                for (int kk = 0; kk < 4; ++kk) { const bf16x8 Bf = *(const bf16x8*)(Bs + (st * 16 + fr) * CS_STR + kk * 32 + fq * 8); ga = __builtin_amdgcn_mfma_f32_16x16x32_bf16(Cf[kk], Bf, ga, 0, 0, 0); }
                const int s = st * 16 + fr; const float as = acs[s];
#pragma unroll
                for (int j = 0; j < 4; ++j) { const int l = w * 16 + fq * 4 + j; const float val = (s <= l) ? ga[j] * __expf(acs[l] - as) : 0.f; Gs[l * CS_STR + s] = f2bf(val); }
            }
        }
        LDS_BARRIER();
        {
            f32x4 Yd[2], Yo[2];
            Yd[0] = Yd[1] = Yo[0] = Yo[1] = (f32x4){0.f, 0.f, 0.f, 0.f};
            const int nkk = (w >> 1) + 1;
#pragma unroll
            for (int kk = 0; kk < 4; ++kk) {
                if (kk < nkk) {
                    const bf16x8 Gf = *(const bf16x8*)(Gs + (w * 16 + fr) * CS_STR + kk * 32 + fq * 8);
#pragma unroll
                    for (int pt = 0; pt < 2; ++pt) {
                        const bf16_t* base = Xd + (kk * 32 + fq * 8 + q4) * X_STR + pt * 16 + p4 * 4;
                        bf16x8 Xf; Xf.lo = tr_read(base); Xf.hi = tr_read(base + 4 * X_STR);
                        Yd[pt] = __builtin_amdgcn_mfma_f32_16x16x32_bf16(Gf, Xf, Yd[pt], 0, 0, 0);
                    }
                }
            }
#pragma unroll
            for (int kk = 0; kk < 4; ++kk)
#pragma unroll
                for (int pt = 0; pt < 2; ++pt) { const bf16x8 Hf = *(const bf16x8*)(Hs + (pt * 16 + fr) * CS_STR + kk * 32 + fq * 8); Yo[pt] = __builtin_amdgcn_mfma_f32_16x16x32_bf16(Cf[kk], Hf, Yo[pt], 0, 0, 0); }
#pragma unroll
            for (int j = 0; j < 4; ++j) {
                const int l = w * 16 + fq * 4 + j; const float el = __expf(acs[l]); const float rdt = Dh / dts[l];
#pragma unroll
                for (int pt = 0; pt < 2; ++pt) {
                    const int pl = pt * 16 + fr;
                    const float xr = bf2f(Xd[l * X_STR + pl]);
                    ybuf[(size_t)(t0 + l) * 1024 + hd * 64 + ph * 32 + pl] = f2bf(Yd[pt][j] + el * Yo[pt][j] + rdt * xr);
                }
            }
        }
        {
            const float dc = __expf(acs[127]);
            Hacc[0] *= dc; Hacc[1] *= dc;
#pragma unroll
            for (int kk = 0; kk < 4; ++kk) {
                const bf16_t* bb = Bs + (kk * 32 + fq * 8 + q4) * CS_STR + w * 16 + p4 * 4;
                bf16x8 Bf; Bf.lo = tr_read(bb); Bf.hi = tr_read(bb + 4 * CS_STR);
#pragma unroll
                for (int pt = 0; pt < 2; ++pt) {
                    const bf16_t* xb = X2 + (kk * 32 + fq * 8 + q4) * X_STR + pt * 16 + p4 * 4;
                    bf16x8 Xf; Xf.lo = tr_read(xb); Xf.hi = tr_read(xb + 4 * X_STR);
                    Hacc[pt] = __builtin_amdgcn_mfma_f32_16x16x32_bf16(Xf, Bf, Hacc[pt], 0, 0, 0);
                }
            }
        }
        LDS_BARRIER();
    }
#undef SSD_PREFETCH
    float* so = P->out + O_SSMP + ((size_t)(b * 16 + hd) * 64 + ph * 32) * 128;
#pragma unroll
    for (int pt = 0; pt < 2; ++pt)
#pragma unroll
        for (int j = 0; j < 4; ++j) so[(size_t)(pt * 16 + fq * 4 + j) * 128 + w * 16 + fr] = Hacc[pt][j];
}

__device__ __forceinline__ void ssd_sample(PP P, int item, const int tid) {
    const int b = item >> 4, hd = item & 15, g = hd >> 3;
    const int p = tid >> 3, n0 = (tid & 7) * 16;
    const float a = -expf(P->a_log[hd]);
    const float Dh = P->ssm_d[hd];
    char* ws = P->ws;
    const bf16_t* xact = (const bf16_t*)(ws + W_XACT);
    const float* dtb = (const float*)(ws + W_DT);
    bf16_t* ybuf = (bf16_t*)(ws + W_Y);
    const size_t sidx = ((size_t)(b * 16 + hd) * 64 + p) * 128 + n0;
    float h[16];
#pragma unroll
    for (int i = 0; i < 4; ++i) { const f32x4 v = *(const f32x4*)(P->state_ssm + sidx + i * 4); h[i * 4] = v[0]; h[i * 4 + 1] = v[1]; h[i * 4 + 2] = v[2]; h[i * 4 + 3] = v[3]; }
#pragma unroll
    for (int i = 0; i < 4; ++i) {
        const int t = TP + b * 4 + i;
        const float xv = bf2f(xact[(size_t)t * 1536 + hd * 64 + p]);
        const float dtv = dtb[(size_t)t * 16 + hd];
        const float dA = __expf(dtv * a), dx = dtv * xv;
        float Bv[16], Cv[16];
        { float t8[8]; unpack8(ld8(xact + (size_t)t * 1536 + 1024 + g * 128 + n0), t8);
#pragma unroll
          for (int e = 0; e < 8; ++e) Bv[e] = t8[e];
          unpack8(ld8(xact + (size_t)t * 1536 + 1024 + g * 128 + n0 + 8), t8);
#pragma unroll
          for (int e = 0; e < 8; ++e) Bv[8 + e] = t8[e];
          unpack8(ld8(xact + (size_t)t * 1536 + 1280 + g * 128 + n0), t8);
#pragma unroll
          for (int e = 0; e < 8; ++e) Cv[e] = t8[e];
          unpack8(ld8(xact + (size_t)t * 1536 + 1280 + g * 128 + n0 + 8), t8);
#pragma unroll
          for (int e = 0; e < 8; ++e) Cv[8 + e] = t8[e]; }
        float part = 0.f;
#pragma unroll
        for (int e = 0; e < 16; ++e) { h[e] = h[e] * dA + dx * Bv[e]; part += h[e] * Cv[e]; }
        part += __shfl_xor(part, 1); part += __shfl_xor(part, 2); part += __shfl_xor(part, 4);
        if ((tid & 7) == 0) ybuf[(size_t)t * 1024 + hd * 64 + p] = f2bf(part + Dh * xv);
    }
    float* so = P->out + O_SSMS + sidx;
#pragma unroll
    for (int i = 0; i < 4; ++i) *(f32x4*)(so + i * 4) = (f32x4){h[i * 4], h[i * 4 + 1], h[i * 4 + 2], h[i * 4 + 3]};
}

__device__ __forceinline__ void phase_gatednorm(PP P, int gw, int nw, const int tid) {
    const int lane = tid & 63;
    char* ws = P->ws;
    const bf16_t* ybuf = (const bf16_t*)(ws + W_Y); const bf16_t* zbuf = (const bf16_t*)(ws + W_Z);
    bf16_t* mix = (bf16_t*)(ws + W_MIX);
    for (int row = gw; row < TT; row += nw) {
        float t[4][4]; float ss0 = 0.f, ss1 = 0.f;
#pragma unroll
        for (int j = 0; j < 4; ++j) {
            const u32x2 yv = *(const u32x2*)(ybuf + (size_t)row * 1024 + j * 256 + lane * 4);
            const u32x2 zv = *(const u32x2*)(zbuf + (size_t)row * 1024 + j * 256 + lane * 4);
            const float y0 = bflo(yv.x), y1 = bfhi(yv.x), y2 = bflo(yv.y), y3 = bfhi(yv.y);
            const float z0 = bflo(zv.x), z1 = bfhi(zv.x), z2 = bflo(zv.y), z3 = bfhi(zv.y);
            t[j][0] = y0 * silu_f(z0); t[j][1] = y1 * silu_f(z1); t[j][2] = y2 * silu_f(z2); t[j][3] = y3 * silu_f(z3);
            const float q = t[j][0] * t[j][0] + t[j][1] * t[j][1] + t[j][2] * t[j][2] + t[j][3] * t[j][3];
            if (j < 2) ss0 += q; else ss1 += q;
        }
        ss0 = wave_sum(ss0); ss1 = wave_sum(ss1);
        const float r0 = rsqrtf(ss0 * (1.0f / 512.0f) + EPS), r1 = rsqrtf(ss1 * (1.0f / 512.0f) + EPS);
#pragma unroll
        for (int j = 0; j < 4; ++j) {
            const float r = j < 2 ? r0 : r1;
            const f32x4 g4 = *(const f32x4*)(P->ssm_norm + j * 256 + lane * 4);
            u32x2 o; o.x = pk2(t[j][0] * r * g4[0], t[j][1] * r * g4[1]); o.y = pk2(t[j][2] * r * g4[2], t[j][3] * r * g4[3]);
            *(u32x2*)(mix + (size_t)row * 2048 + j * 256 + lane * 4) = o;
        }
    }
}

__device__ __forceinline__ void phase_norm(PP P, const float* gain, bool final_out, int gw, int nw, const int tid) {
    const int lane = tid & 63;
    char* ws = P->ws;
    const float* xres = (const float*)(ws + W_XRES);
    for (int row = gw; row < TT; row += nw) {
        f32x4 xv[4]; float ss = 0.f;
#pragma unroll
        for (int j = 0; j < 4; ++j) { xv[j] = *(const f32x4*)(xres + (size_t)row * 1024 + j * 256 + lane * 4); ss += xv[j][0] * xv[j][0] + xv[j][1] * xv[j][1] + xv[j][2] * xv[j][2] + xv[j][3] * xv[j][3]; }
        ss = wave_sum(ss);
        const float rstd = rsqrtf(ss * (1.0f / 1024.0f) + EPS);
#pragma unroll
        for (int j = 0; j < 4; ++j) {
            const f32x4 g4 = *(const f32x4*)(gain + j * 256 + lane * 4);
            const f32x4 y = xv[j] * rstd * g4;
            if (final_out) *(f32x4*)(P->out + O_YP + (size_t)row * 1024 + j * 256 + lane * 4) = y;
            else { u32x2 o; o.x = pk2(y[0], y[1]); o.y = pk2(y[2], y[3]); *(u32x2*)((bf16_t*)(ws + W_H) + (size_t)row * 1024 + j * 256 + lane * 4) = o; }
        }
    }
}

__device__ __forceinline__ void attn_sample(PP P, int item, char* shm, const int tid) {
    const int w = tid >> 6, lane = tid & 63, fr = lane & 15, fq = lane >> 4;
    const int b = item >> 2, hh = item & 3;
    char* ws = P->ws;
    const bf16_t* qb = (const bf16_t*)(ws + W_Q);
    float* sc = (float*)shm;
    float* part = (float*)(shm + 4096);
    bf16x8 qf[8];
#pragma unroll
    for (int kk = 0; kk < 8; ++kk) {
        bf16x8 z = {0, 0, 0, 0, 0, 0, 0, 0};
        if (fr < 4) z = *(const bf16x8*)(qb + (size_t)(TP + b * 4 + fr) * 1024 + hh * 256 + kk * 32 + fq * 8);
        qf[kk] = z;
    }
#pragma unroll
    for (int mt = 0; mt < 2; ++mt) {
        const int key = w * 32 + mt * 16 + fr;
        const float* kp = P->cache_k + ((size_t)(b * 256 + key) * 4 + hh) * 256 + fq * 8;
        f32x4 acc = (f32x4){0.f, 0.f, 0.f, 0.f};
#pragma unroll
        for (int kk = 0; kk < 8; ++kk) {
            const f32x4 k0 = *(const f32x4*)(kp + kk * 32), k1 = *(const f32x4*)(kp + kk * 32 + 4);
            u32x4 pk; pk.x = pk2(k0[0], k0[1]); pk.y = pk2(k0[2], k0[3]); pk.z = pk2(k1[0], k1[1]); pk.w = pk2(k1[2], k1[3]);
            acc = __builtin_amdgcn_mfma_f32_16x16x32_bf16(qf[kk], __builtin_bit_cast(bf16x8, pk), acc, 0, 0, 0);
        }
        if (fq == 0) {
#pragma unroll
            for (int j = 0; j < 4; ++j) sc[j * 256 + w * 32 + mt * 16 + fr] = acc[j];
        }
    }
    __syncthreads();
    if (w < 4) {
        f32x4 s = *(const f32x4*)(sc + w * 256 + lane * 4);
        float m = fmaxf(fmaxf(s[0], s[1]), fmaxf(s[2], s[3])); m = wave_max(m);
        s[0] = __expf(s[0] - m); s[1] = __expf(s[1] - m); s[2] = __expf(s[2] - m); s[3] = __expf(s[3] - m);
        float su = (s[0] + s[1]) + (s[2] + s[3]); su = wave_sum(su);
        const float inv = 1.0f / su;
        *(f32x4*)(sc + w * 256 + lane * 4) = s * inv;
    }
    __syncthreads();
    {
        f32x4 o[4];
#pragma unroll
        for (int i = 0; i < 4; ++i) o[i] = (f32x4){0.f, 0.f, 0.f, 0.f};
        const float* vp = P->cache_v + ((size_t)(b * 256 + w * 32) * 4 + hh) * 256 + lane * 4;
#pragma unroll 8
        for (int mm = 0; mm < 32; ++mm) {
            const f32x4 v = *(const f32x4*)(vp + (size_t)mm * 1024);
#pragma unroll
            for (int i = 0; i < 4; ++i) o[i] += sc[i * 256 + w * 32 + mm] * v;
        }
#pragma unroll
        for (int i = 0; i < 4; ++i) *(f32x4*)(part + (w * 4 + i) * 256 + lane * 4) = o[i];
    }
    __syncthreads();
    {
        const int i = tid >> 7, d2 = (tid & 127) * 2;
        float s0 = 0.f, s1 = 0.f;
#pragma unroll
        for (int ww = 0; ww < 8; ++ww) { s0 += part[(ww * 4 + i) * 256 + d2]; s1 += part[(ww * 4 + i) * 256 + d2 + 1]; }
        *(unsigned*)((bf16_t*)(ws + W_O) + (size_t)(TP + b * 4 + i) * 1024 + hh * 256 + d2) = pk2(s0, s1);
    }
    __syncthreads();
}

__device__ __forceinline__ void phase_ffnconv(PP P, int gtid, int nthreads) {
    char* ws = P->ws;
    const bf16_t* u = (const bf16_t*)(ws + W_U);
    bf16_t* act = (bf16_t*)(ws + W_ACT);
    for (int idx = gtid; idx < 1152 * 352; idx += nthreads) {
        const int run = idx / 352, cg = idx % 352;
        const bool samp = run >= 1024;
        int t0, len, bidx, tl0;
        if (!samp) { t0 = run * 16; len = 16; bidx = t0 >> 11; tl0 = t0 & 2047; } else { bidx = run - 1024; t0 = TP + bidx * 4; len = 4; tl0 = 0; }
        const int cgc = cg * 8, cvc = 2816 + cg * 8;
        float wg0[8], wg1[8], wg2[8], wv0[8], wv1[8], wv2[8], bg[8], bv[8], hg0[8], hg1[8], hv0[8], hv1[8];
#pragma unroll
        for (int e = 0; e < 8; ++e) {
            wg0[e] = P->ffn_w[cgc + e]; wg1[e] = P->ffn_w[5632 + cgc + e]; wg2[e] = P->ffn_w[11264 + cgc + e];
            wv0[e] = P->ffn_w[cvc + e]; wv1[e] = P->ffn_w[5632 + cvc + e]; wv2[e] = P->ffn_w[11264 + cvc + e];
            bg[e] = P->ffn_b[cgc + e]; bv[e] = P->ffn_b[cvc + e];
        }
        if (samp) {
#pragma unroll
            for (int e = 0; e < 8; ++e) {
                hg0[e] = P->state_ffn[(size_t)(bidx * 2 + 0) * 5632 + cgc + e]; hg1[e] = P->state_ffn[(size_t)(bidx * 2 + 1) * 5632 + cgc + e];
                hv0[e] = P->state_ffn[(size_t)(bidx * 2 + 0) * 5632 + cvc + e]; hv1[e] = P->state_ffn[(size_t)(bidx * 2 + 1) * 5632 + cvc + e];
            }
        } else if (tl0 > 0) {
            unpack8(ld8(u + (size_t)(t0 - 2) * 5632 + cgc), hg0); unpack8(ld8(u + (size_t)(t0 - 1) * 5632 + cgc), hg1);
            unpack8(ld8(u + (size_t)(t0 - 2) * 5632 + cvc), hv0); unpack8(ld8(u + (size_t)(t0 - 1) * 5632 + cvc), hv1);
        } else {
#pragma unroll
            for (int e = 0; e < 8; ++e) { hg0[e] = 0.f; hg1[e] = 0.f; hv0[e] = 0.f; hv1[e] = 0.f; }
        }
#pragma unroll 4
        for (int j = 0; j < len; ++j) {
            float ug[8], uv[8], o8[8];
            unpack8(ld8(u + (size_t)(t0 + j) * 5632 + cgc), ug); unpack8(ld8(u + (size_t)(t0 + j) * 5632 + cvc), uv);
#pragma unroll
            for (int e = 0; e < 8; ++e) {
                const float gc = bg[e] + wg0[e] * hg0[e] + wg1[e] * hg1[e] + wg2[e] * ug[e];
                const float vc = bv[e] + wv0[e] * hv0[e] + wv1[e] * hv1[e] + wv2[e] * uv[e];
                o8[e] = silu_f(gc) * vc;
            }
            *(u32x4*)(act + (size_t)(t0 + j) * 2816 + cgc) = pack8(o8);
            float* o = nullptr;
            if (samp) { if (j >= 2) o = P->out + O_FFNS + (size_t)(bidx * 2 + j - 2) * 5632; }
            else { const int tl = tl0 + j; if (tl >= 2046) o = P->out + O_FFNP + (size_t)(bidx * 2 + tl - 2046) * 5632; }
            if (o) {
#pragma unroll
                for (int e = 0; e < 8; ++e) { o[cgc + e] = ug[e]; o[cvc + e] = uv[e]; }
            }
#pragma unroll
            for (int e = 0; e < 8; ++e) { hg0[e] = hg1[e]; hg1[e] = ug[e]; hv0[e] = hv1[e]; hv1[e] = uv[e]; }
        }
    }
}

#define XB_TMO      128
#define XB_XCNT(j)  (256  + 64 * (j))
#define XB_XSUB(j)  (1280 + 64 * (j))
#define XB_XGEN(j)  (2304 + 64 * (j))
#define XB_TOP      3328
#define XB_TOPGEN   3392
#define XCD_BAR_WORDS 3456
#define XB_SPIN_CAP (1u << 18)
__device__ __forceinline__ unsigned xb_ld(unsigned* p)              { return __hip_atomic_load(p, __ATOMIC_RELAXED, __HIP_MEMORY_SCOPE_AGENT); }
__device__ __forceinline__ unsigned xb_add(unsigned* p, unsigned v) { return __hip_atomic_fetch_add(p, v, __ATOMIC_RELAXED, __HIP_MEMORY_SCOPE_AGENT); }
__device__ __forceinline__ unsigned xb_xcc_id() { return (unsigned)__builtin_amdgcn_s_getreg((3 << 11) | 20) & 0xFu; }
#define XB_SPIN(cond, bar) do { unsigned _sp = 0; while (cond) { __builtin_amdgcn_s_sleep(1); \
    if ((++_sp & 255u) == 0u) { if (xb_ld(&(bar)[XB_TMO])) break; if (_sp > XB_SPIN_CAP) { atomicAdd(&(bar)[XB_TMO], 1u); break; } } } } while (0)
__device__ __forceinline__ void xcd_barrier_complete(unsigned* bar, unsigned x, unsigned& nloc, unsigned& nx) {
    const unsigned G = gridDim.x;
    unsigned sum, cnt, mine, sp = 0u;
    for (;;) {
        sum = 0u; cnt = 0u; mine = 0u;
#pragma unroll
        for (unsigned j = 0; j < 16; ++j) { const unsigned c = xb_ld(&bar[XB_XCNT(j)]); sum += c; cnt += (c > 0u) ? 1u : 0u; mine = (j == x) ? c : mine; }
        if (sum == G) break;
        __builtin_amdgcn_s_sleep(1);
        if ((++sp & 255u) == 0u) { if (xb_ld(&bar[XB_TMO])) break; if (sp > XB_SPIN_CAP) { atomicAdd(&bar[XB_TMO], 1u); break; } }
    }
    nloc = mine > 0u ? mine : 1u; nx = cnt > 0u ? cnt : 1u;
}
__device__ __forceinline__ void xcd_barrier(unsigned* bar, volatile LDSB unsigned* st, const int tid) {
    asm volatile("s_waitcnt vmcnt(0)" ::: "memory");
    __syncthreads();
    if (tid == 0) {
        const unsigned x = xb_xcc_id();
        __builtin_amdgcn_s_waitcnt(0);
        unsigned nloc = st[0], nx = st[1];
        if (nloc == 0u) { xcd_barrier_complete(bar, x, nloc, nx); st[0] = nloc; st[1] = nx; }
        const unsigned old = xb_add(&bar[XB_XSUB(x)], 1u);
        const unsigned gen = old / nloc;
        if (old + 1u == (gen + 1u) * nloc) {
            __builtin_amdgcn_fence(__ATOMIC_RELEASE, "agent");
            asm volatile("s_waitcnt vmcnt(0)" ::: "memory");
            const unsigned og = xb_add(&bar[XB_TOP], 1u);
            const unsigned tg = og / nx;
            if (og + 1u == (tg + 1u) * nx) xb_add(&bar[XB_TOPGEN], 1u);
            else XB_SPIN(xb_ld(&bar[XB_TOPGEN]) == tg, bar);
            __builtin_amdgcn_fence(__ATOMIC_ACQUIRE, "agent");
            xb_add(&bar[XB_XGEN(x)], 1u);
            asm volatile("s_waitcnt vmcnt(0)" ::: "memory");
        } else {
            XB_SPIN(xb_ld(&bar[XB_XGEN(x)]) == gen, bar);
            __builtin_amdgcn_fence(__ATOMIC_ACQUIRE, "agent");
            asm volatile("s_waitcnt vmcnt(0)" ::: "memory");
        }
    }
    __syncthreads();
}

extern __shared__ __attribute__((aligned(16))) char smem[];

__global__ void __launch_bounds__(NTHR) hybrid_fwd(Params Pin) {
    char* shm = smem;
    volatile LDSB unsigned* bst = (volatile LDSB unsigned*)(smem + 139264);
    if (threadIdx.x == 0) { bst[0] = 0u; bst[1] = 0u; (void)xb_add((unsigned*)(Pin.ws + W_BAR) + XB_XCNT(xb_xcc_id()), 1u); }
    __syncthreads();
    for (int ph = Pin.ph_lo; ph < Pin.ph_hi; ++ph) {
        if (ph == 6 || ph == 11) continue;
        const int reps = ((REPEAT_MASK >> ph) & 1) ? 2 : 1;
        for (int rep = 0; rep < reps; ++rep) {
        if (rep > 0) xcd_barrier((unsigned*)(Pin.ws + W_BAR), bst, threadIdx.x);
        int tid = threadIdx.x, blk = blockIdx.x, nblk = gridDim.x;
        asm volatile("" : "+v"(tid));
        asm volatile("" : "+s"(blk), "+s"(nblk));
        PP P = (PP)__builtin_amdgcn_kernarg_segment_ptr();
        asm volatile("" : "+s"(P));
        const int lb = (blk & 7) * (nblk >> 3) + (blk >> 3);
        const int gtid = blk * NTHR + tid, nthreads = nblk * NTHR;
        const int gw = blk * 8 + (tid >> 6), nw = nblk * 8;
        switch (ph) {
#if PHASE_MASK & 1
        case 0: phase_prep(P, shm, blk, nblk, tid); break;
#endif
#if PHASE_MASK & 4
        case 2: phase_convpool(P, gtid, nthreads); break;
#endif
#if PHASE_MASK & 8
        case 3:
            for (int r3 = 0; r3 < (PROBE3 == 1 ? 2 : 1); ++r3) { for (int it = blk; it < 256; it += nblk) ssd_prompt(P, it, shm, tid); }
            for (int r3 = 0; r3 < (PROBE3 == 2 ? 2 : 1); ++r3) { for (int it = blk; it < 2048; it += nblk) ssd_sample(P, it, tid); }
            break;
#endif
#if PHASE_MASK & 16
        case 4: phase_gatednorm(P, gw, nw, tid); break;
#endif
#if PHASE_MASK & 64
        case 6: phase_norm(P, P->norm_mem, false, gw, nw, tid); break;
        case 11: phase_norm(P, P->norm_ffn, false, gw, nw, tid); break;
        case 15: phase_norm(P, P->final_norm, true, gw, nw, tid); break;
#endif
#if PHASE_MASK & 8192
        case 13: phase_ffnconv(P, gtid, nthreads); break;
#endif
        default: break;
        }
#if PHASE_MASK & 2
        if (ph == 1 || ph == 3 || ph == 5 || ph == 7 || ph == 8 || ph == 9 || ph == 10 || ph == 12 || ph == 14) gemm_phase(P, ph, shm, lb, blk, nblk, tid);
#endif
#if PHASE_MASK & 256
        if (ph == 9) { for (int it = blk; it < 512; it += nblk) attn_sample(P, it, shm, tid); }
#endif
        }
        if (ph + 1 < Pin.ph_hi && ph != 8) xcd_barrier((unsigned*)(Pin.ws + W_BAR), bst, threadIdx.x);
        if (ph == 8) { asm volatile("s_waitcnt vmcnt(0)" ::: "memory"); __syncthreads(); }
        if (EXTRA_SYNCS && ph == 0) { for (int i = 0; i < EXTRA_SYNCS; ++i) xcd_barrier((unsigned*)(Pin.ws + W_BAR), bst, threadIdx.x); }
    }
}

extern "C" void kernel_launch(void* const* d_in, const int* in_sizes, int n_in, void* d_out, int out_size, void* d_ws, size_t ws_size, hipStream_t stream) {
    static int grid_blocks = 0;
    if (!grid_blocks) {
        int dev = 0, cus = 0, per_cu = 0;
        hipGetDevice(&dev);
        hipDeviceGetAttribute(&cus, hipDeviceAttributeMultiprocessorCount, dev);
        hipFuncSetAttribute((const void*)hybrid_fwd, hipFuncAttributeMaxDynamicSharedMemorySize, LDS_BYTES);
        hipOccupancyMaxActiveBlocksPerMultiprocessor(&per_cu, hybrid_fwd, NTHR, LDS_BYTES);
        if (per_cu < 1) per_cu = 1;
        grid_blocks = cus * 1;
        grid_blocks &= ~7;
        if (grid_blocks < 8) grid_blocks = 8;
    }
    Params p{};
    const float* const* in = (const float* const*)d_in;
    p.x_prompt = in[0]; p.x_sample = in[1]; p.mem_prompt = in[2]; p.state_ssm = in[3]; p.state_conv = in[4]; p.state_pool = in[5]; p.state_ffn = in[6];
    p.cache_k = in[7]; p.cache_v = in[8]; p.norm_mix = in[9]; p.w_in = in[10]; p.conv_w = in[11]; p.conv_b = in[12]; p.dt_bias = in[13]; p.a_log = in[14];
    p.ssm_d = in[15]; p.ssm_norm = in[16]; p.w_pool = in[17]; p.pool_scale = in[18]; p.w_out = in[19]; p.norm_mem = in[20]; p.norm_memkv = in[21];
    p.w_mq = in[22]; p.w_mk = in[23]; p.w_mv = in[24]; p.w_mo = in[25]; p.norm_ffn = in[26]; p.w_up = in[27]; p.ffn_w = in[28]; p.ffn_b = in[29];
    p.w_down = in[30]; p.final_norm = in[31];
    p.out = (float*)d_out; p.ws = (char*)d_ws; p.ph_lo = 0; p.ph_hi = 16;
    hipMemsetAsync((char*)d_ws + W_BAR, 0, 16384, stream);
    void* args[] = {&p};
    hipError_t e = hipLaunchCooperativeKernel((const void*)hybrid_fwd, dim3(grid_blocks), dim3(NTHR), args, LDS_BYTES, stream);
    if (e != hipSuccess) fprintf(stderr, "cooperative launch failed: %s (grid %d)\n", hipGetErrorString(e), grid_blocks);
}
```

```cpp
#include <hip/hip_runtime.h>
#include <hip/hip_cooperative_groups.h>
#include <cstdio>
namespace cg = cooperative_groups;

typedef unsigned short bf16_t;
typedef short bf16x8 __attribute__((ext_vector_type(8)));
typedef short s16x4 __attribute__((ext_vector_type(4)));
typedef float f32x4 __attribute__((ext_vector_type(4)));
typedef unsigned u32x4 __attribute__((ext_vector_type(4)));
typedef unsigned u32x2 __attribute__((ext_vector_type(2)));
#define LDSB __attribute__((address_space(3)))

constexpr int TP = 16384, TS = 512, TT = TP + TS;
constexpr int NTHR = 512;
constexpr int LDS_BYTES = 139264 + 256;
constexpr float EPS = 1e-6f;
#ifndef PHASE_MASK
#define PHASE_MASK 0xFFFF
#endif
#ifndef REPEAT_MASK
#define REPEAT_MASK 0
#endif
#ifndef PROBE3
#define PROBE3 0
#endif
#ifndef EXTRA_SYNCS
#define EXTRA_SYNCS 0
#endif

constexpr size_t O_YP = 0;
constexpr size_t O_YS = O_YP + (size_t)TP * 1024;
constexpr size_t O_SSMP = O_YS + (size_t)TS * 1024;
constexpr size_t O_SSMS = O_SSMP + (size_t)8 * 16 * 64 * 128;
constexpr size_t O_CONVP = O_SSMS + (size_t)128 * 16 * 64 * 128;
constexpr size_t O_CONVS = O_CONVP + (size_t)8 * 3 * 1536;
constexpr size_t O_POOLP = O_CONVS + (size_t)128 * 3 * 1536;
constexpr size_t O_POOLS = O_POOLP + (size_t)8 * 15 * 1024;
constexpr size_t O_FFNP = O_POOLS + (size_t)128 * 15 * 1024;
constexpr size_t O_FFNS = O_FFNP + (size_t)8 * 2 * 5632;
constexpr size_t O_MK = O_FFNS + (size_t)128 * 2 * 5632;
constexpr size_t O_MV = O_MK + (size_t)8 * 256 * 1024;

constexpr size_t W_WIN = 0;
constexpr size_t W_WPOOL = W_WIN + (size_t)3584 * 1024 * 2;
constexpr size_t W_WOUT = W_WPOOL + (size_t)4 * 256 * 256 * 2;
constexpr size_t W_WMQ = W_WOUT + (size_t)1024 * 2048 * 2;
constexpr size_t W_WMK = W_WMQ + (size_t)1024 * 1024 * 2;
constexpr size_t W_WMV = W_WMK + (size_t)1024 * 1024 * 2;
constexpr size_t W_WMO = W_WMV + (size_t)1024 * 1024 * 2;
constexpr size_t W_WUP = W_WMO + (size_t)1024 * 1024 * 2;
constexpr size_t W_WDOWN = W_WUP + (size_t)5632 * 1024 * 2;
constexpr size_t W_H = W_WDOWN + (size_t)1024 * 2816 * 2;
constexpr size_t W_HM = W_H + (size_t)TT * 1024 * 2;
constexpr size_t W_KB = W_HM + (size_t)2048 * 1024 * 2;
constexpr size_t W_VT = W_KB + (size_t)2048 * 1024 * 2;
constexpr size_t W_DT = W_VT + (size_t)2048 * 1024 * 2;
constexpr size_t W_XRES = W_DT + (size_t)TT * 16 * 4;
constexpr size_t W_ARENA = W_XRES + (size_t)TT * 1024 * 4;
constexpr size_t W_Z = W_ARENA;
constexpr size_t W_PROJ2 = W_Z + (size_t)TT * 1024 * 2;
constexpr size_t W_XACT = W_PROJ2 + (size_t)TT * 2560 * 2;
constexpr size_t W_POOLED = W_XACT + (size_t)TT * 1536 * 2;
constexpr size_t W_Y = W_POOLED + (size_t)TT * 1024 * 2;
constexpr size_t W_MIX = W_Y + (size_t)TT * 1024 * 2;
constexpr size_t W_END_A = W_MIX + (size_t)TT * 2048 * 2;
constexpr size_t W_Q = W_PROJ2;
constexpr size_t W_P = W_Q + (size_t)TT * 1024 * 2;
constexpr size_t W_O = W_P + (size_t)TP * 1024 * 2;
constexpr size_t W_U = W_ARENA;
constexpr size_t W_ACT = W_U + (size_t)TT * 5632 * 2;
constexpr size_t W_END_C = W_ACT + (size_t)TT * 2816 * 2;
constexpr size_t W_BAR = W_END_A;
constexpr size_t W_SS1 = W_BAR + 16384;
constexpr size_t W_SS2 = W_SS1 + (size_t)TT * 4;
constexpr size_t W_SS3 = W_SS2 + (size_t)TT * 4;
constexpr size_t W_TOTAL = W_SS3 + (size_t)TT * 4;
static_assert(W_O + (size_t)TT * 1024 * 2 <= W_POOLED, "era B overflow");
static_assert(W_END_C <= W_END_A, "era C overflow");

struct Params {
    const float *x_prompt, *x_sample, *mem_prompt, *state_ssm, *state_conv, *state_pool, *state_ffn, *cache_k, *cache_v;
    const float *norm_mix, *w_in, *conv_w, *conv_b, *dt_bias, *a_log, *ssm_d, *ssm_norm, *w_pool, *pool_scale, *w_out;
    const float *norm_mem, *norm_memkv, *w_mq, *w_mk, *w_mv, *w_mo, *norm_ffn, *w_up, *ffn_w, *ffn_b, *w_down, *final_norm;
    float* out;
    char* ws;
    int ph_lo, ph_hi;
};

typedef const __attribute__((address_space(4))) Params* PP;

__device__ __forceinline__ unsigned pk2(float lo, float hi) { unsigned r; asm("v_cvt_pk_bf16_f32 %0, %1, %2" : "=v"(r) : "v"(lo), "v"(hi)); return r; }
__device__ __forceinline__ bf16_t f2bf(float f) { return (bf16_t)(pk2(f, 0.f) & 0xffffu); }
__device__ __forceinline__ float bf2f(bf16_t b) { return __uint_as_float(((unsigned)b) << 16); }
__device__ __forceinline__ float bflo(unsigned u) { return __uint_as_float(u << 16); }
__device__ __forceinline__ float bfhi(unsigned u) { return __uint_as_float(u & 0xffff0000u); }
__device__ __forceinline__ void unpack8(u32x4 v, float (&f)[8]) {
    f[0] = bflo(v.x); f[1] = bfhi(v.x); f[2] = bflo(v.y); f[3] = bfhi(v.y); f[4] = bflo(v.z); f[5] = bfhi(v.z); f[6] = bflo(v.w); f[7] = bfhi(v.w);
}
__device__ __forceinline__ u32x4 pack8(const float (&f)[8]) { u32x4 r; r.x = pk2(f[0], f[1]); r.y = pk2(f[2], f[3]); r.z = pk2(f[4], f[5]); r.w = pk2(f[6], f[7]); return r; }
__device__ __forceinline__ float wave_sum(float v) {
#pragma unroll
    for (int o = 1; o < 64; o <<= 1) v += __shfl_xor(v, o);
    return v;
}
__device__ __forceinline__ float wave_max(float v) {
#pragma unroll
    for (int o = 1; o < 64; o <<= 1) v = fmaxf(v, __shfl_xor(v, o));
    return v;
}
__device__ __forceinline__ float silu_f(float x) { return x / (1.0f + __expf(-x)); }

constexpr int HTB = 128 * 64 * 2;
__device__ __forceinline__ int lds_byte(int r, int c) { const int st = (r >> 4) * 2 + (c >> 5), rr = r & 15, cc = c & 31, ob = rr * 64 + cc * 2; return st * 1024 + (ob ^ (((ob >> 9) & 1) << 5)); }
__device__ __forceinline__ void stage_rc(int b, int& R, int& C) { const int st = b / 1024, sb = b % 1024, swz = sb ^ (((sb >> 9) & 1) << 5); R = (st >> 1) * 16 + swz / 64; C = (st & 1) * 32 + (swz % 64) / 2; }

enum { E_PROJ = 0, E_MEMKV, E_POOL, E_OUT, E_Q, E_QK, E_PV, E_MO, E_UP, E_DOWN };

template <int EK>
__device__ __forceinline__ float epi_apply(PP P, int row, int col, f32x4 v) {
    char* ws = P->ws;
    if constexpr (EK == E_PROJ) {
        u32x2 o; o.x = pk2(v[0], v[1]); o.y = pk2(v[2], v[3]);
        if (col < 1024) *(u32x2*)((bf16_t*)(ws + W_Z) + (size_t)row * 1024 + col) = o;
        else *(u32x2*)((bf16_t*)(ws + W_PROJ2) + (size_t)row * 2560 + (col - 1024)) = o;
    } else if constexpr (EK == E_MEMKV) {
        if (col < 1024) {
            *(f32x4*)(P->out + O_MK + (size_t)row * 1024 + col) = v;
            u32x2 o; o.x = pk2(v[0], v[1]); o.y = pk2(v[2], v[3]);
            *(u32x2*)((bf16_t*)(ws + W_KB) + (size_t)row * 1024 + col) = o;
        } else {
            const int c = col - 1024;
            *(f32x4*)(P->out + O_MV + (size_t)row * 1024 + c) = v;
            const int b = row >> 8, m = row & 255, hh = c >> 8, d = c & 255;
            bf16_t* vt = (bf16_t*)(ws + W_VT) + ((size_t)(b * 4 + hh) * 256 + d) * 256 + m;
#pragma unroll
            for (int j = 0; j < 4; ++j) vt[j * 256] = f2bf(v[j]);
        }
    } else if constexpr (EK == E_POOL) {
        const f32x4 sc = *(const f32x4*)(P->pool_scale + col);
        u32x2 o; o.x = pk2(v[0] * sc[0], v[1] * sc[1]); o.y = pk2(v[2] * sc[2], v[3] * sc[3]);
        *(u32x2*)((bf16_t*)(ws + W_MIX) + (size_t)row * 2048 + 1024 + col) = o;
    } else if constexpr (EK == E_OUT) {
        const float* xin = row < TP ? P->x_prompt + (size_t)row * 1024 : P->x_sample + (size_t)(row - TP) * 1024;
        const f32x4 x = *(const f32x4*)(xin + col) + v;
        u32x2 o; o.x = pk2(x[0], x[1]); o.y = pk2(x[2], x[3]);
        *(u32x2*)((bf16_t*)(ws + W_H) + (size_t)row * 1024 + col) = o;
        return (x[0] * x[0] + x[1] * x[1]) + (x[2] * x[2] + x[3] * x[3]);
    } else if constexpr (EK == E_Q) {
        u32x2 o; o.x = pk2(v[0], v[1]); o.y = pk2(v[2], v[3]);
        *(u32x2*)((bf16_t*)(ws + W_Q) + (size_t)row * 1024 + col) = o;
    } else if constexpr (EK == E_PV) {
        u32x2 o; o.x = pk2(v[0], v[1]); o.y = pk2(v[2], v[3]);
        *(u32x2*)((bf16_t*)(ws + W_O) + (size_t)row * 1024 + col) = o;
    } else if constexpr (EK == E_MO || EK == E_DOWN) {
        u32x2* hp = (u32x2*)((bf16_t*)(ws + W_H) + (size_t)row * 1024 + col);
        const u32x2 hv = *hp;
        const f32x4 x = (f32x4){bflo(hv.x), bfhi(hv.x), bflo(hv.y), bfhi(hv.y)} + v;
        u32x2 o; o.x = pk2(x[0], x[1]); o.y = pk2(x[2], x[3]);
        *hp = o;
        return (x[0] * x[0] + x[1] * x[1]) + (x[2] * x[2] + x[3] * x[3]);
    } else if constexpr (EK == E_UP) {
        u32x2 o; o.x = pk2(v[0], v[1]); o.y = pk2(v[2], v[3]);
        *(u32x2*)((bf16_t*)(ws + W_U) + (size_t)row * 5632 + col) = o;
    }
    return 0.f;
}
template <int EK>
__device__ __forceinline__ float epi_rowscale(PP P, int row) {
    if constexpr (EK == E_Q) return rsqrtf(((const float*)(P->ws + W_SS1))[row] * (1.0f / 1024.0f) + EPS) * 0.0625f;
    else if constexpr (EK == E_UP) return rsqrtf(((const float*)(P->ws + W_SS2))[row] * (1.0f / 1024.0f) + EPS);
    else return 1.0f;
}
__device__ __forceinline__ float epi_apply_rt(PP P, int ekind, int row, int col, f32x4 v) {
    switch (ekind) {
    case E_POOL: return epi_apply<E_POOL>(P, row, col, v);
    case E_OUT: return epi_apply<E_OUT>(P, row, col, v);
    case E_Q: return epi_apply<E_Q>(P, row, col, v * epi_rowscale<E_Q>(P, row));
    case E_MO: return epi_apply<E_MO>(P, row, col, v);
    default: return epi_apply<E_DOWN>(P, row, col, v);
    }
}
template <int EK>
__device__ __forceinline__ void epi_loop(PP P, const f32x4 (&acc)[2][2][4][2], int rbase, int cbase, int fq) {
#pragma unroll
    for (int ai = 0; ai < 2; ++ai)
#pragma unroll
        for (int m = 0; m < 4; ++m) {
            const int row = rbase + ai * 128 + m * 16;
            const float rs = epi_rowscale<EK>(P, row);
            float ss = 0.f;
#pragma unroll
            for (int bj = 0; bj < 2; ++bj)
#pragma unroll
                for (int n = 0; n < 2; ++n) {
                    if constexpr (EK == E_Q || EK == E_UP) ss += epi_apply<EK>(P, row, cbase + bj * 128 + n * 16, acc[ai][bj][m][n] * rs);
                    else ss += epi_apply<EK>(P, row, cbase + bj * 128 + n * 16, acc[ai][bj][m][n]);
                }
            if constexpr (EK == E_OUT || EK == E_MO || EK == E_DOWN) {
                ss += __shfl_xor(ss, 16); ss += __shfl_xor(ss, 32);
                if (fq == 0) unsafeAtomicAdd((float*)(P->ws + (EK == E_OUT ? W_SS1 : EK == E_MO ? W_SS2 : W_SS3)) + row, ss);
            }
        }
}

struct PhaseCfg { const char* A; const char* B; int lda, ldb, K, nbig, nsmall, ncol64, ekind; };
__device__ __forceinline__ PhaseCfg phase_cfg(PP P, int gp) {
    const char* ws = P->ws; PhaseCfg c;
    switch (gp) {
    case 1:  c.A = ws + W_H;      c.B = ws + W_WIN;   c.lda = 1024; c.ldb = 1024; c.K = 1024; c.nbig = 66 * 14 + 64; c.nsmall = 0; c.ncol64 = 56; c.ekind = E_PROJ; break;
    case 3:  c.A = ws + W_POOLED; c.B = ws + W_WPOOL; c.lda = 1024; c.ldb = 256;  c.K = 256;  c.nbig = 256; c.nsmall = 256; c.ncol64 = 16; c.ekind = E_POOL; break;
    case 5:  c.A = ws + W_MIX;    c.B = ws + W_WOUT;  c.lda = 2048; c.ldb = 2048; c.K = 2048; c.nbig = 256; c.nsmall = 256; c.ncol64 = 16; c.ekind = E_OUT; break;
    case 7:  c.A = ws + W_H;      c.B = ws + W_WMQ;   c.lda = 1024; c.ldb = 1024; c.K = 1024; c.nbig = 256; c.nsmall = 256; c.ncol64 = 16; c.ekind = E_Q; break;
    case 8:  c.A = ws + W_Q;      c.B = ws + W_KB;    c.lda = 1024; c.ldb = 1024; c.K = 256;  c.nbig = 256; c.nsmall = 0;   c.ncol64 = 16; c.ekind = E_QK; break;
    case 9:  c.A = ws + W_P;      c.B = ws + W_VT;    c.lda = 1024; c.ldb = 256;  c.K = 256;  c.nbig = 256; c.nsmall = 0;   c.ncol64 = 16; c.ekind = E_PV; break;
    case 10: c.A = ws + W_O;      c.B = ws + W_WMO;   c.lda = 1024; c.ldb = 1024; c.K = 1024; c.nbig = 256; c.nsmall = 256; c.ncol64 = 16; c.ekind = E_MO; break;
    case 12: c.A = ws + W_H;      c.B = ws + W_WUP;   c.lda = 1024; c.ldb = 1024; c.K = 1024; c.nbig = 66 * 22; c.nsmall = 0; c.ncol64 = 88; c.ekind = E_UP; break;
    default: c.A = ws + W_ACT;    c.B = ws + W_WDOWN; c.lda = 2816; c.ldb = 2816; c.K = 2816; c.nbig = 256; c.nsmall = 256; c.ncol64 = 16; c.ekind = E_DOWN; break;
    }
    return c;
}
struct UnitD { const char* A; const char* B; int row0, col0, ekind; };
__device__ __forceinline__ void map_unit(int L, int nM, int nN, int& pm, int& pn) {
    const int nwg = nM * nN, q = nwg >> 3, r = nwg & 7, xcd = L & 7, off = L >> 3;
    const int wgid = (xcd < r ? xcd * (q + 1) : r * (q + 1) + (xcd - r) * q) + off;
    const int nig = 8 * nN, gid = wgid / nig, fm = gid * 8, gsz = (nM - fm) < 8 ? (nM - fm) : 8;
    const int w = wgid - gid * nig;
    pm = fm + w % gsz; pn = w / gsz;
}
__device__ __forceinline__ UnitD unit_decode(PP P, const PhaseCfg& c, int gp, int L) {
    UnitD d; d.ekind = c.ekind;
    int pm, pn;
    switch (gp) {
    case 1:
        if (L < 924) { map_unit(L, 66, 14, pm, pn); d.A = c.A + (size_t)pm * 256 * 2048; d.B = c.B + (size_t)pn * 256 * 2048; }
        else { map_unit(L - 924, 8, 8, pm, pn); d.A = P->ws + W_HM + (size_t)pm * 256 * 2048; d.B = P->ws + W_WMK + (size_t)pn * 256 * 2048; d.ekind = E_MEMKV; }
        break;
    case 3: map_unit(L, 64, 4, pm, pn); d.A = c.A + (size_t)pm * 256 * 2048 + pn * 512; d.B = c.B + (size_t)pn * 131072; break;
    case 8: map_unit(L, 64, 4, pm, pn); d.A = c.A + (size_t)pm * 256 * 2048 + pn * 512; d.B = c.B + (size_t)(pm >> 3) * 256 * 2048 + pn * 512; break;
    case 9: map_unit(L, 64, 4, pm, pn); d.A = c.A + (size_t)pm * 256 * 2048 + pn * 512; d.B = c.B + (size_t)((pm >> 3) * 4 + pn) * 131072; break;
    case 12: map_unit(L, 66, 22, pm, pn); d.A = c.A + (size_t)pm * 256 * 2048; d.B = c.B + (size_t)pn * 256 * 2048; break;
    default: map_unit(L, 64, 4, pm, pn); d.A = c.A + (size_t)pm * 256 * c.lda * 2; d.B = c.B + (size_t)pn * 256 * c.ldb * 2; break;
    }
    d.row0 = pm * 256; d.col0 = pn * 256;
    return d;
}

__device__ __forceinline__ void gemm_phase(PP P, int gp, char* shm_g, int lb, int blk, int nblk, const int tid) {
    LDSB unsigned char* lds = (LDSB unsigned char*)shm_g;
    const int wid = __builtin_amdgcn_readfirstlane(tid >> 6), lane = tid & 63, wr = wid >> 2, wc = wid & 3, fr = lane & 15, fq = lane >> 4;
    const PhaseCfg cfg = phase_cfg(P, gp);
    const int K = cfg.K, nt = K / 64;
    unsigned voffA, voffB;
    { int R, C; stage_rc(tid * 16, R, C); voffA = (unsigned)(R * cfg.lda + C) * 2u; voffB = (unsigned)(R * cfg.ldb + C) * 2u; }
    const size_t qstepvoffA = (size_t)64 * cfg.lda * 2, qstepvoffB = (size_t)64 * cfg.ldb * 2;
    const size_t kstep = 128;
    const size_t hstepA = (size_t)128 * cfg.lda * 2, hstepB = (size_t)128 * cfg.ldb * 2;
    const unsigned ldsw = (unsigned)wid * 1024u;
    const int aoff = lds_byte(wr * 64 + fr, fq * 8), boff = lds_byte(wc * 32 + fr, fq * 8);
    const bool chain = (cfg.ekind != E_QK);
#define G_SA(b, h) (((b) * 2 + (h)) * HTB)
#define G_SB(b, h) ((4 + (b) * 2 + (h)) * HTB)
#define G_STAGE(bufoff, gbase, voff) do { \
        __builtin_amdgcn_global_load_lds((const unsigned*)((const char*)(gbase) + (voff)), (LDSB unsigned*)(lds + (bufoff) + ldsw), 16, 0, 0); \
        __builtin_amdgcn_global_load_lds((const unsigned*)((const char*)(gbase) + qstep##voff + (voff)), (LDSB unsigned*)(lds + (bufoff) + ldsw + 8192), 16, 0, 0); } while (0)
#define G_LDA(dst, b, h) do { _Pragma("unroll") for (int m = 0; m < 4; ++m) _Pragma("unroll") for (int k = 0; k < 2; ++k) dst[m][k] = *(const LDSB bf16x8*)(lds + G_SA(b, h) + aoff + m * 2048 + k * 1024); } while (0)
#define G_LDB(dst, b, h) do { _Pragma("unroll") for (int n = 0; n < 2; ++n) _Pragma("unroll") for (int k = 0; k < 2; ++k) dst[n][k] = *(const LDSB bf16x8*)(lds + G_SB(b, h) + boff + n * 2048 + k * 1024); } while (0)
#define G_MMA(ai, bj, Af, Bf) do { __builtin_amdgcn_s_setprio(1); _Pragma("unroll") for (int m = 0; m < 4; ++m) _Pragma("unroll") for (int n = 0; n < 2; ++n) _Pragma("unroll") for (int k = 0; k < 2; ++k) \
        acc[ai][bj][m][n] = __builtin_amdgcn_mfma_f32_16x16x32_bf16(Bf[n][k], Af[m][k], acc[ai][bj][m][n], 0, 0, 0); __builtin_amdgcn_s_setprio(0); } while (0)
#define G_WAIT_V(n) asm volatile("s_waitcnt vmcnt(" #n ")" ::: "memory")
#define G_WAIT_L(n) asm volatile("s_waitcnt lgkmcnt(" #n ")" ::: "memory")
#define G_BAR __builtin_amdgcn_s_barrier()
#define G_SCHED __builtin_amdgcn_sched_barrier(0)
    int u = blk;
    while (u < cfg.nbig) {
        UnitD cur = unit_decode(P, cfg, gp, u);
        f32x4 acc[2][2][4][2];
#pragma unroll
        for (int a = 0; a < 2; ++a)
#pragma unroll
            for (int b = 0; b < 2; ++b)
#pragma unroll
                for (int m = 0; m < 4; ++m)
#pragma unroll
                    for (int n = 0; n < 2; ++n) acc[a][b][m][n] = (f32x4){0.f, 0.f, 0.f, 0.f};
        bf16x8 At[4][2], B0[2][2], B1[2][2];
        const char* cA = cur.A; const char* cB = cur.B;
        G_STAGE(G_SB(0, 0), cB, voffB); G_STAGE(G_SA(0, 0), cA, voffA); G_STAGE(G_SB(0, 1), cB + hstepB, voffB); G_STAGE(G_SA(0, 1), cA + hstepA, voffA);
        if (wr == 1) G_BAR;
        G_WAIT_V(4); G_BAR;
        G_STAGE(G_SB(1, 0), cB + kstep, voffB); G_STAGE(G_SA(1, 0), cA + kstep, voffA); G_STAGE(G_SB(1, 1), cB + hstepB + kstep, voffB);
        G_WAIT_V(6); G_BAR;
        for (;;) {
            const bool has_next = chain && (u + nblk < cfg.nbig);
            UnitD nxt = cur;
            if (has_next) nxt = unit_decode(P, cfg, gp, u + nblk);
            const char* nA = nxt.A; const char* nB = nxt.B;
            for (int t = 0; t < nt; t += 2) {
                const bool last = (t == nt - 2);
                const char* a1 = cA + (size_t)(t + 1) * kstep;
                const char* a2 = last ? nA : cA + (size_t)(t + 2) * kstep; const char* b2 = last ? nB : cB + (size_t)(t + 2) * kstep;
                const char* a3 = a2 + kstep; const char* b3 = b2 + kstep;
                G_LDB(B0, 0, 0); G_SCHED; G_LDA(At, 0, 0); G_STAGE(G_SA(1, 1), a1 + hstepA, voffA);
                G_WAIT_L(8); G_BAR; G_WAIT_L(0); G_MMA(0, 0, At, B0); G_BAR; G_SCHED;
                G_LDB(B1, 0, 1); G_STAGE(G_SB(0, 0), b2, voffB);
                G_BAR; G_WAIT_L(0); G_MMA(0, 1, At, B1); G_BAR;
                G_LDA(At, 0, 1); G_STAGE(G_SA(0, 0), a2, voffA);
                G_BAR; G_WAIT_L(0); G_MMA(1, 0, At, B0); G_BAR; G_SCHED;
                G_STAGE(G_SB(0, 1), b2 + hstepB, voffB);
                G_WAIT_V(6); G_BAR; G_MMA(1, 1, At, B1); G_BAR;
                G_LDB(B0, 1, 0); G_SCHED; G_LDA(At, 1, 0); G_STAGE(G_SA(0, 1), a2 + hstepA, voffA);
                G_WAIT_L(8); G_BAR; G_WAIT_L(0); G_MMA(0, 0, At, B0); G_BAR; G_SCHED;
                G_LDB(B1, 1, 1); G_STAGE(G_SB(1, 0), b3, voffB);
                G_BAR; G_WAIT_L(0); G_MMA(0, 1, At, B1); G_BAR;
                G_LDA(At, 1, 1); G_STAGE(G_SA(1, 0), a3, voffA);
                G_BAR; G_WAIT_L(0); G_MMA(1, 0, At, B0); G_BAR; G_SCHED;
                G_STAGE(G_SB(1, 1), b3 + hstepB, voffB);
                G_WAIT_V(6); G_BAR; G_MMA(1, 1, At, B1); G_BAR;
            }
            if (chain) {
                const int rbase = cur.row0 + wr * 64 + fr, cbase = cur.col0 + wc * 32 + fq * 4;
                switch (cur.ekind) {
                case E_PROJ: epi_loop<E_PROJ>(P, acc, rbase, cbase, fq); break;
                case E_MEMKV: epi_loop<E_MEMKV>(P, acc, rbase, cbase, fq); break;
                case E_POOL: epi_loop<E_POOL>(P, acc, rbase, cbase, fq); break;
                case E_OUT: epi_loop<E_OUT>(P, acc, rbase, cbase, fq); break;
                case E_Q: epi_loop<E_Q>(P, acc, rbase, cbase, fq); break;
                case E_PV: epi_loop<E_PV>(P, acc, rbase, cbase, fq); break;
                case E_MO: epi_loop<E_MO>(P, acc, rbase, cbase, fq); break;
                case E_UP: epi_loop<E_UP>(P, acc, rbase, cbase, fq); break;
                default: epi_loop<E_DOWN>(P, acc, rbase, cbase, fq); break;
                }
            }
            if (!has_next) break;
#pragma unroll
            for (int a = 0; a < 2; ++a)
#pragma unroll
                for (int b = 0; b < 2; ++b)
#pragma unroll
                    for (int m = 0; m < 4; ++m)
#pragma unroll
                        for (int n = 0; n < 2; ++n) acc[a][b][m][n] = (f32x4){0.f, 0.f, 0.f, 0.f};
            cur = nxt; cA = nA; cB = nB; u += nblk;
        }
        G_WAIT_V(0);
        if (wr == 0) G_BAR;
        G_BAR;
        if (!chain) {
            float* redm = (float*)(shm_g + 131072);
            float* reds = (float*)(shm_g + 135168);
#pragma unroll
            for (int ai = 0; ai < 2; ++ai)
#pragma unroll
                for (int m = 0; m < 4; ++m) {
                    float t = -3.0e38f;
#pragma unroll
                    for (int bj = 0; bj < 2; ++bj)
#pragma unroll
                        for (int n = 0; n < 2; ++n)
#pragma unroll
                            for (int j = 0; j < 4; ++j) t = fmaxf(t, acc[ai][bj][m][n][j]);
                    t = fmaxf(t, __shfl_xor(t, 16)); t = fmaxf(t, __shfl_xor(t, 32));
                    if (fq == 0) redm[(ai * 128 + wr * 64 + m * 16 + fr) * 4 + wc] = t;
                }
            __syncthreads();
#pragma unroll
            for (int ai = 0; ai < 2; ++ai)
#pragma unroll
                for (int m = 0; m < 4; ++m) {
                    const f32x4 r = *(const f32x4*)(redm + (ai * 128 + wr * 64 + m * 16 + fr) * 4);
                    const float M = fmaxf(fmaxf(r[0], r[1]), fmaxf(r[2], r[3]));
                    float s = 0.f;
#pragma unroll
                    for (int bj = 0; bj < 2; ++bj)
#pragma unroll
                        for (int n = 0; n < 2; ++n)
#pragma unroll
                            for (int j = 0; j < 4; ++j) { const float e = __expf(acc[ai][bj][m][n][j] - M); acc[ai][bj][m][n][j] = e; s += e; }
                    s += __shfl_xor(s, 16); s += __shfl_xor(s, 32);
                    if (fq == 0) reds[(ai * 128 + wr * 64 + m * 16 + fr) * 4 + wc] = s;
                }
            __syncthreads();
#pragma unroll
            for (int ai = 0; ai < 2; ++ai)
#pragma unroll
                for (int m = 0; m < 4; ++m) {
                    const int rl = ai * 128 + wr * 64 + m * 16 + fr;
                    const f32x4 r = *(const f32x4*)(reds + rl * 4);
                    const float inv = 1.0f / ((r[0] + r[1]) + (r[2] + r[3]));
                    bf16_t* prow = (bf16_t*)(P->ws + W_P) + (size_t)(cur.row0 + rl) * 1024 + cur.col0;
#pragma unroll
                    for (int bj = 0; bj < 2; ++bj)
#pragma unroll
                        for (int n = 0; n < 2; ++n) {
                            const f32x4 v = acc[ai][bj][m][n];
                            u32x2 o; o.x = pk2(v[0] * inv, v[1] * inv); o.y = pk2(v[2] * inv, v[3] * inv);
                            *(u32x2*)(prow + bj * 128 + wc * 32 + n * 16 + fq * 4) = o;
                        }
                }
            __syncthreads();
        }
        u += nblk;
    }
#undef G_SA
#undef G_SB
#undef G_STAGE
#undef G_LDA
#undef G_LDB
#undef G_MMA
    const int rot = cfg.nbig % nblk;
    for (int s0 = (lb - rot + nblk) % nblk; s0 < cfg.nsmall; s0 += nblk) {
        const int pr = s0 / cfg.ncol64, pc = s0 % cfg.ncol64;
        const int row0 = TP + pr * 32, col0 = pc * 64;
        const bf16_t* Ab = (const bf16_t*)cfg.A + (size_t)row0 * cfg.lda;
        const bf16_t* Bb;
        if (gp == 3) { const int g = pc >> 2; Ab += g * 256; Bb = (const bf16_t*)cfg.B + (size_t)g * 65536 + (size_t)(col0 - g * 256) * 256; }
        else Bb = (const bf16_t*)cfg.B + (size_t)col0 * cfg.ldb;
        const int kw = K >> 3, nks = kw >> 5;
        f32x4 acc[2][4];
#pragma unroll
        for (int mi = 0; mi < 2; ++mi)
#pragma unroll
            for (int ni = 0; ni < 4; ++ni) acc[mi][ni] = (f32x4){0.f, 0.f, 0.f, 0.f};
        const bf16_t* ap = Ab + (size_t)fr * cfg.lda + wid * kw + fq * 8;
        const bf16_t* bp = Bb + (size_t)fr * cfg.ldb + wid * kw + fq * 8;
        for (int ks0 = 0; ks0 < nks; ks0 += 4) {
            bf16x8 a[4][2], b[4][4];
#pragma unroll
            for (int q = 0; q < 4; ++q) {
                const bool ok = ks0 + q < nks;
#pragma unroll
                for (int mi = 0; mi < 2; ++mi) { bf16x8 z = {0, 0, 0, 0, 0, 0, 0, 0}; if (ok) z = *(const bf16x8*)(ap + (size_t)mi * 16 * cfg.lda + (ks0 + q) * 32); a[q][mi] = z; }
#pragma unroll
                for (int ni = 0; ni < 4; ++ni) { bf16x8 z = {0, 0, 0, 0, 0, 0, 0, 0}; if (ok) z = *(const bf16x8*)(bp + (size_t)ni * 16 * cfg.ldb + (ks0 + q) * 32); b[q][ni] = z; }
            }
#pragma unroll
            for (int q = 0; q < 4; ++q)
#pragma unroll
                for (int mi = 0; mi < 2; ++mi)
#pragma unroll
                    for (int ni = 0; ni < 4; ++ni) acc[mi][ni] = __builtin_amdgcn_mfma_f32_16x16x32_bf16(b[q][ni], a[q][mi], acc[mi][ni], 0, 0, 0);
        }
        float* red = (float*)shm_g;
#pragma unroll
        for (int mi = 0; mi < 2; ++mi)
#pragma unroll
            for (int ni = 0; ni < 4; ++ni) *(f32x4*)(red + wid * 2048 + (mi * 16 + fr) * 64 + ni * 16 + fq * 4) = acc[mi][ni];
        __syncthreads();
        {
            const int r = tid >> 4, c = (tid & 15) * 4;
            f32x4 v = *(const f32x4*)(red + r * 64 + c);
#pragma unroll
            for (int w = 1; w < 8; ++w) v += *(const f32x4*)(red + w * 2048 + r * 64 + c);
            float ss = epi_apply_rt(P, cfg.ekind, row0 + r, col0 + c, v);
            if (cfg.ekind == E_OUT || cfg.ekind == E_MO || cfg.ekind == E_DOWN) {
                ss += __shfl_xor(ss, 1); ss += __shfl_xor(ss, 2); ss += __shfl_xor(ss, 4); ss += __shfl_xor(ss, 8);
                if ((tid & 15) == 0) unsafeAtomicAdd((float*)(P->ws + (cfg.ekind == E_OUT ? W_SS1 : cfg.ekind == E_MO ? W_SS2 : W_SS3)) + row0 + r, ss);
            }
        }
        __syncthreads();
    }
}

__device__ __forceinline__ void tr_tile(const float* __restrict__ src, int ld_src, bf16_t* __restrict__ dst, int ld_dst, int k0, int n0s, int n0d, float* tile, const int tid, const float* __restrict__ gain = nullptr) {
    { const int kr = tid >> 4, nc = (tid & 15) * 4;
#pragma unroll
      for (int i = 0; i < 2; ++i) { const int k = kr + i * 32; f32x4 v = *(const f32x4*)(src + (size_t)(k0 + k) * ld_src + n0s + nc); if (gain) v *= gain[k0 + k];
          tile[k * 65 + nc + 0] = v[0]; tile[k * 65 + nc + 1] = v[1]; tile[k * 65 + nc + 2] = v[2]; tile[k * 65 + nc + 3] = v[3]; } }
    __syncthreads();
    { const int n = tid >> 3, k8 = (tid & 7) * 8; float f[8];
#pragma unroll
      for (int e = 0; e < 8; ++e) f[e] = tile[(k8 + e) * 65 + n];
      *(u32x4*)(dst + (size_t)(n0d + n) * ld_dst + k0 + k8) = pack8(f); }
    __syncthreads();
}

__device__ __forceinline__ void phase_prep(PP P, char* shm, int blk, int nblk, const int tid) {
    const int wid = tid >> 6, lane = tid & 63;
    float* tile = (float*)shm;
    float* wdt = (float*)(shm + 32768);
    for (int i = blk * NTHR + tid; i < 3 * TT; i += nblk * NTHR) ((float*)(P->ws + W_SS1))[i] = 0.f;
    for (int i = tid; i < 1024 * 16; i += NTHR) { const int k = i >> 4, hd = i & 15; wdt[hd * 1024 + k] = P->w_in[(size_t)k * 3600 + 2560 + hd]; }
    __syncthreads();
    char* ws = P->ws;
    for (int it = blk; it < TT / 8 + 2048 / 8; it += nblk) {
        const bool ismem = it >= TT / 8;
        const int row = (ismem ? it - TT / 8 : it) * 8 + wid;
        const float* xr = ismem ? P->mem_prompt + (size_t)row * 1024 : (row < TP ? P->x_prompt + (size_t)row * 1024 : P->x_sample + (size_t)(row - TP) * 1024);
        const float* gg = ismem ? P->norm_memkv : P->norm_mix;
        bf16_t* orow = (bf16_t*)(ws + (ismem ? W_HM : W_H)) + (size_t)row * 1024;
        f32x4 xv[4]; float ss = 0.f;
#pragma unroll
        for (int j = 0; j < 4; ++j) { xv[j] = *(const f32x4*)(xr + j * 256 + lane * 4); ss += xv[j][0] * xv[j][0] + xv[j][1] * xv[j][1] + xv[j][2] * xv[j][2] + xv[j][3] * xv[j][3]; }
        ss = wave_sum(ss);
        const float rstd = rsqrtf(ss * (1.0f / 1024.0f) + EPS);
#pragma unroll
        for (int j = 0; j < 4; ++j) { const f32x4 g4 = *(const f32x4*)(gg + j * 256 + lane * 4); xv[j] = xv[j] * rstd * g4;
            u32x2 o; o.x = pk2(xv[j][0], xv[j][1]); o.y = pk2(xv[j][2], xv[j][3]); *(u32x2*)(orow + j * 256 + lane * 4) = o; }
        if (!ismem) {
            float mine = 0.f;
#pragma unroll
            for (int hd = 0; hd < 16; ++hd) {
                float acc = 0.f;
#pragma unroll
                for (int j = 0; j < 4; ++j) { const f32x4 w4 = *(const f32x4*)(wdt + hd * 1024 + j * 256 + lane * 4); acc += xv[j][0] * w4[0] + xv[j][1] * w4[1] + xv[j][2] * w4[2] + xv[j][3] * w4[3]; }
                acc = wave_sum(acc);
                if (lane == hd) mine = acc;
            }
            if (lane < 16) { const float x = mine + P->dt_bias[lane]; const float ey = __expf(-fabsf(x)); const float l1p = ey < 0.03f ? ey * (1.0f - ey * (0.5f - ey * (0.33333333f - 0.25f * ey))) : __logf(1.0f + ey); const float sp = fmaxf(x, 0.f) + l1p; ((float*)(ws + W_DT))[(size_t)row * 16 + lane] = sp; }
        }
    }
    __syncthreads();
    for (int it = blk; it < 4608; it += nblk) {
        int i = it;
        if (i < 896) { const int kt = i / 56, ntl = i % 56; const int n0d = ntl * 64; const int n0s = n0d < 2560 ? n0d : n0d + 16; tr_tile(P->w_in, 3600, (bf16_t*)(ws + W_WIN), 1024, kt * 64, n0s, n0d, tile, tid); continue; }
        i -= 896;
        if (i < 64) { const int g = i >> 4, kt = (i >> 2) & 3, ntl = i & 3; tr_tile(P->w_pool + (size_t)g * 65536, 256, (bf16_t*)(ws + W_WPOOL) + (size_t)g * 65536, 256, kt * 64, ntl * 64, ntl * 64, tile, tid); continue; }
        i -= 64;
        if (i < 512) { const int kt = i >> 4, ntl = i & 15; tr_tile(P->w_out, 1024, (bf16_t*)(ws + W_WOUT), 2048, kt * 64, ntl * 64, ntl * 64, tile, tid); continue; }
        i -= 512;
        if (i < 1024) { const int wsel = i >> 8, r = i & 255, kt = r >> 4, ntl = r & 15;
            const float* src = wsel == 0 ? P->w_mq : wsel == 1 ? P->w_mk : wsel == 2 ? P->w_mv : P->w_mo;
            bf16_t* dst = (bf16_t*)(ws + (wsel == 0 ? W_WMQ : wsel == 1 ? W_WMK : wsel == 2 ? W_WMV : W_WMO));
            tr_tile(src, 1024, dst, 1024, kt * 64, ntl * 64, ntl * 64, tile, tid, wsel == 0 ? P->norm_mem : nullptr); continue; }
        i -= 1024;
        if (i < 1408) { const int kt = i / 88, ntl = i % 88; tr_tile(P->w_up, 5632, (bf16_t*)(ws + W_WUP), 1024, kt * 64, ntl * 64, ntl * 64, tile, tid, P->norm_ffn); continue; }
        i -= 1408;
        { const int kt = i >> 4, ntl = i & 15; tr_tile(P->w_down, 1024, (bf16_t*)(ws + W_WDOWN), 2816, kt * 64, ntl * 64, ntl * 64, tile, tid); }
    }
}

__device__ __forceinline__ u32x4 ld8(const bf16_t* p) { return *(const u32x4*)p; }

__device__ __forceinline__ void phase_convpool(PP P, int gtid, int nthreads) {
    char* ws = P->ws;
    const bf16_t* proj2 = (const bf16_t*)(ws + W_PROJ2);
    bf16_t* xact = (bf16_t*)(ws + W_XACT);
    bf16_t* pooled = (bf16_t*)(ws + W_POOLED);
    for (int idx = gtid; idx < 1152 * 320; idx += nthreads) {
        const int run = idx / 320, cg = idx % 320;
        const bool samp = run >= 1024;
        int t0, len, bidx, tl0;
        if (!samp) { t0 = run * 16; len = 16; bidx = t0 >> 11; tl0 = t0 & 2047; } else { bidx = run - 1024; t0 = TP + bidx * 4; len = 4; tl0 = 0; }
        if (cg < 192) {
            const int c0 = cg * 8;
            float w0[8], w1[8], w2[8], w3[8], bs[8], h0[8], h1[8], h2[8];
#pragma unroll
            for (int e = 0; e < 8; ++e) { w0[e] = P->conv_w[c0 + e]; w1[e] = P->conv_w[1536 + c0 + e]; w2[e] = P->conv_w[3072 + c0 + e]; w3[e] = P->conv_w[4608 + c0 + e]; bs[e] = P->conv_b[c0 + e]; }
            if (samp) {
#pragma unroll
                for (int e = 0; e < 8; ++e) { h0[e] = P->state_conv[(size_t)(bidx * 3 + 0) * 1536 + c0 + e]; h1[e] = P->state_conv[(size_t)(bidx * 3 + 1) * 1536 + c0 + e]; h2[e] = P->state_conv[(size_t)(bidx * 3 + 2) * 1536 + c0 + e]; }
            } else if (tl0 > 0) {
                unpack8(ld8(proj2 + (size_t)(t0 - 3) * 2560 + c0), h0); unpack8(ld8(proj2 + (size_t)(t0 - 2) * 2560 + c0), h1); unpack8(ld8(proj2 + (size_t)(t0 - 1) * 2560 + c0), h2);
            } else {
#pragma unroll
                for (int e = 0; e < 8; ++e) { h0[e] = 0.f; h1[e] = 0.f; h2[e] = 0.f; }
            }
            u32x4 rx[16];
#pragma unroll
            for (int j = 0; j < 16; ++j) { if (j < len) rx[j] = ld8(proj2 + (size_t)(t0 + j) * 2560 + c0); }
#pragma unroll
            for (int j = 0; j < 16; ++j) {
                if (j < len) {
                float x3[8], y[8]; unpack8(rx[j], x3);
#pragma unroll
                for (int e = 0; e < 8; ++e) { const float v = bs[e] + w0[e] * h0[e] + w1[e] * h1[e] + w2[e] * h2[e] + w3[e] * x3[e]; y[e] = silu_f(v); }
                *(u32x4*)(xact + (size_t)(t0 + j) * 1536 + c0) = pack8(y);
                if (samp) { if (j >= 1) { float* o = P->out + O_CONVS + (size_t)(bidx * 3 + j - 1) * 1536 + c0;
#pragma unroll
                        for (int e = 0; e < 8; ++e) o[e] = x3[e]; } }
                else { const int tl = tl0 + j; if (tl >= 2045) { float* o = P->out + O_CONVP + (size_t)(bidx * 3 + tl - 2045) * 1536 + c0;
#pragma unroll
                        for (int e = 0; e < 8; ++e) o[e] = x3[e]; } }
#pragma unroll
                for (int e = 0; e < 8; ++e) { h0[e] = h1[e]; h1[e] = h2[e]; h2[e] = x3[e]; }
                }
            }
        } else {
            const int c0 = (cg - 192) * 8; const int win = 2 << (c0 >> 8);
            const bf16_t* vp = proj2 + 1536 + c0;
            const float* prev = P->state_pool + (size_t)bidx * 15 * 1024 + c0;
            float sum[8];
#pragma unroll
            for (int e = 0; e < 8; ++e) sum[e] = 0.f;
            if (samp) {
                for (int jj = 1; jj < win; ++jj) {
#pragma unroll
                    for (int e = 0; e < 8; ++e) sum[e] += prev[(size_t)(15 - jj) * 1024 + e]; }
                float* o = P->out + O_POOLS + (size_t)bidx * 15 * 1024 + c0;
                for (int i = 0; i < 11; ++i) {
#pragma unroll
                    for (int e = 0; e < 8; ++e) o[(size_t)i * 1024 + e] = prev[(size_t)(i + 4) * 1024 + e]; }
            } else if (tl0 > 0) {
                for (int jj = 1; jj < win; ++jj) { float v[8]; unpack8(ld8(vp + (size_t)(t0 - jj) * 2560), v);
#pragma unroll
                    for (int e = 0; e < 8; ++e) sum[e] += v[e]; }
            }
            u32x4 rp[16];
#pragma unroll
            for (int j = 0; j < 16; ++j) { if (j < len) rp[j] = ld8(vp + (size_t)(t0 + j) * 2560); }
#pragma unroll
            for (int j = 0; j < 16; ++j) {
                if (j >= len) continue;
                float v[8], o8[8]; unpack8(rp[j], v);
                const int tl = tl0 + j;
                const float inv = 1.0f / (float)(samp ? win : (tl + 1 < win ? tl + 1 : win));
#pragma unroll
                for (int e = 0; e < 8; ++e) { sum[e] += v[e]; o8[e] = sum[e] * inv - v[e]; }
                *(u32x4*)(pooled + (size_t)(t0 + j) * 1024 + c0) = pack8(o8);
                const int to = j - win + 1;
                if (samp) {
                    if (to >= 0) { float q[8]; unpack8(ld8(vp + (size_t)(t0 + to) * 2560), q);
#pragma unroll
                        for (int e = 0; e < 8; ++e) sum[e] -= q[e]; }
                    else {
#pragma unroll
                        for (int e = 0; e < 8; ++e) sum[e] -= prev[(size_t)(15 + to) * 1024 + e]; }
                    float* o = P->out + O_POOLS + (size_t)(bidx * 15 + 11 + j) * 1024 + c0;
#pragma unroll
                    for (int e = 0; e < 8; ++e) o[e] = v[e];
                } else {
                    if (tl0 + to >= 0) { float q[8]; unpack8(ld8(vp + (size_t)(t0 + to) * 2560), q);
#pragma unroll
                        for (int e = 0; e < 8; ++e) sum[e] -= q[e]; }
                    if (tl >= 2033) { float* o = P->out + O_POOLP + (size_t)(bidx * 15 + tl - 2033) * 1024 + c0;
#pragma unroll
                        for (int e = 0; e < 8; ++e) o[e] = v[e]; }
                }
            }
        }
    }
}

constexpr int CS_STR = 136;
constexpr int X_STR = 40;
__device__ __forceinline__ s16x4 tr_read(const bf16_t* p) { return __builtin_bit_cast(s16x4, __builtin_amdgcn_ds_read_tr16_b64_v4i16((LDSB s16x4*)p)); }

#define LDS_BARRIER() asm volatile("s_waitcnt lgkmcnt(0)\n\ts_barrier" ::: "memory")
__device__ __forceinline__ void ssd_prompt(PP P, int item, char* shm, const int tid) {
    const int w = tid >> 6, lane = tid & 63, fr = lane & 15, fq = lane >> 4;
    const int b = item >> 5, hd = (item >> 1) & 15, ph = item & 1, g = hd >> 3;
    const float a = -expf(P->a_log[hd]);
    const float Dh = P->ssm_d[hd];
    char* ws = P->ws;
    const bf16_t* xact = (const bf16_t*)(ws + W_XACT);
    const float* dtb = (const float*)(ws + W_DT);
    bf16_t* ybuf = (bf16_t*)(ws + W_Y);
    bf16_t* Cs = (bf16_t*)(shm);
    bf16_t* Bs = (bf16_t*)(shm + 34816);
    bf16_t* Gs = (bf16_t*)(shm + 69632);
    bf16_t* Xd = (bf16_t*)(shm + 104448);
    bf16_t* X2 = (bf16_t*)(shm + 104448 + 10240);
    bf16_t* Hs = (bf16_t*)(shm + 124928);
    float* acs = (float*)(shm + 133632);
    float* dts = (float*)(shm + 134144);
    f32x4 Hacc[2];
    Hacc[0] = (f32x4){0.f, 0.f, 0.f, 0.f}; Hacc[1] = (f32x4){0.f, 0.f, 0.f, 0.f};
    const int q4 = fr >> 2, p4 = fr & 3;
    u32x4 pc[4], pb[4], px; float pd0, pd1;
    const int ls = tid >> 4, ln8 = (tid & 15) * 8;
    const int xs = tid >> 2, xp8 = (tid & 3) * 8;
#define SSD_PREFETCH(cc) do { const int _t0 = b * 2048 + (cc) * 128; \
        _Pragma("unroll") for (int i = 0; i < 4; ++i) { const bf16_t* src = xact + (size_t)(_t0 + ls + i * 32) * 1536 + g * 128 + ln8; pc[i] = *(const u32x4*)(src + 1280); pb[i] = *(const u32x4*)(src + 1024); } \
        px = *(const u32x4*)(xact + (size_t)(_t0 + xs) * 1536 + hd * 64 + ph * 32 + xp8); \
        pd0 = dtb[(size_t)(_t0 + 2 * lane) * 16 + hd]; pd1 = dtb[(size_t)(_t0 + 2 * lane + 1) * 16 + hd]; } while (0)
    SSD_PREFETCH(0);
    for (int c = 0; c < 16; ++c) {
        const int t0 = b * 2048 + c * 128;
        if (w == 0) {
            const float d0 = pd0, d1 = pd1;
            const float s = (d0 + d1) * a; float v = s;
#pragma unroll
            for (int off = 1; off < 64; off <<= 1) { const float t = __shfl_up(v, off); if (lane >= off) v += t; }
            const float excl = v - s;
            acs[2 * lane] = excl + d0 * a; acs[2 * lane + 1] = v; dts[2 * lane] = d0; dts[2 * lane + 1] = d1;
        }
#pragma unroll
        for (int pt = 0; pt < 2; ++pt)
#pragma unroll
            for (int j = 0; j < 4; ++j) Hs[(pt * 16 + fq * 4 + j) * CS_STR + w * 16 + fr] = f2bf(Hacc[pt][j]);
#pragma unroll
        for (int i = 0; i < 4; ++i) { *(u32x4*)(Cs + (ls + i * 32) * CS_STR + ln8) = pc[i]; *(u32x4*)(Bs + (ls + i * 32) * CS_STR + ln8) = pb[i]; }
        LDS_BARRIER();
        {
            float x[8], xa[8], xb[8]; unpack8(px, x);
            const float dtv = dts[xs], dec = __expf(acs[127] - acs[xs]) * dtv;
#pragma unroll
            for (int e = 0; e < 8; ++e) { xa[e] = x[e] * dtv; xb[e] = x[e] * dec; }
            *(u32x4*)(Xd + xs * X_STR + xp8) = pack8(xa);
            *(u32x4*)(X2 + xs * X_STR + xp8) = pack8(xb);
        }
        if (c < 15) SSD_PREFETCH(c + 1);
        bf16x8 Cf[4];
#pragma unroll
        for (int kk = 0; kk < 4; ++kk) Cf[kk] = *(const bf16x8*)(Cs + (w * 16 + fr) * CS_STR + kk * 32 + fq * 8);
        const int nst = (w | 1) + 1;
#pragma unroll
        for (int st = 0; st < 8; ++st) {
            if (st < nst) {
                f32x4 ga = (f32x4){0.f, 0.f, 0.f, 0.f};
#pragma unroll
                for (int kk = 0; kk < 4; ++kk) { const bf16x8 Bf = *(const bf16x8*)(Bs + (st * 16 + fr) * CS_STR + kk * 32 + fq * 8); ga = __builtin_amdgcn_mfma_f32_16x16x32_bf16(Cf[kk], Bf, ga, 0, 0, 0); }
                const int s = st * 16 + fr; const float as = acs[s];
#pragma unroll
                for (int j = 0; j < 4; ++j) { const int l = w * 16 + fq * 4 + j; const float val = (s <= l) ? ga[j] * __expf(acs[l] - as) : 0.f; Gs[l * CS_STR + s] = f2bf(val); }
            }
        }
        LDS_BARRIER();
        {
            f32x4 Yd[2], Yo[2];
            Yd[0] = Yd[1] = Yo[0] = Yo[1] = (f32x4){0.f, 0.f, 0.f, 0.f};
            const int nkk = (w >> 1) + 1;
#pragma unroll
            for (int kk = 0; kk < 4; ++kk) {
                if (kk < nkk) {
                    const bf16x8 Gf = *(const bf16x8*)(Gs + (w * 16 + fr) * CS_STR + kk * 32 + fq * 8);
#pragma unroll
                    for (int pt = 0; pt < 2; ++pt) {
                        const bf16_t* base = Xd + (kk * 32 + fq * 8 + q4) * X_STR + pt * 16 + p4 * 4;
                        bf16x8 Xf; Xf.lo = tr_read(base); Xf.hi = tr_read(base + 4 * X_STR);
                        Yd[pt] = __builtin_amdgcn_mfma_f32_16x16x32_bf16(Gf, Xf, Yd[pt], 0, 0, 0);
                    }
                }
            }
#pragma unroll
            for (int kk = 0; kk < 4; ++kk)
#pragma unroll
                for (int pt = 0; pt < 2; ++pt) { const bf16x8 Hf = *(const bf16x8*)(Hs + (pt * 16 + fr) * CS_STR + kk * 32 + fq * 8); Yo[pt] = __builtin_amdgcn_mfma_f32_16x16x32_bf16(Cf[kk], Hf, Yo[pt], 0, 0, 0); }
#pragma unroll
            for (int j = 0; j < 4; ++j) {
                const int l = w * 16 + fq * 4 + j; const float el = __expf(acs[l]); const float rdt = Dh / dts[l];
#pragma unroll
                for (int pt = 0; pt < 2; ++pt) {
                    const int pl = pt * 16 + fr;
                    const float xr = bf2f(Xd[l * X_STR + pl]);
                    ybuf[(size_t)(t0 + l) * 1024 + hd * 64 + ph * 32 + pl] = f2bf(Yd[pt][j] + el * Yo[pt][j] + rdt * xr);
                }
            }
        }
        {
            const float dc = __expf(acs[127]);
            Hacc[0] *= dc; Hacc[1] *= dc;
#pragma unroll
            for (int kk = 0; kk < 4; ++kk) {
                const bf16_t* bb = Bs + (kk * 32 + fq * 8 + q4) * CS_STR + w * 16 + p4 * 4;
                bf16x8 Bf; Bf.lo = tr_read(bb); Bf.hi = tr_read(bb + 4 * CS_STR);
#pragma unroll
                for (int pt = 0; pt < 2; ++pt) {
                    const bf16_t* xb = X2 + (kk * 32 + fq * 8 + q4) * X_STR + pt * 16 + p4 * 4;
                    bf16x8 Xf; Xf.lo = tr_read(xb); Xf.hi = tr_read(xb + 4 * X_STR);
                    Hacc[pt] = __builtin_amdgcn_mfma_f32_16x16x32_bf16(Xf, Bf, Hacc[pt], 0, 0, 0);
                }
            }
        }
        LDS_BARRIER();
    }
#undef SSD_PREFETCH
    float* so = P->out + O_SSMP + ((size_t)(b * 16 + hd) * 64 + ph * 32) * 128;
#pragma unroll
    for (int pt = 0; pt < 2; ++pt)
#pragma unroll
        for (int j = 0; j < 4; ++j) so[(size_t)(pt * 16 + fq * 4 + j) * 128 + w * 16 + fr] = Hacc[pt][j];
}

template <int NI>
__device__ __forceinline__ void ssd_sample(PP P, int item0, int istride, const int tid) {
    const int p = tid >> 3, n0 = (tid & 7) * 16;
    char* ws = P->ws;
    const bf16_t* xact = (const bf16_t*)(ws + W_XACT);
    const float* dtb = (const float*)(ws + W_DT);
    bf16_t* ybuf = (bf16_t*)(ws + W_Y);
    f32x4 hs[NI][4]; u32x4 rb[NI][4][2], rc[NI][4][2]; float xv[NI][4], dtv[NI][4];
#pragma unroll
    for (int q = 0; q < NI; ++q) {
        const int item = item0 + q * istride, b = item >> 4, hd = item & 15, g = hd >> 3;
        const size_t sidx = ((size_t)(b * 16 + hd) * 64 + p) * 128 + n0;
#pragma unroll
        for (int i = 0; i < 4; ++i) hs[q][i] = __builtin_nontemporal_load((const f32x4*)(P->state_ssm + sidx + i * 4));
#pragma unroll
        for (int i = 0; i < 4; ++i) {
            const int t = TP + b * 4 + i;
            xv[q][i] = bf2f(xact[(size_t)t * 1536 + hd * 64 + p]);
            dtv[q][i] = dtb[(size_t)t * 16 + hd];
            rb[q][i][0] = ld8(xact + (size_t)t * 1536 + 1024 + g * 128 + n0); rb[q][i][1] = ld8(xact + (size_t)t * 1536 + 1024 + g * 128 + n0 + 8);
            rc[q][i][0] = ld8(xact + (size_t)t * 1536 + 1280 + g * 128 + n0); rc[q][i][1] = ld8(xact + (size_t)t * 1536 + 1280 + g * 128 + n0 + 8);
        }
    }
#pragma unroll
    for (int q = 0; q < NI; ++q) {
        const int item = item0 + q * istride, b = item >> 4, hd = item & 15;
        const float a = -expf(P->a_log[hd]);
        const float Dh = P->ssm_d[hd];
        const size_t sidx = ((size_t)(b * 16 + hd) * 64 + p) * 128 + n0;
        float h[16];
#pragma unroll
        for (int i = 0; i < 4; ++i) { h[i * 4] = hs[q][i][0]; h[i * 4 + 1] = hs[q][i][1]; h[i * 4 + 2] = hs[q][i][2]; h[i * 4 + 3] = hs[q][i][3]; }
#pragma unroll
        for (int i = 0; i < 4; ++i) {
            const int t = TP + b * 4 + i;
            const float dA = __expf(dtv[q][i] * a), dx = dtv[q][i] * xv[q][i];
            float Bv[16], Cv[16];
            { float t8[8]; unpack8(rb[q][i][0], t8);
#pragma unroll
              for (int e = 0; e < 8; ++e) Bv[e] = t8[e];
              unpack8(rb[q][i][1], t8);
#pragma unroll
              for (int e = 0; e < 8; ++e) Bv[8 + e] = t8[e];
              unpack8(rc[q][i][0], t8);
#pragma unroll
              for (int e = 0; e < 8; ++e) Cv[e] = t8[e];
              unpack8(rc[q][i][1], t8);
#pragma unroll
              for (int e = 0; e < 8; ++e) Cv[8 + e] = t8[e]; }
            float part = 0.f;
#pragma unroll
            for (int e = 0; e < 16; ++e) { h[e] = h[e] * dA + dx * Bv[e]; part += h[e] * Cv[e]; }
            part += __shfl_xor(part, 1); part += __shfl_xor(part, 2); part += __shfl_xor(part, 4);
            if ((tid & 7) == 0) ybuf[(size_t)t * 1024 + hd * 64 + p] = f2bf(part + Dh * xv[q][i]);
        }
        float* so = P->out + O_SSMS + sidx;
#pragma unroll
        for (int i = 0; i < 4; ++i) __builtin_nontemporal_store((f32x4){h[i * 4], h[i * 4 + 1], h[i * 4 + 2], h[i * 4 + 3]}, (f32x4*)(so + i * 4));
    }
}

__device__ __forceinline__ void phase_gatednorm(PP P, int gw, int nw, const int tid) {
    const int lane = tid & 63;
    char* ws = P->ws;
    const bf16_t* ybuf = (const bf16_t*)(ws + W_Y); const bf16_t* zbuf = (const bf16_t*)(ws + W_Z);
    bf16_t* mix = (bf16_t*)(ws + W_MIX);
    for (int row = gw; row < TT; row += nw) {
        float t[4][4]; float ss0 = 0.f, ss1 = 0.f;
#pragma unroll
        for (int j = 0; j < 4; ++j) {
            const u32x2 yv = *(const u32x2*)(ybuf + (size_t)row * 1024 + j * 256 + lane * 4);
            const u32x2 zv = *(const u32x2*)(zbuf + (size_t)row * 1024 + j * 256 + lane * 4);
            const float y0 = bflo(yv.x), y1 = bfhi(yv.x), y2 = bflo(yv.y), y3 = bfhi(yv.y);
            const float z0 = bflo(zv.x), z1 = bfhi(zv.x), z2 = bflo(zv.y), z3 = bfhi(zv.y);
            t[j][0] = y0 * silu_f(z0); t[j][1] = y1 * silu_f(z1); t[j][2] = y2 * silu_f(z2); t[j][3] = y3 * silu_f(z3);
            const float q = t[j][0] * t[j][0] + t[j][1] * t[j][1] + t[j][2] * t[j][2] + t[j][3] * t[j][3];
            if (j < 2) ss0 += q; else ss1 += q;
        }
        ss0 = wave_sum(ss0); ss1 = wave_sum(ss1);
        const float r0 = rsqrtf(ss0 * (1.0f / 512.0f) + EPS), r1 = rsqrtf(ss1 * (1.0f / 512.0f) + EPS);
#pragma unroll
        for (int j = 0; j < 4; ++j) {
            const float r = j < 2 ? r0 : r1;
            const f32x4 g4 = *(const f32x4*)(P->ssm_norm + j * 256 + lane * 4);
            u32x2 o; o.x = pk2(t[j][0] * r * g4[0], t[j][1] * r * g4[1]); o.y = pk2(t[j][2] * r * g4[2], t[j][3] * r * g4[3]);
            *(u32x2*)(mix + (size_t)row * 2048 + j * 256 + lane * 4) = o;
        }
    }
}

__device__ __forceinline__ void phase_norm(PP P, const float* gain, bool final_out, int gw, int nw, const int tid) {
    const int lane = tid & 63;
    char* ws = P->ws;
    const bf16_t* hb = (const bf16_t*)(ws + W_H);
    const float* ss3 = (const float*)(ws + W_SS3);
    for (int row0 = gw; row0 < TT; row0 += 4 * nw) {
        u32x2 xv[4][4]; float sq[4];
#pragma unroll
        for (int r = 0; r < 4; ++r) { const int row = row0 + r * nw; if (row < TT) { sq[r] = ss3[row];
#pragma unroll
            for (int j = 0; j < 4; ++j) xv[r][j] = *(const u32x2*)(hb + (size_t)row * 1024 + j * 256 + lane * 4); } }
#pragma unroll
        for (int r = 0; r < 4; ++r) { const int row = row0 + r * nw; if (row < TT) {
            const float rstd = rsqrtf(sq[r] * (1.0f / 1024.0f) + EPS);
#pragma unroll
            for (int j = 0; j < 4; ++j) {
                const f32x4 g4 = *(const f32x4*)(gain + j * 256 + lane * 4);
                const f32x4 x = (f32x4){bflo(xv[r][j].x), bfhi(xv[r][j].x), bflo(xv[r][j].y), bfhi(xv[r][j].y)};
                __builtin_nontemporal_store(x * rstd * g4, (f32x4*)(P->out + O_YP + (size_t)row * 1024 + j * 256 + lane * 4));
            }
        } }
    }
}

__device__ __forceinline__ void attn_sample(PP P, int item, char* shm, const int tid) {
    const int w = tid >> 6, lane = tid & 63, fr = lane & 15, fq = lane >> 4;
    const int b = item >> 2, hh = item & 3;
    char* ws = P->ws;
    const bf16_t* qb = (const bf16_t*)(ws + W_Q);
    float* sc = (float*)shm;
    float* part = (float*)(shm + 4096);
    const float* vp = P->cache_v + ((size_t)(b * 256 + w * 32) * 4 + hh) * 256 + lane * 4;
    f32x4 v0[16], v1[16];
#pragma unroll
    for (int mm = 0; mm < 16; ++mm) v0[mm] = __builtin_nontemporal_load((const f32x4*)(vp + (size_t)mm * 1024));
    bf16x8 qf[8];
#pragma unroll
    for (int kk = 0; kk < 8; ++kk) {
        bf16x8 z = {0, 0, 0, 0, 0, 0, 0, 0};
        if (fr < 4) z = *(const bf16x8*)(qb + (size_t)(TP + b * 4 + fr) * 1024 + hh * 256 + kk * 32 + fq * 8);
        qf[kk] = z;
    }
#pragma unroll
    for (int mt = 0; mt < 2; ++mt) {
        const int key = w * 32 + mt * 16 + fr;
        const float* kp = P->cache_k + ((size_t)(b * 256 + key) * 4 + hh) * 256 + fq * 8;
        f32x4 k0[8], k1[8];
#pragma unroll
        for (int kk = 0; kk < 8; ++kk) { k0[kk] = __builtin_nontemporal_load((const f32x4*)(kp + kk * 32)); k1[kk] = __builtin_nontemporal_load((const f32x4*)(kp + kk * 32 + 4)); }
        f32x4 acc = (f32x4){0.f, 0.f, 0.f, 0.f};
#pragma unroll
        for (int kk = 0; kk < 8; ++kk) {
            u32x4 pk; pk.x = pk2(k0[kk][0], k0[kk][1]); pk.y = pk2(k0[kk][2], k0[kk][3]); pk.z = pk2(k1[kk][0], k1[kk][1]); pk.w = pk2(k1[kk][2], k1[kk][3]);
            acc = __builtin_amdgcn_mfma_f32_16x16x32_bf16(qf[kk], __builtin_bit_cast(bf16x8, pk), acc, 0, 0, 0);
        }
        if (fq == 0) {
#pragma unroll
            for (int j = 0; j < 4; ++j) sc[j * 256 + w * 32 + mt * 16 + fr] = acc[j];
        }
    }
    LDS_BARRIER();
#pragma unroll
    for (int mm = 0; mm < 16; ++mm) v1[mm] = __builtin_nontemporal_load((const f32x4*)(vp + (size_t)(16 + mm) * 1024));
    if (w < 4) {
        f32x4 s = *(const f32x4*)(sc + w * 256 + lane * 4);
        float m = fmaxf(fmaxf(s[0], s[1]), fmaxf(s[2], s[3])); m = wave_max(m);
        s[0] = __expf(s[0] - m); s[1] = __expf(s[1] - m); s[2] = __expf(s[2] - m); s[3] = __expf(s[3] - m);
        float su = (s[0] + s[1]) + (s[2] + s[3]); su = wave_sum(su);
        const float inv = 1.0f / su;
        *(f32x4*)(sc + w * 256 + lane * 4) = s * inv;
    }
    LDS_BARRIER();
    {
        f32x4 o[4];
#pragma unroll
        for (int i = 0; i < 4; ++i) o[i] = (f32x4){0.f, 0.f, 0.f, 0.f};
#pragma unroll
        for (int mm = 0; mm < 16; ++mm) {
#pragma unroll
            for (int i = 0; i < 4; ++i) o[i] += sc[i * 256 + w * 32 + mm] * v0[mm];
        }
#pragma unroll
        for (int mm = 0; mm < 16; ++mm) {
#pragma unroll
            for (int i = 0; i < 4; ++i) o[i] += sc[i * 256 + w * 32 + 16 + mm] * v1[mm];
        }
#pragma unroll
        for (int i = 0; i < 4; ++i) *(f32x4*)(part + (w * 4 + i) * 256 + lane * 4) = o[i];
    }
    LDS_BARRIER();
    {
        const int i = tid >> 7, d2 = (tid & 127) * 2;
        float s0 = 0.f, s1 = 0.f;
#pragma unroll
        for (int ww = 0; ww < 8; ++ww) { s0 += part[(ww * 4 + i) * 256 + d2]; s1 += part[(ww * 4 + i) * 256 + d2 + 1]; }
        *(unsigned*)((bf16_t*)(ws + W_O) + (size_t)(TP + b * 4 + i) * 1024 + hh * 256 + d2) = pk2(s0, s1);
    }
    LDS_BARRIER();
}

__device__ __forceinline__ void phase_ffnconv(PP P, int gtid, int nthreads) {
    char* ws = P->ws;
    const bf16_t* u = (const bf16_t*)(ws + W_U);
    bf16_t* act = (bf16_t*)(ws + W_ACT);
    for (int idx = gtid; idx < 1152 * 352; idx += nthreads) {
        const int run = idx / 352, cg = idx % 352;
        const bool samp = run >= 1024;
        int t0, len, bidx, tl0;
        if (!samp) { t0 = run * 16; len = 16; bidx = t0 >> 11; tl0 = t0 & 2047; } else { bidx = run - 1024; t0 = TP + bidx * 4; len = 4; tl0 = 0; }
        const int cgc = cg * 8, cvc = 2816 + cg * 8;
        float wg0[8], wg1[8], wg2[8], wv0[8], wv1[8], wv2[8], bg[8], bv[8], hg0[8], hg1[8], hv0[8], hv1[8];
#pragma unroll
        for (int e = 0; e < 8; ++e) {
            wg0[e] = P->ffn_w[cgc + e]; wg1[e] = P->ffn_w[5632 + cgc + e]; wg2[e] = P->ffn_w[11264 + cgc + e];
            wv0[e] = P->ffn_w[cvc + e]; wv1[e] = P->ffn_w[5632 + cvc + e]; wv2[e] = P->ffn_w[11264 + cvc + e];
            bg[e] = P->ffn_b[cgc + e]; bv[e] = P->ffn_b[cvc + e];
        }
        if (samp) {
#pragma unroll
            for (int e = 0; e < 8; ++e) {
                hg0[e] = P->state_ffn[(size_t)(bidx * 2 + 0) * 5632 + cgc + e]; hg1[e] = P->state_ffn[(size_t)(bidx * 2 + 1) * 5632 + cgc + e];
                hv0[e] = P->state_ffn[(size_t)(bidx * 2 + 0) * 5632 + cvc + e]; hv1[e] = P->state_ffn[(size_t)(bidx * 2 + 1) * 5632 + cvc + e];
            }
        } else if (tl0 > 0) {
            unpack8(ld8(u + (size_t)(t0 - 2) * 5632 + cgc), hg0); unpack8(ld8(u + (size_t)(t0 - 1) * 5632 + cgc), hg1);
            unpack8(ld8(u + (size_t)(t0 - 2) * 5632 + cvc), hv0); unpack8(ld8(u + (size_t)(t0 - 1) * 5632 + cvc), hv1);
        } else {
#pragma unroll
            for (int e = 0; e < 8; ++e) { hg0[e] = 0.f; hg1[e] = 0.f; hv0[e] = 0.f; hv1[e] = 0.f; }
        }
        for (int jb = 0; jb < len; jb += 8) {
        u32x4 rg[8], rv[8];
        const bf16_t* ub = u + (size_t)(t0 + jb) * 5632 + cgc;
#pragma unroll
        for (int jj = 0; jj < 8; ++jj) { if (jb + jj < len) { rg[jj] = ld8(ub + (size_t)jj * 5632); rv[jj] = ld8(ub + (size_t)jj * 5632 + 2816); } }
#pragma unroll
        for (int jj = 0; jj < 8; ++jj) {
            const int j = jb + jj;
            if (j < len) {
            float ug[8], uv[8], o8[8];
            unpack8(rg[jj], ug); unpack8(rv[jj], uv);
#pragma unroll
            for (int e = 0; e < 8; ++e) {
                const float gc = bg[e] + wg0[e] * hg0[e] + wg1[e] * hg1[e] + wg2[e] * ug[e];
                const float vc = bv[e] + wv0[e] * hv0[e] + wv1[e] * hv1[e] + wv2[e] * uv[e];
                o8[e] = silu_f(gc) * vc;
            }
            *(u32x4*)(act + (size_t)(t0 + j) * 2816 + cgc) = pack8(o8);
            float* o = nullptr;
            if (samp) { if (j >= 2) o = P->out + O_FFNS + (size_t)(bidx * 2 + j - 2) * 5632; }
            else { const int tl = tl0 + j; if (tl >= 2046) o = P->out + O_FFNP + (size_t)(bidx * 2 + tl - 2046) * 5632; }
            if (o) {
#pragma unroll
                for (int e = 0; e < 8; ++e) { o[cgc + e] = ug[e]; o[cvc + e] = uv[e]; }
            }
#pragma unroll
            for (int e = 0; e < 8; ++e) { hg0[e] = hg1[e]; hg1[e] = ug[e]; hv0[e] = hv1[e]; hv1[e] = uv[e]; }
            }
        }
        }
    }
}

#define XB_TMO      128
#define XB_XCNT(j)  (256  + 64 * (j))
#define XB_XSUB(j)  (1280 + 64 * (j))
#define XB_XGEN(j)  (2304 + 64 * (j))
#define XB_TOP      3328
#define XB_TOPGEN   3392
#define XCD_BAR_WORDS 3456
#define XB_SPIN_CAP (1u << 18)
__device__ __forceinline__ unsigned xb_ld(unsigned* p)              { return __hip_atomic_load(p, __ATOMIC_RELAXED, __HIP_MEMORY_SCOPE_AGENT); }
__device__ __forceinline__ unsigned xb_add(unsigned* p, unsigned v) { return __hip_atomic_fetch_add(p, v, __ATOMIC_RELAXED, __HIP_MEMORY_SCOPE_AGENT); }
__device__ __forceinline__ unsigned xb_xcc_id() { return (unsigned)__builtin_amdgcn_s_getreg((3 << 11) | 20) & 0xFu; }
#define XB_SPIN(cond, bar) do { unsigned _sp = 0; while (cond) { __builtin_amdgcn_s_sleep(1); \
    if ((++_sp & 255u) == 0u) { if (xb_ld(&(bar)[XB_TMO])) break; if (_sp > XB_SPIN_CAP) { atomicAdd(&(bar)[XB_TMO], 1u); break; } } } } while (0)
__device__ __forceinline__ void xcd_barrier_complete(unsigned* bar, unsigned x, unsigned& nloc, unsigned& nx) {
    const unsigned G = gridDim.x;
    unsigned sum, cnt, mine, sp = 0u;
    for (;;) {
        sum = 0u; cnt = 0u; mine = 0u;
#pragma unroll
        for (unsigned j = 0; j < 16; ++j) { const unsigned c = xb_ld(&bar[XB_XCNT(j)]); sum += c; cnt += (c > 0u) ? 1u : 0u; mine = (j == x) ? c : mine; }
        if (sum == G) break;
        __builtin_amdgcn_s_sleep(1);
        if ((++sp & 255u) == 0u) { if (xb_ld(&bar[XB_TMO])) break; if (sp > XB_SPIN_CAP) { atomicAdd(&bar[XB_TMO], 1u); break; } }
    }
    nloc = mine > 0u ? mine : 1u; nx = cnt > 0u ? cnt : 1u;
}
__device__ __forceinline__ void xcd_barrier(unsigned* bar, volatile LDSB unsigned* st, const int tid) {
    asm volatile("s_waitcnt vmcnt(0)" ::: "memory");
    __syncthreads();
    if (tid == 0) {
        const unsigned x = xb_xcc_id();
        __builtin_amdgcn_s_waitcnt(0);
        unsigned nloc = st[0], nx = st[1];
        if (nloc == 0u) { xcd_barrier_complete(bar, x, nloc, nx); st[0] = nloc; st[1] = nx; }
        const unsigned old = xb_add(&bar[XB_XSUB(x)], 1u);
        const unsigned gen = old / nloc;
        if (old + 1u == (gen + 1u) * nloc) {
            __builtin_amdgcn_fence(__ATOMIC_RELEASE, "agent");
            asm volatile("s_waitcnt vmcnt(0)" ::: "memory");
            const unsigned og = xb_add(&bar[XB_TOP], 1u);
            const unsigned tg = og / nx;
            if (og + 1u == (tg + 1u) * nx) xb_add(&bar[XB_TOPGEN], 1u);
            else XB_SPIN(xb_ld(&bar[XB_TOPGEN]) == tg, bar);
            __builtin_amdgcn_fence(__ATOMIC_ACQUIRE, "agent");
            xb_add(&bar[XB_XGEN(x)], 1u);
            asm volatile("s_waitcnt vmcnt(0)" ::: "memory");
        } else {
            XB_SPIN(xb_ld(&bar[XB_XGEN(x)]) == gen, bar);
            __builtin_amdgcn_fence(__ATOMIC_ACQUIRE, "agent");
            asm volatile("s_waitcnt vmcnt(0)" ::: "memory");
        }
    }
    __syncthreads();
}

extern __shared__ __attribute__((aligned(16))) char smem[];

__global__ void __launch_bounds__(NTHR) hybrid_fwd(Params Pin) {
    char* shm = smem;
    volatile LDSB unsigned* bst = (volatile LDSB unsigned*)(smem + 139264);
    if (threadIdx.x == 0) { bst[0] = 0u; bst[1] = 0u; (void)xb_add((unsigned*)(Pin.ws + W_BAR) + XB_XCNT(xb_xcc_id()), 1u); }
    __syncthreads();
    for (int ph = Pin.ph_lo; ph < Pin.ph_hi; ++ph) {
        if (ph == 6 || ph == 11) continue;
        const int reps = ((REPEAT_MASK >> ph) & 1) ? 2 : 1;
        for (int rep = 0; rep < reps; ++rep) {
        if (rep > 0) xcd_barrier((unsigned*)(Pin.ws + W_BAR), bst, threadIdx.x);
        int tid = threadIdx.x, blk = blockIdx.x, nblk = gridDim.x;
        asm volatile("" : "+v"(tid));
        asm volatile("" : "+s"(blk), "+s"(nblk));
        PP P = (PP)__builtin_amdgcn_kernarg_segment_ptr();
        asm volatile("" : "+s"(P));
        const int lb = (blk & 7) * (nblk >> 3) + (blk >> 3);
        const int gtid = blk * NTHR + tid, nthreads = nblk * NTHR;
        const int gw = blk * 8 + (tid >> 6), nw = nblk * 8;
        switch (ph) {
#if PHASE_MASK & 1
        case 0: phase_prep(P, shm, blk, nblk, tid); break;
#endif
#if PHASE_MASK & 4
        case 2: phase_convpool(P, gtid, nthreads); break;
#endif
#if PHASE_MASK & 8
        case 3:
            for (int r3 = 0; r3 < (PROBE3 == 1 ? 2 : 1); ++r3) { for (int it = blk; it < 256; it += nblk) ssd_prompt(P, it, shm, tid); }
            for (int r3 = 0; r3 < (PROBE3 == 2 ? 2 : 1); ++r3) { int it = blk; for (; it + nblk < 2048; it += 2 * nblk) ssd_sample<2>(P, it, nblk, tid); for (; it < 2048; it += nblk) ssd_sample<1>(P, it, nblk, tid); }
            break;
#endif
#if PHASE_MASK & 16
        case 4: phase_gatednorm(P, gw, nw, tid); break;
#endif
#if PHASE_MASK & 64
        case 6: phase_norm(P, P->norm_mem, false, gw, nw, tid); break;
        case 11: phase_norm(P, P->norm_ffn, false, gw, nw, tid); break;
        case 15: phase_norm(P, P->final_norm, true, gw, nw, tid); break;
#endif
#if PHASE_MASK & 8192
        case 13: phase_ffnconv(P, gtid, nthreads); break;
#endif
        default: break;
        }
#if PHASE_MASK & 2
        if (ph == 1 || ph == 3 || ph == 5 || ph == 7 || ph == 8 || ph == 9 || ph == 10 || ph == 12 || ph == 14) gemm_phase(P, ph, shm, lb, blk, nblk, tid);
#endif
#if PHASE_MASK & 256
        if (ph == 9) { for (int r3 = 0; r3 < (PROBE3 == 3 ? 2 : 1); ++r3) { for (int it = blk; it < 512; it += nblk) attn_sample(P, it, shm, tid); } }
#endif
        }
        if (ph + 1 < Pin.ph_hi && ph != 8) xcd_barrier((unsigned*)(Pin.ws + W_BAR), bst, threadIdx.x);
        if (ph == 8) { asm volatile("s_waitcnt vmcnt(0)" ::: "memory"); __syncthreads(); }
        if (EXTRA_SYNCS && ph == 0) { for (int i = 0; i < EXTRA_SYNCS; ++i) xcd_barrier((unsigned*)(Pin.ws + W_BAR), bst, threadIdx.x); }
    }
}

extern "C" void kernel_launch(void* const* d_in, const int* in_sizes, int n_in, void* d_out, int out_size, void* d_ws, size_t ws_size, hipStream_t stream) {
    static int grid_blocks = 0;
    if (!grid_blocks) {
        int dev = 0, cus = 0, per_cu = 0;
        hipGetDevice(&dev);
        hipDeviceGetAttribute(&cus, hipDeviceAttributeMultiprocessorCount, dev);
        hipFuncSetAttribute((const void*)hybrid_fwd, hipFuncAttributeMaxDynamicSharedMemorySize, LDS_BYTES);
        hipOccupancyMaxActiveBlocksPerMultiprocessor(&per_cu, hybrid_fwd, NTHR, LDS_BYTES);
        if (per_cu < 1) per_cu = 1;
        grid_blocks = cus * 1;
        grid_blocks &= ~7;
        if (grid_blocks < 8) grid_blocks = 8;
    }
    Params p{};
    const float* const* in = (const float* const*)d_in;
    p.x_prompt = in[0]; p.x_sample = in[1]; p.mem_prompt = in[2]; p.state_ssm = in[3]; p.state_conv = in[4]; p.state_pool = in[5]; p.state_ffn = in[6];
    p.cache_k = in[7]; p.cache_v = in[8]; p.norm_mix = in[9]; p.w_in = in[10]; p.conv_w = in[11]; p.conv_b = in[12]; p.dt_bias = in[13]; p.a_log = in[14];
    p.ssm_d = in[15]; p.ssm_norm = in[16]; p.w_pool = in[17]; p.pool_scale = in[18]; p.w_out = in[19]; p.norm_mem = in[20]; p.norm_memkv = in[21];
    p.w_mq = in[22]; p.w_mk = in[23]; p.w_mv = in[24]; p.w_mo = in[25]; p.norm_ffn = in[26]; p.w_up = in[27]; p.ffn_w = in[28]; p.ffn_b = in[29];
    p.w_down = in[30]; p.final_norm = in[31];
    p.out = (float*)d_out; p.ws = (char*)d_ws; p.ph_lo = 0; p.ph_hi = 16;
    hipMemsetAsync((char*)d_ws + W_BAR, 0, 16384, stream);
    void* args[] = {&p};
    hipError_t e = hipLaunchCooperativeKernel((const void*)hybrid_fwd, dim3(grid_blocks), dim3(NTHR), args, LDS_BYTES, stream);
    if (e != hipSuccess) fprintf(stderr, "cooperative launch failed: %s (grid %d)\n", hipGetErrorString(e), grid_blocks);
}
```

```cpp
#include <hip/hip_runtime.h>
#include <hip/hip_cooperative_groups.h>
#include <cstdio>
namespace cg = cooperative_groups;

typedef unsigned short bf16_t;
typedef short bf16x8 __attribute__((ext_vector_type(8)));
typedef short s16x4 __attribute__((ext_vector_type(4)));
typedef float f32x4 __attribute__((ext_vector_type(4)));
typedef unsigned u32x4 __attribute__((ext_vector_type(4)));
typedef unsigned u32x2 __attribute__((ext_vector_type(2)));
#define LDSB __attribute__((address_space(3)))

constexpr int TP = 16384, TS = 512, TT = TP + TS;
constexpr int NTHR = 512;
constexpr int LDS_BYTES = 139264 + 256;
constexpr float EPS = 1e-6f;
#ifndef PHASE_MASK
#define PHASE_MASK 0xFFFF
#endif
#ifndef REPEAT_MASK
#define REPEAT_MASK 0
#endif
#ifndef PROBE3
#define PROBE3 0
#endif
#ifndef EXTRA_SYNCS
#define EXTRA_SYNCS 0
#endif

constexpr size_t O_YP = 0;
constexpr size_t O_YS = O_YP + (size_t)TP * 1024;
constexpr size_t O_SSMP = O_YS + (size_t)TS * 1024;
constexpr size_t O_SSMS = O_SSMP + (size_t)8 * 16 * 64 * 128;
constexpr size_t O_CONVP = O_SSMS + (size_t)128 * 16 * 64 * 128;
constexpr size_t O_CONVS = O_CONVP + (size_t)8 * 3 * 1536;
constexpr size_t O_POOLP = O_CONVS + (size_t)128 * 3 * 1536;
constexpr size_t O_POOLS = O_POOLP + (size_t)8 * 15 * 1024;
constexpr size_t O_FFNP = O_POOLS + (size_t)128 * 15 * 1024;
constexpr size_t O_FFNS = O_FFNP + (size_t)8 * 2 * 5632;
constexpr size_t O_MK = O_FFNS + (size_t)128 * 2 * 5632;
constexpr size_t O_MV = O_MK + (size_t)8 * 256 * 1024;

constexpr size_t W_WIN = 0;
constexpr size_t W_WPOOL = W_WIN + (size_t)3584 * 1024 * 2;
constexpr size_t W_WOUT = W_WPOOL + (size_t)4 * 256 * 256 * 2;
constexpr size_t W_WMQ = W_WOUT + (size_t)1024 * 2048 * 2;
constexpr size_t W_WMK = W_WMQ + (size_t)1024 * 1024 * 2;
constexpr size_t W_WMV = W_WMK + (size_t)1024 * 1024 * 2;
constexpr size_t W_WMO = W_WMV + (size_t)1024 * 1024 * 2;
constexpr size_t W_WUP = W_WMO + (size_t)1024 * 1024 * 2;
constexpr size_t W_WDOWN = W_WUP + (size_t)5632 * 1024 * 2;
constexpr size_t W_H = W_WDOWN + (size_t)1024 * 2816 * 2;
constexpr size_t W_HM = W_H + (size_t)TT * 1024 * 2;
constexpr size_t W_KB = W_HM + (size_t)2048 * 1024 * 2;
constexpr size_t W_VT = W_KB + (size_t)2048 * 1024 * 2;
constexpr size_t W_DT = W_VT + (size_t)2048 * 1024 * 2;
constexpr size_t W_XRES = W_DT + (size_t)TT * 16 * 4;
constexpr size_t W_ARENA = W_XRES + (size_t)TT * 1024 * 4;
constexpr size_t W_Z = W_ARENA;
constexpr size_t W_PROJ2 = W_Z + (size_t)TT * 1024 * 2;
constexpr size_t W_XACT = W_PROJ2 + (size_t)TT * 2560 * 2;
constexpr size_t W_POOLED = W_XACT + (size_t)TT * 1536 * 2;
constexpr size_t W_Y = W_POOLED + (size_t)TT * 1024 * 2;
constexpr size_t W_MIX = W_Y + (size_t)TT * 1024 * 2;
constexpr size_t W_END_A = W_MIX + (size_t)TT * 2048 * 2;
constexpr size_t W_Q = W_PROJ2;
constexpr size_t W_P = W_Q + (size_t)TT * 1024 * 2;
constexpr size_t W_O = W_P + (size_t)TP * 1024 * 2;
constexpr size_t W_U = W_ARENA;
constexpr size_t W_ACT = W_U + (size_t)TT * 5632 * 2;
constexpr size_t W_END_C = W_ACT + (size_t)TT * 2816 * 2;
constexpr size_t W_BAR = W_END_A;
constexpr size_t W_SS1 = W_BAR + 16384;
constexpr size_t W_SS2 = W_SS1 + (size_t)TT * 4;
constexpr size_t W_SS3 = W_SS2 + (size_t)TT * 4;
constexpr size_t W_TOTAL = W_SS3 + (size_t)TT * 4;
static_assert(W_O + (size_t)TT * 1024 * 2 <= W_POOLED, "era B overflow");
static_assert(W_END_C <= W_END_A, "era C overflow");

struct Params {
    const float *x_prompt, *x_sample, *mem_prompt, *state_ssm, *state_conv, *state_pool, *state_ffn, *cache_k, *cache_v;
    const float *norm_mix, *w_in, *conv_w, *conv_b, *dt_bias, *a_log, *ssm_d, *ssm_norm, *w_pool, *pool_scale, *w_out;
    const float *norm_mem, *norm_memkv, *w_mq, *w_mk, *w_mv, *w_mo, *norm_ffn, *w_up, *ffn_w, *ffn_b, *w_down, *final_norm;
    float* out;
    char* ws;
    int ph_lo, ph_hi;
};

typedef const __attribute__((address_space(4))) Params* PP;

__device__ __forceinline__ unsigned pk2(float lo, float hi) { unsigned r; asm("v_cvt_pk_bf16_f32 %0, %1, %2" : "=v"(r) : "v"(lo), "v"(hi)); return r; }
__device__ __forceinline__ bf16_t f2bf(float f) { return (bf16_t)(pk2(f, 0.f) & 0xffffu); }
__device__ __forceinline__ float bf2f(bf16_t b) { return __uint_as_float(((unsigned)b) << 16); }
__device__ __forceinline__ float bflo(unsigned u) { return __uint_as_float(u << 16); }
__device__ __forceinline__ float bfhi(unsigned u) { return __uint_as_float(u & 0xffff0000u); }
__device__ __forceinline__ void unpack8(u32x4 v, float (&f)[8]) {
    f[0] = bflo(v.x); f[1] = bfhi(v.x); f[2] = bflo(v.y); f[3] = bfhi(v.y); f[4] = bflo(v.z); f[5] = bfhi(v.z); f[6] = bflo(v.w); f[7] = bfhi(v.w);
}
__device__ __forceinline__ u32x4 pack8(const float (&f)[8]) { u32x4 r; r.x = pk2(f[0], f[1]); r.y = pk2(f[2], f[3]); r.z = pk2(f[4], f[5]); r.w = pk2(f[6], f[7]); return r; }
__device__ __forceinline__ float wave_sum(float v) {
#pragma unroll
    for (int o = 1; o < 64; o <<= 1) v += __shfl_xor(v, o);
    return v;
}
__device__ __forceinline__ float wave_max(float v) {
#pragma unroll
    for (int o = 1; o < 64; o <<= 1) v = fmaxf(v, __shfl_xor(v, o));
    return v;
}
__device__ __forceinline__ float silu_f(float x) { return x / (1.0f + __expf(-x)); }

constexpr int HTB = 128 * 64 * 2;
__device__ __forceinline__ int lds_byte(int r, int c) { const int st = (r >> 4) * 2 + (c >> 5), rr = r & 15, cc = c & 31, ob = rr * 64 + cc * 2; return st * 1024 + (ob ^ (((ob >> 9) & 1) << 5)); }
__device__ __forceinline__ void stage_rc(int b, int& R, int& C) { const int st = b / 1024, sb = b % 1024, swz = sb ^ (((sb >> 9) & 1) << 5); R = (st >> 1) * 16 + swz / 64; C = (st & 1) * 32 + (swz % 64) / 2; }

enum { E_PROJ = 0, E_MEMKV, E_POOL, E_OUT, E_Q, E_QK, E_PV, E_MO, E_UP, E_DOWN };

template <int EK>
__device__ __forceinline__ float epi_apply(PP P, int row, int col, f32x4 v) {
    char* ws = P->ws;
    if constexpr (EK == E_PROJ) {
        u32x2 o; o.x = pk2(v[0], v[1]); o.y = pk2(v[2], v[3]);
        if (col < 1024) *(u32x2*)((bf16_t*)(ws + W_Z) + (size_t)row * 1024 + col) = o;
        else *(u32x2*)((bf16_t*)(ws + W_PROJ2) + (size_t)row * 2560 + (col - 1024)) = o;
    } else if constexpr (EK == E_MEMKV) {
        if (col < 1024) {
            *(f32x4*)(P->out + O_MK + (size_t)row * 1024 + col) = v;
            u32x2 o; o.x = pk2(v[0], v[1]); o.y = pk2(v[2], v[3]);
            *(u32x2*)((bf16_t*)(ws + W_KB) + (size_t)row * 1024 + col) = o;
        } else {
            const int c = col - 1024;
            *(f32x4*)(P->out + O_MV + (size_t)row * 1024 + c) = v;
            const int b = row >> 8, m = row & 255, hh = c >> 8, d = c & 255;
            bf16_t* vt = (bf16_t*)(ws + W_VT) + ((size_t)(b * 4 + hh) * 256 + d) * 256 + m;
#pragma unroll
            for (int j = 0; j < 4; ++j) vt[j * 256] = f2bf(v[j]);
        }
    } else if constexpr (EK == E_POOL) {
        const f32x4 sc = *(const f32x4*)(P->pool_scale + col);
        u32x2 o; o.x = pk2(v[0] * sc[0], v[1] * sc[1]); o.y = pk2(v[2] * sc[2], v[3] * sc[3]);
        *(u32x2*)((bf16_t*)(ws + W_MIX) + (size_t)row * 2048 + 1024 + col) = o;
    } else if constexpr (EK == E_OUT) {
        const float* xin = row < TP ? P->x_prompt + (size_t)row * 1024 : P->x_sample + (size_t)(row - TP) * 1024;
        const f32x4 x = *(const f32x4*)(xin + col) + v;
        u32x2 o; o.x = pk2(x[0], x[1]); o.y = pk2(x[2], x[3]);
        *(u32x2*)((bf16_t*)(ws + W_H) + (size_t)row * 1024 + col) = o;
        return (x[0] * x[0] + x[1] * x[1]) + (x[2] * x[2] + x[3] * x[3]);
    } else if constexpr (EK == E_Q) {
        u32x2 o; o.x = pk2(v[0], v[1]); o.y = pk2(v[2], v[3]);
        *(u32x2*)((bf16_t*)(ws + W_Q) + (size_t)row * 1024 + col) = o;
    } else if constexpr (EK == E_PV) {
        u32x2 o; o.x = pk2(v[0], v[1]); o.y = pk2(v[2], v[3]);
        *(u32x2*)((bf16_t*)(ws + W_O) + (size_t)row * 1024 + col) = o;
    } else if constexpr (EK == E_MO || EK == E_DOWN) {
        u32x2* hp = (u32x2*)((bf16_t*)(ws + W_H) + (size_t)row * 1024 + col);
        const u32x2 hv = *hp;
        const f32x4 x = (f32x4){bflo(hv.x), bfhi(hv.x), bflo(hv.y), bfhi(hv.y)} + v;
        u32x2 o; o.x = pk2(x[0], x[1]); o.y = pk2(x[2], x[3]);
        *hp = o;
        return (x[0] * x[0] + x[1] * x[1]) + (x[2] * x[2] + x[3] * x[3]);
    } else if constexpr (EK == E_UP) {
        u32x2 o; o.x = pk2(v[0], v[1]); o.y = pk2(v[2], v[3]);
        *(u32x2*)((bf16_t*)(ws + W_U) + (size_t)row * 5632 + col) = o;
    }
    return 0.f;
}
template <int EK>
__device__ __forceinline__ float epi_rowscale(PP P, int row) {
    if constexpr (EK == E_Q) return rsqrtf(((const float*)(P->ws + W_SS1))[row] * (1.0f / 1024.0f) + EPS) * 0.0625f;
    else if constexpr (EK == E_UP) return rsqrtf(((const float*)(P->ws + W_SS2))[row] * (1.0f / 1024.0f) + EPS);
    else return 1.0f;
}
__device__ __forceinline__ float epi_apply_rt(PP P, int ekind, int row, int col, f32x4 v) {
    switch (ekind) {
    case E_POOL: return epi_apply<E_POOL>(P, row, col, v);
    case E_OUT: return epi_apply<E_OUT>(P, row, col, v);
    case E_Q: return epi_apply<E_Q>(P, row, col, v * epi_rowscale<E_Q>(P, row));
    case E_MO: return epi_apply<E_MO>(P, row, col, v);
    default: return epi_apply<E_DOWN>(P, row, col, v);
    }
}
template <int EK>
__device__ __forceinline__ void epi_loop(PP P, const f32x4 (&acc)[2][2][4][2], int rbase, int cbase, int fq) {
#pragma unroll
    for (int ai = 0; ai < 2; ++ai)
#pragma unroll
        for (int m = 0; m < 4; ++m) {
            const int row = rbase + ai * 128 + m * 16;
            const float rs = epi_rowscale<EK>(P, row);
            float ss = 0.f;
#pragma unroll
            for (int bj = 0; bj < 2; ++bj)
#pragma unroll
                for (int n = 0; n < 2; ++n) {
                    if constexpr (EK == E_Q || EK == E_UP) ss += epi_apply<EK>(P, row, cbase + bj * 128 + n * 16, acc[ai][bj][m][n] * rs);
                    else ss += epi_apply<EK>(P, row, cbase + bj * 128 + n * 16, acc[ai][bj][m][n]);
                }
            if constexpr (EK == E_OUT || EK == E_MO || EK == E_DOWN) {
                ss += __shfl_xor(ss, 16); ss += __shfl_xor(ss, 32);
                if (fq == 0) unsafeAtomicAdd((float*)(P->ws + (EK == E_OUT ? W_SS1 : EK == E_MO ? W_SS2 : W_SS3)) + row, ss);
            }
        }
}

struct PhaseCfg { const char* A; const char* B; int lda, ldb, K, nbig, nsmall, ncol64, ekind; };
__device__ __forceinline__ PhaseCfg phase_cfg(PP P, int gp) {
    const char* ws = P->ws; PhaseCfg c;
    switch (gp) {
    case 1:  c.A = ws + W_H;      c.B = ws + W_WIN;   c.lda = 1024; c.ldb = 1024; c.K = 1024; c.nbig = 66 * 14 + 64; c.nsmall = 0; c.ncol64 = 56; c.ekind = E_PROJ; break;
    case 3:  c.A = ws + W_POOLED; c.B = ws + W_WPOOL; c.lda = 1024; c.ldb = 256;  c.K = 256;  c.nbig = 256; c.nsmall = 256; c.ncol64 = 16; c.ekind = E_POOL; break;
    case 5:  c.A = ws + W_MIX;    c.B = ws + W_WOUT;  c.lda = 2048; c.ldb = 2048; c.K = 2048; c.nbig = 256; c.nsmall = 256; c.ncol64 = 16; c.ekind = E_OUT; break;
    case 7:  c.A = ws + W_H;      c.B = ws + W_WMQ;   c.lda = 1024; c.ldb = 1024; c.K = 1024; c.nbig = 256; c.nsmall = 256; c.ncol64 = 16; c.ekind = E_Q; break;
    case 8:  c.A = ws + W_Q;      c.B = ws + W_KB;    c.lda = 1024; c.ldb = 1024; c.K = 256;  c.nbig = 256; c.nsmall = 0;   c.ncol64 = 16; c.ekind = E_QK; break;
    case 9:  c.A = ws + W_P;      c.B = ws + W_VT;    c.lda = 1024; c.ldb = 256;  c.K = 256;  c.nbig = 256; c.nsmall = 0;   c.ncol64 = 16; c.ekind = E_PV; break;
    case 10: c.A = ws + W_O;      c.B = ws + W_WMO;   c.lda = 1024; c.ldb = 1024; c.K = 1024; c.nbig = 256; c.nsmall = 256; c.ncol64 = 16; c.ekind = E_MO; break;
    case 12: c.A = ws + W_H;      c.B = ws + W_WUP;   c.lda = 1024; c.ldb = 1024; c.K = 1024; c.nbig = 66 * 22; c.nsmall = 0; c.ncol64 = 88; c.ekind = E_UP; break;
    default: c.A = ws + W_ACT;    c.B = ws + W_WDOWN; c.lda = 2816; c.ldb = 2816; c.K = 2816; c.nbig = 256; c.nsmall = 256; c.ncol64 = 16; c.ekind = E_DOWN; break;
    }
    return c;
}
struct UnitD { const char* A; const char* B; int row0, col0, ekind; };
__device__ __forceinline__ void map_unit(int L, int nM, int nN, int& pm, int& pn) {
    const int nwg = nM * nN, q = nwg >> 3, r = nwg & 7, xcd = L & 7, off = L >> 3;
    const int wgid = (xcd < r ? xcd * (q + 1) : r * (q + 1) + (xcd - r) * q) + off;
    const int nig = 8 * nN, gid = wgid / nig, fm = gid * 8, gsz = (nM - fm) < 8 ? (nM - fm) : 8;
    const int w = wgid - gid * nig;
    pm = fm + w % gsz; pn = w / gsz;
}
__device__ __forceinline__ UnitD unit_decode(PP P, const PhaseCfg& c, int gp, int L) {
    UnitD d; d.ekind = c.ekind;
    int pm, pn;
    switch (gp) {
    case 1:
        if (L < 924) { map_unit(L, 66, 14, pm, pn); d.A = c.A + (size_t)pm * 256 * 2048; d.B = c.B + (size_t)pn * 256 * 2048; }
        else { map_unit(L - 924, 8, 8, pm, pn); d.A = P->ws + W_HM + (size_t)pm * 256 * 2048; d.B = P->ws + W_WMK + (size_t)pn * 256 * 2048; d.ekind = E_MEMKV; }
        break;
    case 3: map_unit(L, 64, 4, pm, pn); d.A = c.A + (size_t)pm * 256 * 2048 + pn * 512; d.B = c.B + (size_t)pn * 131072; break;
    case 8: map_unit(L, 64, 4, pm, pn); d.A = c.A + (size_t)pm * 256 * 2048 + pn * 512; d.B = c.B + (size_t)(pm >> 3) * 256 * 2048 + pn * 512; break;
    case 9: map_unit(L, 64, 4, pm, pn); d.A = c.A + (size_t)pm * 256 * 2048 + pn * 512; d.B = c.B + (size_t)((pm >> 3) * 4 + pn) * 131072; break;
    case 12: map_unit(L, 66, 22, pm, pn); d.A = c.A + (size_t)pm * 256 * 2048; d.B = c.B + (size_t)pn * 256 * 2048; break;
    default: map_unit(L, 64, 4, pm, pn); d.A = c.A + (size_t)pm * 256 * c.lda * 2; d.B = c.B + (size_t)pn * 256 * c.ldb * 2; break;
    }
    d.row0 = pm * 256; d.col0 = pn * 256;
    return d;
}

__device__ __forceinline__ void gemm_phase(PP P, int gp, char* shm_g, int lb, int blk, int nblk, const int tid) {
    LDSB unsigned char* lds = (LDSB unsigned char*)shm_g;
    const int wid = __builtin_amdgcn_readfirstlane(tid >> 6), lane = tid & 63, wr = wid >> 2, wc = wid & 3, fr = lane & 15, fq = lane >> 4;
    const PhaseCfg cfg = phase_cfg(P, gp);
    const int K = cfg.K, nt = K / 64;
    unsigned voffA, voffB;
    { int R, C; stage_rc(tid * 16, R, C); voffA = (unsigned)(R * cfg.lda + C) * 2u; voffB = (unsigned)(R * cfg.ldb + C) * 2u; }
    const size_t qstepvoffA = (size_t)64 * cfg.lda * 2, qstepvoffB = (size_t)64 * cfg.ldb * 2;
    const size_t kstep = 128;
    const size_t hstepA = (size_t)128 * cfg.lda * 2, hstepB = (size_t)128 * cfg.ldb * 2;
    const unsigned ldsw = (unsigned)wid * 1024u;
    const int aoff = lds_byte(wr * 64 + fr, fq * 8), boff = lds_byte(wc * 32 + fr, fq * 8);
    const bool chain = (cfg.ekind != E_QK);
#define G_SA(b, h) (((b) * 2 + (h)) * HTB)
#define G_SB(b, h) ((4 + (b) * 2 + (h)) * HTB)
#define G_STAGE(bufoff, gbase, voff) do { \
        __builtin_amdgcn_global_load_lds((const unsigned*)((const char*)(gbase) + (voff)), (LDSB unsigned*)(lds + (bufoff) + ldsw), 16, 0, 0); \
        __builtin_amdgcn_global_load_lds((const unsigned*)((const char*)(gbase) + qstep##voff + (voff)), (LDSB unsigned*)(lds + (bufoff) + ldsw + 8192), 16, 0, 0); } while (0)
#define G_LDA(dst, b, h) do { _Pragma("unroll") for (int m = 0; m < 4; ++m) _Pragma("unroll") for (int k = 0; k < 2; ++k) dst[m][k] = *(const LDSB bf16x8*)(lds + G_SA(b, h) + aoff + m * 2048 + k * 1024); } while (0)
#define G_LDB(dst, b, h) do { _Pragma("unroll") for (int n = 0; n < 2; ++n) _Pragma("unroll") for (int k = 0; k < 2; ++k) dst[n][k] = *(const LDSB bf16x8*)(lds + G_SB(b, h) + boff + n * 2048 + k * 1024); } while (0)
#define G_MMA(ai, bj, Af, Bf) do { __builtin_amdgcn_s_setprio(1); _Pragma("unroll") for (int m = 0; m < 4; ++m) _Pragma("unroll") for (int n = 0; n < 2; ++n) _Pragma("unroll") for (int k = 0; k < 2; ++k) \
        acc[ai][bj][m][n] = __builtin_amdgcn_mfma_f32_16x16x32_bf16(Bf[n][k], Af[m][k], acc[ai][bj][m][n], 0, 0, 0); __builtin_amdgcn_s_setprio(0); } while (0)
#define G_WAIT_V(n) asm volatile("s_waitcnt vmcnt(" #n ")" ::: "memory")
#define G_WAIT_L(n) asm volatile("s_waitcnt lgkmcnt(" #n ")" ::: "memory")
#define G_BAR __builtin_amdgcn_s_barrier()
#define G_SCHED __builtin_amdgcn_sched_barrier(0)
    int u = blk;
    while (u < cfg.nbig) {
        UnitD cur = unit_decode(P, cfg, gp, u);
        f32x4 acc[2][2][4][2];
#pragma unroll
        for (int a = 0; a < 2; ++a)
#pragma unroll
            for (int b = 0; b < 2; ++b)
#pragma unroll
                for (int m = 0; m < 4; ++m)
#pragma unroll
                    for (int n = 0; n < 2; ++n) acc[a][b][m][n] = (f32x4){0.f, 0.f, 0.f, 0.f};
        bf16x8 At[4][2], B0[2][2], B1[2][2];
        const char* cA = cur.A; const char* cB = cur.B;
        G_STAGE(G_SB(0, 0), cB, voffB); G_STAGE(G_SA(0, 0), cA, voffA); G_STAGE(G_SB(0, 1), cB + hstepB, voffB); G_STAGE(G_SA(0, 1), cA + hstepA, voffA);
        if (wr == 1) G_BAR;
        G_WAIT_V(4); G_BAR;
        G_STAGE(G_SB(1, 0), cB + kstep, voffB); G_STAGE(G_SA(1, 0), cA + kstep, voffA); G_STAGE(G_SB(1, 1), cB + hstepB + kstep, voffB);
        G_WAIT_V(6); G_BAR;
        for (;;) {
            const bool has_next = chain && (u + nblk < cfg.nbig);
            UnitD nxt = cur;
            if (has_next) nxt = unit_decode(P, cfg, gp, u + nblk);
            const char* nA = nxt.A; const char* nB = nxt.B;
            for (int t = 0; t < nt; t += 2) {
                const bool last = (t == nt - 2);
                const char* a1 = cA + (size_t)(t + 1) * kstep;
                const char* a2 = last ? nA : cA + (size_t)(t + 2) * kstep; const char* b2 = last ? nB : cB + (size_t)(t + 2) * kstep;
                const char* a3 = a2 + kstep; const char* b3 = b2 + kstep;
                G_LDB(B0, 0, 0); G_SCHED; G_LDA(At, 0, 0); G_STAGE(G_SA(1, 1), a1 + hstepA, voffA);
                G_WAIT_L(8); G_BAR; G_WAIT_L(0); G_MMA(0, 0, At, B0); G_BAR; G_SCHED;
                G_LDB(B1, 0, 1); G_STAGE(G_SB(0, 0), b2, voffB);
                G_BAR; G_WAIT_L(0); G_MMA(0, 1, At, B1); G_BAR;
                G_LDA(At, 0, 1); G_STAGE(G_SA(0, 0), a2, voffA);
                G_BAR; G_WAIT_L(0); G_MMA(1, 0, At, B0); G_BAR; G_SCHED;
                G_STAGE(G_SB(0, 1), b2 + hstepB, voffB);
                G_WAIT_V(6); G_BAR; G_MMA(1, 1, At, B1); G_BAR;
                G_LDB(B0, 1, 0); G_SCHED; G_LDA(At, 1, 0); G_STAGE(G_SA(0, 1), a2 + hstepA, voffA);
                G_WAIT_L(8); G_BAR; G_WAIT_L(0); G_MMA(0, 0, At, B0); G_BAR; G_SCHED;
                G_LDB(B1, 1, 1); G_STAGE(G_SB(1, 0), b3, voffB);
                G_BAR; G_WAIT_L(0); G_MMA(0, 1, At, B1); G_BAR;
                G_LDA(At, 1, 1); G_STAGE(G_SA(1, 0), a3, voffA);
                G_BAR; G_WAIT_L(0); G_MMA(1, 0, At, B0); G_BAR; G_SCHED;
                G_STAGE(G_SB(1, 1), b3 + hstepB, voffB);
                G_WAIT_V(6); G_BAR; G_MMA(1, 1, At, B1); G_BAR;
            }
            if (chain) {
                const int rbase = cur.row0 + wr * 64 + fr, cbase = cur.col0 + wc * 32 + fq * 4;
                switch (cur.ekind) {
                case E_PROJ: epi_loop<E_PROJ>(P, acc, rbase, cbase, fq); break;
                case E_MEMKV: epi_loop<E_MEMKV>(P, acc, rbase, cbase, fq); break;
                case E_POOL: epi_loop<E_POOL>(P, acc, rbase, cbase, fq); break;
                case E_OUT: epi_loop<E_OUT>(P, acc, rbase, cbase, fq); break;
                case E_Q: epi_loop<E_Q>(P, acc, rbase, cbase, fq); break;
                case E_PV: epi_loop<E_PV>(P, acc, rbase, cbase, fq); break;
                case E_MO: epi_loop<E_MO>(P, acc, rbase, cbase, fq); break;
                case E_UP: epi_loop<E_UP>(P, acc, rbase, cbase, fq); break;
                default: epi_loop<E_DOWN>(P, acc, rbase, cbase, fq); break;
                }
            }
            if (!has_next) break;
#pragma unroll
            for (int a = 0; a < 2; ++a)
#pragma unroll
                for (int b = 0; b < 2; ++b)
#pragma unroll
                    for (int m = 0; m < 4; ++m)
#pragma unroll
                        for (int n = 0; n < 2; ++n) acc[a][b][m][n] = (f32x4){0.f, 0.f, 0.f, 0.f};
            cur = nxt; cA = nA; cB = nB; u += nblk;
        }
        G_WAIT_V(0);
        if (wr == 0) G_BAR;
        G_BAR;
        if (!chain) {
            float* redm = (float*)(shm_g + 131072);
            float* reds = (float*)(shm_g + 135168);
#pragma unroll
            for (int ai = 0; ai < 2; ++ai)
#pragma unroll
                for (int m = 0; m < 4; ++m) {
                    float t = -3.0e38f;
#pragma unroll
                    for (int bj = 0; bj < 2; ++bj)
#pragma unroll
                        for (int n = 0; n < 2; ++n)
#pragma unroll
                            for (int j = 0; j < 4; ++j) t = fmaxf(t, acc[ai][bj][m][n][j]);
                    t = fmaxf(t, __shfl_xor(t, 16)); t = fmaxf(t, __shfl_xor(t, 32));
                    if (fq == 0) redm[(ai * 128 + wr * 64 + m * 16 + fr) * 4 + wc] = t;
                }
            __syncthreads();
#pragma unroll
            for (int ai = 0; ai < 2; ++ai)
#pragma unroll
                for (int m = 0; m < 4; ++m) {
                    const f32x4 r = *(const f32x4*)(redm + (ai * 128 + wr * 64 + m * 16 + fr) * 4);
                    const float M = fmaxf(fmaxf(r[0], r[1]), fmaxf(r[2], r[3]));
                    float s = 0.f;
#pragma unroll
                    for (int bj = 0; bj < 2; ++bj)
#pragma unroll
                        for (int n = 0; n < 2; ++n)
#pragma unroll
                            for (int j = 0; j < 4; ++j) { const float e = __expf(acc[ai][bj][m][n][j] - M); acc[ai][bj][m][n][j] = e; s += e; }
                    s += __shfl_xor(s, 16); s += __shfl_xor(s, 32);
                    if (fq == 0) reds[(ai * 128 + wr * 64 + m * 16 + fr) * 4 + wc] = s;
                }
            __syncthreads();
#pragma unroll
            for (int ai = 0; ai < 2; ++ai)
#pragma unroll
                for (int m = 0; m < 4; ++m) {
                    const int rl = ai * 128 + wr * 64 + m * 16 + fr;
                    const f32x4 r = *(const f32x4*)(reds + rl * 4);
                    const float inv = 1.0f / ((r[0] + r[1]) + (r[2] + r[3]));
                    bf16_t* prow = (bf16_t*)(P->ws + W_P) + (size_t)(cur.row0 + rl) * 1024 + cur.col0;
#pragma unroll
                    for (int bj = 0; bj < 2; ++bj)
#pragma unroll
                        for (int n = 0; n < 2; ++n) {
                            const f32x4 v = acc[ai][bj][m][n];
                            u32x2 o; o.x = pk2(v[0] * inv, v[1] * inv); o.y = pk2(v[2] * inv, v[3] * inv);
                            *(u32x2*)(prow + bj * 128 + wc * 32 + n * 16 + fq * 4) = o;
                        }
                }
            __syncthreads();
        }
        u += nblk;
    }
#undef G_SA
#undef G_SB
#undef G_STAGE
#undef G_LDA
#undef G_LDB
#undef G_MMA
    const int rot = cfg.nbig % nblk;
    for (int s0 = (lb - rot + nblk) % nblk; s0 < cfg.nsmall; s0 += nblk) {
        const int pr = s0 / cfg.ncol64, pc = s0 % cfg.ncol64;
        const int row0 = TP + pr * 32, col0 = pc * 64;
        const bf16_t* Ab = (const bf16_t*)cfg.A + (size_t)row0 * cfg.lda;
        const bf16_t* Bb;
        if (gp == 3) { const int g = pc >> 2; Ab += g * 256; Bb = (const bf16_t*)cfg.B + (size_t)g * 65536 + (size_t)(col0 - g * 256) * 256; }
        else Bb = (const bf16_t*)cfg.B + (size_t)col0 * cfg.ldb;
        const int kw = K >> 3, nks = kw >> 5;
        f32x4 acc[2][4];
#pragma unroll
        for (int mi = 0; mi < 2; ++mi)
#pragma unroll
            for (int ni = 0; ni < 4; ++ni) acc[mi][ni] = (f32x4){0.f, 0.f, 0.f, 0.f};
        const bf16_t* ap = Ab + (size_t)fr * cfg.lda + wid * kw + fq * 8;
        const bf16_t* bp = Bb + (size_t)fr * cfg.ldb + wid * kw + fq * 8;
        for (int ks0 = 0; ks0 < nks; ks0 += 4) {
            bf16x8 a[4][2], b[4][4];
#pragma unroll
            for (int q = 0; q < 4; ++q) {
                const bool ok = ks0 + q < nks;
#pragma unroll
                for (int mi = 0; mi < 2; ++mi) { bf16x8 z = {0, 0, 0, 0, 0, 0, 0, 0}; if (ok) z = *(const bf16x8*)(ap + (size_t)mi * 16 * cfg.lda + (ks0 + q) * 32); a[q][mi] = z; }
#pragma unroll
                for (int ni = 0; ni < 4; ++ni) { bf16x8 z = {0, 0, 0, 0, 0, 0, 0, 0}; if (ok) z = *(const bf16x8*)(bp + (size_t)ni * 16 * cfg.ldb + (ks0 + q) * 32); b[q][ni] = z; }
            }
#pragma unroll
            for (int q = 0; q < 4; ++q)
#pragma unroll
                for (int mi = 0; mi < 2; ++mi)
#pragma unroll
                    for (int ni = 0; ni < 4; ++ni) acc[mi][ni] = __builtin_amdgcn_mfma_f32_16x16x32_bf16(b[q][ni], a[q][mi], acc[mi][ni], 0, 0, 0);
        }
        float* red = (float*)shm_g;
#pragma unroll
        for (int mi = 0; mi < 2; ++mi)
#pragma unroll
            for (int ni = 0; ni < 4; ++ni) *(f32x4*)(red + wid * 2048 + (mi * 16 + fr) * 64 + ni * 16 + fq * 4) = acc[mi][ni];
        __syncthreads();
        {
            const int r = tid >> 4, c = (tid & 15) * 4;
            f32x4 v = *(const f32x4*)(red + r * 64 + c);
#pragma unroll
            for (int w = 1; w < 8; ++w) v += *(const f32x4*)(red + w * 2048 + r * 64 + c);
            float ss = epi_apply_rt(P, cfg.ekind, row0 + r, col0 + c, v);
            if (cfg.ekind == E_OUT || cfg.ekind == E_MO || cfg.ekind == E_DOWN) {
                ss += __shfl_xor(ss, 1); ss += __shfl_xor(ss, 2); ss += __shfl_xor(ss, 4); ss += __shfl_xor(ss, 8);
                if ((tid & 15) == 0) unsafeAtomicAdd((float*)(P->ws + (cfg.ekind == E_OUT ? W_SS1 : cfg.ekind == E_MO ? W_SS2 : W_SS3)) + row0 + r, ss);
            }
        }
        __syncthreads();
    }
}

struct TrDesc { const float* src; bf16_t* dst; const float* gain; int ld_src, ld_dst, k0, n0s, n0d; };
__device__ __forceinline__ TrDesc tr_decode(PP P, int i) {
    char* ws = P->ws; TrDesc d; d.gain = nullptr;
    if (i < 896) { const int kt = i / 56, ntl = i % 56; d.n0d = ntl * 64; d.n0s = d.n0d < 2560 ? d.n0d : d.n0d + 16; d.src = P->w_in; d.ld_src = 3600; d.dst = (bf16_t*)(ws + W_WIN); d.ld_dst = 1024; d.k0 = kt * 64; return d; }
    i -= 896;
    if (i < 64) { const int g = i >> 4, kt = (i >> 2) & 3, ntl = i & 3; d.src = P->w_pool + (size_t)g * 65536; d.ld_src = 256; d.dst = (bf16_t*)(ws + W_WPOOL) + (size_t)g * 65536; d.ld_dst = 256; d.k0 = kt * 64; d.n0s = d.n0d = ntl * 64; return d; }
    i -= 64;
    if (i < 512) { const int kt = i >> 4, ntl = i & 15; d.src = P->w_out; d.ld_src = 1024; d.dst = (bf16_t*)(ws + W_WOUT); d.ld_dst = 2048; d.k0 = kt * 64; d.n0s = d.n0d = ntl * 64; return d; }
    i -= 512;
    if (i < 1024) { const int wsel = i >> 8, r = i & 255, kt = r >> 4, ntl = r & 15;
        d.src = wsel == 0 ? P->w_mq : wsel == 1 ? P->w_mk : wsel == 2 ? P->w_mv : P->w_mo;
        d.dst = (bf16_t*)(ws + (wsel == 0 ? W_WMQ : wsel == 1 ? W_WMK : wsel == 2 ? W_WMV : W_WMO));
        d.gain = wsel == 0 ? P->norm_mem : nullptr; d.ld_src = 1024; d.ld_dst = 1024; d.k0 = kt * 64; d.n0s = d.n0d = ntl * 64; return d; }
    i -= 1024;
    if (i < 1408) { const int kt = i / 88, ntl = i % 88; d.src = P->w_up; d.ld_src = 5632; d.dst = (bf16_t*)(ws + W_WUP); d.ld_dst = 1024; d.gain = P->norm_ffn; d.k0 = kt * 64; d.n0s = d.n0d = ntl * 64; return d; }
    i -= 1408;
    { const int kt = i >> 4, ntl = i & 15; d.src = P->w_down; d.ld_src = 1024; d.dst = (bf16_t*)(ws + W_WDOWN); d.ld_dst = 2816; d.k0 = kt * 64; d.n0s = d.n0d = ntl * 64; return d; }
}

__device__ __forceinline__ void phase_prep(PP P, char* shm, int blk, int nblk, const int tid) {
    const int wid = tid >> 6, lane = tid & 63;
    float* tiles = (float*)shm;
    float* wdt = (float*)(shm + 69632);
    for (int i = blk * NTHR + tid; i < 3 * TT; i += nblk * NTHR) ((float*)(P->ws + W_SS1))[i] = 0.f;
    for (int i = tid; i < 1024 * 16; i += NTHR) { const int k = i >> 4, hd = i & 15; wdt[hd * 1024 + k] = P->w_in[(size_t)k * 3600 + 2560 + hd]; }
    __syncthreads();
    char* ws = P->ws;
    constexpr int NGRP = (TT + 2048) / 32;
    for (int it = blk; it < NGRP; it += nblk) {
        const int rbase = it * 32 + wid * 4;
        const bool ismem = rbase >= TT;
        f32x4 xv[4][4];
#pragma unroll
        for (int r = 0; r < 4; ++r) {
            const int row = (ismem ? rbase - TT : rbase) + r;
            const float* xr = ismem ? P->mem_prompt + (size_t)row * 1024 : (row < TP ? P->x_prompt + (size_t)row * 1024 : P->x_sample + (size_t)(row - TP) * 1024);
#pragma unroll
            for (int j = 0; j < 4; ++j) xv[r][j] = __builtin_nontemporal_load((const f32x4*)(xr + j * 256 + lane * 4));
        }
        const float* gg = ismem ? P->norm_memkv : P->norm_mix;
#pragma unroll
        for (int r = 0; r < 4; ++r) {
            const int row = (ismem ? rbase - TT : rbase) + r;
            bf16_t* orow = (bf16_t*)(ws + (ismem ? W_HM : W_H)) + (size_t)row * 1024;
            float ss = 0.f;
#pragma unroll
            for (int j = 0; j < 4; ++j) ss += xv[r][j][0] * xv[r][j][0] + xv[r][j][1] * xv[r][j][1] + xv[r][j][2] * xv[r][j][2] + xv[r][j][3] * xv[r][j][3];
            ss = wave_sum(ss);
            const float rstd = rsqrtf(ss * (1.0f / 1024.0f) + EPS);
#pragma unroll
            for (int j = 0; j < 4; ++j) { const f32x4 g4 = *(const f32x4*)(gg + j * 256 + lane * 4); xv[r][j] = xv[r][j] * rstd * g4;
                u32x2 o; o.x = pk2(xv[r][j][0], xv[r][j][1]); o.y = pk2(xv[r][j][2], xv[r][j][3]); *(u32x2*)(orow + j * 256 + lane * 4) = o; }
            if (!ismem) {
                float mine = 0.f;
#pragma unroll
                for (int hd = 0; hd < 16; ++hd) {
                    float acc = 0.f;
#pragma unroll
                    for (int j = 0; j < 4; ++j) { const f32x4 w4 = *(const f32x4*)(wdt + hd * 1024 + j * 256 + lane * 4); acc += xv[r][j][0] * w4[0] + xv[r][j][1] * w4[1] + xv[r][j][2] * w4[2] + xv[r][j][3] * w4[3]; }
                    acc = wave_sum(acc);
                    if (lane == hd) mine = acc;
                }
                if (lane < 16) { const float x = mine + P->dt_bias[lane]; const float ey = __expf(-fabsf(x)); const float l1p = ey < 0.03f ? ey * (1.0f - ey * (0.5f - ey * (0.33333333f - 0.25f * ey))) : __logf(1.0f + ey); const float sp = fmaxf(x, 0.f) + l1p; ((float*)(ws + W_DT))[(size_t)row * 16 + lane] = sp; }
            }
        }
    }
    __syncthreads();
    const int kr = tid >> 4, nc = (tid & 15) * 4, tn = tid >> 3, tk8 = (tid & 7) * 8;
    for (int it = blk; it < 4608; it += 4 * nblk) {
        f32x4 v[4][2];
#pragma unroll
        for (int q = 0; q < 4; ++q) {
            const int i = it + q * nblk;
            if (i < 4608) { const TrDesc d = tr_decode(P, i);
#pragma unroll
                for (int h = 0; h < 2; ++h) { const int k = kr + h * 32; f32x4 t = __builtin_nontemporal_load((const f32x4*)(d.src + (size_t)(d.k0 + k) * d.ld_src + d.n0s + nc)); if (d.gain) t *= d.gain[d.k0 + k]; v[q][h] = t; } }
        }
#pragma unroll
        for (int q = 0; q < 4; ++q) {
            if (it + q * nblk < 4608) { float* tile = tiles + q * (64 * 65);
#pragma unroll
                for (int h = 0; h < 2; ++h) { const int k = kr + h * 32; tile[k * 65 + nc + 0] = v[q][h][0]; tile[k * 65 + nc + 1] = v[q][h][1]; tile[k * 65 + nc + 2] = v[q][h][2]; tile[k * 65 + nc + 3] = v[q][h][3]; } }
        }
        __syncthreads();
#pragma unroll
        for (int q = 0; q < 4; ++q) {
            const int i = it + q * nblk;
            if (i < 4608) { const TrDesc d = tr_decode(P, i); const float* tile = tiles + q * (64 * 65); float f[8];
#pragma unroll
                for (int e2 = 0; e2 < 8; ++e2) f[e2] = tile[(tk8 + e2) * 65 + tn];
                *(u32x4*)(d.dst + (size_t)(d.n0d + tn) * d.ld_dst + d.k0 + tk8) = pack8(f); }
        }
        __syncthreads();
    }
}

__device__ __forceinline__ u32x4 ld8(const bf16_t* p) { return *(const u32x4*)p; }

__device__ __forceinline__ void phase_convpool(PP P, int gtid, int nthreads) {
    char* ws = P->ws;
    const bf16_t* proj2 = (const bf16_t*)(ws + W_PROJ2);
    bf16_t* xact = (bf16_t*)(ws + W_XACT);
    bf16_t* pooled = (bf16_t*)(ws + W_POOLED);
    for (int idx = gtid; idx < 1152 * 320; idx += nthreads) {
        const int run = idx / 320, cg = idx % 320;
        const bool samp = run >= 1024;
        int t0, len, bidx, tl0;
        if (!samp) { t0 = run * 16; len = 16; bidx = t0 >> 11; tl0 = t0 & 2047; } else { bidx = run - 1024; t0 = TP + bidx * 4; len = 4; tl0 = 0; }
        if (cg < 192) {
            const int c0 = cg * 8;
            float w0[8], w1[8], w2[8], w3[8], bs[8], h0[8], h1[8], h2[8];
#pragma unroll
            for (int e = 0; e < 8; ++e) { w0[e] = P->conv_w[c0 + e]; w1[e] = P->conv_w[1536 + c0 + e]; w2[e] = P->conv_w[3072 + c0 + e]; w3[e] = P->conv_w[4608 + c0 + e]; bs[e] = P->conv_b[c0 + e]; }
            if (samp) {
#pragma unroll
                for (int e = 0; e < 8; ++e) { h0[e] = P->state_conv[(size_t)(bidx * 3 + 0) * 1536 + c0 + e]; h1[e] = P->state_conv[(size_t)(bidx * 3 + 1) * 1536 + c0 + e]; h2[e] = P->state_conv[(size_t)(bidx * 3 + 2) * 1536 + c0 + e]; }
            } else if (tl0 > 0) {
                unpack8(ld8(proj2 + (size_t)(t0 - 3) * 2560 + c0), h0); unpack8(ld8(proj2 + (size_t)(t0 - 2) * 2560 + c0), h1); unpack8(ld8(proj2 + (size_t)(t0 - 1) * 2560 + c0), h2);
            } else {
#pragma unroll
                for (int e = 0; e < 8; ++e) { h0[e] = 0.f; h1[e] = 0.f; h2[e] = 0.f; }
            }
            u32x4 rx[16];
#pragma unroll
            for (int j = 0; j < 16; ++j) { if (j < len) rx[j] = ld8(proj2 + (size_t)(t0 + j) * 2560 + c0); }
#pragma unroll
            for (int j = 0; j < 16; ++j) {
                if (j < len) {
                float x3[8], y[8]; unpack8(rx[j], x3);
#pragma unroll
                for (int e = 0; e < 8; ++e) { const float v = bs[e] + w0[e] * h0[e] + w1[e] * h1[e] + w2[e] * h2[e] + w3[e] * x3[e]; y[e] = silu_f(v); }
                *(u32x4*)(xact + (size_t)(t0 + j) * 1536 + c0) = pack8(y);
                if (samp) { if (j >= 1) { float* o = P->out + O_CONVS + (size_t)(bidx * 3 + j - 1) * 1536 + c0;
#pragma unroll
                        for (int e = 0; e < 8; ++e) o[e] = x3[e]; } }
                else { const int tl = tl0 + j; if (tl >= 2045) { float* o = P->out + O_CONVP + (size_t)(bidx * 3 + tl - 2045) * 1536 + c0;
#pragma unroll
                        for (int e = 0; e < 8; ++e) o[e] = x3[e]; } }
#pragma unroll
                for (int e = 0; e < 8; ++e) { h0[e] = h1[e]; h1[e] = h2[e]; h2[e] = x3[e]; }
                }
            }
        } else {
            const int c0 = (cg - 192) * 8; const int win = 2 << (c0 >> 8);
            const bf16_t* vp = proj2 + 1536 + c0;
            const float* prev = P->state_pool + (size_t)bidx * 15 * 1024 + c0;
            float sum[8];
#pragma unroll
            for (int e = 0; e < 8; ++e) sum[e] = 0.f;
            if (samp) {
                for (int jj = 1; jj < win; ++jj) {
#pragma unroll
                    for (int e = 0; e < 8; ++e) sum[e] += prev[(size_t)(15 - jj) * 1024 + e]; }
                float* o = P->out + O_POOLS + (size_t)bidx * 15 * 1024 + c0;
                for (int i = 0; i < 11; ++i) {
#pragma unroll
                    for (int e = 0; e < 8; ++e) o[(size_t)i * 1024 + e] = prev[(size_t)(i + 4) * 1024 + e]; }
            } else if (tl0 > 0) {
                for (int jj = 1; jj < win; ++jj) { float v[8]; unpack8(ld8(vp + (size_t)(t0 - jj) * 2560), v);
#pragma unroll
                    for (int e = 0; e < 8; ++e) sum[e] += v[e]; }
            }
            u32x4 rp[16];
#pragma unroll
            for (int j = 0; j < 16; ++j) { if (j < len) rp[j] = ld8(vp + (size_t)(t0 + j) * 2560); }
#pragma unroll
            for (int j = 0; j < 16; ++j) {
                if (j >= len) continue;
                float v[8], o8[8]; unpack8(rp[j], v);
                const int tl = tl0 + j;
                const float inv = 1.0f / (float)(samp ? win : (tl + 1 < win ? tl + 1 : win));
#pragma unroll
                for (int e = 0; e < 8; ++e) { sum[e] += v[e]; o8[e] = sum[e] * inv - v[e]; }
                *(u32x4*)(pooled + (size_t)(t0 + j) * 1024 + c0) = pack8(o8);
                const int to = j - win + 1;
                if (samp) {
                    if (to >= 0) { float q[8]; unpack8(ld8(vp + (size_t)(t0 + to) * 2560), q);
#pragma unroll
                        for (int e = 0; e < 8; ++e) sum[e] -= q[e]; }
                    else {
#pragma unroll
                        for (int e = 0; e < 8; ++e) sum[e] -= prev[(size_t)(15 + to) * 1024 + e]; }
                    float* o = P->out + O_POOLS + (size_t)(bidx * 15 + 11 + j) * 1024 + c0;
#pragma unroll
                    for (int e = 0; e < 8; ++e) o[e] = v[e];
                } else {
                    if (tl0 + to >= 0) { float q[8]; unpack8(ld8(vp + (size_t)(t0 + to) * 2560), q);
#pragma unroll
                        for (int e = 0; e < 8; ++e) sum[e] -= q[e]; }
                    if (tl >= 2033) { float* o = P->out + O_POOLP + (size_t)(bidx * 15 + tl - 2033) * 1024 + c0;
#pragma unroll
                        for (int e = 0; e < 8; ++e) o[e] = v[e]; }
                }
            }
        }
    }
}

constexpr int CS_STR = 136;
constexpr int X_STR = 40;
__device__ __forceinline__ s16x4 tr_read(const bf16_t* p) { return __builtin_bit_cast(s16x4, __builtin_amdgcn_ds_read_tr16_b64_v4i16((LDSB s16x4*)p)); }

#define LDS_BARRIER() asm volatile("s_waitcnt lgkmcnt(0)\n\ts_barrier" ::: "memory")
__device__ __forceinline__ void ssd_prompt(PP P, int item, char* shm, const int tid) {
    const int w = tid >> 6, lane = tid & 63, fr = lane & 15, fq = lane >> 4;
    const int b = item >> 5, hd = (item >> 1) & 15, ph = item & 1, g = hd >> 3;
    const float a = -expf(P->a_log[hd]);
    const float Dh = P->ssm_d[hd];
    char* ws = P->ws;
    const bf16_t* xact = (const bf16_t*)(ws + W_XACT);
    const float* dtb = (const float*)(ws + W_DT);
    bf16_t* ybuf = (bf16_t*)(ws + W_Y);
    bf16_t* Cs = (bf16_t*)(shm);
    bf16_t* Bs = (bf16_t*)(shm + 34816);
    bf16_t* Xd = (bf16_t*)(shm + 69632);
    bf16_t* X2 = (bf16_t*)(shm + 69632 + 10240);
    bf16_t* Ht = (bf16_t*)(shm + 69632 + 20480);
    float* acs = (float*)(shm + 69632 + 30720);
    float* dts = (float*)(shm + 69632 + 31232);
    f32x4 Hacc[2];
    Hacc[0] = (f32x4){0.f, 0.f, 0.f, 0.f}; Hacc[1] = (f32x4){0.f, 0.f, 0.f, 0.f};
    const int q4 = fr >> 2, p4 = fr & 3;
    u32x4 pc[4], pb[4], px; float pd0, pd1;
    const int ls = tid >> 4, ln8 = (tid & 15) * 8;
    const int xs = tid >> 2, xp8 = (tid & 3) * 8;
#define SSD_PREFETCH(cc) do { const int _t0 = b * 2048 + (cc) * 128; \
        _Pragma("unroll") for (int i = 0; i < 4; ++i) { const bf16_t* src = xact + (size_t)(_t0 + ls + i * 32) * 1536 + g * 128 + ln8; pc[i] = *(const u32x4*)(src + 1280); pb[i] = *(const u32x4*)(src + 1024); } \
        px = *(const u32x4*)(xact + (size_t)(_t0 + xs) * 1536 + hd * 64 + ph * 32 + xp8); \
        pd0 = dtb[(size_t)(_t0 + 2 * lane) * 16 + hd]; pd1 = dtb[(size_t)(_t0 + 2 * lane + 1) * 16 + hd]; } while (0)
    SSD_PREFETCH(0);
    for (int c = 0; c < 16; ++c) {
        const int t0 = b * 2048 + c * 128;
        if (w == 0) {
            const float d0 = pd0, d1 = pd1;
            const float s = (d0 + d1) * a; float v = s;
#pragma unroll
            for (int off = 1; off < 64; off <<= 1) { const float t = __shfl_up(v, off); if (lane >= off) v += t; }
            const float excl = v - s;
            acs[2 * lane] = excl + d0 * a; acs[2 * lane + 1] = v; dts[2 * lane] = d0; dts[2 * lane + 1] = d1;
        }
#pragma unroll
        for (int pt = 0; pt < 2; ++pt) { u32x2 o; o.x = pk2(Hacc[pt][0], Hacc[pt][1]); o.y = pk2(Hacc[pt][2], Hacc[pt][3]); *(u32x2*)(Ht + (w * 16 + fr) * X_STR + pt * 16 + fq * 4) = o; }
#pragma unroll
        for (int i = 0; i < 4; ++i) { *(u32x4*)(Cs + (ls + i * 32) * CS_STR + ln8) = pc[i]; *(u32x4*)(Bs + (ls + i * 32) * CS_STR + ln8) = pb[i]; }
        LDS_BARRIER();
        {
            float x[8], xa[8], xb[8]; unpack8(px, x);
            const float dtv = dts[xs], dec = __expf(acs[127] - acs[xs]) * dtv;
#pragma unroll
            for (int e = 0; e < 8; ++e) { xa[e] = x[e] * dtv; xb[e] = x[e] * dec; }
            *(u32x4*)(Xd + xs * X_STR + xp8) = pack8(xa);
            *(u32x4*)(X2 + xs * X_STR + xp8) = pack8(xb);
        }
        if (c < 15) SSD_PREFETCH(c + 1);
        bf16x8 Cf[4];
#pragma unroll
        for (int kk = 0; kk < 4; ++kk) Cf[kk] = *(const bf16x8*)(Cs + (w * 16 + fr) * CS_STR + kk * 32 + fq * 8);
        const int lrow = w * 16 + fr; const float al = acs[lrow];
        bf16x8 Gf[4];
#pragma unroll
        for (int kk = 0; kk < 4; ++kk) {
            u32x2 half[2];
#pragma unroll
            for (int hh = 0; hh < 2; ++hh) {
                const int st = 2 * kk + hh;
                half[hh].x = 0u; half[hh].y = 0u;
                if (st <= w) {
                    f32x4 ga = (f32x4){0.f, 0.f, 0.f, 0.f};
#pragma unroll
                    for (int k2 = 0; k2 < 4; ++k2) { const bf16x8 Bf = *(const bf16x8*)(Bs + (st * 16 + fr) * CS_STR + k2 * 32 + fq * 8); ga = __builtin_amdgcn_mfma_f32_16x16x32_bf16(Bf, Cf[k2], ga, 0, 0, 0); }
                    const int s0 = st * 16 + fq * 4; const f32x4 as4 = *(const f32x4*)(acs + s0);
                    float gv[4];
#pragma unroll
                    for (int j = 0; j < 4; ++j) gv[j] = (s0 + j <= lrow) ? ga[j] * __expf(al - as4[j]) : 0.f;
                    half[hh].x = pk2(gv[0], gv[1]); half[hh].y = pk2(gv[2], gv[3]);
                }
            }
            u32x4 g4; g4.x = half[0].x; g4.y = half[0].y; g4.z = half[1].x; g4.w = half[1].y;
            Gf[kk] = __builtin_bit_cast(bf16x8, g4);
        }
        LDS_BARRIER();
        {
            f32x4 Yd[2], Yo[2];
            Yd[0] = Yd[1] = Yo[0] = Yo[1] = (f32x4){0.f, 0.f, 0.f, 0.f};
            const int nkk = (w >> 1) + 1;
#pragma unroll
            for (int kk = 0; kk < 4; ++kk) {
                if (kk < nkk) {
#pragma unroll
                    for (int pt = 0; pt < 2; ++pt) {
                        const bf16_t* base = Xd + (kk * 32 + fq * 4 + q4) * X_STR + pt * 16 + p4 * 4;
                        bf16x8 Xf; Xf.lo = tr_read(base); Xf.hi = tr_read(base + 16 * X_STR);
                        Yd[pt] = __builtin_amdgcn_mfma_f32_16x16x32_bf16(Xf, Gf[kk], Yd[pt], 0, 0, 0);
                    }
                }
            }
#pragma unroll
            for (int kk = 0; kk < 4; ++kk)
#pragma unroll
                for (int pt = 0; pt < 2; ++pt) {
                    const bf16_t* hbp = Ht + (kk * 32 + fq * 8 + q4) * X_STR + pt * 16 + p4 * 4;
                    bf16x8 Hf; Hf.lo = tr_read(hbp); Hf.hi = tr_read(hbp + 4 * X_STR);
                    Yo[pt] = __builtin_amdgcn_mfma_f32_16x16x32_bf16(Hf, Cf[kk], Yo[pt], 0, 0, 0);
                }
            const float el = __expf(al); const float rdt = Dh / dts[lrow];
#pragma unroll
            for (int pt = 0; pt < 2; ++pt) {
                const u32x2 xr = *(const u32x2*)(Xd + lrow * X_STR + pt * 16 + fq * 4);
                const f32x4 y = Yd[pt] + el * Yo[pt] + rdt * (f32x4){bflo(xr.x), bfhi(xr.x), bflo(xr.y), bfhi(xr.y)};
                u32x2 o; o.x = pk2(y[0], y[1]); o.y = pk2(y[2], y[3]);
                *(u32x2*)(ybuf + (size_t)(t0 + lrow) * 1024 + hd * 64 + ph * 32 + pt * 16 + fq * 4) = o;
            }
        }
        {
            const float dc = __expf(acs[127]);
            Hacc[0] *= dc; Hacc[1] *= dc;
#pragma unroll
            for (int kk = 0; kk < 4; ++kk) {
                const bf16_t* bb = Bs + (kk * 32 + fq * 8 + q4) * CS_STR + w * 16 + p4 * 4;
                bf16x8 Bf; Bf.lo = tr_read(bb); Bf.hi = tr_read(bb + 4 * CS_STR);
#pragma unroll
                for (int pt = 0; pt < 2; ++pt) {
                    const bf16_t* xb = X2 + (kk * 32 + fq * 8 + q4) * X_STR + pt * 16 + p4 * 4;
                    bf16x8 Xf; Xf.lo = tr_read(xb); Xf.hi = tr_read(xb + 4 * X_STR);
                    Hacc[pt] = __builtin_amdgcn_mfma_f32_16x16x32_bf16(Xf, Bf, Hacc[pt], 0, 0, 0);
                }
            }
        }
        LDS_BARRIER();
    }
#undef SSD_PREFETCH
    float* so = P->out + O_SSMP + ((size_t)(b * 16 + hd) * 64 + ph * 32) * 128;
#pragma unroll
    for (int pt = 0; pt < 2; ++pt)
#pragma unroll
        for (int j = 0; j < 4; ++j) so[(size_t)(pt * 16 + fq * 4 + j) * 128 + w * 16 + fr] = Hacc[pt][j];
}

template <int NI>
__device__ __forceinline__ void ssd_sample(PP P, int item0, int istride, const int tid) {
    const int p = tid >> 3, n0 = (tid & 7) * 16;
    char* ws = P->ws;
    const bf16_t* xact = (const bf16_t*)(ws + W_XACT);
    const float* dtb = (const float*)(ws + W_DT);
    bf16_t* ybuf = (bf16_t*)(ws + W_Y);
    f32x4 hs[NI][4]; u32x4 rb[NI][4][2], rc[NI][4][2]; float xv[NI][4], dtv[NI][4];
#pragma unroll
    for (int q = 0; q < NI; ++q) {
        const int item = item0 + q * istride, b = item >> 4, hd = item & 15, g = hd >> 3;
        const size_t sidx = ((size_t)(b * 16 + hd) * 64 + p) * 128 + n0;
#pragma unroll
        for (int i = 0; i < 4; ++i) hs[q][i] = __builtin_nontemporal_load((const f32x4*)(P->state_ssm + sidx + i * 4));
#pragma unroll
        for (int i = 0; i < 4; ++i) {
            const int t = TP + b * 4 + i;
            xv[q][i] = bf2f(xact[(size_t)t * 1536 + hd * 64 + p]);
            dtv[q][i] = dtb[(size_t)t * 16 + hd];
            rb[q][i][0] = ld8(xact + (size_t)t * 1536 + 1024 + g * 128 + n0); rb[q][i][1] = ld8(xact + (size_t)t * 1536 + 1024 + g * 128 + n0 + 8);
            rc[q][i][0] = ld8(xact + (size_t)t * 1536 + 1280 + g * 128 + n0); rc[q][i][1] = ld8(xact + (size_t)t * 1536 + 1280 + g * 128 + n0 + 8);
        }
    }
#pragma unroll
    for (int q = 0; q < NI; ++q) {
        const int item = item0 + q * istride, b = item >> 4, hd = item & 15;
        const float a = -expf(P->a_log[hd]);
        const float Dh = P->ssm_d[hd];
        const size_t sidx = ((size_t)(b * 16 + hd) * 64 + p) * 128 + n0;
        float h[16];
#pragma unroll
        for (int i = 0; i < 4; ++i) { h[i * 4] = hs[q][i][0]; h[i * 4 + 1] = hs[q][i][1]; h[i * 4 + 2] = hs[q][i][2]; h[i * 4 + 3] = hs[q][i][3]; }
#pragma unroll
        for (int i = 0; i < 4; ++i) {
            const int t = TP + b * 4 + i;
            const float dA = __expf(dtv[q][i] * a), dx = dtv[q][i] * xv[q][i];
            float Bv[16], Cv[16];
            { float t8[8]; unpack8(rb[q][i][0], t8);
#pragma unroll
              for (int e = 0; e < 8; ++e) Bv[e] = t8[e];
              unpack8(rb[q][i][1], t8);
#pragma unroll
              for (int e = 0; e < 8; ++e) Bv[8 + e] = t8[e];
              unpack8(rc[q][i][0], t8);
#pragma unroll
              for (int e = 0; e < 8; ++e) Cv[e] = t8[e];
              unpack8(rc[q][i][1], t8);
#pragma unroll
              for (int e = 0; e < 8; ++e) Cv[8 + e] = t8[e]; }
            float part = 0.f;
#pragma unroll
            for (int e = 0; e < 16; ++e) { h[e] = h[e] * dA + dx * Bv[e]; part += h[e] * Cv[e]; }
            part += __shfl_xor(part, 1); part += __shfl_xor(part, 2); part += __shfl_xor(part, 4);
            if ((tid & 7) == 0) ybuf[(size_t)t * 1024 + hd * 64 + p] = f2bf(part + Dh * xv[q][i]);
        }
        float* so = P->out + O_SSMS + sidx;
#pragma unroll
        for (int i = 0; i < 4; ++i) __builtin_nontemporal_store((f32x4){h[i * 4], h[i * 4 + 1], h[i * 4 + 2], h[i * 4 + 3]}, (f32x4*)(so + i * 4));
    }
}

__device__ __forceinline__ void phase_gatednorm(PP P, int gw, int nw, const int tid) {
    const int lane = tid & 63;
    char* ws = P->ws;
    const bf16_t* ybuf = (const bf16_t*)(ws + W_Y); const bf16_t* zbuf = (const bf16_t*)(ws + W_Z);
    bf16_t* mix = (bf16_t*)(ws + W_MIX);
    for (int row0 = gw; row0 < TT; row0 += 4 * nw) {
        u32x2 yv[4][4], zv[4][4];
#pragma unroll
        for (int r = 0; r < 4; ++r) { const int row = row0 + r * nw; if (row < TT) {
#pragma unroll
            for (int j = 0; j < 4; ++j) { yv[r][j] = *(const u32x2*)(ybuf + (size_t)row * 1024 + j * 256 + lane * 4); zv[r][j] = *(const u32x2*)(zbuf + (size_t)row * 1024 + j * 256 + lane * 4); } } }
#pragma unroll
        for (int r = 0; r < 4; ++r) { const int row = row0 + r * nw; if (row < TT) {
            float t[4][4]; float ss0 = 0.f, ss1 = 0.f;
#pragma unroll
            for (int j = 0; j < 4; ++j) {
                const float y0 = bflo(yv[r][j].x), y1 = bfhi(yv[r][j].x), y2 = bflo(yv[r][j].y), y3 = bfhi(yv[r][j].y);
                const float z0 = bflo(zv[r][j].x), z1 = bfhi(zv[r][j].x), z2 = bflo(zv[r][j].y), z3 = bfhi(zv[r][j].y);
                t[j][0] = y0 * silu_f(z0); t[j][1] = y1 * silu_f(z1); t[j][2] = y2 * silu_f(z2); t[j][3] = y3 * silu_f(z3);
                const float q = t[j][0] * t[j][0] + t[j][1] * t[j][1] + t[j][2] * t[j][2] + t[j][3] * t[j][3];
                if (j < 2) ss0 += q; else ss1 += q;
            }
            ss0 = wave_sum(ss0); ss1 = wave_sum(ss1);
            const float r0 = rsqrtf(ss0 * (1.0f / 512.0f) + EPS), r1 = rsqrtf(ss1 * (1.0f / 512.0f) + EPS);
#pragma unroll
            for (int j = 0; j < 4; ++j) {
                const float rr = j < 2 ? r0 : r1;
                const f32x4 g4 = *(const f32x4*)(P->ssm_norm + j * 256 + lane * 4);
                u32x2 o; o.x = pk2(t[j][0] * rr * g4[0], t[j][1] * rr * g4[1]); o.y = pk2(t[j][2] * rr * g4[2], t[j][3] * rr * g4[3]);
                *(u32x2*)(mix + (size_t)row * 2048 + j * 256 + lane * 4) = o;
            }
        } }
    }
}

__device__ __forceinline__ void phase_norm(PP P, const float* gain, bool final_out, int gw, int nw, const int tid) {
    const int lane = tid & 63;
    char* ws = P->ws;
    const bf16_t* hb = (const bf16_t*)(ws + W_H);
    const float* ss3 = (const float*)(ws + W_SS3);
    for (int row0 = gw; row0 < TT; row0 += 4 * nw) {
        u32x2 xv[4][4]; float sq[4];
#pragma unroll
        for (int r = 0; r < 4; ++r) { const int row = row0 + r * nw; if (row < TT) { sq[r] = ss3[row];
#pragma unroll
            for (int j = 0; j < 4; ++j) xv[r][j] = *(const u32x2*)(hb + (size_t)row * 1024 + j * 256 + lane * 4); } }
#pragma unroll
        for (int r = 0; r < 4; ++r) { const int row = row0 + r * nw; if (row < TT) {
            const float rstd = rsqrtf(sq[r] * (1.0f / 1024.0f) + EPS);
#pragma unroll
            for (int j = 0; j < 4; ++j) {
                const f32x4 g4 = *(const f32x4*)(gain + j * 256 + lane * 4);
                const f32x4 x = (f32x4){bflo(xv[r][j].x), bfhi(xv[r][j].x), bflo(xv[r][j].y), bfhi(xv[r][j].y)};
                __builtin_nontemporal_store(x * rstd * g4, (f32x4*)(P->out + O_YP + (size_t)row * 1024 + j * 256 + lane * 4));
            }
        } }
    }
}

__device__ __forceinline__ void attn_sample(PP P, int item, char* shm, const int tid) {
    const int w = tid >> 6, lane = tid & 63, fr = lane & 15, fq = lane >> 4;
    const int b = item >> 2, hh = item & 3;
    char* ws = P->ws;
    const bf16_t* qb = (const bf16_t*)(ws + W_Q);
    float* sc = (float*)shm;
    float* part = (float*)(shm + 4096);
    const float* vp = P->cache_v + ((size_t)(b * 256 + w * 32) * 4 + hh) * 256 + lane * 4;
    f32x4 v0[16], v1[16];
#pragma unroll
    for (int mm = 0; mm < 16; ++mm) v0[mm] = __builtin_nontemporal_load((const f32x4*)(vp + (size_t)mm * 1024));
    bf16x8 qf[8];
#pragma unroll
    for (int kk = 0; kk < 8; ++kk) {
        bf16x8 z = {0, 0, 0, 0, 0, 0, 0, 0};
        if (fr < 4) z = *(const bf16x8*)(qb + (size_t)(TP + b * 4 + fr) * 1024 + hh * 256 + kk * 32 + fq * 8);
        qf[kk] = z;
    }
#pragma unroll
    for (int mt = 0; mt < 2; ++mt) {
        const int key = w * 32 + mt * 16 + fr;
        const float* kp = P->cache_k + ((size_t)(b * 256 + key) * 4 + hh) * 256 + fq * 8;
        f32x4 k0[8], k1[8];
#pragma unroll
        for (int kk = 0; kk < 8; ++kk) { k0[kk] = __builtin_nontemporal_load((const f32x4*)(kp + kk * 32)); k1[kk] = __builtin_nontemporal_load((const f32x4*)(kp + kk * 32 + 4)); }
        f32x4 acc = (f32x4){0.f, 0.f, 0.f, 0.f};
#pragma unroll
        for (int kk = 0; kk < 8; ++kk) {
            u32x4 pk; pk.x = pk2(k0[kk][0], k0[kk][1]); pk.y = pk2(k0[kk][2], k0[kk][3]); pk.z = pk2(k1[kk][0], k1[kk][1]); pk.w = pk2(k1[kk][2], k1[kk][3]);
            acc = __builtin_amdgcn_mfma_f32_16x16x32_bf16(qf[kk], __builtin_bit_cast(bf16x8, pk), acc, 0, 0, 0);
        }
        if (fq == 0) {
#pragma unroll
            for (int j = 0; j < 4; ++j) sc[j * 256 + w * 32 + mt * 16 + fr] = acc[j];
        }
    }
    LDS_BARRIER();
#pragma unroll
    for (int mm = 0; mm < 16; ++mm) v1[mm] = __builtin_nontemporal_load((const f32x4*)(vp + (size_t)(16 + mm) * 1024));
    if (w < 4) {
        f32x4 s = *(const f32x4*)(sc + w * 256 + lane * 4);
        float m = fmaxf(fmaxf(s[0], s[1]), fmaxf(s[2], s[3])); m = wave_max(m);
        s[0] = __expf(s[0] - m); s[1] = __expf(s[1] - m); s[2] = __expf(s[2] - m); s[3] = __expf(s[3] - m);
        float su = (s[0] + s[1]) + (s[2] + s[3]); su = wave_sum(su);
        const float inv = 1.0f / su;
        *(f32x4*)(sc + w * 256 + lane * 4) = s * inv;
    }
    LDS_BARRIER();
    {
        f32x4 o[4];
#pragma unroll
        for (int i = 0; i < 4; ++i) o[i] = (f32x4){0.f, 0.f, 0.f, 0.f};
#pragma unroll
        for (int mm = 0; mm < 16; ++mm) {
#pragma unroll
            for (int i = 0; i < 4; ++i) o[i] += sc[i * 256 + w * 32 + mm] * v0[mm];
        }
#pragma unroll
        for (int mm = 0; mm < 16; ++mm) {
#pragma unroll
            for (int i = 0; i < 4; ++i) o[i] += sc[i * 256 + w * 32 + 16 + mm] * v1[mm];
        }
#pragma unroll
        for (int i = 0; i < 4; ++i) *(f32x4*)(part + (w * 4 + i) * 256 + lane * 4) = o[i];
    }
    LDS_BARRIER();
    {
        const int i = tid >> 7, d2 = (tid & 127) * 2;
        float s0 = 0.f, s1 = 0.f;
#pragma unroll
        for (int ww = 0; ww < 8; ++ww) { s0 += part[(ww * 4 + i) * 256 + d2]; s1 += part[(ww * 4 + i) * 256 + d2 + 1]; }
        *(unsigned*)((bf16_t*)(ws + W_O) + (size_t)(TP + b * 4 + i) * 1024 + hh * 256 + d2) = pk2(s0, s1);
    }
    LDS_BARRIER();
}

__device__ __forceinline__ void phase_ffnconv(PP P, int gtid, int nthreads) {
    char* ws = P->ws;
    const bf16_t* u = (const bf16_t*)(ws + W_U);
    bf16_t* act = (bf16_t*)(ws + W_ACT);
    for (int idx = gtid; idx < 1152 * 352; idx += nthreads) {
        const int run = idx / 352, cg = idx % 352;
        const bool samp = run >= 1024;
        int t0, len, bidx, tl0;
        if (!samp) { t0 = run * 16; len = 16; bidx = t0 >> 11; tl0 = t0 & 2047; } else { bidx = run - 1024; t0 = TP + bidx * 4; len = 4; tl0 = 0; }
        const int cgc = cg * 8, cvc = 2816 + cg * 8;
        float wg0[8], wg1[8], wg2[8], wv0[8], wv1[8], wv2[8], bg[8], bv[8], hg0[8], hg1[8], hv0[8], hv1[8];
#pragma unroll
        for (int e = 0; e < 8; ++e) {
            wg0[e] = P->ffn_w[cgc + e]; wg1[e] = P->ffn_w[5632 + cgc + e]; wg2[e] = P->ffn_w[11264 + cgc + e];
            wv0[e] = P->ffn_w[cvc + e]; wv1[e] = P->ffn_w[5632 + cvc + e]; wv2[e] = P->ffn_w[11264 + cvc + e];
            bg[e] = P->ffn_b[cgc + e]; bv[e] = P->ffn_b[cvc + e];
        }
        if (samp) {
#pragma unroll
            for (int e = 0; e < 8; ++e) {
                hg0[e] = P->state_ffn[(size_t)(bidx * 2 + 0) * 5632 + cgc + e]; hg1[e] = P->state_ffn[(size_t)(bidx * 2 + 1) * 5632 + cgc + e];
                hv0[e] = P->state_ffn[(size_t)(bidx * 2 + 0) * 5632 + cvc + e]; hv1[e] = P->state_ffn[(size_t)(bidx * 2 + 1) * 5632 + cvc + e];
            }
        } else if (tl0 > 0) {
            unpack8(ld8(u + (size_t)(t0 - 2) * 5632 + cgc), hg0); unpack8(ld8(u + (size_t)(t0 - 1) * 5632 + cgc), hg1);
            unpack8(ld8(u + (size_t)(t0 - 2) * 5632 + cvc), hv0); unpack8(ld8(u + (size_t)(t0 - 1) * 5632 + cvc), hv1);
        } else {
#pragma unroll
            for (int e = 0; e < 8; ++e) { hg0[e] = 0.f; hg1[e] = 0.f; hv0[e] = 0.f; hv1[e] = 0.f; }
        }
        for (int jb = 0; jb < len; jb += 8) {
        u32x4 rg[8], rv[8];
        const bf16_t* ub = u + (size_t)(t0 + jb) * 5632 + cgc;
#pragma unroll
        for (int jj = 0; jj < 8; ++jj) { if (jb + jj < len) { rg[jj] = ld8(ub + (size_t)jj * 5632); rv[jj] = ld8(ub + (size_t)jj * 5632 + 2816); } }
#pragma unroll
        for (int jj = 0; jj < 8; ++jj) {
            const int j = jb + jj;
            if (j < len) {
            float ug[8], uv[8], o8[8];
            unpack8(rg[jj], ug); unpack8(rv[jj], uv);
#pragma unroll
            for (int e = 0; e < 8; ++e) {
                const float gc = bg[e] + wg0[e] * hg0[e] + wg1[e] * hg1[e] + wg2[e] * ug[e];
                const float vc = bv[e] + wv0[e] * hv0[e] + wv1[e] * hv1[e] + wv2[e] * uv[e];
                o8[e] = silu_f(gc) * vc;
            }
            *(u32x4*)(act + (size_t)(t0 + j) * 2816 + cgc) = pack8(o8);
            float* o = nullptr;
            if (samp) { if (j >= 2) o = P->out + O_FFNS + (size_t)(bidx * 2 + j - 2) * 5632; }
            else { const int tl = tl0 + j; if (tl >= 2046) o = P->out + O_FFNP + (size_t)(bidx * 2 + tl - 2046) * 5632; }
            if (o) {
#pragma unroll
                for (int e = 0; e < 8; ++e) { o[cgc + e] = ug[e]; o[cvc + e] = uv[e]; }
            }
#pragma unroll
            for (int e = 0; e < 8; ++e) { hg0[e] = hg1[e]; hg1[e] = ug[e]; hv0[e] = hv1[e]; hv1[e] = uv[e]; }
            }
        }
        }
    }
}

#define XB_TMO      128
#define XB_XCNT(j)  (256  + 64 * (j))
#define XB_XSUB(j)  (1280 + 64 * (j))
#define XB_XGEN(j)  (2304 + 64 * (j))
#define XB_TOP      3328
#define XB_TOPGEN   3392
#define XCD_BAR_WORDS 3456
#define XB_SPIN_CAP (1u << 18)
__device__ __forceinline__ unsigned xb_ld(unsigned* p)              { return __hip_atomic_load(p, __ATOMIC_RELAXED, __HIP_MEMORY_SCOPE_AGENT); }
__device__ __forceinline__ unsigned xb_add(unsigned* p, unsigned v) { return __hip_atomic_fetch_add(p, v, __ATOMIC_RELAXED, __HIP_MEMORY_SCOPE_AGENT); }
__device__ __forceinline__ unsigned xb_xcc_id() { return (unsigned)__builtin_amdgcn_s_getreg((3 << 11) | 20) & 0xFu; }
#define XB_SPIN(cond, bar) do { unsigned _sp = 0; while (cond) { __builtin_amdgcn_s_sleep(1); \
    if ((++_sp & 255u) == 0u) { if (xb_ld(&(bar)[XB_TMO])) break; if (_sp > XB_SPIN_CAP) { atomicAdd(&(bar)[XB_TMO], 1u); break; } } } } while (0)
__device__ __forceinline__ void xcd_barrier_complete(unsigned* bar, unsigned x, unsigned& nloc, unsigned& nx) {
    const unsigned G = gridDim.x;
    unsigned sum, cnt, mine, sp = 0u;
    for (;;) {
        sum = 0u; cnt = 0u; mine = 0u;
#pragma unroll
        for (unsigned j = 0; j < 16; ++j) { const unsigned c = xb_ld(&bar[XB_XCNT(j)]); sum += c; cnt += (c > 0u) ? 1u : 0u; mine = (j == x) ? c : mine; }
        if (sum == G) break;
        __builtin_amdgcn_s_sleep(1);
        if ((++sp & 255u) == 0u) { if (xb_ld(&bar[XB_TMO])) break; if (sp > XB_SPIN_CAP) { atomicAdd(&bar[XB_TMO], 1u); break; } }
    }
    nloc = mine > 0u ? mine : 1u; nx = cnt > 0u ? cnt : 1u;
}
__device__ __forceinline__ void xcd_barrier(unsigned* bar, volatile LDSB unsigned* st, const int tid) {
    asm volatile("s_waitcnt vmcnt(0)" ::: "memory");
    __syncthreads();
    if (tid == 0) {
        const unsigned x = xb_xcc_id();
        __builtin_amdgcn_s_waitcnt(0);
        unsigned nloc = st[0], nx = st[1];
        if (nloc == 0u) { xcd_barrier_complete(bar, x, nloc, nx); st[0] = nloc; st[1] = nx; }
        const unsigned old = xb_add(&bar[XB_XSUB(x)], 1u);
        const unsigned gen = old / nloc;
        if (old + 1u == (gen + 1u) * nloc) {
            __builtin_amdgcn_fence(__ATOMIC_RELEASE, "agent");
            asm volatile("s_waitcnt vmcnt(0)" ::: "memory");
            const unsigned og = xb_add(&bar[XB_TOP], 1u);
            const unsigned tg = og / nx;
            if (og + 1u == (tg + 1u) * nx) xb_add(&bar[XB_TOPGEN], 1u);
            else XB_SPIN(xb_ld(&bar[XB_TOPGEN]) == tg, bar);
            __builtin_amdgcn_fence(__ATOMIC_ACQUIRE, "agent");
            xb_add(&bar[XB_XGEN(x)], 1u);
            asm volatile("s_waitcnt vmcnt(0)" ::: "memory");
        } else {
            XB_SPIN(xb_ld(&bar[XB_XGEN(x)]) == gen, bar);
            __builtin_amdgcn_fence(__ATOMIC_ACQUIRE, "agent");
            asm volatile("s_waitcnt vmcnt(0)" ::: "memory");
        }
    }
    __syncthreads();
}

extern __shared__ __attribute__((aligned(16))) char smem[];

__global__ void __launch_bounds__(NTHR) hybrid_fwd(Params Pin) {
    char* shm = smem;
    volatile LDSB unsigned* bst = (volatile LDSB unsigned*)(smem + 139264);
    if (threadIdx.x == 0) { bst[0] = 0u; bst[1] = 0u; (void)xb_add((unsigned*)(Pin.ws + W_BAR) + XB_XCNT(xb_xcc_id()), 1u); }
    __syncthreads();
    for (int ph = Pin.ph_lo; ph < Pin.ph_hi; ++ph) {
        if (ph == 6 || ph == 11) continue;
        const int reps = ((REPEAT_MASK >> ph) & 1) ? 2 : 1;
        for (int rep = 0; rep < reps; ++rep) {
        if (rep > 0) xcd_barrier((unsigned*)(Pin.ws + W_BAR), bst, threadIdx.x);
        int tid = threadIdx.x, blk = blockIdx.x, nblk = gridDim.x;
        asm volatile("" : "+v"(tid));
        asm volatile("" : "+s"(blk), "+s"(nblk));
        PP P = (PP)__builtin_amdgcn_kernarg_segment_ptr();
        asm volatile("" : "+s"(P));
        const int lb = (blk & 7) * (nblk >> 3) + (blk >> 3);
        const int gtid = blk * NTHR + tid, nthreads = nblk * NTHR;
        const int gw = blk * 8 + (tid >> 6), nw = nblk * 8;
        switch (ph) {
#if PHASE_MASK & 1
        case 0: phase_prep(P, shm, blk, nblk, tid); break;
#endif
#if PHASE_MASK & 4
        case 2: phase_convpool(P, gtid, nthreads); break;
#endif
#if PHASE_MASK & 8
        case 3:
            if (blk & 1) { int it = blk; for (; it + nblk < 2048; it += 2 * nblk) ssd_sample<2>(P, it, nblk, tid); for (; it < 2048; it += nblk) ssd_sample<1>(P, it, nblk, tid); }
            for (int it = blk; it < 256; it += nblk) ssd_prompt(P, it, shm, tid);
            if (!(blk & 1)) { int it = blk; for (; it + nblk < 2048; it += 2 * nblk) ssd_sample<2>(P, it, nblk, tid); for (; it < 2048; it += nblk) ssd_sample<1>(P, it, nblk, tid); }
            break;
#endif
#if PHASE_MASK & 16
        case 4: phase_gatednorm(P, gw, nw, tid); break;
#endif
#if PHASE_MASK & 64
        case 6: phase_norm(P, P->norm_mem, false, gw, nw, tid); break;
        case 11: phase_norm(P, P->norm_ffn, false, gw, nw, tid); break;
        case 15: phase_norm(P, P->final_norm, true, gw, nw, tid); break;
#endif
#if PHASE_MASK & 8192
        case 13: phase_ffnconv(P, gtid, nthreads); break;
#endif
        default: break;
        }
#if PHASE_MASK & 256
        if (ph == 8 && (blk & 1)) { for (int it = blk; it < 512; it += nblk) attn_sample(P, it, shm, tid); __syncthreads(); }
#endif
#if PHASE_MASK & 2
        if (ph == 1 || ph == 3 || ph == 5 || ph == 7 || ph == 8 || ph == 9 || ph == 10 || ph == 12 || ph == 14) gemm_phase(P, ph, shm, lb, blk, nblk, tid);
#endif
#if PHASE_MASK & 256
        if (ph == 9 && !(blk & 1)) { for (int it = blk; it < 512; it += nblk) attn_sample(P, it, shm, tid); }
#endif
        }
        if (ph + 1 < Pin.ph_hi && ph != 8) xcd_barrier((unsigned*)(Pin.ws + W_BAR), bst, threadIdx.x);
        if (ph == 8) { asm volatile("s_waitcnt vmcnt(0)" ::: "memory"); __syncthreads(); }
        if (EXTRA_SYNCS && ph == 0) { for (int i = 0; i < EXTRA_SYNCS; ++i) xcd_barrier((unsigned*)(Pin.ws + W_BAR), bst, threadIdx.x); }
    }
}

extern "C" void kernel_launch(void* const* d_in, const int* in_sizes, int n_in, void* d_out, int out_size, void* d_ws, size_t ws_size, hipStream_t stream) {
    static int grid_blocks = 0;
    if (!grid_blocks) {
        int dev = 0, cus = 0, per_cu = 0;
        hipGetDevice(&dev);
        hipDeviceGetAttribute(&cus, hipDeviceAttributeMultiprocessorCount, dev);
        hipFuncSetAttribute((const void*)hybrid_fwd, hipFuncAttributeMaxDynamicSharedMemorySize, LDS_BYTES);
        hipOccupancyMaxActiveBlocksPerMultiprocessor(&per_cu, hybrid_fwd, NTHR, LDS_BYTES);
        if (per_cu < 1) per_cu = 1;
        grid_blocks = cus * 1;
        grid_blocks &= ~7;
        if (grid_blocks < 8) grid_blocks = 8;
    }
    Params p{};
    const float* const* in = (const float* const*)d_in;
    p.x_prompt = in[0]; p.x_sample = in[1]; p.mem_prompt = in[2]; p.state_ssm = in[3]; p.state_conv = in[4]; p.state_pool = in[5]; p.state_ffn = in[6];
    p.cache_k = in[7]; p.cache_v = in[8]; p.norm_mix = in[9]; p.w_in = in[10]; p.conv_w = in[11]; p.conv_b = in[12]; p.dt_bias = in[13]; p.a_log = in[14];
    p.ssm_d = in[15]; p.ssm_norm = in[16]; p.w_pool = in[17]; p.pool_scale = in[18]; p.w_out = in[19]; p.norm_mem = in[20]; p.norm_memkv = in[21];
    p.w_mq = in[22]; p.w_mk = in[23]; p.w_mv = in[24]; p.w_mo = in[25]; p.norm_ffn = in[26]; p.w_up = in[27]; p.ffn_w = in[28]; p.ffn_b = in[29];
    p.w_down = in[30]; p.final_norm = in[31];
    p.out = (float*)d_out; p.ws = (char*)d_ws; p.ph_lo = 0; p.ph_hi = 16;
    hipMemsetAsync((char*)d_ws + W_BAR, 0, 16384, stream);
    void* args[] = {&p};
    hipError_t e = hipLaunchCooperativeKernel((const void*)hybrid_fwd, dim3(grid_blocks), dim3(NTHR), args, LDS_BYTES, stream);
    if (e != hipSuccess) fprintf(stderr, "cooperative launch failed: %s (grid %d)\n", hipGetErrorString(e), grid_blocks);
}
```

```cpp
#include <hip/hip_runtime.h>
#include <hip/hip_cooperative_groups.h>
#include <cstdio>
namespace cg = cooperative_groups;

typedef unsigned short bf16_t;
typedef short bf16x8 __attribute__((ext_vector_type(8)));
typedef short s16x4 __attribute__((ext_vector_type(4)));
typedef float f32x4 __attribute__((ext_vector_type(4)));
typedef unsigned u32x4 __attribute__((ext_vector_type(4)));
typedef unsigned u32x2 __attribute__((ext_vector_type(2)));
#define LDSB __attribute__((address_space(3)))

constexpr int TP = 16384, TS = 512, TT = TP + TS;
constexpr int NTHR = 512;
constexpr int LDS_BYTES = 139264 + 256;
constexpr float EPS = 1e-6f;
#ifndef PHASE_MASK
#define PHASE_MASK 0xFFFF
#endif
#ifndef REPEAT_MASK
#define REPEAT_MASK 0
#endif
#ifndef PROBE3
#define PROBE3 0
#endif
#ifndef EXTRA_SYNCS
#define EXTRA_SYNCS 0
#endif

constexpr size_t O_YP = 0;
constexpr size_t O_YS = O_YP + (size_t)TP * 1024;
constexpr size_t O_SSMP = O_YS + (size_t)TS * 1024;
constexpr size_t O_SSMS = O_SSMP + (size_t)8 * 16 * 64 * 128;
constexpr size_t O_CONVP = O_SSMS + (size_t)128 * 16 * 64 * 128;
constexpr size_t O_CONVS = O_CONVP + (size_t)8 * 3 * 1536;
constexpr size_t O_POOLP = O_CONVS + (size_t)128 * 3 * 1536;
constexpr size_t O_POOLS = O_POOLP + (size_t)8 * 15 * 1024;
constexpr size_t O_FFNP = O_POOLS + (size_t)128 * 15 * 1024;
constexpr size_t O_FFNS = O_FFNP + (size_t)8 * 2 * 5632;
constexpr size_t O_MK = O_FFNS + (size_t)128 * 2 * 5632;
constexpr size_t O_MV = O_MK + (size_t)8 * 256 * 1024;

constexpr size_t W_WIN = 0;
constexpr size_t W_WPOOL = W_WIN + (size_t)3584 * 1024 * 2;
constexpr size_t W_WOUT = W_WPOOL + (size_t)4 * 256 * 256 * 2;
constexpr size_t W_WMQ = W_WOUT + (size_t)1024 * 2048 * 2;
constexpr size_t W_WMK = W_WMQ + (size_t)1024 * 1024 * 2;
constexpr size_t W_WMV = W_WMK + (size_t)1024 * 1024 * 2;
constexpr size_t W_WMO = W_WMV + (size_t)1024 * 1024 * 2;
constexpr size_t W_WUP = W_WMO + (size_t)1024 * 1024 * 2;
constexpr size_t W_WDOWN = W_WUP + (size_t)5632 * 1024 * 2;
constexpr size_t W_H = W_WDOWN + (size_t)1024 * 2816 * 2;
constexpr size_t W_HM = W_H + (size_t)TT * 1024 * 2;
constexpr size_t W_KB = W_HM + (size_t)2048 * 1024 * 2;
constexpr size_t W_VT = W_KB + (size_t)2048 * 1024 * 2;
constexpr size_t W_DT = W_VT + (size_t)2048 * 1024 * 2;
constexpr size_t W_XRES = W_DT + (size_t)TT * 16 * 4;
constexpr size_t W_ARENA = W_XRES + (size_t)TT * 1024 * 4;
constexpr size_t W_Z = W_ARENA;
constexpr size_t W_PROJ2 = W_Z + (size_t)TT * 1024 * 2;
constexpr size_t W_XACT = W_PROJ2 + (size_t)TT * 2560 * 2;
constexpr size_t W_POOLED = W_XACT + (size_t)TT * 1536 * 2;
constexpr size_t W_Y = W_POOLED + (size_t)TT * 1024 * 2;
constexpr size_t W_MIX = W_Y + (size_t)TT * 1024 * 2;
constexpr size_t W_END_A = W_MIX + (size_t)TT * 2048 * 2;
constexpr size_t W_Q = W_PROJ2;
constexpr size_t W_P = W_Q + (size_t)TT * 1024 * 2;
constexpr size_t W_O = W_P + (size_t)TP * 1024 * 2;
constexpr size_t W_U = W_ARENA;
constexpr size_t W_ACT = W_U + (size_t)TT * 5632 * 2;
constexpr size_t W_END_C = W_ACT + (size_t)TT * 2816 * 2;
constexpr size_t W_BAR = W_END_A;
constexpr size_t W_SS1 = W_BAR + 16384;
constexpr size_t W_SS2 = W_SS1 + (size_t)TT * 4;
constexpr size_t W_SS3 = W_SS2 + (size_t)TT * 4;
constexpr size_t W_WLO = W_SS3 + (size_t)TT * 4;
constexpr size_t W_TOTAL = W_WLO + (size_t)1024 * 1024 * 2;
static_assert(W_O + (size_t)TT * 1024 * 2 <= W_POOLED, "era B overflow");
static_assert(W_END_C <= W_END_A, "era C overflow");

struct Params {
    const float *x_prompt, *x_sample, *mem_prompt, *state_ssm, *state_conv, *state_pool, *state_ffn, *cache_k, *cache_v;
    const float *norm_mix, *w_in, *conv_w, *conv_b, *dt_bias, *a_log, *ssm_d, *ssm_norm, *w_pool, *pool_scale, *w_out;
    const float *norm_mem, *norm_memkv, *w_mq, *w_mk, *w_mv, *w_mo, *norm_ffn, *w_up, *ffn_w, *ffn_b, *w_down, *final_norm;
    float* out;
    char* ws;
    int ph_lo, ph_hi;
};

typedef const __attribute__((address_space(4))) Params* PP;

__device__ __forceinline__ unsigned pk2(float lo, float hi) { unsigned r; asm("v_cvt_pk_bf16_f32 %0, %1, %2" : "=v"(r) : "v"(lo), "v"(hi)); return r; }
__device__ __forceinline__ bf16_t f2bf(float f) { return (bf16_t)(pk2(f, 0.f) & 0xffffu); }
__device__ __forceinline__ float bf2f(bf16_t b) { return __uint_as_float(((unsigned)b) << 16); }
__device__ __forceinline__ float bflo(unsigned u) { return __uint_as_float(u << 16); }
__device__ __forceinline__ float bfhi(unsigned u) { return __uint_as_float(u & 0xffff0000u); }
__device__ __forceinline__ void unpack8(u32x4 v, float (&f)[8]) {
    f[0] = bflo(v.x); f[1] = bfhi(v.x); f[2] = bflo(v.y); f[3] = bfhi(v.y); f[4] = bflo(v.z); f[5] = bfhi(v.z); f[6] = bflo(v.w); f[7] = bfhi(v.w);
}
__device__ __forceinline__ u32x4 pack8(const float (&f)[8]) { u32x4 r; r.x = pk2(f[0], f[1]); r.y = pk2(f[2], f[3]); r.z = pk2(f[4], f[5]); r.w = pk2(f[6], f[7]); return r; }
__device__ __forceinline__ float wave_sum(float v) {
#pragma unroll
    for (int o = 1; o < 64; o <<= 1) v += __shfl_xor(v, o);
    return v;
}
__device__ __forceinline__ float wave_max(float v) {
#pragma unroll
    for (int o = 1; o < 64; o <<= 1) v = fmaxf(v, __shfl_xor(v, o));
    return v;
}
__device__ __forceinline__ float silu_f(float x) { return x / (1.0f + __expf(-x)); }

constexpr int HTB = 128 * 64 * 2;
__device__ __forceinline__ int lds_byte(int r, int c) { const int st = (r >> 4) * 2 + (c >> 5), rr = r & 15, cc = c & 31, ob = rr * 64 + cc * 2; return st * 1024 + (ob ^ (((ob >> 9) & 1) << 5)); }
__device__ __forceinline__ void stage_rc(int b, int& R, int& C) { const int st = b / 1024, sb = b % 1024, swz = sb ^ (((sb >> 9) & 1) << 5); R = (st >> 1) * 16 + swz / 64; C = (st & 1) * 32 + (swz % 64) / 2; }

enum { E_PROJ = 0, E_MEMKV, E_POOL, E_OUT, E_Q, E_QK, E_PV, E_MO, E_UP, E_DOWN, E_FOLD };

template <int EK>
__device__ __forceinline__ float epi_apply(PP P, int row, int col, f32x4 v) {
    char* ws = P->ws;
    if constexpr (EK == E_PROJ) {
        u32x2 o; o.x = pk2(v[0], v[1]); o.y = pk2(v[2], v[3]);
        if (col < 1024) *(u32x2*)((bf16_t*)(ws + W_Z) + (size_t)row * 1024 + col) = o;
        else *(u32x2*)((bf16_t*)(ws + W_PROJ2) + (size_t)row * 2560 + (col - 1024)) = o;
    } else if constexpr (EK == E_MEMKV) {
        if (col < 1024) {
            *(f32x4*)(P->out + O_MK + (size_t)row * 1024 + col) = v;
            u32x2 o; o.x = pk2(v[0], v[1]); o.y = pk2(v[2], v[3]);
            *(u32x2*)((bf16_t*)(ws + W_KB) + (size_t)row * 1024 + col) = o;
        } else {
            const int c = col - 1024;
            *(f32x4*)(P->out + O_MV + (size_t)row * 1024 + c) = v;
            const int b = row >> 8, m = row & 255, hh = c >> 8, d = c & 255;
            bf16_t* vt = (bf16_t*)(ws + W_VT) + ((size_t)(b * 4 + hh) * 256 + d) * 256 + m;
#pragma unroll
            for (int j = 0; j < 4; ++j) vt[j * 256] = f2bf(v[j]);
        }
    } else if constexpr (EK == E_POOL) {
        const f32x4 sc = *(const f32x4*)(P->pool_scale + col);
        u32x2 o; o.x = pk2(v[0] * sc[0], v[1] * sc[1]); o.y = pk2(v[2] * sc[2], v[3] * sc[3]);
        *(u32x2*)((bf16_t*)(ws + W_MIX) + (size_t)row * 2048 + 1024 + col) = o;
    } else if constexpr (EK == E_OUT) {
        const float* xin = row < TP ? P->x_prompt + (size_t)row * 1024 : P->x_sample + (size_t)(row - TP) * 1024;
        const f32x4 x = *(const f32x4*)(xin + col) + v;
        u32x2 o; o.x = pk2(x[0], x[1]); o.y = pk2(x[2], x[3]);
        *(u32x2*)((bf16_t*)(ws + W_H) + (size_t)row * 1024 + col) = o;
        return (x[0] * x[0] + x[1] * x[1]) + (x[2] * x[2] + x[3] * x[3]);
    } else if constexpr (EK == E_Q) {
        u32x2 o; o.x = pk2(v[0], v[1]); o.y = pk2(v[2], v[3]);
        *(u32x2*)((bf16_t*)(ws + W_Q) + (size_t)row * 1024 + col) = o;
    } else if constexpr (EK == E_PV) {
        u32x2 o; o.x = pk2(v[0], v[1]); o.y = pk2(v[2], v[3]);
        *(u32x2*)((bf16_t*)(ws + W_O) + (size_t)row * 1024 + col) = o;
    } else if constexpr (EK == E_MO || EK == E_DOWN) {
        u32x2* hp = (u32x2*)((bf16_t*)(ws + W_H) + (size_t)row * 1024 + col);
        const u32x2 hv = *hp;
        const f32x4 x = (f32x4){bflo(hv.x), bfhi(hv.x), bflo(hv.y), bfhi(hv.y)} + v;
        u32x2 o; o.x = pk2(x[0], x[1]); o.y = pk2(x[2], x[3]);
        *hp = o;
        return (x[0] * x[0] + x[1] * x[1]) + (x[2] * x[2] + x[3] * x[3]);
    } else if constexpr (EK == E_UP) {
        u32x2 o; o.x = pk2(v[0], v[1]); o.y = pk2(v[2], v[3]);
        *(u32x2*)((bf16_t*)(ws + W_U) + (size_t)row * 5632 + col) = o;
    }
    return 0.f;
}
template <int EK>
__device__ __forceinline__ float epi_rowscale(PP P, int row) {
    if constexpr (EK == E_Q) return rsqrtf(((const float*)(P->ws + W_SS1))[row] * (1.0f / 1024.0f) + EPS) * 0.0625f;
    else if constexpr (EK == E_UP) return rsqrtf(((const float*)(P->ws + W_SS2))[row] * (1.0f / 1024.0f) + EPS);
    else return 1.0f;
}
__device__ __forceinline__ float epi_apply_rt(PP P, int ekind, int row, int col, f32x4 v) {
    switch (ekind) {
    case E_FOLD: { u32x2 o; o.x = pk2(v[0], v[1]); o.y = pk2(v[2], v[3]); *(u32x2*)((bf16_t*)(P->ws + W_WOUT) + (size_t)row * 2048 + 1024 + col) = o; return 0.f; }
    case E_OUT: return epi_apply<E_OUT>(P, row, col, v);
    case E_Q: return epi_apply<E_Q>(P, row, col, v * epi_rowscale<E_Q>(P, row));
    case E_MO: return epi_apply<E_MO>(P, row, col, v);
    default: return epi_apply<E_DOWN>(P, row, col, v);
    }
}
template <int EK>
__device__ __forceinline__ void epi_loop(PP P, const f32x4 (&acc)[2][2][4][2], int rbase, int cbase, int fq) {
#pragma unroll
    for (int ai = 0; ai < 2; ++ai)
#pragma unroll
        for (int m = 0; m < 4; ++m) {
            const int row = rbase + ai * 128 + m * 16;
            const float rs = epi_rowscale<EK>(P, row);
            float ss = 0.f;
#pragma unroll
            for (int bj = 0; bj < 2; ++bj)
#pragma unroll
                for (int n = 0; n < 2; ++n) {
                    if constexpr (EK == E_Q || EK == E_UP) ss += epi_apply<EK>(P, row, cbase + bj * 128 + n * 16, acc[ai][bj][m][n] * rs);
                    else ss += epi_apply<EK>(P, row, cbase + bj * 128 + n * 16, acc[ai][bj][m][n]);
                }
            if constexpr (EK == E_OUT || EK == E_MO || EK == E_DOWN) {
                ss += __shfl_xor(ss, 16); ss += __shfl_xor(ss, 32);
                if (fq == 0) unsafeAtomicAdd((float*)(P->ws + (EK == E_OUT ? W_SS1 : EK == E_MO ? W_SS2 : W_SS3)) + row, ss);
            }
        }
}

struct PhaseCfg { const char* A; const char* B; int lda, ldb, K, nbig, nsmall, ncol64, ekind; };
__device__ __forceinline__ PhaseCfg phase_cfg(PP P, int gp) {
    const char* ws = P->ws; PhaseCfg c;
    switch (gp) {
    case 1:  c.A = ws + W_H;      c.B = ws + W_WIN;   c.lda = 1024; c.ldb = 1024; c.K = 1024; c.nbig = 66 * 14 + 64; c.nsmall = 512; c.ncol64 = 16; c.ekind = E_PROJ; break;
    case 3:  c.A = ws + W_POOLED; c.B = ws + W_WPOOL; c.lda = 1024; c.ldb = 256;  c.K = 256;  c.nbig = 256; c.nsmall = 256; c.ncol64 = 16; c.ekind = E_POOL; break;
    case 5:  c.A = ws + W_MIX;    c.B = ws + W_WOUT;  c.lda = 2048; c.ldb = 2048; c.K = 2048; c.nbig = 256; c.nsmall = 256; c.ncol64 = 16; c.ekind = E_OUT; break;
    case 7:  c.A = ws + W_H;      c.B = ws + W_WMQ;   c.lda = 1024; c.ldb = 1024; c.K = 1024; c.nbig = 256; c.nsmall = 256; c.ncol64 = 16; c.ekind = E_Q; break;
    case 8:  c.A = ws + W_Q;      c.B = ws + W_KB;    c.lda = 1024; c.ldb = 1024; c.K = 256;  c.nbig = 256; c.nsmall = 0;   c.ncol64 = 16; c.ekind = E_QK; break;
    case 9:  c.A = ws + W_P;      c.B = ws + W_VT;    c.lda = 1024; c.ldb = 256;  c.K = 256;  c.nbig = 256; c.nsmall = 0;   c.ncol64 = 16; c.ekind = E_PV; break;
    case 10: c.A = ws + W_O;      c.B = ws + W_WMO;   c.lda = 1024; c.ldb = 1024; c.K = 1024; c.nbig = 256; c.nsmall = 256; c.ncol64 = 16; c.ekind = E_MO; break;
    case 12: c.A = ws + W_H;      c.B = ws + W_WUP;   c.lda = 1024; c.ldb = 1024; c.K = 1024; c.nbig = 66 * 22; c.nsmall = 0; c.ncol64 = 88; c.ekind = E_UP; break;
    default: c.A = ws + W_ACT;    c.B = ws + W_WDOWN; c.lda = 2816; c.ldb = 2816; c.K = 2816; c.nbig = 256; c.nsmall = 256; c.ncol64 = 16; c.ekind = E_DOWN; break;
    }
    return c;
}
struct UnitD { const char* A; const char* B; int row0, col0, ekind; };
__device__ __forceinline__ void map_unit(int L, int nM, int nN, int& pm, int& pn) {
    const int nwg = nM * nN, q = nwg >> 3, r = nwg & 7, xcd = L & 7, off = L >> 3;
    const int wgid = (xcd < r ? xcd * (q + 1) : r * (q + 1) + (xcd - r) * q) + off;
    const int nig = 8 * nN, gid = wgid / nig, fm = gid * 8, gsz = (nM - fm) < 8 ? (nM - fm) : 8;
    const int w = wgid - gid * nig;
    pm = fm + w % gsz; pn = w / gsz;
}
__device__ __forceinline__ UnitD unit_decode(PP P, const PhaseCfg& c, int gp, int L) {
    UnitD d; d.ekind = c.ekind;
    int pm, pn;
    switch (gp) {
    case 1:
        if (L < 924) { map_unit(L, 66, 14, pm, pn); d.A = c.A + (size_t)pm * 256 * 2048; d.B = c.B + (size_t)pn * 256 * 2048; }
        else { map_unit(L - 924, 8, 8, pm, pn); d.A = P->ws + W_HM + (size_t)pm * 256 * 2048; d.B = P->ws + W_WMK + (size_t)pn * 256 * 2048; d.ekind = E_MEMKV; }
        break;
    case 3: map_unit(L, 64, 4, pm, pn); d.A = c.A + (size_t)pm * 256 * 2048 + pn * 512; d.B = c.B + (size_t)pn * 131072; break;
    case 8: map_unit(L, 64, 4, pm, pn); d.A = c.A + (size_t)pm * 256 * 2048 + pn * 512; d.B = c.B + (size_t)(pm >> 3) * 256 * 2048 + pn * 512; break;
    case 9: map_unit(L, 64, 4, pm, pn); d.A = c.A + (size_t)pm * 256 * 2048 + pn * 512; d.B = c.B + (size_t)((pm >> 3) * 4 + pn) * 131072; break;
    case 12: map_unit(L, 66, 22, pm, pn); d.A = c.A + (size_t)pm * 256 * 2048; d.B = c.B + (size_t)pn * 256 * 2048; break;
    default: map_unit(L, 64, 4, pm, pn); d.A = c.A + (size_t)pm * 256 * c.lda * 2; d.B = c.B + (size_t)pn * 256 * c.ldb * 2; break;
    }
    d.row0 = pm * 256; d.col0 = pn * 256;
    return d;
}

__device__ __forceinline__ void gemm_phase(PP P, int gp, char* shm_g, int lb, int blk, int nblk, const int tid) {
    LDSB unsigned char* lds = (LDSB unsigned char*)shm_g;
    const int wid = __builtin_amdgcn_readfirstlane(tid >> 6), lane = tid & 63, wr = wid >> 2, wc = wid & 3, fr = lane & 15, fq = lane >> 4;
    const PhaseCfg cfg = phase_cfg(P, gp);
    const int K = cfg.K, nt = K / 64;
    unsigned voffA, voffB;
    { int R, C; stage_rc(tid * 16, R, C); voffA = (unsigned)(R * cfg.lda + C) * 2u; voffB = (unsigned)(R * cfg.ldb + C) * 2u; }
    const size_t qstepvoffA = (size_t)64 * cfg.lda * 2, qstepvoffB = (size_t)64 * cfg.ldb * 2;
    const size_t kstep = 128;
    const size_t hstepA = (size_t)128 * cfg.lda * 2, hstepB = (size_t)128 * cfg.ldb * 2;
    const unsigned ldsw = (unsigned)wid * 1024u;
    const int aoff = lds_byte(wr * 64 + fr, fq * 8), boff = lds_byte(wc * 32 + fr, fq * 8);
    const bool chain = (cfg.ekind != E_QK);
#define G_SA(b, h) (((b) * 2 + (h)) * HTB)
#define G_SB(b, h) ((4 + (b) * 2 + (h)) * HTB)
#define G_STAGE(bufoff, gbase, voff) do { \
        __builtin_amdgcn_global_load_lds((const unsigned*)((const char*)(gbase) + (voff)), (LDSB unsigned*)(lds + (bufoff) + ldsw), 16, 0, 0); \
        __builtin_amdgcn_global_load_lds((const unsigned*)((const char*)(gbase) + qstep##voff + (voff)), (LDSB unsigned*)(lds + (bufoff) + ldsw + 8192), 16, 0, 0); } while (0)
#define G_LDA(dst, b, h) do { _Pragma("unroll") for (int m = 0; m < 4; ++m) _Pragma("unroll") for (int k = 0; k < 2; ++k) dst[m][k] = *(const LDSB bf16x8*)(lds + G_SA(b, h) + aoff + m * 2048 + k * 1024); } while (0)
#define G_LDB(dst, b, h) do { _Pragma("unroll") for (int n = 0; n < 2; ++n) _Pragma("unroll") for (int k = 0; k < 2; ++k) dst[n][k] = *(const LDSB bf16x8*)(lds + G_SB(b, h) + boff + n * 2048 + k * 1024); } while (0)
#define G_MMA(ai, bj, Af, Bf) do { __builtin_amdgcn_s_setprio(1); _Pragma("unroll") for (int m = 0; m < 4; ++m) _Pragma("unroll") for (int n = 0; n < 2; ++n) _Pragma("unroll") for (int k = 0; k < 2; ++k) \
        acc[ai][bj][m][n] = __builtin_amdgcn_mfma_f32_16x16x32_bf16(Bf[n][k], Af[m][k], acc[ai][bj][m][n], 0, 0, 0); __builtin_amdgcn_s_setprio(0); } while (0)
#define G_WAIT_V(n) asm volatile("s_waitcnt vmcnt(" #n ")" ::: "memory")
#define G_WAIT_L(n) asm volatile("s_waitcnt lgkmcnt(" #n ")" ::: "memory")
#define G_BAR __builtin_amdgcn_s_barrier()
#define G_SCHED __builtin_amdgcn_sched_barrier(0)
    int u = blk;
    while (u < cfg.nbig) {
        UnitD cur = unit_decode(P, cfg, gp, u);
        f32x4 acc[2][2][4][2];
#pragma unroll
        for (int a = 0; a < 2; ++a)
#pragma unroll
            for (int b = 0; b < 2; ++b)
#pragma unroll
                for (int m = 0; m < 4; ++m)
#pragma unroll
                    for (int n = 0; n < 2; ++n) acc[a][b][m][n] = (f32x4){0.f, 0.f, 0.f, 0.f};
        bf16x8 At[4][2], B0[2][2], B1[2][2];
        const char* cA = cur.A; const char* cB = cur.B;
        G_STAGE(G_SB(0, 0), cB, voffB); G_STAGE(G_SA(0, 0), cA, voffA); G_STAGE(G_SB(0, 1), cB + hstepB, voffB); G_STAGE(G_SA(0, 1), cA + hstepA, voffA);
        if (wr == 1) G_BAR;
        G_WAIT_V(4); G_BAR;
        G_STAGE(G_SB(1, 0), cB + kstep, voffB); G_STAGE(G_SA(1, 0), cA + kstep, voffA); G_STAGE(G_SB(1, 1), cB + hstepB + kstep, voffB);
        G_WAIT_V(6); G_BAR;
        for (;;) {
            const bool has_next = chain && (u + nblk < cfg.nbig);
            UnitD nxt = cur;
            if (has_next) nxt = unit_decode(P, cfg, gp, u + nblk);
            const char* nA = nxt.A; const char* nB = nxt.B;
            for (int t = 0; t < nt; t += 2) {
                const bool last = (t == nt - 2);
                const char* a1 = cA + (size_t)(t + 1) * kstep;
                const char* a2 = last ? nA : cA + (size_t)(t + 2) * kstep; const char* b2 = last ? nB : cB + (size_t)(t + 2) * kstep;
                const char* a3 = a2 + kstep; const char* b3 = b2 + kstep;
                G_LDB(B0, 0, 0); G_SCHED; G_LDA(At, 0, 0); G_STAGE(G_SA(1, 1), a1 + hstepA, voffA);
                G_WAIT_L(8); G_BAR; G_WAIT_L(0); G_MMA(0, 0, At, B0); G_BAR; G_SCHED;
                G_LDB(B1, 0, 1); G_STAGE(G_SB(0, 0), b2, voffB);
                G_BAR; G_WAIT_L(0); G_MMA(0, 1, At, B1); G_BAR;
                G_LDA(At, 0, 1); G_STAGE(G_SA(0, 0), a2, voffA);
                G_BAR; G_WAIT_L(0); G_MMA(1, 0, At, B0); G_BAR; G_SCHED;
                G_STAGE(G_SB(0, 1), b2 + hstepB, voffB);
                G_WAIT_V(6); G_BAR; G_MMA(1, 1, At, B1); G_BAR;
                G_LDB(B0, 1, 0); G_SCHED; G_LDA(At, 1, 0); G_STAGE(G_SA(0, 1), a2 + hstepA, voffA);
                G_WAIT_L(8); G_BAR; G_WAIT_L(0); G_MMA(0, 0, At, B0); G_BAR; G_SCHED;
                G_LDB(B1, 1, 1); G_STAGE(G_SB(1, 0), b3, voffB);
                G_BAR; G_WAIT_L(0); G_MMA(0, 1, At, B1); G_BAR;
                G_LDA(At, 1, 1); G_STAGE(G_SA(1, 0), a3, voffA);
                G_BAR; G_WAIT_L(0); G_MMA(1, 0, At, B0); G_BAR; G_SCHED;
                G_STAGE(G_SB(1, 1), b3 + hstepB, voffB);
                G_WAIT_V(6); G_BAR; G_MMA(1, 1, At, B1); G_BAR;
            }
            if (chain) {
                const int rbase = cur.row0 + wr * 64 + fr, cbase = cur.col0 + wc * 32 + fq * 4;
                switch (cur.ekind) {
                case E_PROJ: epi_loop<E_PROJ>(P, acc, rbase, cbase, fq); break;
                case E_MEMKV: epi_loop<E_MEMKV>(P, acc, rbase, cbase, fq); break;
                case E_POOL: epi_loop<E_POOL>(P, acc, rbase, cbase, fq); break;
                case E_OUT: epi_loop<E_OUT>(P, acc, rbase, cbase, fq); break;
                case E_Q: epi_loop<E_Q>(P, acc, rbase, cbase, fq); break;
                case E_PV: epi_loop<E_PV>(P, acc, rbase, cbase, fq); break;
                case E_MO: epi_loop<E_MO>(P, acc, rbase, cbase, fq); break;
                case E_UP: epi_loop<E_UP>(P, acc, rbase, cbase, fq); break;
                default: epi_loop<E_DOWN>(P, acc, rbase, cbase, fq); break;
                }
            }
            if (!has_next) break;
#pragma unroll
            for (int a = 0; a < 2; ++a)
#pragma unroll
                for (int b = 0; b < 2; ++b)
#pragma unroll
                    for (int m = 0; m < 4; ++m)
#pragma unroll
                        for (int n = 0; n < 2; ++n) acc[a][b][m][n] = (f32x4){0.f, 0.f, 0.f, 0.f};
            cur = nxt; cA = nA; cB = nB; u += nblk;
        }
        G_WAIT_V(0);
        if (wr == 0) G_BAR;
        G_BAR;
        if (!chain) {
            float* redm = (float*)(shm_g + 131072);
            float* reds = (float*)(shm_g + 135168);
#pragma unroll
            for (int ai = 0; ai < 2; ++ai)
#pragma unroll
                for (int m = 0; m < 4; ++m) {
                    float t = -3.0e38f;
#pragma unroll
                    for (int bj = 0; bj < 2; ++bj)
#pragma unroll
                        for (int n = 0; n < 2; ++n)
#pragma unroll
                            for (int j = 0; j < 4; ++j) t = fmaxf(t, acc[ai][bj][m][n][j]);
                    t = fmaxf(t, __shfl_xor(t, 16)); t = fmaxf(t, __shfl_xor(t, 32));
                    if (fq == 0) redm[(ai * 128 + wr * 64 + m * 16 + fr) * 4 + wc] = t;
                }
            __syncthreads();
#pragma unroll
            for (int ai = 0; ai < 2; ++ai)
#pragma unroll
                for (int m = 0; m < 4; ++m) {
                    const f32x4 r = *(const f32x4*)(redm + (ai * 128 + wr * 64 + m * 16 + fr) * 4);
                    const float M = fmaxf(fmaxf(r[0], r[1]), fmaxf(r[2], r[3]));
                    float s = 0.f;
#pragma unroll
                    for (int bj = 0; bj < 2; ++bj)
#pragma unroll
                        for (int n = 0; n < 2; ++n)
#pragma unroll
                            for (int j = 0; j < 4; ++j) { const float e = __expf(acc[ai][bj][m][n][j] - M); acc[ai][bj][m][n][j] = e; s += e; }
                    s += __shfl_xor(s, 16); s += __shfl_xor(s, 32);
                    if (fq == 0) reds[(ai * 128 + wr * 64 + m * 16 + fr) * 4 + wc] = s;
                }
            __syncthreads();
#pragma unroll
            for (int ai = 0; ai < 2; ++ai)
#pragma unroll
                for (int m = 0; m < 4; ++m) {
                    const int rl = ai * 128 + wr * 64 + m * 16 + fr;
                    const f32x4 r = *(const f32x4*)(reds + rl * 4);
                    const float inv = 1.0f / ((r[0] + r[1]) + (r[2] + r[3]));
                    bf16_t* prow = (bf16_t*)(P->ws + W_P) + (size_t)(cur.row0 + rl) * 1024 + cur.col0;
#pragma unroll
                    for (int bj = 0; bj < 2; ++bj)
#pragma unroll
                        for (int n = 0; n < 2; ++n) {
                            const f32x4 v = acc[ai][bj][m][n];
                            u32x2 o; o.x = pk2(v[0] * inv, v[1] * inv); o.y = pk2(v[2] * inv, v[3] * inv);
                            *(u32x2*)(prow + bj * 128 + wc * 32 + n * 16 + fq * 4) = o;
                        }
                }
            __syncthreads();
        }
        u += nblk;
    }
#undef G_SA
#undef G_SB
#undef G_STAGE
#undef G_LDA
#undef G_LDB
#undef G_MMA
    const int rot = cfg.nbig % nblk;
    for (int s0 = (lb - rot + nblk) % nblk; s0 < cfg.nsmall; s0 += nblk) {
        const int pr = s0 / cfg.ncol64, pc = s0 % cfg.ncol64;
        const int row0 = (gp == 1 ? 0 : TP) + pr * 32, col0 = pc * 64;
        int lda_s = cfg.lda, ldb_s = cfg.ldb, K_s = K, ek_s = cfg.ekind;
        const bf16_t* Ab; const bf16_t* Bb;
        if (gp == 1) {
            const int g = pc >> 2; lda_s = 1024; ldb_s = 256; K_s = 256; ek_s = E_FOLD;
            Ab = (const bf16_t*)(P->ws + W_WLO) + (size_t)row0 * 1024 + g * 256; Bb = (const bf16_t*)(P->ws + W_WPOOL) + (size_t)g * 65536 + (size_t)(col0 - g * 256) * 256;
        } else { Ab = (const bf16_t*)cfg.A + (size_t)row0 * cfg.lda; Bb = (const bf16_t*)cfg.B + (size_t)col0 * cfg.ldb; }
        const int kw = K_s >> 3, nks = kw >> 5;
        f32x4 acc[2][4];
#pragma unroll
        for (int mi = 0; mi < 2; ++mi)
#pragma unroll
            for (int ni = 0; ni < 4; ++ni) acc[mi][ni] = (f32x4){0.f, 0.f, 0.f, 0.f};
        const bf16_t* ap = Ab + (size_t)fr * lda_s + wid * kw + fq * 8;
        const bf16_t* bp = Bb + (size_t)fr * ldb_s + wid * kw + fq * 8;
        for (int ks0 = 0; ks0 < nks; ks0 += 4) {
            bf16x8 a[4][2], b[4][4];
#pragma unroll
            for (int q = 0; q < 4; ++q) {
                const bool ok = ks0 + q < nks;
#pragma unroll
                for (int mi = 0; mi < 2; ++mi) { bf16x8 z = {0, 0, 0, 0, 0, 0, 0, 0}; if (ok) z = *(const bf16x8*)(ap + (size_t)mi * 16 * lda_s + (ks0 + q) * 32); a[q][mi] = z; }
#pragma unroll
                for (int ni = 0; ni < 4; ++ni) { bf16x8 z = {0, 0, 0, 0, 0, 0, 0, 0}; if (ok) z = *(const bf16x8*)(bp + (size_t)ni * 16 * ldb_s + (ks0 + q) * 32); b[q][ni] = z; }
            }
#pragma unroll
            for (int q = 0; q < 4; ++q)
#pragma unroll
                for (int mi = 0; mi < 2; ++mi)
#pragma unroll
                    for (int ni = 0; ni < 4; ++ni) acc[mi][ni] = __builtin_amdgcn_mfma_f32_16x16x32_bf16(b[q][ni], a[q][mi], acc[mi][ni], 0, 0, 0);
        }
        float* red = (float*)shm_g;
#pragma unroll
        for (int mi = 0; mi < 2; ++mi)
#pragma unroll
            for (int ni = 0; ni < 4; ++ni) *(f32x4*)(red + wid * 2048 + (mi * 16 + fr) * 64 + ni * 16 + fq * 4) = acc[mi][ni];
        __syncthreads();
        {
            const int r = tid >> 4, c = (tid & 15) * 4;
            f32x4 v = *(const f32x4*)(red + r * 64 + c);
#pragma unroll
            for (int w = 1; w < 8; ++w) v += *(const f32x4*)(red + w * 2048 + r * 64 + c);
            float ss = epi_apply_rt(P, ek_s, row0 + r, col0 + c, v);
            if (cfg.ekind == E_OUT || cfg.ekind == E_MO || cfg.ekind == E_DOWN) {
                ss += __shfl_xor(ss, 1); ss += __shfl_xor(ss, 2); ss += __shfl_xor(ss, 4); ss += __shfl_xor(ss, 8);
                if ((tid & 15) == 0) unsafeAtomicAdd((float*)(P->ws + (cfg.ekind == E_OUT ? W_SS1 : cfg.ekind == E_MO ? W_SS2 : W_SS3)) + row0 + r, ss);
            }
        }
        __syncthreads();
    }
}

struct TrDesc { const float* src; bf16_t* dst; const float* gain; int ld_src, ld_dst, k0, n0s, n0d; };
__device__ __forceinline__ TrDesc tr_decode(PP P, int i) {
    char* ws = P->ws; TrDesc d; d.gain = nullptr;
    if (i < 896) { const int kt = i / 56, ntl = i % 56; d.n0d = ntl * 64; d.n0s = d.n0d < 2560 ? d.n0d : d.n0d + 16; d.src = P->w_in; d.ld_src = 3600; d.dst = (bf16_t*)(ws + W_WIN); d.ld_dst = 1024; d.k0 = kt * 64; return d; }
    i -= 896;
    if (i < 512) { const int kt = i >> 4, ntl = i & 15; d.ld_src = 1024; d.n0s = d.n0d = ntl * 64;
        if (kt < 16) { d.src = P->w_out; d.dst = (bf16_t*)(ws + W_WOUT); d.ld_dst = 2048; d.k0 = kt * 64; }
        else { d.src = P->w_out + (size_t)1024 * 1024; d.dst = (bf16_t*)(ws + W_WLO); d.ld_dst = 1024; d.k0 = (kt - 16) * 64; }
        return d; }
    i -= 512;
    if (i < 1024) { const int wsel = i >> 8, r = i & 255, kt = r >> 4, ntl = r & 15;
        d.src = wsel == 0 ? P->w_mq : wsel == 1 ? P->w_mk : wsel == 2 ? P->w_mv : P->w_mo;
        d.dst = (bf16_t*)(ws + (wsel == 0 ? W_WMQ : wsel == 1 ? W_WMK : wsel == 2 ? W_WMV : W_WMO));
        d.gain = wsel == 0 ? P->norm_mem : nullptr; d.ld_src = 1024; d.ld_dst = 1024; d.k0 = kt * 64; d.n0s = d.n0d = ntl * 64; return d; }
    i -= 1024;
    if (i < 1408) { const int kt = i / 88, ntl = i % 88; d.src = P->w_up; d.ld_src = 5632; d.dst = (bf16_t*)(ws + W_WUP); d.ld_dst = 1024; d.gain = P->norm_ffn; d.k0 = kt * 64; d.n0s = d.n0d = ntl * 64; return d; }
    i -= 1408;
    { const int kt = i >> 4, ntl = i & 15; d.src = P->w_down; d.ld_src = 1024; d.dst = (bf16_t*)(ws + W_WDOWN); d.ld_dst = 2816; d.k0 = kt * 64; d.n0s = d.n0d = ntl * 64; return d; }
}

__device__ __forceinline__ void phase_prep(PP P, char* shm, int blk, int nblk, const int tid) {
    const int wid = tid >> 6, lane = tid & 63;
    float* tiles = (float*)shm;
    float* wdt = (float*)(shm + 69632);
    for (int i = blk * NTHR + tid; i < 3 * TT; i += nblk * NTHR) ((float*)(P->ws + W_SS1))[i] = 0.f;
    for (int i = (blk * NTHR + tid) * 4; i < 4 * 65536; i += nblk * NTHR * 4) {
        const f32x4 wv = *(const f32x4*)(P->w_pool + i), sv = *(const f32x4*)(P->pool_scale + (i >> 16) * 256 + (i & 255));
        u32x2 o; o.x = pk2(wv[0] * sv[0], wv[1] * sv[1]); o.y = pk2(wv[2] * sv[2], wv[3] * sv[3]);
        *(u32x2*)((bf16_t*)(P->ws + W_WPOOL) + i) = o;
    }
    for (int i = tid; i < 1024 * 16; i += NTHR) { const int k = i >> 4, hd = i & 15; wdt[hd * 1024 + k] = P->w_in[(size_t)k * 3600 + 2560 + hd]; }
    __syncthreads();
    char* ws = P->ws;
    constexpr int NGRP = (TT + 2048) / 32;
    for (int it = blk; it < NGRP; it += nblk) {
        const int rbase = it * 32 + wid * 4;
        const bool ismem = rbase >= TT;
        f32x4 xv[4][4];
#pragma unroll
        for (int r = 0; r < 4; ++r) {
            const int row = (ismem ? rbase - TT : rbase) + r;
            const float* xr = ismem ? P->mem_prompt + (size_t)row * 1024 : (row < TP ? P->x_prompt + (size_t)row * 1024 : P->x_sample + (size_t)(row - TP) * 1024);
#pragma unroll
            for (int j = 0; j < 4; ++j) xv[r][j] = __builtin_nontemporal_load((const f32x4*)(xr + j * 256 + lane * 4));
        }
        const float* gg = ismem ? P->norm_memkv : P->norm_mix;
#pragma unroll
        for (int r = 0; r < 4; ++r) {
            const int row = (ismem ? rbase - TT : rbase) + r;
            bf16_t* orow = (bf16_t*)(ws + (ismem ? W_HM : W_H)) + (size_t)row * 1024;
            float ss = 0.f;
#pragma unroll
            for (int j = 0; j < 4; ++j) ss += xv[r][j][0] * xv[r][j][0] + xv[r][j][1] * xv[r][j][1] + xv[r][j][2] * xv[r][j][2] + xv[r][j][3] * xv[r][j][3];
            ss = wave_sum(ss);
            const float rstd = rsqrtf(ss * (1.0f / 1024.0f) + EPS);
#pragma unroll
            for (int j = 0; j < 4; ++j) { const f32x4 g4 = *(const f32x4*)(gg + j * 256 + lane * 4); xv[r][j] = xv[r][j] * rstd * g4;
                u32x2 o; o.x = pk2(xv[r][j][0], xv[r][j][1]); o.y = pk2(xv[r][j][2], xv[r][j][3]); *(u32x2*)(orow + j * 256 + lane * 4) = o; }
            if (!ismem) {
                float mine = 0.f;
#pragma unroll
                for (int hd = 0; hd < 16; ++hd) {
                    float acc = 0.f;
#pragma unroll
                    for (int j = 0; j < 4; ++j) { const f32x4 w4 = *(const f32x4*)(wdt + hd * 1024 + j * 256 + lane * 4); acc += xv[r][j][0] * w4[0] + xv[r][j][1] * w4[1] + xv[r][j][2] * w4[2] + xv[r][j][3] * w4[3]; }
                    acc = wave_sum(acc);
                    if (lane == hd) mine = acc;
                }
                if (lane < 16) { const float x = mine + P->dt_bias[lane]; const float ey = __expf(-fabsf(x)); const float l1p = ey < 0.03f ? ey * (1.0f - ey * (0.5f - ey * (0.33333333f - 0.25f * ey))) : __logf(1.0f + ey); const float sp = fmaxf(x, 0.f) + l1p; ((float*)(ws + W_DT))[(size_t)row * 16 + lane] = sp; }
            }
        }
    }
    __syncthreads();
    const int kr = tid >> 4, nc = (tid & 15) * 4, tn = tid >> 3, tk8 = (tid & 7) * 8;
    for (int it = blk; it < 4544; it += 4 * nblk) {
        f32x4 v[4][2];
#pragma unroll
        for (int q = 0; q < 4; ++q) {
            const int i = it + q * nblk;
            if (i < 4544) { const TrDesc d = tr_decode(P, i);
#pragma unroll
                for (int h = 0; h < 2; ++h) { const int k = kr + h * 32; f32x4 t = __builtin_nontemporal_load((const f32x4*)(d.src + (size_t)(d.k0 + k) * d.ld_src + d.n0s + nc)); if (d.gain) t *= d.gain[d.k0 + k]; v[q][h] = t; } }
        }
#pragma unroll
        for (int q = 0; q < 4; ++q) {
            if (it + q * nblk < 4544) { float* tile = tiles + q * (64 * 65);
#pragma unroll
                for (int h = 0; h < 2; ++h) { const int k = kr + h * 32; tile[k * 65 + nc + 0] = v[q][h][0]; tile[k * 65 + nc + 1] = v[q][h][1]; tile[k * 65 + nc + 2] = v[q][h][2]; tile[k * 65 + nc + 3] = v[q][h][3]; } }
        }
        __syncthreads();
#pragma unroll
        for (int q = 0; q < 4; ++q) {
            const int i = it + q * nblk;
            if (i < 4544) { const TrDesc d = tr_decode(P, i); const float* tile = tiles + q * (64 * 65); float f[8];
#pragma unroll
                for (int e2 = 0; e2 < 8; ++e2) f[e2] = tile[(tk8 + e2) * 65 + tn];
                *(u32x4*)(d.dst + (size_t)(d.n0d + tn) * d.ld_dst + d.k0 + tk8) = pack8(f); }
        }
        __syncthreads();
    }
}

__device__ __forceinline__ u32x4 ld8(const bf16_t* p) { return *(const u32x4*)p; }

__device__ __forceinline__ void phase_convpool(PP P, int gtid, int nthreads) {
    char* ws = P->ws;
    const bf16_t* proj2 = (const bf16_t*)(ws + W_PROJ2);
    bf16_t* xact = (bf16_t*)(ws + W_XACT);
    bf16_t* pooled = (bf16_t*)(ws + W_POOLED);
    for (int idx = gtid; idx < 1152 * 320; idx += nthreads) {
        const int run = idx / 320, cg = idx % 320;
        const bool samp = run >= 1024;
        int t0, len, bidx, tl0;
        if (!samp) { t0 = run * 16; len = 16; bidx = t0 >> 11; tl0 = t0 & 2047; } else { bidx = run - 1024; t0 = TP + bidx * 4; len = 4; tl0 = 0; }
        if (cg < 192) {
            const int c0 = cg * 8;
            float w0[8], w1[8], w2[8], w3[8], bs[8], h0[8], h1[8], h2[8];
#pragma unroll
            for (int e = 0; e < 8; ++e) { w0[e] = P->conv_w[c0 + e]; w1[e] = P->conv_w[1536 + c0 + e]; w2[e] = P->conv_w[3072 + c0 + e]; w3[e] = P->conv_w[4608 + c0 + e]; bs[e] = P->conv_b[c0 + e]; }
            if (samp) {
#pragma unroll
                for (int e = 0; e < 8; ++e) { h0[e] = P->state_conv[(size_t)(bidx * 3 + 0) * 1536 + c0 + e]; h1[e] = P->state_conv[(size_t)(bidx * 3 + 1) * 1536 + c0 + e]; h2[e] = P->state_conv[(size_t)(bidx * 3 + 2) * 1536 + c0 + e]; }
            } else if (tl0 > 0) {
                unpack8(ld8(proj2 + (size_t)(t0 - 3) * 2560 + c0), h0); unpack8(ld8(proj2 + (size_t)(t0 - 2) * 2560 + c0), h1); unpack8(ld8(proj2 + (size_t)(t0 - 1) * 2560 + c0), h2);
            } else {
#pragma unroll
                for (int e = 0; e < 8; ++e) { h0[e] = 0.f; h1[e] = 0.f; h2[e] = 0.f; }
            }
            u32x4 rx[16];
#pragma unroll
            for (int j = 0; j < 16; ++j) { if (j < len) rx[j] = ld8(proj2 + (size_t)(t0 + j) * 2560 + c0); }
#pragma unroll
            for (int j = 0; j < 16; ++j) {
                if (j < len) {
                float x3[8], y[8]; unpack8(rx[j], x3);
#pragma unroll
                for (int e = 0; e < 8; ++e) { const float v = bs[e] + w0[e] * h0[e] + w1[e] * h1[e] + w2[e] * h2[e] + w3[e] * x3[e]; y[e] = silu_f(v); }
                *(u32x4*)(xact + (size_t)(t0 + j) * 1536 + c0) = pack8(y);
                if (samp) { if (j >= 1) { float* o = P->out + O_CONVS + (size_t)(bidx * 3 + j - 1) * 1536 + c0;
#pragma unroll
                        for (int e = 0; e < 8; ++e) o[e] = x3[e]; } }
                else { const int tl = tl0 + j; if (tl >= 2045) { float* o = P->out + O_CONVP + (size_t)(bidx * 3 + tl - 2045) * 1536 + c0;
#pragma unroll
                        for (int e = 0; e < 8; ++e) o[e] = x3[e]; } }
#pragma unroll
                for (int e = 0; e < 8; ++e) { h0[e] = h1[e]; h1[e] = h2[e]; h2[e] = x3[e]; }
                }
            }
        } else {
            const int c0 = (cg - 192) * 8; const int win = 2 << (c0 >> 8);
            const bf16_t* vp = proj2 + 1536 + c0;
            const float* prev = P->state_pool + (size_t)bidx * 15 * 1024 + c0;
            float sum[8];
#pragma unroll
            for (int e = 0; e < 8; ++e) sum[e] = 0.f;
            if (samp) {
                for (int jj = 1; jj < win; ++jj) {
#pragma unroll
                    for (int e = 0; e < 8; ++e) sum[e] += prev[(size_t)(15 - jj) * 1024 + e]; }
                float* o = P->out + O_POOLS + (size_t)bidx * 15 * 1024 + c0;
                for (int i = 0; i < 11; ++i) {
#pragma unroll
                    for (int e = 0; e < 8; ++e) o[(size_t)i * 1024 + e] = prev[(size_t)(i + 4) * 1024 + e]; }
            } else if (tl0 > 0) {
                for (int jj = 1; jj < win; ++jj) { float v[8]; unpack8(ld8(vp + (size_t)(t0 - jj) * 2560), v);
#pragma unroll
                    for (int e = 0; e < 8; ++e) sum[e] += v[e]; }
            }
            u32x4 rp[16];
#pragma unroll
            for (int j = 0; j < 16; ++j) { if (j < len) rp[j] = ld8(vp + (size_t)(t0 + j) * 2560); }
#pragma unroll
            for (int j = 0; j < 16; ++j) {
                if (j >= len) continue;
                float v[8], o8[8]; unpack8(rp[j], v);
                const int tl = tl0 + j;
                const float inv = 1.0f / (float)(samp ? win : (tl + 1 < win ? tl + 1 : win));
#pragma unroll
                for (int e = 0; e < 8; ++e) { sum[e] += v[e]; o8[e] = sum[e] * inv - v[e]; }
                *(u32x4*)((bf16_t*)(ws + W_MIX) + (size_t)(t0 + j) * 2048 + 1024 + c0) = pack8(o8);
                const int to = j - win + 1;
                if (samp) {
                    if (to >= 0) { float q[8]; unpack8(ld8(vp + (size_t)(t0 + to) * 2560), q);
#pragma unroll
                        for (int e = 0; e < 8; ++e) sum[e] -= q[e]; }
                    else {
#pragma unroll
                        for (int e = 0; e < 8; ++e) sum[e] -= prev[(size_t)(15 + to) * 1024 + e]; }
                    float* o = P->out + O_POOLS + (size_t)(bidx * 15 + 11 + j) * 1024 + c0;
#pragma unroll
                    for (int e = 0; e < 8; ++e) o[e] = v[e];
                } else {
                    if (tl0 + to >= 0) { float q[8]; unpack8(ld8(vp + (size_t)(t0 + to) * 2560), q);
#pragma unroll
                        for (int e = 0; e < 8; ++e) sum[e] -= q[e]; }
                    if (tl >= 2033) { float* o = P->out + O_POOLP + (size_t)(bidx * 15 + tl - 2033) * 1024 + c0;
#pragma unroll
                        for (int e = 0; e < 8; ++e) o[e] = v[e]; }
                }
            }
        }
    }
}

constexpr int CS_STR = 136;
constexpr int X_STR = 40;
__device__ __forceinline__ s16x4 tr_read(const bf16_t* p) { return __builtin_bit_cast(s16x4, __builtin_amdgcn_ds_read_tr16_b64_v4i16((LDSB s16x4*)p)); }

#define LDS_BARRIER() asm volatile("s_waitcnt lgkmcnt(0)\n\ts_barrier" ::: "memory")
__device__ __forceinline__ void ssd_prompt(PP P, int item, char* shm, const int tid) {
    const int w = tid >> 6, lane = tid & 63, fr = lane & 15, fq = lane >> 4;
    const int b = item >> 5, hd = (item >> 1) & 15, ph = item & 1, g = hd >> 3;
    const float a = -expf(P->a_log[hd]);
    const float Dh = P->ssm_d[hd];
    char* ws = P->ws;
    const bf16_t* xact = (const bf16_t*)(ws + W_XACT);
    const float* dtb = (const float*)(ws + W_DT);
    bf16_t* ybuf = (bf16_t*)(ws + W_Y);
    bf16_t* Cs = (bf16_t*)(shm);
    bf16_t* Bs = (bf16_t*)(shm + 34816);
    bf16_t* Xd = (bf16_t*)(shm + 69632);
    bf16_t* X2 = (bf16_t*)(shm + 69632 + 10240);
    bf16_t* Ht = (bf16_t*)(shm + 69632 + 20480);
    float* acs = (float*)(shm + 69632 + 30720);
    float* dts = (float*)(shm + 69632 + 31232);
    f32x4 Hacc[2];
    Hacc[0] = (f32x4){0.f, 0.f, 0.f, 0.f}; Hacc[1] = (f32x4){0.f, 0.f, 0.f, 0.f};
    const int q4 = fr >> 2, p4 = fr & 3;
    u32x4 pc[4], pb[4], px; float pd0, pd1;
    const int ls = tid >> 4, ln8 = (tid & 15) * 8;
    const int xs = tid >> 2, xp8 = (tid & 3) * 8;
#define SSD_PREFETCH(cc) do { const int _t0 = b * 2048 + (cc) * 128; \
        _Pragma("unroll") for (int i = 0; i < 4; ++i) { const bf16_t* src = xact + (size_t)(_t0 + ls + i * 32) * 1536 + g * 128 + ln8; pc[i] = *(const u32x4*)(src + 1280); pb[i] = *(const u32x4*)(src + 1024); } \
        px = *(const u32x4*)(xact + (size_t)(_t0 + xs) * 1536 + hd * 64 + ph * 32 + xp8); \
        pd0 = dtb[(size_t)(_t0 + 2 * lane) * 16 + hd]; pd1 = dtb[(size_t)(_t0 + 2 * lane + 1) * 16 + hd]; } while (0)
    SSD_PREFETCH(0);
    for (int c = 0; c < 16; ++c) {
        const int t0 = b * 2048 + c * 128;
        if (w == 0) {
            const float d0 = pd0, d1 = pd1;
            const float s = (d0 + d1) * a; float v = s;
#pragma unroll
            for (int off = 1; off < 64; off <<= 1) { const float t = __shfl_up(v, off); if (lane >= off) v += t; }
            const float excl = v - s;
            acs[2 * lane] = excl + d0 * a; acs[2 * lane + 1] = v; dts[2 * lane] = d0; dts[2 * lane + 1] = d1;
        }
#pragma unroll
        for (int pt = 0; pt < 2; ++pt) { u32x2 o; o.x = pk2(Hacc[pt][0], Hacc[pt][1]); o.y = pk2(Hacc[pt][2], Hacc[pt][3]); *(u32x2*)(Ht + (w * 16 + fr) * X_STR + pt * 16 + fq * 4) = o; }
#pragma unroll
        for (int i = 0; i < 4; ++i) { *(u32x4*)(Cs + (ls + i * 32) * CS_STR + ln8) = pc[i]; *(u32x4*)(Bs + (ls + i * 32) * CS_STR + ln8) = pb[i]; }
        LDS_BARRIER();
        {
            float x[8], xa[8], xb[8]; unpack8(px, x);
            const float dtv = dts[xs], dec = __expf(acs[127] - acs[xs]) * dtv;
#pragma unroll
            for (int e = 0; e < 8; ++e) { xa[e] = x[e] * dtv; xb[e] = x[e] * dec; }
            *(u32x4*)(Xd + xs * X_STR + xp8) = pack8(xa);
            *(u32x4*)(X2 + xs * X_STR + xp8) = pack8(xb);
        }
        if (c < 15) SSD_PREFETCH(c + 1);
        bf16x8 Cf[4];
#pragma unroll
        for (int kk = 0; kk < 4; ++kk) Cf[kk] = *(const bf16x8*)(Cs + (w * 16 + fr) * CS_STR + kk * 32 + fq * 8);
        const int lrow = w * 16 + fr; const float al = acs[lrow];
        bf16x8 Gf[4];
#pragma unroll
        for (int kk = 0; kk < 4; ++kk) {
            u32x2 half[2];
#pragma unroll
            for (int hh = 0; hh < 2; ++hh) {
                const int st = 2 * kk + hh;
                half[hh].x = 0u; half[hh].y = 0u;
                if (st <= w) {
                    f32x4 ga = (f32x4){0.f, 0.f, 0.f, 0.f};
#pragma unroll
                    for (int k2 = 0; k2 < 4; ++k2) { const bf16x8 Bf = *(const bf16x8*)(Bs + (st * 16 + fr) * CS_STR + k2 * 32 + fq * 8); ga = __builtin_amdgcn_mfma_f32_16x16x32_bf16(Bf, Cf[k2], ga, 0, 0, 0); }
                    const int s0 = st * 16 + fq * 4; const f32x4 as4 = *(const f32x4*)(acs + s0);
                    float gv[4];
#pragma unroll
                    for (int j = 0; j < 4; ++j) gv[j] = (s0 + j <= lrow) ? ga[j] * __expf(al - as4[j]) : 0.f;
                    half[hh].x = pk2(gv[0], gv[1]); half[hh].y = pk2(gv[2], gv[3]);
                }
            }
            u32x4 g4; g4.x = half[0].x; g4.y = half[0].y; g4.z = half[1].x; g4.w = half[1].y;
            Gf[kk] = __builtin_bit_cast(bf16x8, g4);
        }
        LDS_BARRIER();
        {
            f32x4 Yd[2], Yo[2];
            Yd[0] = Yd[1] = Yo[0] = Yo[1] = (f32x4){0.f, 0.f, 0.f, 0.f};
            const int nkk = (w >> 1) + 1;
#pragma unroll
            for (int kk = 0; kk < 4; ++kk) {
                if (kk < nkk) {
#pragma unroll
                    for (int pt = 0; pt < 2; ++pt) {
                        const bf16_t* base = Xd + (kk * 32 + fq * 4 + q4) * X_STR + pt * 16 + p4 * 4;
                        bf16x8 Xf; Xf.lo = tr_read(base); Xf.hi = tr_read(base + 16 * X_STR);
                        Yd[pt] = __builtin_amdgcn_mfma_f32_16x16x32_bf16(Xf, Gf[kk], Yd[pt], 0, 0, 0);
                    }
                }
            }
#pragma unroll
            for (int kk = 0; kk < 4; ++kk)
#pragma unroll
                for (int pt = 0; pt < 2; ++pt) {
                    const bf16_t* hbp = Ht + (kk * 32 + fq * 8 + q4) * X_STR + pt * 16 + p4 * 4;
                    bf16x8 Hf; Hf.lo = tr_read(hbp); Hf.hi = tr_read(hbp + 4 * X_STR);
                    Yo[pt] = __builtin_amdgcn_mfma_f32_16x16x32_bf16(Hf, Cf[kk], Yo[pt], 0, 0, 0);
                }
            const float el = __expf(al); const float rdt = Dh / dts[lrow];
#pragma unroll
            for (int pt = 0; pt < 2; ++pt) {
                const u32x2 xr = *(const u32x2*)(Xd + lrow * X_STR + pt * 16 + fq * 4);
                const f32x4 y = Yd[pt] + el * Yo[pt] + rdt * (f32x4){bflo(xr.x), bfhi(xr.x), bflo(xr.y), bfhi(xr.y)};
                u32x2 o; o.x = pk2(y[0], y[1]); o.y = pk2(y[2], y[3]);
                *(u32x2*)(ybuf + (size_t)(t0 + lrow) * 1024 + hd * 64 + ph * 32 + pt * 16 + fq * 4) = o;
            }
        }
        {
            const float dc = __expf(acs[127]);
            Hacc[0] *= dc; Hacc[1] *= dc;
#pragma unroll
            for (int kk = 0; kk < 4; ++kk) {
                const bf16_t* bb = Bs + (kk * 32 + fq * 8 + q4) * CS_STR + w * 16 + p4 * 4;
                bf16x8 Bf; Bf.lo = tr_read(bb); Bf.hi = tr_read(bb + 4 * CS_STR);
#pragma unroll
                for (int pt = 0; pt < 2; ++pt) {
                    const bf16_t* xb = X2 + (kk * 32 + fq * 8 + q4) * X_STR + pt * 16 + p4 * 4;
                    bf16x8 Xf; Xf.lo = tr_read(xb); Xf.hi = tr_read(xb + 4 * X_STR);
                    Hacc[pt] = __builtin_amdgcn_mfma_f32_16x16x32_bf16(Xf, Bf, Hacc[pt], 0, 0, 0);
                }
            }
        }
        LDS_BARRIER();
    }
#undef SSD_PREFETCH
    float* so = P->out + O_SSMP + ((size_t)(b * 16 + hd) * 64 + ph * 32) * 128;
#pragma unroll
    for (int pt = 0; pt < 2; ++pt)
#pragma unroll
        for (int j = 0; j < 4; ++j) so[(size_t)(pt * 16 + fq * 4 + j) * 128 + w * 16 + fr] = Hacc[pt][j];
}

template <int NI>
__device__ __forceinline__ void ssd_sample(PP P, int item0, int istride, const int tid) {
    const int p = tid >> 3, n0 = (tid & 7) * 16;
    char* ws = P->ws;
    const bf16_t* xact = (const bf16_t*)(ws + W_XACT);
    const float* dtb = (const float*)(ws + W_DT);
    bf16_t* ybuf = (bf16_t*)(ws + W_Y);
    f32x4 hs[NI][4]; u32x4 rb[NI][4][2], rc[NI][4][2]; float xv[NI][4], dtv[NI][4];
#pragma unroll
    for (int q = 0; q < NI; ++q) {
        const int item = item0 + q * istride, b = item >> 4, hd = item & 15, g = hd >> 3;
        const size_t sidx = ((size_t)(b * 16 + hd) * 64 + p) * 128 + n0;
#pragma unroll
        for (int i = 0; i < 4; ++i) hs[q][i] = __builtin_nontemporal_load((const f32x4*)(P->state_ssm + sidx + i * 4));
#pragma unroll
        for (int i = 0; i < 4; ++i) {
            const int t = TP + b * 4 + i;
            xv[q][i] = bf2f(xact[(size_t)t * 1536 + hd * 64 + p]);
            dtv[q][i] = dtb[(size_t)t * 16 + hd];
            rb[q][i][0] = ld8(xact + (size_t)t * 1536 + 1024 + g * 128 + n0); rb[q][i][1] = ld8(xact + (size_t)t * 1536 + 1024 + g * 128 + n0 + 8);
            rc[q][i][0] = ld8(xact + (size_t)t * 1536 + 1280 + g * 128 + n0); rc[q][i][1] = ld8(xact + (size_t)t * 1536 + 1280 + g * 128 + n0 + 8);
        }
    }
#pragma unroll
    for (int q = 0; q < NI; ++q) {
        const int item = item0 + q * istride, b = item >> 4, hd = item & 15;
        const float a = -expf(P->a_log[hd]);
        const float Dh = P->ssm_d[hd];
        const size_t sidx = ((size_t)(b * 16 + hd) * 64 + p) * 128 + n0;
        float h[16];
#pragma unroll
        for (int i = 0; i < 4; ++i) { h[i * 4] = hs[q][i][0]; h[i * 4 + 1] = hs[q][i][1]; h[i * 4 + 2] = hs[q][i][2]; h[i * 4 + 3] = hs[q][i][3]; }
#pragma unroll
        for (int i = 0; i < 4; ++i) {
            const int t = TP + b * 4 + i;
            const float dA = __expf(dtv[q][i] * a), dx = dtv[q][i] * xv[q][i];
            float Bv[16], Cv[16];
            { float t8[8]; unpack8(rb[q][i][0], t8);
#pragma unroll
              for (int e = 0; e < 8; ++e) Bv[e] = t8[e];
              unpack8(rb[q][i][1], t8);
#pragma unroll
              for (int e = 0; e < 8; ++e) Bv[8 + e] = t8[e];
              unpack8(rc[q][i][0], t8);
#pragma unroll
              for (int e = 0; e < 8; ++e) Cv[e] = t8[e];
              unpack8(rc[q][i][1], t8);
#pragma unroll
              for (int e = 0; e < 8; ++e) Cv[8 + e] = t8[e]; }
            float part = 0.f;
#pragma unroll
            for (int e = 0; e < 16; ++e) { h[e] = h[e] * dA + dx * Bv[e]; part += h[e] * Cv[e]; }
            part += __shfl_xor(part, 1); part += __shfl_xor(part, 2); part += __shfl_xor(part, 4);
            if ((tid & 7) == 0) ybuf[(size_t)t * 1024 + hd * 64 + p] = f2bf(part + Dh * xv[q][i]);
        }
        float* so = P->out + O_SSMS + sidx;
#pragma unroll
        for (int i = 0; i < 4; ++i) __builtin_nontemporal_store((f32x4){h[i * 4], h[i * 4 + 1], h[i * 4 + 2], h[i * 4 + 3]}, (f32x4*)(so + i * 4));
    }
}

__device__ __forceinline__ void phase_gatednorm(PP P, int gw, int nw, const int tid) {
    const int lane = tid & 63;
    char* ws = P->ws;
    const bf16_t* ybuf = (const bf16_t*)(ws + W_Y); const bf16_t* zbuf = (const bf16_t*)(ws + W_Z);
    bf16_t* mix = (bf16_t*)(ws + W_MIX);
    for (int row0 = gw; row0 < TT; row0 += 4 * nw) {
        u32x2 yv[4][4], zv[4][4];
#pragma unroll
        for (int r = 0; r < 4; ++r) { const int row = row0 + r * nw; if (row < TT) {
#pragma unroll
            for (int j = 0; j < 4; ++j) { yv[r][j] = *(const u32x2*)(ybuf + (size_t)row * 1024 + j * 256 + lane * 4); zv[r][j] = *(const u32x2*)(zbuf + (size_t)row * 1024 + j * 256 + lane * 4); } } }
#pragma unroll
        for (int r = 0; r < 4; ++r) { const int row = row0 + r * nw; if (row < TT) {
            float t[4][4]; float ss0 = 0.f, ss1 = 0.f;
#pragma unroll
            for (int j = 0; j < 4; ++j) {
                const float y0 = bflo(yv[r][j].x), y1 = bfhi(yv[r][j].x), y2 = bflo(yv[r][j].y), y3 = bfhi(yv[r][j].y);
                const float z0 = bflo(zv[r][j].x), z1 = bfhi(zv[r][j].x), z2 = bflo(zv[r][j].y), z3 = bfhi(zv[r][j].y);
                t[j][0] = y0 * silu_f(z0); t[j][1] = y1 * silu_f(z1); t[j][2] = y2 * silu_f(z2); t[j][3] = y3 * silu_f(z3);
                const float q = t[j][0] * t[j][0] + t[j][1] * t[j][1] + t[j][2] * t[j][2] + t[j][3] * t[j][3];
                if (j < 2) ss0 += q; else ss1 += q;
            }
            ss0 = wave_sum(ss0); ss1 = wave_sum(ss1);
            const float r0 = rsqrtf(ss0 * (1.0f / 512.0f) + EPS), r1 = rsqrtf(ss1 * (1.0f / 512.0f) + EPS);
#pragma unroll
            for (int j = 0; j < 4; ++j) {
                const float rr = j < 2 ? r0 : r1;
                const f32x4 g4 = *(const f32x4*)(P->ssm_norm + j * 256 + lane * 4);
                u32x2 o; o.x = pk2(t[j][0] * rr * g4[0], t[j][1] * rr * g4[1]); o.y = pk2(t[j][2] * rr * g4[2], t[j][3] * rr * g4[3]);
                *(u32x2*)(mix + (size_t)row * 2048 + j * 256 + lane * 4) = o;
            }
        } }
    }
}

__device__ __forceinline__ void phase_norm(PP P, const float* gain, bool final_out, int gw, int nw, const int tid) {
    const int lane = tid & 63;
    char* ws = P->ws;
    const bf16_t* hb = (const bf16_t*)(ws + W_H);
    const float* ss3 = (const float*)(ws + W_SS3);
    for (int row0 = gw; row0 < TT; row0 += 4 * nw) {
        u32x2 xv[4][4]; float sq[4];
#pragma unroll
        for (int r = 0; r < 4; ++r) { const int row = row0 + r * nw; if (row < TT) { sq[r] = ss3[row];
#pragma unroll
            for (int j = 0; j < 4; ++j) xv[r][j] = *(const u32x2*)(hb + (size_t)row * 1024 + j * 256 + lane * 4); } }
#pragma unroll
        for (int r = 0; r < 4; ++r) { const int row = row0 + r * nw; if (row < TT) {
            const float rstd = rsqrtf(sq[r] * (1.0f / 1024.0f) + EPS);
#pragma unroll
            for (int j = 0; j < 4; ++j) {
                const f32x4 g4 = *(const f32x4*)(gain + j * 256 + lane * 4);
                const f32x4 x = (f32x4){bflo(xv[r][j].x), bfhi(xv[r][j].x), bflo(xv[r][j].y), bfhi(xv[r][j].y)};
                __builtin_nontemporal_store(x * rstd * g4, (f32x4*)(P->out + O_YP + (size_t)row * 1024 + j * 256 + lane * 4));
            }
        } }
    }
}

__device__ __forceinline__ void attn_sample(PP P, int item, char* shm, const int tid) {
    const int w = tid >> 6, lane = tid & 63, fr = lane & 15, fq = lane >> 4;
    const int b = item >> 2, hh = item & 3;
    char* ws = P->ws;
    const bf16_t* qb = (const bf16_t*)(ws + W_Q);
    float* sc = (float*)shm;
    float* part = (float*)(shm + 4096);
    const float* vp = P->cache_v + ((size_t)(b * 256 + w * 32) * 4 + hh) * 256 + lane * 4;
    f32x4 v0[16], v1[16];
#pragma unroll
    for (int mm = 0; mm < 16; ++mm) v0[mm] = __builtin_nontemporal_load((const f32x4*)(vp + (size_t)mm * 1024));
    bf16x8 qf[8];
#pragma unroll
    for (int kk = 0; kk < 8; ++kk) {
        bf16x8 z = {0, 0, 0, 0, 0, 0, 0, 0};
        if (fr < 4) z = *(const bf16x8*)(qb + (size_t)(TP + b * 4 + fr) * 1024 + hh * 256 + kk * 32 + fq * 8);
        qf[kk] = z;
    }
#pragma unroll
    for (int mt = 0; mt < 2; ++mt) {
        const int key = w * 32 + mt * 16 + fr;
        const float* kp = P->cache_k + ((size_t)(b * 256 + key) * 4 + hh) * 256 + fq * 8;
        f32x4 k0[8], k1[8];
#pragma unroll
        for (int kk = 0; kk < 8; ++kk) { k0[kk] = __builtin_nontemporal_load((const f32x4*)(kp + kk * 32)); k1[kk] = __builtin_nontemporal_load((const f32x4*)(kp + kk * 32 + 4)); }
        f32x4 acc = (f32x4){0.f, 0.f, 0.f, 0.f};
#pragma unroll
        for (int kk = 0; kk < 8; ++kk) {
            u32x4 pk; pk.x = pk2(k0[kk][0], k0[kk][1]); pk.y = pk2(k0[kk][2], k0[kk][3]); pk.z = pk2(k1[kk][0], k1[kk][1]); pk.w = pk2(k1[kk][2], k1[kk][3]);
            acc = __builtin_amdgcn_mfma_f32_16x16x32_bf16(qf[kk], __builtin_bit_cast(bf16x8, pk), acc, 0, 0, 0);
        }
        if (fq == 0) {
#pragma unroll
            for (int j = 0; j < 4; ++j) sc[j * 256 + w * 32 + mt * 16 + fr] = acc[j];
        }
    }
    LDS_BARRIER();
#pragma unroll
    for (int mm = 0; mm < 16; ++mm) v1[mm] = __builtin_nontemporal_load((const f32x4*)(vp + (size_t)(16 + mm) * 1024));
    if (w < 4) {
        f32x4 s = *(const f32x4*)(sc + w * 256 + lane * 4);
        float m = fmaxf(fmaxf(s[0], s[1]), fmaxf(s[2], s[3])); m = wave_max(m);
        s[0] = __expf(s[0] - m); s[1] = __expf(s[1] - m); s[2] = __expf(s[2] - m); s[3] = __expf(s[3] - m);
        float su = (s[0] + s[1]) + (s[2] + s[3]); su = wave_sum(su);
        const float inv = 1.0f / su;
        *(f32x4*)(sc + w * 256 + lane * 4) = s * inv;
    }
    LDS_BARRIER();
    {
        f32x4 o[4];
#pragma unroll
        for (int i = 0; i < 4; ++i) o[i] = (f32x4){0.f, 0.f, 0.f, 0.f};
#pragma unroll
        for (int mm = 0; mm < 16; ++mm) {
#pragma unroll
            for (int i = 0; i < 4; ++i) o[i] += sc[i * 256 + w * 32 + mm] * v0[mm];
        }
#pragma unroll
        for (int mm = 0; mm < 16; ++mm) {
#pragma unroll
            for (int i = 0; i < 4; ++i) o[i] += sc[i * 256 + w * 32 + 16 + mm] * v1[mm];
        }
#pragma unroll
        for (int i = 0; i < 4; ++i) *(f32x4*)(part + (w * 4 + i) * 256 + lane * 4) = o[i];
    }
    LDS_BARRIER();
    {
        const int i = tid >> 7, d2 = (tid & 127) * 2;
        float s0 = 0.f, s1 = 0.f;
#pragma unroll
        for (int ww = 0; ww < 8; ++ww) { s0 += part[(ww * 4 + i) * 256 + d2]; s1 += part[(ww * 4 + i) * 256 + d2 + 1]; }
        *(unsigned*)((bf16_t*)(ws + W_O) + (size_t)(TP + b * 4 + i) * 1024 + hh * 256 + d2) = pk2(s0, s1);
    }
    LDS_BARRIER();
}

__device__ __forceinline__ void phase_ffnconv(PP P, int gtid, int nthreads) {
    char* ws = P->ws;
    const bf16_t* u = (const bf16_t*)(ws + W_U);
    bf16_t* act = (bf16_t*)(ws + W_ACT);
    for (int idx = gtid; idx < 1152 * 352; idx += nthreads) {
        const int run = idx / 352, cg = idx % 352;
        const bool samp = run >= 1024;
        int t0, len, bidx, tl0;
        if (!samp) { t0 = run * 16; len = 16; bidx = t0 >> 11; tl0 = t0 & 2047; } else { bidx = run - 1024; t0 = TP + bidx * 4; len = 4; tl0 = 0; }
        const int cgc = cg * 8, cvc = 2816 + cg * 8;
        float wg0[8], wg1[8], wg2[8], wv0[8], wv1[8], wv2[8], bg[8], bv[8], hg0[8], hg1[8], hv0[8], hv1[8];
#pragma unroll
        for (int e = 0; e < 8; ++e) {
            wg0[e] = P->ffn_w[cgc + e]; wg1[e] = P->ffn_w[5632 + cgc + e]; wg2[e] = P->ffn_w[11264 + cgc + e];
            wv0[e] = P->ffn_w[cvc + e]; wv1[e] = P->ffn_w[5632 + cvc + e]; wv2[e] = P->ffn_w[11264 + cvc + e];
            bg[e] = P->ffn_b[cgc + e]; bv[e] = P->ffn_b[cvc + e];
        }
        if (samp) {
#pragma unroll
            for (int e = 0; e < 8; ++e) {
                hg0[e] = P->state_ffn[(size_t)(bidx * 2 + 0) * 5632 + cgc + e]; hg1[e] = P->state_ffn[(size_t)(bidx * 2 + 1) * 5632 + cgc + e];
                hv0[e] = P->state_ffn[(size_t)(bidx * 2 + 0) * 5632 + cvc + e]; hv1[e] = P->state_ffn[(size_t)(bidx * 2 + 1) * 5632 + cvc + e];
            }
        } else if (tl0 > 0) {
            unpack8(ld8(u + (size_t)(t0 - 2) * 5632 + cgc), hg0); unpack8(ld8(u + (size_t)(t0 - 1) * 5632 + cgc), hg1);
            unpack8(ld8(u + (size_t)(t0 - 2) * 5632 + cvc), hv0); unpack8(ld8(u + (size_t)(t0 - 1) * 5632 + cvc), hv1);
        } else {
#pragma unroll
            for (int e = 0; e < 8; ++e) { hg0[e] = 0.f; hg1[e] = 0.f; hv0[e] = 0.f; hv1[e] = 0.f; }
        }
        for (int jb = 0; jb < len; jb += 8) {
        u32x4 rg[8], rv[8];
        const bf16_t* ub = u + (size_t)(t0 + jb) * 5632 + cgc;
#pragma unroll
        for (int jj = 0; jj < 8; ++jj) { if (jb + jj < len) { rg[jj] = ld8(ub + (size_t)jj * 5632); rv[jj] = ld8(ub + (size_t)jj * 5632 + 2816); } }
#pragma unroll
        for (int jj = 0; jj < 8; ++jj) {
            const int j = jb + jj;
            if (j < len) {
            float ug[8], uv[8], o8[8];
            unpack8(rg[jj], ug); unpack8(rv[jj], uv);
#pragma unroll
            for (int e = 0; e < 8; ++e) {
                const float gc = bg[e] + wg0[e] * hg0[e] + wg1[e] * hg1[e] + wg2[e] * ug[e];
                const float vc = bv[e] + wv0[e] * hv0[e] + wv1[e] * hv1[e] + wv2[e] * uv[e];
                o8[e] = silu_f(gc) * vc;
            }
            *(u32x4*)(act + (size_t)(t0 + j) * 2816 + cgc) = pack8(o8);
            float* o = nullptr;
            if (samp) { if (j >= 2) o = P->out + O_FFNS + (size_t)(bidx * 2 + j - 2) * 5632; }
            else { const int tl = tl0 + j; if (tl >= 2046) o = P->out + O_FFNP + (size_t)(bidx * 2 + tl - 2046) * 5632; }
            if (o) {
#pragma unroll
                for (int e = 0; e < 8; ++e) { o[cgc + e] = ug[e]; o[cvc + e] = uv[e]; }
            }
#pragma unroll
            for (int e = 0; e < 8; ++e) { hg0[e] = hg1[e]; hg1[e] = ug[e]; hv0[e] = hv1[e]; hv1[e] = uv[e]; }
            }
        }
        }
    }
}

#define XB_TMO      128
#define XB_XCNT(j)  (256  + 64 * (j))
#define XB_XSUB(j)  (1280 + 64 * (j))
#define XB_XGEN(j)  (2304 + 64 * (j))
#define XB_TOP      3328
#define XB_TOPGEN   3392
#define XCD_BAR_WORDS 3456
#define XB_SPIN_CAP (1u << 18)
__device__ __forceinline__ unsigned xb_ld(unsigned* p)              { return __hip_atomic_load(p, __ATOMIC_RELAXED, __HIP_MEMORY_SCOPE_AGENT); }
__device__ __forceinline__ unsigned xb_add(unsigned* p, unsigned v) { return __hip_atomic_fetch_add(p, v, __ATOMIC_RELAXED, __HIP_MEMORY_SCOPE_AGENT); }
__device__ __forceinline__ unsigned xb_xcc_id() { return (unsigned)__builtin_amdgcn_s_getreg((3 << 11) | 20) & 0xFu; }
#define XB_SPIN(cond, bar) do { unsigned _sp = 0; while (cond) { __builtin_amdgcn_s_sleep(1); \
    if ((++_sp & 255u) == 0u) { if (xb_ld(&(bar)[XB_TMO])) break; if (_sp > XB_SPIN_CAP) { atomicAdd(&(bar)[XB_TMO], 1u); break; } } } } while (0)
__device__ __forceinline__ void xcd_barrier_complete(unsigned* bar, unsigned x, unsigned& nloc, unsigned& nx) {
    const unsigned G = gridDim.x;
    unsigned sum, cnt, mine, sp = 0u;
    for (;;) {
        sum = 0u; cnt = 0u; mine = 0u;
#pragma unroll
        for (unsigned j = 0; j < 16; ++j) { const unsigned c = xb_ld(&bar[XB_XCNT(j)]); sum += c; cnt += (c > 0u) ? 1u : 0u; mine = (j == x) ? c : mine; }
        if (sum == G) break;
        __builtin_amdgcn_s_sleep(1);
        if ((++sp & 255u) == 0u) { if (xb_ld(&bar[XB_TMO])) break; if (sp > XB_SPIN_CAP) { atomicAdd(&bar[XB_TMO], 1u); break; } }
    }
    nloc = mine > 0u ? mine : 1u; nx = cnt > 0u ? cnt : 1u;
}
__device__ __forceinline__ void xcd_barrier(unsigned* bar, volatile LDSB unsigned* st, const int tid) {
    asm volatile("s_waitcnt vmcnt(0)" ::: "memory");
    __syncthreads();
    if (tid == 0) {
        const unsigned x = xb_xcc_id();
        __builtin_amdgcn_s_waitcnt(0);
        unsigned nloc = st[0], nx = st[1];
        if (nloc == 0u) { xcd_barrier_complete(bar, x, nloc, nx); st[0] = nloc; st[1] = nx; }
        const unsigned old = xb_add(&bar[XB_XSUB(x)], 1u);
        const unsigned gen = old / nloc;
        if (old + 1u == (gen + 1u) * nloc) {
            __builtin_amdgcn_fence(__ATOMIC_RELEASE, "agent");
            asm volatile("s_waitcnt vmcnt(0)" ::: "memory");
            const unsigned og = xb_add(&bar[XB_TOP], 1u);
            const unsigned tg = og / nx;
            if (og + 1u == (tg + 1u) * nx) xb_add(&bar[XB_TOPGEN], 1u);
            else XB_SPIN(xb_ld(&bar[XB_TOPGEN]) == tg, bar);
            __builtin_amdgcn_fence(__ATOMIC_ACQUIRE, "agent");
            xb_add(&bar[XB_XGEN(x)], 1u);
            asm volatile("s_waitcnt vmcnt(0)" ::: "memory");
        } else {
            XB_SPIN(xb_ld(&bar[XB_XGEN(x)]) == gen, bar);
            __builtin_amdgcn_fence(__ATOMIC_ACQUIRE, "agent");
            asm volatile("s_waitcnt vmcnt(0)" ::: "memory");
        }
    }
    __syncthreads();
}

extern __shared__ __attribute__((aligned(16))) char smem[];

__global__ void __launch_bounds__(NTHR) hybrid_fwd(Params Pin) {
    char* shm = smem;
    volatile LDSB unsigned* bst = (volatile LDSB unsigned*)(smem + 139264);
    if (threadIdx.x == 0) { bst[0] = 0u; bst[1] = 0u; (void)xb_add((unsigned*)(Pin.ws + W_BAR) + XB_XCNT(xb_xcc_id()), 1u); }
    __syncthreads();
    for (int ph = Pin.ph_lo; ph < Pin.ph_hi; ++ph) {
        if (ph == 6 || ph == 11) continue;
        const int reps = ((REPEAT_MASK >> ph) & 1) ? 2 : 1;
        for (int rep = 0; rep < reps; ++rep) {
        if (rep > 0) xcd_barrier((unsigned*)(Pin.ws + W_BAR), bst, threadIdx.x);
        int tid = threadIdx.x, blk = blockIdx.x, nblk = gridDim.x;
        asm volatile("" : "+v"(tid));
        asm volatile("" : "+s"(blk), "+s"(nblk));
        PP P = (PP)__builtin_amdgcn_kernarg_segment_ptr();
        asm volatile("" : "+s"(P));
        const int lb = (blk & 7) * (nblk >> 3) + (blk >> 3);
        const int gtid = blk * NTHR + tid, nthreads = nblk * NTHR;
        const int gw = blk * 8 + (tid >> 6), nw = nblk * 8;
        switch (ph) {
#if PHASE_MASK & 1
        case 0: phase_prep(P, shm, blk, nblk, tid); break;
#endif
#if PHASE_MASK & 4
        case 2: phase_convpool(P, gtid, nthreads); break;
#endif
#if PHASE_MASK & 8
        case 3:
            if (blk & 1) { int it = blk; for (; it + nblk < 2048; it += 2 * nblk) ssd_sample<2>(P, it, nblk, tid); for (; it < 2048; it += nblk) ssd_sample<1>(P, it, nblk, tid); }
            for (int it = blk; it < 256; it += nblk) ssd_prompt(P, it, shm, tid);
            if (!(blk & 1)) { int it = blk; for (; it + nblk < 2048; it += 2 * nblk) ssd_sample<2>(P, it, nblk, tid); for (; it < 2048; it += nblk) ssd_sample<1>(P, it, nblk, tid); }
            break;
#endif
#if PHASE_MASK & 16
        case 4: phase_gatednorm(P, gw, nw, tid); break;
#endif
#if PHASE_MASK & 64
        case 6: phase_norm(P, P->norm_mem, false, gw, nw, tid); break;
        case 11: phase_norm(P, P->norm_ffn, false, gw, nw, tid); break;
        case 15: phase_norm(P, P->final_norm, true, gw, nw, tid); break;
#endif
#if PHASE_MASK & 8192
        case 13: phase_ffnconv(P, gtid, nthreads); break;
#endif
        default: break;
        }
#if PHASE_MASK & 256
        if (ph == 8 && (blk & 1)) { for (int it = blk; it < 512; it += nblk) attn_sample(P, it, shm, tid); __syncthreads(); }
#endif
#if PHASE_MASK & 2
        if (ph == 1 || ph == 5 || ph == 7 || ph == 8 || ph == 9 || ph == 10 || ph == 12 || ph == 14) gemm_phase(P, ph, shm, lb, blk, nblk, tid);
#endif
#if PHASE_MASK & 256
        if (ph == 9 && !(blk & 1)) { for (int it = blk; it < 512; it += nblk) attn_sample(P, it, shm, tid); }
#endif
        }
        if (ph + 1 < Pin.ph_hi && ph != 8) xcd_barrier((unsigned*)(Pin.ws + W_BAR), bst, threadIdx.x);
        if (ph == 8) { asm volatile("s_waitcnt vmcnt(0)" ::: "memory"); __syncthreads(); }
        if (EXTRA_SYNCS && ph == 0) { for (int i = 0; i < EXTRA_SYNCS; ++i) xcd_barrier((unsigned*)(Pin.ws + W_BAR), bst, threadIdx.x); }
    }
}

extern "C" void kernel_launch(void* const* d_in, const int* in_sizes, int n_in, void* d_out, int out_size, void* d_ws, size_t ws_size, hipStream_t stream) {
    static int grid_blocks = 0;
    if (!grid_blocks) {
        int dev = 0, cus = 0, per_cu = 0;
        hipGetDevice(&dev);
        hipDeviceGetAttribute(&cus, hipDeviceAttributeMultiprocessorCount, dev);
        hipFuncSetAttribute((const void*)hybrid_fwd, hipFuncAttributeMaxDynamicSharedMemorySize, LDS_BYTES);
        hipOccupancyMaxActiveBlocksPerMultiprocessor(&per_cu, hybrid_fwd, NTHR, LDS_BYTES);
        if (per_cu < 1) per_cu = 1;
        grid_blocks = cus * 1;
        grid_blocks &= ~7;
        if (grid_blocks < 8) grid_blocks = 8;
    }
    Params p{};
    const float* const* in = (const float* const*)d_in;
    p.x_prompt = in[0]; p.x_sample = in[1]; p.mem_prompt = in[2]; p.state_ssm = in[3]; p.state_conv = in[4]; p.state_pool = in[5]; p.state_ffn = in[6];
    p.cache_k = in[7]; p.cache_v = in[8]; p.norm_mix = in[9]; p.w_in = in[10]; p.conv_w = in[11]; p.conv_b = in[12]; p.dt_bias = in[13]; p.a_log = in[14];
    p.ssm_d = in[15]; p.ssm_norm = in[16]; p.w_pool = in[17]; p.pool_scale = in[18]; p.w_out = in[19]; p.norm_mem = in[20]; p.norm_memkv = in[21];
    p.w_mq = in[22]; p.w_mk = in[23]; p.w_mv = in[24]; p.w_mo = in[25]; p.norm_ffn = in[26]; p.w_up = in[27]; p.ffn_w = in[28]; p.ffn_b = in[29];
    p.w_down = in[30]; p.final_norm = in[31];
    p.out = (float*)d_out; p.ws = (char*)d_ws; p.ph_lo = 0; p.ph_hi = 16;
    hipMemsetAsync((char*)d_ws + W_BAR, 0, 16384, stream);
    void* args[] = {&p};
    hipError_t e = hipLaunchCooperativeKernel((const void*)hybrid_fwd, dim3(grid_blocks), dim3(NTHR), args, LDS_BYTES, stream);
    if (e != hipSuccess) fprintf(stderr, "cooperative launch failed: %s (grid %d)\n", hipGetErrorString(e), grid_blocks);
}
```

```cpp
#include <hip/hip_runtime.h>
#include <hip/hip_cooperative_groups.h>
#include <cstdio>
namespace cg = cooperative_groups;

typedef unsigned short bf16_t;
typedef short bf16x8 __attribute__((ext_vector_type(8)));
typedef short s16x4 __attribute__((ext_vector_type(4)));
typedef float f32x4 __attribute__((ext_vector_type(4)));
typedef unsigned u32x4 __attribute__((ext_vector_type(4)));
typedef unsigned u32x2 __attribute__((ext_vector_type(2)));
#define LDSB __attribute__((address_space(3)))

constexpr int TP = 16384, TS = 512, TT = TP + TS;
constexpr int NTHR = 512;
constexpr int LDS_BYTES = 139264 + 256;
constexpr float EPS = 1e-6f;
#ifndef PHASE_MASK
#define PHASE_MASK 0xFFFF
#endif
#ifndef REPEAT_MASK
#define REPEAT_MASK 0
#endif
#ifndef PROBE3
#define PROBE3 0
#endif
#ifndef EXTRA_SYNCS
#define EXTRA_SYNCS 0
#endif

constexpr size_t O_YP = 0;
constexpr size_t O_YS = O_YP + (size_t)TP * 1024;
constexpr size_t O_SSMP = O_YS + (size_t)TS * 1024;
constexpr size_t O_SSMS = O_SSMP + (size_t)8 * 16 * 64 * 128;
constexpr size_t O_CONVP = O_SSMS + (size_t)128 * 16 * 64 * 128;
constexpr size_t O_CONVS = O_CONVP + (size_t)8 * 3 * 1536;
constexpr size_t O_POOLP = O_CONVS + (size_t)128 * 3 * 1536;
constexpr size_t O_POOLS = O_POOLP + (size_t)8 * 15 * 1024;
constexpr size_t O_FFNP = O_POOLS + (size_t)128 * 15 * 1024;
constexpr size_t O_FFNS = O_FFNP + (size_t)8 * 2 * 5632;
constexpr size_t O_MK = O_FFNS + (size_t)128 * 2 * 5632;
constexpr size_t O_MV = O_MK + (size_t)8 * 256 * 1024;

constexpr size_t W_WIN = 0;
constexpr size_t W_WPOOL = W_WIN + (size_t)3584 * 1024 * 2;
constexpr size_t W_WOUT = W_WPOOL + (size_t)4 * 256 * 256 * 2;
constexpr size_t W_WMQ = W_WOUT + (size_t)1024 * 2048 * 2;
constexpr size_t W_WMK = W_WMQ + (size_t)1024 * 1024 * 2;
constexpr size_t W_WMV = W_WMK + (size_t)1024 * 1024 * 2;
constexpr size_t W_WMO = W_WMV + (size_t)1024 * 1024 * 2;
constexpr size_t W_WUP = W_WMO + (size_t)1024 * 1024 * 2;
constexpr size_t W_WDOWN = W_WUP + (size_t)5632 * 1024 * 2;
constexpr size_t W_H = W_WDOWN + (size_t)1024 * 2816 * 2;
constexpr size_t W_HM = W_H + (size_t)TT * 1024 * 2;
constexpr size_t W_KB = W_HM + (size_t)2048 * 1024 * 2;
constexpr size_t W_VT = W_KB + (size_t)2048 * 1024 * 2;
constexpr size_t W_DT = W_VT + (size_t)2048 * 1024 * 2;
constexpr size_t W_XRES = W_DT + (size_t)TT * 16 * 4;
constexpr size_t W_ARENA = W_XRES + (size_t)TT * 1024 * 4;
constexpr size_t W_Z = W_ARENA;
constexpr size_t W_PROJ2 = W_Z + (size_t)TT * 1024 * 2;
constexpr size_t W_XACT = W_PROJ2 + (size_t)TT * 2560 * 2;
constexpr size_t W_POOLED = W_XACT + (size_t)TT * 1536 * 2;
constexpr size_t W_Y = W_POOLED + (size_t)TT * 1024 * 2;
constexpr size_t W_MIX = W_Y + (size_t)TT * 1024 * 2;
constexpr size_t W_END_A = W_MIX + (size_t)TT * 2048 * 2;
constexpr size_t W_Q = W_PROJ2;
constexpr size_t W_P = W_Q + (size_t)TT * 1024 * 2;
constexpr size_t W_O = W_P + (size_t)TP * 1024 * 2;
constexpr size_t W_U = W_ARENA;
constexpr size_t W_ACT = W_U + (size_t)TT * 5632 * 2;
constexpr size_t W_END_C = W_ACT + (size_t)TT * 2816 * 2;
constexpr size_t W_BAR = W_END_A;
constexpr size_t W_SS1 = W_BAR + 16384;
constexpr size_t W_SS2 = W_SS1 + (size_t)TT * 4;
constexpr size_t W_SS3 = W_SS2 + (size_t)TT * 4;
constexpr size_t W_WLO = W_SS3 + (size_t)TT * 4;
constexpr size_t W_TOTAL = W_WLO + (size_t)1024 * 1024 * 2;
static_assert(W_O + (size_t)TT * 1024 * 2 <= W_POOLED, "era B overflow");
static_assert(W_END_C <= W_END_A, "era C overflow");

struct Params {
    const float *x_prompt, *x_sample, *mem_prompt, *state_ssm, *state_conv, *state_pool, *state_ffn, *cache_k, *cache_v;
    const float *norm_mix, *w_in, *conv_w, *conv_b, *dt_bias, *a_log, *ssm_d, *ssm_norm, *w_pool, *pool_scale, *w_out;
    const float *norm_mem, *norm_memkv, *w_mq, *w_mk, *w_mv, *w_mo, *norm_ffn, *w_up, *ffn_w, *ffn_b, *w_down, *final_norm;
    float* out;
    char* ws;
    int ph_lo, ph_hi;
};

typedef const __attribute__((address_space(4))) Params* PP;

__device__ __forceinline__ unsigned pk2(float lo, float hi) { unsigned r; asm("v_cvt_pk_bf16_f32 %0, %1, %2" : "=v"(r) : "v"(lo), "v"(hi)); return r; }
__device__ __forceinline__ bf16_t f2bf(float f) { return (bf16_t)(pk2(f, 0.f) & 0xffffu); }
__device__ __forceinline__ float bf2f(bf16_t b) { return __uint_as_float(((unsigned)b) << 16); }
__device__ __forceinline__ float bflo(unsigned u) { return __uint_as_float(u << 16); }
__device__ __forceinline__ float bfhi(unsigned u) { return __uint_as_float(u & 0xffff0000u); }
__device__ __forceinline__ void unpack8(u32x4 v, float (&f)[8]) {
    f[0] = bflo(v.x); f[1] = bfhi(v.x); f[2] = bflo(v.y); f[3] = bfhi(v.y); f[4] = bflo(v.z); f[5] = bfhi(v.z); f[6] = bflo(v.w); f[7] = bfhi(v.w);
}
__device__ __forceinline__ u32x4 pack8(const float (&f)[8]) { u32x4 r; r.x = pk2(f[0], f[1]); r.y = pk2(f[2], f[3]); r.z = pk2(f[4], f[5]); r.w = pk2(f[6], f[7]); return r; }
__device__ __forceinline__ float wave_sum(float v) {
#pragma unroll
    for (int o = 1; o < 64; o <<= 1) v += __shfl_xor(v, o);
    return v;
}
__device__ __forceinline__ float wave_max(float v) {
#pragma unroll
    for (int o = 1; o < 64; o <<= 1) v = fmaxf(v, __shfl_xor(v, o));
    return v;
}
__device__ __forceinline__ float silu_f(float x) { return x / (1.0f + __expf(-x)); }

constexpr int HTB = 128 * 64 * 2;
__device__ __forceinline__ int lds_byte(int r, int c) { const int st = (r >> 4) * 2 + (c >> 5), rr = r & 15, cc = c & 31, ob = rr * 64 + cc * 2; return st * 1024 + (ob ^ (((ob >> 9) & 1) << 5)); }
__device__ __forceinline__ void stage_rc(int b, int& R, int& C) { const int st = b / 1024, sb = b % 1024, swz = sb ^ (((sb >> 9) & 1) << 5); R = (st >> 1) * 16 + swz / 64; C = (st & 1) * 32 + (swz % 64) / 2; }

enum { E_PROJ = 0, E_MEMKV, E_POOL, E_OUT, E_Q, E_QK, E_PV, E_MO, E_UP, E_DOWN, E_FOLD };

template <int EK>
__device__ __forceinline__ float epi_apply(PP P, int row, int col, f32x4 v) {
    char* ws = P->ws;
    if constexpr (EK == E_PROJ) {
        u32x2 o; o.x = pk2(v[0], v[1]); o.y = pk2(v[2], v[3]);
        if (col < 1024) *(u32x2*)((bf16_t*)(ws + W_Z) + (size_t)row * 1024 + col) = o;
        else *(u32x2*)((bf16_t*)(ws + W_PROJ2) + (size_t)row * 2560 + (col - 1024)) = o;
    } else if constexpr (EK == E_MEMKV) {
        if (col < 1024) {
            *(f32x4*)(P->out + O_MK + (size_t)row * 1024 + col) = v;
            u32x2 o; o.x = pk2(v[0], v[1]); o.y = pk2(v[2], v[3]);
            *(u32x2*)((bf16_t*)(ws + W_KB) + (size_t)row * 1024 + col) = o;
        } else {
            const int c = col - 1024;
            *(f32x4*)(P->out + O_MV + (size_t)row * 1024 + c) = v;
            const int b = row >> 8, m = row & 255, hh = c >> 8, d = c & 255;
            bf16_t* vt = (bf16_t*)(ws + W_VT) + ((size_t)(b * 4 + hh) * 256 + d) * 256 + m;
#pragma unroll
            for (int j = 0; j < 4; ++j) vt[j * 256] = f2bf(v[j]);
        }
    } else if constexpr (EK == E_POOL) {
        const f32x4 sc = *(const f32x4*)(P->pool_scale + col);
        u32x2 o; o.x = pk2(v[0] * sc[0], v[1] * sc[1]); o.y = pk2(v[2] * sc[2], v[3] * sc[3]);
        *(u32x2*)((bf16_t*)(ws + W_MIX) + (size_t)row * 2048 + 1024 + col) = o;
    } else if constexpr (EK == E_OUT) {
        const float* xin = row < TP ? P->x_prompt + (size_t)row * 1024 : P->x_sample + (size_t)(row - TP) * 1024;
        const f32x4 x = *(const f32x4*)(xin + col) + v;
        u32x2 o; o.x = pk2(x[0], x[1]); o.y = pk2(x[2], x[3]);
        *(u32x2*)((bf16_t*)(ws + W_H) + (size_t)row * 1024 + col) = o;
        return (x[0] * x[0] + x[1] * x[1]) + (x[2] * x[2] + x[3] * x[3]);
    } else if constexpr (EK == E_Q) {
        u32x2 o; o.x = pk2(v[0], v[1]); o.y = pk2(v[2], v[3]);
        *(u32x2*)((bf16_t*)(ws + W_Q) + (size_t)row * 1024 + col) = o;
    } else if constexpr (EK == E_PV) {
        u32x2 o; o.x = pk2(v[0], v[1]); o.y = pk2(v[2], v[3]);
        *(u32x2*)((bf16_t*)(ws + W_O) + (size_t)row * 1024 + col) = o;
    } else if constexpr (EK == E_MO || EK == E_DOWN) {
        u32x2* hp = (u32x2*)((bf16_t*)(ws + W_H) + (size_t)row * 1024 + col);
        const u32x2 hv = *hp;
        const f32x4 x = (f32x4){bflo(hv.x), bfhi(hv.x), bflo(hv.y), bfhi(hv.y)} + v;
        u32x2 o; o.x = pk2(x[0], x[1]); o.y = pk2(x[2], x[3]);
        *hp = o;
        return (x[0] * x[0] + x[1] * x[1]) + (x[2] * x[2] + x[3] * x[3]);
    } else if constexpr (EK == E_UP) {
        u32x2 o; o.x = pk2(v[0], v[1]); o.y = pk2(v[2], v[3]);
        *(u32x2*)((bf16_t*)(ws + W_U) + (size_t)row * 5632 + col) = o;
    }
    return 0.f;
}
template <int EK>
__device__ __forceinline__ float epi_rowscale(PP P, int row) {
    if constexpr (EK == E_Q) return rsqrtf(((const float*)(P->ws + W_SS1))[row] * (1.0f / 1024.0f) + EPS) * 0.0625f;
    else if constexpr (EK == E_UP) return rsqrtf(((const float*)(P->ws + W_SS2))[row] * (1.0f / 1024.0f) + EPS);
    else return 1.0f;
}
__device__ __forceinline__ float epi_apply_rt(PP P, int ekind, int row, int col, f32x4 v) {
    switch (ekind) {
    case E_FOLD: { u32x2 o; o.x = pk2(v[0], v[1]); o.y = pk2(v[2], v[3]); *(u32x2*)((bf16_t*)(P->ws + W_WOUT) + (size_t)row * 2048 + 1024 + col) = o; return 0.f; }
    case E_OUT: return epi_apply<E_OUT>(P, row, col, v);
    case E_Q: return epi_apply<E_Q>(P, row, col, v * epi_rowscale<E_Q>(P, row));
    case E_MO: return epi_apply<E_MO>(P, row, col, v);
    default: return epi_apply<E_DOWN>(P, row, col, v);
    }
}
template <int EK>
__device__ __forceinline__ void epi_loop(PP P, const f32x4 (&acc)[2][2][4][2], int rbase, int cbase, int fq) {
    if constexpr (EK == E_PROJ || EK == E_UP) {
        const int cb8 = cbase + 4 * fq;
#pragma unroll
        for (int ai = 0; ai < 2; ++ai)
#pragma unroll
            for (int m = 0; m < 4; ++m) {
                const int row = rbase + ai * 128 + m * 16;
                const float rs = epi_rowscale<EK>(P, row);
#pragma unroll
                for (int bj = 0; bj < 2; ++bj) {
                    const f32x4 v0 = acc[ai][bj][m][0] * rs, v1 = acc[ai][bj][m][1] * rs;
                    u32x4 o; o.x = pk2(v0[0], v0[1]); o.y = pk2(v0[2], v0[3]); o.z = pk2(v1[0], v1[1]); o.w = pk2(v1[2], v1[3]);
                    const int col = cb8 + bj * 128;
                    if constexpr (EK == E_UP) *(u32x4*)((bf16_t*)(P->ws + W_U) + (size_t)row * 5632 + col) = o;
                    else { if (col < 1024) *(u32x4*)((bf16_t*)(P->ws + W_Z) + (size_t)row * 1024 + col) = o;
                           else *(u32x4*)((bf16_t*)(P->ws + W_PROJ2) + (size_t)row * 2560 + (col - 1024)) = o; }
                }
            }
        return;
    }
#pragma unroll
    for (int ai = 0; ai < 2; ++ai)
#pragma unroll
        for (int m = 0; m < 4; ++m) {
            const int row = rbase + ai * 128 + m * 16;
            const float rs = epi_rowscale<EK>(P, row);
            float ss = 0.f;
#pragma unroll
            for (int bj = 0; bj < 2; ++bj)
#pragma unroll
                for (int n = 0; n < 2; ++n) {
                    if constexpr (EK == E_Q || EK == E_UP) ss += epi_apply<EK>(P, row, cbase + bj * 128 + n * 16, acc[ai][bj][m][n] * rs);
                    else ss += epi_apply<EK>(P, row, cbase + bj * 128 + n * 16, acc[ai][bj][m][n]);
                }
            if constexpr (EK == E_OUT || EK == E_MO || EK == E_DOWN) {
                ss += __shfl_xor(ss, 16); ss += __shfl_xor(ss, 32);
                if (fq == 0) unsafeAtomicAdd((float*)(P->ws + (EK == E_OUT ? W_SS1 : EK == E_MO ? W_SS2 : W_SS3)) + row, ss);
            }
        }
}

struct PhaseCfg { const char* A; const char* B; int lda, ldb, K, nbig, nsmall, ncol64, ekind; };
__device__ __forceinline__ PhaseCfg phase_cfg(PP P, int gp) {
    const char* ws = P->ws; PhaseCfg c;
    switch (gp) {
    case 1:  c.A = ws + W_H;      c.B = ws + W_WIN;   c.lda = 1024; c.ldb = 1024; c.K = 1024; c.nbig = 66 * 14 + 64; c.nsmall = 512; c.ncol64 = 16; c.ekind = E_PROJ; break;
    case 3:  c.A = ws + W_POOLED; c.B = ws + W_WPOOL; c.lda = 1024; c.ldb = 256;  c.K = 256;  c.nbig = 256; c.nsmall = 256; c.ncol64 = 16; c.ekind = E_POOL; break;
    case 5:  c.A = ws + W_MIX;    c.B = ws + W_WOUT;  c.lda = 2048; c.ldb = 2048; c.K = 2048; c.nbig = 256; c.nsmall = 256; c.ncol64 = 16; c.ekind = E_OUT; break;
    case 7:  c.A = ws + W_H;      c.B = ws + W_WMQ;   c.lda = 1024; c.ldb = 1024; c.K = 1024; c.nbig = 256; c.nsmall = 256; c.ncol64 = 16; c.ekind = E_Q; break;
    case 8:  c.A = ws + W_Q;      c.B = ws + W_KB;    c.lda = 1024; c.ldb = 1024; c.K = 256;  c.nbig = 256; c.nsmall = 0;   c.ncol64 = 16; c.ekind = E_QK; break;
    case 9:  c.A = ws + W_P;      c.B = ws + W_VT;    c.lda = 1024; c.ldb = 256;  c.K = 256;  c.nbig = 256; c.nsmall = 0;   c.ncol64 = 16; c.ekind = E_PV; break;
    case 10: c.A = ws + W_O;      c.B = ws + W_WMO;   c.lda = 1024; c.ldb = 1024; c.K = 1024; c.nbig = 256; c.nsmall = 256; c.ncol64 = 16; c.ekind = E_MO; break;
    case 12: c.A = ws + W_H;      c.B = ws + W_WUP;   c.lda = 1024; c.ldb = 1024; c.K = 1024; c.nbig = 66 * 22; c.nsmall = 0; c.ncol64 = 88; c.ekind = E_UP; break;
    default: c.A = ws + W_ACT;    c.B = ws + W_WDOWN; c.lda = 2816; c.ldb = 2816; c.K = 2816; c.nbig = 256; c.nsmall = 256; c.ncol64 = 16; c.ekind = E_DOWN; break;
    }
    return c;
}
struct UnitD { const char* A; const char* B; int row0, col0, ekind; };
__device__ __forceinline__ void map_unit(int L, int nM, int nN, int& pm, int& pn) {
    const int nwg = nM * nN, q = nwg >> 3, r = nwg & 7, xcd = L & 7, off = L >> 3;
    const int wgid = (xcd < r ? xcd * (q + 1) : r * (q + 1) + (xcd - r) * q) + off;
    const int nig = 8 * nN, gid = wgid / nig, fm = gid * 8, gsz = (nM - fm) < 8 ? (nM - fm) : 8;
    const int w = wgid - gid * nig;
    pm = fm + w % gsz; pn = w / gsz;
}
__device__ __forceinline__ UnitD unit_decode(PP P, const PhaseCfg& c, int gp, int L) {
    UnitD d; d.ekind = c.ekind;
    int pm, pn;
    switch (gp) {
    case 1:
        if (L < 924) { map_unit(L, 66, 14, pm, pn); d.A = c.A + (size_t)pm * 256 * 2048; d.B = c.B + (size_t)pn * 256 * 2048; }
        else { map_unit(L - 924, 8, 8, pm, pn); d.A = P->ws + W_HM + (size_t)pm * 256 * 2048; d.B = P->ws + W_WMK + (size_t)pn * 256 * 2048; d.ekind = E_MEMKV; }
        break;
    case 3: map_unit(L, 64, 4, pm, pn); d.A = c.A + (size_t)pm * 256 * 2048 + pn * 512; d.B = c.B + (size_t)pn * 131072; break;
    case 8: map_unit(L, 64, 4, pm, pn); d.A = c.A + (size_t)pm * 256 * 2048 + pn * 512; d.B = c.B + (size_t)(pm >> 3) * 256 * 2048 + pn * 512; break;
    case 9: map_unit(L, 64, 4, pm, pn); d.A = c.A + (size_t)pm * 256 * 2048 + pn * 512; d.B = c.B + (size_t)((pm >> 3) * 4 + pn) * 131072; break;
    case 12: map_unit(L, 66, 22, pm, pn); d.A = c.A + (size_t)pm * 256 * 2048; d.B = c.B + (size_t)pn * 256 * 2048; break;
    default: map_unit(L, 64, 4, pm, pn); d.A = c.A + (size_t)pm * 256 * c.lda * 2; d.B = c.B + (size_t)pn * 256 * c.ldb * 2; break;
    }
    d.row0 = pm * 256; d.col0 = pn * 256;
    return d;
}

__device__ __forceinline__ void gemm_phase(PP P, int gp, char* shm_g, int lb, int blk, int nblk, const int tid) {
    LDSB unsigned char* lds = (LDSB unsigned char*)shm_g;
    const int wid = __builtin_amdgcn_readfirstlane(tid >> 6), lane = tid & 63, wr = wid >> 2, wc = wid & 3, fr = lane & 15, fq = lane >> 4;
    const PhaseCfg cfg = phase_cfg(P, gp);
    const int K = cfg.K, nt = K / 64;
    unsigned voffA, voffB;
    { int R, C; stage_rc(tid * 16, R, C); voffA = (unsigned)(R * cfg.lda + C) * 2u; voffB = (unsigned)(R * cfg.ldb + C) * 2u; }
    const size_t qstepvoffA = (size_t)64 * cfg.lda * 2, qstepvoffB = (size_t)64 * cfg.ldb * 2;
    const size_t kstep = 128;
    const size_t hstepA = (size_t)128 * cfg.lda * 2, hstepB = (size_t)128 * cfg.ldb * 2;
    const unsigned ldsw = (unsigned)wid * 1024u;
    const int aoff = lds_byte(wr * 64 + fr, fq * 8), boff = lds_byte(wc * 32 + fr, fq * 8);
    const bool chain = (cfg.ekind != E_QK);
#define G_SA(b, h) (((b) * 2 + (h)) * HTB)
#define G_SB(b, h) ((4 + (b) * 2 + (h)) * HTB)
#define G_STAGE(bufoff, gbase, voff) do { \
        __builtin_amdgcn_global_load_lds((const unsigned*)((const char*)(gbase) + (voff)), (LDSB unsigned*)(lds + (bufoff) + ldsw), 16, 0, 0); \
        __builtin_amdgcn_global_load_lds((const unsigned*)((const char*)(gbase) + qstep##voff + (voff)), (LDSB unsigned*)(lds + (bufoff) + ldsw + 8192), 16, 0, 0); } while (0)
#define G_LDA(dst, b, h) do { _Pragma("unroll") for (int m = 0; m < 4; ++m) _Pragma("unroll") for (int k = 0; k < 2; ++k) dst[m][k] = *(const LDSB bf16x8*)(lds + G_SA(b, h) + aoff + m * 2048 + k * 1024); } while (0)
#define G_LDB(dst, b, h) do { _Pragma("unroll") for (int n = 0; n < 2; ++n) _Pragma("unroll") for (int k = 0; k < 2; ++k) dst[n][k] = *(const LDSB bf16x8*)(lds + G_SB(b, h) + boff + n * 2048 + k * 1024); } while (0)
#define G_MMA(ai, bj, Af, Bf) do { __builtin_amdgcn_s_setprio(1); _Pragma("unroll") for (int m = 0; m < 4; ++m) _Pragma("unroll") for (int n = 0; n < 2; ++n) _Pragma("unroll") for (int k = 0; k < 2; ++k) \
        acc[ai][bj][m][n] = __builtin_amdgcn_mfma_f32_16x16x32_bf16(Bf[n][k], Af[m][k], acc[ai][bj][m][n], 0, 0, 0); __builtin_amdgcn_s_setprio(0); } while (0)
#define G_WAIT_V(n) asm volatile("s_waitcnt vmcnt(" #n ")" ::: "memory")
#define G_WAIT_L(n) asm volatile("s_waitcnt lgkmcnt(" #n ")" ::: "memory")
#define G_BAR __builtin_amdgcn_s_barrier()
#define G_SCHED __builtin_amdgcn_sched_barrier(0)
    int u = blk;
    while (u < cfg.nbig) {
        UnitD cur = unit_decode(P, cfg, gp, u);
        f32x4 acc[2][2][4][2];
#pragma unroll
        for (int a = 0; a < 2; ++a)
#pragma unroll
            for (int b = 0; b < 2; ++b)
#pragma unroll
                for (int m = 0; m < 4; ++m)
#pragma unroll
                    for (int n = 0; n < 2; ++n) acc[a][b][m][n] = (f32x4){0.f, 0.f, 0.f, 0.f};
        bf16x8 At[4][2], B0[2][2], B1[2][2];
        const char* cA = cur.A; const char* cB = cur.B;
        G_STAGE(G_SB(0, 0), cB, voffB); G_STAGE(G_SA(0, 0), cA, voffA); G_STAGE(G_SB(0, 1), cB + hstepB, voffB); G_STAGE(G_SA(0, 1), cA + hstepA, voffA);
        if (wr == 1) G_BAR;
        G_WAIT_V(4); G_BAR;
        G_STAGE(G_SB(1, 0), cB + kstep, voffB); G_STAGE(G_SA(1, 0), cA + kstep, voffA); G_STAGE(G_SB(1, 1), cB + hstepB + kstep, voffB);
        G_WAIT_V(6); G_BAR;
        for (;;) {
            const bool has_next = chain && (u + nblk < cfg.nbig);
            UnitD nxt = cur;
            if (has_next) nxt = unit_decode(P, cfg, gp, u + nblk);
            const char* nA = nxt.A; const char* nB = nxt.B;
            for (int t = 0; t < nt; t += 2) {
                const bool last = (t == nt - 2);
                const char* a1 = cA + (size_t)(t + 1) * kstep;
                const char* a2 = last ? nA : cA + (size_t)(t + 2) * kstep; const char* b2 = last ? nB : cB + (size_t)(t + 2) * kstep;
                const char* a3 = a2 + kstep; const char* b3 = b2 + kstep;
                G_LDB(B0, 0, 0); G_SCHED; G_LDA(At, 0, 0); G_STAGE(G_SA(1, 1), a1 + hstepA, voffA);
                G_WAIT_L(8); G_BAR; G_WAIT_L(0); G_MMA(0, 0, At, B0); G_BAR; G_SCHED;
                G_LDB(B1, 0, 1); G_STAGE(G_SB(0, 0), b2, voffB);
                G_BAR; G_WAIT_L(0); G_MMA(0, 1, At, B1); G_BAR;
                G_LDA(At, 0, 1); G_STAGE(G_SA(0, 0), a2, voffA);
                G_BAR; G_WAIT_L(0); G_MMA(1, 0, At, B0); G_BAR; G_SCHED;
                G_STAGE(G_SB(0, 1), b2 + hstepB, voffB);
                G_WAIT_V(6); G_BAR; G_MMA(1, 1, At, B1); G_BAR;
                G_LDB(B0, 1, 0); G_SCHED; G_LDA(At, 1, 0); G_STAGE(G_SA(0, 1), a2 + hstepA, voffA);
                G_WAIT_L(8); G_BAR; G_WAIT_L(0); G_MMA(0, 0, At, B0); G_BAR; G_SCHED;
                G_LDB(B1, 1, 1); G_STAGE(G_SB(1, 0), b3, voffB);
                G_BAR; G_WAIT_L(0); G_MMA(0, 1, At, B1); G_BAR;
                G_LDA(At, 1, 1); G_STAGE(G_SA(1, 0), a3, voffA);
                G_BAR; G_WAIT_L(0); G_MMA(1, 0, At, B0); G_BAR; G_SCHED;
                G_STAGE(G_SB(1, 1), b3 + hstepB, voffB);
                G_WAIT_V(6); G_BAR; G_MMA(1, 1, At, B1); G_BAR;
            }
            if (chain) {
                const int rbase = cur.row0 + wr * 64 + fr, cbase = cur.col0 + wc * 32 + fq * 4;
                switch (cur.ekind) {
                case E_PROJ: epi_loop<E_PROJ>(P, acc, rbase, cbase, fq); break;
                case E_MEMKV: epi_loop<E_MEMKV>(P, acc, rbase, cbase, fq); break;
                case E_POOL: epi_loop<E_POOL>(P, acc, rbase, cbase, fq); break;
                case E_OUT: epi_loop<E_OUT>(P, acc, rbase, cbase, fq); break;
                case E_Q: epi_loop<E_Q>(P, acc, rbase, cbase, fq); break;
                case E_PV: epi_loop<E_PV>(P, acc, rbase, cbase, fq); break;
                case E_MO: epi_loop<E_MO>(P, acc, rbase, cbase, fq); break;
                case E_UP: epi_loop<E_UP>(P, acc, rbase, cbase, fq); break;
                default: epi_loop<E_DOWN>(P, acc, rbase, cbase, fq); break;
                }
            }
            if (!has_next) break;
#pragma unroll
            for (int a = 0; a < 2; ++a)
#pragma unroll
                for (int b = 0; b < 2; ++b)
#pragma unroll
                    for (int m = 0; m < 4; ++m)
#pragma unroll
                        for (int n = 0; n < 2; ++n) acc[a][b][m][n] = (f32x4){0.f, 0.f, 0.f, 0.f};
            cur = nxt; cA = nA; cB = nB; u += nblk;
        }
        G_WAIT_V(0);
        if (wr == 0) G_BAR;
        G_BAR;
        if (!chain) {
            float* redm = (float*)(shm_g + 131072);
            float* reds = (float*)(shm_g + 135168);
#pragma unroll
            for (int ai = 0; ai < 2; ++ai)
#pragma unroll
                for (int m = 0; m < 4; ++m) {
                    float t = -3.0e38f;
#pragma unroll
                    for (int bj = 0; bj < 2; ++bj)
#pragma unroll
                        for (int n = 0; n < 2; ++n)
#pragma unroll
                            for (int j = 0; j < 4; ++j) t = fmaxf(t, acc[ai][bj][m][n][j]);
                    t = fmaxf(t, __shfl_xor(t, 16)); t = fmaxf(t, __shfl_xor(t, 32));
                    if (fq == 0) redm[(ai * 128 + wr * 64 + m * 16 + fr) * 4 + wc] = t;
                }
            __syncthreads();
#pragma unroll
            for (int ai = 0; ai < 2; ++ai)
#pragma unroll
                for (int m = 0; m < 4; ++m) {
                    const f32x4 r = *(const f32x4*)(redm + (ai * 128 + wr * 64 + m * 16 + fr) * 4);
                    const float M = fmaxf(fmaxf(r[0], r[1]), fmaxf(r[2], r[3]));
                    float s = 0.f;
#pragma unroll
                    for (int bj = 0; bj < 2; ++bj)
#pragma unroll
                        for (int n = 0; n < 2; ++n)
#pragma unroll
                            for (int j = 0; j < 4; ++j) { const float e = __expf(acc[ai][bj][m][n][j] - M); acc[ai][bj][m][n][j] = e; s += e; }
                    s += __shfl_xor(s, 16); s += __shfl_xor(s, 32);
                    if (fq == 0) reds[(ai * 128 + wr * 64 + m * 16 + fr) * 4 + wc] = s;
                }
            __syncthreads();
#pragma unroll
            for (int ai = 0; ai < 2; ++ai)
#pragma unroll
                for (int m = 0; m < 4; ++m) {
                    const int rl = ai * 128 + wr * 64 + m * 16 + fr;
                    const f32x4 r = *(const f32x4*)(reds + rl * 4);
                    const float inv = 1.0f / ((r[0] + r[1]) + (r[2] + r[3]));
                    bf16_t* prow = (bf16_t*)(P->ws + W_P) + (size_t)(cur.row0 + rl) * 1024 + cur.col0;
#pragma unroll
                    for (int bj = 0; bj < 2; ++bj)
#pragma unroll
                        for (int n = 0; n < 2; ++n) {
                            const f32x4 v = acc[ai][bj][m][n];
                            u32x2 o; o.x = pk2(v[0] * inv, v[1] * inv); o.y = pk2(v[2] * inv, v[3] * inv);
                            *(u32x2*)(prow + bj * 128 + wc * 32 + n * 16 + fq * 4) = o;
                        }
                }
            __syncthreads();
        }
        u += nblk;
    }
#undef G_SA
#undef G_SB
#undef G_STAGE
#undef G_LDA
#undef G_LDB
#undef G_MMA
    const int rot = cfg.nbig % nblk;
    for (int s0 = (lb - rot + nblk) % nblk; s0 < cfg.nsmall; s0 += nblk) {
        const int pr = s0 / cfg.ncol64, pc = s0 % cfg.ncol64;
        const int row0 = (gp == 1 ? 0 : TP) + pr * 32, col0 = pc * 64;
        int lda_s = cfg.lda, ldb_s = cfg.ldb, K_s = K, ek_s = cfg.ekind;
        const bf16_t* Ab; const bf16_t* Bb;
        if (gp == 1) {
            const int g = pc >> 2; lda_s = 1024; ldb_s = 256; K_s = 256; ek_s = E_FOLD;
            Ab = (const bf16_t*)(P->ws + W_WLO) + (size_t)row0 * 1024 + g * 256; Bb = (const bf16_t*)(P->ws + W_WPOOL) + (size_t)g * 65536 + (size_t)(col0 - g * 256) * 256;
        } else { Ab = (const bf16_t*)cfg.A + (size_t)row0 * cfg.lda; Bb = (const bf16_t*)cfg.B + (size_t)col0 * cfg.ldb; }
        const int kw = K_s >> 3, nks = kw >> 5;
        f32x4 acc[2][4];
#pragma unroll
        for (int mi = 0; mi < 2; ++mi)
#pragma unroll
            for (int ni = 0; ni < 4; ++ni) acc[mi][ni] = (f32x4){0.f, 0.f, 0.f, 0.f};
        const bf16_t* ap = Ab + (size_t)fr * lda_s + wid * kw + fq * 8;
        const bf16_t* bp = Bb + (size_t)fr * ldb_s + wid * kw + fq * 8;
        for (int ks0 = 0; ks0 < nks; ks0 += 4) {
            bf16x8 a[4][2], b[4][4];
#pragma unroll
            for (int q = 0; q < 4; ++q) {
                const bool ok = ks0 + q < nks;
#pragma unroll
                for (int mi = 0; mi < 2; ++mi) { bf16x8 z = {0, 0, 0, 0, 0, 0, 0, 0}; if (ok) z = *(const bf16x8*)(ap + (size_t)mi * 16 * lda_s + (ks0 + q) * 32); a[q][mi] = z; }
#pragma unroll
                for (int ni = 0; ni < 4; ++ni) { bf16x8 z = {0, 0, 0, 0, 0, 0, 0, 0}; if (ok) z = *(const bf16x8*)(bp + (size_t)ni * 16 * ldb_s + (ks0 + q) * 32); b[q][ni] = z; }
            }
#pragma unroll
            for (int q = 0; q < 4; ++q)
#pragma unroll
                for (int mi = 0; mi < 2; ++mi)
#pragma unroll
                    for (int ni = 0; ni < 4; ++ni) acc[mi][ni] = __builtin_amdgcn_mfma_f32_16x16x32_bf16(b[q][ni], a[q][mi], acc[mi][ni], 0, 0, 0);
        }
        float* red = (float*)shm_g;
#pragma unroll
        for (int mi = 0; mi < 2; ++mi)
#pragma unroll
            for (int ni = 0; ni < 4; ++ni) *(f32x4*)(red + wid * 2048 + (mi * 16 + fr) * 64 + ni * 16 + fq * 4) = acc[mi][ni];
        __syncthreads();
        {
            const int r = tid >> 4, c = (tid & 15) * 4;
            f32x4 v = *(const f32x4*)(red + r * 64 + c);
#pragma unroll
            for (int w = 1; w < 8; ++w) v += *(const f32x4*)(red + w * 2048 + r * 64 + c);
            float ss = epi_apply_rt(P, ek_s, row0 + r, col0 + c, v);
            if (cfg.ekind == E_OUT || cfg.ekind == E_MO || cfg.ekind == E_DOWN) {
                ss += __shfl_xor(ss, 1); ss += __shfl_xor(ss, 2); ss += __shfl_xor(ss, 4); ss += __shfl_xor(ss, 8);
                if ((tid & 15) == 0) unsafeAtomicAdd((float*)(P->ws + (cfg.ekind == E_OUT ? W_SS1 : cfg.ekind == E_MO ? W_SS2 : W_SS3)) + row0 + r, ss);
            }
        }
        __syncthreads();
    }
}

__device__ __forceinline__ int perm32(int rho) { const int n = rho >> 4, i = rho & 15; return 8 * (i >> 2) + 4 * n + (i & 3); }
struct TrDesc { const float* src; bf16_t* dst; const float* gain; int ld_src, ld_dst, k0, n0s, n0d, perm; };
__device__ __forceinline__ TrDesc tr_decode(PP P, int i) {
    char* ws = P->ws; TrDesc d; d.gain = nullptr; d.perm = 0;
    if (i < 896) { const int kt = i / 56, ntl = i % 56; d.n0d = ntl * 64; d.n0s = d.n0d < 2560 ? d.n0d : d.n0d + 16; d.src = P->w_in; d.ld_src = 3600; d.dst = (bf16_t*)(ws + W_WIN); d.ld_dst = 1024; d.k0 = kt * 64; d.perm = 1; return d; }
    i -= 896;
    if (i < 512) { const int kt = i >> 4, ntl = i & 15; d.ld_src = 1024; d.n0s = d.n0d = ntl * 64;
        if (kt < 16) { d.src = P->w_out; d.dst = (bf16_t*)(ws + W_WOUT); d.ld_dst = 2048; d.k0 = kt * 64; }
        else { d.src = P->w_out + (size_t)1024 * 1024; d.dst = (bf16_t*)(ws + W_WLO); d.ld_dst = 1024; d.k0 = (kt - 16) * 64; }
        return d; }
    i -= 512;
    if (i < 1024) { const int wsel = i >> 8, r = i & 255, kt = r >> 4, ntl = r & 15;
        d.src = wsel == 0 ? P->w_mq : wsel == 1 ? P->w_mk : wsel == 2 ? P->w_mv : P->w_mo;
        d.dst = (bf16_t*)(ws + (wsel == 0 ? W_WMQ : wsel == 1 ? W_WMK : wsel == 2 ? W_WMV : W_WMO));
        d.gain = wsel == 0 ? P->norm_mem : nullptr; d.ld_src = 1024; d.ld_dst = 1024; d.k0 = kt * 64; d.n0s = d.n0d = ntl * 64; return d; }
    i -= 1024;
    if (i < 1408) { const int kt = i / 88, ntl = i % 88; d.src = P->w_up; d.ld_src = 5632; d.dst = (bf16_t*)(ws + W_WUP); d.ld_dst = 1024; d.gain = P->norm_ffn; d.k0 = kt * 64; d.n0s = d.n0d = ntl * 64; d.perm = 1; return d; }
    i -= 1408;
    { const int kt = i >> 4, ntl = i & 15; d.src = P->w_down; d.ld_src = 1024; d.dst = (bf16_t*)(ws + W_WDOWN); d.ld_dst = 2816; d.k0 = kt * 64; d.n0s = d.n0d = ntl * 64; return d; }
}

__device__ __forceinline__ void phase_prep(PP P, char* shm, int blk, int nblk, const int tid) {
    const int wid = tid >> 6, lane = tid & 63;
    float* tiles = (float*)shm;
    float* wdt = (float*)(shm + 69632);
    for (int i = blk * NTHR + tid; i < 3 * TT; i += nblk * NTHR) ((float*)(P->ws + W_SS1))[i] = 0.f;
    for (int i = (blk * NTHR + tid) * 4; i < 4 * 65536; i += nblk * NTHR * 4) {
        const f32x4 wv = *(const f32x4*)(P->w_pool + i), sv = *(const f32x4*)(P->pool_scale + (i >> 16) * 256 + (i & 255));
        u32x2 o; o.x = pk2(wv[0] * sv[0], wv[1] * sv[1]); o.y = pk2(wv[2] * sv[2], wv[3] * sv[3]);
        *(u32x2*)((bf16_t*)(P->ws + W_WPOOL) + i) = o;
    }
    for (int i = tid; i < 1024 * 16; i += NTHR) { const int k = i >> 4, hd = i & 15; wdt[hd * 1024 + k] = P->w_in[(size_t)k * 3600 + 2560 + hd]; }
    __syncthreads();
    char* ws = P->ws;
    constexpr int NGRP = (TT + 2048) / 32;
    for (int it = blk; it < NGRP; it += nblk) {
        const int rbase = it * 32 + wid * 4;
        const bool ismem = rbase >= TT;
        f32x4 xv[4][4];
#pragma unroll
        for (int r = 0; r < 4; ++r) {
            const int row = (ismem ? rbase - TT : rbase) + r;
            const float* xr = ismem ? P->mem_prompt + (size_t)row * 1024 : (row < TP ? P->x_prompt + (size_t)row * 1024 : P->x_sample + (size_t)(row - TP) * 1024);
#pragma unroll
            for (int j = 0; j < 4; ++j) xv[r][j] = __builtin_nontemporal_load((const f32x4*)(xr + j * 256 + lane * 4));
        }
        const float* gg = ismem ? P->norm_memkv : P->norm_mix;
#pragma unroll
        for (int r = 0; r < 4; ++r) {
            const int row = (ismem ? rbase - TT : rbase) + r;
            bf16_t* orow = (bf16_t*)(ws + (ismem ? W_HM : W_H)) + (size_t)row * 1024;
            float ss = 0.f;
#pragma unroll
            for (int j = 0; j < 4; ++j) ss += xv[r][j][0] * xv[r][j][0] + xv[r][j][1] * xv[r][j][1] + xv[r][j][2] * xv[r][j][2] + xv[r][j][3] * xv[r][j][3];
            ss = wave_sum(ss);
            const float rstd = rsqrtf(ss * (1.0f / 1024.0f) + EPS);
#pragma unroll
            for (int j = 0; j < 4; ++j) { const f32x4 g4 = *(const f32x4*)(gg + j * 256 + lane * 4); xv[r][j] = xv[r][j] * rstd * g4;
                u32x2 o; o.x = pk2(xv[r][j][0], xv[r][j][1]); o.y = pk2(xv[r][j][2], xv[r][j][3]); *(u32x2*)(orow + j * 256 + lane * 4) = o; }
            if (!ismem) {
                float mine = 0.f;
#pragma unroll
                for (int hd = 0; hd < 16; ++hd) {
                    float acc = 0.f;
#pragma unroll
                    for (int j = 0; j < 4; ++j) { const f32x4 w4 = *(const f32x4*)(wdt + hd * 1024 + j * 256 + lane * 4); acc += xv[r][j][0] * w4[0] + xv[r][j][1] * w4[1] + xv[r][j][2] * w4[2] + xv[r][j][3] * w4[3]; }
                    acc = wave_sum(acc);
                    if (lane == hd) mine = acc;
                }
                if (lane < 16) { const float x = mine + P->dt_bias[lane]; const float ey = __expf(-fabsf(x)); const float l1p = ey < 0.03f ? ey * (1.0f - ey * (0.5f - ey * (0.33333333f - 0.25f * ey))) : __logf(1.0f + ey); const float sp = fmaxf(x, 0.f) + l1p; ((float*)(ws + W_DT))[(size_t)row * 16 + lane] = sp; }
            }
        }
    }
    __syncthreads();
    const int kr = tid >> 4, nc = (tid & 15) * 4, tn = tid >> 3, tk8 = (tid & 7) * 8;
    for (int it = blk; it < 4544; it += 4 * nblk) {
        f32x4 v[4][2];
#pragma unroll
        for (int q = 0; q < 4; ++q) {
            const int i = it + q * nblk;
            if (i < 4544) { const TrDesc d = tr_decode(P, i);
#pragma unroll
                for (int h = 0; h < 2; ++h) { const int k = kr + h * 32; f32x4 t = __builtin_nontemporal_load((const f32x4*)(d.src + (size_t)(d.k0 + k) * d.ld_src + d.n0s + nc)); if (d.gain) t *= d.gain[d.k0 + k]; v[q][h] = t; } }
        }
#pragma unroll
        for (int q = 0; q < 4; ++q) {
            if (it + q * nblk < 4544) { float* tile = tiles + q * (64 * 65);
#pragma unroll
                for (int h = 0; h < 2; ++h) { const int k = kr + h * 32; tile[k * 65 + nc + 0] = v[q][h][0]; tile[k * 65 + nc + 1] = v[q][h][1]; tile[k * 65 + nc + 2] = v[q][h][2]; tile[k * 65 + nc + 3] = v[q][h][3]; } }
        }
        __syncthreads();
#pragma unroll
        for (int q = 0; q < 4; ++q) {
            const int i = it + q * nblk;
            if (i < 4544) { const TrDesc d = tr_decode(P, i); const float* tile = tiles + q * (64 * 65); float f[8];
                const int sc = d.perm ? (tn & 32) + perm32(tn & 31) : tn;
#pragma unroll
                for (int e2 = 0; e2 < 8; ++e2) f[e2] = tile[(tk8 + e2) * 65 + sc];
                *(u32x4*)(d.dst + (size_t)(d.n0d + tn) * d.ld_dst + d.k0 + tk8) = pack8(f); }
        }
        __syncthreads();
    }
}

__device__ __forceinline__ u32x4 ld8(const bf16_t* p) { return *(const u32x4*)p; }

__device__ __forceinline__ void phase_convpool(PP P, int gtid, int nthreads) {
    char* ws = P->ws;
    const bf16_t* proj2 = (const bf16_t*)(ws + W_PROJ2);
    bf16_t* xact = (bf16_t*)(ws + W_XACT);
    bf16_t* pooled = (bf16_t*)(ws + W_POOLED);
    for (int idx = gtid; idx < 1152 * 320; idx += nthreads) {
        const int run = idx / 320, cg = idx % 320;
        const bool samp = run >= 1024;
        int t0, len, bidx, tl0;
        if (!samp) { t0 = run * 16; len = 16; bidx = t0 >> 11; tl0 = t0 & 2047; } else { bidx = run - 1024; t0 = TP + bidx * 4; len = 4; tl0 = 0; }
        if (cg < 192) {
            const int c0 = cg * 8;
            float w0[8], w1[8], w2[8], w3[8], bs[8], h0[8], h1[8], h2[8];
#pragma unroll
            for (int e = 0; e < 8; ++e) { w0[e] = P->conv_w[c0 + e]; w1[e] = P->conv_w[1536 + c0 + e]; w2[e] = P->conv_w[3072 + c0 + e]; w3[e] = P->conv_w[4608 + c0 + e]; bs[e] = P->conv_b[c0 + e]; }
            if (samp) {
#pragma unroll
                for (int e = 0; e < 8; ++e) { h0[e] = P->state_conv[(size_t)(bidx * 3 + 0) * 1536 + c0 + e]; h1[e] = P->state_conv[(size_t)(bidx * 3 + 1) * 1536 + c0 + e]; h2[e] = P->state_conv[(size_t)(bidx * 3 + 2) * 1536 + c0 + e]; }
            } else if (tl0 > 0) {
                unpack8(ld8(proj2 + (size_t)(t0 - 3) * 2560 + c0), h0); unpack8(ld8(proj2 + (size_t)(t0 - 2) * 2560 + c0), h1); unpack8(ld8(proj2 + (size_t)(t0 - 1) * 2560 + c0), h2);
            } else {
#pragma unroll
                for (int e = 0; e < 8; ++e) { h0[e] = 0.f; h1[e] = 0.f; h2[e] = 0.f; }
            }
            u32x4 rx[16];
#pragma unroll
            for (int j = 0; j < 16; ++j) { if (j < len) rx[j] = ld8(proj2 + (size_t)(t0 + j) * 2560 + c0); }
#pragma unroll
            for (int j = 0; j < 16; ++j) {
                if (j < len) {
                float x3[8], y[8]; unpack8(rx[j], x3);
#pragma unroll
                for (int e = 0; e < 8; ++e) { const float v = bs[e] + w0[e] * h0[e] + w1[e] * h1[e] + w2[e] * h2[e] + w3[e] * x3[e]; y[e] = silu_f(v); }
                *(u32x4*)(xact + (size_t)(t0 + j) * 1536 + c0) = pack8(y);
                if (samp) { if (j >= 1) { float* o = P->out + O_CONVS + (size_t)(bidx * 3 + j - 1) * 1536 + c0;
#pragma unroll
                        for (int e = 0; e < 8; ++e) o[e] = x3[e]; } }
                else { const int tl = tl0 + j; if (tl >= 2045) { float* o = P->out + O_CONVP + (size_t)(bidx * 3 + tl - 2045) * 1536 + c0;
#pragma unroll
                        for (int e = 0; e < 8; ++e) o[e] = x3[e]; } }
#pragma unroll
                for (int e = 0; e < 8; ++e) { h0[e] = h1[e]; h1[e] = h2[e]; h2[e] = x3[e]; }
                }
            }
        } else {
            const int c0 = (cg - 192) * 8; const int win = 2 << (c0 >> 8);
            const bf16_t* vp = proj2 + 1536 + c0;
            const float* prev = P->state_pool + (size_t)bidx * 15 * 1024 + c0;
            float sum[8];
#pragma unroll
            for (int e = 0; e < 8; ++e) sum[e] = 0.f;
            if (samp) {
                for (int jj = 1; jj < win; ++jj) {
#pragma unroll
                    for (int e = 0; e < 8; ++e) sum[e] += prev[(size_t)(15 - jj) * 1024 + e]; }
                float* o = P->out + O_POOLS + (size_t)bidx * 15 * 1024 + c0;
                for (int i = 0; i < 11; ++i) {
#pragma unroll
                    for (int e = 0; e < 8; ++e) o[(size_t)i * 1024 + e] = prev[(size_t)(i + 4) * 1024 + e]; }
            } else if (tl0 > 0) {
                for (int jj = 1; jj < win; ++jj) { float v[8]; unpack8(ld8(vp + (size_t)(t0 - jj) * 2560), v);
#pragma unroll
                    for (int e = 0; e < 8; ++e) sum[e] += v[e]; }
            }
            u32x4 rp[16];
#pragma unroll
            for (int j = 0; j < 16; ++j) { if (j < len) rp[j] = ld8(vp + (size_t)(t0 + j) * 2560); }
#pragma unroll
            for (int j = 0; j < 16; ++j) {
                if (j >= len) continue;
                float v[8], o8[8]; unpack8(rp[j], v);
                const int tl = tl0 + j;
                const float inv = 1.0f / (float)(samp ? win : (tl + 1 < win ? tl + 1 : win));
#pragma unroll
                for (int e = 0; e < 8; ++e) { sum[e] += v[e]; o8[e] = sum[e] * inv - v[e]; }
                *(u32x4*)((bf16_t*)(ws + W_MIX) + (size_t)(t0 + j) * 2048 + 1024 + c0) = pack8(o8);
                const int to = j - win + 1;
                if (samp) {
                    if (to >= 0) { float q[8]; unpack8(ld8(vp + (size_t)(t0 + to) * 2560), q);
#pragma unroll
                        for (int e = 0; e < 8; ++e) sum[e] -= q[e]; }
                    else {
#pragma unroll
                        for (int e = 0; e < 8; ++e) sum[e] -= prev[(size_t)(15 + to) * 1024 + e]; }
                    float* o = P->out + O_POOLS + (size_t)(bidx * 15 + 11 + j) * 1024 + c0;
#pragma unroll
                    for (int e = 0; e < 8; ++e) o[e] = v[e];
                } else {
                    if (tl0 + to >= 0) { float q[8]; unpack8(ld8(vp + (size_t)(t0 + to) * 2560), q);
#pragma unroll
                        for (int e = 0; e < 8; ++e) sum[e] -= q[e]; }
                    if (tl >= 2033) { float* o = P->out + O_POOLP + (size_t)(bidx * 15 + tl - 2033) * 1024 + c0;
#pragma unroll
                        for (int e = 0; e < 8; ++e) o[e] = v[e]; }
                }
            }
        }
    }
}

constexpr int CS_STR = 136;
constexpr int X_STR = 40;
__device__ __forceinline__ s16x4 tr_read(const bf16_t* p) { return __builtin_bit_cast(s16x4, __builtin_amdgcn_ds_read_tr16_b64_v4i16((LDSB s16x4*)p)); }

#define LDS_BARRIER() asm volatile("s_waitcnt lgkmcnt(0)\n\ts_barrier" ::: "memory")
__device__ __forceinline__ void ssd_prompt(PP P, int item, char* shm, const int tid) {
    const int w = tid >> 6, lane = tid & 63, fr = lane & 15, fq = lane >> 4;
    const int b = item >> 5, hd = (item >> 1) & 15, ph = item & 1, g = hd >> 3;
    const float a = -expf(P->a_log[hd]);
    const float Dh = P->ssm_d[hd];
    char* ws = P->ws;
    const bf16_t* xact = (const bf16_t*)(ws + W_XACT);
    const float* dtb = (const float*)(ws + W_DT);
    bf16_t* ybuf = (bf16_t*)(ws + W_Y);
    bf16_t* Cs = (bf16_t*)(shm);
    bf16_t* Bs = (bf16_t*)(shm + 34816);
    bf16_t* Xd = (bf16_t*)(shm + 69632);
    bf16_t* X2 = (bf16_t*)(shm + 69632 + 10240);
    bf16_t* Ht = (bf16_t*)(shm + 69632 + 20480);
    float* acs = (float*)(shm + 69632 + 30720);
    float* dts = (float*)(shm + 69632 + 31232);
    f32x4 Hacc[2];
    Hacc[0] = (f32x4){0.f, 0.f, 0.f, 0.f}; Hacc[1] = (f32x4){0.f, 0.f, 0.f, 0.f};
    const int q4 = fr >> 2, p4 = fr & 3;
    u32x4 pc[4], pb[4], px; float pd0, pd1;
    const int ls = tid >> 4, ln8 = (tid & 15) * 8;
    const int xs = tid >> 2, xp8 = (tid & 3) * 8;
#define SSD_PREFETCH(cc) do { const int _t0 = b * 2048 + (cc) * 128; \
        _Pragma("unroll") for (int i = 0; i < 4; ++i) { const bf16_t* src = xact + (size_t)(_t0 + ls + i * 32) * 1536 + g * 128 + ln8; pc[i] = *(const u32x4*)(src + 1280); pb[i] = *(const u32x4*)(src + 1024); } \
        px = *(const u32x4*)(xact + (size_t)(_t0 + xs) * 1536 + hd * 64 + ph * 32 + xp8); \
        pd0 = dtb[(size_t)(_t0 + 2 * lane) * 16 + hd]; pd1 = dtb[(size_t)(_t0 + 2 * lane + 1) * 16 + hd]; } while (0)
    SSD_PREFETCH(0);
    for (int c = 0; c < 16; ++c) {
        const int t0 = b * 2048 + c * 128;
        if (w == 0) {
            const float d0 = pd0, d1 = pd1;
            const float s = (d0 + d1) * a; float v = s;
#pragma unroll
            for (int off = 1; off < 64; off <<= 1) { const float t = __shfl_up(v, off); if (lane >= off) v += t; }
            const float excl = v - s;
            acs[2 * lane] = excl + d0 * a; acs[2 * lane + 1] = v; dts[2 * lane] = d0; dts[2 * lane + 1] = d1;
        }
#pragma unroll
        for (int pt = 0; pt < 2; ++pt) { u32x2 o; o.x = pk2(Hacc[pt][0], Hacc[pt][1]); o.y = pk2(Hacc[pt][2], Hacc[pt][3]); *(u32x2*)(Ht + (w * 16 + fr) * X_STR + pt * 16 + fq * 4) = o; }
#pragma unroll
        for (int i = 0; i < 4; ++i) { *(u32x4*)(Cs + (ls + i * 32) * CS_STR + ln8) = pc[i]; *(u32x4*)(Bs + (ls + i * 32) * CS_STR + ln8) = pb[i]; }
        LDS_BARRIER();
        {
            float x[8], xa[8], xb[8]; unpack8(px, x);
            const float dtv = dts[xs], dec = __expf(acs[127] - acs[xs]) * dtv;
#pragma unroll
            for (int e = 0; e < 8; ++e) { xa[e] = x[e] * dtv; xb[e] = x[e] * dec; }
            *(u32x4*)(Xd + xs * X_STR + xp8) = pack8(xa);
            *(u32x4*)(X2 + xs * X_STR + xp8) = pack8(xb);
        }
        if (c < 15) SSD_PREFETCH(c + 1);
        bf16x8 Cf[4];
#pragma unroll
        for (int kk = 0; kk < 4; ++kk) Cf[kk] = *(const bf16x8*)(Cs + (w * 16 + fr) * CS_STR + kk * 32 + fq * 8);
        const int lrow = w * 16 + fr; const float al = acs[lrow];
        bf16x8 Gf[4];
#pragma unroll
        for (int kk = 0; kk < 4; ++kk) {
            u32x2 half[2];
#pragma unroll
            for (int hh = 0; hh < 2; ++hh) {
                const int st = 2 * kk + hh;
                half[hh].x = 0u; half[hh].y = 0u;
                if (st <= w) {
                    f32x4 ga = (f32x4){0.f, 0.f, 0.f, 0.f};
#pragma unroll
                    for (int k2 = 0; k2 < 4; ++k2) { const bf16x8 Bf = *(const bf16x8*)(Bs + (st * 16 + fr) * CS_STR + k2 * 32 + fq * 8); ga = __builtin_amdgcn_mfma_f32_16x16x32_bf16(Bf, Cf[k2], ga, 0, 0, 0); }
                    const int s0 = st * 16 + fq * 4; const f32x4 as4 = *(const f32x4*)(acs + s0);
                    float gv[4];
#pragma unroll
                    for (int j = 0; j < 4; ++j) gv[j] = (s0 + j <= lrow) ? ga[j] * __expf(al - as4[j]) : 0.f;
                    half[hh].x = pk2(gv[0], gv[1]); half[hh].y = pk2(gv[2], gv[3]);
                }
            }
            u32x4 g4; g4.x = half[0].x; g4.y = half[0].y; g4.z = half[1].x; g4.w = half[1].y;
            Gf[kk] = __builtin_bit_cast(bf16x8, g4);
        }
        LDS_BARRIER();
        {
            f32x4 Yd[2], Yo[2];
            Yd[0] = Yd[1] = Yo[0] = Yo[1] = (f32x4){0.f, 0.f, 0.f, 0.f};
            const int nkk = (w >> 1) + 1;
#pragma unroll
            for (int kk = 0; kk < 4; ++kk) {
                if (kk < nkk) {
#pragma unroll
                    for (int pt = 0; pt < 2; ++pt) {
                        const bf16_t* base = Xd + (kk * 32 + fq * 4 + q4) * X_STR + pt * 16 + p4 * 4;
                        bf16x8 Xf; Xf.lo = tr_read(base); Xf.hi = tr_read(base + 16 * X_STR);
                        Yd[pt] = __builtin_amdgcn_mfma_f32_16x16x32_bf16(Xf, Gf[kk], Yd[pt], 0, 0, 0);
                    }
                }
            }
#pragma unroll
            for (int kk = 0; kk < 4; ++kk)
#pragma unroll
                for (int pt = 0; pt < 2; ++pt) {
                    const bf16_t* hbp = Ht + (kk * 32 + fq * 8 + q4) * X_STR + pt * 16 + p4 * 4;
                    bf16x8 Hf; Hf.lo = tr_read(hbp); Hf.hi = tr_read(hbp + 4 * X_STR);
                    Yo[pt] = __builtin_amdgcn_mfma_f32_16x16x32_bf16(Hf, Cf[kk], Yo[pt], 0, 0, 0);
                }
            const float el = __expf(al); const float rdt = Dh / dts[lrow];
#pragma unroll
            for (int pt = 0; pt < 2; ++pt) {
                const u32x2 xr = *(const u32x2*)(Xd + lrow * X_STR + pt * 16 + fq * 4);
                const f32x4 y = Yd[pt] + el * Yo[pt] + rdt * (f32x4){bflo(xr.x), bfhi(xr.x), bflo(xr.y), bfhi(xr.y)};
                u32x2 o; o.x = pk2(y[0], y[1]); o.y = pk2(y[2], y[3]);
                *(u32x2*)(ybuf + (size_t)(t0 + lrow) * 1024 + hd * 64 + ph * 32 + pt * 16 + fq * 4) = o;
            }
        }
        {
            const float dc = __expf(acs[127]);
            Hacc[0] *= dc; Hacc[1] *= dc;
#pragma unroll
            for (int kk = 0; kk < 4; ++kk) {
                const bf16_t* bb = Bs + (kk * 32 + fq * 8 + q4) * CS_STR + w * 16 + p4 * 4;
                bf16x8 Bf; Bf.lo = tr_read(bb); Bf.hi = tr_read(bb + 4 * CS_STR);
#pragma unroll
                for (int pt = 0; pt < 2; ++pt) {
                    const bf16_t* xb = X2 + (kk * 32 + fq * 8 + q4) * X_STR + pt * 16 + p4 * 4;
                    bf16x8 Xf; Xf.lo = tr_read(xb); Xf.hi = tr_read(xb + 4 * X_STR);
                    Hacc[pt] = __builtin_amdgcn_mfma_f32_16x16x32_bf16(Xf, Bf, Hacc[pt], 0, 0, 0);
                }
            }
        }
        LDS_BARRIER();
    }
#undef SSD_PREFETCH
    float* so = P->out + O_SSMP + ((size_t)(b * 16 + hd) * 64 + ph * 32) * 128;
#pragma unroll
    for (int pt = 0; pt < 2; ++pt)
#pragma unroll
        for (int j = 0; j < 4; ++j) so[(size_t)(pt * 16 + fq * 4 + j) * 128 + w * 16 + fr] = Hacc[pt][j];
}

template <int NI>
__device__ __forceinline__ void ssd_sample(PP P, int item0, int istride, const int tid) {
    const int p = tid >> 3, n0 = (tid & 7) * 16;
    char* ws = P->ws;
    const bf16_t* xact = (const bf16_t*)(ws + W_XACT);
    const float* dtb = (const float*)(ws + W_DT);
    bf16_t* ybuf = (bf16_t*)(ws + W_Y);
    f32x4 hs[NI][4]; u32x4 rb[NI][4][2], rc[NI][4][2]; float xv[NI][4], dtv[NI][4];
#pragma unroll
    for (int q = 0; q < NI; ++q) {
        const int item = item0 + q * istride, b = item >> 4, hd = item & 15, g = hd >> 3;
        const size_t sidx = ((size_t)(b * 16 + hd) * 64 + p) * 128 + n0;
#pragma unroll
        for (int i = 0; i < 4; ++i) hs[q][i] = __builtin_nontemporal_load((const f32x4*)(P->state_ssm + sidx + i * 4));
#pragma unroll
        for (int i = 0; i < 4; ++i) {
            const int t = TP + b * 4 + i;
            xv[q][i] = bf2f(xact[(size_t)t * 1536 + hd * 64 + p]);
            dtv[q][i] = dtb[(size_t)t * 16 + hd];
            rb[q][i][0] = ld8(xact + (size_t)t * 1536 + 1024 + g * 128 + n0); rb[q][i][1] = ld8(xact + (size_t)t * 1536 + 1024 + g * 128 + n0 + 8);
            rc[q][i][0] = ld8(xact + (size_t)t * 1536 + 1280 + g * 128 + n0); rc[q][i][1] = ld8(xact + (size_t)t * 1536 + 1280 + g * 128 + n0 + 8);
        }
    }
#pragma unroll
    for (int q = 0; q < NI; ++q) {
        const int item = item0 + q * istride, b = item >> 4, hd = item & 15;
        const float a = -expf(P->a_log[hd]);
        const float Dh = P->ssm_d[hd];
        const size_t sidx = ((size_t)(b * 16 + hd) * 64 + p) * 128 + n0;
        float h[16];
#pragma unroll
        for (int i = 0; i < 4; ++i) { h[i * 4] = hs[q][i][0]; h[i * 4 + 1] = hs[q][i][1]; h[i * 4 + 2] = hs[q][i][2]; h[i * 4 + 3] = hs[q][i][3]; }
#pragma unroll
        for (int i = 0; i < 4; ++i) {
            const int t = TP + b * 4 + i;
            const float dA = __expf(dtv[q][i] * a), dx = dtv[q][i] * xv[q][i];
            float Bv[16], Cv[16];
            { float t8[8]; unpack8(rb[q][i][0], t8);
#pragma unroll
              for (int e = 0; e < 8; ++e) Bv[e] = t8[e];
              unpack8(rb[q][i][1], t8);
#pragma unroll
              for (int e = 0; e < 8; ++e) Bv[8 + e] = t8[e];
              unpack8(rc[q][i][0], t8);
#pragma unroll
              for (int e = 0; e < 8; ++e) Cv[e] = t8[e];
              unpack8(rc[q][i][1], t8);
#pragma unroll
              for (int e = 0; e < 8; ++e) Cv[8 + e] = t8[e]; }
            float part = 0.f;
#pragma unroll
            for (int e = 0; e < 16; ++e) { h[e] = h[e] * dA + dx * Bv[e]; part += h[e] * Cv[e]; }
            part += __shfl_xor(part, 1); part += __shfl_xor(part, 2); part += __shfl_xor(part, 4);
            if ((tid & 7) == 0) ybuf[(size_t)t * 1024 + hd * 64 + p] = f2bf(part + Dh * xv[q][i]);
        }
        float* so = P->out + O_SSMS + sidx;
#pragma unroll
        for (int i = 0; i < 4; ++i) __builtin_nontemporal_store((f32x4){h[i * 4], h[i * 4 + 1], h[i * 4 + 2], h[i * 4 + 3]}, (f32x4*)(so + i * 4));
    }
}

__device__ __forceinline__ void phase_gatednorm(PP P, int gw, int nw, const int tid) {
    const int lane = tid & 63;
    char* ws = P->ws;
    const bf16_t* ybuf = (const bf16_t*)(ws + W_Y); const bf16_t* zbuf = (const bf16_t*)(ws + W_Z);
    bf16_t* mix = (bf16_t*)(ws + W_MIX);
    for (int row0 = gw; row0 < TT; row0 += 4 * nw) {
        u32x2 yv[4][4], zv[4][4];
#pragma unroll
        for (int r = 0; r < 4; ++r) { const int row = row0 + r * nw; if (row < TT) {
#pragma unroll
            for (int j = 0; j < 4; ++j) { yv[r][j] = *(const u32x2*)(ybuf + (size_t)row * 1024 + j * 256 + lane * 4); zv[r][j] = *(const u32x2*)(zbuf + (size_t)row * 1024 + j * 256 + lane * 4); } } }
#pragma unroll
        for (int r = 0; r < 4; ++r) { const int row = row0 + r * nw; if (row < TT) {
            float t[4][4]; float ss0 = 0.f, ss1 = 0.f;
#pragma unroll
            for (int j = 0; j < 4; ++j) {
                const float y0 = bflo(yv[r][j].x), y1 = bfhi(yv[r][j].x), y2 = bflo(yv[r][j].y), y3 = bfhi(yv[r][j].y);
                const float z0 = bflo(zv[r][j].x), z1 = bfhi(zv[r][j].x), z2 = bflo(zv[r][j].y), z3 = bfhi(zv[r][j].y);
                t[j][0] = y0 * silu_f(z0); t[j][1] = y1 * silu_f(z1); t[j][2] = y2 * silu_f(z2); t[j][3] = y3 * silu_f(z3);
                const float q = t[j][0] * t[j][0] + t[j][1] * t[j][1] + t[j][2] * t[j][2] + t[j][3] * t[j][3];
                if (j < 2) ss0 += q; else ss1 += q;
            }
            ss0 = wave_sum(ss0); ss1 = wave_sum(ss1);
            const float r0 = rsqrtf(ss0 * (1.0f / 512.0f) + EPS), r1 = rsqrtf(ss1 * (1.0f / 512.0f) + EPS);
#pragma unroll
            for (int j = 0; j < 4; ++j) {
                const float rr = j < 2 ? r0 : r1;
                const f32x4 g4 = *(const f32x4*)(P->ssm_norm + j * 256 + lane * 4);
                u32x2 o; o.x = pk2(t[j][0] * rr * g4[0], t[j][1] * rr * g4[1]); o.y = pk2(t[j][2] * rr * g4[2], t[j][3] * rr * g4[3]);
                *(u32x2*)(mix + (size_t)row * 2048 + j * 256 + lane * 4) = o;
            }
        } }
    }
}

__device__ __forceinline__ void phase_norm(PP P, const float* gain, bool final_out, int gw, int nw, const int tid) {
    const int lane = tid & 63;
    char* ws = P->ws;
    const bf16_t* hb = (const bf16_t*)(ws + W_H);
    const float* ss3 = (const float*)(ws + W_SS3);
    for (int row0 = gw; row0 < TT; row0 += 4 * nw) {
        u32x2 xv[4][4]; float sq[4];
#pragma unroll
        for (int r = 0; r < 4; ++r) { const int row = row0 + r * nw; if (row < TT) { sq[r] = ss3[row];
#pragma unroll
            for (int j = 0; j < 4; ++j) xv[r][j] = *(const u32x2*)(hb + (size_t)row * 1024 + j * 256 + lane * 4); } }
#pragma unroll
        for (int r = 0; r < 4; ++r) { const int row = row0 + r * nw; if (row < TT) {
            const float rstd = rsqrtf(sq[r] * (1.0f / 1024.0f) + EPS);
#pragma unroll
            for (int j = 0; j < 4; ++j) {
                const f32x4 g4 = *(const f32x4*)(gain + j * 256 + lane * 4);
                const f32x4 x = (f32x4){bflo(xv[r][j].x), bfhi(xv[r][j].x), bflo(xv[r][j].y), bfhi(xv[r][j].y)};
                __builtin_nontemporal_store(x * rstd * g4, (f32x4*)(P->out + O_YP + (size_t)row * 1024 + j * 256 + lane * 4));
            }
        } }
    }
}

__device__ __forceinline__ void attn_sample(PP P, int item, char* shm, const int tid) {
    const int w = tid >> 6, lane = tid & 63, fr = lane & 15, fq = lane >> 4;
    const int b = item >> 2, hh = item & 3;
    char* ws = P->ws;
    const bf16_t* qb = (const bf16_t*)(ws + W_Q);
    float* sc = (float*)shm;
    float* part = (float*)(shm + 4096);
    const float* vp = P->cache_v + ((size_t)(b * 256 + w * 32) * 4 + hh) * 256 + lane * 4;
    f32x4 v0[16], v1[16];
#pragma unroll
    for (int mm = 0; mm < 16; ++mm) v0[mm] = __builtin_nontemporal_load((const f32x4*)(vp + (size_t)mm * 1024));
    bf16x8 qf[8];
#pragma unroll
    for (int kk = 0; kk < 8; ++kk) {
        bf16x8 z = {0, 0, 0, 0, 0, 0, 0, 0};
        if (fr < 4) z = *(const bf16x8*)(qb + (size_t)(TP + b * 4 + fr) * 1024 + hh * 256 + kk * 32 + fq * 8);
        qf[kk] = z;
    }
#pragma unroll
    for (int mt = 0; mt < 2; ++mt) {
        const int key = w * 32 + mt * 16 + fr;
        const float* kp = P->cache_k + ((size_t)(b * 256 + key) * 4 + hh) * 256 + fq * 8;
        f32x4 k0[8], k1[8];
#pragma unroll
        for (int kk = 0; kk < 8; ++kk) { k0[kk] = __builtin_nontemporal_load((const f32x4*)(kp + kk * 32)); k1[kk] = __builtin_nontemporal_load((const f32x4*)(kp + kk * 32 + 4)); }
        f32x4 acc = (f32x4){0.f, 0.f, 0.f, 0.f};
#pragma unroll
        for (int kk = 0; kk < 8; ++kk) {
            u32x4 pk; pk.x = pk2(k0[kk][0], k0[kk][1]); pk.y = pk2(k0[kk][2], k0[kk][3]); pk.z = pk2(k1[kk][0], k1[kk][1]); pk.w = pk2(k1[kk][2], k1[kk][3]);
            acc = __builtin_amdgcn_mfma_f32_16x16x32_bf16(qf[kk], __builtin_bit_cast(bf16x8, pk), acc, 0, 0, 0);
        }
        if (fq == 0) {
#pragma unroll
            for (int j = 0; j < 4; ++j) sc[j * 256 + w * 32 + mt * 16 + fr] = acc[j];
        }
    }
    LDS_BARRIER();
#pragma unroll
    for (int mm = 0; mm < 16; ++mm) v1[mm] = __builtin_nontemporal_load((const f32x4*)(vp + (size_t)(16 + mm) * 1024));
    if (w < 4) {
        f32x4 s = *(const f32x4*)(sc + w * 256 + lane * 4);
        float m = fmaxf(fmaxf(s[0], s[1]), fmaxf(s[2], s[3])); m = wave_max(m);
        s[0] = __expf(s[0] - m); s[1] = __expf(s[1] - m); s[2] = __expf(s[2] - m); s[3] = __expf(s[3] - m);
        float su = (s[0] + s[1]) + (s[2] + s[3]); su = wave_sum(su);
        const float inv = 1.0f / su;
        *(f32x4*)(sc + w * 256 + lane * 4) = s * inv;
    }
    LDS_BARRIER();
    {
        f32x4 o[4];
#pragma unroll
        for (int i = 0; i < 4; ++i) o[i] = (f32x4){0.f, 0.f, 0.f, 0.f};
#pragma unroll
        for (int mm = 0; mm < 16; ++mm) {
#pragma unroll
            for (int i = 0; i < 4; ++i) o[i] += sc[i * 256 + w * 32 + mm] * v0[mm];
        }
#pragma unroll
        for (int mm = 0; mm < 16; ++mm) {
#pragma unroll
            for (int i = 0; i < 4; ++i) o[i] += sc[i * 256 + w * 32 + 16 + mm] * v1[mm];
        }
#pragma unroll
        for (int i = 0; i < 4; ++i) *(f32x4*)(part + (w * 4 + i) * 256 + lane * 4) = o[i];
    }
    LDS_BARRIER();
    {
        const int i = tid >> 7, d2 = (tid & 127) * 2;
        float s0 = 0.f, s1 = 0.f;
#pragma unroll
        for (int ww = 0; ww < 8; ++ww) { s0 += part[(ww * 4 + i) * 256 + d2]; s1 += part[(ww * 4 + i) * 256 + d2 + 1]; }
        *(unsigned*)((bf16_t*)(ws + W_O) + (size_t)(TP + b * 4 + i) * 1024 + hh * 256 + d2) = pk2(s0, s1);
    }
    LDS_BARRIER();
}

__device__ __forceinline__ void phase_ffnconv(PP P, int gtid, int nthreads) {
    char* ws = P->ws;
    const bf16_t* u = (const bf16_t*)(ws + W_U);
    bf16_t* act = (bf16_t*)(ws + W_ACT);
    for (int idx = gtid; idx < 1152 * 352; idx += nthreads) {
        const int run = idx / 352, cg = idx % 352;
        const bool samp = run >= 1024;
        int t0, len, bidx, tl0;
        if (!samp) { t0 = run * 16; len = 16; bidx = t0 >> 11; tl0 = t0 & 2047; } else { bidx = run - 1024; t0 = TP + bidx * 4; len = 4; tl0 = 0; }
        const int cgc = cg * 8, cvc = 2816 + cg * 8;
        float wg0[8], wg1[8], wg2[8], wv0[8], wv1[8], wv2[8], bg[8], bv[8], hg0[8], hg1[8], hv0[8], hv1[8];
#pragma unroll
        for (int e = 0; e < 8; ++e) {
            wg0[e] = P->ffn_w[cgc + e]; wg1[e] = P->ffn_w[5632 + cgc + e]; wg2[e] = P->ffn_w[11264 + cgc + e];
            wv0[e] = P->ffn_w[cvc + e]; wv1[e] = P->ffn_w[5632 + cvc + e]; wv2[e] = P->ffn_w[11264 + cvc + e];
            bg[e] = P->ffn_b[cgc + e]; bv[e] = P->ffn_b[cvc + e];
        }
        if (samp) {
#pragma unroll
            for (int e = 0; e < 8; ++e) {
                hg0[e] = P->state_ffn[(size_t)(bidx * 2 + 0) * 5632 + cgc + e]; hg1[e] = P->state_ffn[(size_t)(bidx * 2 + 1) * 5632 + cgc + e];
                hv0[e] = P->state_ffn[(size_t)(bidx * 2 + 0) * 5632 + cvc + e]; hv1[e] = P->state_ffn[(size_t)(bidx * 2 + 1) * 5632 + cvc + e];
            }
        } else if (tl0 > 0) {
            unpack8(ld8(u + (size_t)(t0 - 2) * 5632 + cgc), hg0); unpack8(ld8(u + (size_t)(t0 - 1) * 5632 + cgc), hg1);
            unpack8(ld8(u + (size_t)(t0 - 2) * 5632 + cvc), hv0); unpack8(ld8(u + (size_t)(t0 - 1) * 5632 + cvc), hv1);
        } else {
#pragma unroll
            for (int e = 0; e < 8; ++e) { hg0[e] = 0.f; hg1[e] = 0.f; hv0[e] = 0.f; hv1[e] = 0.f; }
        }
        for (int jb = 0; jb < len; jb += 8) {
        u32x4 rg[8], rv[8];
        const bf16_t* ub = u + (size_t)(t0 + jb) * 5632 + cgc;
#pragma unroll
        for (int jj = 0; jj < 8; ++jj) { if (jb + jj < len) { rg[jj] = ld8(ub + (size_t)jj * 5632); rv[jj] = ld8(ub + (size_t)jj * 5632 + 2816); } }
#pragma unroll
        for (int jj = 0; jj < 8; ++jj) {
            const int j = jb + jj;
            if (j < len) {
            float ug[8], uv[8], o8[8];
            unpack8(rg[jj], ug); unpack8(rv[jj], uv);
#pragma unroll
            for (int e = 0; e < 8; ++e) {
                const float gc = bg[e] + wg0[e] * hg0[e] + wg1[e] * hg1[e] + wg2[e] * ug[e];
                const float vc = bv[e] + wv0[e] * hv0[e] + wv1[e] * hv1[e] + wv2[e] * uv[e];
                o8[e] = silu_f(gc) * vc;
            }
            *(u32x4*)(act + (size_t)(t0 + j) * 2816 + cgc) = pack8(o8);
            float* o = nullptr;
            if (samp) { if (j >= 2) o = P->out + O_FFNS + (size_t)(bidx * 2 + j - 2) * 5632; }
            else { const int tl = tl0 + j; if (tl >= 2046) o = P->out + O_FFNP + (size_t)(bidx * 2 + tl - 2046) * 5632; }
            if (o) {
#pragma unroll
                for (int e = 0; e < 8; ++e) { o[cgc + e] = ug[e]; o[cvc + e] = uv[e]; }
            }
#pragma unroll
            for (int e = 0; e < 8; ++e) { hg0[e] = hg1[e]; hg1[e] = ug[e]; hv0[e] = hv1[e]; hv1[e] = uv[e]; }
            }
        }
        }
    }
}

#define XB_TMO      128
#define XB_XCNT(j)  (256  + 64 * (j))
#define XB_XSUB(j)  (1280 + 64 * (j))
#define XB_XGEN(j)  (2304 + 64 * (j))
#define XB_TOP      3328
#define XB_TOPGEN   3392
#define XCD_BAR_WORDS 3456
#define XB_SPIN_CAP (1u << 18)
__device__ __forceinline__ unsigned xb_ld(unsigned* p)              { return __hip_atomic_load(p, __ATOMIC_RELAXED, __HIP_MEMORY_SCOPE_AGENT); }
__device__ __forceinline__ unsigned xb_add(unsigned* p, unsigned v) { return __hip_atomic_fetch_add(p, v, __ATOMIC_RELAXED, __HIP_MEMORY_SCOPE_AGENT); }
__device__ __forceinline__ unsigned xb_xcc_id() { return (unsigned)__builtin_amdgcn_s_getreg((3 << 11) | 20) & 0xFu; }
#define XB_SPIN(cond, bar) do { unsigned _sp = 0; while (cond) { __builtin_amdgcn_s_sleep(1); \
    if ((++_sp & 255u) == 0u) { if (xb_ld(&(bar)[XB_TMO])) break; if (_sp > XB_SPIN_CAP) { atomicAdd(&(bar)[XB_TMO], 1u); break; } } } } while (0)
__device__ __forceinline__ void xcd_barrier_complete(unsigned* bar, unsigned x, unsigned& nloc, unsigned& nx) {
    const unsigned G = gridDim.x;
    unsigned sum, cnt, mine, sp = 0u;
    for (;;) {
        sum = 0u; cnt = 0u; mine = 0u;
#pragma unroll
        for (unsigned j = 0; j < 16; ++j) { const unsigned c = xb_ld(&bar[XB_XCNT(j)]); sum += c; cnt += (c > 0u) ? 1u : 0u; mine = (j == x) ? c : mine; }
        if (sum == G) break;
        __builtin_amdgcn_s_sleep(1);
        if ((++sp & 255u) == 0u) { if (xb_ld(&bar[XB_TMO])) break; if (sp > XB_SPIN_CAP) { atomicAdd(&bar[XB_TMO], 1u); break; } }
    }
    nloc = mine > 0u ? mine : 1u; nx = cnt > 0u ? cnt : 1u;
}
__device__ __forceinline__ void xcd_barrier(unsigned* bar, volatile LDSB unsigned* st, const int tid) {
    asm volatile("s_waitcnt vmcnt(0)" ::: "memory");
    __syncthreads();
    if (tid == 0) {
        const unsigned x = xb_xcc_id();
        __builtin_amdgcn_s_waitcnt(0);
        unsigned nloc = st[0], nx = st[1];
        if (nloc == 0u) { xcd_barrier_complete(bar, x, nloc, nx); st[0] = nloc; st[1] = nx; }
        const unsigned old = xb_add(&bar[XB_XSUB(x)], 1u);
        const unsigned gen = old / nloc;
        if (old + 1u == (gen + 1u) * nloc) {
            __builtin_amdgcn_fence(__ATOMIC_RELEASE, "agent");
            asm volatile("s_waitcnt vmcnt(0)" ::: "memory");
            const unsigned og = xb_add(&bar[XB_TOP], 1u);
            const unsigned tg = og / nx;
            if (og + 1u == (tg + 1u) * nx) xb_add(&bar[XB_TOPGEN], 1u);
            else XB_SPIN(xb_ld(&bar[XB_TOPGEN]) == tg, bar);
            __builtin_amdgcn_fence(__ATOMIC_ACQUIRE, "agent");
            xb_add(&bar[XB_XGEN(x)], 1u);
            asm volatile("s_waitcnt vmcnt(0)" ::: "memory");
        } else {
            XB_SPIN(xb_ld(&bar[XB_XGEN(x)]) == gen, bar);
            __builtin_amdgcn_fence(__ATOMIC_ACQUIRE, "agent");
            asm volatile("s_waitcnt vmcnt(0)" ::: "memory");
        }
    }
    __syncthreads();
}

extern __shared__ __attribute__((aligned(16))) char smem[];

__global__ void __launch_bounds__(NTHR) hybrid_fwd(Params Pin) {
    char* shm = smem;
    volatile LDSB unsigned* bst = (volatile LDSB unsigned*)(smem + 139264);
    if (threadIdx.x == 0) { bst[0] = 0u; bst[1] = 0u; (void)xb_add((unsigned*)(Pin.ws + W_BAR) + XB_XCNT(xb_xcc_id()), 1u); }
    __syncthreads();
    for (int ph = Pin.ph_lo; ph < Pin.ph_hi; ++ph) {
        if (ph == 6 || ph == 11) continue;
        const int reps = ((REPEAT_MASK >> ph) & 1) ? 2 : 1;
        for (int rep = 0; rep < reps; ++rep) {
        if (rep > 0) xcd_barrier((unsigned*)(Pin.ws + W_BAR), bst, threadIdx.x);
        int tid = threadIdx.x, blk = blockIdx.x, nblk = gridDim.x;
        asm volatile("" : "+v"(tid));
        asm volatile("" : "+s"(blk), "+s"(nblk));
        PP P = (PP)__builtin_amdgcn_kernarg_segment_ptr();
        asm volatile("" : "+s"(P));
        const int lb = (blk & 7) * (nblk >> 3) + (blk >> 3);
        const int gtid = blk * NTHR + tid, nthreads = nblk * NTHR;
        const int gw = blk * 8 + (tid >> 6), nw = nblk * 8;
        switch (ph) {
#if PHASE_MASK & 1
        case 0: phase_prep(P, shm, blk, nblk, tid); break;
#endif
#if PHASE_MASK & 4
        case 2: phase_convpool(P, gtid, nthreads); break;
#endif
#if PHASE_MASK & 8
        case 3:
            if (blk & 1) { int it = blk; for (; it + nblk < 2048; it += 2 * nblk) ssd_sample<2>(P, it, nblk, tid); for (; it < 2048; it += nblk) ssd_sample<1>(P, it, nblk, tid); }
            for (int it = blk; it < 256; it += nblk) ssd_prompt(P, it, shm, tid);
            if (!(blk & 1)) { int it = blk; for (; it + nblk < 2048; it += 2 * nblk) ssd_sample<2>(P, it, nblk, tid); for (; it < 2048; it += nblk) ssd_sample<1>(P, it, nblk, tid); }
            break;
#endif
#if PHASE_MASK & 16
        case 4: phase_gatednorm(P, gw, nw, tid); break;
#endif
#if PHASE_MASK & 64
        case 6: phase_norm(P, P->norm_mem, false, gw, nw, tid); break;
        case 11: phase_norm(P, P->norm_ffn, false, gw, nw, tid); break;
        case 15: phase_norm(P, P->final_norm, true, gw, nw, tid); break;
#endif
#if PHASE_MASK & 8192
        case 13: phase_ffnconv(P, gtid, nthreads); break;
#endif
        default: break;
        }
#if PHASE_MASK & 256
        if (ph == 8 && (blk & 1)) { for (int it = blk; it < 512; it += nblk) attn_sample(P, it, shm, tid); __syncthreads(); }
#endif
#if PHASE_MASK & 2
        if (ph == 1 || ph == 5 || ph == 7 || ph == 8 || ph == 9 || ph == 10 || ph == 12 || ph == 14) gemm_phase(P, ph, shm, lb, blk, nblk, tid);
#endif
#if PHASE_MASK & 256
        if (ph == 9 && !(blk & 1)) { for (int it = blk; it < 512; it += nblk) attn_sample(P, it, shm, tid); }
#endif
        }
        if (ph + 1 < Pin.ph_hi && ph != 8) xcd_barrier((unsigned*)(Pin.ws + W_BAR), bst, threadIdx.x);
        if (ph == 8) { asm volatile("s_waitcnt vmcnt(0)" ::: "memory"); __syncthreads(); }
        if (EXTRA_SYNCS && ph == 0) { for (int i = 0; i < EXTRA_SYNCS; ++i) xcd_barrier((unsigned*)(Pin.ws + W_BAR), bst, threadIdx.x); }
    }
}

extern "C" void kernel_launch(void* const* d_in, const int* in_sizes, int n_in, void* d_out, int out_size, void* d_ws, size_t ws_size, hipStream_t stream) {
    static int grid_blocks = 0;
    if (!grid_blocks) {
        int dev = 0, cus = 0, per_cu = 0;
        hipGetDevice(&dev);
        hipDeviceGetAttribute(&cus, hipDeviceAttributeMultiprocessorCount, dev);
        hipFuncSetAttribute((const void*)hybrid_fwd, hipFuncAttributeMaxDynamicSharedMemorySize, LDS_BYTES);
        hipOccupancyMaxActiveBlocksPerMultiprocessor(&per_cu, hybrid_fwd, NTHR, LDS_BYTES);
        if (per_cu < 1) per_cu = 1;
        grid_blocks = cus * 1;
        grid_blocks &= ~7;
        if (grid_blocks < 8) grid_blocks = 8;
    }
    Params p{};
    const float* const* in = (const float* const*)d_in;
    p.x_prompt = in[0]; p.x_sample = in[1]; p.mem_prompt = in[2]; p.state_ssm = in[3]; p.state_conv = in[4]; p.state_pool = in[5]; p.state_ffn = in[6];
    p.cache_k = in[7]; p.cache_v = in[8]; p.norm_mix = in[9]; p.w_in = in[10]; p.conv_w = in[11]; p.conv_b = in[12]; p.dt_bias = in[13]; p.a_log = in[14];
    p.ssm_d = in[15]; p.ssm_norm = in[16]; p.w_pool = in[17]; p.pool_scale = in[18]; p.w_out = in[19]; p.norm_mem = in[20]; p.norm_memkv = in[21];
    p.w_mq = in[22]; p.w_mk = in[23]; p.w_mv = in[24]; p.w_mo = in[25]; p.norm_ffn = in[26]; p.w_up = in[27]; p.ffn_w = in[28]; p.ffn_b = in[29];
    p.w_down = in[30]; p.final_norm = in[31];
    p.out = (float*)d_out; p.ws = (char*)d_ws; p.ph_lo = 0; p.ph_hi = 16;
    hipMemsetAsync((char*)d_ws + W_BAR, 0, 16384, stream);
    void* args[] = {&p};
    hipError_t e = hipLaunchCooperativeKernel((const void*)hybrid_fwd, dim3(grid_blocks), dim3(NTHR), args, LDS_BYTES, stream);
    if (e != hipSuccess) fprintf(stderr, "cooperative launch failed: %s (grid %d)\n", hipGetErrorString(e), grid_blocks);
}
```

```cpp
#include <hip/hip_runtime.h>
#include <hip/hip_cooperative_groups.h>
#include <cstdio>
namespace cg = cooperative_groups;

typedef unsigned short bf16_t;
typedef short bf16x8 __attribute__((ext_vector_type(8)));
typedef short s16x4 __attribute__((ext_vector_type(4)));
typedef float f32x4 __attribute__((ext_vector_type(4)));
typedef unsigned u32x4 __attribute__((ext_vector_type(4)));
typedef unsigned u32x2 __attribute__((ext_vector_type(2)));
#define LDSB __attribute__((address_space(3)))

constexpr int TP = 16384, TS = 512, TT = TP + TS;
constexpr int NTHR = 512;
constexpr int LDS_BYTES = 139264 + 256;
constexpr float EPS = 1e-6f;
#ifndef PHASE_MASK
#define PHASE_MASK 0xFFFF
#endif
#ifndef REPEAT_MASK
#define REPEAT_MASK 0
#endif
#ifndef PROBE3
#define PROBE3 0
#endif
#ifndef EXTRA_SYNCS
#define EXTRA_SYNCS 0
#endif

constexpr size_t O_YP = 0;
constexpr size_t O_YS = O_YP + (size_t)TP * 1024;
constexpr size_t O_SSMP = O_YS + (size_t)TS * 1024;
constexpr size_t O_SSMS = O_SSMP + (size_t)8 * 16 * 64 * 128;
constexpr size_t O_CONVP = O_SSMS + (size_t)128 * 16 * 64 * 128;
constexpr size_t O_CONVS = O_CONVP + (size_t)8 * 3 * 1536;
constexpr size_t O_POOLP = O_CONVS + (size_t)128 * 3 * 1536;
constexpr size_t O_POOLS = O_POOLP + (size_t)8 * 15 * 1024;
constexpr size_t O_FFNP = O_POOLS + (size_t)128 * 15 * 1024;
constexpr size_t O_FFNS = O_FFNP + (size_t)8 * 2 * 5632;
constexpr size_t O_MK = O_FFNS + (size_t)128 * 2 * 5632;
constexpr size_t O_MV = O_MK + (size_t)8 * 256 * 1024;

constexpr size_t W_WIN = 0;
constexpr size_t W_WPOOL = W_WIN + (size_t)3584 * 1024 * 2;
constexpr size_t W_WOUT = W_WPOOL + (size_t)4 * 256 * 256 * 2;
constexpr size_t W_WMQ = W_WOUT + (size_t)1024 * 2048 * 2;
constexpr size_t W_WMK = W_WMQ + (size_t)1024 * 1024 * 2;
constexpr size_t W_WMV = W_WMK + (size_t)1024 * 1024 * 2;
constexpr size_t W_WMO = W_WMV + (size_t)1024 * 1024 * 2;
constexpr size_t W_WUP = W_WMO + (size_t)1024 * 1024 * 2;
constexpr size_t W_WDOWN = W_WUP + (size_t)5632 * 1024 * 2;
constexpr size_t W_H = W_WDOWN + (size_t)1024 * 2816 * 2;
constexpr size_t W_HM = W_H + (size_t)TT * 1024 * 2;
constexpr size_t W_KB = W_HM + (size_t)2048 * 1024 * 2;
constexpr size_t W_VT = W_KB + (size_t)2048 * 1024 * 2;
constexpr size_t W_DT = W_VT + (size_t)2048 * 1024 * 2;
constexpr size_t W_XRES = W_DT + (size_t)TT * 16 * 4;
constexpr size_t W_ARENA = W_XRES + (size_t)TT * 1024 * 4;
constexpr size_t W_Z = W_ARENA;
constexpr size_t W_PROJ2 = W_Z + (size_t)TT * 1024 * 2;
constexpr size_t W_XACT = W_PROJ2 + (size_t)TT * 2560 * 2;
constexpr size_t W_POOLED = W_XACT + (size_t)TT * 1536 * 2;
constexpr size_t W_Y = W_POOLED + (size_t)TT * 1024 * 2;
constexpr size_t W_MIX = W_Y + (size_t)TT * 1024 * 2;
constexpr size_t W_END_A = W_MIX + (size_t)TT * 2048 * 2;
constexpr size_t W_Q = W_PROJ2;
constexpr size_t W_P = W_Q + (size_t)TT * 1024 * 2;
constexpr size_t W_O = W_P + (size_t)TP * 1024 * 2;
constexpr size_t W_U = W_ARENA;
constexpr size_t W_ACT = W_U + (size_t)TT * 5632 * 2;
constexpr size_t W_END_C = W_ACT + (size_t)TT * 2816 * 2;
constexpr size_t W_BAR = W_END_A;
constexpr size_t W_SS1 = W_BAR + 16384;
constexpr size_t W_SS2 = W_SS1 + (size_t)TT * 4;
constexpr size_t W_SS3 = W_SS2 + (size_t)TT * 4;
constexpr size_t W_WLO = W_SS3 + (size_t)TT * 4;
constexpr size_t W_TOTAL = W_WLO + (size_t)1024 * 1024 * 2;
static_assert(W_O + (size_t)TT * 1024 * 2 <= W_POOLED, "era B overflow");
static_assert(W_END_C <= W_END_A, "era C overflow");

struct Params {
    const float *x_prompt, *x_sample, *mem_prompt, *state_ssm, *state_conv, *state_pool, *state_ffn, *cache_k, *cache_v;
    const float *norm_mix, *w_in, *conv_w, *conv_b, *dt_bias, *a_log, *ssm_d, *ssm_norm, *w_pool, *pool_scale, *w_out;
    const float *norm_mem, *norm_memkv, *w_mq, *w_mk, *w_mv, *w_mo, *norm_ffn, *w_up, *ffn_w, *ffn_b, *w_down, *final_norm;
    float* out;
    char* ws;
    int ph_lo, ph_hi;
};

typedef const __attribute__((address_space(4))) Params* PP;

__device__ __forceinline__ unsigned pk2(float lo, float hi) { unsigned r; asm("v_cvt_pk_bf16_f32 %0, %1, %2" : "=v"(r) : "v"(lo), "v"(hi)); return r; }
__device__ __forceinline__ bf16_t f2bf(float f) { return (bf16_t)(pk2(f, 0.f) & 0xffffu); }
__device__ __forceinline__ float bf2f(bf16_t b) { return __uint_as_float(((unsigned)b) << 16); }
__device__ __forceinline__ float bflo(unsigned u) { return __uint_as_float(u << 16); }
__device__ __forceinline__ float bfhi(unsigned u) { return __uint_as_float(u & 0xffff0000u); }
__device__ __forceinline__ void unpack8(u32x4 v, float (&f)[8]) {
    f[0] = bflo(v.x); f[1] = bfhi(v.x); f[2] = bflo(v.y); f[3] = bfhi(v.y); f[4] = bflo(v.z); f[5] = bfhi(v.z); f[6] = bflo(v.w); f[7] = bfhi(v.w);
}
__device__ __forceinline__ u32x4 pack8(const float (&f)[8]) { u32x4 r; r.x = pk2(f[0], f[1]); r.y = pk2(f[2], f[3]); r.z = pk2(f[4], f[5]); r.w = pk2(f[6], f[7]); return r; }
__device__ __forceinline__ float wave_sum(float v) {
#pragma unroll
    for (int o = 1; o < 64; o <<= 1) v += __shfl_xor(v, o);
    return v;
}
__device__ __forceinline__ float wave_max(float v) {
#pragma unroll
    for (int o = 1; o < 64; o <<= 1) v = fmaxf(v, __shfl_xor(v, o));
    return v;
}
__device__ __forceinline__ float silu_f(float x) { return x / (1.0f + __expf(-x)); }

constexpr int HTB = 128 * 64 * 2;
__device__ __forceinline__ int lds_byte(int r, int c) { const int st = (r >> 4) * 2 + (c >> 5), rr = r & 15, cc = c & 31, ob = rr * 64 + cc * 2; return st * 1024 + (ob ^ (((ob >> 9) & 1) << 5)); }
__device__ __forceinline__ void stage_rc(int b, int& R, int& C) { const int st = b / 1024, sb = b % 1024, swz = sb ^ (((sb >> 9) & 1) << 5); R = (st >> 1) * 16 + swz / 64; C = (st & 1) * 32 + (swz % 64) / 2; }

__device__ __forceinline__ int perm32(int rho) { const int n = rho >> 4, i = rho & 15; return 8 * (i >> 2) + 4 * n + (i & 3); }
__device__ __forceinline__ int invperm32(int c) { return 16 * ((c >> 2) & 1) + 4 * (c >> 3) + (c & 3); }
enum { E_PROJ = 0, E_MEMKV, E_POOL, E_OUT, E_Q, E_QK, E_PV, E_MO, E_UP, E_DOWN, E_FOLD };

template <int EK>
__device__ __forceinline__ float epi_apply(PP P, int row, int col, f32x4 v) {
    char* ws = P->ws;
    if constexpr (EK == E_PROJ) {
        u32x2 o; o.x = pk2(v[0], v[1]); o.y = pk2(v[2], v[3]);
        if (col < 1024) *(u32x2*)((bf16_t*)(ws + W_Z) + (size_t)row * 1024 + col) = o;
        else *(u32x2*)((bf16_t*)(ws + W_PROJ2) + (size_t)row * 2560 + (col - 1024)) = o;
    } else if constexpr (EK == E_MEMKV) {
        if (col < 1024) {
            *(f32x4*)(P->out + O_MK + (size_t)row * 1024 + col) = v;
            u32x2 o; o.x = pk2(v[0], v[1]); o.y = pk2(v[2], v[3]);
            *(u32x2*)((bf16_t*)(ws + W_KB) + (size_t)((row & ~31) + invperm32(row & 31)) * 1024 + col) = o;
        } else {
            const int c = col - 1024;
            *(f32x4*)(P->out + O_MV + (size_t)row * 1024 + c) = v;
            const int b = row >> 8, m = row & 255, hh = c >> 8, d = c & 255;
            bf16_t* vt = (bf16_t*)(ws + W_VT) + ((size_t)(b * 4 + hh) * 256 + (d & ~31) + invperm32(d & 31)) * 256 + m;
#pragma unroll
            for (int j = 0; j < 4; ++j) vt[j * 256] = f2bf(v[j]);
        }
    } else if constexpr (EK == E_POOL) {
        const f32x4 sc = *(const f32x4*)(P->pool_scale + col);
        u32x2 o; o.x = pk2(v[0] * sc[0], v[1] * sc[1]); o.y = pk2(v[2] * sc[2], v[3] * sc[3]);
        *(u32x2*)((bf16_t*)(ws + W_MIX) + (size_t)row * 2048 + 1024 + col) = o;
    } else if constexpr (EK == E_OUT) {
        const float* xin = row < TP ? P->x_prompt + (size_t)row * 1024 : P->x_sample + (size_t)(row - TP) * 1024;
        const f32x4 x = *(const f32x4*)(xin + col) + v;
        u32x2 o; o.x = pk2(x[0], x[1]); o.y = pk2(x[2], x[3]);
        *(u32x2*)((bf16_t*)(ws + W_H) + (size_t)row * 1024 + col) = o;
        return (x[0] * x[0] + x[1] * x[1]) + (x[2] * x[2] + x[3] * x[3]);
    } else if constexpr (EK == E_Q) {
        u32x2 o; o.x = pk2(v[0], v[1]); o.y = pk2(v[2], v[3]);
        *(u32x2*)((bf16_t*)(ws + W_Q) + (size_t)row * 1024 + col) = o;
    } else if constexpr (EK == E_PV) {
        u32x2 o; o.x = pk2(v[0], v[1]); o.y = pk2(v[2], v[3]);
        *(u32x2*)((bf16_t*)(ws + W_O) + (size_t)row * 1024 + col) = o;
    } else if constexpr (EK == E_MO || EK == E_DOWN) {
        u32x2* hp = (u32x2*)((bf16_t*)(ws + W_H) + (size_t)row * 1024 + col);
        const u32x2 hv = *hp;
        const f32x4 x = (f32x4){bflo(hv.x), bfhi(hv.x), bflo(hv.y), bfhi(hv.y)} + v;
        u32x2 o; o.x = pk2(x[0], x[1]); o.y = pk2(x[2], x[3]);
        *hp = o;
        return (x[0] * x[0] + x[1] * x[1]) + (x[2] * x[2] + x[3] * x[3]);
    } else if constexpr (EK == E_UP) {
        u32x2 o; o.x = pk2(v[0], v[1]); o.y = pk2(v[2], v[3]);
        *(u32x2*)((bf16_t*)(ws + W_U) + (size_t)row * 5632 + col) = o;
    }
    return 0.f;
}
template <int EK>
__device__ __forceinline__ float epi_rowscale(PP P, int row) {
    if constexpr (EK == E_Q) return rsqrtf(((const float*)(P->ws + W_SS1))[row] * (1.0f / 1024.0f) + EPS) * 0.0625f;
    else if constexpr (EK == E_UP) return rsqrtf(((const float*)(P->ws + W_SS2))[row] * (1.0f / 1024.0f) + EPS);
    else return 1.0f;
}
__device__ __forceinline__ float epi_apply_rt(PP P, int ekind, int row, int col, f32x4 v) {
    switch (ekind) {
    case E_FOLD: { u32x2 o; o.x = pk2(v[0], v[1]); o.y = pk2(v[2], v[3]); const int prow = (row & ~31) + invperm32(row & 31); *(u32x2*)((bf16_t*)(P->ws + W_WOUT) + (size_t)prow * 2048 + 1024 + col) = o; return 0.f; }
    case E_OUT: return epi_apply<E_OUT>(P, row, col, v);
    case E_Q: return epi_apply<E_Q>(P, row, col, v * epi_rowscale<E_Q>(P, row));
    case E_MO: return epi_apply<E_MO>(P, row, col, v);
    default: return epi_apply<E_DOWN>(P, row, col, v);
    }
}
template <int EK>
__device__ __forceinline__ void epi_loop(PP P, const f32x4 (&acc)[2][2][4][2], int rbase, int cbase, int fq) {
    if constexpr (EK == E_PROJ || EK == E_UP || EK == E_Q || EK == E_PV || EK == E_OUT || EK == E_MO || EK == E_DOWN) {
        const int cb8 = cbase + 4 * fq;
#pragma unroll
        for (int ai = 0; ai < 2; ++ai)
#pragma unroll
            for (int m = 0; m < 4; ++m) {
                const int row = rbase + ai * 128 + m * 16;
                const float rs = epi_rowscale<EK>(P, row);
                float ss = 0.f;
#pragma unroll
                for (int bj = 0; bj < 2; ++bj) {
                    f32x4 v0 = acc[ai][bj][m][0], v1 = acc[ai][bj][m][1];
                    const int col = cb8 + bj * 128;
                    if constexpr (EK == E_PROJ || EK == E_UP || EK == E_Q) { v0 *= rs; v1 *= rs; }
                    if constexpr (EK == E_OUT) {
                        const float* xin = (row < TP ? P->x_prompt + (size_t)row * 1024 : P->x_sample + (size_t)(row - TP) * 1024) + col;
                        v0 += *(const f32x4*)xin; v1 += *(const f32x4*)(xin + 4);
                    }
                    if constexpr (EK == E_MO || EK == E_DOWN) {
                        const u32x4 hv = *(const u32x4*)((const bf16_t*)(P->ws + W_H) + (size_t)row * 1024 + col);
                        v0 += (f32x4){bflo(hv.x), bfhi(hv.x), bflo(hv.y), bfhi(hv.y)}; v1 += (f32x4){bflo(hv.z), bfhi(hv.z), bflo(hv.w), bfhi(hv.w)};
                    }
                    if constexpr (EK == E_OUT || EK == E_MO || EK == E_DOWN) ss += ((v0[0] * v0[0] + v0[1] * v0[1]) + (v0[2] * v0[2] + v0[3] * v0[3])) + ((v1[0] * v1[0] + v1[1] * v1[1]) + (v1[2] * v1[2] + v1[3] * v1[3]));
                    u32x4 o; o.x = pk2(v0[0], v0[1]); o.y = pk2(v0[2], v0[3]); o.z = pk2(v1[0], v1[1]); o.w = pk2(v1[2], v1[3]);
                    if constexpr (EK == E_UP) *(u32x4*)((bf16_t*)(P->ws + W_U) + (size_t)row * 5632 + col) = o;
                    else if constexpr (EK == E_Q) *(u32x4*)((bf16_t*)(P->ws + W_Q) + (size_t)row * 1024 + col) = o;
                    else if constexpr (EK == E_PV) *(u32x4*)((bf16_t*)(P->ws + W_O) + (size_t)row * 1024 + col) = o;
                    else if constexpr (EK == E_PROJ) { if (col < 1024) *(u32x4*)((bf16_t*)(P->ws + W_Z) + (size_t)row * 1024 + col) = o;
                           else *(u32x4*)((bf16_t*)(P->ws + W_PROJ2) + (size_t)row * 2560 + (col - 1024)) = o; }
                    else *(u32x4*)((bf16_t*)(P->ws + W_H) + (size_t)row * 1024 + col) = o;
                }
                if constexpr (EK == E_OUT || EK == E_MO || EK == E_DOWN) {
                    ss += __shfl_xor(ss, 16); ss += __shfl_xor(ss, 32);
                    if (fq == 0) unsafeAtomicAdd((float*)(P->ws + (EK == E_OUT ? W_SS1 : EK == E_MO ? W_SS2 : W_SS3)) + row, ss);
                }
            }
        return;
    }
#pragma unroll
    for (int ai = 0; ai < 2; ++ai)
#pragma unroll
        for (int m = 0; m < 4; ++m) {
            const int row = rbase + ai * 128 + m * 16;
            const float rs = epi_rowscale<EK>(P, row);
            float ss = 0.f;
#pragma unroll
            for (int bj = 0; bj < 2; ++bj)
#pragma unroll
                for (int n = 0; n < 2; ++n) {
                    if constexpr (EK == E_Q || EK == E_UP) ss += epi_apply<EK>(P, row, cbase + bj * 128 + n * 16, acc[ai][bj][m][n] * rs);
                    else ss += epi_apply<EK>(P, row, cbase + bj * 128 + n * 16, acc[ai][bj][m][n]);
                }
            if constexpr (EK == E_OUT || EK == E_MO || EK == E_DOWN) {
                ss += __shfl_xor(ss, 16); ss += __shfl_xor(ss, 32);
                if (fq == 0) unsafeAtomicAdd((float*)(P->ws + (EK == E_OUT ? W_SS1 : EK == E_MO ? W_SS2 : W_SS3)) + row, ss);
            }
        }
}

struct PhaseCfg { const char* A; const char* B; int lda, ldb, K, nbig, nsmall, ncol64, ekind; };
__device__ __forceinline__ PhaseCfg phase_cfg(PP P, int gp) {
    const char* ws = P->ws; PhaseCfg c;
    switch (gp) {
    case 1:  c.A = ws + W_H;      c.B = ws + W_WIN;   c.lda = 1024; c.ldb = 1024; c.K = 1024; c.nbig = 66 * 14 + 64; c.nsmall = 512; c.ncol64 = 16; c.ekind = E_PROJ; break;
    case 3:  c.A = ws + W_POOLED; c.B = ws + W_WPOOL; c.lda = 1024; c.ldb = 256;  c.K = 256;  c.nbig = 256; c.nsmall = 256; c.ncol64 = 16; c.ekind = E_POOL; break;
    case 5:  c.A = ws + W_MIX;    c.B = ws + W_WOUT;  c.lda = 2048; c.ldb = 2048; c.K = 2048; c.nbig = 256; c.nsmall = 256; c.ncol64 = 16; c.ekind = E_OUT; break;
    case 7:  c.A = ws + W_H;      c.B = ws + W_WMQ;   c.lda = 1024; c.ldb = 1024; c.K = 1024; c.nbig = 256; c.nsmall = 256; c.ncol64 = 16; c.ekind = E_Q; break;
    case 8:  c.A = ws + W_Q;      c.B = ws + W_KB;    c.lda = 1024; c.ldb = 1024; c.K = 256;  c.nbig = 256; c.nsmall = 0;   c.ncol64 = 16; c.ekind = E_QK; break;
    case 9:  c.A = ws + W_P;      c.B = ws + W_VT;    c.lda = 1024; c.ldb = 256;  c.K = 256;  c.nbig = 256; c.nsmall = 0;   c.ncol64 = 16; c.ekind = E_PV; break;
    case 10: c.A = ws + W_O;      c.B = ws + W_WMO;   c.lda = 1024; c.ldb = 1024; c.K = 1024; c.nbig = 256; c.nsmall = 256; c.ncol64 = 16; c.ekind = E_MO; break;
    case 12: c.A = ws + W_H;      c.B = ws + W_WUP;   c.lda = 1024; c.ldb = 1024; c.K = 1024; c.nbig = 66 * 22; c.nsmall = 0; c.ncol64 = 88; c.ekind = E_UP; break;
    default: c.A = ws + W_ACT;    c.B = ws + W_WDOWN; c.lda = 2816; c.ldb = 2816; c.K = 2816; c.nbig = 256; c.nsmall = 256; c.ncol64 = 16; c.ekind = E_DOWN; break;
    }
    return c;
}
struct UnitD { const char* A; const char* B; int row0, col0, ekind; };
__device__ __forceinline__ void map_unit(int L, int nM, int nN, int& pm, int& pn) {
    const int nwg = nM * nN, q = nwg >> 3, r = nwg & 7, xcd = L & 7, off = L >> 3;
    const int wgid = (xcd < r ? xcd * (q + 1) : r * (q + 1) + (xcd - r) * q) + off;
    const int nig = 8 * nN, gid = wgid / nig, fm = gid * 8, gsz = (nM - fm) < 8 ? (nM - fm) : 8;
    const int w = wgid - gid * nig;
    pm = fm + w % gsz; pn = w / gsz;
}
__device__ __forceinline__ UnitD unit_decode(PP P, const PhaseCfg& c, int gp, int L) {
    UnitD d; d.ekind = c.ekind;
    int pm, pn;
    switch (gp) {
    case 1:
        if (L < 924) { map_unit(L, 66, 14, pm, pn); d.A = c.A + (size_t)pm * 256 * 2048; d.B = c.B + (size_t)pn * 256 * 2048; }
        else { map_unit(L - 924, 8, 8, pm, pn); d.A = P->ws + W_HM + (size_t)pm * 256 * 2048; d.B = P->ws + W_WMK + (size_t)pn * 256 * 2048; d.ekind = E_MEMKV; }
        break;
    case 3: map_unit(L, 64, 4, pm, pn); d.A = c.A + (size_t)pm * 256 * 2048 + pn * 512; d.B = c.B + (size_t)pn * 131072; break;
    case 8: map_unit(L, 64, 4, pm, pn); d.A = c.A + (size_t)pm * 256 * 2048 + pn * 512; d.B = c.B + (size_t)(pm >> 3) * 256 * 2048 + pn * 512; break;
    case 9: map_unit(L, 64, 4, pm, pn); d.A = c.A + (size_t)pm * 256 * 2048 + pn * 512; d.B = c.B + (size_t)((pm >> 3) * 4 + pn) * 131072; break;
    case 12: map_unit(L, 66, 22, pm, pn); d.A = c.A + (size_t)pm * 256 * 2048; d.B = c.B + (size_t)pn * 256 * 2048; break;
    default: map_unit(L, 64, 4, pm, pn); d.A = c.A + (size_t)pm * 256 * c.lda * 2; d.B = c.B + (size_t)pn * 256 * c.ldb * 2; break;
    }
    d.row0 = pm * 256; d.col0 = pn * 256;
    return d;
}

__device__ __forceinline__ void gemm_phase(PP P, int gp, char* shm_g, int lb, int blk, int nblk, const int tid) {
    LDSB unsigned char* lds = (LDSB unsigned char*)shm_g;
    const int wid = __builtin_amdgcn_readfirstlane(tid >> 6), lane = tid & 63, wr = wid >> 2, wc = wid & 3, fr = lane & 15, fq = lane >> 4;
    const PhaseCfg cfg = phase_cfg(P, gp);
    const int K = cfg.K, nt = K / 64;
    unsigned voffA, voffB;
    { int R, C; stage_rc(tid * 16, R, C); voffA = (unsigned)(R * cfg.lda + C) * 2u; voffB = (unsigned)(R * cfg.ldb + C) * 2u; }
    const size_t qstepvoffA = (size_t)64 * cfg.lda * 2, qstepvoffB = (size_t)64 * cfg.ldb * 2;
    const size_t kstep = 128;
    const size_t hstepA = (size_t)128 * cfg.lda * 2, hstepB = (size_t)128 * cfg.ldb * 2;
    const unsigned ldsw = (unsigned)wid * 1024u;
    const int aoff = lds_byte(wr * 64 + fr, fq * 8), boff = lds_byte(wc * 32 + fr, fq * 8);
    const bool chain = (cfg.ekind != E_QK);
#define G_SA(b, h) (((b) * 2 + (h)) * HTB)
#define G_SB(b, h) ((4 + (b) * 2 + (h)) * HTB)
#define G_STAGE(bufoff, gbase, voff) do { \
        __builtin_amdgcn_global_load_lds((const unsigned*)((const char*)(gbase) + (voff)), (LDSB unsigned*)(lds + (bufoff) + ldsw), 16, 0, 0); \
        __builtin_amdgcn_global_load_lds((const unsigned*)((const char*)(gbase) + qstep##voff + (voff)), (LDSB unsigned*)(lds + (bufoff) + ldsw + 8192), 16, 0, 0); } while (0)
#define G_LDA(dst, b, h) do { _Pragma("unroll") for (int m = 0; m < 4; ++m) _Pragma("unroll") for (int k = 0; k < 2; ++k) dst[m][k] = *(const LDSB bf16x8*)(lds + G_SA(b, h) + aoff + m * 2048 + k * 1024); } while (0)
#define G_LDB(dst, b, h) do { _Pragma("unroll") for (int n = 0; n < 2; ++n) _Pragma("unroll") for (int k = 0; k < 2; ++k) dst[n][k] = *(const LDSB bf16x8*)(lds + G_SB(b, h) + boff + n * 2048 + k * 1024); } while (0)
#define G_MMA(ai, bj, Af, Bf) do { __builtin_amdgcn_s_setprio(1); _Pragma("unroll") for (int m = 0; m < 4; ++m) _Pragma("unroll") for (int n = 0; n < 2; ++n) _Pragma("unroll") for (int k = 0; k < 2; ++k) \
        acc[ai][bj][m][n] = __builtin_amdgcn_mfma_f32_16x16x32_bf16(Bf[n][k], Af[m][k], acc[ai][bj][m][n], 0, 0, 0); __builtin_amdgcn_s_setprio(0); } while (0)
#define G_WAIT_V(n) asm volatile("s_waitcnt vmcnt(" #n ")" ::: "memory")
#define G_WAIT_L(n) asm volatile("s_waitcnt lgkmcnt(" #n ")" ::: "memory")
#define G_BAR __builtin_amdgcn_s_barrier()
#define G_SCHED __builtin_amdgcn_sched_barrier(0)
    int u = blk;
    while (u < cfg.nbig) {
        UnitD cur = unit_decode(P, cfg, gp, u);
        f32x4 acc[2][2][4][2];
#pragma unroll
        for (int a = 0; a < 2; ++a)
#pragma unroll
            for (int b = 0; b < 2; ++b)
#pragma unroll
                for (int m = 0; m < 4; ++m)
#pragma unroll
                    for (int n = 0; n < 2; ++n) acc[a][b][m][n] = (f32x4){0.f, 0.f, 0.f, 0.f};
        bf16x8 At[4][2], B0[2][2], B1[2][2];
        const char* cA = cur.A; const char* cB = cur.B;
        G_STAGE(G_SB(0, 0), cB, voffB); G_STAGE(G_SA(0, 0), cA, voffA); G_STAGE(G_SB(0, 1), cB + hstepB, voffB); G_STAGE(G_SA(0, 1), cA + hstepA, voffA);
        if (wr == 1) G_BAR;
        G_WAIT_V(4); G_BAR;
        G_STAGE(G_SB(1, 0), cB + kstep, voffB); G_STAGE(G_SA(1, 0), cA + kstep, voffA); G_STAGE(G_SB(1, 1), cB + hstepB + kstep, voffB);
        G_WAIT_V(6); G_BAR;
        for (;;) {
            const bool has_next = chain && (u + nblk < cfg.nbig);
            UnitD nxt = cur;
            if (has_next) nxt = unit_decode(P, cfg, gp, u + nblk);
            const char* nA = nxt.A; const char* nB = nxt.B;
            for (int t = 0; t < nt; t += 2) {
                const bool last = (t == nt - 2);
                const char* a1 = cA + (size_t)(t + 1) * kstep;
                const char* a2 = last ? nA : cA + (size_t)(t + 2) * kstep; const char* b2 = last ? nB : cB + (size_t)(t + 2) * kstep;
                const char* a3 = a2 + kstep; const char* b3 = b2 + kstep;
                G_LDB(B0, 0, 0); G_SCHED; G_LDA(At, 0, 0); G_STAGE(G_SA(1, 1), a1 + hstepA, voffA);
                G_WAIT_L(8); G_BAR; G_WAIT_L(0); G_MMA(0, 0, At, B0); G_BAR; G_SCHED;
                G_LDB(B1, 0, 1); G_STAGE(G_SB(0, 0), b2, voffB);
                G_BAR; G_WAIT_L(0); G_MMA(0, 1, At, B1); G_BAR;
                G_LDA(At, 0, 1); G_STAGE(G_SA(0, 0), a2, voffA);
                G_BAR; G_WAIT_L(0); G_MMA(1, 0, At, B0); G_BAR; G_SCHED;
                G_STAGE(G_SB(0, 1), b2 + hstepB, voffB);
                G_WAIT_V(6); G_BAR; G_MMA(1, 1, At, B1); G_BAR;
                G_LDB(B0, 1, 0); G_SCHED; G_LDA(At, 1, 0); G_STAGE(G_SA(0, 1), a2 + hstepA, voffA);
                G_WAIT_L(8); G_BAR; G_WAIT_L(0); G_MMA(0, 0, At, B0); G_BAR; G_SCHED;
                G_LDB(B1, 1, 1); G_STAGE(G_SB(1, 0), b3, voffB);
                G_BAR; G_WAIT_L(0); G_MMA(0, 1, At, B1); G_BAR;
                G_LDA(At, 1, 1); G_STAGE(G_SA(1, 0), a3, voffA);
                G_BAR; G_WAIT_L(0); G_MMA(1, 0, At, B0); G_BAR; G_SCHED;
                G_STAGE(G_SB(1, 1), b3 + hstepB, voffB);
                G_WAIT_V(6); G_BAR; G_MMA(1, 1, At, B1); G_BAR;
            }
            if (chain) {
                const int rbase = cur.row0 + wr * 64 + fr, cbase = cur.col0 + wc * 32 + fq * 4;
                switch (cur.ekind) {
                case E_PROJ: epi_loop<E_PROJ>(P, acc, rbase, cbase, fq); break;
                case E_MEMKV: epi_loop<E_MEMKV>(P, acc, rbase, cbase, fq); break;
                case E_POOL: epi_loop<E_POOL>(P, acc, rbase, cbase, fq); break;
                case E_OUT: epi_loop<E_OUT>(P, acc, rbase, cbase, fq); break;
                case E_Q: epi_loop<E_Q>(P, acc, rbase, cbase, fq); break;
                case E_PV: epi_loop<E_PV>(P, acc, rbase, cbase, fq); break;
                case E_MO: epi_loop<E_MO>(P, acc, rbase, cbase, fq); break;
                case E_UP: epi_loop<E_UP>(P, acc, rbase, cbase, fq); break;
                default: epi_loop<E_DOWN>(P, acc, rbase, cbase, fq); break;
                }
            }
            if (!has_next) break;
#pragma unroll
            for (int a = 0; a < 2; ++a)
#pragma unroll
                for (int b = 0; b < 2; ++b)
#pragma unroll
                    for (int m = 0; m < 4; ++m)
#pragma unroll
                        for (int n = 0; n < 2; ++n) acc[a][b][m][n] = (f32x4){0.f, 0.f, 0.f, 0.f};
            cur = nxt; cA = nA; cB = nB; u += nblk;
        }
        G_WAIT_V(0);
        if (wr == 0) G_BAR;
        G_BAR;
        if (!chain) {
            float* redm = (float*)(shm_g + 131072);
            float* reds = (float*)(shm_g + 135168);
#pragma unroll
            for (int ai = 0; ai < 2; ++ai)
#pragma unroll
                for (int m = 0; m < 4; ++m) {
                    float t = -3.0e38f;
#pragma unroll
                    for (int bj = 0; bj < 2; ++bj)
#pragma unroll
                        for (int n = 0; n < 2; ++n)
#pragma unroll
                            for (int j = 0; j < 4; ++j) t = fmaxf(t, acc[ai][bj][m][n][j]);
                    t = fmaxf(t, __shfl_xor(t, 16)); t = fmaxf(t, __shfl_xor(t, 32));
                    if (fq == 0) redm[(ai * 128 + wr * 64 + m * 16 + fr) * 4 + wc] = t;
                }
            __syncthreads();
#pragma unroll
            for (int ai = 0; ai < 2; ++ai)
#pragma unroll
                for (int m = 0; m < 4; ++m) {
                    const f32x4 r = *(const f32x4*)(redm + (ai * 128 + wr * 64 + m * 16 + fr) * 4);
                    const float M = fmaxf(fmaxf(r[0], r[1]), fmaxf(r[2], r[3]));
                    float s = 0.f;
#pragma unroll
                    for (int bj = 0; bj < 2; ++bj)
#pragma unroll
                        for (int n = 0; n < 2; ++n)
#pragma unroll
                            for (int j = 0; j < 4; ++j) { const float e = __expf(acc[ai][bj][m][n][j] - M); acc[ai][bj][m][n][j] = e; s += e; }
                    s += __shfl_xor(s, 16); s += __shfl_xor(s, 32);
                    if (fq == 0) reds[(ai * 128 + wr * 64 + m * 16 + fr) * 4 + wc] = s;
                }
            __syncthreads();
#pragma unroll
            for (int ai = 0; ai < 2; ++ai)
#pragma unroll
                for (int m = 0; m < 4; ++m) {
                    const int rl = ai * 128 + wr * 64 + m * 16 + fr;
                    const f32x4 r = *(const f32x4*)(reds + rl * 4);
                    const float inv = 1.0f / ((r[0] + r[1]) + (r[2] + r[3]));
                    bf16_t* prow = (bf16_t*)(P->ws + W_P) + (size_t)(cur.row0 + rl) * 1024 + cur.col0;
#pragma unroll
                    for (int bj = 0; bj < 2; ++bj) {
                        const f32x4 v0 = acc[ai][bj][m][0], v1 = acc[ai][bj][m][1];
                        u32x4 o; o.x = pk2(v0[0] * inv, v0[1] * inv); o.y = pk2(v0[2] * inv, v0[3] * inv); o.z = pk2(v1[0] * inv, v1[1] * inv); o.w = pk2(v1[2] * inv, v1[3] * inv);
                        *(u32x4*)(prow + bj * 128 + wc * 32 + fq * 8) = o;
                    }
                }
            __syncthreads();
        }
        u += nblk;
    }
#undef G_SA
#undef G_SB
#undef G_STAGE
#undef G_LDA
#undef G_LDB
#undef G_MMA
    const int rot = cfg.nbig % nblk;
    for (int s0 = (lb - rot + nblk) % nblk; s0 < cfg.nsmall; s0 += nblk) {
        const int pr = s0 / cfg.ncol64, pc = s0 % cfg.ncol64;
        const int row0 = (gp == 1 ? 0 : TP) + pr * 32, col0 = pc * 64;
        int lda_s = cfg.lda, ldb_s = cfg.ldb, K_s = K, ek_s = cfg.ekind;
        const bf16_t* Ab; const bf16_t* Bb;
        if (gp == 1) {
            const int g = pc >> 2; lda_s = 1024; ldb_s = 256; K_s = 256; ek_s = E_FOLD;
            Ab = (const bf16_t*)(P->ws + W_WLO) + (size_t)row0 * 1024 + g * 256; Bb = (const bf16_t*)(P->ws + W_WPOOL) + (size_t)g * 65536 + (size_t)(col0 - g * 256) * 256;
        } else { Ab = (const bf16_t*)cfg.A + (size_t)row0 * cfg.lda; Bb = (const bf16_t*)cfg.B + (size_t)col0 * cfg.ldb; }
        const int kw = K_s >> 3, nks = kw >> 5;
        f32x4 acc[2][4];
#pragma unroll
        for (int mi = 0; mi < 2; ++mi)
#pragma unroll
            for (int ni = 0; ni < 4; ++ni) acc[mi][ni] = (f32x4){0.f, 0.f, 0.f, 0.f};
        const bf16_t* ap = Ab + (size_t)fr * lda_s + wid * kw + fq * 8;
        const bf16_t* bp = Bb + (size_t)fr * ldb_s + wid * kw + fq * 8;
        for (int ks0 = 0; ks0 < nks; ks0 += 4) {
            bf16x8 a[4][2], b[4][4];
#pragma unroll
            for (int q = 0; q < 4; ++q) {
                const bool ok = ks0 + q < nks;
#pragma unroll
                for (int mi = 0; mi < 2; ++mi) { bf16x8 z = {0, 0, 0, 0, 0, 0, 0, 0}; if (ok) z = *(const bf16x8*)(ap + (size_t)mi * 16 * lda_s + (ks0 + q) * 32); a[q][mi] = z; }
#pragma unroll
                for (int ni = 0; ni < 4; ++ni) { bf16x8 z = {0, 0, 0, 0, 0, 0, 0, 0}; if (ok) z = *(const bf16x8*)(bp + (size_t)ni * 16 * ldb_s + (ks0 + q) * 32); b[q][ni] = z; }
            }
#pragma unroll
            for (int q = 0; q < 4; ++q)
#pragma unroll
                for (int mi = 0; mi < 2; ++mi)
#pragma unroll
                    for (int ni = 0; ni < 4; ++ni) acc[mi][ni] = __builtin_amdgcn_mfma_f32_16x16x32_bf16(b[q][ni], a[q][mi], acc[mi][ni], 0, 0, 0);
        }
        float* red = (float*)shm_g;
#pragma unroll
        for (int mi = 0; mi < 2; ++mi)
#pragma unroll
            for (int ni = 0; ni < 4; ++ni) *(f32x4*)(red + wid * 2048 + (mi * 16 + fr) * 64 + ni * 16 + fq * 4) = acc[mi][ni];
        __syncthreads();
        {
            const int r = tid >> 4, c = (tid & 15) * 4;
            f32x4 v = *(const f32x4*)(red + r * 64 + c);
#pragma unroll
            for (int w = 1; w < 8; ++w) v += *(const f32x4*)(red + w * 2048 + r * 64 + c);
            const int cl = (gp == 1) ? c : (c & 32) + perm32(c & 31);
            float ss = epi_apply_rt(P, ek_s, row0 + r, col0 + cl, v);
            if (cfg.ekind == E_OUT || cfg.ekind == E_MO || cfg.ekind == E_DOWN) {
                ss += __shfl_xor(ss, 1); ss += __shfl_xor(ss, 2); ss += __shfl_xor(ss, 4); ss += __shfl_xor(ss, 8);
                if ((tid & 15) == 0) unsafeAtomicAdd((float*)(P->ws + (cfg.ekind == E_OUT ? W_SS1 : cfg.ekind == E_MO ? W_SS2 : W_SS3)) + row0 + r, ss);
            }
        }
        __syncthreads();
    }
}

struct TrDesc { const float* src; bf16_t* dst; const float* gain; int ld_src, ld_dst, k0, n0s, n0d, perm; };
__device__ __forceinline__ TrDesc tr_decode(PP P, int i) {
    char* ws = P->ws; TrDesc d; d.gain = nullptr; d.perm = 0;
    if (i < 896) { const int kt = i / 56, ntl = i % 56; d.n0d = ntl * 64; d.n0s = d.n0d < 2560 ? d.n0d : d.n0d + 16; d.src = P->w_in; d.ld_src = 3600; d.dst = (bf16_t*)(ws + W_WIN); d.ld_dst = 1024; d.k0 = kt * 64; d.perm = 1; return d; }
    i -= 896;
    if (i < 512) { const int kt = i >> 4, ntl = i & 15; d.ld_src = 1024; d.n0s = d.n0d = ntl * 64;
        d.perm = kt < 16 ? 1 : 0;
        if (kt < 16) { d.src = P->w_out; d.dst = (bf16_t*)(ws + W_WOUT); d.ld_dst = 2048; d.k0 = kt * 64; }
        else { d.src = P->w_out + (size_t)1024 * 1024; d.dst = (bf16_t*)(ws + W_WLO); d.ld_dst = 1024; d.k0 = (kt - 16) * 64; }
        return d; }
    i -= 512;
    if (i < 1024) { const int wsel = i >> 8, r = i & 255, kt = r >> 4, ntl = r & 15;
        d.src = wsel == 0 ? P->w_mq : wsel == 1 ? P->w_mk : wsel == 2 ? P->w_mv : P->w_mo;
        d.dst = (bf16_t*)(ws + (wsel == 0 ? W_WMQ : wsel == 1 ? W_WMK : wsel == 2 ? W_WMV : W_WMO));
        d.gain = wsel == 0 ? P->norm_mem : nullptr; d.ld_src = 1024; d.ld_dst = 1024; d.k0 = kt * 64; d.n0s = d.n0d = ntl * 64; d.perm = (wsel == 0 || wsel == 3) ? 1 : 0; return d; }
    i -= 1024;
    if (i < 1408) { const int kt = i / 88, ntl = i % 88; d.src = P->w_up; d.ld_src = 5632; d.dst = (bf16_t*)(ws + W_WUP); d.ld_dst = 1024; d.gain = P->norm_ffn; d.k0 = kt * 64; d.n0s = d.n0d = ntl * 64; d.perm = 1; return d; }
    i -= 1408;
    { const int kt = i >> 4, ntl = i & 15; d.src = P->w_down; d.ld_src = 1024; d.dst = (bf16_t*)(ws + W_WDOWN); d.ld_dst = 2816; d.k0 = kt * 64; d.n0s = d.n0d = ntl * 64; d.perm = 1; return d; }
}

__device__ __forceinline__ void phase_prep(PP P, char* shm, int blk, int nblk, const int tid) {
    const int wid = tid >> 6, lane = tid & 63;
    float* tiles = (float*)shm;
    float* wdt = (float*)(shm + 69632);
    for (int i = blk * NTHR + tid; i < 3 * TT; i += nblk * NTHR) ((float*)(P->ws + W_SS1))[i] = 0.f;
    for (int i = (blk * NTHR + tid) * 4; i < 4 * 65536; i += nblk * NTHR * 4) {
        const f32x4 wv = *(const f32x4*)(P->w_pool + i), sv = *(const f32x4*)(P->pool_scale + (i >> 16) * 256 + (i & 255));
        u32x2 o; o.x = pk2(wv[0] * sv[0], wv[1] * sv[1]); o.y = pk2(wv[2] * sv[2], wv[3] * sv[3]);
        *(u32x2*)((bf16_t*)(P->ws + W_WPOOL) + i) = o;
    }
    for (int i = tid; i < 1024 * 16; i += NTHR) { const int k = i >> 4, hd = i & 15; wdt[hd * 1024 + k] = P->w_in[(size_t)k * 3600 + 2560 + hd]; }
    __syncthreads();
    char* ws = P->ws;
    constexpr int NGRP = (TT + 2048) / 32;
    for (int it = blk; it < NGRP; it += nblk) {
        const int rbase = it * 32 + wid * 4;
        const bool ismem = rbase >= TT;
        f32x4 xv[4][4];
#pragma unroll
        for (int r = 0; r < 4; ++r) {
            const int row = (ismem ? rbase - TT : rbase) + r;
            const float* xr = ismem ? P->mem_prompt + (size_t)row * 1024 : (row < TP ? P->x_prompt + (size_t)row * 1024 : P->x_sample + (size_t)(row - TP) * 1024);
#pragma unroll
            for (int j = 0; j < 4; ++j) xv[r][j] = __builtin_nontemporal_load((const f32x4*)(xr + j * 256 + lane * 4));
        }
        const float* gg = ismem ? P->norm_memkv : P->norm_mix;
#pragma unroll
        for (int r = 0; r < 4; ++r) {
            const int row = (ismem ? rbase - TT : rbase) + r;
            bf16_t* orow = (bf16_t*)(ws + (ismem ? W_HM : W_H)) + (size_t)row * 1024;
            float ss = 0.f;
#pragma unroll
            for (int j = 0; j < 4; ++j) ss += xv[r][j][0] * xv[r][j][0] + xv[r][j][1] * xv[r][j][1] + xv[r][j][2] * xv[r][j][2] + xv[r][j][3] * xv[r][j][3];
            ss = wave_sum(ss);
            const float rstd = rsqrtf(ss * (1.0f / 1024.0f) + EPS);
#pragma unroll
            for (int j = 0; j < 4; ++j) { const f32x4 g4 = *(const f32x4*)(gg + j * 256 + lane * 4); xv[r][j] = xv[r][j] * rstd * g4;
                u32x2 o; o.x = pk2(xv[r][j][0], xv[r][j][1]); o.y = pk2(xv[r][j][2], xv[r][j][3]); *(u32x2*)(orow + j * 256 + lane * 4) = o; }
            if (!ismem) {
                float mine = 0.f;
#pragma unroll
                for (int hd = 0; hd < 16; ++hd) {
                    float acc = 0.f;
#pragma unroll
                    for (int j = 0; j < 4; ++j) { const f32x4 w4 = *(const f32x4*)(wdt + hd * 1024 + j * 256 + lane * 4); acc += xv[r][j][0] * w4[0] + xv[r][j][1] * w4[1] + xv[r][j][2] * w4[2] + xv[r][j][3] * w4[3]; }
                    acc = wave_sum(acc);
                    if (lane == hd) mine = acc;
                }
                if (lane < 16) { const float x = mine + P->dt_bias[lane]; const float ey = __expf(-fabsf(x)); const float l1p = ey < 0.03f ? ey * (1.0f - ey * (0.5f - ey * (0.33333333f - 0.25f * ey))) : __logf(1.0f + ey); const float sp = fmaxf(x, 0.f) + l1p; ((float*)(ws + W_DT))[(size_t)row * 16 + lane] = sp; }
            }
        }
    }
    __syncthreads();
    const int kr = tid >> 4, nc = (tid & 15) * 4, tn = tid >> 3, tk8 = (tid & 7) * 8;
    for (int it = blk; it < 4544; it += 4 * nblk) {
        f32x4 v[4][2];
#pragma unroll
        for (int q = 0; q < 4; ++q) {
            const int i = it + q * nblk;
            if (i < 4544) { const TrDesc d = tr_decode(P, i);
#pragma unroll
                for (int h = 0; h < 2; ++h) { const int k = kr + h * 32; f32x4 t = __builtin_nontemporal_load((const f32x4*)(d.src + (size_t)(d.k0 + k) * d.ld_src + d.n0s + nc)); if (d.gain) t *= d.gain[d.k0 + k]; v[q][h] = t; } }
        }
#pragma unroll
        for (int q = 0; q < 4; ++q) {
            if (it + q * nblk < 4544) { float* tile = tiles + q * (64 * 65);
#pragma unroll
                for (int h = 0; h < 2; ++h) { const int k = kr + h * 32; tile[k * 65 + nc + 0] = v[q][h][0]; tile[k * 65 + nc + 1] = v[q][h][1]; tile[k * 65 + nc + 2] = v[q][h][2]; tile[k * 65 + nc + 3] = v[q][h][3]; } }
        }
        __syncthreads();
#pragma unroll
        for (int q = 0; q < 4; ++q) {
            const int i = it + q * nblk;
            if (i < 4544) { const TrDesc d = tr_decode(P, i); const float* tile = tiles + q * (64 * 65); float f[8];
                const int sc = d.perm ? (tn & 32) + perm32(tn & 31) : tn;
#pragma unroll
                for (int e2 = 0; e2 < 8; ++e2) f[e2] = tile[(tk8 + e2) * 65 + sc];
                *(u32x4*)(d.dst + (size_t)(d.n0d + tn) * d.ld_dst + d.k0 + tk8) = pack8(f); }
        }
        __syncthreads();
    }
}

__device__ __forceinline__ u32x4 ld8(const bf16_t* p) { return *(const u32x4*)p; }

__device__ __forceinline__ void phase_convpool(PP P, int gtid, int nthreads) {
    char* ws = P->ws;
    const bf16_t* proj2 = (const bf16_t*)(ws + W_PROJ2);
    bf16_t* xact = (bf16_t*)(ws + W_XACT);
    bf16_t* pooled = (bf16_t*)(ws + W_POOLED);
    for (int idx = gtid; idx < 1152 * 320; idx += nthreads) {
        const int run = idx / 320, cg = idx % 320;
        const bool samp = run >= 1024;
        int t0, len, bidx, tl0;
        if (!samp) { t0 = run * 16; len = 16; bidx = t0 >> 11; tl0 = t0 & 2047; } else { bidx = run - 1024; t0 = TP + bidx * 4; len = 4; tl0 = 0; }
        if (cg < 192) {
            const int c0 = cg * 8;
            float w0[8], w1[8], w2[8], w3[8], bs[8], h0[8], h1[8], h2[8];
#pragma unroll
            for (int e = 0; e < 8; ++e) { w0[e] = P->conv_w[c0 + e]; w1[e] = P->conv_w[1536 + c0 + e]; w2[e] = P->conv_w[3072 + c0 + e]; w3[e] = P->conv_w[4608 + c0 + e]; bs[e] = P->conv_b[c0 + e]; }
            if (samp) {
#pragma unroll
                for (int e = 0; e < 8; ++e) { h0[e] = P->state_conv[(size_t)(bidx * 3 + 0) * 1536 + c0 + e]; h1[e] = P->state_conv[(size_t)(bidx * 3 + 1) * 1536 + c0 + e]; h2[e] = P->state_conv[(size_t)(bidx * 3 + 2) * 1536 + c0 + e]; }
            } else if (tl0 > 0) {
                unpack8(ld8(proj2 + (size_t)(t0 - 3) * 2560 + c0), h0); unpack8(ld8(proj2 + (size_t)(t0 - 2) * 2560 + c0), h1); unpack8(ld8(proj2 + (size_t)(t0 - 1) * 2560 + c0), h2);
            } else {
#pragma unroll
                for (int e = 0; e < 8; ++e) { h0[e] = 0.f; h1[e] = 0.f; h2[e] = 0.f; }
            }
            u32x4 rx[16];
#pragma unroll
            for (int j = 0; j < 16; ++j) { if (j < len) rx[j] = ld8(proj2 + (size_t)(t0 + j) * 2560 + c0); }
#pragma unroll
            for (int j = 0; j < 16; ++j) {
                if (j < len) {
                float x3[8], y[8]; unpack8(rx[j], x3);
#pragma unroll
                for (int e = 0; e < 8; ++e) { const float v = bs[e] + w0[e] * h0[e] + w1[e] * h1[e] + w2[e] * h2[e] + w3[e] * x3[e]; y[e] = silu_f(v); }
                *(u32x4*)(xact + (size_t)(t0 + j) * 1536 + c0) = pack8(y);
                if (samp) { if (j >= 1) { float* o = P->out + O_CONVS + (size_t)(bidx * 3 + j - 1) * 1536 + c0;
#pragma unroll
                        for (int e = 0; e < 8; ++e) o[e] = x3[e]; } }
                else { const int tl = tl0 + j; if (tl >= 2045) { float* o = P->out + O_CONVP + (size_t)(bidx * 3 + tl - 2045) * 1536 + c0;
#pragma unroll
                        for (int e = 0; e < 8; ++e) o[e] = x3[e]; } }
#pragma unroll
                for (int e = 0; e < 8; ++e) { h0[e] = h1[e]; h1[e] = h2[e]; h2[e] = x3[e]; }
                }
            }
        } else {
            const int c0 = (cg - 192) * 8; const int win = 2 << (c0 >> 8);
            const bf16_t* vp = proj2 + 1536 + c0;
            const float* prev = P->state_pool + (size_t)bidx * 15 * 1024 + c0;
            float sum[8];
#pragma unroll
            for (int e = 0; e < 8; ++e) sum[e] = 0.f;
            if (samp) {
                for (int jj = 1; jj < win; ++jj) {
#pragma unroll
                    for (int e = 0; e < 8; ++e) sum[e] += prev[(size_t)(15 - jj) * 1024 + e]; }
                float* o = P->out + O_POOLS + (size_t)bidx * 15 * 1024 + c0;
                for (int i = 0; i < 11; ++i) {
#pragma unroll
                    for (int e = 0; e < 8; ++e) o[(size_t)i * 1024 + e] = prev[(size_t)(i + 4) * 1024 + e]; }
            } else if (tl0 > 0) {
                for (int jj = 1; jj < win; ++jj) { float v[8]; unpack8(ld8(vp + (size_t)(t0 - jj) * 2560), v);
#pragma unroll
                    for (int e = 0; e < 8; ++e) sum[e] += v[e]; }
            }
            u32x4 rp[16];
#pragma unroll
            for (int j = 0; j < 16; ++j) { if (j < len) rp[j] = ld8(vp + (size_t)(t0 + j) * 2560); }
#pragma unroll
            for (int j = 0; j < 16; ++j) {
                if (j >= len) continue;
                float v[8], o8[8]; unpack8(rp[j], v);
                const int tl = tl0 + j;
                const float inv = 1.0f / (float)(samp ? win : (tl + 1 < win ? tl + 1 : win));
#pragma unroll
                for (int e = 0; e < 8; ++e) { sum[e] += v[e]; o8[e] = sum[e] * inv - v[e]; }
                *(u32x4*)((bf16_t*)(ws + W_MIX) + (size_t)(t0 + j) * 2048 + 1024 + c0) = pack8(o8);
                const int to = j - win + 1;
                if (samp) {
                    if (to >= 0) { float q[8]; unpack8(ld8(vp + (size_t)(t0 + to) * 2560), q);
#pragma unroll
                        for (int e = 0; e < 8; ++e) sum[e] -= q[e]; }
                    else {
#pragma unroll
                        for (int e = 0; e < 8; ++e) sum[e] -= prev[(size_t)(15 + to) * 1024 + e]; }
                    float* o = P->out + O_POOLS + (size_t)(bidx * 15 + 11 + j) * 1024 + c0;
#pragma unroll
                    for (int e = 0; e < 8; ++e) o[e] = v[e];
                } else {
                    if (tl0 + to >= 0) { float q[8]; unpack8(ld8(vp + (size_t)(t0 + to) * 2560), q);
#pragma unroll
                        for (int e = 0; e < 8; ++e) sum[e] -= q[e]; }
                    if (tl >= 2033) { float* o = P->out + O_POOLP + (size_t)(bidx * 15 + tl - 2033) * 1024 + c0;
#pragma unroll
                        for (int e = 0; e < 8; ++e) o[e] = v[e]; }
                }
            }
        }
    }
}

constexpr int CS_STR = 136;
constexpr int X_STR = 40;
__device__ __forceinline__ s16x4 tr_read(const bf16_t* p) { return __builtin_bit_cast(s16x4, __builtin_amdgcn_ds_read_tr16_b64_v4i16((LDSB s16x4*)p)); }

#define LDS_BARRIER() asm volatile("s_waitcnt lgkmcnt(0)\n\ts_barrier" ::: "memory")
__device__ __forceinline__ void ssd_prompt(PP P, int item, char* shm, const int tid) {
    const int w = tid >> 6, lane = tid & 63, fr = lane & 15, fq = lane >> 4;
    const int b = item >> 5, hd = (item >> 1) & 15, ph = item & 1, g = hd >> 3;
    const float a = -expf(P->a_log[hd]);
    const float Dh = P->ssm_d[hd];
    char* ws = P->ws;
    const bf16_t* xact = (const bf16_t*)(ws + W_XACT);
    const float* dtb = (const float*)(ws + W_DT);
    bf16_t* ybuf = (bf16_t*)(ws + W_Y);
    bf16_t* Cs = (bf16_t*)(shm);
    bf16_t* Bs = (bf16_t*)(shm + 34816);
    bf16_t* Xd = (bf16_t*)(shm + 69632);
    bf16_t* X2 = (bf16_t*)(shm + 69632 + 10240);
    bf16_t* Ht = (bf16_t*)(shm + 69632 + 20480);
    float* acs = (float*)(shm + 69632 + 30720);
    float* dts = (float*)(shm + 69632 + 31232);
    f32x4 Hacc[2];
    Hacc[0] = (f32x4){0.f, 0.f, 0.f, 0.f}; Hacc[1] = (f32x4){0.f, 0.f, 0.f, 0.f};
    const int q4 = fr >> 2, p4 = fr & 3;
    u32x4 pc[4], pb[4], px; float pd0, pd1;
    const int ls = tid >> 4, ln8 = (tid & 15) * 8;
    const int xs = tid >> 2, xp8 = (tid & 3) * 8;
#define SSD_PREFETCH(cc) do { const int _t0 = b * 2048 + (cc) * 128; \
        _Pragma("unroll") for (int i = 0; i < 4; ++i) { const bf16_t* src = xact + (size_t)(_t0 + ls + i * 32) * 1536 + g * 128 + ln8; pc[i] = *(const u32x4*)(src + 1280); pb[i] = *(const u32x4*)(src + 1024); } \
        px = *(const u32x4*)(xact + (size_t)(_t0 + xs) * 1536 + hd * 64 + ph * 32 + xp8); \
        pd0 = dtb[(size_t)(_t0 + 2 * lane) * 16 + hd]; pd1 = dtb[(size_t)(_t0 + 2 * lane + 1) * 16 + hd]; } while (0)
    SSD_PREFETCH(0);
    for (int c = 0; c < 16; ++c) {
        const int t0 = b * 2048 + c * 128;
        if (w == 0) {
            const float d0 = pd0, d1 = pd1;
            const float s = (d0 + d1) * a; float v = s;
#pragma unroll
            for (int off = 1; off < 64; off <<= 1) { const float t = __shfl_up(v, off); if (lane >= off) v += t; }
            const float excl = v - s;
            acs[2 * lane] = excl + d0 * a; acs[2 * lane + 1] = v; dts[2 * lane] = d0; dts[2 * lane + 1] = d1;
        }
#pragma unroll
        for (int pt = 0; pt < 2; ++pt) { u32x2 o; o.x = pk2(Hacc[pt][0], Hacc[pt][1]); o.y = pk2(Hacc[pt][2], Hacc[pt][3]); *(u32x2*)(Ht + (w * 16 + fr) * X_STR + pt * 16 + fq * 4) = o; }
#pragma unroll
        for (int i = 0; i < 4; ++i) { *(u32x4*)(Cs + (ls + i * 32) * CS_STR + ln8) = pc[i]; *(u32x4*)(Bs + (ls + i * 32) * CS_STR + ln8) = pb[i]; }
        LDS_BARRIER();
        {
            float x[8], xa[8], xb[8]; unpack8(px, x);
            const float dtv = dts[xs], dec = __expf(acs[127] - acs[xs]) * dtv;
#pragma unroll
            for (int e = 0; e < 8; ++e) { xa[e] = x[e] * dtv; xb[e] = x[e] * dec; }
            *(u32x4*)(Xd + xs * X_STR + xp8) = pack8(xa);
            *(u32x4*)(X2 + xs * X_STR + xp8) = pack8(xb);
        }
        if (c < 15) SSD_PREFETCH(c + 1);
        bf16x8 Cf[4];
#pragma unroll
        for (int kk = 0; kk < 4; ++kk) Cf[kk] = *(const bf16x8*)(Cs + (w * 16 + fr) * CS_STR + kk * 32 + fq * 8);
        const int lrow = w * 16 + fr; const float al = acs[lrow];
        bf16x8 Gf[4];
#pragma unroll
        for (int kk = 0; kk < 4; ++kk) {
            u32x2 half[2];
#pragma unroll
            for (int hh = 0; hh < 2; ++hh) {
                const int st = 2 * kk + hh;
                half[hh].x = 0u; half[hh].y = 0u;
                if (st <= w) {
                    f32x4 ga = (f32x4){0.f, 0.f, 0.f, 0.f};
#pragma unroll
                    for (int k2 = 0; k2 < 4; ++k2) { const bf16x8 Bf = *(const bf16x8*)(Bs + (st * 16 + fr) * CS_STR + k2 * 32 + fq * 8); ga = __builtin_amdgcn_mfma_f32_16x16x32_bf16(Bf, Cf[k2], ga, 0, 0, 0); }
                    const int s0 = st * 16 + fq * 4; const f32x4 as4 = *(const f32x4*)(acs + s0);
                    float gv[4];
#pragma unroll
                    for (int j = 0; j < 4; ++j) gv[j] = (s0 + j <= lrow) ? ga[j] * __expf(al - as4[j]) : 0.f;
                    half[hh].x = pk2(gv[0], gv[1]); half[hh].y = pk2(gv[2], gv[3]);
                }
            }
            u32x4 g4; g4.x = half[0].x; g4.y = half[0].y; g4.z = half[1].x; g4.w = half[1].y;
            Gf[kk] = __builtin_bit_cast(bf16x8, g4);
        }
        LDS_BARRIER();
        {
            f32x4 Yd[2], Yo[2];
            Yd[0] = Yd[1] = Yo[0] = Yo[1] = (f32x4){0.f, 0.f, 0.f, 0.f};
            const int nkk = (w >> 1) + 1;
#pragma unroll
            for (int kk = 0; kk < 4; ++kk) {
                if (kk < nkk) {
#pragma unroll
                    for (int pt = 0; pt < 2; ++pt) {
                        const bf16_t* base = Xd + (kk * 32 + fq * 4 + q4) * X_STR + pt * 16 + p4 * 4;
                        bf16x8 Xf; Xf.lo = tr_read(base); Xf.hi = tr_read(base + 16 * X_STR);
                        Yd[pt] = __builtin_amdgcn_mfma_f32_16x16x32_bf16(Xf, Gf[kk], Yd[pt], 0, 0, 0);
                    }
                }
            }
#pragma unroll
            for (int kk = 0; kk < 4; ++kk)
#pragma unroll
                for (int pt = 0; pt < 2; ++pt) {
                    const bf16_t* hbp = Ht + (kk * 32 + fq * 8 + q4) * X_STR + pt * 16 + p4 * 4;
                    bf16x8 Hf; Hf.lo = tr_read(hbp); Hf.hi = tr_read(hbp + 4 * X_STR);
                    Yo[pt] = __builtin_amdgcn_mfma_f32_16x16x32_bf16(Hf, Cf[kk], Yo[pt], 0, 0, 0);
                }
            const float el = __expf(al); const float rdt = Dh / dts[lrow];
#pragma unroll
            for (int pt = 0; pt < 2; ++pt) {
                const u32x2 xr = *(const u32x2*)(Xd + lrow * X_STR + pt * 16 + fq * 4);
                const f32x4 y = Yd[pt] + el * Yo[pt] + rdt * (f32x4){bflo(xr.x), bfhi(xr.x), bflo(xr.y), bfhi(xr.y)};
                u32x2 o; o.x = pk2(y[0], y[1]); o.y = pk2(y[2], y[3]);
                *(u32x2*)(ybuf + (size_t)(t0 + lrow) * 1024 + hd * 64 + ph * 32 + pt * 16 + fq * 4) = o;
            }
        }
        {
            const float dc = __expf(acs[127]);
            Hacc[0] *= dc; Hacc[1] *= dc;
#pragma unroll
            for (int kk = 0; kk < 4; ++kk) {
                const bf16_t* bb = Bs + (kk * 32 + fq * 8 + q4) * CS_STR + w * 16 + p4 * 4;
                bf16x8 Bf; Bf.lo = tr_read(bb); Bf.hi = tr_read(bb + 4 * CS_STR);
#pragma unroll
                for (int pt = 0; pt < 2; ++pt) {
                    const bf16_t* xb = X2 + (kk * 32 + fq * 8 + q4) * X_STR + pt * 16 + p4 * 4;
                    bf16x8 Xf; Xf.lo = tr_read(xb); Xf.hi = tr_read(xb + 4 * X_STR);
                    Hacc[pt] = __builtin_amdgcn_mfma_f32_16x16x32_bf16(Xf, Bf, Hacc[pt], 0, 0, 0);
                }
            }
        }
        LDS_BARRIER();
    }
#undef SSD_PREFETCH
    float* so = P->out + O_SSMP + ((size_t)(b * 16 + hd) * 64 + ph * 32) * 128;
#pragma unroll
    for (int pt = 0; pt < 2; ++pt)
#pragma unroll
        for (int j = 0; j < 4; ++j) so[(size_t)(pt * 16 + fq * 4 + j) * 128 + w * 16 + fr] = Hacc[pt][j];
}

template <int NI>
__device__ __forceinline__ void ssd_sample(PP P, int item0, int istride, const int tid) {
    const int p = tid >> 3, n0 = (tid & 7) * 16;
    char* ws = P->ws;
    const bf16_t* xact = (const bf16_t*)(ws + W_XACT);
    const float* dtb = (const float*)(ws + W_DT);
    bf16_t* ybuf = (bf16_t*)(ws + W_Y);
    f32x4 hs[NI][4]; u32x4 rb[NI][4][2], rc[NI][4][2]; float xv[NI][4], dtv[NI][4];
#pragma unroll
    for (int q = 0; q < NI; ++q) {
        const int item = item0 + q * istride, b = item >> 4, hd = item & 15, g = hd >> 3;
        const size_t sidx = ((size_t)(b * 16 + hd) * 64 + p) * 128 + n0;
#pragma unroll
        for (int i = 0; i < 4; ++i) hs[q][i] = __builtin_nontemporal_load((const f32x4*)(P->state_ssm + sidx + i * 4));
#pragma unroll
        for (int i = 0; i < 4; ++i) {
            const int t = TP + b * 4 + i;
            xv[q][i] = bf2f(xact[(size_t)t * 1536 + hd * 64 + p]);
            dtv[q][i] = dtb[(size_t)t * 16 + hd];
            rb[q][i][0] = ld8(xact + (size_t)t * 1536 + 1024 + g * 128 + n0); rb[q][i][1] = ld8(xact + (size_t)t * 1536 + 1024 + g * 128 + n0 + 8);
            rc[q][i][0] = ld8(xact + (size_t)t * 1536 + 1280 + g * 128 + n0); rc[q][i][1] = ld8(xact + (size_t)t * 1536 + 1280 + g * 128 + n0 + 8);
        }
    }
#pragma unroll
    for (int q = 0; q < NI; ++q) {
        const int item = item0 + q * istride, b = item >> 4, hd = item & 15;
        const float a = -expf(P->a_log[hd]);
        const float Dh = P->ssm_d[hd];
        const size_t sidx = ((size_t)(b * 16 + hd) * 64 + p) * 128 + n0;
        float h[16];
#pragma unroll
        for (int i = 0; i < 4; ++i) { h[i * 4] = hs[q][i][0]; h[i * 4 + 1] = hs[q][i][1]; h[i * 4 + 2] = hs[q][i][2]; h[i * 4 + 3] = hs[q][i][3]; }
#pragma unroll
        for (int i = 0; i < 4; ++i) {
            const int t = TP + b * 4 + i;
            const float dA = __expf(dtv[q][i] * a), dx = dtv[q][i] * xv[q][i];
            float Bv[16], Cv[16];
            { float t8[8]; unpack8(rb[q][i][0], t8);
#pragma unroll
              for (int e = 0; e < 8; ++e) Bv[e] = t8[e];
              unpack8(rb[q][i][1], t8);
#pragma unroll
              for (int e = 0; e < 8; ++e) Bv[8 + e] = t8[e];
              unpack8(rc[q][i][0], t8);
#pragma unroll
              for (int e = 0; e < 8; ++e) Cv[e] = t8[e];
              unpack8(rc[q][i][1], t8);
#pragma unroll
              for (int e = 0; e < 8; ++e) Cv[8 + e] = t8[e]; }
            float part = 0.f;
#pragma unroll
            for (int e = 0; e < 16; ++e) { h[e] = h[e] * dA + dx * Bv[e]; part += h[e] * Cv[e]; }
            part += __shfl_xor(part, 1); part += __shfl_xor(part, 2); part += __shfl_xor(part, 4);
            if ((tid & 7) == 0) ybuf[(size_t)t * 1024 + hd * 64 + p] = f2bf(part + Dh * xv[q][i]);
        }
        float* so = P->out + O_SSMS + sidx;
#pragma unroll
        for (int i = 0; i < 4; ++i) __builtin_nontemporal_store((f32x4){h[i * 4], h[i * 4 + 1], h[i * 4 + 2], h[i * 4 + 3]}, (f32x4*)(so + i * 4));
    }
}

__device__ __forceinline__ void phase_gatednorm(PP P, int gw, int nw, const int tid) {
    const int lane = tid & 63;
    char* ws = P->ws;
    const bf16_t* ybuf = (const bf16_t*)(ws + W_Y); const bf16_t* zbuf = (const bf16_t*)(ws + W_Z);
    bf16_t* mix = (bf16_t*)(ws + W_MIX);
    for (int row0 = gw; row0 < TT; row0 += 4 * nw) {
        u32x2 yv[4][4], zv[4][4];
#pragma unroll
        for (int r = 0; r < 4; ++r) { const int row = row0 + r * nw; if (row < TT) {
#pragma unroll
            for (int j = 0; j < 4; ++j) { yv[r][j] = *(const u32x2*)(ybuf + (size_t)row * 1024 + j * 256 + lane * 4); zv[r][j] = *(const u32x2*)(zbuf + (size_t)row * 1024 + j * 256 + lane * 4); } } }
#pragma unroll
        for (int r = 0; r < 4; ++r) { const int row = row0 + r * nw; if (row < TT) {
            float t[4][4]; float ss0 = 0.f, ss1 = 0.f;
#pragma unroll
            for (int j = 0; j < 4; ++j) {
                const float y0 = bflo(yv[r][j].x), y1 = bfhi(yv[r][j].x), y2 = bflo(yv[r][j].y), y3 = bfhi(yv[r][j].y);
                const float z0 = bflo(zv[r][j].x), z1 = bfhi(zv[r][j].x), z2 = bflo(zv[r][j].y), z3 = bfhi(zv[r][j].y);
                t[j][0] = y0 * silu_f(z0); t[j][1] = y1 * silu_f(z1); t[j][2] = y2 * silu_f(z2); t[j][3] = y3 * silu_f(z3);
                const float q = t[j][0] * t[j][0] + t[j][1] * t[j][1] + t[j][2] * t[j][2] + t[j][3] * t[j][3];
                if (j < 2) ss0 += q; else ss1 += q;
            }
            ss0 = wave_sum(ss0); ss1 = wave_sum(ss1);
            const float r0 = rsqrtf(ss0 * (1.0f / 512.0f) + EPS), r1 = rsqrtf(ss1 * (1.0f / 512.0f) + EPS);
#pragma unroll
            for (int j = 0; j < 4; ++j) {
                const float rr = j < 2 ? r0 : r1;
                const f32x4 g4 = *(const f32x4*)(P->ssm_norm + j * 256 + lane * 4);
                u32x2 o; o.x = pk2(t[j][0] * rr * g4[0], t[j][1] * rr * g4[1]); o.y = pk2(t[j][2] * rr * g4[2], t[j][3] * rr * g4[3]);
                *(u32x2*)(mix + (size_t)row * 2048 + j * 256 + lane * 4) = o;
            }
        } }
    }
}

__device__ __forceinline__ void phase_norm(PP P, const float* gain, bool final_out, int gw, int nw, const int tid) {
    const int lane = tid & 63;
    char* ws = P->ws;
    const bf16_t* hb = (const bf16_t*)(ws + W_H);
    const float* ss3 = (const float*)(ws + W_SS3);
    for (int row0 = gw; row0 < TT; row0 += 4 * nw) {
        u32x2 xv[4][4]; float sq[4];
#pragma unroll
        for (int r = 0; r < 4; ++r) { const int row = row0 + r * nw; if (row < TT) { sq[r] = ss3[row];
#pragma unroll
            for (int j = 0; j < 4; ++j) xv[r][j] = *(const u32x2*)(hb + (size_t)row * 1024 + j * 256 + lane * 4); } }
#pragma unroll
        for (int r = 0; r < 4; ++r) { const int row = row0 + r * nw; if (row < TT) {
            const float rstd = rsqrtf(sq[r] * (1.0f / 1024.0f) + EPS);
#pragma unroll
            for (int j = 0; j < 4; ++j) {
                const f32x4 g4 = *(const f32x4*)(gain + j * 256 + lane * 4);
                const f32x4 x = (f32x4){bflo(xv[r][j].x), bfhi(xv[r][j].x), bflo(xv[r][j].y), bfhi(xv[r][j].y)};
                __builtin_nontemporal_store(x * rstd * g4, (f32x4*)(P->out + O_YP + (size_t)row * 1024 + j * 256 + lane * 4));
            }
        } }
    }
}

__device__ __forceinline__ void attn_sample(PP P, int item, char* shm, const int tid) {
    const int w = tid >> 6, lane = tid & 63, fr = lane & 15, fq = lane >> 4;
    const int b = item >> 2, hh = item & 3;
    char* ws = P->ws;
    const bf16_t* qb = (const bf16_t*)(ws + W_Q);
    float* sc = (float*)shm;
    float* part = (float*)(shm + 4096);
    const float* vp = P->cache_v + ((size_t)(b * 256 + w * 32) * 4 + hh) * 256 + lane * 4;
    f32x4 v0[16], v1[16];
#pragma unroll
    for (int mm = 0; mm < 16; ++mm) v0[mm] = __builtin_nontemporal_load((const f32x4*)(vp + (size_t)mm * 1024));
    bf16x8 qf[8];
#pragma unroll
    for (int kk = 0; kk < 8; ++kk) {
        bf16x8 z = {0, 0, 0, 0, 0, 0, 0, 0};
        if (fr < 4) z = *(const bf16x8*)(qb + (size_t)(TP + b * 4 + fr) * 1024 + hh * 256 + kk * 32 + fq * 8);
        qf[kk] = z;
    }
#pragma unroll
    for (int mt = 0; mt < 2; ++mt) {
        const int key = w * 32 + mt * 16 + fr;
        const float* kp = P->cache_k + ((size_t)(b * 256 + key) * 4 + hh) * 256 + fq * 8;
        f32x4 k0[8], k1[8];
#pragma unroll
        for (int kk = 0; kk < 8; ++kk) { k0[kk] = __builtin_nontemporal_load((const f32x4*)(kp + kk * 32)); k1[kk] = __builtin_nontemporal_load((const f32x4*)(kp + kk * 32 + 4)); }
        f32x4 acc = (f32x4){0.f, 0.f, 0.f, 0.f};
#pragma unroll
        for (int kk = 0; kk < 8; ++kk) {
            u32x4 pk; pk.x = pk2(k0[kk][0], k0[kk][1]); pk.y = pk2(k0[kk][2], k0[kk][3]); pk.z = pk2(k1[kk][0], k1[kk][1]); pk.w = pk2(k1[kk][2], k1[kk][3]);
            acc = __builtin_amdgcn_mfma_f32_16x16x32_bf16(qf[kk], __builtin_bit_cast(bf16x8, pk), acc, 0, 0, 0);
        }
        if (fq == 0) {
#pragma unroll
            for (int j = 0; j < 4; ++j) sc[j * 256 + w * 32 + mt * 16 + fr] = acc[j];
        }
    }
    LDS_BARRIER();
#pragma unroll
    for (int mm = 0; mm < 16; ++mm) v1[mm] = __builtin_nontemporal_load((const f32x4*)(vp + (size_t)(16 + mm) * 1024));
    if (w < 4) {
        f32x4 s = *(const f32x4*)(sc + w * 256 + lane * 4);
        float m = fmaxf(fmaxf(s[0], s[1]), fmaxf(s[2], s[3])); m = wave_max(m);
        s[0] = __expf(s[0] - m); s[1] = __expf(s[1] - m); s[2] = __expf(s[2] - m); s[3] = __expf(s[3] - m);
        float su = (s[0] + s[1]) + (s[2] + s[3]); su = wave_sum(su);
        const float inv = 1.0f / su;
        *(f32x4*)(sc + w * 256 + lane * 4) = s * inv;
    }
    LDS_BARRIER();
    {
        f32x4 o[4];
#pragma unroll
        for (int i = 0; i < 4; ++i) o[i] = (f32x4){0.f, 0.f, 0.f, 0.f};
#pragma unroll
        for (int mm = 0; mm < 16; ++mm) {
#pragma unroll
            for (int i = 0; i < 4; ++i) o[i] += sc[i * 256 + w * 32 + mm] * v0[mm];
        }
#pragma unroll
        for (int mm = 0; mm < 16; ++mm) {
#pragma unroll
            for (int i = 0; i < 4; ++i) o[i] += sc[i * 256 + w * 32 + 16 + mm] * v1[mm];
        }
#pragma unroll
        for (int i = 0; i < 4; ++i) *(f32x4*)(part + (w * 4 + i) * 256 + lane * 4) = o[i];
    }
    LDS_BARRIER();
    {
        const int i = tid >> 7, d2 = (tid & 127) * 2;
        float s0 = 0.f, s1 = 0.f;
#pragma unroll
        for (int ww = 0; ww < 8; ++ww) { s0 += part[(ww * 4 + i) * 256 + d2]; s1 += part[(ww * 4 + i) * 256 + d2 + 1]; }
        *(unsigned*)((bf16_t*)(ws + W_O) + (size_t)(TP + b * 4 + i) * 1024 + hh * 256 + d2) = pk2(s0, s1);
    }
    LDS_BARRIER();
}

__device__ __forceinline__ void phase_ffnconv(PP P, int gtid, int nthreads) {
    char* ws = P->ws;
    const bf16_t* u = (const bf16_t*)(ws + W_U);
    bf16_t* act = (bf16_t*)(ws + W_ACT);
    for (int idx = gtid; idx < 1152 * 352; idx += nthreads) {
        const int run = idx / 352, cg = idx % 352;
        const bool samp = run >= 1024;
        int t0, len, bidx, tl0;
        if (!samp) { t0 = run * 16; len = 16; bidx = t0 >> 11; tl0 = t0 & 2047; } else { bidx = run - 1024; t0 = TP + bidx * 4; len = 4; tl0 = 0; }
        const int cgc = cg * 8, cvc = 2816 + cg * 8;
        float wg0[8], wg1[8], wg2[8], wv0[8], wv1[8], wv2[8], bg[8], bv[8], hg0[8], hg1[8], hv0[8], hv1[8];
#pragma unroll
        for (int e = 0; e < 8; ++e) {
            wg0[e] = P->ffn_w[cgc + e]; wg1[e] = P->ffn_w[5632 + cgc + e]; wg2[e] = P->ffn_w[11264 + cgc + e];
            wv0[e] = P->ffn_w[cvc + e]; wv1[e] = P->ffn_w[5632 + cvc + e]; wv2[e] = P->ffn_w[11264 + cvc + e];
            bg[e] = P->ffn_b[cgc + e]; bv[e] = P->ffn_b[cvc + e];
        }
        if (samp) {
#pragma unroll
            for (int e = 0; e < 8; ++e) {
                hg0[e] = P->state_ffn[(size_t)(bidx * 2 + 0) * 5632 + cgc + e]; hg1[e] = P->state_ffn[(size_t)(bidx * 2 + 1) * 5632 + cgc + e];
                hv0[e] = P->state_ffn[(size_t)(bidx * 2 + 0) * 5632 + cvc + e]; hv1[e] = P->state_ffn[(size_t)(bidx * 2 + 1) * 5632 + cvc + e];
            }
        } else if (tl0 > 0) {
            unpack8(ld8(u + (size_t)(t0 - 2) * 5632 + cgc), hg0); unpack8(ld8(u + (size_t)(t0 - 1) * 5632 + cgc), hg1);
            unpack8(ld8(u + (size_t)(t0 - 2) * 5632 + cvc), hv0); unpack8(ld8(u + (size_t)(t0 - 1) * 5632 + cvc), hv1);
        } else {
#pragma unroll
            for (int e = 0; e < 8; ++e) { hg0[e] = 0.f; hg1[e] = 0.f; hv0[e] = 0.f; hv1[e] = 0.f; }
        }
        for (int jb = 0; jb < len; jb += 8) {
        u32x4 rg[8], rv[8];
        const bf16_t* ub = u + (size_t)(t0 + jb) * 5632 + cgc;
#pragma unroll
        for (int jj = 0; jj < 8; ++jj) { if (jb + jj < len) { rg[jj] = ld8(ub + (size_t)jj * 5632); rv[jj] = ld8(ub + (size_t)jj * 5632 + 2816); } }
#pragma unroll
        for (int jj = 0; jj < 8; ++jj) {
            const int j = jb + jj;
            if (j < len) {
            float ug[8], uv[8], o8[8];
            unpack8(rg[jj], ug); unpack8(rv[jj], uv);
#pragma unroll
            for (int e = 0; e < 8; ++e) {
                const float gc = bg[e] + wg0[e] * hg0[e] + wg1[e] * hg1[e] + wg2[e] * ug[e];
                const float vc = bv[e] + wv0[e] * hv0[e] + wv1[e] * hv1[e] + wv2[e] * uv[e];
                o8[e] = silu_f(gc) * vc;
            }
            *(u32x4*)(act + (size_t)(t0 + j) * 2816 + cgc) = pack8(o8);
            float* o = nullptr;
            if (samp) { if (j >= 2) o = P->out + O_FFNS + (size_t)(bidx * 2 + j - 2) * 5632; }
            else { const int tl = tl0 + j; if (tl >= 2046) o = P->out + O_FFNP + (size_t)(bidx * 2 + tl - 2046) * 5632; }
            if (o) {
#pragma unroll
                for (int e = 0; e < 8; ++e) { o[cgc + e] = ug[e]; o[cvc + e] = uv[e]; }
            }
#pragma unroll
            for (int e = 0; e < 8; ++e) { hg0[e] = hg1[e]; hg1[e] = ug[e]; hv0[e] = hv1[e]; hv1[e] = uv[e]; }
            }
        }
        }
    }
}

#define XB_TMO      128
#define XB_XCNT(j)  (256  + 64 * (j))
#define XB_XSUB(j)  (1280 + 64 * (j))
#define XB_XGEN(j)  (2304 + 64 * (j))
#define XB_TOP      3328
#define XB_TOPGEN   3392
#define XCD_BAR_WORDS 3456
#define XB_SPIN_CAP (1u << 18)
__device__ __forceinline__ unsigned xb_ld(unsigned* p)              { return __hip_atomic_load(p, __ATOMIC_RELAXED, __HIP_MEMORY_SCOPE_AGENT); }
__device__ __forceinline__ unsigned xb_add(unsigned* p, unsigned v) { return __hip_atomic_fetch_add(p, v, __ATOMIC_RELAXED, __HIP_MEMORY_SCOPE_AGENT); }
__device__ __forceinline__ unsigned xb_xcc_id() { return (unsigned)__builtin_amdgcn_s_getreg((3 << 11) | 20) & 0xFu; }
#define XB_SPIN(cond, bar) do { unsigned _sp = 0; while (cond) { __builtin_amdgcn_s_sleep(1); \
    if ((++_sp & 255u) == 0u) { if (xb_ld(&(bar)[XB_TMO])) break; if (_sp > XB_SPIN_CAP) { atomicAdd(&(bar)[XB_TMO], 1u); break; } } } } while (0)
__device__ __forceinline__ void xcd_barrier_complete(unsigned* bar, unsigned x, unsigned& nloc, unsigned& nx) {
    const unsigned G = gridDim.x;
    unsigned sum, cnt, mine, sp = 0u;
    for (;;) {
        sum = 0u; cnt = 0u; mine = 0u;
#pragma unroll
        for (unsigned j = 0; j < 16; ++j) { const unsigned c = xb_ld(&bar[XB_XCNT(j)]); sum += c; cnt += (c > 0u) ? 1u : 0u; mine = (j == x) ? c : mine; }
        if (sum == G) break;
        __builtin_amdgcn_s_sleep(1);
        if ((++sp & 255u) == 0u) { if (xb_ld(&bar[XB_TMO])) break; if (sp > XB_SPIN_CAP) { atomicAdd(&bar[XB_TMO], 1u); break; } }
    }
    nloc = mine > 0u ? mine : 1u; nx = cnt > 0u ? cnt : 1u;
}
__device__ __forceinline__ void xcd_barrier(unsigned* bar, volatile LDSB unsigned* st, const int tid) {
    asm volatile("s_waitcnt vmcnt(0)" ::: "memory");
    __syncthreads();
    if (tid == 0) {
        const unsigned x = xb_xcc_id();
        __builtin_amdgcn_s_waitcnt(0);
        unsigned nloc = st[0], nx = st[1];
        if (nloc == 0u) { xcd_barrier_complete(bar, x, nloc, nx); st[0] = nloc; st[1] = nx; }
        const unsigned old = xb_add(&bar[XB_XSUB(x)], 1u);
        const unsigned gen = old / nloc;
        if (old + 1u == (gen + 1u) * nloc) {
            __builtin_amdgcn_fence(__ATOMIC_RELEASE, "agent");
            asm volatile("s_waitcnt vmcnt(0)" ::: "memory");
            const unsigned og = xb_add(&bar[XB_TOP], 1u);
            const unsigned tg = og / nx;
            if (og + 1u == (tg + 1u) * nx) xb_add(&bar[XB_TOPGEN], 1u);
            else XB_SPIN(xb_ld(&bar[XB_TOPGEN]) == tg, bar);
            __builtin_amdgcn_fence(__ATOMIC_ACQUIRE, "agent");
            xb_add(&bar[XB_XGEN(x)], 1u);
            asm volatile("s_waitcnt vmcnt(0)" ::: "memory");
        } else {
            XB_SPIN(xb_ld(&bar[XB_XGEN(x)]) == gen, bar);
            __builtin_amdgcn_fence(__ATOMIC_ACQUIRE, "agent");
            asm volatile("s_waitcnt vmcnt(0)" ::: "memory");
        }
    }
    __syncthreads();
}

extern __shared__ __attribute__((aligned(16))) char smem[];

__global__ void __launch_bounds__(NTHR) hybrid_fwd(Params Pin) {
    char* shm = smem;
    volatile LDSB unsigned* bst = (volatile LDSB unsigned*)(smem + 139264);
    if (threadIdx.x == 0) { bst[0] = 0u; bst[1] = 0u; (void)xb_add((unsigned*)(Pin.ws + W_BAR) + XB_XCNT(xb_xcc_id()), 1u); }
    __syncthreads();
    for (int ph = Pin.ph_lo; ph < Pin.ph_hi; ++ph) {
        if (ph == 6 || ph == 11) continue;
        const int reps = ((REPEAT_MASK >> ph) & 1) ? 2 : 1;
        for (int rep = 0; rep < reps; ++rep) {
        if (rep > 0) xcd_barrier((unsigned*)(Pin.ws + W_BAR), bst, threadIdx.x);
        int tid = threadIdx.x, blk = blockIdx.x, nblk = gridDim.x;
        asm volatile("" : "+v"(tid));
        asm volatile("" : "+s"(blk), "+s"(nblk));
        PP P = (PP)__builtin_amdgcn_kernarg_segment_ptr();
        asm volatile("" : "+s"(P));
        const int lb = (blk & 7) * (nblk >> 3) + (blk >> 3);
        const int gtid = blk * NTHR + tid, nthreads = nblk * NTHR;
        const int gw = blk * 8 + (tid >> 6), nw = nblk * 8;
        switch (ph) {
#if PHASE_MASK & 1
        case 0: phase_prep(P, shm, blk, nblk, tid); break;
#endif
#if PHASE_MASK & 4
        case 2: phase_convpool(P, gtid, nthreads); break;
#endif
#if PHASE_MASK & 8
        case 3:
            if (blk & 1) { int it = blk; for (; it + nblk < 2048; it += 2 * nblk) ssd_sample<2>(P, it, nblk, tid); for (; it < 2048; it += nblk) ssd_sample<1>(P, it, nblk, tid); }
            for (int it = blk; it < 256; it += nblk) ssd_prompt(P, it, shm, tid);
            if (!(blk & 1)) { int it = blk; for (; it + nblk < 2048; it += 2 * nblk) ssd_sample<2>(P, it, nblk, tid); for (; it < 2048; it += nblk) ssd_sample<1>(P, it, nblk, tid); }
            break;
#endif
#if PHASE_MASK & 16
        case 4: phase_gatednorm(P, gw, nw, tid); break;
#endif
#if PHASE_MASK & 64
        case 6: phase_norm(P, P->norm_mem, false, gw, nw, tid); break;
        case 11: phase_norm(P, P->norm_ffn, false, gw, nw, tid); break;
        case 15: phase_norm(P, P->final_norm, true, gw, nw, tid); break;
#endif
#if PHASE_MASK & 8192
        case 13: phase_ffnconv(P, gtid, nthreads); break;
#endif
        default: break;
        }
#if PHASE_MASK & 256
        if (ph == 8 && (blk & 1)) { for (int it = blk; it < 512; it += nblk) attn_sample(P, it, shm, tid); __syncthreads(); }
#endif
#if PHASE_MASK & 2
        if (ph == 1 || ph == 5 || ph == 7 || ph == 8 || ph == 9 || ph == 10 || ph == 12 || ph == 14) gemm_phase(P, ph, shm, lb, blk, nblk, tid);
#endif
#if PHASE_MASK & 256
        if (ph == 9 && !(blk & 1)) { for (int it = blk; it < 512; it += nblk) attn_sample(P, it, shm, tid); }
#endif
        }
        if (ph + 1 < Pin.ph_hi && ph != 8) xcd_barrier((unsigned*)(Pin.ws + W_BAR), bst, threadIdx.x);
        if (ph == 8) { asm volatile("s_waitcnt vmcnt(0)" ::: "memory"); __syncthreads(); }
        if (EXTRA_SYNCS && ph == 0) { for (int i = 0; i < EXTRA_SYNCS; ++i) xcd_barrier((unsigned*)(Pin.ws + W_BAR), bst, threadIdx.x); }
    }
}

extern "C" void kernel_launch(void* const* d_in, const int* in_sizes, int n_in, void* d_out, int out_size, void* d_ws, size_t ws_size, hipStream_t stream) {
    static int grid_blocks = 0;
    if (!grid_blocks) {
        int dev = 0, cus = 0, per_cu = 0;
        hipGetDevice(&dev);
        hipDeviceGetAttribute(&cus, hipDeviceAttributeMultiprocessorCount, dev);
        hipFuncSetAttribute((const void*)hybrid_fwd, hipFuncAttributeMaxDynamicSharedMemorySize, LDS_BYTES);
        hipOccupancyMaxActiveBlocksPerMultiprocessor(&per_cu, hybrid_fwd, NTHR, LDS_BYTES);
        if (per_cu < 1) per_cu = 1;
        grid_blocks = cus * 1;
        grid_blocks &= ~7;
        if (grid_blocks < 8) grid_blocks = 8;
    }
    Params p{};
    const float* const* in = (const float* const*)d_in;
    p.x_prompt = in[0]; p.x_sample = in[1]; p.mem_prompt = in[2]; p.state_ssm = in[3]; p.state_conv = in[4]; p.state_pool = in[5]; p.state_ffn = in[6];
    p.cache_k = in[7]; p.cache_v = in[8]; p.norm_mix = in[9]; p.w_in = in[10]; p.conv_w = in[11]; p.conv_b = in[12]; p.dt_bias = in[13]; p.a_log = in[14];
    p.ssm_d = in[15]; p.ssm_norm = in[16]; p.w_pool = in[17]; p.pool_scale = in[18]; p.w_out = in[19]; p.norm_mem = in[20]; p.norm_memkv = in[21];
    p.w_mq = in[22]; p.w_mk = in[23]; p.w_mv = in[24]; p.w_mo = in[25]; p.norm_ffn = in[26]; p.w_up = in[27]; p.ffn_w = in[28]; p.ffn_b = in[29];
    p.w_down = in[30]; p.final_norm = in[31];
    p.out = (float*)d_out; p.ws = (char*)d_ws; p.ph_lo = 0; p.ph_hi = 16;
    hipMemsetAsync((char*)d_ws + W_BAR, 0, 16384, stream);
    void* args[] = {&p};
    hipError_t e = hipLaunchCooperativeKernel((const void*)hybrid_fwd, dim3(grid_blocks), dim3(NTHR), args, LDS_BYTES, stream);
    if (e != hipSuccess) fprintf(stderr, "cooperative launch failed: %s (grid %d)\n", hipGetErrorString(e), grid_blocks);
}
```

```cpp
#include <hip/hip_runtime.h>
#include <hip/hip_cooperative_groups.h>
#include <cstdio>
namespace cg = cooperative_groups;

typedef unsigned short bf16_t;
typedef short bf16x8 __attribute__((ext_vector_type(8)));
typedef short s16x4 __attribute__((ext_vector_type(4)));
typedef float f32x4 __attribute__((ext_vector_type(4)));
typedef unsigned u32x4 __attribute__((ext_vector_type(4)));
typedef unsigned u32x2 __attribute__((ext_vector_type(2)));
#define LDSB __attribute__((address_space(3)))

constexpr int TP = 16384, TS = 512, TT = TP + TS;
constexpr int NTHR = 512;
constexpr int LDS_BYTES = 139264 + 256;
constexpr float EPS = 1e-6f;
#ifndef PHASE_MASK
#define PHASE_MASK 0xFFFF
#endif
#ifndef REPEAT_MASK
#define REPEAT_MASK 0
#endif
#ifndef PROBE3
#define PROBE3 0
#endif
#ifndef EXTRA_SYNCS
#define EXTRA_SYNCS 0
#endif

constexpr size_t O_YP = 0;
constexpr size_t O_YS = O_YP + (size_t)TP * 1024;
constexpr size_t O_SSMP = O_YS + (size_t)TS * 1024;
constexpr size_t O_SSMS = O_SSMP + (size_t)8 * 16 * 64 * 128;
constexpr size_t O_CONVP = O_SSMS + (size_t)128 * 16 * 64 * 128;
constexpr size_t O_CONVS = O_CONVP + (size_t)8 * 3 * 1536;
constexpr size_t O_POOLP = O_CONVS + (size_t)128 * 3 * 1536;
constexpr size_t O_POOLS = O_POOLP + (size_t)8 * 15 * 1024;
constexpr size_t O_FFNP = O_POOLS + (size_t)128 * 15 * 1024;
constexpr size_t O_FFNS = O_FFNP + (size_t)8 * 2 * 5632;
constexpr size_t O_MK = O_FFNS + (size_t)128 * 2 * 5632;
constexpr size_t O_MV = O_MK + (size_t)8 * 256 * 1024;

constexpr size_t W_WIN = 0;
constexpr size_t W_WPOOL = W_WIN + (size_t)3584 * 1024 * 2;
constexpr size_t W_WOUT = W_WPOOL + (size_t)4 * 256 * 256 * 2;
constexpr size_t W_WMQ = W_WOUT + (size_t)1024 * 2048 * 2;
constexpr size_t W_WMK = W_WMQ + (size_t)1024 * 1024 * 2;
constexpr size_t W_WMV = W_WMK + (size_t)1024 * 1024 * 2;
constexpr size_t W_WMO = W_WMV + (size_t)1024 * 1024 * 2;
constexpr size_t W_WUP = W_WMO + (size_t)1024 * 1024 * 2;
constexpr size_t W_WDOWN = W_WUP + (size_t)5632 * 1024 * 2;
constexpr size_t W_H = W_WDOWN + (size_t)1024 * 2816 * 2;
constexpr size_t W_HM = W_H + (size_t)TT * 1024 * 2;
constexpr size_t W_KB = W_HM + (size_t)2048 * 1024 * 2;
constexpr size_t W_VT = W_KB + (size_t)2048 * 1024 * 2;
constexpr size_t W_DT = W_VT + (size_t)2048 * 1024 * 2;
constexpr size_t W_XRES = W_DT + (size_t)TT * 16 * 4;
constexpr size_t W_ARENA = W_XRES + (size_t)TT * 1024 * 4;
constexpr size_t W_Z = W_ARENA;
constexpr size_t W_PROJ2 = W_Z + (size_t)TT * 1024 * 2;
constexpr size_t W_XACT = W_PROJ2 + (size_t)TT * 2560 * 2;
constexpr size_t W_POOLED = W_XACT + (size_t)TT * 1536 * 2;
constexpr size_t W_Y = W_POOLED + (size_t)TT * 1024 * 2;
constexpr size_t W_MIX = W_Y + (size_t)TT * 1024 * 2;
constexpr size_t W_END_A = W_MIX + (size_t)TT * 2048 * 2;
constexpr size_t W_Q = W_PROJ2;
constexpr size_t W_P = W_Q + (size_t)TT * 1024 * 2;
constexpr size_t W_O = W_P + (size_t)TP * 1024 * 2;
constexpr size_t W_U = W_ARENA;
constexpr size_t W_ACT = W_U + (size_t)TT * 5632 * 2;
constexpr size_t W_END_C = W_ACT + (size_t)TT * 2816 * 2;
constexpr size_t W_BAR = W_END_A;
constexpr size_t W_SS1 = W_BAR + 16384;
constexpr size_t W_SS2 = W_SS1 + (size_t)TT * 4;
constexpr size_t W_SS3 = W_SS2 + (size_t)TT * 4;
constexpr size_t W_WLO = W_SS3 + (size_t)TT * 4;
constexpr size_t W_TOTAL = W_WLO + (size_t)1024 * 1024 * 2;
static_assert(W_O + (size_t)TT * 1024 * 2 <= W_POOLED, "era B overflow");
static_assert(W_END_C <= W_END_A, "era C overflow");

struct Params {
    const float *x_prompt, *x_sample, *mem_prompt, *state_ssm, *state_conv, *state_pool, *state_ffn, *cache_k, *cache_v;
    const float *norm_mix, *w_in, *conv_w, *conv_b, *dt_bias, *a_log, *ssm_d, *ssm_norm, *w_pool, *pool_scale, *w_out;
    const float *norm_mem, *norm_memkv, *w_mq, *w_mk, *w_mv, *w_mo, *norm_ffn, *w_up, *ffn_w, *ffn_b, *w_down, *final_norm;
    float* out;
    char* ws;
    int ph_lo, ph_hi;
};

typedef const __attribute__((address_space(4))) Params* PP;

__device__ __forceinline__ unsigned pk2(float lo, float hi) { unsigned r; asm("v_cvt_pk_bf16_f32 %0, %1, %2" : "=v"(r) : "v"(lo), "v"(hi)); return r; }
__device__ __forceinline__ bf16_t f2bf(float f) { return (bf16_t)(pk2(f, 0.f) & 0xffffu); }
__device__ __forceinline__ float bf2f(bf16_t b) { return __uint_as_float(((unsigned)b) << 16); }
__device__ __forceinline__ float bflo(unsigned u) { return __uint_as_float(u << 16); }
__device__ __forceinline__ float bfhi(unsigned u) { return __uint_as_float(u & 0xffff0000u); }
__device__ __forceinline__ void unpack8(u32x4 v, float (&f)[8]) {
    f[0] = bflo(v.x); f[1] = bfhi(v.x); f[2] = bflo(v.y); f[3] = bfhi(v.y); f[4] = bflo(v.z); f[5] = bfhi(v.z); f[6] = bflo(v.w); f[7] = bfhi(v.w);
}
__device__ __forceinline__ u32x4 pack8(const float (&f)[8]) { u32x4 r; r.x = pk2(f[0], f[1]); r.y = pk2(f[2], f[3]); r.z = pk2(f[4], f[5]); r.w = pk2(f[6], f[7]); return r; }
__device__ __forceinline__ float wave_sum(float v) {
#pragma unroll
    for (int o = 1; o < 64; o <<= 1) v += __shfl_xor(v, o);
    return v;
}
__device__ __forceinline__ float wave_max(float v) {
#pragma unroll
    for (int o = 1; o < 64; o <<= 1) v = fmaxf(v, __shfl_xor(v, o));
    return v;
}
__device__ __forceinline__ float silu_f(float x) { return x / (1.0f + __expf(-x)); }

constexpr int HTB = 128 * 64 * 2;
__device__ __forceinline__ int lds_byte(int r, int c) { const int st = (r >> 4) * 2 + (c >> 5), rr = r & 15, cc = c & 31, ob = rr * 64 + cc * 2; return st * 1024 + (ob ^ (((ob >> 9) & 1) << 5)); }
__device__ __forceinline__ void stage_rc(int b, int& R, int& C) { const int st = b / 1024, sb = b % 1024, swz = sb ^ (((sb >> 9) & 1) << 5); R = (st >> 1) * 16 + swz / 64; C = (st & 1) * 32 + (swz % 64) / 2; }

__device__ __forceinline__ int perm32(int rho) { const int n = rho >> 4, i = rho & 15; return 8 * (i >> 2) + 4 * n + (i & 3); }
__device__ __forceinline__ int invperm32(int c) { return 16 * ((c >> 2) & 1) + 4 * (c >> 3) + (c & 3); }
enum { E_PROJ = 0, E_MEMKV, E_POOL, E_OUT, E_Q, E_QK, E_PV, E_MO, E_UP, E_DOWN, E_FOLD };

template <int EK>
__device__ __forceinline__ float epi_apply(PP P, int row, int col, f32x4 v) {
    char* ws = P->ws;
    if constexpr (EK == E_PROJ) {
        u32x2 o; o.x = pk2(v[0], v[1]); o.y = pk2(v[2], v[3]);
        if (col < 1024) *(u32x2*)((bf16_t*)(ws + W_Z) + (size_t)row * 1024 + col) = o;
        else *(u32x2*)((bf16_t*)(ws + W_PROJ2) + (size_t)row * 2560 + (col - 1024)) = o;
    } else if constexpr (EK == E_MEMKV) {
        if (col < 1024) {
            *(f32x4*)(P->out + O_MK + (size_t)row * 1024 + col) = v;
            u32x2 o; o.x = pk2(v[0], v[1]); o.y = pk2(v[2], v[3]);
            *(u32x2*)((bf16_t*)(ws + W_KB) + (size_t)((row & ~31) + invperm32(row & 31)) * 1024 + col) = o;
        } else {
            const int c = col - 1024;
            *(f32x4*)(P->out + O_MV + (size_t)row * 1024 + c) = v;
            const int b = row >> 8, m = row & 255, hh = c >> 8, d = c & 255;
            bf16_t* vt = (bf16_t*)(ws + W_VT) + ((size_t)(b * 4 + hh) * 256 + (d & ~31) + invperm32(d & 31)) * 256 + m;
#pragma unroll
            for (int j = 0; j < 4; ++j) vt[j * 256] = f2bf(v[j]);
        }
    } else if constexpr (EK == E_POOL) {
        const f32x4 sc = *(const f32x4*)(P->pool_scale + col);
        u32x2 o; o.x = pk2(v[0] * sc[0], v[1] * sc[1]); o.y = pk2(v[2] * sc[2], v[3] * sc[3]);
        *(u32x2*)((bf16_t*)(ws + W_MIX) + (size_t)row * 2048 + 1024 + col) = o;
    } else if constexpr (EK == E_OUT) {
        const float* xin = row < TP ? P->x_prompt + (size_t)row * 1024 : P->x_sample + (size_t)(row - TP) * 1024;
        const f32x4 x = *(const f32x4*)(xin + col) + v;
        u32x2 o; o.x = pk2(x[0], x[1]); o.y = pk2(x[2], x[3]);
        *(u32x2*)((bf16_t*)(ws + W_H) + (size_t)row * 1024 + col) = o;
        return (x[0] * x[0] + x[1] * x[1]) + (x[2] * x[2] + x[3] * x[3]);
    } else if constexpr (EK == E_Q) {
        u32x2 o; o.x = pk2(v[0], v[1]); o.y = pk2(v[2], v[3]);
        *(u32x2*)((bf16_t*)(ws + W_Q) + (size_t)row * 1024 + col) = o;
    } else if constexpr (EK == E_PV) {
        u32x2 o; o.x = pk2(v[0], v[1]); o.y = pk2(v[2], v[3]);
        *(u32x2*)((bf16_t*)(ws + W_O) + (size_t)row * 1024 + col) = o;
    } else if constexpr (EK == E_MO || EK == E_DOWN) {
        u32x2* hp = (u32x2*)((bf16_t*)(ws + W_H) + (size_t)row * 1024 + col);
        const u32x2 hv = *hp;
        const f32x4 x = (f32x4){bflo(hv.x), bfhi(hv.x), bflo(hv.y), bfhi(hv.y)} + v;
        u32x2 o; o.x = pk2(x[0], x[1]); o.y = pk2(x[2], x[3]);
        *hp = o;
        return (x[0] * x[0] + x[1] * x[1]) + (x[2] * x[2] + x[3] * x[3]);
    } else if constexpr (EK == E_UP) {
        u32x2 o; o.x = pk2(v[0], v[1]); o.y = pk2(v[2], v[3]);
        *(u32x2*)((bf16_t*)(ws + W_U) + (size_t)row * 5632 + col) = o;
    }
    return 0.f;
}
template <int EK>
__device__ __forceinline__ float epi_rowscale(PP P, int row) {
    if constexpr (EK == E_Q) return rsqrtf(((const float*)(P->ws + W_SS1))[row] * (1.0f / 1024.0f) + EPS) * 0.0625f;
    else if constexpr (EK == E_UP) return rsqrtf(((const float*)(P->ws + W_SS2))[row] * (1.0f / 1024.0f) + EPS);
    else return 1.0f;
}
__device__ __forceinline__ float epi_apply_rt(PP P, int ekind, int row, int col, f32x4 v) {
    switch (ekind) {
    case E_FOLD: { u32x2 o; o.x = pk2(v[0], v[1]); o.y = pk2(v[2], v[3]); const int prow = (row & ~31) + invperm32(row & 31); *(u32x2*)((bf16_t*)(P->ws + W_WOUT) + (size_t)prow * 2048 + 1024 + col) = o; return 0.f; }
    case E_OUT: return epi_apply<E_OUT>(P, row, col, v);
    case E_Q: return epi_apply<E_Q>(P, row, col, v * epi_rowscale<E_Q>(P, row));
    case E_MO: return epi_apply<E_MO>(P, row, col, v);
    default: return epi_apply<E_DOWN>(P, row, col, v);
    }
}
template <int EK>
__device__ __forceinline__ void epi_loop(PP P, const f32x4 (&acc)[2][2][4][2], int rbase, int cbase, int fq) {
    if constexpr (EK == E_PROJ || EK == E_UP || EK == E_Q || EK == E_PV || EK == E_OUT || EK == E_MO || EK == E_DOWN) {
        const int cb8 = cbase + 4 * fq;
#pragma unroll
        for (int ai = 0; ai < 2; ++ai)
#pragma unroll
            for (int m = 0; m < 4; ++m) {
                const int row = rbase + ai * 128 + m * 16;
                const float rs = epi_rowscale<EK>(P, row);
                float ss = 0.f;
#pragma unroll
                for (int bj = 0; bj < 2; ++bj) {
                    f32x4 v0 = acc[ai][bj][m][0], v1 = acc[ai][bj][m][1];
                    const int col = cb8 + bj * 128;
                    if constexpr (EK == E_PROJ || EK == E_UP || EK == E_Q) { v0 *= rs; v1 *= rs; }
                    if constexpr (EK == E_OUT) {
                        const float* xin = (row < TP ? P->x_prompt + (size_t)row * 1024 : P->x_sample + (size_t)(row - TP) * 1024) + col;
                        v0 += *(const f32x4*)xin; v1 += *(const f32x4*)(xin + 4);
                    }
                    if constexpr (EK == E_MO || EK == E_DOWN) {
                        const u32x4 hv = *(const u32x4*)((const bf16_t*)(P->ws + W_H) + (size_t)row * 1024 + col);
                        v0 += (f32x4){bflo(hv.x), bfhi(hv.x), bflo(hv.y), bfhi(hv.y)}; v1 += (f32x4){bflo(hv.z), bfhi(hv.z), bflo(hv.w), bfhi(hv.w)};
                    }
                    if constexpr (EK == E_OUT || EK == E_MO || EK == E_DOWN) ss += ((v0[0] * v0[0] + v0[1] * v0[1]) + (v0[2] * v0[2] + v0[3] * v0[3])) + ((v1[0] * v1[0] + v1[1] * v1[1]) + (v1[2] * v1[2] + v1[3] * v1[3]));
                    u32x4 o; o.x = pk2(v0[0], v0[1]); o.y = pk2(v0[2], v0[3]); o.z = pk2(v1[0], v1[1]); o.w = pk2(v1[2], v1[3]);
                    if constexpr (EK == E_UP) *(u32x4*)((bf16_t*)(P->ws + W_U) + (size_t)row * 5632 + col) = o;
                    else if constexpr (EK == E_Q) *(u32x4*)((bf16_t*)(P->ws + W_Q) + (size_t)row * 1024 + col) = o;
                    else if constexpr (EK == E_PV) *(u32x4*)((bf16_t*)(P->ws + W_O) + (size_t)row * 1024 + col) = o;
                    else if constexpr (EK == E_PROJ) { if (col < 1024) *(u32x4*)((bf16_t*)(P->ws + W_Z) + (size_t)row * 1024 + col) = o;
                           else *(u32x4*)((bf16_t*)(P->ws + W_PROJ2) + (size_t)row * 2560 + (col - 1024)) = o; }
                    else *(u32x4*)((bf16_t*)(P->ws + W_H) + (size_t)row * 1024 + col) = o;
                }
                if constexpr (EK == E_OUT || EK == E_MO || EK == E_DOWN) {
                    ss += __shfl_xor(ss, 16); ss += __shfl_xor(ss, 32);
                    if (fq == 0) unsafeAtomicAdd((float*)(P->ws + (EK == E_OUT ? W_SS1 : EK == E_MO ? W_SS2 : W_SS3)) + row, ss);
                }
            }
        return;
    }
#pragma unroll
    for (int ai = 0; ai < 2; ++ai)
#pragma unroll
        for (int m = 0; m < 4; ++m) {
            const int row = rbase + ai * 128 + m * 16;
            const float rs = epi_rowscale<EK>(P, row);
            float ss = 0.f;
#pragma unroll
            for (int bj = 0; bj < 2; ++bj)
#pragma unroll
                for (int n = 0; n < 2; ++n) {
                    if constexpr (EK == E_Q || EK == E_UP) ss += epi_apply<EK>(P, row, cbase + bj * 128 + n * 16, acc[ai][bj][m][n] * rs);
                    else ss += epi_apply<EK>(P, row, cbase + bj * 128 + n * 16, acc[ai][bj][m][n]);
                }
            if constexpr (EK == E_OUT || EK == E_MO || EK == E_DOWN) {
                ss += __shfl_xor(ss, 16); ss += __shfl_xor(ss, 32);
                if (fq == 0) unsafeAtomicAdd((float*)(P->ws + (EK == E_OUT ? W_SS1 : EK == E_MO ? W_SS2 : W_SS3)) + row, ss);
            }
        }
}

struct PhaseCfg { const char* A; const char* B; int lda, ldb, K, nbig, nsmall, ncol64, ekind; };
__device__ __forceinline__ PhaseCfg phase_cfg(PP P, int gp) {
    const char* ws = P->ws; PhaseCfg c;
    switch (gp) {
    case 1:  c.A = ws + W_H;      c.B = ws + W_WIN;   c.lda = 1024; c.ldb = 1024; c.K = 1024; c.nbig = 66 * 14 + 64; c.nsmall = 512; c.ncol64 = 16; c.ekind = E_PROJ; break;
    case 3:  c.A = ws + W_POOLED; c.B = ws + W_WPOOL; c.lda = 1024; c.ldb = 256;  c.K = 256;  c.nbig = 256; c.nsmall = 256; c.ncol64 = 16; c.ekind = E_POOL; break;
    case 5:  c.A = ws + W_MIX;    c.B = ws + W_WOUT;  c.lda = 2048; c.ldb = 2048; c.K = 2048; c.nbig = 256; c.nsmall = 256; c.ncol64 = 16; c.ekind = E_OUT; break;
    case 7:  c.A = ws + W_H;      c.B = ws + W_WMQ;   c.lda = 1024; c.ldb = 1024; c.K = 1024; c.nbig = 256; c.nsmall = 256; c.ncol64 = 16; c.ekind = E_Q; break;
    case 8:  c.A = ws + W_Q;      c.B = ws + W_KB;    c.lda = 1024; c.ldb = 1024; c.K = 256;  c.nbig = 256; c.nsmall = 0;   c.ncol64 = 16; c.ekind = E_QK; break;
    case 9:  c.A = ws + W_P;      c.B = ws + W_VT;    c.lda = 1024; c.ldb = 256;  c.K = 256;  c.nbig = 256; c.nsmall = 0;   c.ncol64 = 16; c.ekind = E_PV; break;
    case 10: c.A = ws + W_O;      c.B = ws + W_WMO;   c.lda = 1024; c.ldb = 1024; c.K = 1024; c.nbig = 256; c.nsmall = 256; c.ncol64 = 16; c.ekind = E_MO; break;
    case 12: c.A = ws + W_H;      c.B = ws + W_WUP;   c.lda = 1024; c.ldb = 1024; c.K = 1024; c.nbig = 66 * 22; c.nsmall = 0; c.ncol64 = 88; c.ekind = E_UP; break;
    default: c.A = ws + W_ACT;    c.B = ws + W_WDOWN; c.lda = 2816; c.ldb = 2816; c.K = 2816; c.nbig = 256; c.nsmall = 256; c.ncol64 = 16; c.ekind = E_DOWN; break;
    }
    return c;
}
struct UnitD { const char* A; const char* B; int row0, col0, ekind; };
__device__ __forceinline__ void map_unit(int L, int nM, int nN, int& pm, int& pn) {
    const int nwg = nM * nN, q = nwg >> 3, r = nwg & 7, xcd = L & 7, off = L >> 3;
    const int wgid = (xcd < r ? xcd * (q + 1) : r * (q + 1) + (xcd - r) * q) + off;
    const int nig = 8 * nN, gid = wgid / nig, fm = gid * 8, gsz = (nM - fm) < 8 ? (nM - fm) : 8;
    const int w = wgid - gid * nig;
    pm = fm + w % gsz; pn = w / gsz;
}
__device__ __forceinline__ UnitD unit_decode(PP P, const PhaseCfg& c, int gp, int L) {
    UnitD d; d.ekind = c.ekind;
    int pm, pn;
    switch (gp) {
    case 1:
        if (L < 924) { map_unit(L, 66, 14, pm, pn); d.A = c.A + (size_t)pm * 256 * 2048; d.B = c.B + (size_t)pn * 256 * 2048; }
        else { map_unit(L - 924, 8, 8, pm, pn); d.A = P->ws + W_HM + (size_t)pm * 256 * 2048; d.B = P->ws + W_WMK + (size_t)pn * 256 * 2048; d.ekind = E_MEMKV; }
        break;
    case 3: map_unit(L, 64, 4, pm, pn); d.A = c.A + (size_t)pm * 256 * 2048 + pn * 512; d.B = c.B + (size_t)pn * 131072; break;
    case 8: map_unit(L, 64, 4, pm, pn); d.A = c.A + (size_t)pm * 256 * 2048 + pn * 512; d.B = c.B + (size_t)(pm >> 3) * 256 * 2048 + pn * 512; break;
    case 9: map_unit(L, 64, 4, pm, pn); d.A = c.A + (size_t)pm * 256 * 2048 + pn * 512; d.B = c.B + (size_t)((pm >> 3) * 4 + pn) * 131072; break;
    case 12: map_unit(L, 66, 22, pm, pn); d.A = c.A + (size_t)pm * 256 * 2048; d.B = c.B + (size_t)pn * 256 * 2048; break;
    default: map_unit(L, 64, 4, pm, pn); d.A = c.A + (size_t)pm * 256 * c.lda * 2; d.B = c.B + (size_t)pn * 256 * c.ldb * 2; break;
    }
    d.row0 = pm * 256; d.col0 = pn * 256;
    return d;
}

__device__ __forceinline__ void gemm_phase(PP P, int gp, char* shm_g, int lb, int blk, int nblk, const int tid) {
    LDSB unsigned char* lds = (LDSB unsigned char*)shm_g;
    const int wid = __builtin_amdgcn_readfirstlane(tid >> 6), lane = tid & 63, wr = wid >> 2, wc = wid & 3, fr = lane & 15, fq = lane >> 4;
    const PhaseCfg cfg = phase_cfg(P, gp);
    const int K = cfg.K, nt = K / 64;
    unsigned voffA, voffB;
    { int R, C; stage_rc(tid * 16, R, C); voffA = (unsigned)(R * cfg.lda + C) * 2u; voffB = (unsigned)(R * cfg.ldb + C) * 2u; }
    const size_t qstepvoffA = (size_t)64 * cfg.lda * 2, qstepvoffB = (size_t)64 * cfg.ldb * 2;
    const size_t kstep = 128;
    const size_t hstepA = (size_t)128 * cfg.lda * 2, hstepB = (size_t)128 * cfg.ldb * 2;
    const unsigned ldsw = (unsigned)wid * 1024u;
    const int aoff = lds_byte(wr * 64 + fr, fq * 8), boff = lds_byte(wc * 32 + fr, fq * 8);
    const bool chain = (cfg.ekind != E_QK);
#define G_SA(b, h) (((b) * 2 + (h)) * HTB)
#define G_SB(b, h) ((4 + (b) * 2 + (h)) * HTB)
#define G_STAGE(bufoff, gbase, voff) do { \
        __builtin_amdgcn_global_load_lds((const unsigned*)((const char*)(gbase) + (voff)), (LDSB unsigned*)(lds + (bufoff) + ldsw), 16, 0, 0); \
        __builtin_amdgcn_global_load_lds((const unsigned*)((const char*)(gbase) + qstep##voff + (voff)), (LDSB unsigned*)(lds + (bufoff) + ldsw + 8192), 16, 0, 0); } while (0)
#define G_LDA(dst, b, h) do { _Pragma("unroll") for (int m = 0; m < 4; ++m) _Pragma("unroll") for (int k = 0; k < 2; ++k) dst[m][k] = *(const LDSB bf16x8*)(lds + G_SA(b, h) + aoff + m * 2048 + k * 1024); } while (0)
#define G_LDB(dst, b, h) do { _Pragma("unroll") for (int n = 0; n < 2; ++n) _Pragma("unroll") for (int k = 0; k < 2; ++k) dst[n][k] = *(const LDSB bf16x8*)(lds + G_SB(b, h) + boff + n * 2048 + k * 1024); } while (0)
#define G_MMA(ai, bj, Af, Bf) do { __builtin_amdgcn_s_setprio(1); _Pragma("unroll") for (int m = 0; m < 4; ++m) _Pragma("unroll") for (int n = 0; n < 2; ++n) _Pragma("unroll") for (int k = 0; k < 2; ++k) \
        acc[ai][bj][m][n] = __builtin_amdgcn_mfma_f32_16x16x32_bf16(Bf[n][k], Af[m][k], acc[ai][bj][m][n], 0, 0, 0); __builtin_amdgcn_s_setprio(0); } while (0)
#define G_WAIT_V(n) asm volatile("s_waitcnt vmcnt(" #n ")" ::: "memory")
#define G_WAIT_L(n) asm volatile("s_waitcnt lgkmcnt(" #n ")" ::: "memory")
#define G_BAR __builtin_amdgcn_s_barrier()
#define G_SCHED __builtin_amdgcn_sched_barrier(0)
    int u = blk;
    while (u < cfg.nbig) {
        UnitD cur = unit_decode(P, cfg, gp, u);
        f32x4 acc[2][2][4][2];
#pragma unroll
        for (int a = 0; a < 2; ++a)
#pragma unroll
            for (int b = 0; b < 2; ++b)
#pragma unroll
                for (int m = 0; m < 4; ++m)
#pragma unroll
                    for (int n = 0; n < 2; ++n) acc[a][b][m][n] = (f32x4){0.f, 0.f, 0.f, 0.f};
        bf16x8 At[4][2], B0[2][2], B1[2][2];
        const char* cA = cur.A; const char* cB = cur.B;
        G_STAGE(G_SB(0, 0), cB, voffB); G_STAGE(G_SA(0, 0), cA, voffA); G_STAGE(G_SB(0, 1), cB + hstepB, voffB); G_STAGE(G_SA(0, 1), cA + hstepA, voffA);
        if (wr == 1) G_BAR;
        G_WAIT_V(4); G_BAR;
        G_STAGE(G_SB(1, 0), cB + kstep, voffB); G_STAGE(G_SA(1, 0), cA + kstep, voffA); G_STAGE(G_SB(1, 1), cB + hstepB + kstep, voffB);
        G_WAIT_V(6); G_BAR;
        for (;;) {
            const bool has_next = chain && (u + nblk < cfg.nbig);
            UnitD nxt = cur;
            if (has_next) nxt = unit_decode(P, cfg, gp, u + nblk);
            const char* nA = nxt.A; const char* nB = nxt.B;
            for (int t = 0; t < nt; t += 2) {
                const bool last = (t == nt - 2);
                const char* a1 = cA + (size_t)(t + 1) * kstep;
                const char* a2 = last ? nA : cA + (size_t)(t + 2) * kstep; const char* b2 = last ? nB : cB + (size_t)(t + 2) * kstep;
                const char* a3 = a2 + kstep; const char* b3 = b2 + kstep;
                G_LDB(B0, 0, 0); G_SCHED; G_LDA(At, 0, 0); G_STAGE(G_SA(1, 1), a1 + hstepA, voffA);
                G_WAIT_L(8); G_BAR; G_WAIT_L(0); G_MMA(0, 0, At, B0); G_BAR; G_SCHED;
                G_LDB(B1, 0, 1); G_STAGE(G_SB(0, 0), b2, voffB);
                G_BAR; G_WAIT_L(0); G_MMA(0, 1, At, B1); G_BAR;
                G_LDA(At, 0, 1); G_STAGE(G_SA(0, 0), a2, voffA);
                G_BAR; G_WAIT_L(0); G_MMA(1, 0, At, B0); G_BAR; G_SCHED;
                G_STAGE(G_SB(0, 1), b2 + hstepB, voffB);
                G_WAIT_V(6); G_BAR; G_MMA(1, 1, At, B1); G_BAR;
                G_LDB(B0, 1, 0); G_SCHED; G_LDA(At, 1, 0); G_STAGE(G_SA(0, 1), a2 + hstepA, voffA);
                G_WAIT_L(8); G_BAR; G_WAIT_L(0); G_MMA(0, 0, At, B0); G_BAR; G_SCHED;
                G_LDB(B1, 1, 1); G_STAGE(G_SB(1, 0), b3, voffB);
                G_BAR; G_WAIT_L(0); G_MMA(0, 1, At, B1); G_BAR;
                G_LDA(At, 1, 1); G_STAGE(G_SA(1, 0), a3, voffA);
                G_BAR; G_WAIT_L(0); G_MMA(1, 0, At, B0); G_BAR; G_SCHED;
                G_STAGE(G_SB(1, 1), b3 + hstepB, voffB);
                G_WAIT_V(6); G_BAR; G_MMA(1, 1, At, B1); G_BAR;
            }
            if (chain) {
                const int rbase = cur.row0 + wr * 64 + fr, cbase = cur.col0 + wc * 32 + fq * 4;
                switch (cur.ekind) {
                case E_PROJ: epi_loop<E_PROJ>(P, acc, rbase, cbase, fq); break;
                case E_MEMKV: epi_loop<E_MEMKV>(P, acc, rbase, cbase, fq); break;
                case E_POOL: epi_loop<E_POOL>(P, acc, rbase, cbase, fq); break;
                case E_OUT: epi_loop<E_OUT>(P, acc, rbase, cbase, fq); break;
                case E_Q: epi_loop<E_Q>(P, acc, rbase, cbase, fq); break;
                case E_PV: epi_loop<E_PV>(P, acc, rbase, cbase, fq); break;
                case E_MO: epi_loop<E_MO>(P, acc, rbase, cbase, fq); break;
                case E_UP: epi_loop<E_UP>(P, acc, rbase, cbase, fq); break;
                default: epi_loop<E_DOWN>(P, acc, rbase, cbase, fq); break;
                }
            }
            if (!has_next) break;
#pragma unroll
            for (int a = 0; a < 2; ++a)
#pragma unroll
                for (int b = 0; b < 2; ++b)
#pragma unroll
                    for (int m = 0; m < 4; ++m)
#pragma unroll
                        for (int n = 0; n < 2; ++n) acc[a][b][m][n] = (f32x4){0.f, 0.f, 0.f, 0.f};
            cur = nxt; cA = nA; cB = nB; u += nblk;
        }
        G_WAIT_V(0);
        if (wr == 0) G_BAR;
        G_BAR;
        if (!chain) {
            float* redm = (float*)(shm_g + 131072);
            float* reds = (float*)(shm_g + 135168);
#pragma unroll
            for (int ai = 0; ai < 2; ++ai)
#pragma unroll
                for (int m = 0; m < 4; ++m) {
                    float t = -3.0e38f;
#pragma unroll
                    for (int bj = 0; bj < 2; ++bj)
#pragma unroll
                        for (int n = 0; n < 2; ++n)
#pragma unroll
                            for (int j = 0; j < 4; ++j) t = fmaxf(t, acc[ai][bj][m][n][j]);
                    t = fmaxf(t, __shfl_xor(t, 16)); t = fmaxf(t, __shfl_xor(t, 32));
                    if (fq == 0) redm[(ai * 128 + wr * 64 + m * 16 + fr) * 4 + wc] = t;
                }
            __syncthreads();
#pragma unroll
            for (int ai = 0; ai < 2; ++ai)
#pragma unroll
                for (int m = 0; m < 4; ++m) {
                    const f32x4 r = *(const f32x4*)(redm + (ai * 128 + wr * 64 + m * 16 + fr) * 4);
                    const float M = fmaxf(fmaxf(r[0], r[1]), fmaxf(r[2], r[3]));
                    float s = 0.f;
#pragma unroll
                    for (int bj = 0; bj < 2; ++bj)
#pragma unroll
                        for (int n = 0; n < 2; ++n)
#pragma unroll
                            for (int j = 0; j < 4; ++j) { const float e = __expf(acc[ai][bj][m][n][j] - M); acc[ai][bj][m][n][j] = e; s += e; }
                    s += __shfl_xor(s, 16); s += __shfl_xor(s, 32);
                    if (fq == 0) reds[(ai * 128 + wr * 64 + m * 16 + fr) * 4 + wc] = s;
                }
            __syncthreads();
#pragma unroll
            for (int ai = 0; ai < 2; ++ai)
#pragma unroll
                for (int m = 0; m < 4; ++m) {
                    const int rl = ai * 128 + wr * 64 + m * 16 + fr;
                    const f32x4 r = *(const f32x4*)(reds + rl * 4);
                    const float inv = 1.0f / ((r[0] + r[1]) + (r[2] + r[3]));
                    bf16_t* prow = (bf16_t*)(P->ws + W_P) + (size_t)(cur.row0 + rl) * 1024 + cur.col0;
#pragma unroll
                    for (int bj = 0; bj < 2; ++bj) {
                        const f32x4 v0 = acc[ai][bj][m][0], v1 = acc[ai][bj][m][1];
                        u32x4 o; o.x = pk2(v0[0] * inv, v0[1] * inv); o.y = pk2(v0[2] * inv, v0[3] * inv); o.z = pk2(v1[0] * inv, v1[1] * inv); o.w = pk2(v1[2] * inv, v1[3] * inv);
                        *(u32x4*)(prow + bj * 128 + wc * 32 + fq * 8) = o;
                    }
                }
            __syncthreads();
        }
        u += nblk;
    }
#undef G_SA
#undef G_SB
#undef G_STAGE
#undef G_LDA
#undef G_LDB
#undef G_MMA
    const int rot = cfg.nbig % nblk;
    for (int s0 = (lb - rot + nblk) % nblk; s0 < cfg.nsmall; s0 += nblk) {
        const int pr = s0 / cfg.ncol64, pc = s0 % cfg.ncol64;
        const int row0 = (gp == 1 ? 0 : TP) + pr * 32, col0 = pc * 64;
        int lda_s = cfg.lda, ldb_s = cfg.ldb, K_s = K, ek_s = cfg.ekind;
        const bf16_t* Ab; const bf16_t* Bb;
        if (gp == 1) {
            const int g = pc >> 2; lda_s = 1024; ldb_s = 256; K_s = 256; ek_s = E_FOLD;
            Ab = (const bf16_t*)(P->ws + W_WLO) + (size_t)row0 * 1024 + g * 256; Bb = (const bf16_t*)(P->ws + W_WPOOL) + (size_t)g * 65536 + (size_t)(col0 - g * 256) * 256;
        } else { Ab = (const bf16_t*)cfg.A + (size_t)row0 * cfg.lda; Bb = (const bf16_t*)cfg.B + (size_t)col0 * cfg.ldb; }
        const int kw = K_s >> 3, nks = kw >> 5;
        f32x4 acc[2][4];
#pragma unroll
        for (int mi = 0; mi < 2; ++mi)
#pragma unroll
            for (int ni = 0; ni < 4; ++ni) acc[mi][ni] = (f32x4){0.f, 0.f, 0.f, 0.f};
        const bf16_t* ap = Ab + (size_t)fr * lda_s + wid * kw + fq * 8;
        const bf16_t* bp = Bb + (size_t)fr * ldb_s + wid * kw + fq * 8;
        for (int ks0 = 0; ks0 < nks; ks0 += 4) {
            bf16x8 a[4][2], b[4][4];
#pragma unroll
            for (int q = 0; q < 4; ++q) {
                const bool ok = ks0 + q < nks;
#pragma unroll
                for (int mi = 0; mi < 2; ++mi) { bf16x8 z = {0, 0, 0, 0, 0, 0, 0, 0}; if (ok) z = *(const bf16x8*)(ap + (size_t)mi * 16 * lda_s + (ks0 + q) * 32); a[q][mi] = z; }
#pragma unroll
                for (int ni = 0; ni < 4; ++ni) { bf16x8 z = {0, 0, 0, 0, 0, 0, 0, 0}; if (ok) z = *(const bf16x8*)(bp + (size_t)ni * 16 * ldb_s + (ks0 + q) * 32); b[q][ni] = z; }
            }
#pragma unroll
            for (int q = 0; q < 4; ++q)
#pragma unroll
                for (int mi = 0; mi < 2; ++mi)
#pragma unroll
                    for (int ni = 0; ni < 4; ++ni) acc[mi][ni] = __builtin_amdgcn_mfma_f32_16x16x32_bf16(b[q][ni], a[q][mi], acc[mi][ni], 0, 0, 0);
        }
        float* red = (float*)shm_g;
#pragma unroll
        for (int mi = 0; mi < 2; ++mi)
#pragma unroll
            for (int ni = 0; ni < 4; ++ni) *(f32x4*)(red + wid * 2048 + (mi * 16 + fr) * 64 + ni * 16 + fq * 4) = acc[mi][ni];
        __syncthreads();
        {
            const int r = tid >> 4, c = (tid & 15) * 4;
            f32x4 v = *(const f32x4*)(red + r * 64 + c);
#pragma unroll
            for (int w = 1; w < 8; ++w) v += *(const f32x4*)(red + w * 2048 + r * 64 + c);
            const int cl = (gp == 1) ? c : (c & 32) + perm32(c & 31);
            float ss = epi_apply_rt(P, ek_s, row0 + r, col0 + cl, v);
            if (cfg.ekind == E_OUT || cfg.ekind == E_MO || cfg.ekind == E_DOWN) {
                ss += __shfl_xor(ss, 1); ss += __shfl_xor(ss, 2); ss += __shfl_xor(ss, 4); ss += __shfl_xor(ss, 8);
                if ((tid & 15) == 0) unsafeAtomicAdd((float*)(P->ws + (cfg.ekind == E_OUT ? W_SS1 : cfg.ekind == E_MO ? W_SS2 : W_SS3)) + row0 + r, ss);
            }
        }
        __syncthreads();
    }
}

struct TrDesc { const float* src; bf16_t* dst; const float* gain; int ld_src, ld_dst, k0, n0s, n0d, perm; };
__device__ __forceinline__ TrDesc tr_decode(PP P, int i) {
    char* ws = P->ws; TrDesc d; d.gain = nullptr; d.perm = 0;
    if (i < 896) { const int kt = i / 56, ntl = i % 56; d.n0d = ntl * 64; d.n0s = d.n0d < 2560 ? d.n0d : d.n0d + 16; d.src = P->w_in; d.ld_src = 3600; d.dst = (bf16_t*)(ws + W_WIN); d.ld_dst = 1024; d.k0 = kt * 64; d.perm = 1; return d; }
    i -= 896;
    if (i < 512) { const int kt = i >> 4, ntl = i & 15; d.ld_src = 1024; d.n0s = d.n0d = ntl * 64;
        d.perm = kt < 16 ? 1 : 0;
        if (kt < 16) { d.src = P->w_out; d.dst = (bf16_t*)(ws + W_WOUT); d.ld_dst = 2048; d.k0 = kt * 64; }
        else { d.src = P->w_out + (size_t)1024 * 1024; d.dst = (bf16_t*)(ws + W_WLO); d.ld_dst = 1024; d.k0 = (kt - 16) * 64; }
        return d; }
    i -= 512;
    if (i < 1024) { const int wsel = i >> 8, r = i & 255, kt = r >> 4, ntl = r & 15;
        d.src = wsel == 0 ? P->w_mq : wsel == 1 ? P->w_mk : wsel == 2 ? P->w_mv : P->w_mo;
        d.dst = (bf16_t*)(ws + (wsel == 0 ? W_WMQ : wsel == 1 ? W_WMK : wsel == 2 ? W_WMV : W_WMO));
        d.gain = wsel == 0 ? P->norm_mem : nullptr; d.ld_src = 1024; d.ld_dst = 1024; d.k0 = kt * 64; d.n0s = d.n0d = ntl * 64; d.perm = (wsel == 0 || wsel == 3) ? 1 : 0; return d; }
    i -= 1024;
    if (i < 1408) { const int kt = i / 88, ntl = i % 88; d.src = P->w_up; d.ld_src = 5632; d.dst = (bf16_t*)(ws + W_WUP); d.ld_dst = 1024; d.gain = P->norm_ffn; d.k0 = kt * 64; d.n0s = d.n0d = ntl * 64; d.perm = 1; return d; }
    i -= 1408;
    { const int kt = i >> 4, ntl = i & 15; d.src = P->w_down; d.ld_src = 1024; d.dst = (bf16_t*)(ws + W_WDOWN); d.ld_dst = 2816; d.k0 = kt * 64; d.n0s = d.n0d = ntl * 64; d.perm = 1; return d; }
}

__device__ __forceinline__ void phase_prep(PP P, char* shm, int blk, int nblk, const int tid) {
    const int wid = tid >> 6, lane = tid & 63;
    float* tiles = (float*)shm;
    float* wdt = (float*)(shm + 69632);
    for (int i = blk * NTHR + tid; i < 3 * TT; i += nblk * NTHR) ((float*)(P->ws + W_SS1))[i] = 0.f;
    for (int i = (blk * NTHR + tid) * 4; i < 4 * 65536; i += nblk * NTHR * 4) {
        const f32x4 wv = *(const f32x4*)(P->w_pool + i), sv = *(const f32x4*)(P->pool_scale + (i >> 16) * 256 + (i & 255));
        u32x2 o; o.x = pk2(wv[0] * sv[0], wv[1] * sv[1]); o.y = pk2(wv[2] * sv[2], wv[3] * sv[3]);
        *(u32x2*)((bf16_t*)(P->ws + W_WPOOL) + i) = o;
    }
    for (int i = tid; i < 1024 * 16; i += NTHR) { const int k = i >> 4, hd = i & 15; wdt[hd * 1024 + k] = P->w_in[(size_t)k * 3600 + 2560 + hd]; }
    __syncthreads();
    char* ws = P->ws;
    constexpr int NGRP = (TT + 2048) / 32;
    for (int it = blk; it < NGRP; it += nblk) {
        const int rbase = it * 32 + wid * 4;
        const bool ismem = rbase >= TT;
        f32x4 xv[4][4];
#pragma unroll
        for (int r = 0; r < 4; ++r) {
            const int row = (ismem ? rbase - TT : rbase) + r;
            const float* xr = ismem ? P->mem_prompt + (size_t)row * 1024 : (row < TP ? P->x_prompt + (size_t)row * 1024 : P->x_sample + (size_t)(row - TP) * 1024);
#pragma unroll
            for (int j = 0; j < 4; ++j) xv[r][j] = __builtin_nontemporal_load((const f32x4*)(xr + j * 256 + lane * 4));
        }
        const float* gg = ismem ? P->norm_memkv : P->norm_mix;
#pragma unroll
        for (int r = 0; r < 4; ++r) {
            const int row = (ismem ? rbase - TT : rbase) + r;
            bf16_t* orow = (bf16_t*)(ws + (ismem ? W_HM : W_H)) + (size_t)row * 1024;
            float ss = 0.f;
#pragma unroll
            for (int j = 0; j < 4; ++j) ss += xv[r][j][0] * xv[r][j][0] + xv[r][j][1] * xv[r][j][1] + xv[r][j][2] * xv[r][j][2] + xv[r][j][3] * xv[r][j][3];
            ss = wave_sum(ss);
            const float rstd = rsqrtf(ss * (1.0f / 1024.0f) + EPS);
#pragma unroll
            for (int j = 0; j < 4; ++j) { const f32x4 g4 = *(const f32x4*)(gg + j * 256 + lane * 4); xv[r][j] = xv[r][j] * rstd * g4;
                u32x2 o; o.x = pk2(xv[r][j][0], xv[r][j][1]); o.y = pk2(xv[r][j][2], xv[r][j][3]); *(u32x2*)(orow + j * 256 + lane * 4) = o; }
        }
        if (!ismem) {
            float vals[64];
#pragma unroll
            for (int hd = 0; hd < 16; ++hd) {
                f32x4 w4[4];
#pragma unroll
                for (int j = 0; j < 4; ++j) w4[j] = *(const f32x4*)(wdt + hd * 1024 + j * 256 + lane * 4);
#pragma unroll
                for (int r = 0; r < 4; ++r) {
                    float a = 0.f;
#pragma unroll
                    for (int j = 0; j < 4; ++j) a += xv[r][j][0] * w4[j][0] + xv[r][j][1] * w4[j][1] + xv[r][j][2] * w4[j][2] + xv[r][j][3] * w4[j][3];
                    vals[r * 16 + hd] = a;
                }
            }
#pragma unroll
            for (int half = 32; half >= 1; half >>= 1) {
                const bool hi = (lane & half) != 0;
#pragma unroll
                for (int i = 0; i < half; ++i) {
                    const float keep = hi ? vals[i + half] : vals[i], send = hi ? vals[i] : vals[i + half];
                    vals[i] = keep + __shfl_xor(send, half);
                }
            }
            const float x = vals[0] + P->dt_bias[lane & 15];
            const float ey = __expf(-fabsf(x)); const float l1p = ey < 0.03f ? ey * (1.0f - ey * (0.5f - ey * (0.33333333f - 0.25f * ey))) : __logf(1.0f + ey);
            ((float*)(ws + W_DT))[(size_t)rbase * 16 + lane] = fmaxf(x, 0.f) + l1p;
        }
    }
    __syncthreads();
    const int kr = tid >> 4, nc = (tid & 15) * 4, tn = tid >> 3, tk8 = (tid & 7) * 8;
    for (int it = blk; it < 4544; it += 4 * nblk) {
        f32x4 v[4][2];
#pragma unroll
        for (int q = 0; q < 4; ++q) {
            const int i = it + q * nblk;
            if (i < 4544) { const TrDesc d = tr_decode(P, i);
#pragma unroll
                for (int h = 0; h < 2; ++h) { const int k = kr + h * 32; f32x4 t = __builtin_nontemporal_load((const f32x4*)(d.src + (size_t)(d.k0 + k) * d.ld_src + d.n0s + nc)); if (d.gain) t *= d.gain[d.k0 + k]; v[q][h] = t; } }
        }
#pragma unroll
        for (int q = 0; q < 4; ++q) {
            if (it + q * nblk < 4544) { float* tile = tiles + q * (64 * 65);
#pragma unroll
                for (int h = 0; h < 2; ++h) { const int k = kr + h * 32; tile[k * 65 + nc + 0] = v[q][h][0]; tile[k * 65 + nc + 1] = v[q][h][1]; tile[k * 65 + nc + 2] = v[q][h][2]; tile[k * 65 + nc + 3] = v[q][h][3]; } }
        }
        __syncthreads();
#pragma unroll
        for (int q = 0; q < 4; ++q) {
            const int i = it + q * nblk;
            if (i < 4544) { const TrDesc d = tr_decode(P, i); const float* tile = tiles + q * (64 * 65); float f[8];
                const int sc = d.perm ? (tn & 32) + perm32(tn & 31) : tn;
#pragma unroll
                for (int e2 = 0; e2 < 8; ++e2) f[e2] = tile[(tk8 + e2) * 65 + sc];
                *(u32x4*)(d.dst + (size_t)(d.n0d + tn) * d.ld_dst + d.k0 + tk8) = pack8(f); }
        }
        __syncthreads();
    }
}

__device__ __forceinline__ u32x4 ld8(const bf16_t* p) { return *(const u32x4*)p; }

__device__ __forceinline__ void phase_convpool(PP P, int gtid, int nthreads) {
    char* ws = P->ws;
    const bf16_t* proj2 = (const bf16_t*)(ws + W_PROJ2);
    bf16_t* xact = (bf16_t*)(ws + W_XACT);
    bf16_t* pooled = (bf16_t*)(ws + W_POOLED);
    for (int idx = gtid; idx < 1152 * 320; idx += nthreads) {
        const int run = idx / 320, cg = idx % 320;
        const bool samp = run >= 1024;
        int t0, len, bidx, tl0;
        if (!samp) { t0 = run * 16; len = 16; bidx = t0 >> 11; tl0 = t0 & 2047; } else { bidx = run - 1024; t0 = TP + bidx * 4; len = 4; tl0 = 0; }
        if (cg < 192) {
            const int c0 = cg * 8;
            float w0[8], w1[8], w2[8], w3[8], bs[8], h0[8], h1[8], h2[8];
#pragma unroll
            for (int e = 0; e < 8; ++e) { w0[e] = P->conv_w[c0 + e]; w1[e] = P->conv_w[1536 + c0 + e]; w2[e] = P->conv_w[3072 + c0 + e]; w3[e] = P->conv_w[4608 + c0 + e]; bs[e] = P->conv_b[c0 + e]; }
            if (samp) {
#pragma unroll
                for (int e = 0; e < 8; ++e) { h0[e] = P->state_conv[(size_t)(bidx * 3 + 0) * 1536 + c0 + e]; h1[e] = P->state_conv[(size_t)(bidx * 3 + 1) * 1536 + c0 + e]; h2[e] = P->state_conv[(size_t)(bidx * 3 + 2) * 1536 + c0 + e]; }
            } else if (tl0 > 0) {
                unpack8(ld8(proj2 + (size_t)(t0 - 3) * 2560 + c0), h0); unpack8(ld8(proj2 + (size_t)(t0 - 2) * 2560 + c0), h1); unpack8(ld8(proj2 + (size_t)(t0 - 1) * 2560 + c0), h2);
            } else {
#pragma unroll
                for (int e = 0; e < 8; ++e) { h0[e] = 0.f; h1[e] = 0.f; h2[e] = 0.f; }
            }
            u32x4 rx[16];
#pragma unroll
            for (int j = 0; j < 16; ++j) { if (j < len) rx[j] = ld8(proj2 + (size_t)(t0 + j) * 2560 + c0); }
#pragma unroll
            for (int j = 0; j < 16; ++j) {
                if (j < len) {
                float x3[8], y[8]; unpack8(rx[j], x3);
#pragma unroll
                for (int e = 0; e < 8; ++e) { const float v = bs[e] + w0[e] * h0[e] + w1[e] * h1[e] + w2[e] * h2[e] + w3[e] * x3[e]; y[e] = silu_f(v); }
                *(u32x4*)(xact + (size_t)(t0 + j) * 1536 + c0) = pack8(y);
                if (samp) { if (j >= 1) { float* o = P->out + O_CONVS + (size_t)(bidx * 3 + j - 1) * 1536 + c0;
#pragma unroll
                        for (int e = 0; e < 8; ++e) o[e] = x3[e]; } }
                else { const int tl = tl0 + j; if (tl >= 2045) { float* o = P->out + O_CONVP + (size_t)(bidx * 3 + tl - 2045) * 1536 + c0;
#pragma unroll
                        for (int e = 0; e < 8; ++e) o[e] = x3[e]; } }
#pragma unroll
                for (int e = 0; e < 8; ++e) { h0[e] = h1[e]; h1[e] = h2[e]; h2[e] = x3[e]; }
                }
            }
        } else {
            const int c0 = (cg - 192) * 8; const int win = 2 << (c0 >> 8);
            const bf16_t* vp = proj2 + 1536 + c0;
            const float* prev = P->state_pool + (size_t)bidx * 15 * 1024 + c0;
            float sum[8];
#pragma unroll
            for (int e = 0; e < 8; ++e) sum[e] = 0.f;
            if (samp) {
                for (int jj = 1; jj < win; ++jj) {
#pragma unroll
                    for (int e = 0; e < 8; ++e) sum[e] += prev[(size_t)(15 - jj) * 1024 + e]; }
                float* o = P->out + O_POOLS + (size_t)bidx * 15 * 1024 + c0;
                for (int i = 0; i < 11; ++i) {
#pragma unroll
                    for (int e = 0; e < 8; ++e) o[(size_t)i * 1024 + e] = prev[(size_t)(i + 4) * 1024 + e]; }
            } else if (tl0 > 0) {
                for (int jj = 1; jj < win; ++jj) { float v[8]; unpack8(ld8(vp + (size_t)(t0 - jj) * 2560), v);
#pragma unroll
                    for (int e = 0; e < 8; ++e) sum[e] += v[e]; }
            }
            u32x4 rp[16];
#pragma unroll
            for (int j = 0; j < 16; ++j) { if (j < len) rp[j] = ld8(vp + (size_t)(t0 + j) * 2560); }
#pragma unroll
            for (int j = 0; j < 16; ++j) {
                if (j >= len) continue;
                float v[8], o8[8]; unpack8(rp[j], v);
                const int tl = tl0 + j;
                const float inv = 1.0f / (float)(samp ? win : (tl + 1 < win ? tl + 1 : win));
#pragma unroll
                for (int e = 0; e < 8; ++e) { sum[e] += v[e]; o8[e] = sum[e] * inv - v[e]; }
                *(u32x4*)((bf16_t*)(ws + W_MIX) + (size_t)(t0 + j) * 2048 + 1024 + c0) = pack8(o8);
                const int to = j - win + 1;
                if (samp) {
                    if (to >= 0) { float q[8]; unpack8(ld8(vp + (size_t)(t0 + to) * 2560), q);
#pragma unroll
                        for (int e = 0; e < 8; ++e) sum[e] -= q[e]; }
                    else {
#pragma unroll
                        for (int e = 0; e < 8; ++e) sum[e] -= prev[(size_t)(15 + to) * 1024 + e]; }
                    float* o = P->out + O_POOLS + (size_t)(bidx * 15 + 11 + j) * 1024 + c0;
#pragma unroll
                    for (int e = 0; e < 8; ++e) o[e] = v[e];
                } else {
                    if (tl0 + to >= 0) { float q[8]; unpack8(ld8(vp + (size_t)(t0 + to) * 2560), q);
#pragma unroll
                        for (int e = 0; e < 8; ++e) sum[e] -= q[e]; }
                    if (tl >= 2033) { float* o = P->out + O_POOLP + (size_t)(bidx * 15 + tl - 2033) * 1024 + c0;
#pragma unroll
                        for (int e = 0; e < 8; ++e) o[e] = v[e]; }
                }
            }
        }
    }
}

constexpr int CS_STR = 136;
constexpr int X_STR = 40;
__device__ __forceinline__ s16x4 tr_read(const bf16_t* p) { return __builtin_bit_cast(s16x4, __builtin_amdgcn_ds_read_tr16_b64_v4i16((LDSB s16x4*)p)); }

#define LDS_BARRIER() asm volatile("s_waitcnt lgkmcnt(0)\n\ts_barrier" ::: "memory")
__device__ __forceinline__ void ssd_prompt(PP P, int item, char* shm, const int tid) {
    const int w = tid >> 6, lane = tid & 63, fr = lane & 15, fq = lane >> 4;
    const int b = item >> 5, hd = (item >> 1) & 15, ph = item & 1, g = hd >> 3;
    const float a = -expf(P->a_log[hd]);
    const float Dh = P->ssm_d[hd];
    char* ws = P->ws;
    const bf16_t* xact = (const bf16_t*)(ws + W_XACT);
    const float* dtb = (const float*)(ws + W_DT);
    bf16_t* ybuf = (bf16_t*)(ws + W_Y);
    bf16_t* Cs = (bf16_t*)(shm);
    bf16_t* Bs = (bf16_t*)(shm + 34816);
    bf16_t* Xd = (bf16_t*)(shm + 69632);
    bf16_t* X2 = (bf16_t*)(shm + 69632 + 10240);
    bf16_t* Ht = (bf16_t*)(shm + 69632 + 20480);
    float* acs = (float*)(shm + 69632 + 30720);
    float* dts = (float*)(shm + 69632 + 31232);
    f32x4 Hacc[2];
    Hacc[0] = (f32x4){0.f, 0.f, 0.f, 0.f}; Hacc[1] = (f32x4){0.f, 0.f, 0.f, 0.f};
    const int q4 = fr >> 2, p4 = fr & 3;
    u32x4 pc[4], pb[4], px; float pd0, pd1;
    const int ls = tid >> 4, ln8 = (tid & 15) * 8;
    const int xs = tid >> 2, xp8 = (tid & 3) * 8;
#define SSD_PREFETCH(cc) do { const int _t0 = b * 2048 + (cc) * 128; \
        _Pragma("unroll") for (int i = 0; i < 4; ++i) { const bf16_t* src = xact + (size_t)(_t0 + ls + i * 32) * 1536 + g * 128 + ln8; pc[i] = *(const u32x4*)(src + 1280); pb[i] = *(const u32x4*)(src + 1024); } \
        px = *(const u32x4*)(xact + (size_t)(_t0 + xs) * 1536 + hd * 64 + ph * 32 + xp8); \
        pd0 = dtb[(size_t)(_t0 + 2 * lane) * 16 + hd]; pd1 = dtb[(size_t)(_t0 + 2 * lane + 1) * 16 + hd]; } while (0)
    SSD_PREFETCH(0);
    for (int c = 0; c < 16; ++c) {
        const int t0 = b * 2048 + c * 128;
        if (w == 0) {
            const float d0 = pd0, d1 = pd1;
            const float s = (d0 + d1) * a; float v = s;
#pragma unroll
            for (int off = 1; off < 64; off <<= 1) { const float t = __shfl_up(v, off); if (lane >= off) v += t; }
            const float excl = v - s;
            acs[2 * lane] = excl + d0 * a; acs[2 * lane + 1] = v; dts[2 * lane] = d0; dts[2 * lane + 1] = d1;
        }
#pragma unroll
        for (int pt = 0; pt < 2; ++pt) { u32x2 o; o.x = pk2(Hacc[pt][0], Hacc[pt][1]); o.y = pk2(Hacc[pt][2], Hacc[pt][3]); *(u32x2*)(Ht + (w * 16 + fr) * X_STR + pt * 16 + fq * 4) = o; }
#pragma unroll
        for (int i = 0; i < 4; ++i) { *(u32x4*)(Cs + (ls + i * 32) * CS_STR + ln8) = pc[i]; *(u32x4*)(Bs + (ls + i * 32) * CS_STR + ln8) = pb[i]; }
        LDS_BARRIER();
        {
            float x[8], xa[8], xb[8]; unpack8(px, x);
            const float dtv = dts[xs], dec = __expf(acs[127] - acs[xs]) * dtv;
#pragma unroll
            for (int e = 0; e < 8; ++e) { xa[e] = x[e] * dtv; xb[e] = x[e] * dec; }
            *(u32x4*)(Xd + xs * X_STR + xp8) = pack8(xa);
            *(u32x4*)(X2 + xs * X_STR + xp8) = pack8(xb);
        }
        if (c < 15) SSD_PREFETCH(c + 1);
        bf16x8 Cf[4];
#pragma unroll
        for (int kk = 0; kk < 4; ++kk) Cf[kk] = *(const bf16x8*)(Cs + (w * 16 + fr) * CS_STR + kk * 32 + fq * 8);
        const int lrow = w * 16 + fr; const float al = acs[lrow];
        bf16x8 Gf[4];
#pragma unroll
        for (int kk = 0; kk < 4; ++kk) {
            u32x2 half[2];
#pragma unroll
            for (int hh = 0; hh < 2; ++hh) {
                const int st = 2 * kk + hh;
                half[hh].x = 0u; half[hh].y = 0u;
                if (st <= w) {
                    f32x4 ga = (f32x4){0.f, 0.f, 0.f, 0.f};
#pragma unroll
                    for (int k2 = 0; k2 < 4; ++k2) { const bf16x8 Bf = *(const bf16x8*)(Bs + (st * 16 + fr) * CS_STR + k2 * 32 + fq * 8); ga = __builtin_amdgcn_mfma_f32_16x16x32_bf16(Bf, Cf[k2], ga, 0, 0, 0); }
                    const int s0 = st * 16 + fq * 4; const f32x4 as4 = *(const f32x4*)(acs + s0);
                    float gv[4];
#pragma unroll
                    for (int j = 0; j < 4; ++j) gv[j] = (s0 + j <= lrow) ? ga[j] * __expf(al - as4[j]) : 0.f;
                    half[hh].x = pk2(gv[0], gv[1]); half[hh].y = pk2(gv[2], gv[3]);
                }
            }
            u32x4 g4; g4.x = half[0].x; g4.y = half[0].y; g4.z = half[1].x; g4.w = half[1].y;
            Gf[kk] = __builtin_bit_cast(bf16x8, g4);
        }
        LDS_BARRIER();
        {
            f32x4 Yd[2], Yo[2];
            Yd[0] = Yd[1] = Yo[0] = Yo[1] = (f32x4){0.f, 0.f, 0.f, 0.f};
            const int nkk = (w >> 1) + 1;
#pragma unroll
            for (int kk = 0; kk < 4; ++kk) {
                if (kk < nkk) {
#pragma unroll
                    for (int pt = 0; pt < 2; ++pt) {
                        const bf16_t* base = Xd + (kk * 32 + fq * 4 + q4) * X_STR + pt * 16 + p4 * 4;
                        bf16x8 Xf; Xf.lo = tr_read(base); Xf.hi = tr_read(base + 16 * X_STR);
                        Yd[pt] = __builtin_amdgcn_mfma_f32_16x16x32_bf16(Xf, Gf[kk], Yd[pt], 0, 0, 0);
                    }
                }
            }
#pragma unroll
            for (int kk = 0; kk < 4; ++kk)
#pragma unroll
                for (int pt = 0; pt < 2; ++pt) {
                    const bf16_t* hbp = Ht + (kk * 32 + fq * 8 + q4) * X_STR + pt * 16 + p4 * 4;
                    bf16x8 Hf; Hf.lo = tr_read(hbp); Hf.hi = tr_read(hbp + 4 * X_STR);
                    Yo[pt] = __builtin_amdgcn_mfma_f32_16x16x32_bf16(Hf, Cf[kk], Yo[pt], 0, 0, 0);
                }
            const float el = __expf(al); const float rdt = Dh / dts[lrow];
#pragma unroll
            for (int pt = 0; pt < 2; ++pt) {
                const u32x2 xr = *(const u32x2*)(Xd + lrow * X_STR + pt * 16 + fq * 4);
                const f32x4 y = Yd[pt] + el * Yo[pt] + rdt * (f32x4){bflo(xr.x), bfhi(xr.x), bflo(xr.y), bfhi(xr.y)};
                u32x2 o; o.x = pk2(y[0], y[1]); o.y = pk2(y[2], y[3]);
                *(u32x2*)(ybuf + (size_t)(t0 + lrow) * 1024 + hd * 64 + ph * 32 + pt * 16 + fq * 4) = o;
            }
        }
        {
            const float dc = __expf(acs[127]);
            Hacc[0] *= dc; Hacc[1] *= dc;
#pragma unroll
            for (int kk = 0; kk < 4; ++kk) {
                const bf16_t* bb = Bs + (kk * 32 + fq * 8 + q4) * CS_STR + w * 16 + p4 * 4;
                bf16x8 Bf; Bf.lo = tr_read(bb); Bf.hi = tr_read(bb + 4 * CS_STR);
#pragma unroll
                for (int pt = 0; pt < 2; ++pt) {
                    const bf16_t* xb = X2 + (kk * 32 + fq * 8 + q4) * X_STR + pt * 16 + p4 * 4;
                    bf16x8 Xf; Xf.lo = tr_read(xb); Xf.hi = tr_read(xb + 4 * X_STR);
                    Hacc[pt] = __builtin_amdgcn_mfma_f32_16x16x32_bf16(Xf, Bf, Hacc[pt], 0, 0, 0);
                }
            }
        }
        LDS_BARRIER();
    }
#undef SSD_PREFETCH
    float* so = P->out + O_SSMP + ((size_t)(b * 16 + hd) * 64 + ph * 32) * 128;
#pragma unroll
    for (int pt = 0; pt < 2; ++pt)
#pragma unroll
        for (int j = 0; j < 4; ++j) so[(size_t)(pt * 16 + fq * 4 + j) * 128 + w * 16 + fr] = Hacc[pt][j];
}

template <int NI>
__device__ __forceinline__ void ssd_sample(PP P, int item0, int istride, const int tid) {
    const int p = tid >> 3, n0 = (tid & 7) * 16;
    char* ws = P->ws;
    const bf16_t* xact = (const bf16_t*)(ws + W_XACT);
    const float* dtb = (const float*)(ws + W_DT);
    bf16_t* ybuf = (bf16_t*)(ws + W_Y);
    f32x4 hs[NI][4]; u32x4 rb[NI][4][2], rc[NI][4][2]; float xv[NI][4], dtv[NI][4];
#pragma unroll
    for (int q = 0; q < NI; ++q) {
        const int item = item0 + q * istride, b = item >> 4, hd = item & 15, g = hd >> 3;
        const size_t sidx = ((size_t)(b * 16 + hd) * 64 + p) * 128 + n0;
#pragma unroll
        for (int i = 0; i < 4; ++i) hs[q][i] = __builtin_nontemporal_load((const f32x4*)(P->state_ssm + sidx + i * 4));
#pragma unroll
        for (int i = 0; i < 4; ++i) {
            const int t = TP + b * 4 + i;
            xv[q][i] = bf2f(xact[(size_t)t * 1536 + hd * 64 + p]);
            dtv[q][i] = dtb[(size_t)t * 16 + hd];
            rb[q][i][0] = ld8(xact + (size_t)t * 1536 + 1024 + g * 128 + n0); rb[q][i][1] = ld8(xact + (size_t)t * 1536 + 1024 + g * 128 + n0 + 8);
            rc[q][i][0] = ld8(xact + (size_t)t * 1536 + 1280 + g * 128 + n0); rc[q][i][1] = ld8(xact + (size_t)t * 1536 + 1280 + g * 128 + n0 + 8);
        }
    }
#pragma unroll
    for (int q = 0; q < NI; ++q) {
        const int item = item0 + q * istride, b = item >> 4, hd = item & 15;
        const float a = -expf(P->a_log[hd]);
        const float Dh = P->ssm_d[hd];
        const size_t sidx = ((size_t)(b * 16 + hd) * 64 + p) * 128 + n0;
        float h[16];
#pragma unroll
        for (int i = 0; i < 4; ++i) { h[i * 4] = hs[q][i][0]; h[i * 4 + 1] = hs[q][i][1]; h[i * 4 + 2] = hs[q][i][2]; h[i * 4 + 3] = hs[q][i][3]; }
#pragma unroll
        for (int i = 0; i < 4; ++i) {
            const int t = TP + b * 4 + i;
            const float dA = __expf(dtv[q][i] * a), dx = dtv[q][i] * xv[q][i];
            float Bv[16], Cv[16];
            { float t8[8]; unpack8(rb[q][i][0], t8);
#pragma unroll
              for (int e = 0; e < 8; ++e) Bv[e] = t8[e];
              unpack8(rb[q][i][1], t8);
#pragma unroll
              for (int e = 0; e < 8; ++e) Bv[8 + e] = t8[e];
              unpack8(rc[q][i][0], t8);
#pragma unroll
              for (int e = 0; e < 8; ++e) Cv[e] = t8[e];
              unpack8(rc[q][i][1], t8);
#pragma unroll
              for (int e = 0; e < 8; ++e) Cv[8 + e] = t8[e]; }
            float part = 0.f;
#pragma unroll
            for (int e = 0; e < 16; ++e) { h[e] = h[e] * dA + dx * Bv[e]; part += h[e] * Cv[e]; }
            part += __shfl_xor(part, 1); part += __shfl_xor(part, 2); part += __shfl_xor(part, 4);
            if ((tid & 7) == 0) ybuf[(size_t)t * 1024 + hd * 64 + p] = f2bf(part + Dh * xv[q][i]);
        }
        float* so = P->out + O_SSMS + sidx;
#pragma unroll
        for (int i = 0; i < 4; ++i) __builtin_nontemporal_store((f32x4){h[i * 4], h[i * 4 + 1], h[i * 4 + 2], h[i * 4 + 3]}, (f32x4*)(so + i * 4));
    }
}

__device__ __forceinline__ void phase_gatednorm(PP P, int gw, int nw, const int tid) {
    const int lane = tid & 63;
    char* ws = P->ws;
    const bf16_t* ybuf = (const bf16_t*)(ws + W_Y); const bf16_t* zbuf = (const bf16_t*)(ws + W_Z);
    bf16_t* mix = (bf16_t*)(ws + W_MIX);
    for (int row0 = gw; row0 < TT; row0 += 4 * nw) {
        u32x2 yv[4][4], zv[4][4];
#pragma unroll
        for (int r = 0; r < 4; ++r) { const int row = row0 + r * nw; if (row < TT) {
#pragma unroll
            for (int j = 0; j < 4; ++j) { yv[r][j] = *(const u32x2*)(ybuf + (size_t)row * 1024 + j * 256 + lane * 4); zv[r][j] = *(const u32x2*)(zbuf + (size_t)row * 1024 + j * 256 + lane * 4); } } }
#pragma unroll
        for (int r = 0; r < 4; ++r) { const int row = row0 + r * nw; if (row < TT) {
            float t[4][4]; float ss0 = 0.f, ss1 = 0.f;
#pragma unroll
            for (int j = 0; j < 4; ++j) {
                const float y0 = bflo(yv[r][j].x), y1 = bfhi(yv[r][j].x), y2 = bflo(yv[r][j].y), y3 = bfhi(yv[r][j].y);
                const float z0 = bflo(zv[r][j].x), z1 = bfhi(zv[r][j].x), z2 = bflo(zv[r][j].y), z3 = bfhi(zv[r][j].y);
                t[j][0] = y0 * silu_f(z0); t[j][1] = y1 * silu_f(z1); t[j][2] = y2 * silu_f(z2); t[j][3] = y3 * silu_f(z3);
                const float q = t[j][0] * t[j][0] + t[j][1] * t[j][1] + t[j][2] * t[j][2] + t[j][3] * t[j][3];
                if (j < 2) ss0 += q; else ss1 += q;
            }
            ss0 = wave_sum(ss0); ss1 = wave_sum(ss1);
            const float r0 = rsqrtf(ss0 * (1.0f / 512.0f) + EPS), r1 = rsqrtf(ss1 * (1.0f / 512.0f) + EPS);
#pragma unroll
            for (int j = 0; j < 4; ++j) {
                const float rr = j < 2 ? r0 : r1;
                const f32x4 g4 = *(const f32x4*)(P->ssm_norm + j * 256 + lane * 4);
                u32x2 o; o.x = pk2(t[j][0] * rr * g4[0], t[j][1] * rr * g4[1]); o.y = pk2(t[j][2] * rr * g4[2], t[j][3] * rr * g4[3]);
                *(u32x2*)(mix + (size_t)row * 2048 + j * 256 + lane * 4) = o;
            }
        } }
    }
}

__device__ __forceinline__ void phase_norm(PP P, const float* gain, bool final_out, int gw, int nw, const int tid) {
    const int lane = tid & 63;
    char* ws = P->ws;
    const bf16_t* hb = (const bf16_t*)(ws + W_H);
    const float* ss3 = (const float*)(ws + W_SS3);
    for (int row0 = gw; row0 < TT; row0 += 4 * nw) {
        u32x2 xv[4][4]; float sq[4];
#pragma unroll
        for (int r = 0; r < 4; ++r) { const int row = row0 + r * nw; if (row < TT) { sq[r] = ss3[row];
#pragma unroll
            for (int j = 0; j < 4; ++j) xv[r][j] = *(const u32x2*)(hb + (size_t)row * 1024 + j * 256 + lane * 4); } }
#pragma unroll
        for (int r = 0; r < 4; ++r) { const int row = row0 + r * nw; if (row < TT) {
            const float rstd = rsqrtf(sq[r] * (1.0f / 1024.0f) + EPS);
#pragma unroll
            for (int j = 0; j < 4; ++j) {
                const f32x4 g4 = *(const f32x4*)(gain + j * 256 + lane * 4);
                const f32x4 x = (f32x4){bflo(xv[r][j].x), bfhi(xv[r][j].x), bflo(xv[r][j].y), bfhi(xv[r][j].y)};
                __builtin_nontemporal_store(x * rstd * g4, (f32x4*)(P->out + O_YP + (size_t)row * 1024 + j * 256 + lane * 4));
            }
        } }
    }
}

__device__ __forceinline__ void attn_sample(PP P, int item, char* shm, const int tid) {
    const int w = tid >> 6, lane = tid & 63, fr = lane & 15, fq = lane >> 4;
    const int b = item >> 2, hh = item & 3;
    char* ws = P->ws;
    const bf16_t* qb = (const bf16_t*)(ws + W_Q);
    float* sc = (float*)shm;
    float* part = (float*)(shm + 4096);
    const float* vp = P->cache_v + ((size_t)(b * 256 + w * 32) * 4 + hh) * 256 + lane * 4;
    f32x4 v0[16], v1[16];
#pragma unroll
    for (int mm = 0; mm < 16; ++mm) v0[mm] = __builtin_nontemporal_load((const f32x4*)(vp + (size_t)mm * 1024));
    bf16x8 qf[8];
#pragma unroll
    for (int kk = 0; kk < 8; ++kk) {
        bf16x8 z = {0, 0, 0, 0, 0, 0, 0, 0};
        if (fr < 4) z = *(const bf16x8*)(qb + (size_t)(TP + b * 4 + fr) * 1024 + hh * 256 + kk * 32 + fq * 8);
        qf[kk] = z;
    }
#pragma unroll
    for (int mt = 0; mt < 2; ++mt) {
        const int key = w * 32 + mt * 16 + fr;
        const float* kp = P->cache_k + ((size_t)(b * 256 + key) * 4 + hh) * 256 + fq * 8;
        f32x4 k0[8], k1[8];
#pragma unroll
        for (int kk = 0; kk < 8; ++kk) { k0[kk] = __builtin_nontemporal_load((const f32x4*)(kp + kk * 32)); k1[kk] = __builtin_nontemporal_load((const f32x4*)(kp + kk * 32 + 4)); }
        f32x4 acc = (f32x4){0.f, 0.f, 0.f, 0.f};
#pragma unroll
        for (int kk = 0; kk < 8; ++kk) {
            u32x4 pk; pk.x = pk2(k0[kk][0], k0[kk][1]); pk.y = pk2(k0[kk][2], k0[kk][3]); pk.z = pk2(k1[kk][0], k1[kk][1]); pk.w = pk2(k1[kk][2], k1[kk][3]);
            acc = __builtin_amdgcn_mfma_f32_16x16x32_bf16(qf[kk], __builtin_bit_cast(bf16x8, pk), acc, 0, 0, 0);
        }
        if (fq == 0) {
#pragma unroll
            for (int j = 0; j < 4; ++j) sc[j * 256 + w * 32 + mt * 16 + fr] = acc[j];
        }
    }
    LDS_BARRIER();
#pragma unroll
    for (int mm = 0; mm < 16; ++mm) v1[mm] = __builtin_nontemporal_load((const f32x4*)(vp + (size_t)(16 + mm) * 1024));
    if (w < 4) {
        f32x4 s = *(const f32x4*)(sc + w * 256 + lane * 4);
        float m = fmaxf(fmaxf(s[0], s[1]), fmaxf(s[2], s[3])); m = wave_max(m);
        s[0] = __expf(s[0] - m); s[1] = __expf(s[1] - m); s[2] = __expf(s[2] - m); s[3] = __expf(s[3] - m);
        float su = (s[0] + s[1]) + (s[2] + s[3]); su = wave_sum(su);
        const float inv = 1.0f / su;
        *(f32x4*)(sc + w * 256 + lane * 4) = s * inv;
    }
    LDS_BARRIER();
    {
        f32x4 o[4];
#pragma unroll
        for (int i = 0; i < 4; ++i) o[i] = (f32x4){0.f, 0.f, 0.f, 0.f};
#pragma unroll
        for (int mm = 0; mm < 16; ++mm) {
#pragma unroll
            for (int i = 0; i < 4; ++i) o[i] += sc[i * 256 + w * 32 + mm] * v0[mm];
        }
#pragma unroll
        for (int mm = 0; mm < 16; ++mm) {
#pragma unroll
            for (int i = 0; i < 4; ++i) o[i] += sc[i * 256 + w * 32 + 16 + mm] * v1[mm];
        }
#pragma unroll
        for (int i = 0; i < 4; ++i) *(f32x4*)(part + (w * 4 + i) * 256 + lane * 4) = o[i];
    }
    LDS_BARRIER();
    {
        const int i = tid >> 7, d2 = (tid & 127) * 2;
        float s0 = 0.f, s1 = 0.f;
#pragma unroll
        for (int ww = 0; ww < 8; ++ww) { s0 += part[(ww * 4 + i) * 256 + d2]; s1 += part[(ww * 4 + i) * 256 + d2 + 1]; }
        *(unsigned*)((bf16_t*)(ws + W_O) + (size_t)(TP + b * 4 + i) * 1024 + hh * 256 + d2) = pk2(s0, s1);
    }
    LDS_BARRIER();
}

__device__ __forceinline__ void phase_ffnconv(PP P, int gtid, int nthreads) {
    char* ws = P->ws;
    const bf16_t* u = (const bf16_t*)(ws + W_U);
    bf16_t* act = (bf16_t*)(ws + W_ACT);
    for (int idx = gtid; idx < 1152 * 352; idx += nthreads) {
        const int run = idx / 352, cg = idx % 352;
        const bool samp = run >= 1024;
        int t0, len, bidx, tl0;
        if (!samp) { t0 = run * 16; len = 16; bidx = t0 >> 11; tl0 = t0 & 2047; } else { bidx = run - 1024; t0 = TP + bidx * 4; len = 4; tl0 = 0; }
        const int cgc = cg * 8, cvc = 2816 + cg * 8;
        float wg0[8], wg1[8], wg2[8], wv0[8], wv1[8], wv2[8], bg[8], bv[8], hg0[8], hg1[8], hv0[8], hv1[8];
#pragma unroll
        for (int e = 0; e < 8; ++e) {
            wg0[e] = P->ffn_w[cgc + e]; wg1[e] = P->ffn_w[5632 + cgc + e]; wg2[e] = P->ffn_w[11264 + cgc + e];
            wv0[e] = P->ffn_w[cvc + e]; wv1[e] = P->ffn_w[5632 + cvc + e]; wv2[e] = P->ffn_w[11264 + cvc + e];
            bg[e] = P->ffn_b[cgc + e]; bv[e] = P->ffn_b[cvc + e];
        }
        if (samp) {
#pragma unroll
            for (int e = 0; e < 8; ++e) {
                hg0[e] = P->state_ffn[(size_t)(bidx * 2 + 0) * 5632 + cgc + e]; hg1[e] = P->state_ffn[(size_t)(bidx * 2 + 1) * 5632 + cgc + e];
                hv0[e] = P->state_ffn[(size_t)(bidx * 2 + 0) * 5632 + cvc + e]; hv1[e] = P->state_ffn[(size_t)(bidx * 2 + 1) * 5632 + cvc + e];
            }
        } else if (tl0 > 0) {
            unpack8(ld8(u + (size_t)(t0 - 2) * 5632 + cgc), hg0); unpack8(ld8(u + (size_t)(t0 - 1) * 5632 + cgc), hg1);
            unpack8(ld8(u + (size_t)(t0 - 2) * 5632 + cvc), hv0); unpack8(ld8(u + (size_t)(t0 - 1) * 5632 + cvc), hv1);
        } else {
#pragma unroll
            for (int e = 0; e < 8; ++e) { hg0[e] = 0.f; hg1[e] = 0.f; hv0[e] = 0.f; hv1[e] = 0.f; }
        }
        for (int jb = 0; jb < len; jb += 8) {
        u32x4 rg[8], rv[8];
        const bf16_t* ub = u + (size_t)(t0 + jb) * 5632 + cgc;
#pragma unroll
        for (int jj = 0; jj < 8; ++jj) { if (jb + jj < len) { rg[jj] = ld8(ub + (size_t)jj * 5632); rv[jj] = ld8(ub + (size_t)jj * 5632 + 2816); } }
#pragma unroll
        for (int jj = 0; jj < 8; ++jj) {
            const int j = jb + jj;
            if (j < len) {
            float ug[8], uv[8], o8[8];
            unpack8(rg[jj], ug); unpack8(rv[jj], uv);
#pragma unroll
            for (int e = 0; e < 8; ++e) {
                const float gc = bg[e] + wg0[e] * hg0[e] + wg1[e] * hg1[e] + wg2[e] * ug[e];
                const float vc = bv[e] + wv0[e] * hv0[e] + wv1[e] * hv1[e] + wv2[e] * uv[e];
                o8[e] = silu_f(gc) * vc;
            }
            *(u32x4*)(act + (size_t)(t0 + j) * 2816 + cgc) = pack8(o8);
            float* o = nullptr;
            if (samp) { if (j >= 2) o = P->out + O_FFNS + (size_t)(bidx * 2 + j - 2) * 5632; }
            else { const int tl = tl0 + j; if (tl >= 2046) o = P->out + O_FFNP + (size_t)(bidx * 2 + tl - 2046) * 5632; }
            if (o) {
#pragma unroll
                for (int e = 0; e < 8; ++e) { o[cgc + e] = ug[e]; o[cvc + e] = uv[e]; }
            }
#pragma unroll
            for (int e = 0; e < 8; ++e) { hg0[e] = hg1[e]; hg1[e] = ug[e]; hv0[e] = hv1[e]; hv1[e] = uv[e]; }
            }
        }
        }
    }
}

#define XB_TMO      128
#define XB_XCNT(j)  (256  + 64 * (j))
#define XB_XSUB(j)  (1280 + 64 * (j))
#define XB_XGEN(j)  (2304 + 64 * (j))
#define XB_TOP      3328
#define XB_TOPGEN   3392
#define XCD_BAR_WORDS 3456
#define XB_SPIN_CAP (1u << 18)
__device__ __forceinline__ unsigned xb_ld(unsigned* p)              { return __hip_atomic_load(p, __ATOMIC_RELAXED, __HIP_MEMORY_SCOPE_AGENT); }
__device__ __forceinline__ unsigned xb_add(unsigned* p, unsigned v) { return __hip_atomic_fetch_add(p, v, __ATOMIC_RELAXED, __HIP_MEMORY_SCOPE_AGENT); }
__device__ __forceinline__ unsigned xb_xcc_id() { return (unsigned)__builtin_amdgcn_s_getreg((3 << 11) | 20) & 0xFu; }
#define XB_SPIN(cond, bar) do { unsigned _sp = 0; while (cond) { __builtin_amdgcn_s_sleep(1); \
    if ((++_sp & 255u) == 0u) { if (xb_ld(&(bar)[XB_TMO])) break; if (_sp > XB_SPIN_CAP) { atomicAdd(&(bar)[XB_TMO], 1u); break; } } } } while (0)
__device__ __forceinline__ void xcd_barrier_complete(unsigned* bar, unsigned x, unsigned& nloc, unsigned& nx) {
    const unsigned G = gridDim.x;
    unsigned sum, cnt, mine, sp = 0u;
    for (;;) {
        sum = 0u; cnt = 0u; mine = 0u;
#pragma unroll
        for (unsigned j = 0; j < 16; ++j) { const unsigned c = xb_ld(&bar[XB_XCNT(j)]); sum += c; cnt += (c > 0u) ? 1u : 0u; mine = (j == x) ? c : mine; }
        if (sum == G) break;
        __builtin_amdgcn_s_sleep(1);
        if ((++sp & 255u) == 0u) { if (xb_ld(&bar[XB_TMO])) break; if (sp > XB_SPIN_CAP) { atomicAdd(&bar[XB_TMO], 1u); break; } }
    }
    nloc = mine > 0u ? mine : 1u; nx = cnt > 0u ? cnt : 1u;
}
__device__ __forceinline__ void xcd_barrier(unsigned* bar, volatile LDSB unsigned* st, const int tid) {
    asm volatile("s_waitcnt vmcnt(0)" ::: "memory");
    __syncthreads();
    if (tid == 0) {
        const unsigned x = xb_xcc_id();
        __builtin_amdgcn_s_waitcnt(0);
        unsigned nloc = st[0], nx = st[1];
        if (nloc == 0u) { xcd_barrier_complete(bar, x, nloc, nx); st[0] = nloc; st[1] = nx; }
        const unsigned old = xb_add(&bar[XB_XSUB(x)], 1u);
        const unsigned gen = old / nloc;
        if (old + 1u == (gen + 1u) * nloc) {
            __builtin_amdgcn_fence(__ATOMIC_RELEASE, "agent");
            asm volatile("s_waitcnt vmcnt(0)" ::: "memory");
            const unsigned og = xb_add(&bar[XB_TOP], 1u);
            const unsigned tg = og / nx;
            if (og + 1u == (tg + 1u) * nx) xb_add(&bar[XB_TOPGEN], 1u);
            else XB_SPIN(xb_ld(&bar[XB_TOPGEN]) == tg, bar);
            __builtin_amdgcn_fence(__ATOMIC_ACQUIRE, "agent");
            xb_add(&bar[XB_XGEN(x)], 1u);
            asm volatile("s_waitcnt vmcnt(0)" ::: "memory");
        } else {
            XB_SPIN(xb_ld(&bar[XB_XGEN(x)]) == gen, bar);
            __builtin_amdgcn_fence(__ATOMIC_ACQUIRE, "agent");
            asm volatile("s_waitcnt vmcnt(0)" ::: "memory");
        }
    }
    __syncthreads();
}

extern __shared__ __attribute__((aligned(16))) char smem[];

__global__ void __launch_bounds__(NTHR) hybrid_fwd(Params Pin) {
    char* shm = smem;
    volatile LDSB unsigned* bst = (volatile LDSB unsigned*)(smem + 139264);
    if (threadIdx.x == 0) { bst[0] = 0u; bst[1] = 0u; (void)xb_add((unsigned*)(Pin.ws + W_BAR) + XB_XCNT(xb_xcc_id()), 1u); }
    __syncthreads();
    for (int ph = Pin.ph_lo; ph < Pin.ph_hi; ++ph) {
        if (ph == 6 || ph == 11) continue;
        const int reps = ((REPEAT_MASK >> ph) & 1) ? 2 : 1;
        for (int rep = 0; rep < reps; ++rep) {
        if (rep > 0) xcd_barrier((unsigned*)(Pin.ws + W_BAR), bst, threadIdx.x);
        int tid = threadIdx.x, blk = blockIdx.x, nblk = gridDim.x;
        asm volatile("" : "+v"(tid));
        asm volatile("" : "+s"(blk), "+s"(nblk));
        PP P = (PP)__builtin_amdgcn_kernarg_segment_ptr();
        asm volatile("" : "+s"(P));
        const int lb = (blk & 7) * (nblk >> 3) + (blk >> 3);
        const int gtid = blk * NTHR + tid, nthreads = nblk * NTHR;
        const int gw = blk * 8 + (tid >> 6), nw = nblk * 8;
        switch (ph) {
#if PHASE_MASK & 1
        case 0: phase_prep(P, shm, blk, nblk, tid); break;
#endif
#if PHASE_MASK & 4
        case 2: phase_convpool(P, gtid, nthreads); break;
#endif
#if PHASE_MASK & 8
        case 3:
            if (blk & 1) { int it = blk; for (; it + nblk < 2048; it += 2 * nblk) ssd_sample<2>(P, it, nblk, tid); for (; it < 2048; it += nblk) ssd_sample<1>(P, it, nblk, tid); }
            for (int it = blk; it < 256; it += nblk) ssd_prompt(P, it, shm, tid);
            if (!(blk & 1)) { int it = blk; for (; it + nblk < 2048; it += 2 * nblk) ssd_sample<2>(P, it, nblk, tid); for (; it < 2048; it += nblk) ssd_sample<1>(P, it, nblk, tid); }
            break;
#endif
#if PHASE_MASK & 16
        case 4: phase_gatednorm(P, gw, nw, tid); break;
#endif
#if PHASE_MASK & 64
        case 6: phase_norm(P, P->norm_mem, false, gw, nw, tid); break;
        case 11: phase_norm(P, P->norm_ffn, false, gw, nw, tid); break;
        case 15: phase_norm(P, P->final_norm, true, gw, nw, tid); break;
#endif
#if PHASE_MASK & 8192
        case 13: phase_ffnconv(P, gtid, nthreads); break;
#endif
        default: break;
        }
#if PHASE_MASK & 256
        if (ph == 8 && (blk & 1)) { for (int it = blk; it < 512; it += nblk) attn_sample(P, it, shm, tid); __syncthreads(); }
#endif
#if PHASE_MASK & 2
        if (ph == 1 || ph == 5 || ph == 7 || ph == 8 || ph == 9 || ph == 10 || ph == 12 || ph == 14) gemm_phase(P, ph, shm, lb, blk, nblk, tid);
#endif
#if PHASE_MASK & 256
        if (ph == 9 && !(blk & 1)) { for (int it = blk; it < 512; it += nblk) attn_sample(P, it, shm, tid); }
#endif
        }
        if (ph + 1 < Pin.ph_hi && ph != 8) xcd_barrier((unsigned*)(Pin.ws + W_BAR), bst, threadIdx.x);
        if (ph == 8) { asm volatile("s_waitcnt vmcnt(0)" ::: "memory"); __syncthreads(); }
        if (EXTRA_SYNCS && ph == 0) { for (int i = 0; i < EXTRA_SYNCS; ++i) xcd_barrier((unsigned*)(Pin.ws + W_BAR), bst, threadIdx.x); }
    }
}

extern "C" void kernel_launch(void* const* d_in, const int* in_sizes, int n_in, void* d_out, int out_size, void* d_ws, size_t ws_size, hipStream_t stream) {
    static int grid_blocks = 0;
    if (!grid_blocks) {
        int dev = 0, cus = 0, per_cu = 0;
        hipGetDevice(&dev);
        hipDeviceGetAttribute(&cus, hipDeviceAttributeMultiprocessorCount, dev);
        hipFuncSetAttribute((const void*)hybrid_fwd, hipFuncAttributeMaxDynamicSharedMemorySize, LDS_BYTES);
        hipOccupancyMaxActiveBlocksPerMultiprocessor(&per_cu, hybrid_fwd, NTHR, LDS_BYTES);
        if (per_cu < 1) per_cu = 1;
        grid_blocks = cus * 1;
        grid_blocks &= ~7;
        if (grid_blocks < 8) grid_blocks = 8;
    }
    Params p{};
    const float* const* in = (const float* const*)d_in;
    p.x_prompt = in[0]; p.x_sample = in[1]; p.mem_prompt = in[2]; p.state_ssm = in[3]; p.state_conv = in[4]; p.state_pool = in[5]; p.state_ffn = in[6];
    p.cache_k = in[7]; p.cache_v = in[8]; p.norm_mix = in[9]; p.w_in = in[10]; p.conv_w = in[11]; p.conv_b = in[12]; p.dt_bias = in[13]; p.a_log = in[14];
    p.ssm_d = in[15]; p.ssm_norm = in[16]; p.w_pool = in[17]; p.pool_scale = in[18]; p.w_out = in[19]; p.norm_mem = in[20]; p.norm_memkv = in[21];
    p.w_mq = in[22]; p.w_mk = in[23]; p.w_mv = in[24]; p.w_mo = in[25]; p.norm_ffn = in[26]; p.w_up = in[27]; p.ffn_w = in[28]; p.ffn_b = in[29];
    p.w_down = in[30]; p.final_norm = in[31];
    p.out = (float*)d_out; p.ws = (char*)d_ws; p.ph_lo = 0; p.ph_hi = 16;
    hipMemsetAsync((char*)d_ws + W_BAR, 0, 16384, stream);
    void* args[] = {&p};
    hipError_t e = hipLaunchCooperativeKernel((const void*)hybrid_fwd, dim3(grid_blocks), dim3(NTHR), args, LDS_BYTES, stream);
    if (e != hipSuccess) fprintf(stderr, "cooperative launch failed: %s (grid %d)\n", hipGetErrorString(e), grid_blocks);
}
```

```cpp
#include <hip/hip_runtime.h>
#include <hip/hip_cooperative_groups.h>
#include <cstdio>
namespace cg = cooperative_groups;

typedef unsigned short bf16_t;
typedef short bf16x8 __attribute__((ext_vector_type(8)));
typedef short s16x4 __attribute__((ext_vector_type(4)));
typedef float f32x4 __attribute__((ext_vector_type(4)));
typedef unsigned u32x4 __attribute__((ext_vector_type(4)));
typedef unsigned u32x2 __attribute__((ext_vector_type(2)));
#define LDSB __attribute__((address_space(3)))

constexpr int TP = 16384, TS = 512, TT = TP + TS;
constexpr int NTHR = 512;
constexpr int LDS_BYTES = 139264 + 256;
constexpr float EPS = 1e-6f;
#ifndef PHASE_MASK
#define PHASE_MASK 0xFFFF
#endif
#ifndef REPEAT_MASK
#define REPEAT_MASK 0
#endif
#ifndef PROBE3
#define PROBE3 0
#endif
#ifndef EXTRA_SYNCS
#define EXTRA_SYNCS 0
#endif

constexpr size_t O_YP = 0;
constexpr size_t O_YS = O_YP + (size_t)TP * 1024;
constexpr size_t O_SSMP = O_YS + (size_t)TS * 1024;
constexpr size_t O_SSMS = O_SSMP + (size_t)8 * 16 * 64 * 128;
constexpr size_t O_CONVP = O_SSMS + (size_t)128 * 16 * 64 * 128;
constexpr size_t O_CONVS = O_CONVP + (size_t)8 * 3 * 1536;
constexpr size_t O_POOLP = O_CONVS + (size_t)128 * 3 * 1536;
constexpr size_t O_POOLS = O_POOLP + (size_t)8 * 15 * 1024;
constexpr size_t O_FFNP = O_POOLS + (size_t)128 * 15 * 1024;
constexpr size_t O_FFNS = O_FFNP + (size_t)8 * 2 * 5632;
constexpr size_t O_MK = O_FFNS + (size_t)128 * 2 * 5632;
constexpr size_t O_MV = O_MK + (size_t)8 * 256 * 1024;

constexpr size_t W_WIN = 0;
constexpr size_t W_WPOOL = W_WIN + (size_t)3584 * 1024 * 2;
constexpr size_t W_WOUT = W_WPOOL + (size_t)4 * 256 * 256 * 2;
constexpr size_t W_WMQ = W_WOUT + (size_t)1024 * 2048 * 2;
constexpr size_t W_WMK = W_WMQ + (size_t)1024 * 1024 * 2;
constexpr size_t W_WMV = W_WMK + (size_t)1024 * 1024 * 2;
constexpr size_t W_WMO = W_WMV + (size_t)1024 * 1024 * 2;
constexpr size_t W_WUP = W_WMO + (size_t)1024 * 1024 * 2;
constexpr size_t W_WDOWN = W_WUP + (size_t)5632 * 1024 * 2;
constexpr size_t W_H = W_WDOWN + (size_t)1024 * 2816 * 2;
constexpr size_t W_HM = W_H + (size_t)TT * 1024 * 2;
constexpr size_t W_KB = W_HM + (size_t)2048 * 1024 * 2;
constexpr size_t W_VT = W_KB + (size_t)2048 * 1024 * 2;
constexpr size_t W_DT = W_VT + (size_t)2048 * 1024 * 2;
constexpr size_t W_XRES = W_DT + (size_t)TT * 16 * 4;
constexpr size_t W_ARENA = W_XRES + (size_t)TT * 1024 * 4;
constexpr size_t W_Z = W_ARENA;
constexpr size_t W_PROJ2 = W_Z + (size_t)TT * 1024 * 2;
constexpr size_t W_XACT = W_PROJ2 + (size_t)TT * 2560 * 2;
constexpr size_t W_POOLED = W_XACT + (size_t)TT * 1536 * 2;
constexpr size_t W_Y = W_POOLED + (size_t)TT * 1024 * 2;
constexpr size_t W_MIX = W_Y + (size_t)TT * 1024 * 2;
constexpr size_t W_END_A = W_MIX + (size_t)TT * 2048 * 2;
constexpr size_t W_Q = W_PROJ2;
constexpr size_t W_P = W_Q + (size_t)TT * 1024 * 2;
constexpr size_t W_O = W_P + (size_t)TP * 1024 * 2;
constexpr size_t W_U = W_ARENA;
constexpr size_t W_ACT = W_U + (size_t)TT * 5632 * 2;
constexpr size_t W_END_C = W_ACT + (size_t)TT * 2816 * 2;
constexpr size_t W_BAR = W_END_A;
constexpr size_t W_SS1 = W_BAR + 16384;
constexpr size_t W_SS2 = W_SS1 + (size_t)TT * 4;
constexpr size_t W_SS3 = W_SS2 + (size_t)TT * 4;
constexpr size_t W_WLO = W_SS3 + (size_t)TT * 4;
constexpr size_t W_TOTAL = W_WLO + (size_t)1024 * 1024 * 2;
static_assert(W_O + (size_t)TT * 1024 * 2 <= W_POOLED, "era B overflow");
static_assert(W_END_C <= W_END_A, "era C overflow");

struct Params {
    const float *x_prompt, *x_sample, *mem_prompt, *state_ssm, *state_conv, *state_pool, *state_ffn, *cache_k, *cache_v;
    const float *norm_mix, *w_in, *conv_w, *conv_b, *dt_bias, *a_log, *ssm_d, *ssm_norm, *w_pool, *pool_scale, *w_out;
    const float *norm_mem, *norm_memkv, *w_mq, *w_mk, *w_mv, *w_mo, *norm_ffn, *w_up, *ffn_w, *ffn_b, *w_down, *final_norm;
    float* out;
    char* ws;
    int ph_lo, ph_hi;
};

typedef const __attribute__((address_space(4))) Params* PP;

__device__ __forceinline__ unsigned pk2(float lo, float hi) { unsigned r; asm("v_cvt_pk_bf16_f32 %0, %1, %2" : "=v"(r) : "v"(lo), "v"(hi)); return r; }
__device__ __forceinline__ bf16_t f2bf(float f) { return (bf16_t)(pk2(f, 0.f) & 0xffffu); }
__device__ __forceinline__ float bf2f(bf16_t b) { return __uint_as_float(((unsigned)b) << 16); }
__device__ __forceinline__ float bflo(unsigned u) { return __uint_as_float(u << 16); }
__device__ __forceinline__ float bfhi(unsigned u) { return __uint_as_float(u & 0xffff0000u); }
__device__ __forceinline__ void unpack8(u32x4 v, float (&f)[8]) {
    f[0] = bflo(v.x); f[1] = bfhi(v.x); f[2] = bflo(v.y); f[3] = bfhi(v.y); f[4] = bflo(v.z); f[5] = bfhi(v.z); f[6] = bflo(v.w); f[7] = bfhi(v.w);
}
__device__ __forceinline__ u32x4 pack8(const float (&f)[8]) { u32x4 r; r.x = pk2(f[0], f[1]); r.y = pk2(f[2], f[3]); r.z = pk2(f[4], f[5]); r.w = pk2(f[6], f[7]); return r; }
__device__ __forceinline__ float wave_sum(float v) {
#pragma unroll
    for (int o = 1; o < 64; o <<= 1) v += __shfl_xor(v, o);
    return v;
}
__device__ __forceinline__ float wave_max(float v) {
#pragma unroll
    for (int o = 1; o < 64; o <<= 1) v = fmaxf(v, __shfl_xor(v, o));
    return v;
}
__device__ __forceinline__ float silu_f(float x) { return x * __builtin_amdgcn_rcpf(1.0f + __expf(-x)); }

constexpr int HTB = 128 * 64 * 2;
__device__ __forceinline__ int lds_byte(int r, int c) { const int st = (r >> 4) * 2 + (c >> 5), rr = r & 15, cc = c & 31, ob = rr * 64 + cc * 2; return st * 1024 + (ob ^ (((ob >> 9) & 1) << 5)); }
__device__ __forceinline__ void stage_rc(int b, int& R, int& C) { const int st = b / 1024, sb = b % 1024, swz = sb ^ (((sb >> 9) & 1) << 5); R = (st >> 1) * 16 + swz / 64; C = (st & 1) * 32 + (swz % 64) / 2; }

__device__ __forceinline__ int perm32(int rho) { const int n = rho >> 4, i = rho & 15; return 8 * (i >> 2) + 4 * n + (i & 3); }
__device__ __forceinline__ int invperm32(int c) { return 16 * ((c >> 2) & 1) + 4 * (c >> 3) + (c & 3); }
enum { E_PROJ = 0, E_MEMKV, E_POOL, E_OUT, E_Q, E_QK, E_PV, E_MO, E_UP, E_DOWN, E_FOLD };

template <int EK>
__device__ __forceinline__ float epi_apply(PP P, int row, int col, f32x4 v) {
    char* ws = P->ws;
    if constexpr (EK == E_PROJ) {
        u32x2 o; o.x = pk2(v[0], v[1]); o.y = pk2(v[2], v[3]);
        if (col < 1024) *(u32x2*)((bf16_t*)(ws + W_Z) + (size_t)row * 1024 + col) = o;
        else *(u32x2*)((bf16_t*)(ws + W_PROJ2) + (size_t)row * 2560 + (col - 1024)) = o;
    } else if constexpr (EK == E_MEMKV) {
        if (col < 1024) {
            *(f32x4*)(P->out + O_MK + (size_t)row * 1024 + col) = v;
            u32x2 o; o.x = pk2(v[0], v[1]); o.y = pk2(v[2], v[3]);
            *(u32x2*)((bf16_t*)(ws + W_KB) + (size_t)((row & ~31) + invperm32(row & 31)) * 1024 + col) = o;
        } else {
            const int c = col - 1024;
            *(f32x4*)(P->out + O_MV + (size_t)row * 1024 + c) = v;
            const int b = row >> 8, m = row & 255, hh = c >> 8, d = c & 255;
            bf16_t* vt = (bf16_t*)(ws + W_VT) + ((size_t)(b * 4 + hh) * 256 + (d & ~31) + invperm32(d & 31)) * 256 + m;
#pragma unroll
            for (int j = 0; j < 4; ++j) vt[j * 256] = f2bf(v[j]);
        }
    } else if constexpr (EK == E_POOL) {
        const f32x4 sc = *(const f32x4*)(P->pool_scale + col);
        u32x2 o; o.x = pk2(v[0] * sc[0], v[1] * sc[1]); o.y = pk2(v[2] * sc[2], v[3] * sc[3]);
        *(u32x2*)((bf16_t*)(ws + W_MIX) + (size_t)row * 2048 + 1024 + col) = o;
    } else if constexpr (EK == E_OUT) {
        const float* xin = row < TP ? P->x_prompt + (size_t)row * 1024 : P->x_sample + (size_t)(row - TP) * 1024;
        const f32x4 x = *(const f32x4*)(xin + col) + v;
        u32x2 o; o.x = pk2(x[0], x[1]); o.y = pk2(x[2], x[3]);
        *(u32x2*)((bf16_t*)(ws + W_H) + (size_t)row * 1024 + col) = o;
        return (x[0] * x[0] + x[1] * x[1]) + (x[2] * x[2] + x[3] * x[3]);
    } else if constexpr (EK == E_Q) {
        u32x2 o; o.x = pk2(v[0], v[1]); o.y = pk2(v[2], v[3]);
        *(u32x2*)((bf16_t*)(ws + W_Q) + (size_t)row * 1024 + col) = o;
    } else if constexpr (EK == E_PV) {
        u32x2 o; o.x = pk2(v[0], v[1]); o.y = pk2(v[2], v[3]);
        *(u32x2*)((bf16_t*)(ws + W_O) + (size_t)row * 1024 + col) = o;
    } else if constexpr (EK == E_MO || EK == E_DOWN) {
        u32x2* hp = (u32x2*)((bf16_t*)(ws + W_H) + (size_t)row * 1024 + col);
        const u32x2 hv = *hp;
        const f32x4 x = (f32x4){bflo(hv.x), bfhi(hv.x), bflo(hv.y), bfhi(hv.y)} + v;
        u32x2 o; o.x = pk2(x[0], x[1]); o.y = pk2(x[2], x[3]);
        *hp = o;
        return (x[0] * x[0] + x[1] * x[1]) + (x[2] * x[2] + x[3] * x[3]);
    } else if constexpr (EK == E_UP) {
        u32x2 o; o.x = pk2(v[0], v[1]); o.y = pk2(v[2], v[3]);
        *(u32x2*)((bf16_t*)(ws + W_U) + (size_t)row * 5632 + col) = o;
    }
    return 0.f;
}
template <int EK>
__device__ __forceinline__ float epi_rowscale(PP P, int row) {
    if constexpr (EK == E_Q) return rsqrtf(((const float*)(P->ws + W_SS1))[row] * (1.0f / 1024.0f) + EPS) * 0.0625f;
    else if constexpr (EK == E_UP) return rsqrtf(((const float*)(P->ws + W_SS2))[row] * (1.0f / 1024.0f) + EPS);
    else return 1.0f;
}
__device__ __forceinline__ float epi_apply_rt(PP P, int ekind, int row, int col, f32x4 v) {
    switch (ekind) {
    case E_FOLD: { u32x2 o; o.x = pk2(v[0], v[1]); o.y = pk2(v[2], v[3]); const int prow = (row & ~31) + invperm32(row & 31); *(u32x2*)((bf16_t*)(P->ws + W_WOUT) + (size_t)prow * 2048 + 1024 + col) = o; return 0.f; }
    case E_OUT: return epi_apply<E_OUT>(P, row, col, v);
    case E_Q: return epi_apply<E_Q>(P, row, col, v * epi_rowscale<E_Q>(P, row));
    case E_MO: return epi_apply<E_MO>(P, row, col, v);
    default: return epi_apply<E_DOWN>(P, row, col, v);
    }
}
template <int EK>
__device__ __forceinline__ void epi_loop(PP P, const f32x4 (&acc)[2][2][4][2], int rbase, int cbase, int fq) {
    if constexpr (EK == E_PROJ || EK == E_UP || EK == E_Q || EK == E_PV || EK == E_OUT || EK == E_MO || EK == E_DOWN) {
        const int cb8 = cbase + 4 * fq;
#pragma unroll
        for (int ai = 0; ai < 2; ++ai)
#pragma unroll
            for (int m = 0; m < 4; ++m) {
                const int row = rbase + ai * 128 + m * 16;
                const float rs = epi_rowscale<EK>(P, row);
                float ss = 0.f;
#pragma unroll
                for (int bj = 0; bj < 2; ++bj) {
                    f32x4 v0 = acc[ai][bj][m][0], v1 = acc[ai][bj][m][1];
                    const int col = cb8 + bj * 128;
                    if constexpr (EK == E_PROJ || EK == E_UP || EK == E_Q) { v0 *= rs; v1 *= rs; }
                    if constexpr (EK == E_OUT) {
                        const float* xin = (row < TP ? P->x_prompt + (size_t)row * 1024 : P->x_sample + (size_t)(row - TP) * 1024) + col;
                        v0 += *(const f32x4*)xin; v1 += *(const f32x4*)(xin + 4);
                    }
                    if constexpr (EK == E_MO || EK == E_DOWN) {
                        const u32x4 hv = *(const u32x4*)((const bf16_t*)(P->ws + W_H) + (size_t)row * 1024 + col);
                        v0 += (f32x4){bflo(hv.x), bfhi(hv.x), bflo(hv.y), bfhi(hv.y)}; v1 += (f32x4){bflo(hv.z), bfhi(hv.z), bflo(hv.w), bfhi(hv.w)};
                    }
                    if constexpr (EK == E_OUT || EK == E_MO || EK == E_DOWN) ss += ((v0[0] * v0[0] + v0[1] * v0[1]) + (v0[2] * v0[2] + v0[3] * v0[3])) + ((v1[0] * v1[0] + v1[1] * v1[1]) + (v1[2] * v1[2] + v1[3] * v1[3]));
                    u32x4 o; o.x = pk2(v0[0], v0[1]); o.y = pk2(v0[2], v0[3]); o.z = pk2(v1[0], v1[1]); o.w = pk2(v1[2], v1[3]);
                    if constexpr (EK == E_UP) *(u32x4*)((bf16_t*)(P->ws + W_U) + (size_t)row * 5632 + col) = o;
                    else if constexpr (EK == E_Q) *(u32x4*)((bf16_t*)(P->ws + W_Q) + (size_t)row * 1024 + col) = o;
                    else if constexpr (EK == E_PV) *(u32x4*)((bf16_t*)(P->ws + W_O) + (size_t)row * 1024 + col) = o;
                    else if constexpr (EK == E_PROJ) { if (col < 1024) *(u32x4*)((bf16_t*)(P->ws + W_Z) + (size_t)row * 1024 + col) = o;
                           else *(u32x4*)((bf16_t*)(P->ws + W_PROJ2) + (size_t)row * 2560 + (col - 1024)) = o; }
                    else *(u32x4*)((bf16_t*)(P->ws + W_H) + (size_t)row * 1024 + col) = o;
                }
                if constexpr (EK == E_OUT || EK == E_MO || EK == E_DOWN) {
                    ss += __shfl_xor(ss, 16); ss += __shfl_xor(ss, 32);
                    if (fq == 0) unsafeAtomicAdd((float*)(P->ws + (EK == E_OUT ? W_SS1 : EK == E_MO ? W_SS2 : W_SS3)) + row, ss);
                }
            }
        return;
    }
#pragma unroll
    for (int ai = 0; ai < 2; ++ai)
#pragma unroll
        for (int m = 0; m < 4; ++m) {
            const int row = rbase + ai * 128 + m * 16;
            const float rs = epi_rowscale<EK>(P, row);
            float ss = 0.f;
#pragma unroll
            for (int bj = 0; bj < 2; ++bj)
#pragma unroll
                for (int n = 0; n < 2; ++n) {
                    if constexpr (EK == E_Q || EK == E_UP) ss += epi_apply<EK>(P, row, cbase + bj * 128 + n * 16, acc[ai][bj][m][n] * rs);
                    else ss += epi_apply<EK>(P, row, cbase + bj * 128 + n * 16, acc[ai][bj][m][n]);
                }
            if constexpr (EK == E_OUT || EK == E_MO || EK == E_DOWN) {
                ss += __shfl_xor(ss, 16); ss += __shfl_xor(ss, 32);
                if (fq == 0) unsafeAtomicAdd((float*)(P->ws + (EK == E_OUT ? W_SS1 : EK == E_MO ? W_SS2 : W_SS3)) + row, ss);
            }
        }
}

struct PhaseCfg { const char* A; const char* B; int lda, ldb, K, nbig, nsmall, ncol64, ekind; };
__device__ __forceinline__ PhaseCfg phase_cfg(PP P, int gp) {
    const char* ws = P->ws; PhaseCfg c;
    switch (gp) {
    case 1:  c.A = ws + W_H;      c.B = ws + W_WIN;   c.lda = 1024; c.ldb = 1024; c.K = 1024; c.nbig = 66 * 14 + 64; c.nsmall = 512; c.ncol64 = 16; c.ekind = E_PROJ; break;
    case 3:  c.A = ws + W_POOLED; c.B = ws + W_WPOOL; c.lda = 1024; c.ldb = 256;  c.K = 256;  c.nbig = 256; c.nsmall = 256; c.ncol64 = 16; c.ekind = E_POOL; break;
    case 5:  c.A = ws + W_MIX;    c.B = ws + W_WOUT;  c.lda = 2048; c.ldb = 2048; c.K = 2048; c.nbig = 256; c.nsmall = 256; c.ncol64 = 16; c.ekind = E_OUT; break;
    case 7:  c.A = ws + W_H;      c.B = ws + W_WMQ;   c.lda = 1024; c.ldb = 1024; c.K = 1024; c.nbig = 256; c.nsmall = 256; c.ncol64 = 16; c.ekind = E_Q; break;
    case 8:  c.A = ws + W_Q;      c.B = ws + W_KB;    c.lda = 1024; c.ldb = 1024; c.K = 256;  c.nbig = 256; c.nsmall = 0;   c.ncol64 = 16; c.ekind = E_QK; break;
    case 9:  c.A = ws + W_P;      c.B = ws + W_VT;    c.lda = 1024; c.ldb = 256;  c.K = 256;  c.nbig = 256; c.nsmall = 0;   c.ncol64 = 16; c.ekind = E_PV; break;
    case 10: c.A = ws + W_O;      c.B = ws + W_WMO;   c.lda = 1024; c.ldb = 1024; c.K = 1024; c.nbig = 256; c.nsmall = 256; c.ncol64 = 16; c.ekind = E_MO; break;
    case 12: c.A = ws + W_H;      c.B = ws + W_WUP;   c.lda = 1024; c.ldb = 1024; c.K = 1024; c.nbig = 66 * 22; c.nsmall = 0; c.ncol64 = 88; c.ekind = E_UP; break;
    default: c.A = ws + W_ACT;    c.B = ws + W_WDOWN; c.lda = 2816; c.ldb = 2816; c.K = 2816; c.nbig = 256; c.nsmall = 256; c.ncol64 = 16; c.ekind = E_DOWN; break;
    }
    return c;
}
struct UnitD { const char* A; const char* B; int row0, col0, ekind; };
__device__ __forceinline__ void map_unit(int L, int nM, int nN, int& pm, int& pn) {
    const int nwg = nM * nN, q = nwg >> 3, r = nwg & 7, xcd = L & 7, off = L >> 3;
    const int wgid = (xcd < r ? xcd * (q + 1) : r * (q + 1) + (xcd - r) * q) + off;
    const int nig = 8 * nN, gid = wgid / nig, fm = gid * 8, gsz = (nM - fm) < 8 ? (nM - fm) : 8;
    const int w = wgid - gid * nig;
    pm = fm + w % gsz; pn = w / gsz;
}
__device__ __forceinline__ UnitD unit_decode(PP P, const PhaseCfg& c, int gp, int L) {
    UnitD d; d.ekind = c.ekind;
    int pm, pn;
    switch (gp) {
    case 1:
        if (L < 924) { map_unit(L, 66, 14, pm, pn); d.A = c.A + (size_t)pm * 256 * 2048; d.B = c.B + (size_t)pn * 256 * 2048; }
        else { map_unit(L - 924, 8, 8, pm, pn); d.A = P->ws + W_HM + (size_t)pm * 256 * 2048; d.B = P->ws + W_WMK + (size_t)pn * 256 * 2048; d.ekind = E_MEMKV; }
        break;
    case 3: map_unit(L, 64, 4, pm, pn); d.A = c.A + (size_t)pm * 256 * 2048 + pn * 512; d.B = c.B + (size_t)pn * 131072; break;
    case 8: map_unit(L, 64, 4, pm, pn); d.A = c.A + (size_t)pm * 256 * 2048 + pn * 512; d.B = c.B + (size_t)(pm >> 3) * 256 * 2048 + pn * 512; break;
    case 9: map_unit(L, 64, 4, pm, pn); d.A = c.A + (size_t)pm * 256 * 2048 + pn * 512; d.B = c.B + (size_t)((pm >> 3) * 4 + pn) * 131072; break;
    case 12: map_unit(L, 66, 22, pm, pn); d.A = c.A + (size_t)pm * 256 * 2048; d.B = c.B + (size_t)pn * 256 * 2048; break;
    default: map_unit(L, 64, 4, pm, pn); d.A = c.A + (size_t)pm * 256 * c.lda * 2; d.B = c.B + (size_t)pn * 256 * c.ldb * 2; break;
    }
    d.row0 = pm * 256; d.col0 = pn * 256;
    return d;
}

__device__ __forceinline__ void gemm_phase(PP P, int gp, char* shm_g, int lb, int blk, int nblk, const int tid) {
    LDSB unsigned char* lds = (LDSB unsigned char*)shm_g;
    const int wid = __builtin_amdgcn_readfirstlane(tid >> 6), lane = tid & 63, wr = wid >> 2, wc = wid & 3, fr = lane & 15, fq = lane >> 4;
    const PhaseCfg cfg = phase_cfg(P, gp);
    const int K = cfg.K, nt = K / 64;
    unsigned voffA, voffB;
    { int R, C; stage_rc(tid * 16, R, C); voffA = (unsigned)(R * cfg.lda + C) * 2u; voffB = (unsigned)(R * cfg.ldb + C) * 2u; }
    const size_t qstepvoffA = (size_t)64 * cfg.lda * 2, qstepvoffB = (size_t)64 * cfg.ldb * 2;
    const size_t kstep = 128;
    const size_t hstepA = (size_t)128 * cfg.lda * 2, hstepB = (size_t)128 * cfg.ldb * 2;
    const unsigned ldsw = (unsigned)wid * 1024u;
    const int aoff = lds_byte(wr * 64 + fr, fq * 8), boff = lds_byte(wc * 32 + fr, fq * 8);
    const bool chain = (cfg.ekind != E_QK);
#define G_SA(b, h) (((b) * 2 + (h)) * HTB)
#define G_SB(b, h) ((4 + (b) * 2 + (h)) * HTB)
#define G_STAGE(bufoff, gbase, voff) do { \
        __builtin_amdgcn_global_load_lds((const unsigned*)((const char*)(gbase) + (voff)), (LDSB unsigned*)(lds + (bufoff) + ldsw), 16, 0, 0); \
        __builtin_amdgcn_global_load_lds((const unsigned*)((const char*)(gbase) + qstep##voff + (voff)), (LDSB unsigned*)(lds + (bufoff) + ldsw + 8192), 16, 0, 0); } while (0)
#define G_LDA(dst, b, h) do { _Pragma("unroll") for (int m = 0; m < 4; ++m) _Pragma("unroll") for (int k = 0; k < 2; ++k) dst[m][k] = *(const LDSB bf16x8*)(lds + G_SA(b, h) + aoff + m * 2048 + k * 1024); } while (0)
#define G_LDB(dst, b, h) do { _Pragma("unroll") for (int n = 0; n < 2; ++n) _Pragma("unroll") for (int k = 0; k < 2; ++k) dst[n][k] = *(const LDSB bf16x8*)(lds + G_SB(b, h) + boff + n * 2048 + k * 1024); } while (0)
#define G_MMA(ai, bj, Af, Bf) do { __builtin_amdgcn_s_setprio(1); _Pragma("unroll") for (int m = 0; m < 4; ++m) _Pragma("unroll") for (int n = 0; n < 2; ++n) _Pragma("unroll") for (int k = 0; k < 2; ++k) \
        acc[ai][bj][m][n] = __builtin_amdgcn_mfma_f32_16x16x32_bf16(Bf[n][k], Af[m][k], acc[ai][bj][m][n], 0, 0, 0); __builtin_amdgcn_s_setprio(0); } while (0)
#define G_WAIT_V(n) asm volatile("s_waitcnt vmcnt(" #n ")" ::: "memory")
#define G_WAIT_L(n) asm volatile("s_waitcnt lgkmcnt(" #n ")" ::: "memory")
#define G_BAR __builtin_amdgcn_s_barrier()
#define G_SCHED __builtin_amdgcn_sched_barrier(0)
    int u = blk;
    while (u < cfg.nbig) {
        UnitD cur = unit_decode(P, cfg, gp, u);
        f32x4 acc[2][2][4][2];
#pragma unroll
        for (int a = 0; a < 2; ++a)
#pragma unroll
            for (int b = 0; b < 2; ++b)
#pragma unroll
                for (int m = 0; m < 4; ++m)
#pragma unroll
                    for (int n = 0; n < 2; ++n) acc[a][b][m][n] = (f32x4){0.f, 0.f, 0.f, 0.f};
        bf16x8 At[4][2], B0[2][2], B1[2][2];
        const char* cA = cur.A; const char* cB = cur.B;
        G_STAGE(G_SB(0, 0), cB, voffB); G_STAGE(G_SA(0, 0), cA, voffA); G_STAGE(G_SB(0, 1), cB + hstepB, voffB); G_STAGE(G_SA(0, 1), cA + hstepA, voffA);
        if (wr == 1) G_BAR;
        G_WAIT_V(4); G_BAR;
        G_STAGE(G_SB(1, 0), cB + kstep, voffB); G_STAGE(G_SA(1, 0), cA + kstep, voffA); G_STAGE(G_SB(1, 1), cB + hstepB + kstep, voffB);
        G_WAIT_V(6); G_BAR;
        for (;;) {
            const bool has_next = chain && (u + nblk < cfg.nbig);
            UnitD nxt = cur;
            if (has_next) nxt = unit_decode(P, cfg, gp, u + nblk);
            const char* nA = nxt.A; const char* nB = nxt.B;
            for (int t = 0; t < nt; t += 2) {
                const bool last = (t == nt - 2);
                const char* a1 = cA + (size_t)(t + 1) * kstep;
                const char* a2 = last ? nA : cA + (size_t)(t + 2) * kstep; const char* b2 = last ? nB : cB + (size_t)(t + 2) * kstep;
                const char* a3 = a2 + kstep; const char* b3 = b2 + kstep;
                G_LDB(B0, 0, 0); G_SCHED; G_LDA(At, 0, 0); G_STAGE(G_SA(1, 1), a1 + hstepA, voffA);
                G_WAIT_L(8); G_BAR; G_WAIT_L(0); G_MMA(0, 0, At, B0); G_BAR; G_SCHED;
                G_LDB(B1, 0, 1); G_STAGE(G_SB(0, 0), b2, voffB);
                G_BAR; G_WAIT_L(0); G_MMA(0, 1, At, B1); G_BAR;
                G_LDA(At, 0, 1); G_STAGE(G_SA(0, 0), a2, voffA);
                G_BAR; G_WAIT_L(0); G_MMA(1, 0, At, B0); G_BAR; G_SCHED;
                G_STAGE(G_SB(0, 1), b2 + hstepB, voffB);
                G_WAIT_V(6); G_BAR; G_MMA(1, 1, At, B1); G_BAR;
                G_LDB(B0, 1, 0); G_SCHED; G_LDA(At, 1, 0); G_STAGE(G_SA(0, 1), a2 + hstepA, voffA);
                G_WAIT_L(8); G_BAR; G_WAIT_L(0); G_MMA(0, 0, At, B0); G_BAR; G_SCHED;
                G_LDB(B1, 1, 1); G_STAGE(G_SB(1, 0), b3, voffB);
                G_BAR; G_WAIT_L(0); G_MMA(0, 1, At, B1); G_BAR;
                G_LDA(At, 1, 1); G_STAGE(G_SA(1, 0), a3, voffA);
                G_BAR; G_WAIT_L(0); G_MMA(1, 0, At, B0); G_BAR; G_SCHED;
                G_STAGE(G_SB(1, 1), b3 + hstepB, voffB);
                G_WAIT_V(6); G_BAR; G_MMA(1, 1, At, B1); G_BAR;
            }
            if (chain) {
                const int rbase = cur.row0 + wr * 64 + fr, cbase = cur.col0 + wc * 32 + fq * 4;
                switch (cur.ekind) {
                case E_PROJ: epi_loop<E_PROJ>(P, acc, rbase, cbase, fq); break;
                case E_MEMKV: epi_loop<E_MEMKV>(P, acc, rbase, cbase, fq); break;
                case E_POOL: epi_loop<E_POOL>(P, acc, rbase, cbase, fq); break;
                case E_OUT: epi_loop<E_OUT>(P, acc, rbase, cbase, fq); break;
                case E_Q: epi_loop<E_Q>(P, acc, rbase, cbase, fq); break;
                case E_PV: epi_loop<E_PV>(P, acc, rbase, cbase, fq); break;
                case E_MO: epi_loop<E_MO>(P, acc, rbase, cbase, fq); break;
                case E_UP: epi_loop<E_UP>(P, acc, rbase, cbase, fq); break;
                default: epi_loop<E_DOWN>(P, acc, rbase, cbase, fq); break;
                }
            }
            if (!has_next) break;
#pragma unroll
            for (int a = 0; a < 2; ++a)
#pragma unroll
                for (int b = 0; b < 2; ++b)
#pragma unroll
                    for (int m = 0; m < 4; ++m)
#pragma unroll
                        for (int n = 0; n < 2; ++n) acc[a][b][m][n] = (f32x4){0.f, 0.f, 0.f, 0.f};
            cur = nxt; cA = nA; cB = nB; u += nblk;
        }
        G_WAIT_V(0);
        if (wr == 0) G_BAR;
        G_BAR;
        if (!chain) {
            float* redm = (float*)(shm_g + 131072);
            float* reds = (float*)(shm_g + 135168);
#pragma unroll
            for (int ai = 0; ai < 2; ++ai)
#pragma unroll
                for (int m = 0; m < 4; ++m) {
                    float t = -3.0e38f;
#pragma unroll
                    for (int bj = 0; bj < 2; ++bj)
#pragma unroll
                        for (int n = 0; n < 2; ++n)
#pragma unroll
                            for (int j = 0; j < 4; ++j) t = fmaxf(t, acc[ai][bj][m][n][j]);
                    t = fmaxf(t, __shfl_xor(t, 16)); t = fmaxf(t, __shfl_xor(t, 32));
                    if (fq == 0) redm[(ai * 128 + wr * 64 + m * 16 + fr) * 4 + wc] = t;
                }
            __syncthreads();
#pragma unroll
            for (int ai = 0; ai < 2; ++ai)
#pragma unroll
                for (int m = 0; m < 4; ++m) {
                    const f32x4 r = *(const f32x4*)(redm + (ai * 128 + wr * 64 + m * 16 + fr) * 4);
                    const float M = fmaxf(fmaxf(r[0], r[1]), fmaxf(r[2], r[3]));
                    float s = 0.f;
#pragma unroll
                    for (int bj = 0; bj < 2; ++bj)
#pragma unroll
                        for (int n = 0; n < 2; ++n)
#pragma unroll
                            for (int j = 0; j < 4; ++j) { const float e = __expf(acc[ai][bj][m][n][j] - M); acc[ai][bj][m][n][j] = e; s += e; }
                    s += __shfl_xor(s, 16); s += __shfl_xor(s, 32);
                    if (fq == 0) reds[(ai * 128 + wr * 64 + m * 16 + fr) * 4 + wc] = s;
                }
            __syncthreads();
#pragma unroll
            for (int ai = 0; ai < 2; ++ai)
#pragma unroll
                for (int m = 0; m < 4; ++m) {
                    const int rl = ai * 128 + wr * 64 + m * 16 + fr;
                    const f32x4 r = *(const f32x4*)(reds + rl * 4);
                    const float inv = 1.0f / ((r[0] + r[1]) + (r[2] + r[3]));
                    bf16_t* prow = (bf16_t*)(P->ws + W_P) + (size_t)(cur.row0 + rl) * 1024 + cur.col0;
#pragma unroll
                    for (int bj = 0; bj < 2; ++bj) {
                        const f32x4 v0 = acc[ai][bj][m][0], v1 = acc[ai][bj][m][1];
                        u32x4 o; o.x = pk2(v0[0] * inv, v0[1] * inv); o.y = pk2(v0[2] * inv, v0[3] * inv); o.z = pk2(v1[0] * inv, v1[1] * inv); o.w = pk2(v1[2] * inv, v1[3] * inv);
                        *(u32x4*)(prow + bj * 128 + wc * 32 + fq * 8) = o;
                    }
                }
            __syncthreads();
        }
        u += nblk;
    }
#undef G_SA
#undef G_SB
#undef G_STAGE
#undef G_LDA
#undef G_LDB
#undef G_MMA
    const int rot = cfg.nbig % nblk;
    for (int s0 = (lb - rot + nblk) % nblk; s0 < cfg.nsmall; s0 += nblk) {
        const int pr = s0 / cfg.ncol64, pc = s0 % cfg.ncol64;
        const int row0 = (gp == 1 ? 0 : TP) + pr * 32, col0 = pc * 64;
        int lda_s = cfg.lda, ldb_s = cfg.ldb, K_s = K, ek_s = cfg.ekind;
        const bf16_t* Ab; const bf16_t* Bb;
        if (gp == 1) {
            const int g = pc >> 2; lda_s = 1024; ldb_s = 256; K_s = 256; ek_s = E_FOLD;
            Ab = (const bf16_t*)(P->ws + W_WLO) + (size_t)row0 * 1024 + g * 256; Bb = (const bf16_t*)(P->ws + W_WPOOL) + (size_t)g * 65536 + (size_t)(col0 - g * 256) * 256;
        } else { Ab = (const bf16_t*)cfg.A + (size_t)row0 * cfg.lda; Bb = (const bf16_t*)cfg.B + (size_t)col0 * cfg.ldb; }
        const int kw = K_s >> 3, nks = kw >> 5;
        f32x4 acc[2][4];
#pragma unroll
        for (int mi = 0; mi < 2; ++mi)
#pragma unroll
            for (int ni = 0; ni < 4; ++ni) acc[mi][ni] = (f32x4){0.f, 0.f, 0.f, 0.f};
        const bf16_t* ap = Ab + (size_t)fr * lda_s + wid * kw + fq * 8;
        const bf16_t* bp = Bb + (size_t)fr * ldb_s + wid * kw + fq * 8;
        for (int ks0 = 0; ks0 < nks; ks0 += 4) {
            bf16x8 a[4][2], b[4][4];
#pragma unroll
            for (int q = 0; q < 4; ++q) {
                const bool ok = ks0 + q < nks;
#pragma unroll
                for (int mi = 0; mi < 2; ++mi) { bf16x8 z = {0, 0, 0, 0, 0, 0, 0, 0}; if (ok) z = *(const bf16x8*)(ap + (size_t)mi * 16 * lda_s + (ks0 + q) * 32); a[q][mi] = z; }
#pragma unroll
                for (int ni = 0; ni < 4; ++ni) { bf16x8 z = {0, 0, 0, 0, 0, 0, 0, 0}; if (ok) z = *(const bf16x8*)(bp + (size_t)ni * 16 * ldb_s + (ks0 + q) * 32); b[q][ni] = z; }
            }
#pragma unroll
            for (int q = 0; q < 4; ++q)
#pragma unroll
                for (int mi = 0; mi < 2; ++mi)
#pragma unroll
                    for (int ni = 0; ni < 4; ++ni) acc[mi][ni] = __builtin_amdgcn_mfma_f32_16x16x32_bf16(b[q][ni], a[q][mi], acc[mi][ni], 0, 0, 0);
        }
        float* red = (float*)shm_g;
#pragma unroll
        for (int mi = 0; mi < 2; ++mi)
#pragma unroll
            for (int ni = 0; ni < 4; ++ni) *(f32x4*)(red + wid * 2048 + (mi * 16 + fr) * 64 + ni * 16 + fq * 4) = acc[mi][ni];
        __syncthreads();
        {
            const int r = tid >> 4, c = (tid & 15) * 4;
            f32x4 v = *(const f32x4*)(red + r * 64 + c);
#pragma unroll
            for (int w = 1; w < 8; ++w) v += *(const f32x4*)(red + w * 2048 + r * 64 + c);
            const int cl = (gp == 1) ? c : (c & 32) + perm32(c & 31);
            float ss = epi_apply_rt(P, ek_s, row0 + r, col0 + cl, v);
            if (cfg.ekind == E_OUT || cfg.ekind == E_MO || cfg.ekind == E_DOWN) {
                ss += __shfl_xor(ss, 1); ss += __shfl_xor(ss, 2); ss += __shfl_xor(ss, 4); ss += __shfl_xor(ss, 8);
                if ((tid & 15) == 0) unsafeAtomicAdd((float*)(P->ws + (cfg.ekind == E_OUT ? W_SS1 : cfg.ekind == E_MO ? W_SS2 : W_SS3)) + row0 + r, ss);
            }
        }
        __syncthreads();
    }
}

struct TrDesc { const float* src; bf16_t* dst; const float* gain; int ld_src, ld_dst, k0, n0s, n0d, perm; };
__device__ __forceinline__ TrDesc tr_decode(PP P, int i) {
    char* ws = P->ws; TrDesc d; d.gain = nullptr; d.perm = 0;
    if (i < 896) { const int kt = i / 56, ntl = i % 56; d.n0d = ntl * 64; d.n0s = d.n0d < 2560 ? d.n0d : d.n0d + 16; d.src = P->w_in; d.ld_src = 3600; d.dst = (bf16_t*)(ws + W_WIN); d.ld_dst = 1024; d.k0 = kt * 64; d.perm = 1; return d; }
    i -= 896;
    if (i < 512) { const int kt = i >> 4, ntl = i & 15; d.ld_src = 1024; d.n0s = d.n0d = ntl * 64;
        d.perm = kt < 16 ? 1 : 0;
        if (kt < 16) { d.src = P->w_out; d.dst = (bf16_t*)(ws + W_WOUT); d.ld_dst = 2048; d.k0 = kt * 64; }
        else { d.src = P->w_out + (size_t)1024 * 1024; d.dst = (bf16_t*)(ws + W_WLO); d.ld_dst = 1024; d.k0 = (kt - 16) * 64; }
        return d; }
    i -= 512;
    if (i < 1024) { const int wsel = i >> 8, r = i & 255, kt = r >> 4, ntl = r & 15;
        d.src = wsel == 0 ? P->w_mq : wsel == 1 ? P->w_mk : wsel == 2 ? P->w_mv : P->w_mo;
        d.dst = (bf16_t*)(ws + (wsel == 0 ? W_WMQ : wsel == 1 ? W_WMK : wsel == 2 ? W_WMV : W_WMO));
        d.gain = wsel == 0 ? P->norm_mem : nullptr; d.ld_src = 1024; d.ld_dst = 1024; d.k0 = kt * 64; d.n0s = d.n0d = ntl * 64; d.perm = (wsel == 0 || wsel == 3) ? 1 : 0; return d; }
    i -= 1024;
    if (i < 1408) { const int kt = i / 88, ntl = i % 88; d.src = P->w_up; d.ld_src = 5632; d.dst = (bf16_t*)(ws + W_WUP); d.ld_dst = 1024; d.gain = P->norm_ffn; d.k0 = kt * 64; d.n0s = d.n0d = ntl * 64; d.perm = 1; return d; }
    i -= 1408;
    { const int kt = i >> 4, ntl = i & 15; d.src = P->w_down; d.ld_src = 1024; d.dst = (bf16_t*)(ws + W_WDOWN); d.ld_dst = 2816; d.k0 = kt * 64; d.n0s = d.n0d = ntl * 64; d.perm = 1; return d; }
}

__device__ __forceinline__ void phase_prep(PP P, char* shm, int blk, int nblk, const int tid) {
    const int wid = tid >> 6, lane = tid & 63;
    float* tiles = (float*)shm;
    float* wdt = (float*)(shm + 69632);
    for (int i = blk * NTHR + tid; i < 3 * TT; i += nblk * NTHR) ((float*)(P->ws + W_SS1))[i] = 0.f;
    for (int i = (blk * NTHR + tid) * 4; i < 4 * 65536; i += nblk * NTHR * 4) {
        const f32x4 wv = *(const f32x4*)(P->w_pool + i), sv = *(const f32x4*)(P->pool_scale + (i >> 16) * 256 + (i & 255));
        u32x2 o; o.x = pk2(wv[0] * sv[0], wv[1] * sv[1]); o.y = pk2(wv[2] * sv[2], wv[3] * sv[3]);
        *(u32x2*)((bf16_t*)(P->ws + W_WPOOL) + i) = o;
    }
    for (int i = tid; i < 1024 * 16; i += NTHR) { const int k = i >> 4, hd = i & 15; wdt[hd * 1024 + k] = P->w_in[(size_t)k * 3600 + 2560 + hd]; }
    __syncthreads();
    char* ws = P->ws;
    constexpr int NGRP = (TT + 2048) / 32;
    for (int it = blk; it < NGRP; it += nblk) {
        const int rbase = it * 32 + wid * 4;
        const bool ismem = rbase >= TT;
        f32x4 xv[4][4];
#pragma unroll
        for (int r = 0; r < 4; ++r) {
            const int row = (ismem ? rbase - TT : rbase) + r;
            const float* xr = ismem ? P->mem_prompt + (size_t)row * 1024 : (row < TP ? P->x_prompt + (size_t)row * 1024 : P->x_sample + (size_t)(row - TP) * 1024);
#pragma unroll
            for (int j = 0; j < 4; ++j) xv[r][j] = __builtin_nontemporal_load((const f32x4*)(xr + j * 256 + lane * 4));
        }
        const float* gg = ismem ? P->norm_memkv : P->norm_mix;
#pragma unroll
        for (int r = 0; r < 4; ++r) {
            const int row = (ismem ? rbase - TT : rbase) + r;
            bf16_t* orow = (bf16_t*)(ws + (ismem ? W_HM : W_H)) + (size_t)row * 1024;
            float ss = 0.f;
#pragma unroll
            for (int j = 0; j < 4; ++j) ss += xv[r][j][0] * xv[r][j][0] + xv[r][j][1] * xv[r][j][1] + xv[r][j][2] * xv[r][j][2] + xv[r][j][3] * xv[r][j][3];
            ss = wave_sum(ss);
            const float rstd = rsqrtf(ss * (1.0f / 1024.0f) + EPS);
#pragma unroll
            for (int j = 0; j < 4; ++j) { const f32x4 g4 = *(const f32x4*)(gg + j * 256 + lane * 4); xv[r][j] = xv[r][j] * rstd * g4;
                u32x2 o; o.x = pk2(xv[r][j][0], xv[r][j][1]); o.y = pk2(xv[r][j][2], xv[r][j][3]); *(u32x2*)(orow + j * 256 + lane * 4) = o; }
        }
        if (!ismem) {
            float vals[64];
#pragma unroll
            for (int hd = 0; hd < 16; ++hd) {
                f32x4 w4[4];
#pragma unroll
                for (int j = 0; j < 4; ++j) w4[j] = *(const f32x4*)(wdt + hd * 1024 + j * 256 + lane * 4);
#pragma unroll
                for (int r = 0; r < 4; ++r) {
                    float a = 0.f;
#pragma unroll
                    for (int j = 0; j < 4; ++j) a += xv[r][j][0] * w4[j][0] + xv[r][j][1] * w4[j][1] + xv[r][j][2] * w4[j][2] + xv[r][j][3] * w4[j][3];
                    vals[r * 16 + hd] = a;
                }
            }
#pragma unroll
            for (int half = 32; half >= 1; half >>= 1) {
                const bool hi = (lane & half) != 0;
#pragma unroll
                for (int i = 0; i < half; ++i) {
                    const float keep = hi ? vals[i + half] : vals[i], send = hi ? vals[i] : vals[i + half];
                    vals[i] = keep + __shfl_xor(send, half);
                }
            }
            const float x = vals[0] + P->dt_bias[lane & 15];
            const float ey = __expf(-fabsf(x)); const float l1p = ey < 0.03f ? ey * (1.0f - ey * (0.5f - ey * (0.33333333f - 0.25f * ey))) : __logf(1.0f + ey);
            ((float*)(ws + W_DT))[(size_t)rbase * 16 + lane] = fmaxf(x, 0.f) + l1p;
        }
    }
    __syncthreads();
    const int kr = tid >> 4, nc = (tid & 15) * 4, tn = tid >> 3, tk8 = (tid & 7) * 8;
    for (int it = blk; it < 4544; it += 4 * nblk) {
        f32x4 v[4][2];
#pragma unroll
        for (int q = 0; q < 4; ++q) {
            const int i = it + q * nblk;
            if (i < 4544) { const TrDesc d = tr_decode(P, i);
#pragma unroll
                for (int h = 0; h < 2; ++h) { const int k = kr + h * 32; f32x4 t = __builtin_nontemporal_load((const f32x4*)(d.src + (size_t)(d.k0 + k) * d.ld_src + d.n0s + nc)); if (d.gain) t *= d.gain[d.k0 + k]; v[q][h] = t; } }
        }
#pragma unroll
        for (int q = 0; q < 4; ++q) {
            if (it + q * nblk < 4544) { float* tile = tiles + q * (64 * 65);
#pragma unroll
                for (int h = 0; h < 2; ++h) { const int k = kr + h * 32; tile[k * 65 + nc + 0] = v[q][h][0]; tile[k * 65 + nc + 1] = v[q][h][1]; tile[k * 65 + nc + 2] = v[q][h][2]; tile[k * 65 + nc + 3] = v[q][h][3]; } }
        }
        __syncthreads();
#pragma unroll
        for (int q = 0; q < 4; ++q) {
            const int i = it + q * nblk;
            if (i < 4544) { const TrDesc d = tr_decode(P, i); const float* tile = tiles + q * (64 * 65); float f[8];
                const int sc = d.perm ? (tn & 32) + perm32(tn & 31) : tn;
#pragma unroll
                for (int e2 = 0; e2 < 8; ++e2) f[e2] = tile[(tk8 + e2) * 65 + sc];
                *(u32x4*)(d.dst + (size_t)(d.n0d + tn) * d.ld_dst + d.k0 + tk8) = pack8(f); }
        }
        __syncthreads();
    }
}

__device__ __forceinline__ u32x4 ld8(const bf16_t* p) { return *(const u32x4*)p; }

__device__ __forceinline__ void phase_convpool(PP P, int gtid, int nthreads) {
    char* ws = P->ws;
    const bf16_t* proj2 = (const bf16_t*)(ws + W_PROJ2);
    bf16_t* xact = (bf16_t*)(ws + W_XACT);
    bf16_t* pooled = (bf16_t*)(ws + W_POOLED);
    for (int idx = gtid; idx < 1152 * 320; idx += nthreads) {
        const int run = idx / 320, cg = idx % 320;
        const bool samp = run >= 1024;
        int t0, len, bidx, tl0;
        if (!samp) { t0 = run * 16; len = 16; bidx = t0 >> 11; tl0 = t0 & 2047; } else { bidx = run - 1024; t0 = TP + bidx * 4; len = 4; tl0 = 0; }
        if (cg < 192) {
            const int c0 = cg * 8;
            float w0[8], w1[8], w2[8], w3[8], bs[8], h0[8], h1[8], h2[8];
#pragma unroll
            for (int e = 0; e < 8; ++e) { w0[e] = P->conv_w[c0 + e]; w1[e] = P->conv_w[1536 + c0 + e]; w2[e] = P->conv_w[3072 + c0 + e]; w3[e] = P->conv_w[4608 + c0 + e]; bs[e] = P->conv_b[c0 + e]; }
            if (samp) {
#pragma unroll
                for (int e = 0; e < 8; ++e) { h0[e] = P->state_conv[(size_t)(bidx * 3 + 0) * 1536 + c0 + e]; h1[e] = P->state_conv[(size_t)(bidx * 3 + 1) * 1536 + c0 + e]; h2[e] = P->state_conv[(size_t)(bidx * 3 + 2) * 1536 + c0 + e]; }
            } else if (tl0 > 0) {
                unpack8(ld8(proj2 + (size_t)(t0 - 3) * 2560 + c0), h0); unpack8(ld8(proj2 + (size_t)(t0 - 2) * 2560 + c0), h1); unpack8(ld8(proj2 + (size_t)(t0 - 1) * 2560 + c0), h2);
            } else {
#pragma unroll
                for (int e = 0; e < 8; ++e) { h0[e] = 0.f; h1[e] = 0.f; h2[e] = 0.f; }
            }
            u32x4 rx[16];
#pragma unroll
            for (int j = 0; j < 16; ++j) { if (j < len) rx[j] = ld8(proj2 + (size_t)(t0 + j) * 2560 + c0); }
#pragma unroll
            for (int j = 0; j < 16; ++j) {
                if (j < len) {
                float x3[8], y[8]; unpack8(rx[j], x3);
#pragma unroll
                for (int e = 0; e < 8; ++e) { const float v = bs[e] + w0[e] * h0[e] + w1[e] * h1[e] + w2[e] * h2[e] + w3[e] * x3[e]; y[e] = silu_f(v); }
                *(u32x4*)(xact + (size_t)(t0 + j) * 1536 + c0) = pack8(y);
                if (samp) { if (j >= 1) { float* o = P->out + O_CONVS + (size_t)(bidx * 3 + j - 1) * 1536 + c0;
#pragma unroll
                        for (int e = 0; e < 8; ++e) o[e] = x3[e]; } }
                else { const int tl = tl0 + j; if (tl >= 2045) { float* o = P->out + O_CONVP + (size_t)(bidx * 3 + tl - 2045) * 1536 + c0;
#pragma unroll
                        for (int e = 0; e < 8; ++e) o[e] = x3[e]; } }
#pragma unroll
                for (int e = 0; e < 8; ++e) { h0[e] = h1[e]; h1[e] = h2[e]; h2[e] = x3[e]; }
                }
            }
        } else {
            const int c0 = (cg - 192) * 8; const int win = 2 << (c0 >> 8);
            const bf16_t* vp = proj2 + 1536 + c0;
            const float* prev = P->state_pool + (size_t)bidx * 15 * 1024 + c0;
            float sum[8];
#pragma unroll
            for (int e = 0; e < 8; ++e) sum[e] = 0.f;
            if (samp) {
                for (int jj = 1; jj < win; ++jj) {
#pragma unroll
                    for (int e = 0; e < 8; ++e) sum[e] += prev[(size_t)(15 - jj) * 1024 + e]; }
                float* o = P->out + O_POOLS + (size_t)bidx * 15 * 1024 + c0;
                for (int i = 0; i < 11; ++i) {
#pragma unroll
                    for (int e = 0; e < 8; ++e) o[(size_t)i * 1024 + e] = prev[(size_t)(i + 4) * 1024 + e]; }
            } else if (tl0 > 0) {
                for (int jj = 1; jj < win; ++jj) { float v[8]; unpack8(ld8(vp + (size_t)(t0 - jj) * 2560), v);
#pragma unroll
                    for (int e = 0; e < 8; ++e) sum[e] += v[e]; }
            }
            u32x4 rp[16];
#pragma unroll
            for (int j = 0; j < 16; ++j) { if (j < len) rp[j] = ld8(vp + (size_t)(t0 + j) * 2560); }
#pragma unroll
            for (int j = 0; j < 16; ++j) {
                if (j >= len) continue;
                float v[8], o8[8]; unpack8(rp[j], v);
                const int tl = tl0 + j;
                const float inv = 1.0f / (float)(samp ? win : (tl + 1 < win ? tl + 1 : win));
#pragma unroll
                for (int e = 0; e < 8; ++e) { sum[e] += v[e]; o8[e] = sum[e] * inv - v[e]; }
                *(u32x4*)((bf16_t*)(ws + W_MIX) + (size_t)(t0 + j) * 2048 + 1024 + c0) = pack8(o8);
                const int to = j - win + 1;
                if (samp) {
                    if (to >= 0) { float q[8]; unpack8(ld8(vp + (size_t)(t0 + to) * 2560), q);
#pragma unroll
                        for (int e = 0; e < 8; ++e) sum[e] -= q[e]; }
                    else {
#pragma unroll
                        for (int e = 0; e < 8; ++e) sum[e] -= prev[(size_t)(15 + to) * 1024 + e]; }
                    float* o = P->out + O_POOLS + (size_t)(bidx * 15 + 11 + j) * 1024 + c0;
#pragma unroll
                    for (int e = 0; e < 8; ++e) o[e] = v[e];
                } else {
                    if (tl0 + to >= 0) { float q[8]; unpack8(ld8(vp + (size_t)(t0 + to) * 2560), q);
#pragma unroll
                        for (int e = 0; e < 8; ++e) sum[e] -= q[e]; }
                    if (tl >= 2033) { float* o = P->out + O_POOLP + (size_t)(bidx * 15 + tl - 2033) * 1024 + c0;
#pragma unroll
                        for (int e = 0; e < 8; ++e) o[e] = v[e]; }
                }
            }
        }
    }
}

constexpr int CS_STR = 136;
constexpr int X_STR = 40;
__device__ __forceinline__ s16x4 tr_read(const bf16_t* p) { return __builtin_bit_cast(s16x4, __builtin_amdgcn_ds_read_tr16_b64_v4i16((LDSB s16x4*)p)); }

#define LDS_BARRIER() asm volatile("s_waitcnt lgkmcnt(0)\n\ts_barrier" ::: "memory")
__device__ __forceinline__ void ssd_prompt(PP P, int item, char* shm, const int tid) {
    const int w = tid >> 6, lane = tid & 63, fr = lane & 15, fq = lane >> 4;
    const int b = item >> 5, hd = (item >> 1) & 15, ph = item & 1, g = hd >> 3;
    const float a = -expf(P->a_log[hd]);
    const float Dh = P->ssm_d[hd];
    char* ws = P->ws;
    const bf16_t* xact = (const bf16_t*)(ws + W_XACT);
    const float* dtb = (const float*)(ws + W_DT);
    bf16_t* ybuf = (bf16_t*)(ws + W_Y);
    bf16_t* Cs = (bf16_t*)(shm);
    bf16_t* Bs = (bf16_t*)(shm + 34816);
    bf16_t* Xd = (bf16_t*)(shm + 69632);
    bf16_t* X2 = (bf16_t*)(shm + 69632 + 10240);
    bf16_t* Ht = (bf16_t*)(shm + 69632 + 20480);
    float* acs = (float*)(shm + 69632 + 30720);
    float* dts = (float*)(shm + 69632 + 31232);
    f32x4 Hacc[2];
    Hacc[0] = (f32x4){0.f, 0.f, 0.f, 0.f}; Hacc[1] = (f32x4){0.f, 0.f, 0.f, 0.f};
    const int q4 = fr >> 2, p4 = fr & 3;
    u32x4 pc[4], pb[4], px; float pd0, pd1;
    const int ls = tid >> 4, ln8 = (tid & 15) * 8;
    const int xs = tid >> 2, xp8 = (tid & 3) * 8;
#define SSD_PREFETCH(cc) do { const int _t0 = b * 2048 + (cc) * 128; \
        _Pragma("unroll") for (int i = 0; i < 4; ++i) { const bf16_t* src = xact + (size_t)(_t0 + ls + i * 32) * 1536 + g * 128 + ln8; pc[i] = *(const u32x4*)(src + 1280); pb[i] = *(const u32x4*)(src + 1024); } \
        px = *(const u32x4*)(xact + (size_t)(_t0 + xs) * 1536 + hd * 64 + ph * 32 + xp8); \
        pd0 = dtb[(size_t)(_t0 + 2 * lane) * 16 + hd]; pd1 = dtb[(size_t)(_t0 + 2 * lane + 1) * 16 + hd]; } while (0)
    SSD_PREFETCH(0);
    for (int c = 0; c < 16; ++c) {
        const int t0 = b * 2048 + c * 128;
        if (w == 0) {
            const float d0 = pd0, d1 = pd1;
            const float s = (d0 + d1) * a; float v = s;
#pragma unroll
            for (int off = 1; off < 64; off <<= 1) { const float t = __shfl_up(v, off); if (lane >= off) v += t; }
            const float excl = v - s;
            acs[2 * lane] = excl + d0 * a; acs[2 * lane + 1] = v; dts[2 * lane] = d0; dts[2 * lane + 1] = d1;
        }
#pragma unroll
        for (int pt = 0; pt < 2; ++pt) { u32x2 o; o.x = pk2(Hacc[pt][0], Hacc[pt][1]); o.y = pk2(Hacc[pt][2], Hacc[pt][3]); *(u32x2*)(Ht + (w * 16 + fr) * X_STR + pt * 16 + fq * 4) = o; }
#pragma unroll
        for (int i = 0; i < 4; ++i) { *(u32x4*)(Cs + (ls + i * 32) * CS_STR + ln8) = pc[i]; *(u32x4*)(Bs + (ls + i * 32) * CS_STR + ln8) = pb[i]; }
        LDS_BARRIER();
        {
            float x[8], xa[8], xb[8]; unpack8(px, x);
            const float dtv = dts[xs], dec = __expf(acs[127] - acs[xs]) * dtv;
#pragma unroll
            for (int e = 0; e < 8; ++e) { xa[e] = x[e] * dtv; xb[e] = x[e] * dec; }
            *(u32x4*)(Xd + xs * X_STR + xp8) = pack8(xa);
            *(u32x4*)(X2 + xs * X_STR + xp8) = pack8(xb);
        }
        if (c < 15) SSD_PREFETCH(c + 1);
        bf16x8 Cf[4];
#pragma unroll
        for (int kk = 0; kk < 4; ++kk) Cf[kk] = *(const bf16x8*)(Cs + (w * 16 + fr) * CS_STR + kk * 32 + fq * 8);
        const int lrow = w * 16 + fr; const float al = acs[lrow];
        bf16x8 Gf[4];
#pragma unroll
        for (int kk = 0; kk < 4; ++kk) {
            u32x2 half[2];
#pragma unroll
            for (int hh = 0; hh < 2; ++hh) {
                const int st = 2 * kk + hh;
                half[hh].x = 0u; half[hh].y = 0u;
                if (st <= w) {
                    f32x4 ga = (f32x4){0.f, 0.f, 0.f, 0.f};
#pragma unroll
                    for (int k2 = 0; k2 < 4; ++k2) { const bf16x8 Bf = *(const bf16x8*)(Bs + (st * 16 + fr) * CS_STR + k2 * 32 + fq * 8); ga = __builtin_amdgcn_mfma_f32_16x16x32_bf16(Bf, Cf[k2], ga, 0, 0, 0); }
                    const int s0 = st * 16 + fq * 4; const f32x4 as4 = *(const f32x4*)(acs + s0);
                    float gv[4];
#pragma unroll
                    for (int j = 0; j < 4; ++j) gv[j] = (s0 + j <= lrow) ? ga[j] * __expf(al - as4[j]) : 0.f;
                    half[hh].x = pk2(gv[0], gv[1]); half[hh].y = pk2(gv[2], gv[3]);
                }
            }
            u32x4 g4; g4.x = half[0].x; g4.y = half[0].y; g4.z = half[1].x; g4.w = half[1].y;
            Gf[kk] = __builtin_bit_cast(bf16x8, g4);
        }
        LDS_BARRIER();
        {
            f32x4 Yd[2], Yo[2];
            Yd[0] = Yd[1] = Yo[0] = Yo[1] = (f32x4){0.f, 0.f, 0.f, 0.f};
            const int nkk = (w >> 1) + 1;
#pragma unroll
            for (int kk = 0; kk < 4; ++kk) {
                if (kk < nkk) {
#pragma unroll
                    for (int pt = 0; pt < 2; ++pt) {
                        const bf16_t* base = Xd + (kk * 32 + fq * 4 + q4) * X_STR + pt * 16 + p4 * 4;
                        bf16x8 Xf; Xf.lo = tr_read(base); Xf.hi = tr_read(base + 16 * X_STR);
                        Yd[pt] = __builtin_amdgcn_mfma_f32_16x16x32_bf16(Xf, Gf[kk], Yd[pt], 0, 0, 0);
                    }
                }
            }
#pragma unroll
            for (int kk = 0; kk < 4; ++kk)
#pragma unroll
                for (int pt = 0; pt < 2; ++pt) {
                    const bf16_t* hbp = Ht + (kk * 32 + fq * 8 + q4) * X_STR + pt * 16 + p4 * 4;
                    bf16x8 Hf; Hf.lo = tr_read(hbp); Hf.hi = tr_read(hbp + 4 * X_STR);
                    Yo[pt] = __builtin_amdgcn_mfma_f32_16x16x32_bf16(Hf, Cf[kk], Yo[pt], 0, 0, 0);
                }
            const float el = __expf(al); const float rdt = Dh / dts[lrow];
#pragma unroll
            for (int pt = 0; pt < 2; ++pt) {
                const u32x2 xr = *(const u32x2*)(Xd + lrow * X_STR + pt * 16 + fq * 4);
                const f32x4 y = Yd[pt] + el * Yo[pt] + rdt * (f32x4){bflo(xr.x), bfhi(xr.x), bflo(xr.y), bfhi(xr.y)};
                u32x2 o; o.x = pk2(y[0], y[1]); o.y = pk2(y[2], y[3]);
                *(u32x2*)(ybuf + (size_t)(t0 + lrow) * 1024 + hd * 64 + ph * 32 + pt * 16 + fq * 4) = o;
            }
        }
        {
            const float dc = __expf(acs[127]);
            Hacc[0] *= dc; Hacc[1] *= dc;
#pragma unroll
            for (int kk = 0; kk < 4; ++kk) {
                const bf16_t* bb = Bs + (kk * 32 + fq * 8 + q4) * CS_STR + w * 16 + p4 * 4;
                bf16x8 Bf; Bf.lo = tr_read(bb); Bf.hi = tr_read(bb + 4 * CS_STR);
#pragma unroll
                for (int pt = 0; pt < 2; ++pt) {
                    const bf16_t* xb = X2 + (kk * 32 + fq * 8 + q4) * X_STR + pt * 16 + p4 * 4;
                    bf16x8 Xf; Xf.lo = tr_read(xb); Xf.hi = tr_read(xb + 4 * X_STR);
                    Hacc[pt] = __builtin_amdgcn_mfma_f32_16x16x32_bf16(Xf, Bf, Hacc[pt], 0, 0, 0);
                }
            }
        }
        LDS_BARRIER();
    }
#undef SSD_PREFETCH
    float* so = P->out + O_SSMP + ((size_t)(b * 16 + hd) * 64 + ph * 32) * 128;
#pragma unroll
    for (int pt = 0; pt < 2; ++pt)
#pragma unroll
        for (int j = 0; j < 4; ++j) so[(size_t)(pt * 16 + fq * 4 + j) * 128 + w * 16 + fr] = Hacc[pt][j];
}

template <int NI>
__device__ __forceinline__ void ssd_sample(PP P, int item0, int istride, const int tid) {
    const int p = tid >> 3, n0 = (tid & 7) * 16;
    char* ws = P->ws;
    const bf16_t* xact = (const bf16_t*)(ws + W_XACT);
    const float* dtb = (const float*)(ws + W_DT);
    bf16_t* ybuf = (bf16_t*)(ws + W_Y);
    f32x4 hs[NI][4]; u32x4 rb[NI][4][2], rc[NI][4][2]; float xv[NI][4], dtv[NI][4];
#pragma unroll
    for (int q = 0; q < NI; ++q) {
        const int item = item0 + q * istride, b = item >> 4, hd = item & 15, g = hd >> 3;
        const size_t sidx = ((size_t)(b * 16 + hd) * 64 + p) * 128 + n0;
#pragma unroll
        for (int i = 0; i < 4; ++i) hs[q][i] = __builtin_nontemporal_load((const f32x4*)(P->state_ssm + sidx + i * 4));
#pragma unroll
        for (int i = 0; i < 4; ++i) {
            const int t = TP + b * 4 + i;
            xv[q][i] = bf2f(xact[(size_t)t * 1536 + hd * 64 + p]);
            dtv[q][i] = dtb[(size_t)t * 16 + hd];
            rb[q][i][0] = ld8(xact + (size_t)t * 1536 + 1024 + g * 128 + n0); rb[q][i][1] = ld8(xact + (size_t)t * 1536 + 1024 + g * 128 + n0 + 8);
            rc[q][i][0] = ld8(xact + (size_t)t * 1536 + 1280 + g * 128 + n0); rc[q][i][1] = ld8(xact + (size_t)t * 1536 + 1280 + g * 128 + n0 + 8);
        }
    }
#pragma unroll
    for (int q = 0; q < NI; ++q) {
        const int item = item0 + q * istride, b = item >> 4, hd = item & 15;
        const float a = -expf(P->a_log[hd]);
        const float Dh = P->ssm_d[hd];
        const size_t sidx = ((size_t)(b * 16 + hd) * 64 + p) * 128 + n0;
        float h[16];
#pragma unroll
        for (int i = 0; i < 4; ++i) { h[i * 4] = hs[q][i][0]; h[i * 4 + 1] = hs[q][i][1]; h[i * 4 + 2] = hs[q][i][2]; h[i * 4 + 3] = hs[q][i][3]; }
#pragma unroll
        for (int i = 0; i < 4; ++i) {
            const int t = TP + b * 4 + i;
            const float dA = __expf(dtv[q][i] * a), dx = dtv[q][i] * xv[q][i];
            float Bv[16], Cv[16];
            { float t8[8]; unpack8(rb[q][i][0], t8);
#pragma unroll
              for (int e = 0; e < 8; ++e) Bv[e] = t8[e];
              unpack8(rb[q][i][1], t8);
#pragma unroll
              for (int e = 0; e < 8; ++e) Bv[8 + e] = t8[e];
              unpack8(rc[q][i][0], t8);
#pragma unroll
              for (int e = 0; e < 8; ++e) Cv[e] = t8[e];
              unpack8(rc[q][i][1], t8);
#pragma unroll
              for (int e = 0; e < 8; ++e) Cv[8 + e] = t8[e]; }
            float part = 0.f;
#pragma unroll
            for (int e = 0; e < 16; ++e) { h[e] = h[e] * dA + dx * Bv[e]; part += h[e] * Cv[e]; }
            part += __shfl_xor(part, 1); part += __shfl_xor(part, 2); part += __shfl_xor(part, 4);
            if ((tid & 7) == 0) ybuf[(size_t)t * 1024 + hd * 64 + p] = f2bf(part + Dh * xv[q][i]);
        }
        float* so = P->out + O_SSMS + sidx;
#pragma unroll
        for (int i = 0; i < 4; ++i) __builtin_nontemporal_store((f32x4){h[i * 4], h[i * 4 + 1], h[i * 4 + 2], h[i * 4 + 3]}, (f32x4*)(so + i * 4));
    }
}

__device__ __forceinline__ void phase_gatednorm(PP P, int gw, int nw, const int tid) {
    const int lane = tid & 63;
    char* ws = P->ws;
    const bf16_t* ybuf = (const bf16_t*)(ws + W_Y); const bf16_t* zbuf = (const bf16_t*)(ws + W_Z);
    bf16_t* mix = (bf16_t*)(ws + W_MIX);
    for (int row0 = gw; row0 < TT; row0 += 4 * nw) {
        u32x2 yv[4][4], zv[4][4];
#pragma unroll
        for (int r = 0; r < 4; ++r) { const int row = row0 + r * nw; if (row < TT) {
#pragma unroll
            for (int j = 0; j < 4; ++j) { yv[r][j] = *(const u32x2*)(ybuf + (size_t)row * 1024 + j * 256 + lane * 4); zv[r][j] = *(const u32x2*)(zbuf + (size_t)row * 1024 + j * 256 + lane * 4); } } }
#pragma unroll
        for (int r = 0; r < 4; ++r) { const int row = row0 + r * nw; if (row < TT) {
            float t[4][4]; float ss0 = 0.f, ss1 = 0.f;
#pragma unroll
            for (int j = 0; j < 4; ++j) {
                const float y0 = bflo(yv[r][j].x), y1 = bfhi(yv[r][j].x), y2 = bflo(yv[r][j].y), y3 = bfhi(yv[r][j].y);
                const float z0 = bflo(zv[r][j].x), z1 = bfhi(zv[r][j].x), z2 = bflo(zv[r][j].y), z3 = bfhi(zv[r][j].y);
                t[j][0] = y0 * silu_f(z0); t[j][1] = y1 * silu_f(z1); t[j][2] = y2 * silu_f(z2); t[j][3] = y3 * silu_f(z3);
                const float q = t[j][0] * t[j][0] + t[j][1] * t[j][1] + t[j][2] * t[j][2] + t[j][3] * t[j][3];
                if (j < 2) ss0 += q; else ss1 += q;
            }
            ss0 = wave_sum(ss0); ss1 = wave_sum(ss1);
            const float r0 = rsqrtf(ss0 * (1.0f / 512.0f) + EPS), r1 = rsqrtf(ss1 * (1.0f / 512.0f) + EPS);
#pragma unroll
            for (int j = 0; j < 4; ++j) {
                const float rr = j < 2 ? r0 : r1;
                const f32x4 g4 = *(const f32x4*)(P->ssm_norm + j * 256 + lane * 4);
                u32x2 o; o.x = pk2(t[j][0] * rr * g4[0], t[j][1] * rr * g4[1]); o.y = pk2(t[j][2] * rr * g4[2], t[j][3] * rr * g4[3]);
                *(u32x2*)(mix + (size_t)row * 2048 + j * 256 + lane * 4) = o;
            }
        } }
    }
}

__device__ __forceinline__ void phase_norm(PP P, const float* gain, bool final_out, int gw, int nw, const int tid) {
    const int lane = tid & 63;
    char* ws = P->ws;
    const bf16_t* hb = (const bf16_t*)(ws + W_H);
    const float* ss3 = (const float*)(ws + W_SS3);
    for (int row0 = gw; row0 < TT; row0 += 4 * nw) {
        u32x2 xv[4][4]; float sq[4];
#pragma unroll
        for (int r = 0; r < 4; ++r) { const int row = row0 + r * nw; if (row < TT) { sq[r] = ss3[row];
#pragma unroll
            for (int j = 0; j < 4; ++j) xv[r][j] = *(const u32x2*)(hb + (size_t)row * 1024 + j * 256 + lane * 4); } }
#pragma unroll
        for (int r = 0; r < 4; ++r) { const int row = row0 + r * nw; if (row < TT) {
            const float rstd = rsqrtf(sq[r] * (1.0f / 1024.0f) + EPS);
#pragma unroll
            for (int j = 0; j < 4; ++j) {
                const f32x4 g4 = *(const f32x4*)(gain + j * 256 + lane * 4);
                const f32x4 x = (f32x4){bflo(xv[r][j].x), bfhi(xv[r][j].x), bflo(xv[r][j].y), bfhi(xv[r][j].y)};
                __builtin_nontemporal_store(x * rstd * g4, (f32x4*)(P->out + O_YP + (size_t)row * 1024 + j * 256 + lane * 4));
            }
        } }
    }
}

__device__ __forceinline__ void attn_sample(PP P, int item, char* shm, const int tid) {
    const int w = tid >> 6, lane = tid & 63, fr = lane & 15, fq = lane >> 4;
    const int b = item >> 2, hh = item & 3;
    char* ws = P->ws;
    const bf16_t* qb = (const bf16_t*)(ws + W_Q);
    float* sc = (float*)shm;
    float* part = (float*)(shm + 4096);
    const float* vp = P->cache_v + ((size_t)(b * 256 + w * 32) * 4 + hh) * 256 + lane * 4;
    f32x4 v0[16], v1[16];
#pragma unroll
    for (int mm = 0; mm < 16; ++mm) v0[mm] = __builtin_nontemporal_load((const f32x4*)(vp + (size_t)mm * 1024));
    bf16x8 qf[8];
#pragma unroll
    for (int kk = 0; kk < 8; ++kk) {
        bf16x8 z = {0, 0, 0, 0, 0, 0, 0, 0};
        if (fr < 4) z = *(const bf16x8*)(qb + (size_t)(TP + b * 4 + fr) * 1024 + hh * 256 + kk * 32 + fq * 8);
        qf[kk] = z;
    }
#pragma unroll
    for (int mt = 0; mt < 2; ++mt) {
        const int key = w * 32 + mt * 16 + fr;
        const float* kp = P->cache_k + ((size_t)(b * 256 + key) * 4 + hh) * 256 + fq * 8;
        f32x4 k0[8], k1[8];
#pragma unroll
        for (int kk = 0; kk < 8; ++kk) { k0[kk] = __builtin_nontemporal_load((const f32x4*)(kp + kk * 32)); k1[kk] = __builtin_nontemporal_load((const f32x4*)(kp + kk * 32 + 4)); }
        f32x4 acc = (f32x4){0.f, 0.f, 0.f, 0.f};
#pragma unroll
        for (int kk = 0; kk < 8; ++kk) {
            u32x4 pk; pk.x = pk2(k0[kk][0], k0[kk][1]); pk.y = pk2(k0[kk][2], k0[kk][3]); pk.z = pk2(k1[kk][0], k1[kk][1]); pk.w = pk2(k1[kk][2], k1[kk][3]);
            acc = __builtin_amdgcn_mfma_f32_16x16x32_bf16(qf[kk], __builtin_bit_cast(bf16x8, pk), acc, 0, 0, 0);
        }
        if (fq == 0) {
#pragma unroll
            for (int j = 0; j < 4; ++j) sc[j * 256 + w * 32 + mt * 16 + fr] = acc[j];
        }
    }
    LDS_BARRIER();
#pragma unroll
    for (int mm = 0; mm < 16; ++mm) v1[mm] = __builtin_nontemporal_load((const f32x4*)(vp + (size_t)(16 + mm) * 1024));
    if (w < 4) {
        f32x4 s = *(const f32x4*)(sc + w * 256 + lane * 4);
        float m = fmaxf(fmaxf(s[0], s[1]), fmaxf(s[2], s[3])); m = wave_max(m);
        s[0] = __expf(s[0] - m); s[1] = __expf(s[1] - m); s[2] = __expf(s[2] - m); s[3] = __expf(s[3] - m);
        float su = (s[0] + s[1]) + (s[2] + s[3]); su = wave_sum(su);
        const float inv = 1.0f / su;
        *(f32x4*)(sc + w * 256 + lane * 4) = s * inv;
    }
    LDS_BARRIER();
    {
        f32x4 o[4];
#pragma unroll
        for (int i = 0; i < 4; ++i) o[i] = (f32x4){0.f, 0.f, 0.f, 0.f};
#pragma unroll
        for (int mm = 0; mm < 16; ++mm) {
#pragma unroll
            for (int i = 0; i < 4; ++i) o[i] += sc[i * 256 + w * 32 + mm] * v0[mm];
        }
#pragma unroll
        for (int mm = 0; mm < 16; ++mm) {
#pragma unroll
            for (int i = 0; i < 4; ++i) o[i] += sc[i * 256 + w * 32 + 16 + mm] * v1[mm];
        }
#pragma unroll
        for (int i = 0; i < 4; ++i) *(f32x4*)(part + (w * 4 + i) * 256 + lane * 4) = o[i];
    }
    LDS_BARRIER();
    {
        const int i = tid >> 7, d2 = (tid & 127) * 2;
        float s0 = 0.f, s1 = 0.f;
#pragma unroll
        for (int ww = 0; ww < 8; ++ww) { s0 += part[(ww * 4 + i) * 256 + d2]; s1 += part[(ww * 4 + i) * 256 + d2 + 1]; }
        *(unsigned*)((bf16_t*)(ws + W_O) + (size_t)(TP + b * 4 + i) * 1024 + hh * 256 + d2) = pk2(s0, s1);
    }
    LDS_BARRIER();
}

__device__ __forceinline__ void phase_ffnconv(PP P, int gtid, int nthreads) {
    char* ws = P->ws;
    const bf16_t* u = (const bf16_t*)(ws + W_U);
    bf16_t* act = (bf16_t*)(ws + W_ACT);
    for (int idx = gtid; idx < 1152 * 352; idx += nthreads) {
        const int run = idx / 352, cg = idx % 352;
        const bool samp = run >= 1024;
        int t0, len, bidx, tl0;
        if (!samp) { t0 = run * 16; len = 16; bidx = t0 >> 11; tl0 = t0 & 2047; } else { bidx = run - 1024; t0 = TP + bidx * 4; len = 4; tl0 = 0; }
        const int cgc = cg * 8, cvc = 2816 + cg * 8;
        float wg0[8], wg1[8], wg2[8], wv0[8], wv1[8], wv2[8], bg[8], bv[8], hg0[8], hg1[8], hv0[8], hv1[8];
#pragma unroll
        for (int e = 0; e < 8; ++e) {
            wg0[e] = P->ffn_w[cgc + e]; wg1[e] = P->ffn_w[5632 + cgc + e]; wg2[e] = P->ffn_w[11264 + cgc + e];
            wv0[e] = P->ffn_w[cvc + e]; wv1[e] = P->ffn_w[5632 + cvc + e]; wv2[e] = P->ffn_w[11264 + cvc + e];
            bg[e] = P->ffn_b[cgc + e]; bv[e] = P->ffn_b[cvc + e];
        }
        if (samp) {
#pragma unroll
            for (int e = 0; e < 8; ++e) {
                hg0[e] = P->state_ffn[(size_t)(bidx * 2 + 0) * 5632 + cgc + e]; hg1[e] = P->state_ffn[(size_t)(bidx * 2 + 1) * 5632 + cgc + e];
                hv0[e] = P->state_ffn[(size_t)(bidx * 2 + 0) * 5632 + cvc + e]; hv1[e] = P->state_ffn[(size_t)(bidx * 2 + 1) * 5632 + cvc + e];
            }
        } else if (tl0 > 0) {
            unpack8(ld8(u + (size_t)(t0 - 2) * 5632 + cgc), hg0); unpack8(ld8(u + (size_t)(t0 - 1) * 5632 + cgc), hg1);
            unpack8(ld8(u + (size_t)(t0 - 2) * 5632 + cvc), hv0); unpack8(ld8(u + (size_t)(t0 - 1) * 5632 + cvc), hv1);
        } else {
#pragma unroll
            for (int e = 0; e < 8; ++e) { hg0[e] = 0.f; hg1[e] = 0.f; hv0[e] = 0.f; hv1[e] = 0.f; }
        }
        for (int jb = 0; jb < len; jb += 8) {
        u32x4 rg[8], rv[8];
        const bf16_t* ub = u + (size_t)(t0 + jb) * 5632 + cgc;
#pragma unroll
        for (int jj = 0; jj < 8; ++jj) { if (jb + jj < len) { rg[jj] = ld8(ub + (size_t)jj * 5632); rv[jj] = ld8(ub + (size_t)jj * 5632 + 2816); } }
#pragma unroll
        for (int jj = 0; jj < 8; ++jj) {
            const int j = jb + jj;
            if (j < len) {
            float ug[8], uv[8], o8[8];
            unpack8(rg[jj], ug); unpack8(rv[jj], uv);
#pragma unroll
            for (int e = 0; e < 8; ++e) {
                const float gc = bg[e] + wg0[e] * hg0[e] + wg1[e] * hg1[e] + wg2[e] * ug[e];
                const float vc = bv[e] + wv0[e] * hv0[e] + wv1[e] * hv1[e] + wv2[e] * uv[e];
                o8[e] = silu_f(gc) * vc;
            }
            *(u32x4*)(act + (size_t)(t0 + j) * 2816 + cgc) = pack8(o8);
            float* o = nullptr;
            if (samp) { if (j >= 2) o = P->out + O_FFNS + (size_t)(bidx * 2 + j - 2) * 5632; }
            else { const int tl = tl0 + j; if (tl >= 2046) o = P->out + O_FFNP + (size_t)(bidx * 2 + tl - 2046) * 5632; }
            if (o) {
#pragma unroll
                for (int e = 0; e < 8; ++e) { o[cgc + e] = ug[e]; o[cvc + e] = uv[e]; }
            }
#pragma unroll
            for (int e = 0; e < 8; ++e) { hg0[e] = hg1[e]; hg1[e] = ug[e]; hv0[e] = hv1[e]; hv1[e] = uv[e]; }
            }
        }
        }
    }
}

#define XB_TMO      128
#define XB_XCNT(j)  (256  + 64 * (j))
#define XB_XSUB(j)  (1280 + 64 * (j))
#define XB_XGEN(j)  (2304 + 64 * (j))
#define XB_TOP      3328
#define XB_TOPGEN   3392
#define XCD_BAR_WORDS 3456
#define XB_SPIN_CAP (1u << 18)
__device__ __forceinline__ unsigned xb_ld(unsigned* p)              { return __hip_atomic_load(p, __ATOMIC_RELAXED, __HIP_MEMORY_SCOPE_AGENT); }
__device__ __forceinline__ unsigned xb_add(unsigned* p, unsigned v) { return __hip_atomic_fetch_add(p, v, __ATOMIC_RELAXED, __HIP_MEMORY_SCOPE_AGENT); }
__device__ __forceinline__ unsigned xb_xcc_id() { return (unsigned)__builtin_amdgcn_s_getreg((3 << 11) | 20) & 0xFu; }
#define XB_SPIN(cond, bar) do { unsigned _sp = 0; while (cond) { __builtin_amdgcn_s_sleep(1); \
    if ((++_sp & 255u) == 0u) { if (xb_ld(&(bar)[XB_TMO])) break; if (_sp > XB_SPIN_CAP) { atomicAdd(&(bar)[XB_TMO], 1u); break; } } } } while (0)
__device__ __forceinline__ void xcd_barrier_complete(unsigned* bar, unsigned x, unsigned& nloc, unsigned& nx) {
    const unsigned G = gridDim.x;
    unsigned sum, cnt, mine, sp = 0u;
    for (;;) {
        sum = 0u; cnt = 0u; mine = 0u;
#pragma unroll
        for (unsigned j = 0; j < 16; ++j) { const unsigned c = xb_ld(&bar[XB_XCNT(j)]); sum += c; cnt += (c > 0u) ? 1u : 0u; mine = (j == x) ? c : mine; }
        if (sum == G) break;
        __builtin_amdgcn_s_sleep(1);
        if ((++sp & 255u) == 0u) { if (xb_ld(&bar[XB_TMO])) break; if (sp > XB_SPIN_CAP) { atomicAdd(&bar[XB_TMO], 1u); break; } }
    }
    nloc = mine > 0u ? mine : 1u; nx = cnt > 0u ? cnt : 1u;
}
__device__ __forceinline__ void xcd_barrier(unsigned* bar, volatile LDSB unsigned* st, const int tid) {
    asm volatile("s_waitcnt vmcnt(0)" ::: "memory");
    __syncthreads();
    if (tid == 0) {
        const unsigned x = xb_xcc_id();
        __builtin_amdgcn_s_waitcnt(0);
        unsigned nloc = st[0], nx = st[1];
        if (nloc == 0u) { xcd_barrier_complete(bar, x, nloc, nx); st[0] = nloc; st[1] = nx; }
        const unsigned old = xb_add(&bar[XB_XSUB(x)], 1u);
        const unsigned gen = old / nloc;
        if (old + 1u == (gen + 1u) * nloc) {
            __builtin_amdgcn_fence(__ATOMIC_RELEASE, "agent");
            asm volatile("s_waitcnt vmcnt(0)" ::: "memory");
            const unsigned og = xb_add(&bar[XB_TOP], 1u);
            const unsigned tg = og / nx;
            if (og + 1u == (tg + 1u) * nx) xb_add(&bar[XB_TOPGEN], 1u);
            else XB_SPIN(xb_ld(&bar[XB_TOPGEN]) == tg, bar);
            __builtin_amdgcn_fence(__ATOMIC_ACQUIRE, "agent");
            xb_add(&bar[XB_XGEN(x)], 1u);
            asm volatile("s_waitcnt vmcnt(0)" ::: "memory");
        } else {
            XB_SPIN(xb_ld(&bar[XB_XGEN(x)]) == gen, bar);
            __builtin_amdgcn_fence(__ATOMIC_ACQUIRE, "agent");
            asm volatile("s_waitcnt vmcnt(0)" ::: "memory");
        }
    }
    __syncthreads();
}

extern __shared__ __attribute__((aligned(16))) char smem[];

__global__ void __launch_bounds__(NTHR) hybrid_fwd(Params Pin) {
    char* shm = smem;
    volatile LDSB unsigned* bst = (volatile LDSB unsigned*)(smem + 139264);
    if (threadIdx.x == 0) { bst[0] = 0u; bst[1] = 0u; (void)xb_add((unsigned*)(Pin.ws + W_BAR) + XB_XCNT(xb_xcc_id()), 1u); }
    __syncthreads();
    for (int ph = Pin.ph_lo; ph < Pin.ph_hi; ++ph) {
        if (ph == 6 || ph == 11) continue;
        const int reps = ((REPEAT_MASK >> ph) & 1) ? 2 : 1;
        for (int rep = 0; rep < reps; ++rep) {
        if (rep > 0) xcd_barrier((unsigned*)(Pin.ws + W_BAR), bst, threadIdx.x);
        int tid = threadIdx.x, blk = blockIdx.x, nblk = gridDim.x;
        asm volatile("" : "+v"(tid));
        asm volatile("" : "+s"(blk), "+s"(nblk));
        PP P = (PP)__builtin_amdgcn_kernarg_segment_ptr();
        asm volatile("" : "+s"(P));
        const int lb = (blk & 7) * (nblk >> 3) + (blk >> 3);
        const int gtid = blk * NTHR + tid, nthreads = nblk * NTHR;
        const int gw = blk * 8 + (tid >> 6), nw = nblk * 8;
        switch (ph) {
#if PHASE_MASK & 1
        case 0: phase_prep(P, shm, blk, nblk, tid); break;
#endif
#if PHASE_MASK & 4
        case 2: phase_convpool(P, gtid, nthreads); break;
#endif
#if PHASE_MASK & 8
        case 3:
            if (blk & 1) { int it = blk; for (; it + nblk < 2048; it += 2 * nblk) ssd_sample<2>(P, it, nblk, tid); for (; it < 2048; it += nblk) ssd_sample<1>(P, it, nblk, tid); }
            for (int it = blk; it < 256; it += nblk) ssd_prompt(P, it, shm, tid);
            if (!(blk & 1)) { int it = blk; for (; it + nblk < 2048; it += 2 * nblk) ssd_sample<2>(P, it, nblk, tid); for (; it < 2048; it += nblk) ssd_sample<1>(P, it, nblk, tid); }
            break;
#endif
#if PHASE_MASK & 16
        case 4: phase_gatednorm(P, gw, nw, tid); break;
#endif
#if PHASE_MASK & 64
        case 6: phase_norm(P, P->norm_mem, false, gw, nw, tid); break;
        case 11: phase_norm(P, P->norm_ffn, false, gw, nw, tid); break;
        case 15: phase_norm(P, P->final_norm, true, gw, nw, tid); break;
#endif
#if PHASE_MASK & 8192
        case 13: phase_ffnconv(P, gtid, nthreads); break;
#endif
        default: break;
        }
#if PHASE_MASK & 256
        if (ph == 8 && (blk & 1)) { for (int it = blk; it < 512; it += nblk) attn_sample(P, it, shm, tid); __syncthreads(); }
#endif
#if PHASE_MASK & 2
        if (ph == 1 || ph == 5 || ph == 7 || ph == 8 || ph == 9 || ph == 10 || ph == 12 || ph == 14) gemm_phase(P, ph, shm, lb, blk, nblk, tid);
#endif
#if PHASE_MASK & 256
        if (ph == 9 && !(blk & 1)) { for (int it = blk; it < 512; it += nblk) attn_sample(P, it, shm, tid); }
#endif
        }
        if (ph + 1 < Pin.ph_hi && ph != 8) xcd_barrier((unsigned*)(Pin.ws + W_BAR), bst, threadIdx.x);
        if (ph == 8) { asm volatile("s_waitcnt vmcnt(0)" ::: "memory"); __syncthreads(); }
        if (EXTRA_SYNCS && ph == 0) { for (int i = 0; i < EXTRA_SYNCS; ++i) xcd_barrier((unsigned*)(Pin.ws + W_BAR), bst, threadIdx.x); }
    }
}

extern "C" void kernel_launch(void* const* d_in, const int* in_sizes, int n_in, void* d_out, int out_size, void* d_ws, size_t ws_size, hipStream_t stream) {
    static int grid_blocks = 0;
    if (!grid_blocks) {
        int dev = 0, cus = 0, per_cu = 0;
        hipGetDevice(&dev);
        hipDeviceGetAttribute(&cus, hipDeviceAttributeMultiprocessorCount, dev);
        hipFuncSetAttribute((const void*)hybrid_fwd, hipFuncAttributeMaxDynamicSharedMemorySize, LDS_BYTES);
        hipOccupancyMaxActiveBlocksPerMultiprocessor(&per_cu, hybrid_fwd, NTHR, LDS_BYTES);
        if (per_cu < 1) per_cu = 1;
        grid_blocks = cus * 1;
        grid_blocks &= ~7;
        if (grid_blocks < 8) grid_blocks = 8;
    }
    Params p{};
    const float* const* in = (const float* const*)d_in;
    p.x_prompt = in[0]; p.x_sample = in[1]; p.mem_prompt = in[2]; p.state_ssm = in[3]; p.state_conv = in[4]; p.state_pool = in[5]; p.state_ffn = in[6];
    p.cache_k = in[7]; p.cache_v = in[8]; p.norm_mix = in[9]; p.w_in = in[10]; p.conv_w = in[11]; p.conv_b = in[12]; p.dt_bias = in[13]; p.a_log = in[14];
    p.ssm_d = in[15]; p.ssm_norm = in[16]; p.w_pool = in[17]; p.pool_scale = in[18]; p.w_out = in[19]; p.norm_mem = in[20]; p.norm_memkv = in[21];
    p.w_mq = in[22]; p.w_mk = in[23]; p.w_mv = in[24]; p.w_mo = in[25]; p.norm_ffn = in[26]; p.w_up = in[27]; p.ffn_w = in[28]; p.ffn_b = in[29];
    p.w_down = in[30]; p.final_norm = in[31];
    p.out = (float*)d_out; p.ws = (char*)d_ws; p.ph_lo = 0; p.ph_hi = 16;
    hipMemsetAsync((char*)d_ws + W_BAR, 0, 16384, stream);
    void* args[] = {&p};
    hipError_t e = hipLaunchCooperativeKernel((const void*)hybrid_fwd, dim3(grid_blocks), dim3(NTHR), args, LDS_BYTES, stream);
    if (e != hipSuccess) fprintf(stderr, "cooperative launch failed: %s (grid %d)\n", hipGetErrorString(e), grid_blocks);
}
```

```cpp
#include <hip/hip_runtime.h>
#include <hip/hip_cooperative_groups.h>
#include <cstdio>
namespace cg = cooperative_groups;

typedef unsigned short bf16_t;
typedef short bf16x8 __attribute__((ext_vector_type(8)));
typedef short s16x4 __attribute__((ext_vector_type(4)));
typedef float f32x4 __attribute__((ext_vector_type(4)));
typedef unsigned u32x4 __attribute__((ext_vector_type(4)));
typedef unsigned u32x2 __attribute__((ext_vector_type(2)));
#define LDSB __attribute__((address_space(3)))

constexpr int TP = 16384, TS = 512, TT = TP + TS;
constexpr int NTHR = 512;
constexpr int LDS_BYTES = 139264 + 256;
constexpr float EPS = 1e-6f;
#ifndef PHASE_MASK
#define PHASE_MASK 0xFFFF
#endif
#ifndef REPEAT_MASK
#define REPEAT_MASK 0
#endif
#ifndef PROBE3
#define PROBE3 0
#endif
#ifndef EXTRA_SYNCS
#define EXTRA_SYNCS 0
#endif

constexpr size_t O_YP = 0;
constexpr size_t O_YS = O_YP + (size_t)TP * 1024;
constexpr size_t O_SSMP = O_YS + (size_t)TS * 1024;
constexpr size_t O_SSMS = O_SSMP + (size_t)8 * 16 * 64 * 128;
constexpr size_t O_CONVP = O_SSMS + (size_t)128 * 16 * 64 * 128;
constexpr size_t O_CONVS = O_CONVP + (size_t)8 * 3 * 1536;
constexpr size_t O_POOLP = O_CONVS + (size_t)128 * 3 * 1536;
constexpr size_t O_POOLS = O_POOLP + (size_t)8 * 15 * 1024;
constexpr size_t O_FFNP = O_POOLS + (size_t)128 * 15 * 1024;
constexpr size_t O_FFNS = O_FFNP + (size_t)8 * 2 * 5632;
constexpr size_t O_MK = O_FFNS + (size_t)128 * 2 * 5632;
constexpr size_t O_MV = O_MK + (size_t)8 * 256 * 1024;

constexpr size_t W_WIN = 0;
constexpr size_t W_WPOOL = W_WIN + (size_t)3584 * 1024 * 2;
constexpr size_t W_WOUT = W_WPOOL + (size_t)4 * 256 * 256 * 2;
constexpr size_t W_WMQ = W_WOUT + (size_t)1024 * 2048 * 2;
constexpr size_t W_WMK = W_WMQ + (size_t)1024 * 1024 * 2;
constexpr size_t W_WMV = W_WMK + (size_t)1024 * 1024 * 2;
constexpr size_t W_WMO = W_WMV + (size_t)1024 * 1024 * 2;
constexpr size_t W_WUP = W_WMO + (size_t)1024 * 1024 * 2;
constexpr size_t W_WDOWN = W_WUP + (size_t)5632 * 1024 * 2;
constexpr size_t W_H = W_WDOWN + (size_t)1024 * 2816 * 2;
constexpr size_t W_HM = W_H + (size_t)TT * 1024 * 2;
constexpr size_t W_KB = W_HM + (size_t)2048 * 1024 * 2;
constexpr size_t W_VT = W_KB + (size_t)2048 * 1024 * 2;
constexpr size_t W_DT = W_VT + (size_t)2048 * 1024 * 2;
constexpr size_t W_XRES = W_DT + (size_t)TT * 16 * 4;
constexpr size_t W_ARENA = W_XRES + (size_t)TT * 1024 * 4;
constexpr size_t W_Z = W_ARENA;
constexpr size_t W_PROJ2 = W_Z + (size_t)TT * 1024 * 2;
constexpr size_t W_XACT = W_PROJ2 + (size_t)TT * 2560 * 2;
constexpr size_t W_POOLED = W_XACT + (size_t)TT * 1536 * 2;
constexpr size_t W_Y = W_POOLED + (size_t)TT * 1024 * 2;
constexpr size_t W_MIX = W_Y + (size_t)TT * 1024 * 2;
constexpr size_t W_END_A = W_MIX + (size_t)TT * 2048 * 2;
constexpr size_t W_Q = W_PROJ2;
constexpr size_t W_P = W_Q + (size_t)TT * 1024 * 2;
constexpr size_t W_O = W_P + (size_t)TP * 1024 * 2;
constexpr size_t W_U = W_ARENA;
constexpr size_t W_ACT = W_U + (size_t)TT * 5632 * 2;
constexpr size_t W_END_C = W_ACT + (size_t)TT * 2816 * 2;
constexpr size_t W_BAR = W_END_A;
constexpr size_t W_SS1 = W_BAR + 16384;
constexpr size_t W_SS2 = W_SS1 + (size_t)TT * 4;
constexpr size_t W_SS3 = W_SS2 + (size_t)TT * 4;
constexpr size_t W_WLO = W_SS3 + (size_t)TT * 4;
constexpr size_t W_TOTAL = W_WLO + (size_t)1024 * 1024 * 2;
static_assert(W_O + (size_t)TT * 1024 * 2 <= W_POOLED, "era B overflow");
static_assert(W_END_C <= W_END_A, "era C overflow");

struct Params {
    const float *x_prompt, *x_sample, *mem_prompt, *state_ssm, *state_conv, *state_pool, *state_ffn, *cache_k, *cache_v;
    const float *norm_mix, *w_in, *conv_w, *conv_b, *dt_bias, *a_log, *ssm_d, *ssm_norm, *w_pool, *pool_scale, *w_out;
    const float *norm_mem, *norm_memkv, *w_mq, *w_mk, *w_mv, *w_mo, *norm_ffn, *w_up, *ffn_w, *ffn_b, *w_down, *final_norm;
    float* out;
    char* ws;
    int ph_lo, ph_hi;
};

typedef const __attribute__((address_space(4))) Params* PP;

__device__ __forceinline__ unsigned pk2(float lo, float hi) { unsigned r; asm("v_cvt_pk_bf16_f32 %0, %1, %2" : "=v"(r) : "v"(lo), "v"(hi)); return r; }
__device__ __forceinline__ bf16_t f2bf(float f) { return (bf16_t)(pk2(f, 0.f) & 0xffffu); }
__device__ __forceinline__ float bf2f(bf16_t b) { return __uint_as_float(((unsigned)b) << 16); }
__device__ __forceinline__ float bflo(unsigned u) { return __uint_as_float(u << 16); }
__device__ __forceinline__ float bfhi(unsigned u) { return __uint_as_float(u & 0xffff0000u); }
__device__ __forceinline__ void unpack8(u32x4 v, float (&f)[8]) {
    f[0] = bflo(v.x); f[1] = bfhi(v.x); f[2] = bflo(v.y); f[3] = bfhi(v.y); f[4] = bflo(v.z); f[5] = bfhi(v.z); f[6] = bflo(v.w); f[7] = bfhi(v.w);
}
__device__ __forceinline__ u32x4 pack8(const float (&f)[8]) { u32x4 r; r.x = pk2(f[0], f[1]); r.y = pk2(f[2], f[3]); r.z = pk2(f[4], f[5]); r.w = pk2(f[6], f[7]); return r; }
__device__ __forceinline__ float wave_sum(float v) {
#pragma unroll
    for (int o = 1; o < 64; o <<= 1) v += __shfl_xor(v, o);
    return v;
}
__device__ __forceinline__ float wave_max(float v) {
#pragma unroll
    for (int o = 1; o < 64; o <<= 1) v = fmaxf(v, __shfl_xor(v, o));
    return v;
}
__device__ __forceinline__ float silu_f(float x) { return x * __builtin_amdgcn_rcpf(1.0f + __expf(-x)); }

constexpr int HTB = 128 * 64 * 2;
__device__ __forceinline__ int lds_byte(int r, int c) { const int st = (r >> 4) * 2 + (c >> 5), rr = r & 15, cc = c & 31, ob = rr * 64 + cc * 2; return st * 1024 + (ob ^ (((ob >> 9) & 1) << 5)); }
__device__ __forceinline__ void stage_rc(int b, int& R, int& C) { const int st = b / 1024, sb = b % 1024, swz = sb ^ (((sb >> 9) & 1) << 5); R = (st >> 1) * 16 + swz / 64; C = (st & 1) * 32 + (swz % 64) / 2; }

__device__ __forceinline__ int perm32(int rho) { const int n = rho >> 4, i = rho & 15; return 8 * (i >> 2) + 4 * n + (i & 3); }
__device__ __forceinline__ int invperm32(int c) { return 16 * ((c >> 2) & 1) + 4 * (c >> 3) + (c & 3); }
enum { E_PROJ = 0, E_MEMKV, E_POOL, E_OUT, E_Q, E_QK, E_PV, E_MO, E_UP, E_DOWN, E_FOLD };

template <int EK>
__device__ __forceinline__ float epi_apply(PP P, int row, int col, f32x4 v) {
    char* ws = P->ws;
    if constexpr (EK == E_PROJ) {
        u32x2 o; o.x = pk2(v[0], v[1]); o.y = pk2(v[2], v[3]);
        if (col < 1024) *(u32x2*)((bf16_t*)(ws + W_Z) + (size_t)row * 1024 + col) = o;
        else *(u32x2*)((bf16_t*)(ws + W_PROJ2) + (size_t)row * 2560 + (col - 1024)) = o;
    } else if constexpr (EK == E_MEMKV) {
        if (col < 1024) {
            *(f32x4*)(P->out + O_MK + (size_t)row * 1024 + col) = v;
            u32x2 o; o.x = pk2(v[0], v[1]); o.y = pk2(v[2], v[3]);
            *(u32x2*)((bf16_t*)(ws + W_KB) + (size_t)((row & ~31) + invperm32(row & 31)) * 1024 + col) = o;
        } else {
            const int c = col - 1024;
            *(f32x4*)(P->out + O_MV + (size_t)row * 1024 + c) = v;
            const int b = row >> 8, m = row & 255, hh = c >> 8, d = c & 255;
            bf16_t* vt = (bf16_t*)(ws + W_VT) + ((size_t)(b * 4 + hh) * 256 + (d & ~31) + invperm32(d & 31)) * 256 + m;
#pragma unroll
            for (int j = 0; j < 4; ++j) vt[j * 256] = f2bf(v[j]);
        }
    } else if constexpr (EK == E_POOL) {
        const f32x4 sc = *(const f32x4*)(P->pool_scale + col);
        u32x2 o; o.x = pk2(v[0] * sc[0], v[1] * sc[1]); o.y = pk2(v[2] * sc[2], v[3] * sc[3]);
        *(u32x2*)((bf16_t*)(ws + W_MIX) + (size_t)row * 2048 + 1024 + col) = o;
    } else if constexpr (EK == E_OUT) {
        const float* xin = row < TP ? P->x_prompt + (size_t)row * 1024 : P->x_sample + (size_t)(row - TP) * 1024;
        const f32x4 x = *(const f32x4*)(xin + col) + v;
        u32x2 o; o.x = pk2(x[0], x[1]); o.y = pk2(x[2], x[3]);
        *(u32x2*)((bf16_t*)(ws + W_H) + (size_t)row * 1024 + col) = o;
        return (x[0] * x[0] + x[1] * x[1]) + (x[2] * x[2] + x[3] * x[3]);
    } else if constexpr (EK == E_Q) {
        u32x2 o; o.x = pk2(v[0], v[1]); o.y = pk2(v[2], v[3]);
        *(u32x2*)((bf16_t*)(ws + W_Q) + (size_t)row * 1024 + col) = o;
    } else if constexpr (EK == E_PV) {
        u32x2 o; o.x = pk2(v[0], v[1]); o.y = pk2(v[2], v[3]);
        *(u32x2*)((bf16_t*)(ws + W_O) + (size_t)row * 1024 + col) = o;
    } else if constexpr (EK == E_MO || EK == E_DOWN) {
        u32x2* hp = (u32x2*)((bf16_t*)(ws + W_H) + (size_t)row * 1024 + col);
        const u32x2 hv = *hp;
        const f32x4 x = (f32x4){bflo(hv.x), bfhi(hv.x), bflo(hv.y), bfhi(hv.y)} + v;
        u32x2 o; o.x = pk2(x[0], x[1]); o.y = pk2(x[2], x[3]);
        *hp = o;
        return (x[0] * x[0] + x[1] * x[1]) + (x[2] * x[2] + x[3] * x[3]);
    } else if constexpr (EK == E_UP) {
        u32x2 o; o.x = pk2(v[0], v[1]); o.y = pk2(v[2], v[3]);
        *(u32x2*)((bf16_t*)(ws + W_U) + (size_t)row * 5632 + col) = o;
    }
    return 0.f;
}
template <int EK>
__device__ __forceinline__ float epi_rowscale(PP P, int row) {
    if constexpr (EK == E_Q) return rsqrtf(((const float*)(P->ws + W_SS1))[row] * (1.0f / 1024.0f) + EPS) * 0.0625f;
    else if constexpr (EK == E_UP) return rsqrtf(((const float*)(P->ws + W_SS2))[row] * (1.0f / 1024.0f) + EPS);
    else return 1.0f;
}
__device__ __forceinline__ float epi_apply_rt(PP P, int ekind, int row, int col, f32x4 v) {
    switch (ekind) {
    case E_FOLD: { u32x2 o; o.x = pk2(v[0], v[1]); o.y = pk2(v[2], v[3]); const int prow = (row & ~31) + invperm32(row & 31); *(u32x2*)((bf16_t*)(P->ws + W_WOUT) + (size_t)prow * 2048 + 1024 + col) = o; return 0.f; }
    case E_OUT: return epi_apply<E_OUT>(P, row, col, v);
    case E_Q: return epi_apply<E_Q>(P, row, col, v * epi_rowscale<E_Q>(P, row));
    case E_MO: return epi_apply<E_MO>(P, row, col, v);
    default: return epi_apply<E_DOWN>(P, row, col, v);
    }
}
template <int EK>
__device__ __forceinline__ void epi_loop(PP P, const f32x4 (&acc)[2][2][4][2], int rbase, int cbase, int fq) {
    if constexpr (EK == E_PROJ || EK == E_UP || EK == E_Q || EK == E_PV || EK == E_OUT || EK == E_MO || EK == E_DOWN) {
        const int cb8 = cbase + 4 * fq;
#pragma unroll
        for (int ai = 0; ai < 2; ++ai)
#pragma unroll
            for (int m = 0; m < 4; ++m) {
                const int row = rbase + ai * 128 + m * 16;
                const float rs = epi_rowscale<EK>(P, row);
                float ss = 0.f;
#pragma unroll
                for (int bj = 0; bj < 2; ++bj) {
                    f32x4 v0 = acc[ai][bj][m][0], v1 = acc[ai][bj][m][1];
                    const int col = cb8 + bj * 128;
                    if constexpr (EK == E_PROJ || EK == E_UP || EK == E_Q) { v0 *= rs; v1 *= rs; }
                    if constexpr (EK == E_OUT) {
                        const float* xin = (row < TP ? P->x_prompt + (size_t)row * 1024 : P->x_sample + (size_t)(row - TP) * 1024) + col;
                        v0 += *(const f32x4*)xin; v1 += *(const f32x4*)(xin + 4);
                    }
                    if constexpr (EK == E_MO || EK == E_DOWN) {
                        const u32x4 hv = *(const u32x4*)((const bf16_t*)(P->ws + W_H) + (size_t)row * 1024 + col);
                        v0 += (f32x4){bflo(hv.x), bfhi(hv.x), bflo(hv.y), bfhi(hv.y)}; v1 += (f32x4){bflo(hv.z), bfhi(hv.z), bflo(hv.w), bfhi(hv.w)};
                    }
                    if constexpr (EK == E_OUT || EK == E_MO || EK == E_DOWN) ss += ((v0[0] * v0[0] + v0[1] * v0[1]) + (v0[2] * v0[2] + v0[3] * v0[3])) + ((v1[0] * v1[0] + v1[1] * v1[1]) + (v1[2] * v1[2] + v1[3] * v1[3]));
                    u32x4 o; o.x = pk2(v0[0], v0[1]); o.y = pk2(v0[2], v0[3]); o.z = pk2(v1[0], v1[1]); o.w = pk2(v1[2], v1[3]);
                    if constexpr (EK == E_UP) *(u32x4*)((bf16_t*)(P->ws + W_U) + (size_t)row * 5632 + col) = o;
                    else if constexpr (EK == E_Q) *(u32x4*)((bf16_t*)(P->ws + W_Q) + (size_t)row * 1024 + col) = o;
                    else if constexpr (EK == E_PV) *(u32x4*)((bf16_t*)(P->ws + W_O) + (size_t)row * 1024 + col) = o;
                    else if constexpr (EK == E_PROJ) { if (col < 1024) *(u32x4*)((bf16_t*)(P->ws + W_Z) + (size_t)row * 1024 + col) = o;
                           else *(u32x4*)((bf16_t*)(P->ws + W_PROJ2) + (size_t)row * 2560 + (col - 1024)) = o; }
                    else *(u32x4*)((bf16_t*)(P->ws + W_H) + (size_t)row * 1024 + col) = o;
                }
                if constexpr (EK == E_OUT || EK == E_MO || EK == E_DOWN) {
                    ss += __shfl_xor(ss, 16); ss += __shfl_xor(ss, 32);
                    if (fq == 0) unsafeAtomicAdd((float*)(P->ws + (EK == E_OUT ? W_SS1 : EK == E_MO ? W_SS2 : W_SS3)) + row, ss);
                }
            }
        return;
    }
#pragma unroll
    for (int ai = 0; ai < 2; ++ai)
#pragma unroll
        for (int m = 0; m < 4; ++m) {
            const int row = rbase + ai * 128 + m * 16;
            const float rs = epi_rowscale<EK>(P, row);
            float ss = 0.f;
#pragma unroll
            for (int bj = 0; bj < 2; ++bj)
#pragma unroll
                for (int n = 0; n < 2; ++n) {
                    if constexpr (EK == E_Q || EK == E_UP) ss += epi_apply<EK>(P, row, cbase + bj * 128 + n * 16, acc[ai][bj][m][n] * rs);
                    else ss += epi_apply<EK>(P, row, cbase + bj * 128 + n * 16, acc[ai][bj][m][n]);
                }
            if constexpr (EK == E_OUT || EK == E_MO || EK == E_DOWN) {
                ss += __shfl_xor(ss, 16); ss += __shfl_xor(ss, 32);
                if (fq == 0) unsafeAtomicAdd((float*)(P->ws + (EK == E_OUT ? W_SS1 : EK == E_MO ? W_SS2 : W_SS3)) + row, ss);
            }
        }
}

struct PhaseCfg { const char* A; const char* B; int lda, ldb, K, nbig, nsmall, ncol64, ekind; };
__device__ __forceinline__ PhaseCfg phase_cfg(PP P, int gp) {
    const char* ws = P->ws; PhaseCfg c;
    switch (gp) {
    case 1:  c.A = ws + W_H;      c.B = ws + W_WIN;   c.lda = 1024; c.ldb = 1024; c.K = 1024; c.nbig = 66 * 14 + 64; c.nsmall = 512; c.ncol64 = 16; c.ekind = E_PROJ; break;
    case 3:  c.A = ws + W_POOLED; c.B = ws + W_WPOOL; c.lda = 1024; c.ldb = 256;  c.K = 256;  c.nbig = 256; c.nsmall = 256; c.ncol64 = 16; c.ekind = E_POOL; break;
    case 5:  c.A = ws + W_MIX;    c.B = ws + W_WOUT;  c.lda = 2048; c.ldb = 2048; c.K = 2048; c.nbig = 256; c.nsmall = 256; c.ncol64 = 16; c.ekind = E_OUT; break;
    case 7:  c.A = ws + W_H;      c.B = ws + W_WMQ;   c.lda = 1024; c.ldb = 1024; c.K = 1024; c.nbig = 256; c.nsmall = 256; c.ncol64 = 16; c.ekind = E_Q; break;
    case 8:  c.A = ws + W_Q;      c.B = ws + W_KB;    c.lda = 1024; c.ldb = 1024; c.K = 256;  c.nbig = 256; c.nsmall = 0;   c.ncol64 = 16; c.ekind = E_QK; break;
    case 9:  c.A = ws + W_P;      c.B = ws + W_VT;    c.lda = 1024; c.ldb = 256;  c.K = 256;  c.nbig = 256; c.nsmall = 0;   c.ncol64 = 16; c.ekind = E_PV; break;
    case 10: c.A = ws + W_O;      c.B = ws + W_WMO;   c.lda = 1024; c.ldb = 1024; c.K = 1024; c.nbig = 256; c.nsmall = 256; c.ncol64 = 16; c.ekind = E_MO; break;
    case 12: c.A = ws + W_H;      c.B = ws + W_WUP;   c.lda = 1024; c.ldb = 1024; c.K = 1024; c.nbig = 66 * 22; c.nsmall = 0; c.ncol64 = 88; c.ekind = E_UP; break;
    default: c.A = ws + W_ACT;    c.B = ws + W_WDOWN; c.lda = 2816; c.ldb = 2816; c.K = 2816; c.nbig = 256; c.nsmall = 256; c.ncol64 = 16; c.ekind = E_DOWN; break;
    }
    return c;
}
struct UnitD { const char* A; const char* B; int row0, col0, ekind; };
__device__ __forceinline__ void map_unit(int L, int nM, int nN, int& pm, int& pn) {
    const int nwg = nM * nN, q = nwg >> 3, r = nwg & 7, xcd = L & 7, off = L >> 3;
    const int wgid = (xcd < r ? xcd * (q + 1) : r * (q + 1) + (xcd - r) * q) + off;
    const int nig = 8 * nN, gid = wgid / nig, fm = gid * 8, gsz = (nM - fm) < 8 ? (nM - fm) : 8;
    const int w = wgid - gid * nig;
    pm = fm + w % gsz; pn = w / gsz;
}
__device__ __forceinline__ UnitD unit_decode(PP P, const PhaseCfg& c, int gp, int L) {
    UnitD d; d.ekind = c.ekind;
    int pm, pn;
    switch (gp) {
    case 1:
        if (L < 924) { map_unit(L, 66, 14, pm, pn); d.A = c.A + (size_t)pm * 256 * 2048; d.B = c.B + (size_t)pn * 256 * 2048; }
        else { map_unit(L - 924, 8, 8, pm, pn); d.A = P->ws + W_HM + (size_t)pm * 256 * 2048; d.B = P->ws + W_WMK + (size_t)pn * 256 * 2048; d.ekind = E_MEMKV; }
        break;
    case 3: map_unit(L, 64, 4, pm, pn); d.A = c.A + (size_t)pm * 256 * 2048 + pn * 512; d.B = c.B + (size_t)pn * 131072; break;
    case 8: map_unit(L, 64, 4, pm, pn); d.A = c.A + (size_t)pm * 256 * 2048 + pn * 512; d.B = c.B + (size_t)(pm >> 3) * 256 * 2048 + pn * 512; break;
    case 9: map_unit(L, 64, 4, pm, pn); d.A = c.A + (size_t)pm * 256 * 2048 + pn * 512; d.B = c.B + (size_t)((pm >> 3) * 4 + pn) * 131072; break;
    case 12: map_unit(L, 66, 22, pm, pn); d.A = c.A + (size_t)pm * 256 * 2048; d.B = c.B + (size_t)pn * 256 * 2048; break;
    default: map_unit(L, 64, 4, pm, pn); d.A = c.A + (size_t)pm * 256 * c.lda * 2; d.B = c.B + (size_t)pn * 256 * c.ldb * 2; break;
    }
    d.row0 = pm * 256; d.col0 = pn * 256;
    return d;
}

__device__ __forceinline__ void gemm_phase(PP P, int gp, char* shm_g, int lb, int blk, int nblk, const int tid) {
    LDSB unsigned char* lds = (LDSB unsigned char*)shm_g;
    const int wid = __builtin_amdgcn_readfirstlane(tid >> 6), lane = tid & 63, wr = wid >> 2, wc = wid & 3, fr = lane & 15, fq = lane >> 4;
    const PhaseCfg cfg = phase_cfg(P, gp);
    const int K = cfg.K, nt = K / 64;
    unsigned voffA, voffB;
    { int R, C; stage_rc(tid * 16, R, C); voffA = (unsigned)(R * cfg.lda + C) * 2u; voffB = (unsigned)(R * cfg.ldb + C) * 2u; }
    const size_t qstepvoffA = (size_t)64 * cfg.lda * 2, qstepvoffB = (size_t)64 * cfg.ldb * 2;
    const size_t kstep = 128;
    const size_t hstepA = (size_t)128 * cfg.lda * 2, hstepB = (size_t)128 * cfg.ldb * 2;
    const unsigned ldsw = (unsigned)wid * 1024u;
    const int aoff = lds_byte(wr * 64 + fr, fq * 8), boff = lds_byte(wc * 32 + fr, fq * 8);
    const bool chain = (cfg.ekind != E_QK);
#define G_SA(b, h) (((b) * 2 + (h)) * HTB)
#define G_SB(b, h) ((4 + (b) * 2 + (h)) * HTB)
#define G_STAGE(bufoff, gbase, voff) do { \
        __builtin_amdgcn_global_load_lds((const unsigned*)((const char*)(gbase) + (voff)), (LDSB unsigned*)(lds + (bufoff) + ldsw), 16, 0, 0); \
        __builtin_amdgcn_global_load_lds((const unsigned*)((const char*)(gbase) + qstep##voff + (voff)), (LDSB unsigned*)(lds + (bufoff) + ldsw + 8192), 16, 0, 0); } while (0)
#define G_LDA(dst, b, h) do { _Pragma("unroll") for (int m = 0; m < 4; ++m) _Pragma("unroll") for (int k = 0; k < 2; ++k) dst[m][k] = *(const LDSB bf16x8*)(lds + G_SA(b, h) + aoff + m * 2048 + k * 1024); } while (0)
#define G_LDB(dst, b, h) do { _Pragma("unroll") for (int n = 0; n < 2; ++n) _Pragma("unroll") for (int k = 0; k < 2; ++k) dst[n][k] = *(const LDSB bf16x8*)(lds + G_SB(b, h) + boff + n * 2048 + k * 1024); } while (0)
#define G_MMA(ai, bj, Af, Bf) do { __builtin_amdgcn_s_setprio(1); _Pragma("unroll") for (int m = 0; m < 4; ++m) _Pragma("unroll") for (int n = 0; n < 2; ++n) _Pragma("unroll") for (int k = 0; k < 2; ++k) \
        acc[ai][bj][m][n] = __builtin_amdgcn_mfma_f32_16x16x32_bf16(Bf[n][k], Af[m][k], acc[ai][bj][m][n], 0, 0, 0); __builtin_amdgcn_s_setprio(0); } while (0)
#define G_WAIT_V(n) asm volatile("s_waitcnt vmcnt(" #n ")" ::: "memory")
#define G_WAIT_L(n) asm volatile("s_waitcnt lgkmcnt(" #n ")" ::: "memory")
#define G_BAR __builtin_amdgcn_s_barrier()
#define G_SCHED __builtin_amdgcn_sched_barrier(0)
    int u = blk;
    while (u < cfg.nbig) {
        UnitD cur = unit_decode(P, cfg, gp, u);
        f32x4 acc[2][2][4][2];
#pragma unroll
        for (int a = 0; a < 2; ++a)
#pragma unroll
            for (int b = 0; b < 2; ++b)
#pragma unroll
                for (int m = 0; m < 4; ++m)
#pragma unroll
                    for (int n = 0; n < 2; ++n) acc[a][b][m][n] = (f32x4){0.f, 0.f, 0.f, 0.f};
        bf16x8 At[4][2], B0[2][2], B1[2][2];
        const char* cA = cur.A; const char* cB = cur.B;
        G_STAGE(G_SB(0, 0), cB, voffB); G_STAGE(G_SA(0, 0), cA, voffA); G_STAGE(G_SB(0, 1), cB + hstepB, voffB); G_STAGE(G_SA(0, 1), cA + hstepA, voffA);
        if (wr == 1) G_BAR;
        G_WAIT_V(4); G_BAR;
        G_STAGE(G_SB(1, 0), cB + kstep, voffB); G_STAGE(G_SA(1, 0), cA + kstep, voffA); G_STAGE(G_SB(1, 1), cB + hstepB + kstep, voffB);
        G_WAIT_V(6); G_BAR;
        for (;;) {
            const bool has_next = chain && (u + nblk < cfg.nbig);
            UnitD nxt = cur;
            if (has_next) nxt = unit_decode(P, cfg, gp, u + nblk);
            const char* nA = nxt.A; const char* nB = nxt.B;
            for (int t = 0; t < nt; t += 2) {
                const bool last = (t == nt - 2);
                const char* a1 = cA + (size_t)(t + 1) * kstep;
                const char* a2 = last ? nA : cA + (size_t)(t + 2) * kstep; const char* b2 = last ? nB : cB + (size_t)(t + 2) * kstep;
                const char* a3 = a2 + kstep; const char* b3 = b2 + kstep;
                G_LDB(B0, 0, 0); G_SCHED; G_LDA(At, 0, 0); G_STAGE(G_SA(1, 1), a1 + hstepA, voffA);
                G_WAIT_L(8); G_BAR; G_WAIT_L(0); G_MMA(0, 0, At, B0); G_BAR; G_SCHED;
                G_LDB(B1, 0, 1); G_STAGE(G_SB(0, 0), b2, voffB);
                G_BAR; G_WAIT_L(0); G_MMA(0, 1, At, B1); G_BAR;
                G_LDA(At, 0, 1); G_STAGE(G_SA(0, 0), a2, voffA);
                G_BAR; G_WAIT_L(0); G_MMA(1, 0, At, B0); G_BAR; G_SCHED;
                G_STAGE(G_SB(0, 1), b2 + hstepB, voffB);
                G_WAIT_V(6); G_BAR; G_MMA(1, 1, At, B1); G_BAR;
                G_LDB(B0, 1, 0); G_SCHED; G_LDA(At, 1, 0); G_STAGE(G_SA(0, 1), a2 + hstepA, voffA);
                G_WAIT_L(8); G_BAR; G_WAIT_L(0); G_MMA(0, 0, At, B0); G_BAR; G_SCHED;
                G_LDB(B1, 1, 1); G_STAGE(G_SB(1, 0), b3, voffB);
                G_BAR; G_WAIT_L(0); G_MMA(0, 1, At, B1); G_BAR;
                G_LDA(At, 1, 1); G_STAGE(G_SA(1, 0), a3, voffA);
                G_BAR; G_WAIT_L(0); G_MMA(1, 0, At, B0); G_BAR; G_SCHED;
                G_STAGE(G_SB(1, 1), b3 + hstepB, voffB);
                G_WAIT_V(6); G_BAR; G_MMA(1, 1, At, B1); G_BAR;
            }
            if (chain) {
                const int rbase = cur.row0 + wr * 64 + fr, cbase = cur.col0 + wc * 32 + fq * 4;
                switch (cur.ekind) {
                case E_PROJ: epi_loop<E_PROJ>(P, acc, rbase, cbase, fq); break;
                case E_MEMKV: epi_loop<E_MEMKV>(P, acc, rbase, cbase, fq); break;
                case E_POOL: epi_loop<E_POOL>(P, acc, rbase, cbase, fq); break;
                case E_OUT: epi_loop<E_OUT>(P, acc, rbase, cbase, fq); break;
                case E_Q: epi_loop<E_Q>(P, acc, rbase, cbase, fq); break;
                case E_PV: epi_loop<E_PV>(P, acc, rbase, cbase, fq); break;
                case E_MO: epi_loop<E_MO>(P, acc, rbase, cbase, fq); break;
                case E_UP: epi_loop<E_UP>(P, acc, rbase, cbase, fq); break;
                default: epi_loop<E_DOWN>(P, acc, rbase, cbase, fq); break;
                }
            }
            if (!has_next) break;
#pragma unroll
            for (int a = 0; a < 2; ++a)
#pragma unroll
                for (int b = 0; b < 2; ++b)
#pragma unroll
                    for (int m = 0; m < 4; ++m)
#pragma unroll
                        for (int n = 0; n < 2; ++n) acc[a][b][m][n] = (f32x4){0.f, 0.f, 0.f, 0.f};
            cur = nxt; cA = nA; cB = nB; u += nblk;
        }
        G_WAIT_V(0);
        if (wr == 0) G_BAR;
        G_BAR;
        if (!chain) {
            float* redm = (float*)(shm_g + 131072);
            float* reds = (float*)(shm_g + 135168);
#pragma unroll
            for (int ai = 0; ai < 2; ++ai)
#pragma unroll
                for (int m = 0; m < 4; ++m) {
                    float t = -3.0e38f;
#pragma unroll
                    for (int bj = 0; bj < 2; ++bj)
#pragma unroll
                        for (int n = 0; n < 2; ++n)
#pragma unroll
                            for (int j = 0; j < 4; ++j) t = fmaxf(t, acc[ai][bj][m][n][j]);
                    t = fmaxf(t, __shfl_xor(t, 16)); t = fmaxf(t, __shfl_xor(t, 32));
                    if (fq == 0) redm[(ai * 128 + wr * 64 + m * 16 + fr) * 4 + wc] = t;
                }
            __syncthreads();
#pragma unroll
            for (int ai = 0; ai < 2; ++ai)
#pragma unroll
                for (int m = 0; m < 4; ++m) {
                    const f32x4 r = *(const f32x4*)(redm + (ai * 128 + wr * 64 + m * 16 + fr) * 4);
                    const float M = fmaxf(fmaxf(r[0], r[1]), fmaxf(r[2], r[3]));
                    float s = 0.f;
#pragma unroll
                    for (int bj = 0; bj < 2; ++bj)
#pragma unroll
                        for (int n = 0; n < 2; ++n)
#pragma unroll
                            for (int j = 0; j < 4; ++j) { const float e = __expf(acc[ai][bj][m][n][j] - M); acc[ai][bj][m][n][j] = e; s += e; }
                    s += __shfl_xor(s, 16); s += __shfl_xor(s, 32);
                    if (fq == 0) reds[(ai * 128 + wr * 64 + m * 16 + fr) * 4 + wc] = s;
                }
            __syncthreads();
#pragma unroll
            for (int ai = 0; ai < 2; ++ai)
#pragma unroll
                for (int m = 0; m < 4; ++m) {
                    const int rl = ai * 128 + wr * 64 + m * 16 + fr;
                    const f32x4 r = *(const f32x4*)(reds + rl * 4);
                    const float inv = 1.0f / ((r[0] + r[1]) + (r[2] + r[3]));
                    bf16_t* prow = (bf16_t*)(P->ws + W_P) + (size_t)(cur.row0 + rl) * 1024 + cur.col0;
#pragma unroll
                    for (int bj = 0; bj < 2; ++bj) {
                        const f32x4 v0 = acc[ai][bj][m][0], v1 = acc[ai][bj][m][1];
                        u32x4 o; o.x = pk2(v0[0] * inv, v0[1] * inv); o.y = pk2(v0[2] * inv, v0[3] * inv); o.z = pk2(v1[0] * inv, v1[1] * inv); o.w = pk2(v1[2] * inv, v1[3] * inv);
                        *(u32x4*)(prow + bj * 128 + wc * 32 + fq * 8) = o;
                    }
                }
            __syncthreads();
        }
        u += nblk;
    }
#undef G_SA
#undef G_SB
#undef G_STAGE
#undef G_LDA
#undef G_LDB
#undef G_MMA
    const int rot = cfg.nbig % nblk;
    for (int s0 = (lb - rot + nblk) % nblk; s0 < cfg.nsmall; s0 += nblk) {
        const int pr = s0 / cfg.ncol64, pc = s0 % cfg.ncol64;
        const int row0 = (gp == 1 ? 0 : TP) + pr * 32, col0 = pc * 64;
        int lda_s = cfg.lda, ldb_s = cfg.ldb, K_s = K, ek_s = cfg.ekind;
        const bf16_t* Ab; const bf16_t* Bb;
        if (gp == 1) {
            const int g = pc >> 2; lda_s = 1024; ldb_s = 256; K_s = 256; ek_s = E_FOLD;
            Ab = (const bf16_t*)(P->ws + W_WLO) + (size_t)row0 * 1024 + g * 256; Bb = (const bf16_t*)(P->ws + W_WPOOL) + (size_t)g * 65536 + (size_t)(col0 - g * 256) * 256;
        } else { Ab = (const bf16_t*)cfg.A + (size_t)row0 * cfg.lda; Bb = (const bf16_t*)cfg.B + (size_t)col0 * cfg.ldb; }
        const int kw = K_s >> 3, nks = kw >> 5;
        f32x4 acc[2][4];
#pragma unroll
        for (int mi = 0; mi < 2; ++mi)
#pragma unroll
            for (int ni = 0; ni < 4; ++ni) acc[mi][ni] = (f32x4){0.f, 0.f, 0.f, 0.f};
        const bf16_t* ap = Ab + (size_t)fr * lda_s + wid * kw + fq * 8;
        const bf16_t* bp = Bb + (size_t)fr * ldb_s + wid * kw + fq * 8;
        for (int ks0 = 0; ks0 < nks; ks0 += 4) {
            bf16x8 a[4][2], b[4][4];
#pragma unroll
            for (int q = 0; q < 4; ++q) {
                const bool ok = ks0 + q < nks;
#pragma unroll
                for (int mi = 0; mi < 2; ++mi) { bf16x8 z = {0, 0, 0, 0, 0, 0, 0, 0}; if (ok) z = *(const bf16x8*)(ap + (size_t)mi * 16 * lda_s + (ks0 + q) * 32); a[q][mi] = z; }
#pragma unroll
                for (int ni = 0; ni < 4; ++ni) { bf16x8 z = {0, 0, 0, 0, 0, 0, 0, 0}; if (ok) z = *(const bf16x8*)(bp + (size_t)ni * 16 * ldb_s + (ks0 + q) * 32); b[q][ni] = z; }
            }
#pragma unroll
            for (int q = 0; q < 4; ++q)
#pragma unroll
                for (int mi = 0; mi < 2; ++mi)
#pragma unroll
                    for (int ni = 0; ni < 4; ++ni) acc[mi][ni] = __builtin_amdgcn_mfma_f32_16x16x32_bf16(b[q][ni], a[q][mi], acc[mi][ni], 0, 0, 0);
        }
        float* red = (float*)shm_g;
#pragma unroll
        for (int mi = 0; mi < 2; ++mi)
#pragma unroll
            for (int ni = 0; ni < 4; ++ni) *(f32x4*)(red + wid * 2048 + (mi * 16 + fr) * 64 + ni * 16 + fq * 4) = acc[mi][ni];
        __syncthreads();
        {
            const int r = tid >> 4, c = (tid & 15) * 4;
            f32x4 v = *(const f32x4*)(red + r * 64 + c);
#pragma unroll
            for (int w = 1; w < 8; ++w) v += *(const f32x4*)(red + w * 2048 + r * 64 + c);
            const int cl = (gp == 1) ? c : (c & 32) + perm32(c & 31);
            float ss = epi_apply_rt(P, ek_s, row0 + r, col0 + cl, v);
            if (cfg.ekind == E_OUT || cfg.ekind == E_MO || cfg.ekind == E_DOWN) {
                ss += __shfl_xor(ss, 1); ss += __shfl_xor(ss, 2); ss += __shfl_xor(ss, 4); ss += __shfl_xor(ss, 8);
                if ((tid & 15) == 0) unsafeAtomicAdd((float*)(P->ws + (cfg.ekind == E_OUT ? W_SS1 : cfg.ekind == E_MO ? W_SS2 : W_SS3)) + row0 + r, ss);
            }
        }
        __syncthreads();
    }
}

struct TrDesc { const float* src; bf16_t* dst; const float* gain; int ld_src, ld_dst, k0, n0s, n0d, perm; };
__device__ __forceinline__ TrDesc tr_decode(PP P, int i) {
    char* ws = P->ws; TrDesc d; d.gain = nullptr; d.perm = 0;
    if (i < 896) { const int kt = i / 56, ntl = i % 56; d.n0d = ntl * 64; d.n0s = d.n0d < 2560 ? d.n0d : d.n0d + 16; d.src = P->w_in; d.ld_src = 3600; d.dst = (bf16_t*)(ws + W_WIN); d.ld_dst = 1024; d.k0 = kt * 64; d.perm = 1; return d; }
    i -= 896;
    if (i < 512) { const int kt = i >> 4, ntl = i & 15; d.ld_src = 1024; d.n0s = d.n0d = ntl * 64;
        d.perm = kt < 16 ? 1 : 0;
        if (kt < 16) { d.src = P->w_out; d.dst = (bf16_t*)(ws + W_WOUT); d.ld_dst = 2048; d.k0 = kt * 64; }
        else { d.src = P->w_out + (size_t)1024 * 1024; d.dst = (bf16_t*)(ws + W_WLO); d.ld_dst = 1024; d.k0 = (kt - 16) * 64; }
        return d; }
    i -= 512;
    if (i < 1024) { const int wsel = i >> 8, r = i & 255, kt = r >> 4, ntl = r & 15;
        d.src = wsel == 0 ? P->w_mq : wsel == 1 ? P->w_mk : wsel == 2 ? P->w_mv : P->w_mo;
        d.dst = (bf16_t*)(ws + (wsel == 0 ? W_WMQ : wsel == 1 ? W_WMK : wsel == 2 ? W_WMV : W_WMO));
        d.gain = wsel == 0 ? P->norm_mem : nullptr; d.ld_src = 1024; d.ld_dst = 1024; d.k0 = kt * 64; d.n0s = d.n0d = ntl * 64; d.perm = (wsel == 0 || wsel == 3) ? 1 : 0; return d; }
    i -= 1024;
    if (i < 1408) { const int kt = i / 88, ntl = i % 88; d.src = P->w_up; d.ld_src = 5632; d.dst = (bf16_t*)(ws + W_WUP); d.ld_dst = 1024; d.gain = P->norm_ffn; d.k0 = kt * 64; d.n0s = d.n0d = ntl * 64; d.perm = 1; return d; }
    i -= 1408;
    { const int kt = i >> 4, ntl = i & 15; d.src = P->w_down; d.ld_src = 1024; d.dst = (bf16_t*)(ws + W_WDOWN); d.ld_dst = 2816; d.k0 = kt * 64; d.n0s = d.n0d = ntl * 64; d.perm = 1; return d; }
}

__device__ __forceinline__ void phase_prep(PP P, char* shm, int blk, int nblk, const int tid) {
    const int wid = tid >> 6, lane = tid & 63;
    float* tiles = (float*)shm;
    float* wdt = (float*)(shm + 69632);
    for (int i = blk * NTHR + tid; i < 3 * TT; i += nblk * NTHR) ((float*)(P->ws + W_SS1))[i] = 0.f;
    for (int i = (blk * NTHR + tid) * 4; i < 4 * 65536; i += nblk * NTHR * 4) {
        const f32x4 wv = *(const f32x4*)(P->w_pool + i), sv = *(const f32x4*)(P->pool_scale + (i >> 16) * 256 + (i & 255));
        u32x2 o; o.x = pk2(wv[0] * sv[0], wv[1] * sv[1]); o.y = pk2(wv[2] * sv[2], wv[3] * sv[3]);
        *(u32x2*)((bf16_t*)(P->ws + W_WPOOL) + i) = o;
    }
    for (int i = tid; i < 1024 * 16; i += NTHR) { const int k = i >> 4, hd = i & 15; wdt[hd * 1024 + k] = P->w_in[(size_t)k * 3600 + 2560 + hd]; }
    __syncthreads();
    char* ws = P->ws;
    constexpr int NGRP = (TT + 2048) / 32;
    for (int it = blk; it < NGRP; it += nblk) {
        const int rbase = it * 32 + wid * 4;
        const bool ismem = rbase >= TT;
        f32x4 xv[4][4];
#pragma unroll
        for (int r = 0; r < 4; ++r) {
            const int row = (ismem ? rbase - TT : rbase) + r;
            const float* xr = ismem ? P->mem_prompt + (size_t)row * 1024 : (row < TP ? P->x_prompt + (size_t)row * 1024 : P->x_sample + (size_t)(row - TP) * 1024);
#pragma unroll
            for (int j = 0; j < 4; ++j) xv[r][j] = __builtin_nontemporal_load((const f32x4*)(xr + j * 256 + lane * 4));
        }
        const float* gg = ismem ? P->norm_memkv : P->norm_mix;
#pragma unroll
        for (int r = 0; r < 4; ++r) {
            const int row = (ismem ? rbase - TT : rbase) + r;
            bf16_t* orow = (bf16_t*)(ws + (ismem ? W_HM : W_H)) + (size_t)row * 1024;
            float ss = 0.f;
#pragma unroll
            for (int j = 0; j < 4; ++j) ss += xv[r][j][0] * xv[r][j][0] + xv[r][j][1] * xv[r][j][1] + xv[r][j][2] * xv[r][j][2] + xv[r][j][3] * xv[r][j][3];
            ss = wave_sum(ss);
            const float rstd = rsqrtf(ss * (1.0f / 1024.0f) + EPS);
#pragma unroll
            for (int j = 0; j < 4; ++j) { const f32x4 g4 = *(const f32x4*)(gg + j * 256 + lane * 4); xv[r][j] = xv[r][j] * rstd * g4;
                u32x2 o; o.x = pk2(xv[r][j][0], xv[r][j][1]); o.y = pk2(xv[r][j][2], xv[r][j][3]); *(u32x2*)(orow + j * 256 + lane * 4) = o; }
        }
        if (!ismem) {
            float vals[64];
#pragma unroll
            for (int hd = 0; hd < 16; ++hd) {
                f32x4 w4[4];
#pragma unroll
                for (int j = 0; j < 4; ++j) w4[j] = *(const f32x4*)(wdt + hd * 1024 + j * 256 + lane * 4);
#pragma unroll
                for (int r = 0; r < 4; ++r) {
                    float a = 0.f;
#pragma unroll
                    for (int j = 0; j < 4; ++j) a += xv[r][j][0] * w4[j][0] + xv[r][j][1] * w4[j][1] + xv[r][j][2] * w4[j][2] + xv[r][j][3] * w4[j][3];
                    vals[r * 16 + hd] = a;
                }
            }
#pragma unroll
            for (int half = 32; half >= 1; half >>= 1) {
                const bool hi = (lane & half) != 0;
#pragma unroll
                for (int i = 0; i < half; ++i) {
                    const float keep = hi ? vals[i + half] : vals[i], send = hi ? vals[i] : vals[i + half];
                    vals[i] = keep + __shfl_xor(send, half);
                }
            }
            const float x = vals[0] + P->dt_bias[lane & 15];
            const float ey = __expf(-fabsf(x)); const float l1p = ey < 0.03f ? ey * (1.0f - ey * (0.5f - ey * (0.33333333f - 0.25f * ey))) : __logf(1.0f + ey);
            ((float*)(ws + W_DT))[(size_t)rbase * 16 + lane] = fmaxf(x, 0.f) + l1p;
        }
    }
    __syncthreads();
    const int kr = tid >> 4, nc = (tid & 15) * 4, tn = tid >> 3, tk8 = (tid & 7) * 8;
    for (int it = blk; it < 4544; it += 4 * nblk) {
        f32x4 v[4][2];
#pragma unroll
        for (int q = 0; q < 4; ++q) {
            const int i = it + q * nblk;
            if (i < 4544) { const TrDesc d = tr_decode(P, i);
#pragma unroll
                for (int h = 0; h < 2; ++h) { const int k = kr + h * 32; f32x4 t = __builtin_nontemporal_load((const f32x4*)(d.src + (size_t)(d.k0 + k) * d.ld_src + d.n0s + nc)); if (d.gain) t *= d.gain[d.k0 + k]; v[q][h] = t; } }
        }
#pragma unroll
        for (int q = 0; q < 4; ++q) {
            if (it + q * nblk < 4544) { float* tile = tiles + q * (64 * 65);
#pragma unroll
                for (int h = 0; h < 2; ++h) { const int k = kr + h * 32; tile[k * 65 + nc + 0] = v[q][h][0]; tile[k * 65 + nc + 1] = v[q][h][1]; tile[k * 65 + nc + 2] = v[q][h][2]; tile[k * 65 + nc + 3] = v[q][h][3]; } }
        }
        __syncthreads();
#pragma unroll
        for (int q = 0; q < 4; ++q) {
            const int i = it + q * nblk;
            if (i < 4544) { const TrDesc d = tr_decode(P, i); const float* tile = tiles + q * (64 * 65); float f[8];
                const int sc = d.perm ? (tn & 32) + perm32(tn & 31) : tn;
#pragma unroll
                for (int e2 = 0; e2 < 8; ++e2) f[e2] = tile[(tk8 + e2) * 65 + sc];
                *(u32x4*)(d.dst + (size_t)(d.n0d + tn) * d.ld_dst + d.k0 + tk8) = pack8(f); }
        }
        __syncthreads();
    }
}

__device__ __forceinline__ u32x4 ld8(const bf16_t* p) { return *(const u32x4*)p; }

__device__ __forceinline__ void phase_convpool(PP P, int gtid, int nthreads) {
    char* ws = P->ws;
    const bf16_t* proj2 = (const bf16_t*)(ws + W_PROJ2);
    bf16_t* xact = (bf16_t*)(ws + W_XACT);
    bf16_t* pooled = (bf16_t*)(ws + W_POOLED);
    for (int idx = gtid; idx < 1152 * 320; idx += nthreads) {
        const int run = idx / 320, cg = idx % 320;
        const bool samp = run >= 1024;
        int t0, len, bidx, tl0;
        if (!samp) { t0 = run * 16; len = 16; bidx = t0 >> 11; tl0 = t0 & 2047; } else { bidx = run - 1024; t0 = TP + bidx * 4; len = 4; tl0 = 0; }
        if (cg < 192) {
            const int c0 = cg * 8;
            float w0[8], w1[8], w2[8], w3[8], bs[8], h0[8], h1[8], h2[8];
#pragma unroll
            for (int e = 0; e < 8; ++e) { w0[e] = P->conv_w[c0 + e]; w1[e] = P->conv_w[1536 + c0 + e]; w2[e] = P->conv_w[3072 + c0 + e]; w3[e] = P->conv_w[4608 + c0 + e]; bs[e] = P->conv_b[c0 + e]; }
            if (samp) {
#pragma unroll
                for (int e = 0; e < 8; ++e) { h0[e] = P->state_conv[(size_t)(bidx * 3 + 0) * 1536 + c0 + e]; h1[e] = P->state_conv[(size_t)(bidx * 3 + 1) * 1536 + c0 + e]; h2[e] = P->state_conv[(size_t)(bidx * 3 + 2) * 1536 + c0 + e]; }
            } else if (tl0 > 0) {
                unpack8(ld8(proj2 + (size_t)(t0 - 3) * 2560 + c0), h0); unpack8(ld8(proj2 + (size_t)(t0 - 2) * 2560 + c0), h1); unpack8(ld8(proj2 + (size_t)(t0 - 1) * 2560 + c0), h2);
            } else {
#pragma unroll
                for (int e = 0; e < 8; ++e) { h0[e] = 0.f; h1[e] = 0.f; h2[e] = 0.f; }
            }
            u32x4 rx[16];
#pragma unroll
            for (int j = 0; j < 16; ++j) { if (j < len) rx[j] = ld8(proj2 + (size_t)(t0 + j) * 2560 + c0); }
#pragma unroll
            for (int j = 0; j < 16; ++j) {
                if (j < len) {
                float x3[8], y[8]; unpack8(rx[j], x3);
#pragma unroll
                for (int e = 0; e < 8; ++e) { const float v = bs[e] + w0[e] * h0[e] + w1[e] * h1[e] + w2[e] * h2[e] + w3[e] * x3[e]; y[e] = silu_f(v); }
                *(u32x4*)(xact + (size_t)(t0 + j) * 1536 + c0) = pack8(y);
                if (samp) { if (j >= 1) { float* o = P->out + O_CONVS + (size_t)(bidx * 3 + j - 1) * 1536 + c0;
#pragma unroll
                        for (int e = 0; e < 8; ++e) o[e] = x3[e]; } }
                else { const int tl = tl0 + j; if (tl >= 2045) { float* o = P->out + O_CONVP + (size_t)(bidx * 3 + tl - 2045) * 1536 + c0;
#pragma unroll
                        for (int e = 0; e < 8; ++e) o[e] = x3[e]; } }
#pragma unroll
                for (int e = 0; e < 8; ++e) { h0[e] = h1[e]; h1[e] = h2[e]; h2[e] = x3[e]; }
                }
            }
        } else {
            const int c0 = (cg - 192) * 8; const int win = 2 << (c0 >> 8);
            const bf16_t* vp = proj2 + 1536 + c0;
            const float* prev = P->state_pool + (size_t)bidx * 15 * 1024 + c0;
            float sum[8];
#pragma unroll
            for (int e = 0; e < 8; ++e) sum[e] = 0.f;
            if (samp) {
                for (int jj = 1; jj < win; ++jj) {
#pragma unroll
                    for (int e = 0; e < 8; ++e) sum[e] += prev[(size_t)(15 - jj) * 1024 + e]; }
                float* o = P->out + O_POOLS + (size_t)bidx * 15 * 1024 + c0;
                for (int i = 0; i < 11; ++i) {
#pragma unroll
                    for (int e = 0; e < 8; ++e) o[(size_t)i * 1024 + e] = prev[(size_t)(i + 4) * 1024 + e]; }
            } else if (tl0 > 0) {
                for (int jj = 1; jj < win; ++jj) { float v[8]; unpack8(ld8(vp + (size_t)(t0 - jj) * 2560), v);
#pragma unroll
                    for (int e = 0; e < 8; ++e) sum[e] += v[e]; }
            }
            u32x4 rp[16];
#pragma unroll
            for (int j = 0; j < 16; ++j) { if (j < len) rp[j] = ld8(vp + (size_t)(t0 + j) * 2560); }
#pragma unroll
            for (int j = 0; j < 16; ++j) {
                if (j >= len) continue;
                float v[8], o8[8]; unpack8(rp[j], v);
                const int tl = tl0 + j;
                const float inv = 1.0f / (float)(samp ? win : (tl + 1 < win ? tl + 1 : win));
#pragma unroll
                for (int e = 0; e < 8; ++e) { sum[e] += v[e]; o8[e] = sum[e] * inv - v[e]; }
                *(u32x4*)((bf16_t*)(ws + W_MIX) + (size_t)(t0 + j) * 2048 + 1024 + c0) = pack8(o8);
                const int to = j - win + 1;
                if (samp) {
                    if (to >= 0) { float q[8]; unpack8(ld8(vp + (size_t)(t0 + to) * 2560), q);
#pragma unroll
                        for (int e = 0; e < 8; ++e) sum[e] -= q[e]; }
                    else {
#pragma unroll
                        for (int e = 0; e < 8; ++e) sum[e] -= prev[(size_t)(15 + to) * 1024 + e]; }
                    float* o = P->out + O_POOLS + (size_t)(bidx * 15 + 11 + j) * 1024 + c0;
#pragma unroll
                    for (int e = 0; e < 8; ++e) o[e] = v[e];
                } else {
                    if (tl0 + to >= 0) { float q[8]; unpack8(ld8(vp + (size_t)(t0 + to) * 2560), q);
#pragma unroll
                        for (int e = 0; e < 8; ++e) sum[e] -= q[e]; }
                    if (tl >= 2033) { float* o = P->out + O_POOLP + (size_t)(bidx * 15 + tl - 2033) * 1024 + c0;
#pragma unroll
                        for (int e = 0; e < 8; ++e) o[e] = v[e]; }
                }
            }
        }
    }
}

constexpr int CS_STR = 136;
constexpr int X_STR = 40;
__device__ __forceinline__ s16x4 tr_read(const bf16_t* p) { return __builtin_bit_cast(s16x4, __builtin_amdgcn_ds_read_tr16_b64_v4i16((LDSB s16x4*)p)); }

#define LDS_BARRIER() asm volatile("s_waitcnt lgkmcnt(0)\n\ts_barrier" ::: "memory")
__device__ __forceinline__ void ssd_prompt(PP P, int item, char* shm, const int tid) {
    const int w = tid >> 6, lane = tid & 63, fr = lane & 15, fq = lane >> 4;
    const int b = item >> 5, hd = (item >> 1) & 15, ph = item & 1, g = hd >> 3;
    const float a = -expf(P->a_log[hd]);
    const float Dh = P->ssm_d[hd];
    char* ws = P->ws;
    const bf16_t* xact = (const bf16_t*)(ws + W_XACT);
    const float* dtb = (const float*)(ws + W_DT);
    bf16_t* ybuf = (bf16_t*)(ws + W_Y);
    bf16_t* Cs = (bf16_t*)(shm);
    bf16_t* Bs = (bf16_t*)(shm + 34816);
    bf16_t* Xd = (bf16_t*)(shm + 69632);
    bf16_t* X2 = (bf16_t*)(shm + 69632 + 10240);
    bf16_t* Ht = (bf16_t*)(shm + 69632 + 20480);
    float* acs = (float*)(shm + 69632 + 30720);
    float* dts = (float*)(shm + 69632 + 31232);
    f32x4 Hacc[2];
    Hacc[0] = (f32x4){0.f, 0.f, 0.f, 0.f}; Hacc[1] = (f32x4){0.f, 0.f, 0.f, 0.f};
    const int q4 = fr >> 2, p4 = fr & 3;
    u32x4 pc[4], pb[4], px; float pd0, pd1;
    const int ls = tid >> 4, ln8 = (tid & 15) * 8;
    const int xs = tid >> 2, xp8 = (tid & 3) * 8;
#define SSD_PREFETCH(cc) do { const int _t0 = b * 2048 + (cc) * 128; \
        _Pragma("unroll") for (int i = 0; i < 4; ++i) { const bf16_t* src = xact + (size_t)(_t0 + ls + i * 32) * 1536 + g * 128 + ln8; pc[i] = *(const u32x4*)(src + 1280); pb[i] = *(const u32x4*)(src + 1024); } \
        px = *(const u32x4*)(xact + (size_t)(_t0 + xs) * 1536 + hd * 64 + ph * 32 + xp8); \
        pd0 = dtb[(size_t)(_t0 + 2 * lane) * 16 + hd]; pd1 = dtb[(size_t)(_t0 + 2 * lane + 1) * 16 + hd]; } while (0)
    SSD_PREFETCH(0);
    for (int c = 0; c < 16; ++c) {
        const int t0 = b * 2048 + c * 128;
        if (w == 0) {
            const float d0 = pd0, d1 = pd1;
            const float s = (d0 + d1) * a; float v = s;
#pragma unroll
            for (int off = 1; off < 64; off <<= 1) { const float t = __shfl_up(v, off); if (lane >= off) v += t; }
            const float excl = v - s;
            acs[2 * lane] = excl + d0 * a; acs[2 * lane + 1] = v; dts[2 * lane] = d0; dts[2 * lane + 1] = d1;
        }
#pragma unroll
        for (int pt = 0; pt < 2; ++pt) { u32x2 o; o.x = pk2(Hacc[pt][0], Hacc[pt][1]); o.y = pk2(Hacc[pt][2], Hacc[pt][3]); *(u32x2*)(Ht + (w * 16 + fr) * X_STR + pt * 16 + fq * 4) = o; }
#pragma unroll
        for (int i = 0; i < 4; ++i) { *(u32x4*)(Cs + (ls + i * 32) * CS_STR + ln8) = pc[i]; *(u32x4*)(Bs + (ls + i * 32) * CS_STR + ln8) = pb[i]; }
        LDS_BARRIER();
        {
            float x[8], xa[8], xb[8]; unpack8(px, x);
            const float dtv = dts[xs], dec = __expf(acs[127] - acs[xs]) * dtv;
#pragma unroll
            for (int e = 0; e < 8; ++e) { xa[e] = x[e] * dtv; xb[e] = x[e] * dec; }
            *(u32x4*)(Xd + xs * X_STR + xp8) = pack8(xa);
            *(u32x4*)(X2 + xs * X_STR + xp8) = pack8(xb);
        }
        if (c < 15) SSD_PREFETCH(c + 1);
        bf16x8 Cf[4];
#pragma unroll
        for (int kk = 0; kk < 4; ++kk) Cf[kk] = *(const bf16x8*)(Cs + (w * 16 + fr) * CS_STR + kk * 32 + fq * 8);
        const int lrow = w * 16 + fr; const float al = acs[lrow];
        bf16x8 Gf[4];
#pragma unroll
        for (int kk = 0; kk < 4; ++kk) {
            u32x2 half[2];
#pragma unroll
            for (int hh = 0; hh < 2; ++hh) {
                const int st = 2 * kk + hh;
                half[hh].x = 0u; half[hh].y = 0u;
                if (st <= w) {
                    f32x4 ga = (f32x4){0.f, 0.f, 0.f, 0.f};
#pragma unroll
                    for (int k2 = 0; k2 < 4; ++k2) { const bf16x8 Bf = *(const bf16x8*)(Bs + (st * 16 + fr) * CS_STR + k2 * 32 + fq * 8); ga = __builtin_amdgcn_mfma_f32_16x16x32_bf16(Bf, Cf[k2], ga, 0, 0, 0); }
                    const int s0 = st * 16 + fq * 4; const f32x4 as4 = *(const f32x4*)(acs + s0);
                    float gv[4];
#pragma unroll
                    for (int j = 0; j < 4; ++j) gv[j] = (s0 + j <= lrow) ? ga[j] * __expf(al - as4[j]) : 0.f;
                    half[hh].x = pk2(gv[0], gv[1]); half[hh].y = pk2(gv[2], gv[3]);
                }
            }
            u32x4 g4; g4.x = half[0].x; g4.y = half[0].y; g4.z = half[1].x; g4.w = half[1].y;
            Gf[kk] = __builtin_bit_cast(bf16x8, g4);
        }
        LDS_BARRIER();
        {
            f32x4 Yd[2], Yo[2];
            Yd[0] = Yd[1] = Yo[0] = Yo[1] = (f32x4){0.f, 0.f, 0.f, 0.f};
            const int nkk = (w >> 1) + 1;
#pragma unroll
            for (int kk = 0; kk < 4; ++kk) {
                if (kk < nkk) {
#pragma unroll
                    for (int pt = 0; pt < 2; ++pt) {
                        const bf16_t* base = Xd + (kk * 32 + fq * 4 + q4) * X_STR + pt * 16 + p4 * 4;
                        bf16x8 Xf; Xf.lo = tr_read(base); Xf.hi = tr_read(base + 16 * X_STR);
                        Yd[pt] = __builtin_amdgcn_mfma_f32_16x16x32_bf16(Xf, Gf[kk], Yd[pt], 0, 0, 0);
                    }
                }
            }
#pragma unroll
            for (int kk = 0; kk < 4; ++kk)
#pragma unroll
                for (int pt = 0; pt < 2; ++pt) {
                    const bf16_t* hbp = Ht + (kk * 32 + fq * 8 + q4) * X_STR + pt * 16 + p4 * 4;
                    bf16x8 Hf; Hf.lo = tr_read(hbp); Hf.hi = tr_read(hbp + 4 * X_STR);
                    Yo[pt] = __builtin_amdgcn_mfma_f32_16x16x32_bf16(Hf, Cf[kk], Yo[pt], 0, 0, 0);
                }
            const float el = __expf(al); const float rdt = Dh / dts[lrow];
#pragma unroll
            for (int pt = 0; pt < 2; ++pt) {
                const u32x2 xr = *(const u32x2*)(Xd + lrow * X_STR + pt * 16 + fq * 4);
                const f32x4 y = Yd[pt] + el * Yo[pt] + rdt * (f32x4){bflo(xr.x), bfhi(xr.x), bflo(xr.y), bfhi(xr.y)};
                u32x2 o; o.x = pk2(y[0], y[1]); o.y = pk2(y[2], y[3]);
                *(u32x2*)(ybuf + (size_t)(t0 + lrow) * 1024 + hd * 64 + ph * 32 + pt * 16 + fq * 4) = o;
            }
        }
        {
            const float dc = __expf(acs[127]);
            Hacc[0] *= dc; Hacc[1] *= dc;
#pragma unroll
            for (int kk = 0; kk < 4; ++kk) {
                const bf16_t* bb = Bs + (kk * 32 + fq * 8 + q4) * CS_STR + w * 16 + p4 * 4;
                bf16x8 Bf; Bf.lo = tr_read(bb); Bf.hi = tr_read(bb + 4 * CS_STR);
#pragma unroll
                for (int pt = 0; pt < 2; ++pt) {
                    const bf16_t* xb = X2 + (kk * 32 + fq * 8 + q4) * X_STR + pt * 16 + p4 * 4;
                    bf16x8 Xf; Xf.lo = tr_read(xb); Xf.hi = tr_read(xb + 4 * X_STR);
                    Hacc[pt] = __builtin_amdgcn_mfma_f32_16x16x32_bf16(Xf, Bf, Hacc[pt], 0, 0, 0);
                }
            }
        }
        LDS_BARRIER();
    }
#undef SSD_PREFETCH
    float* so = P->out + O_SSMP + ((size_t)(b * 16 + hd) * 64 + ph * 32) * 128;
#pragma unroll
    for (int pt = 0; pt < 2; ++pt)
#pragma unroll
        for (int j = 0; j < 4; ++j) so[(size_t)(pt * 16 + fq * 4 + j) * 128 + w * 16 + fr] = Hacc[pt][j];
}

template <int NI>
__device__ __forceinline__ void ssd_sample(PP P, int item0, int istride, const int tid) {
    const int p = tid >> 3, n0 = (tid & 7) * 16;
    char* ws = P->ws;
    const bf16_t* xact = (const bf16_t*)(ws + W_XACT);
    const float* dtb = (const float*)(ws + W_DT);
    bf16_t* ybuf = (bf16_t*)(ws + W_Y);
    f32x4 hs[NI][4]; u32x4 rb[NI][4][2], rc[NI][4][2]; float xv[NI][4], dtv[NI][4];
#pragma unroll
    for (int q = 0; q < NI; ++q) {
        const int item = item0 + q * istride, b = item >> 4, hd = item & 15, g = hd >> 3;
        const size_t sidx = ((size_t)(b * 16 + hd) * 64 + p) * 128 + n0;
#pragma unroll
        for (int i = 0; i < 4; ++i) hs[q][i] = __builtin_nontemporal_load((const f32x4*)(P->state_ssm + sidx + i * 4));
#pragma unroll
        for (int i = 0; i < 4; ++i) {
            const int t = TP + b * 4 + i;
            xv[q][i] = bf2f(xact[(size_t)t * 1536 + hd * 64 + p]);
            dtv[q][i] = dtb[(size_t)t * 16 + hd];
            rb[q][i][0] = ld8(xact + (size_t)t * 1536 + 1024 + g * 128 + n0); rb[q][i][1] = ld8(xact + (size_t)t * 1536 + 1024 + g * 128 + n0 + 8);
            rc[q][i][0] = ld8(xact + (size_t)t * 1536 + 1280 + g * 128 + n0); rc[q][i][1] = ld8(xact + (size_t)t * 1536 + 1280 + g * 128 + n0 + 8);
        }
    }
#pragma unroll
    for (int q = 0; q < NI; ++q) {
        const int item = item0 + q * istride, b = item >> 4, hd = item & 15;
        const float a = -expf(P->a_log[hd]);
        const float Dh = P->ssm_d[hd];
        const size_t sidx = ((size_t)(b * 16 + hd) * 64 + p) * 128 + n0;
        float h[16];
#pragma unroll
        for (int i = 0; i < 4; ++i) { h[i * 4] = hs[q][i][0]; h[i * 4 + 1] = hs[q][i][1]; h[i * 4 + 2] = hs[q][i][2]; h[i * 4 + 3] = hs[q][i][3]; }
#pragma unroll
        for (int i = 0; i < 4; ++i) {
            const int t = TP + b * 4 + i;
            const float dA = __expf(dtv[q][i] * a), dx = dtv[q][i] * xv[q][i];
            float Bv[16], Cv[16];
            { float t8[8]; unpack8(rb[q][i][0], t8);
#pragma unroll
              for (int e = 0; e < 8; ++e) Bv[e] = t8[e];
              unpack8(rb[q][i][1], t8);
#pragma unroll
              for (int e = 0; e < 8; ++e) Bv[8 + e] = t8[e];
              unpack8(rc[q][i][0], t8);
#pragma unroll
              for (int e = 0; e < 8; ++e) Cv[e] = t8[e];
              unpack8(rc[q][i][1], t8);
#pragma unroll
              for (int e = 0; e < 8; ++e) Cv[8 + e] = t8[e]; }
            float part = 0.f;
#pragma unroll
            for (int e = 0; e < 16; ++e) { h[e] = h[e] * dA + dx * Bv[e]; part += h[e] * Cv[e]; }
            part += __shfl_xor(part, 1); part += __shfl_xor(part, 2); part += __shfl_xor(part, 4);
            if ((tid & 7) == 0) ybuf[(size_t)t * 1024 + hd * 64 + p] = f2bf(part + Dh * xv[q][i]);
        }
        float* so = P->out + O_SSMS + sidx;
#pragma unroll
        for (int i = 0; i < 4; ++i) __builtin_nontemporal_store((f32x4){h[i * 4], h[i * 4 + 1], h[i * 4 + 2], h[i * 4 + 3]}, (f32x4*)(so + i * 4));
    }
}

__device__ __forceinline__ void phase_gatednorm(PP P, int gw, int nw, const int tid) {
    const int lane = tid & 63;
    char* ws = P->ws;
    const bf16_t* ybuf = (const bf16_t*)(ws + W_Y); const bf16_t* zbuf = (const bf16_t*)(ws + W_Z);
    bf16_t* mix = (bf16_t*)(ws + W_MIX);
    for (int row0 = gw; row0 < TT; row0 += 4 * nw) {
        u32x2 yv[4][4], zv[4][4];
#pragma unroll
        for (int r = 0; r < 4; ++r) { const int row = row0 + r * nw; if (row < TT) {
#pragma unroll
            for (int j = 0; j < 4; ++j) { yv[r][j] = *(const u32x2*)(ybuf + (size_t)row * 1024 + j * 256 + lane * 4); zv[r][j] = *(const u32x2*)(zbuf + (size_t)row * 1024 + j * 256 + lane * 4); } } }
#pragma unroll
        for (int r = 0; r < 4; ++r) { const int row = row0 + r * nw; if (row < TT) {
            float t[4][4]; float ss0 = 0.f, ss1 = 0.f;
#pragma unroll
            for (int j = 0; j < 4; ++j) {
                const float y0 = bflo(yv[r][j].x), y1 = bfhi(yv[r][j].x), y2 = bflo(yv[r][j].y), y3 = bfhi(yv[r][j].y);
                const float z0 = bflo(zv[r][j].x), z1 = bfhi(zv[r][j].x), z2 = bflo(zv[r][j].y), z3 = bfhi(zv[r][j].y);
                t[j][0] = y0 * silu_f(z0); t[j][1] = y1 * silu_f(z1); t[j][2] = y2 * silu_f(z2); t[j][3] = y3 * silu_f(z3);
                const float q = t[j][0] * t[j][0] + t[j][1] * t[j][1] + t[j][2] * t[j][2] + t[j][3] * t[j][3];
                if (j < 2) ss0 += q; else ss1 += q;
            }
            ss0 = wave_sum(ss0); ss1 = wave_sum(ss1);
            const float r0 = rsqrtf(ss0 * (1.0f / 512.0f) + EPS), r1 = rsqrtf(ss1 * (1.0f / 512.0f) + EPS);
#pragma unroll
            for (int j = 0; j < 4; ++j) {
                const float rr = j < 2 ? r0 : r1;
                const f32x4 g4 = *(const f32x4*)(P->ssm_norm + j * 256 + lane * 4);
                u32x2 o; o.x = pk2(t[j][0] * rr * g4[0], t[j][1] * rr * g4[1]); o.y = pk2(t[j][2] * rr * g4[2], t[j][3] * rr * g4[3]);
                *(u32x2*)(mix + (size_t)row * 2048 + j * 256 + lane * 4) = o;
            }
        } }
    }
}

__device__ __forceinline__ void phase_norm(PP P, const float* gain, bool final_out, int gw, int nw, const int tid) {
    const int lane = tid & 63;
    char* ws = P->ws;
    const bf16_t* hb = (const bf16_t*)(ws + W_H);
    const float* ss3 = (const float*)(ws + W_SS3);
    for (int row0 = gw; row0 < TT; row0 += 4 * nw) {
        u32x2 xv[4][4]; float sq[4];
#pragma unroll
        for (int r = 0; r < 4; ++r) { const int row = row0 + r * nw; if (row < TT) { sq[r] = ss3[row];
#pragma unroll
            for (int j = 0; j < 4; ++j) xv[r][j] = *(const u32x2*)(hb + (size_t)row * 1024 + j * 256 + lane * 4); } }
#pragma unroll
        for (int r = 0; r < 4; ++r) { const int row = row0 + r * nw; if (row < TT) {
            const float rstd = rsqrtf(sq[r] * (1.0f / 1024.0f) + EPS);
#pragma unroll
            for (int j = 0; j < 4; ++j) {
                const f32x4 g4 = *(const f32x4*)(gain + j * 256 + lane * 4);
                const f32x4 x = (f32x4){bflo(xv[r][j].x), bfhi(xv[r][j].x), bflo(xv[r][j].y), bfhi(xv[r][j].y)};
                __builtin_nontemporal_store(x * rstd * g4, (f32x4*)(P->out + O_YP + (size_t)row * 1024 + j * 256 + lane * 4));
            }
        } }
    }
}

__device__ __forceinline__ void attn_sample(PP P, int item, char* shm, const int tid) {
    const int w = tid >> 6, lane = tid & 63, fr = lane & 15, fq = lane >> 4;
    const int b = item >> 2, hh = item & 3;
    char* ws = P->ws;
    const bf16_t* qb = (const bf16_t*)(ws + W_Q);
    float* sc = (float*)shm;
    float* part = (float*)(shm + 4096);
    const float* vp = P->cache_v + ((size_t)(b * 256 + w * 32) * 4 + hh) * 256 + lane * 4;
    f32x4 v0[16], v1[16];
#pragma unroll
    for (int mm = 0; mm < 16; ++mm) v0[mm] = __builtin_nontemporal_load((const f32x4*)(vp + (size_t)mm * 1024));
    bf16x8 qf[8];
#pragma unroll
    for (int kk = 0; kk < 8; ++kk) {
        bf16x8 z = {0, 0, 0, 0, 0, 0, 0, 0};
        if (fr < 4) z = *(const bf16x8*)(qb + (size_t)(TP + b * 4 + fr) * 1024 + hh * 256 + kk * 32 + fq * 8);
        qf[kk] = z;
    }
#pragma unroll
    for (int mt = 0; mt < 2; ++mt) {
        const int key = w * 32 + mt * 16 + fr;
        const float* kp = P->cache_k + ((size_t)(b * 256 + key) * 4 + hh) * 256 + fq * 8;
        f32x4 k0[8], k1[8];
#pragma unroll
        for (int kk = 0; kk < 8; ++kk) { k0[kk] = __builtin_nontemporal_load((const f32x4*)(kp + kk * 32)); k1[kk] = __builtin_nontemporal_load((const f32x4*)(kp + kk * 32 + 4)); }
        f32x4 acc = (f32x4){0.f, 0.f, 0.f, 0.f};
#pragma unroll
        for (int kk = 0; kk < 8; ++kk) {
            u32x4 pk; pk.x = pk2(k0[kk][0], k0[kk][1]); pk.y = pk2(k0[kk][2], k0[kk][3]); pk.z = pk2(k1[kk][0], k1[kk][1]); pk.w = pk2(k1[kk][2], k1[kk][3]);
            acc = __builtin_amdgcn_mfma_f32_16x16x32_bf16(qf[kk], __builtin_bit_cast(bf16x8, pk), acc, 0, 0, 0);
        }
        if (fq == 0) {
#pragma unroll
            for (int j = 0; j < 4; ++j) sc[j * 256 + w * 32 + mt * 16 + fr] = acc[j];
        }
    }
    LDS_BARRIER();
#pragma unroll
    for (int mm = 0; mm < 16; ++mm) v1[mm] = __builtin_nontemporal_load((const f32x4*)(vp + (size_t)(16 + mm) * 1024));
    if (w < 4) {
        f32x4 s = *(const f32x4*)(sc + w * 256 + lane * 4);
        float m = fmaxf(fmaxf(s[0], s[1]), fmaxf(s[2], s[3])); m = wave_max(m);
        s[0] = __expf(s[0] - m); s[1] = __expf(s[1] - m); s[2] = __expf(s[2] - m); s[3] = __expf(s[3] - m);
        float su = (s[0] + s[1]) + (s[2] + s[3]); su = wave_sum(su);
        const float inv = 1.0f / su;
        *(f32x4*)(sc + w * 256 + lane * 4) = s * inv;
    }
    LDS_BARRIER();
    {
        f32x4 o[4];
#pragma unroll
        for (int i = 0; i < 4; ++i) o[i] = (f32x4){0.f, 0.f, 0.f, 0.f};
#pragma unroll
        for (int mm = 0; mm < 16; ++mm) {
#pragma unroll
            for (int i = 0; i < 4; ++i) o[i] += sc[i * 256 + w * 32 + mm] * v0[mm];
        }
#pragma unroll
        for (int mm = 0; mm < 16; ++mm) {
#pragma unroll
            for (int i = 0; i < 4; ++i) o[i] += sc[i * 256 + w * 32 + 16 + mm] * v1[mm];
        }
#pragma unroll
        for (int i = 0; i < 4; ++i) *(f32x4*)(part + (w * 4 + i) * 256 + lane * 4) = o[i];
    }
    LDS_BARRIER();
    {
        const int i = tid >> 7, d2 = (tid & 127) * 2;
        float s0 = 0.f, s1 = 0.f;
#pragma unroll
        for (int ww = 0; ww < 8; ++ww) { s0 += part[(ww * 4 + i) * 256 + d2]; s1 += part[(ww * 4 + i) * 256 + d2 + 1]; }
        *(unsigned*)((bf16_t*)(ws + W_O) + (size_t)(TP + b * 4 + i) * 1024 + hh * 256 + d2) = pk2(s0, s1);
    }
    LDS_BARRIER();
}

__device__ __forceinline__ void phase_ffnconv(PP P, int gtid, int nthreads) {
    char* ws = P->ws;
    const bf16_t* u = (const bf16_t*)(ws + W_U);
    bf16_t* act = (bf16_t*)(ws + W_ACT);
    for (int idx = gtid; idx < 1152 * 352; idx += nthreads) {
        const int run = idx / 352, cg = idx % 352;
        const bool samp = run >= 1024;
        int t0, len, bidx, tl0;
        if (!samp) { t0 = run * 16; len = 16; bidx = t0 >> 11; tl0 = t0 & 2047; } else { bidx = run - 1024; t0 = TP + bidx * 4; len = 4; tl0 = 0; }
        const int cgc = cg * 8, cvc = 2816 + cg * 8;
        float wg0[8], wg1[8], wg2[8], wv0[8], wv1[8], wv2[8], bg[8], bv[8], hg0[8], hg1[8], hv0[8], hv1[8];
#pragma unroll
        for (int e = 0; e < 8; ++e) {
            wg0[e] = P->ffn_w[cgc + e]; wg1[e] = P->ffn_w[5632 + cgc + e]; wg2[e] = P->ffn_w[11264 + cgc + e];
            wv0[e] = P->ffn_w[cvc + e]; wv1[e] = P->ffn_w[5632 + cvc + e]; wv2[e] = P->ffn_w[11264 + cvc + e];
            bg[e] = P->ffn_b[cgc + e]; bv[e] = P->ffn_b[cvc + e];
        }
        if (samp) {
#pragma unroll
            for (int e = 0; e < 8; ++e) {
                hg0[e] = P->state_ffn[(size_t)(bidx * 2 + 0) * 5632 + cgc + e]; hg1[e] = P->state_ffn[(size_t)(bidx * 2 + 1) * 5632 + cgc + e];
                hv0[e] = P->state_ffn[(size_t)(bidx * 2 + 0) * 5632 + cvc + e]; hv1[e] = P->state_ffn[(size_t)(bidx * 2 + 1) * 5632 + cvc + e];
            }
        } else if (tl0 > 0) {
            unpack8(ld8(u + (size_t)(t0 - 2) * 5632 + cgc), hg0); unpack8(ld8(u + (size_t)(t0 - 1) * 5632 + cgc), hg1);
            unpack8(ld8(u + (size_t)(t0 - 2) * 5632 + cvc), hv0); unpack8(ld8(u + (size_t)(t0 - 1) * 5632 + cvc), hv1);
        } else {
#pragma unroll
            for (int e = 0; e < 8; ++e) { hg0[e] = 0.f; hg1[e] = 0.f; hv0[e] = 0.f; hv1[e] = 0.f; }
        }
        for (int jb = 0; jb < len; jb += 8) {
        u32x4 rg[8], rv[8];
        const bf16_t* ub = u + (size_t)(t0 + jb) * 5632 + cgc;
#pragma unroll
        for (int jj = 0; jj < 8; ++jj) { if (jb + jj < len) { rg[jj] = ld8(ub + (size_t)jj * 5632); rv[jj] = ld8(ub + (size_t)jj * 5632 + 2816); } }
#pragma unroll
        for (int jj = 0; jj < 8; ++jj) {
            const int j = jb + jj;
            if (j < len) {
            float ug[8], uv[8], o8[8];
            unpack8(rg[jj], ug); unpack8(rv[jj], uv);
#pragma unroll
            for (int e = 0; e < 8; ++e) {
                const float gc = bg[e] + wg0[e] * hg0[e] + wg1[e] * hg1[e] + wg2[e] * ug[e];
                const float vc = bv[e] + wv0[e] * hv0[e] + wv1[e] * hv1[e] + wv2[e] * uv[e];
                o8[e] = silu_f(gc) * vc;
            }
            *(u32x4*)(act + (size_t)(t0 + j) * 2816 + cgc) = pack8(o8);
            float* o = nullptr;
            if (samp) { if (j >= 2) o = P->out + O_FFNS + (size_t)(bidx * 2 + j - 2) * 5632; }
            else { const int tl = tl0 + j; if (tl >= 2046) o = P->out + O_FFNP + (size_t)(bidx * 2 + tl - 2046) * 5632; }
            if (o) {
#pragma unroll
                for (int e = 0; e < 8; ++e) { o[cgc + e] = ug[e]; o[cvc + e] = uv[e]; }
            }
#pragma unroll
            for (int e = 0; e < 8; ++e) { hg0[e] = hg1[e]; hg1[e] = ug[e]; hv0[e] = hv1[e]; hv1[e] = uv[e]; }
            }
        }
        }
    }
}

#define XB_TMO      128
#define XB_XCNT(j)  (256  + 64 * (j))
#define XB_XSUB(j)  (1280 + 64 * (j))
#define XB_XGEN(j)  (2304 + 64 * (j))
#define XB_TOP      3328
#define XB_TOPGEN   3392
#define XCD_BAR_WORDS 3456
#define XB_SPIN_CAP (1u << 20)
__device__ __forceinline__ unsigned xb_ld(unsigned* p)              { return __hip_atomic_load(p, __ATOMIC_RELAXED, __HIP_MEMORY_SCOPE_AGENT); }
__device__ __forceinline__ unsigned xb_add(unsigned* p, unsigned v) { return __hip_atomic_fetch_add(p, v, __ATOMIC_RELAXED, __HIP_MEMORY_SCOPE_AGENT); }
__device__ __forceinline__ unsigned xb_xcc_id() { return (unsigned)__builtin_amdgcn_s_getreg((3 << 11) | 20) & 0xFu; }
#define XB_SPIN(cond, bar) do { unsigned _sp = 0; while (cond) { \
    if ((++_sp & 255u) == 0u) { if (xb_ld(&(bar)[XB_TMO])) break; if (_sp > XB_SPIN_CAP) { atomicAdd(&(bar)[XB_TMO], 1u); break; } } } } while (0)
__device__ __forceinline__ void xcd_barrier_complete(unsigned* bar, unsigned x, unsigned& nloc, unsigned& nx) {
    const unsigned G = gridDim.x;
    unsigned sum, cnt, mine, sp = 0u;
    for (;;) {
        sum = 0u; cnt = 0u; mine = 0u;
#pragma unroll
        for (unsigned j = 0; j < 16; ++j) { const unsigned c = xb_ld(&bar[XB_XCNT(j)]); sum += c; cnt += (c > 0u) ? 1u : 0u; mine = (j == x) ? c : mine; }
        if (sum == G) break;
        __builtin_amdgcn_s_sleep(1);
        if ((++sp & 255u) == 0u) { if (xb_ld(&bar[XB_TMO])) break; if (sp > XB_SPIN_CAP) { atomicAdd(&bar[XB_TMO], 1u); break; } }
    }
    nloc = mine > 0u ? mine : 1u; nx = cnt > 0u ? cnt : 1u;
}
__device__ __forceinline__ void xcd_barrier(unsigned* bar, volatile LDSB unsigned* st, const int tid) {
    asm volatile("s_waitcnt vmcnt(0)" ::: "memory");
    __syncthreads();
    if (tid == 0) {
        const unsigned x = xb_xcc_id();
        __builtin_amdgcn_s_waitcnt(0);
        unsigned nloc = st[0], nx = st[1];
        if (nloc == 0u) { xcd_barrier_complete(bar, x, nloc, nx); st[0] = nloc; st[1] = nx; }
        const unsigned old = xb_add(&bar[XB_XSUB(x)], 1u);
        const unsigned gen = old / nloc;
        if (old + 1u == (gen + 1u) * nloc) {
            __builtin_amdgcn_fence(__ATOMIC_RELEASE, "agent");
            asm volatile("s_waitcnt vmcnt(0)" ::: "memory");
            const unsigned og = xb_add(&bar[XB_TOP], 1u);
            const unsigned tg = og / nx;
            if (og + 1u == (tg + 1u) * nx) xb_add(&bar[XB_TOPGEN], 1u);
            else XB_SPIN(xb_ld(&bar[XB_TOPGEN]) == tg, bar);
            __builtin_amdgcn_fence(__ATOMIC_ACQUIRE, "agent");
            xb_add(&bar[XB_XGEN(x)], 1u);
            asm volatile("s_waitcnt vmcnt(0)" ::: "memory");
        } else {
            XB_SPIN(xb_ld(&bar[XB_XGEN(x)]) == gen, bar);
            __builtin_amdgcn_fence(__ATOMIC_ACQUIRE, "agent");
            asm volatile("s_waitcnt vmcnt(0)" ::: "memory");
        }
    }
    __syncthreads();
}

extern __shared__ __attribute__((aligned(16))) char smem[];

__global__ void __launch_bounds__(NTHR) hybrid_fwd(Params Pin) {
    char* shm = smem;
    volatile LDSB unsigned* bst = (volatile LDSB unsigned*)(smem + 139264);
    if (threadIdx.x == 0) { bst[0] = 0u; bst[1] = 0u; (void)xb_add((unsigned*)(Pin.ws + W_BAR) + XB_XCNT(xb_xcc_id()), 1u); }
    __syncthreads();
    for (int ph = Pin.ph_lo; ph < Pin.ph_hi; ++ph) {
        if (ph == 6 || ph == 11) continue;
        const int reps = ((REPEAT_MASK >> ph) & 1) ? 2 : 1;
        for (int rep = 0; rep < reps; ++rep) {
        if (rep > 0) xcd_barrier((unsigned*)(Pin.ws + W_BAR), bst, threadIdx.x);
        int tid = threadIdx.x, blk = blockIdx.x, nblk = gridDim.x;
        asm volatile("" : "+v"(tid));
        asm volatile("" : "+s"(blk), "+s"(nblk));
        PP P = (PP)__builtin_amdgcn_kernarg_segment_ptr();
        asm volatile("" : "+s"(P));
        const int lb = (blk & 7) * (nblk >> 3) + (blk >> 3);
        const int gtid = blk * NTHR + tid, nthreads = nblk * NTHR;
        const int gw = blk * 8 + (tid >> 6), nw = nblk * 8;
        switch (ph) {
#if PHASE_MASK & 1
        case 0: phase_prep(P, shm, blk, nblk, tid); break;
#endif
#if PHASE_MASK & 4
        case 2: phase_convpool(P, gtid, nthreads); break;
#endif
#if PHASE_MASK & 8
        case 3:
            if (blk & 1) { int it = blk; for (; it + nblk < 2048; it += 2 * nblk) ssd_sample<2>(P, it, nblk, tid); for (; it < 2048; it += nblk) ssd_sample<1>(P, it, nblk, tid); }
            for (int it = blk; it < 256; it += nblk) ssd_prompt(P, it, shm, tid);
            if (!(blk & 1)) { int it = blk; for (; it + nblk < 2048; it += 2 * nblk) ssd_sample<2>(P, it, nblk, tid); for (; it < 2048; it += nblk) ssd_sample<1>(P, it, nblk, tid); }
            break;
#endif
#if PHASE_MASK & 16
        case 4: phase_gatednorm(P, gw, nw, tid); break;
#endif
#if PHASE_MASK & 64
        case 6: phase_norm(P, P->norm_mem, false, gw, nw, tid); break;
        case 11: phase_norm(P, P->norm_ffn, false, gw, nw, tid); break;
        case 15: phase_norm(P, P->final_norm, true, gw, nw, tid); break;
#endif
#if PHASE_MASK & 8192
        case 13: phase_ffnconv(P, gtid, nthreads); break;
#endif
        default: break;
        }
#if PHASE_MASK & 256
        if (ph == 8 && (blk & 1)) { for (int it = blk; it < 512; it += nblk) attn_sample(P, it, shm, tid); __syncthreads(); }
#endif
#if PHASE_MASK & 2
        if (ph == 1 || ph == 5 || ph == 7 || ph == 8 || ph == 9 || ph == 10 || ph == 12 || ph == 14) gemm_phase(P, ph, shm, lb, blk, nblk, tid);
#endif
#if PHASE_MASK & 256
        if (ph == 9 && !(blk & 1)) { for (int it = blk; it < 512; it += nblk) attn_sample(P, it, shm, tid); }
#endif
        }
        if (ph + 1 < Pin.ph_hi && ph != 8) xcd_barrier((unsigned*)(Pin.ws + W_BAR), bst, threadIdx.x);
        if (ph == 8) { asm volatile("s_waitcnt vmcnt(0)" ::: "memory"); __syncthreads(); }
        if (EXTRA_SYNCS && ph == 0) { for (int i = 0; i < EXTRA_SYNCS; ++i) xcd_barrier((unsigned*)(Pin.ws + W_BAR), bst, threadIdx.x); }
    }
}

extern "C" void kernel_launch(void* const* d_in, const int* in_sizes, int n_in, void* d_out, int out_size, void* d_ws, size_t ws_size, hipStream_t stream) {
    static int grid_blocks = 0;
    if (!grid_blocks) {
        int dev = 0, cus = 0, per_cu = 0;
        hipGetDevice(&dev);
        hipDeviceGetAttribute(&cus, hipDeviceAttributeMultiprocessorCount, dev);
        hipFuncSetAttribute((const void*)hybrid_fwd, hipFuncAttributeMaxDynamicSharedMemorySize, LDS_BYTES);
        hipOccupancyMaxActiveBlocksPerMultiprocessor(&per_cu, hybrid_fwd, NTHR, LDS_BYTES);
        if (per_cu < 1) per_cu = 1;
        grid_blocks = cus * 1;
        grid_blocks &= ~7;
        if (grid_blocks < 8) grid_blocks = 8;
    }
    Params p{};
    const float* const* in = (const float* const*)d_in;
    p.x_prompt = in[0]; p.x_sample = in[1]; p.mem_prompt = in[2]; p.state_ssm = in[3]; p.state_conv = in[4]; p.state_pool = in[5]; p.state_ffn = in[6];
    p.cache_k = in[7]; p.cache_v = in[8]; p.norm_mix = in[9]; p.w_in = in[10]; p.conv_w = in[11]; p.conv_b = in[12]; p.dt_bias = in[13]; p.a_log = in[14];
    p.ssm_d = in[15]; p.ssm_norm = in[16]; p.w_pool = in[17]; p.pool_scale = in[18]; p.w_out = in[19]; p.norm_mem = in[20]; p.norm_memkv = in[21];
    p.w_mq = in[22]; p.w_mk = in[23]; p.w_mv = in[24]; p.w_mo = in[25]; p.norm_ffn = in[26]; p.w_up = in[27]; p.ffn_w = in[28]; p.ffn_b = in[29];
    p.w_down = in[30]; p.final_norm = in[31];
    p.out = (float*)d_out; p.ws = (char*)d_ws; p.ph_lo = 0; p.ph_hi = 16;
    hipMemsetAsync((char*)d_ws + W_BAR, 0, 16384, stream);
    void* args[] = {&p};
    hipError_t e = hipLaunchCooperativeKernel((const void*)hybrid_fwd, dim3(grid_blocks), dim3(NTHR), args, LDS_BYTES, stream);
    if (e != hipSuccess) fprintf(stderr, "cooperative launch failed: %s (grid %d)\n", hipGetErrorString(e), grid_blocks);
}
```

```cpp
#include <hip/hip_runtime.h>
#include <hip/hip_cooperative_groups.h>
#include <cstdio>
namespace cg = cooperative_groups;

typedef unsigned short bf16_t;
typedef short bf16x8 __attribute__((ext_vector_type(8)));
typedef short s16x4 __attribute__((ext_vector_type(4)));
typedef float f32x4 __attribute__((ext_vector_type(4)));
typedef unsigned u32x4 __attribute__((ext_vector_type(4)));
typedef unsigned u32x2 __attribute__((ext_vector_type(2)));
#define LDSB __attribute__((address_space(3)))

constexpr int TP = 16384, TS = 512, TT = TP + TS;
constexpr int NTHR = 512;
constexpr int LDS_BYTES = 139264 + 256;
constexpr float EPS = 1e-6f;
#ifndef PHASE_MASK
#define PHASE_MASK 0xFFFF
#endif
#ifndef REPEAT_MASK
#define REPEAT_MASK 0
#endif
#ifndef PROBE3
#define PROBE3 0
#endif
#ifndef EXTRA_SYNCS
#define EXTRA_SYNCS 0
#endif

constexpr size_t O_YP = 0;
constexpr size_t O_YS = O_YP + (size_t)TP * 1024;
constexpr size_t O_SSMP = O_YS + (size_t)TS * 1024;
constexpr size_t O_SSMS = O_SSMP + (size_t)8 * 16 * 64 * 128;
constexpr size_t O_CONVP = O_SSMS + (size_t)128 * 16 * 64 * 128;
constexpr size_t O_CONVS = O_CONVP + (size_t)8 * 3 * 1536;
constexpr size_t O_POOLP = O_CONVS + (size_t)128 * 3 * 1536;
constexpr size_t O_POOLS = O_POOLP + (size_t)8 * 15 * 1024;
constexpr size_t O_FFNP = O_POOLS + (size_t)128 * 15 * 1024;
constexpr size_t O_FFNS = O_FFNP + (size_t)8 * 2 * 5632;
constexpr size_t O_MK = O_FFNS + (size_t)128 * 2 * 5632;
constexpr size_t O_MV = O_MK + (size_t)8 * 256 * 1024;

constexpr size_t W_WIN = 0;
constexpr size_t W_WPOOL = W_WIN + (size_t)3584 * 1024 * 2;
constexpr size_t W_WOUT = W_WPOOL + (size_t)4 * 256 * 256 * 2;
constexpr size_t W_WMQ = W_WOUT + (size_t)1024 * 2048 * 2;
constexpr size_t W_WMK = W_WMQ + (size_t)1024 * 1024 * 2;
constexpr size_t W_WMV = W_WMK + (size_t)1024 * 1024 * 2;
constexpr size_t W_WMO = W_WMV + (size_t)1024 * 1024 * 2;
constexpr size_t W_WUP = W_WMO + (size_t)1024 * 1024 * 2;
constexpr size_t W_WDOWN = W_WUP + (size_t)5632 * 1024 * 2;
constexpr size_t W_H = W_WDOWN + (size_t)1024 * 2816 * 2;
constexpr size_t W_HM = W_H + (size_t)TT * 1024 * 2;
constexpr size_t W_KB = W_HM + (size_t)2048 * 1024 * 2;
constexpr size_t W_VT = W_KB + (size_t)2048 * 1024 * 2;
constexpr size_t W_DT = W_VT + (size_t)2048 * 1024 * 2;
constexpr size_t W_XRES = W_DT + (size_t)TT * 16 * 4;
constexpr size_t W_ARENA = W_XRES + (size_t)TT * 1024 * 4;
constexpr size_t W_Z = W_ARENA;
constexpr size_t W_PROJ2 = W_Z + (size_t)TT * 1024 * 2;
constexpr size_t W_XACT = W_PROJ2 + (size_t)TT * 2560 * 2;
constexpr size_t W_POOLED = W_XACT + (size_t)TT * 1536 * 2;
constexpr size_t W_Y = W_POOLED + (size_t)TT * 1024 * 2;
constexpr size_t W_MIX = W_Y + (size_t)TT * 1024 * 2;
constexpr size_t W_END_A = W_MIX + (size_t)TT * 2048 * 2;
constexpr size_t W_Q = W_PROJ2;
constexpr size_t W_P = W_Q + (size_t)TT * 1024 * 2;
constexpr size_t W_O = W_P + (size_t)TP * 1024 * 2;
constexpr size_t W_U = W_ARENA;
constexpr size_t W_ACT = W_U + (size_t)TT * 5632 * 2;
constexpr size_t W_END_C = W_ACT + (size_t)TT * 2816 * 2;
constexpr size_t W_BAR = W_END_A;
constexpr size_t W_SS1 = W_BAR + 16384;
constexpr size_t W_SS2 = W_SS1 + (size_t)TT * 4;
constexpr size_t W_SS3 = W_SS2 + (size_t)TT * 4;
constexpr size_t W_WLO = W_SS3 + (size_t)TT * 4;
constexpr size_t W_TOTAL = W_WLO + (size_t)1024 * 1024 * 2;
static_assert(W_O + (size_t)TT * 1024 * 2 <= W_POOLED, "era B overflow");
static_assert(W_END_C <= W_END_A, "era C overflow");

struct Params {
    const float *x_prompt, *x_sample, *mem_prompt, *state_ssm, *state_conv, *state_pool, *state_ffn, *cache_k, *cache_v;
    const float *norm_mix, *w_in, *conv_w, *conv_b, *dt_bias, *a_log, *ssm_d, *ssm_norm, *w_pool, *pool_scale, *w_out;
    const float *norm_mem, *norm_memkv, *w_mq, *w_mk, *w_mv, *w_mo, *norm_ffn, *w_up, *ffn_w, *ffn_b, *w_down, *final_norm;
    float* out;
    char* ws;
    int ph_lo, ph_hi;
};

typedef const __attribute__((address_space(4))) Params* PP;

__device__ __forceinline__ unsigned pk2(float lo, float hi) { unsigned r; asm("v_cvt_pk_bf16_f32 %0, %1, %2" : "=v"(r) : "v"(lo), "v"(hi)); return r; }
__device__ __forceinline__ bf16_t f2bf(float f) { return (bf16_t)(pk2(f, 0.f) & 0xffffu); }
__device__ __forceinline__ float bf2f(bf16_t b) { return __uint_as_float(((unsigned)b) << 16); }
__device__ __forceinline__ float bflo(unsigned u) { return __uint_as_float(u << 16); }
__device__ __forceinline__ float bfhi(unsigned u) { return __uint_as_float(u & 0xffff0000u); }
__device__ __forceinline__ void unpack8(u32x4 v, float (&f)[8]) {
    f[0] = bflo(v.x); f[1] = bfhi(v.x); f[2] = bflo(v.y); f[3] = bfhi(v.y); f[4] = bflo(v.z); f[5] = bfhi(v.z); f[6] = bflo(v.w); f[7] = bfhi(v.w);
}
__device__ __forceinline__ u32x4 pack8(const float (&f)[8]) { u32x4 r; r.x = pk2(f[0], f[1]); r.y = pk2(f[2], f[3]); r.z = pk2(f[4], f[5]); r.w = pk2(f[6], f[7]); return r; }
__device__ __forceinline__ float wave_sum(float v) {
#pragma unroll
    for (int o = 1; o < 64; o <<= 1) v += __shfl_xor(v, o);
    return v;
}
__device__ __forceinline__ float wave_max(float v) {
#pragma unroll
    for (int o = 1; o < 64; o <<= 1) v = fmaxf(v, __shfl_xor(v, o));
    return v;
}
__device__ __forceinline__ float silu_f(float x) { return x * __builtin_amdgcn_rcpf(1.0f + __expf(-x)); }

constexpr int HTB = 128 * 64 * 2;
__device__ __forceinline__ int lds_byte(int r, int c) { const int st = (r >> 4) * 2 + (c >> 5), rr = r & 15, cc = c & 31, ob = rr * 64 + cc * 2; return st * 1024 + (ob ^ (((ob >> 9) & 1) << 5)); }
__device__ __forceinline__ void stage_rc(int b, int& R, int& C) { const int st = b / 1024, sb = b % 1024, swz = sb ^ (((sb >> 9) & 1) << 5); R = (st >> 1) * 16 + swz / 64; C = (st & 1) * 32 + (swz % 64) / 2; }

__device__ __forceinline__ int perm32(int rho) { const int n = rho >> 4, i = rho & 15; return 8 * (i >> 2) + 4 * n + (i & 3); }
__device__ __forceinline__ int invperm32(int c) { return 16 * ((c >> 2) & 1) + 4 * (c >> 3) + (c & 3); }
enum { E_PROJ = 0, E_MEMKV, E_POOL, E_OUT, E_Q, E_QK, E_PV, E_MO, E_UP, E_DOWN, E_FOLD };

template <int EK>
__device__ __forceinline__ float epi_apply(PP P, int row, int col, f32x4 v) {
    char* ws = P->ws;
    if constexpr (EK == E_PROJ) {
        u32x2 o; o.x = pk2(v[0], v[1]); o.y = pk2(v[2], v[3]);
        if (col < 1024) *(u32x2*)((bf16_t*)(ws + W_Z) + (size_t)row * 1024 + col) = o;
        else *(u32x2*)((bf16_t*)(ws + W_PROJ2) + (size_t)row * 2560 + (col - 1024)) = o;
    } else if constexpr (EK == E_MEMKV) {
        if (col < 1024) {
            *(f32x4*)(P->out + O_MK + (size_t)row * 1024 + col) = v;
            u32x2 o; o.x = pk2(v[0], v[1]); o.y = pk2(v[2], v[3]);
            *(u32x2*)((bf16_t*)(ws + W_KB) + (size_t)((row & ~31) + invperm32(row & 31)) * 1024 + col) = o;
        } else {
            const int c = col - 1024;
            *(f32x4*)(P->out + O_MV + (size_t)row * 1024 + c) = v;
            const int b = row >> 8, m = row & 255, hh = c >> 8, d = c & 255;
            bf16_t* vt = (bf16_t*)(ws + W_VT) + ((size_t)(b * 4 + hh) * 256 + (d & ~31) + invperm32(d & 31)) * 256 + m;
#pragma unroll
            for (int j = 0; j < 4; ++j) vt[j * 256] = f2bf(v[j]);
        }
    } else if constexpr (EK == E_POOL) {
        const f32x4 sc = *(const f32x4*)(P->pool_scale + col);
        u32x2 o; o.x = pk2(v[0] * sc[0], v[1] * sc[1]); o.y = pk2(v[2] * sc[2], v[3] * sc[3]);
        *(u32x2*)((bf16_t*)(ws + W_MIX) + (size_t)row * 2048 + 1024 + col) = o;
    } else if constexpr (EK == E_OUT) {
        const float* xin = row < TP ? P->x_prompt + (size_t)row * 1024 : P->x_sample + (size_t)(row - TP) * 1024;
        const f32x4 x = *(const f32x4*)(xin + col) + v;
        u32x2 o; o.x = pk2(x[0], x[1]); o.y = pk2(x[2], x[3]);
        *(u32x2*)((bf16_t*)(ws + W_H) + (size_t)row * 1024 + col) = o;
        return (x[0] * x[0] + x[1] * x[1]) + (x[2] * x[2] + x[3] * x[3]);
    } else if constexpr (EK == E_Q) {
        u32x2 o; o.x = pk2(v[0], v[1]); o.y = pk2(v[2], v[3]);
        *(u32x2*)((bf16_t*)(ws + W_Q) + (size_t)row * 1024 + col) = o;
    } else if constexpr (EK == E_PV) {
        u32x2 o; o.x = pk2(v[0], v[1]); o.y = pk2(v[2], v[3]);
        *(u32x2*)((bf16_t*)(ws + W_O) + (size_t)row * 1024 + col) = o;
    } else if constexpr (EK == E_MO || EK == E_DOWN) {
        u32x2* hp = (u32x2*)((bf16_t*)(ws + W_H) + (size_t)row * 1024 + col);
        const u32x2 hv = *hp;
        const f32x4 x = (f32x4){bflo(hv.x), bfhi(hv.x), bflo(hv.y), bfhi(hv.y)} + v;
        u32x2 o; o.x = pk2(x[0], x[1]); o.y = pk2(x[2], x[3]);
        *hp = o;
        return (x[0] * x[0] + x[1] * x[1]) + (x[2] * x[2] + x[3] * x[3]);
    } else if constexpr (EK == E_UP) {
        u32x2 o; o.x = pk2(v[0], v[1]); o.y = pk2(v[2], v[3]);
        *(u32x2*)((bf16_t*)(ws + W_U) + (size_t)row * 5632 + col) = o;
    }
    return 0.f;
}
template <int EK>
__device__ __forceinline__ float epi_rowscale(PP P, int row) {
    if constexpr (EK == E_Q) return rsqrtf(((const float*)(P->ws + W_SS1))[row] * (1.0f / 1024.0f) + EPS) * 0.0625f;
    else if constexpr (EK == E_UP) return rsqrtf(((const float*)(P->ws + W_SS2))[row] * (1.0f / 1024.0f) + EPS);
    else return 1.0f;
}
__device__ __forceinline__ float epi_apply_rt(PP P, int ekind, int row, int col, f32x4 v) {
    switch (ekind) {
    case E_FOLD: { u32x2 o; o.x = pk2(v[0], v[1]); o.y = pk2(v[2], v[3]); const int prow = (row & ~31) + invperm32(row & 31); *(u32x2*)((bf16_t*)(P->ws + W_WOUT) + (size_t)prow * 2048 + 1024 + col) = o; return 0.f; }
    case E_OUT: return epi_apply<E_OUT>(P, row, col, v);
    case E_Q: return epi_apply<E_Q>(P, row, col, v * epi_rowscale<E_Q>(P, row));
    case E_MO: return epi_apply<E_MO>(P, row, col, v);
    default: return epi_apply<E_DOWN>(P, row, col, v);
    }
}
template <int EK>
__device__ __forceinline__ void epi_loop(PP P, const f32x4 (&acc)[2][2][4][2], int rbase, int cbase, int fq) {
    if constexpr (EK == E_PROJ || EK == E_UP || EK == E_Q || EK == E_PV || EK == E_OUT || EK == E_MO || EK == E_DOWN) {
        const int cb8 = cbase + 4 * fq;
#pragma unroll
        for (int ai = 0; ai < 2; ++ai)
#pragma unroll
            for (int m = 0; m < 4; ++m) {
                const int row = rbase + ai * 128 + m * 16;
                const float rs = epi_rowscale<EK>(P, row);
                float ss = 0.f;
#pragma unroll
                for (int bj = 0; bj < 2; ++bj) {
                    f32x4 v0 = acc[ai][bj][m][0], v1 = acc[ai][bj][m][1];
                    const int col = cb8 + bj * 128;
                    if constexpr (EK == E_PROJ || EK == E_UP || EK == E_Q) { v0 *= rs; v1 *= rs; }
                    if constexpr (EK == E_OUT) {
                        const float* xin = (row < TP ? P->x_prompt + (size_t)row * 1024 : P->x_sample + (size_t)(row - TP) * 1024) + col;
                        v0 += *(const f32x4*)xin; v1 += *(const f32x4*)(xin + 4);
                    }
                    if constexpr (EK == E_MO || EK == E_DOWN) {
                        const u32x4 hv = *(const u32x4*)((const bf16_t*)(P->ws + W_H) + (size_t)row * 1024 + col);
                        v0 += (f32x4){bflo(hv.x), bfhi(hv.x), bflo(hv.y), bfhi(hv.y)}; v1 += (f32x4){bflo(hv.z), bfhi(hv.z), bflo(hv.w), bfhi(hv.w)};
                    }
                    if constexpr (EK == E_OUT || EK == E_MO || EK == E_DOWN) ss += ((v0[0] * v0[0] + v0[1] * v0[1]) + (v0[2] * v0[2] + v0[3] * v0[3])) + ((v1[0] * v1[0] + v1[1] * v1[1]) + (v1[2] * v1[2] + v1[3] * v1[3]));
                    u32x4 o; o.x = pk2(v0[0], v0[1]); o.y = pk2(v0[2], v0[3]); o.z = pk2(v1[0], v1[1]); o.w = pk2(v1[2], v1[3]);
                    if constexpr (EK == E_UP) *(u32x4*)((bf16_t*)(P->ws + W_U) + (size_t)row * 5632 + col) = o;
                    else if constexpr (EK == E_Q) *(u32x4*)((bf16_t*)(P->ws + W_Q) + (size_t)row * 1024 + col) = o;
                    else if constexpr (EK == E_PV) *(u32x4*)((bf16_t*)(P->ws + W_O) + (size_t)row * 1024 + col) = o;
                    else if constexpr (EK == E_PROJ) { if (col < 1024) *(u32x4*)((bf16_t*)(P->ws + W_Z) + (size_t)row * 1024 + col) = o;
                           else *(u32x4*)((bf16_t*)(P->ws + W_PROJ2) + (size_t)row * 2560 + (col - 1024)) = o; }
                    else *(u32x4*)((bf16_t*)(P->ws + W_H) + (size_t)row * 1024 + col) = o;
                }
                if constexpr (EK == E_OUT || EK == E_MO || EK == E_DOWN) {
                    ss += __shfl_xor(ss, 16); ss += __shfl_xor(ss, 32);
                    if (fq == 0) unsafeAtomicAdd((float*)(P->ws + (EK == E_OUT ? W_SS1 : EK == E_MO ? W_SS2 : W_SS3)) + row, ss);
                }
            }
        return;
    }
#pragma unroll
    for (int ai = 0; ai < 2; ++ai)
#pragma unroll
        for (int m = 0; m < 4; ++m) {
            const int row = rbase + ai * 128 + m * 16;
            const float rs = epi_rowscale<EK>(P, row);
            float ss = 0.f;
#pragma unroll
            for (int bj = 0; bj < 2; ++bj)
#pragma unroll
                for (int n = 0; n < 2; ++n) {
                    if constexpr (EK == E_Q || EK == E_UP) ss += epi_apply<EK>(P, row, cbase + bj * 128 + n * 16, acc[ai][bj][m][n] * rs);
                    else ss += epi_apply<EK>(P, row, cbase + bj * 128 + n * 16, acc[ai][bj][m][n]);
                }
            if constexpr (EK == E_OUT || EK == E_MO || EK == E_DOWN) {
                ss += __shfl_xor(ss, 16); ss += __shfl_xor(ss, 32);
                if (fq == 0) unsafeAtomicAdd((float*)(P->ws + (EK == E_OUT ? W_SS1 : EK == E_MO ? W_SS2 : W_SS3)) + row, ss);
            }
        }
}

struct PhaseCfg { const char* A; const char* B; int lda, ldb, K, nbig, nsmall, ncol64, ekind; };
__device__ __forceinline__ PhaseCfg phase_cfg(PP P, int gp) {
    const char* ws = P->ws; PhaseCfg c;
    switch (gp) {
    case 1:  c.A = ws + W_H;      c.B = ws + W_WIN;   c.lda = 1024; c.ldb = 1024; c.K = 1024; c.nbig = 66 * 14 + 64; c.nsmall = 512; c.ncol64 = 16; c.ekind = E_PROJ; break;
    case 3:  c.A = ws + W_POOLED; c.B = ws + W_WPOOL; c.lda = 1024; c.ldb = 256;  c.K = 256;  c.nbig = 256; c.nsmall = 256; c.ncol64 = 16; c.ekind = E_POOL; break;
    case 5:  c.A = ws + W_MIX;    c.B = ws + W_WOUT;  c.lda = 2048; c.ldb = 2048; c.K = 2048; c.nbig = 256; c.nsmall = 256; c.ncol64 = 16; c.ekind = E_OUT; break;
    case 7:  c.A = ws + W_H;      c.B = ws + W_WMQ;   c.lda = 1024; c.ldb = 1024; c.K = 1024; c.nbig = 256; c.nsmall = 256; c.ncol64 = 16; c.ekind = E_Q; break;
    case 8:  c.A = ws + W_Q;      c.B = ws + W_KB;    c.lda = 1024; c.ldb = 1024; c.K = 256;  c.nbig = 256; c.nsmall = 0;   c.ncol64 = 16; c.ekind = E_QK; break;
    case 9:  c.A = ws + W_P;      c.B = ws + W_VT;    c.lda = 1024; c.ldb = 256;  c.K = 256;  c.nbig = 256; c.nsmall = 0;   c.ncol64 = 16; c.ekind = E_PV; break;
    case 10: c.A = ws + W_O;      c.B = ws + W_WMO;   c.lda = 1024; c.ldb = 1024; c.K = 1024; c.nbig = 256; c.nsmall = 256; c.ncol64 = 16; c.ekind = E_MO; break;
    case 12: c.A = ws + W_H;      c.B = ws + W_WUP;   c.lda = 1024; c.ldb = 1024; c.K = 1024; c.nbig = 66 * 22; c.nsmall = 0; c.ncol64 = 88; c.ekind = E_UP; break;
    default: c.A = ws + W_ACT;    c.B = ws + W_WDOWN; c.lda = 2816; c.ldb = 2816; c.K = 2816; c.nbig = 256; c.nsmall = 256; c.ncol64 = 16; c.ekind = E_DOWN; break;
    }
    return c;
}
struct UnitD { const char* A; const char* B; int row0, col0, ekind; };
__device__ __forceinline__ void map_unit(int L, int nM, int nN, int& pm, int& pn) {
    const int nwg = nM * nN, q = nwg >> 3, r = nwg & 7, xcd = L & 7, off = L >> 3;
    const int wgid = (xcd < r ? xcd * (q + 1) : r * (q + 1) + (xcd - r) * q) + off;
    const int nig = 8 * nN, gid = wgid / nig, fm = gid * 8, gsz = (nM - fm) < 8 ? (nM - fm) : 8;
    const int w = wgid - gid * nig;
    pm = fm + w % gsz; pn = w / gsz;
}
__device__ __forceinline__ UnitD unit_decode(PP P, const PhaseCfg& c, int gp, int L) {
    UnitD d; d.ekind = c.ekind;
    int pm, pn;
    switch (gp) {
    case 1:
        if (L < 924) { map_unit(L, 66, 14, pm, pn); d.A = c.A + (size_t)pm * 256 * 2048; d.B = c.B + (size_t)pn * 256 * 2048; }
        else { map_unit(L - 924, 8, 8, pm, pn); d.A = P->ws + W_HM + (size_t)pm * 256 * 2048; d.B = P->ws + W_WMK + (size_t)pn * 256 * 2048; d.ekind = E_MEMKV; }
        break;
    case 3: map_unit(L, 64, 4, pm, pn); d.A = c.A + (size_t)pm * 256 * 2048 + pn * 512; d.B = c.B + (size_t)pn * 131072; break;
    case 8: map_unit(L, 64, 4, pm, pn); d.A = c.A + (size_t)pm * 256 * 2048 + pn * 512; d.B = c.B + (size_t)(pm >> 3) * 256 * 2048 + pn * 512; break;
    case 9: map_unit(L, 64, 4, pm, pn); d.A = c.A + (size_t)pm * 256 * 2048 + pn * 512; d.B = c.B + (size_t)((pm >> 3) * 4 + pn) * 131072; break;
    case 12: map_unit(L, 66, 22, pm, pn); d.A = c.A + (size_t)pm * 256 * 2048; d.B = c.B + (size_t)pn * 256 * 2048; break;
    default: map_unit(L, 64, 4, pm, pn); d.A = c.A + (size_t)pm * 256 * c.lda * 2; d.B = c.B + (size_t)pn * 256 * c.ldb * 2; break;
    }
    d.row0 = pm * 256; d.col0 = pn * 256;
    return d;
}

__device__ __forceinline__ void gemm_phase(PP P, int gp, char* shm_g, int lb, int blk, int nblk, const int tid) {
    LDSB unsigned char* lds = (LDSB unsigned char*)shm_g;
    const int wid = __builtin_amdgcn_readfirstlane(tid >> 6), lane = tid & 63, wr = wid >> 2, wc = wid & 3, fr = lane & 15, fq = lane >> 4;
    const PhaseCfg cfg = phase_cfg(P, gp);
    const int K = cfg.K, nt = K / 64;
    unsigned voffA, voffB;
    { int R, C; stage_rc(tid * 16, R, C); voffA = (unsigned)(R * cfg.lda + C) * 2u; voffB = (unsigned)(R * cfg.ldb + C) * 2u; }
    const size_t qstepvoffA = (size_t)64 * cfg.lda * 2, qstepvoffB = (size_t)64 * cfg.ldb * 2;
    const size_t kstep = 128;
    const size_t hstepA = (size_t)128 * cfg.lda * 2, hstepB = (size_t)128 * cfg.ldb * 2;
    const unsigned ldsw = (unsigned)wid * 1024u;
    const int aoff = lds_byte(wr * 64 + fr, fq * 8), boff = lds_byte(wc * 32 + fr, fq * 8);
    const bool chain = (cfg.ekind != E_QK);
#define G_SA(b, h) (((b) * 2 + (h)) * HTB)
#define G_SB(b, h) ((4 + (b) * 2 + (h)) * HTB)
#define G_STAGE(bufoff, gbase, voff) do { \
        __builtin_amdgcn_global_load_lds((const unsigned*)((const char*)(gbase) + (voff)), (LDSB unsigned*)(lds + (bufoff) + ldsw), 16, 0, 0); \
        __builtin_amdgcn_global_load_lds((const unsigned*)((const char*)(gbase) + qstep##voff + (voff)), (LDSB unsigned*)(lds + (bufoff) + ldsw + 8192), 16, 0, 0); } while (0)
#define G_LDA(dst, b, h) do { _Pragma("unroll") for (int m = 0; m < 4; ++m) _Pragma("unroll") for (int k = 0; k < 2; ++k) dst[m][k] = *(const LDSB bf16x8*)(lds + G_SA(b, h) + aoff + m * 2048 + k * 1024); } while (0)
#define G_LDB(dst, b, h) do { _Pragma("unroll") for (int n = 0; n < 2; ++n) _Pragma("unroll") for (int k = 0; k < 2; ++k) dst[n][k] = *(const LDSB bf16x8*)(lds + G_SB(b, h) + boff + n * 2048 + k * 1024); } while (0)
#define G_MMA(ai, bj, Af, Bf) do { __builtin_amdgcn_s_setprio(1); _Pragma("unroll") for (int m = 0; m < 4; ++m) _Pragma("unroll") for (int n = 0; n < 2; ++n) _Pragma("unroll") for (int k = 0; k < 2; ++k) \
        acc[ai][bj][m][n] = __builtin_amdgcn_mfma_f32_16x16x32_bf16(Bf[n][k], Af[m][k], acc[ai][bj][m][n], 0, 0, 0); __builtin_amdgcn_s_setprio(0); } while (0)
#define G_WAIT_V(n) asm volatile("s_waitcnt vmcnt(" #n ")" ::: "memory")
#define G_WAIT_L(n) asm volatile("s_waitcnt lgkmcnt(" #n ")" ::: "memory")
#define G_BAR __builtin_amdgcn_s_barrier()
#define G_SCHED __builtin_amdgcn_sched_barrier(0)
    int u = blk;
    while (u < cfg.nbig) {
        UnitD cur = unit_decode(P, cfg, gp, u);
        f32x4 acc[2][2][4][2];
#pragma unroll
        for (int a = 0; a < 2; ++a)
#pragma unroll
            for (int b = 0; b < 2; ++b)
#pragma unroll
                for (int m = 0; m < 4; ++m)
#pragma unroll
                    for (int n = 0; n < 2; ++n) acc[a][b][m][n] = (f32x4){0.f, 0.f, 0.f, 0.f};
        bf16x8 At[4][2], B0[2][2], B1[2][2];
        const char* cA = cur.A; const char* cB = cur.B;
        G_STAGE(G_SB(0, 0), cB, voffB); G_STAGE(G_SA(0, 0), cA, voffA); G_STAGE(G_SB(0, 1), cB + hstepB, voffB); G_STAGE(G_SA(0, 1), cA + hstepA, voffA);
        if (wr == 1) G_BAR;
        G_WAIT_V(4); G_BAR;
        G_STAGE(G_SB(1, 0), cB + kstep, voffB); G_STAGE(G_SA(1, 0), cA + kstep, voffA); G_STAGE(G_SB(1, 1), cB + hstepB + kstep, voffB);
        G_WAIT_V(6); G_BAR;
        for (;;) {
            const bool has_next = chain && (u + nblk < cfg.nbig);
            UnitD nxt = cur;
            if (has_next) nxt = unit_decode(P, cfg, gp, u + nblk);
            const char* nA = nxt.A; const char* nB = nxt.B;
            for (int t = 0; t < nt; t += 2) {
                const bool last = (t == nt - 2);
                const char* a1 = cA + (size_t)(t + 1) * kstep;
                const char* a2 = last ? nA : cA + (size_t)(t + 2) * kstep; const char* b2 = last ? nB : cB + (size_t)(t + 2) * kstep;
                const char* a3 = a2 + kstep; const char* b3 = b2 + kstep;
                G_LDB(B0, 0, 0); G_SCHED; G_LDA(At, 0, 0); G_STAGE(G_SA(1, 1), a1 + hstepA, voffA);
                G_WAIT_L(8); G_BAR; G_WAIT_L(0); G_MMA(0, 0, At, B0); G_BAR; G_SCHED;
                G_LDB(B1, 0, 1); G_STAGE(G_SB(0, 0), b2, voffB);
                G_BAR; G_WAIT_L(0); G_MMA(0, 1, At, B1); G_BAR;
                G_LDA(At, 0, 1); G_STAGE(G_SA(0, 0), a2, voffA);
                G_BAR; G_WAIT_L(0); G_MMA(1, 0, At, B0); G_BAR; G_SCHED;
                G_STAGE(G_SB(0, 1), b2 + hstepB, voffB);
                G_WAIT_V(6); G_BAR; G_MMA(1, 1, At, B1); G_BAR;
                G_LDB(B0, 1, 0); G_SCHED; G_LDA(At, 1, 0); G_STAGE(G_SA(0, 1), a2 + hstepA, voffA);
                G_WAIT_L(8); G_BAR; G_WAIT_L(0); G_MMA(0, 0, At, B0); G_BAR; G_SCHED;
                G_LDB(B1, 1, 1); G_STAGE(G_SB(1, 0), b3, voffB);
                G_BAR; G_WAIT_L(0); G_MMA(0, 1, At, B1); G_BAR;
                G_LDA(At, 1, 1); G_STAGE(G_SA(1, 0), a3, voffA);
                G_BAR; G_WAIT_L(0); G_MMA(1, 0, At, B0); G_BAR; G_SCHED;
                G_STAGE(G_SB(1, 1), b3 + hstepB, voffB);
                G_WAIT_V(6); G_BAR; G_MMA(1, 1, At, B1); G_BAR;
            }
            if (chain) {
                const int rbase = cur.row0 + wr * 64 + fr, cbase = cur.col0 + wc * 32 + fq * 4;
                switch (cur.ekind) {
                case E_PROJ: epi_loop<E_PROJ>(P, acc, rbase, cbase, fq); break;
                case E_MEMKV: epi_loop<E_MEMKV>(P, acc, rbase, cbase, fq); break;
                case E_POOL: epi_loop<E_POOL>(P, acc, rbase, cbase, fq); break;
                case E_OUT: epi_loop<E_OUT>(P, acc, rbase, cbase, fq); break;
                case E_Q: epi_loop<E_Q>(P, acc, rbase, cbase, fq); break;
                case E_PV: epi_loop<E_PV>(P, acc, rbase, cbase, fq); break;
                case E_MO: epi_loop<E_MO>(P, acc, rbase, cbase, fq); break;
                case E_UP: epi_loop<E_UP>(P, acc, rbase, cbase, fq); break;
                default: epi_loop<E_DOWN>(P, acc, rbase, cbase, fq); break;
                }
            }
            if (!has_next) break;
#pragma unroll
            for (int a = 0; a < 2; ++a)
#pragma unroll
                for (int b = 0; b < 2; ++b)
#pragma unroll
                    for (int m = 0; m < 4; ++m)
#pragma unroll
                        for (int n = 0; n < 2; ++n) acc[a][b][m][n] = (f32x4){0.f, 0.f, 0.f, 0.f};
            cur = nxt; cA = nA; cB = nB; u += nblk;
        }
        G_WAIT_V(0);
        if (wr == 0) G_BAR;
        G_BAR;
        if (!chain) {
            float* redm = (float*)(shm_g + 131072);
            float* reds = (float*)(shm_g + 135168);
#pragma unroll
            for (int ai = 0; ai < 2; ++ai)
#pragma unroll
                for (int m = 0; m < 4; ++m) {
                    float t = -3.0e38f;
#pragma unroll
                    for (int bj = 0; bj < 2; ++bj)
#pragma unroll
                        for (int n = 0; n < 2; ++n)
#pragma unroll
                            for (int j = 0; j < 4; ++j) t = fmaxf(t, acc[ai][bj][m][n][j]);
                    t = fmaxf(t, __shfl_xor(t, 16)); t = fmaxf(t, __shfl_xor(t, 32));
                    if (fq == 0) redm[(ai * 128 + wr * 64 + m * 16 + fr) * 4 + wc] = t;
                }
            __syncthreads();
#pragma unroll
            for (int ai = 0; ai < 2; ++ai)
#pragma unroll
                for (int m = 0; m < 4; ++m) {
                    const f32x4 r = *(const f32x4*)(redm + (ai * 128 + wr * 64 + m * 16 + fr) * 4);
                    const float M = fmaxf(fmaxf(r[0], r[1]), fmaxf(r[2], r[3]));
                    float s = 0.f;
#pragma unroll
                    for (int bj = 0; bj < 2; ++bj)
#pragma unroll
                        for (int n = 0; n < 2; ++n)
#pragma unroll
                            for (int j = 0; j < 4; ++j) { const float e = __expf(acc[ai][bj][m][n][j] - M); acc[ai][bj][m][n][j] = e; s += e; }
                    s += __shfl_xor(s, 16); s += __shfl_xor(s, 32);
                    if (fq == 0) reds[(ai * 128 + wr * 64 + m * 16 + fr) * 4 + wc] = s;
                }
            __syncthreads();
#pragma unroll
            for (int ai = 0; ai < 2; ++ai)
#pragma unroll
                for (int m = 0; m < 4; ++m) {
                    const int rl = ai * 128 + wr * 64 + m * 16 + fr;
                    const f32x4 r = *(const f32x4*)(reds + rl * 4);
                    const float inv = 1.0f / ((r[0] + r[1]) + (r[2] + r[3]));
                    bf16_t* prow = (bf16_t*)(P->ws + W_P) + (size_t)(cur.row0 + rl) * 1024 + cur.col0;
#pragma unroll
                    for (int bj = 0; bj < 2; ++bj) {
                        const f32x4 v0 = acc[ai][bj][m][0], v1 = acc[ai][bj][m][1];
                        u32x4 o; o.x = pk2(v0[0] * inv, v0[1] * inv); o.y = pk2(v0[2] * inv, v0[3] * inv); o.z = pk2(v1[0] * inv, v1[1] * inv); o.w = pk2(v1[2] * inv, v1[3] * inv);
                        *(u32x4*)(prow + bj * 128 + wc * 32 + fq * 8) = o;
                    }
                }
            __syncthreads();
        }
        u += nblk;
    }
#undef G_SA
#undef G_SB
#undef G_STAGE
#undef G_LDA
#undef G_LDB
#undef G_MMA
    const int rot = cfg.nbig % nblk;
    for (int s0 = (lb - rot + nblk) % nblk; s0 < cfg.nsmall; s0 += nblk) {
        const int pr = s0 / cfg.ncol64, pc = s0 % cfg.ncol64;
        const int row0 = (gp == 1 ? 0 : TP) + pr * 32, col0 = pc * 64;
        int lda_s = cfg.lda, ldb_s = cfg.ldb, K_s = K, ek_s = cfg.ekind;
        const bf16_t* Ab; const bf16_t* Bb;
        if (gp == 1) {
            const int g = pc >> 2; lda_s = 1024; ldb_s = 256; K_s = 256; ek_s = E_FOLD;
            Ab = (const bf16_t*)(P->ws + W_WLO) + (size_t)row0 * 1024 + g * 256; Bb = (const bf16_t*)(P->ws + W_WPOOL) + (size_t)g * 65536 + (size_t)(col0 - g * 256) * 256;
        } else { Ab = (const bf16_t*)cfg.A + (size_t)row0 * cfg.lda; Bb = (const bf16_t*)cfg.B + (size_t)col0 * cfg.ldb; }
        const int kw = K_s >> 3, nks = kw >> 5;
        f32x4 acc[2][4];
#pragma unroll
        for (int mi = 0; mi < 2; ++mi)
#pragma unroll
            for (int ni = 0; ni < 4; ++ni) acc[mi][ni] = (f32x4){0.f, 0.f, 0.f, 0.f};
        const bf16_t* ap = Ab + (size_t)fr * lda_s + wid * kw + fq * 8;
        const bf16_t* bp = Bb + (size_t)fr * ldb_s + wid * kw + fq * 8;
        for (int ks0 = 0; ks0 < nks; ks0 += 4) {
            bf16x8 a[4][2], b[4][4];
#pragma unroll
            for (int q = 0; q < 4; ++q) {
                const bool ok = ks0 + q < nks;
#pragma unroll
                for (int mi = 0; mi < 2; ++mi) { bf16x8 z = {0, 0, 0, 0, 0, 0, 0, 0}; if (ok) z = *(const bf16x8*)(ap + (size_t)mi * 16 * lda_s + (ks0 + q) * 32); a[q][mi] = z; }
#pragma unroll
                for (int ni = 0; ni < 4; ++ni) { bf16x8 z = {0, 0, 0, 0, 0, 0, 0, 0}; if (ok) z = *(const bf16x8*)(bp + (size_t)ni * 16 * ldb_s + (ks0 + q) * 32); b[q][ni] = z; }
            }
#pragma unroll
            for (int q = 0; q < 4; ++q)
#pragma unroll
                for (int mi = 0; mi < 2; ++mi)
#pragma unroll
                    for (int ni = 0; ni < 4; ++ni) acc[mi][ni] = __builtin_amdgcn_mfma_f32_16x16x32_bf16(b[q][ni], a[q][mi], acc[mi][ni], 0, 0, 0);
        }
        float* red = (float*)shm_g;
#pragma unroll
        for (int mi = 0; mi < 2; ++mi)
#pragma unroll
            for (int ni = 0; ni < 4; ++ni) *(f32x4*)(red + wid * 2048 + (mi * 16 + fr) * 64 + ni * 16 + fq * 4) = acc[mi][ni];
        __syncthreads();
        {
            const int r = tid >> 4, c = (tid & 15) * 4;
            f32x4 v = *(const f32x4*)(red + r * 64 + c);
#pragma unroll
            for (int w = 1; w < 8; ++w) v += *(const f32x4*)(red + w * 2048 + r * 64 + c);
            const int cl = (gp == 1) ? c : (c & 32) + perm32(c & 31);
            float ss = epi_apply_rt(P, ek_s, row0 + r, col0 + cl, v);
            if (cfg.ekind == E_OUT || cfg.ekind == E_MO || cfg.ekind == E_DOWN) {
                ss += __shfl_xor(ss, 1); ss += __shfl_xor(ss, 2); ss += __shfl_xor(ss, 4); ss += __shfl_xor(ss, 8);
                if ((tid & 15) == 0) unsafeAtomicAdd((float*)(P->ws + (cfg.ekind == E_OUT ? W_SS1 : cfg.ekind == E_MO ? W_SS2 : W_SS3)) + row0 + r, ss);
            }
        }
        __syncthreads();
    }
}

struct TrDesc { const float* src; bf16_t* dst; const float* gain; int ld_src, ld_dst, k0, n0s, n0d, perm; };
__device__ __forceinline__ TrDesc tr_decode(PP P, int i) {
    char* ws = P->ws; TrDesc d; d.gain = nullptr; d.perm = 0;
    if (i < 896) { const int kt = i / 56, ntl = i % 56; d.n0d = ntl * 64; d.n0s = d.n0d < 2560 ? d.n0d : d.n0d + 16; d.src = P->w_in; d.ld_src = 3600; d.dst = (bf16_t*)(ws + W_WIN); d.ld_dst = 1024; d.k0 = kt * 64; d.perm = 1; return d; }
    i -= 896;
    if (i < 512) { const int kt = i >> 4, ntl = i & 15; d.ld_src = 1024; d.n0s = d.n0d = ntl * 64;
        d.perm = kt < 16 ? 1 : 0;
        if (kt < 16) { d.src = P->w_out; d.dst = (bf16_t*)(ws + W_WOUT); d.ld_dst = 2048; d.k0 = kt * 64; }
        else { d.src = P->w_out + (size_t)1024 * 1024; d.dst = (bf16_t*)(ws + W_WLO); d.ld_dst = 1024; d.k0 = (kt - 16) * 64; }
        return d; }
    i -= 512;
    if (i < 1024) { const int wsel = i >> 8, r = i & 255, kt = r >> 4, ntl = r & 15;
        d.src = wsel == 0 ? P->w_mq : wsel == 1 ? P->w_mk : wsel == 2 ? P->w_mv : P->w_mo;
        d.dst = (bf16_t*)(ws + (wsel == 0 ? W_WMQ : wsel == 1 ? W_WMK : wsel == 2 ? W_WMV : W_WMO));
        d.gain = wsel == 0 ? P->norm_mem : nullptr; d.ld_src = 1024; d.ld_dst = 1024; d.k0 = kt * 64; d.n0s = d.n0d = ntl * 64; d.perm = (wsel == 0 || wsel == 3) ? 1 : 0; return d; }
    i -= 1024;
    if (i < 1408) { const int kt = i / 88, ntl = i % 88; d.src = P->w_up; d.ld_src = 5632; d.dst = (bf16_t*)(ws + W_WUP); d.ld_dst = 1024; d.gain = P->norm_ffn; d.k0 = kt * 64; d.n0s = d.n0d = ntl * 64; d.perm = 1; return d; }
    i -= 1408;
    { const int kt = i >> 4, ntl = i & 15; d.src = P->w_down; d.ld_src = 1024; d.dst = (bf16_t*)(ws + W_WDOWN); d.ld_dst = 2816; d.k0 = kt * 64; d.n0s = d.n0d = ntl * 64; d.perm = 1; return d; }
}

__device__ __forceinline__ void phase_prep(PP P, char* shm, int blk, int nblk, const int tid) {
    const int wid = tid >> 6, lane = tid & 63;
    float* tiles = (float*)shm;
    float* wdt = (float*)(shm + 69632);
    for (int i = blk * NTHR + tid; i < 3 * TT; i += nblk * NTHR) ((float*)(P->ws + W_SS1))[i] = 0.f;
    for (int i = (blk * NTHR + tid) * 4; i < 4 * 65536; i += nblk * NTHR * 4) {
        const f32x4 wv = *(const f32x4*)(P->w_pool + i), sv = *(const f32x4*)(P->pool_scale + (i >> 16) * 256 + (i & 255));
        u32x2 o; o.x = pk2(wv[0] * sv[0], wv[1] * sv[1]); o.y = pk2(wv[2] * sv[2], wv[3] * sv[3]);
        *(u32x2*)((bf16_t*)(P->ws + W_WPOOL) + i) = o;
    }
    for (int i = tid; i < 1024 * 16; i += NTHR) { const int k = i >> 4, hd = i & 15; wdt[hd * 1024 + k] = P->w_in[(size_t)k * 3600 + 2560 + hd]; }
    __syncthreads();
    char* ws = P->ws;
    constexpr int NGRP = (TT + 2048) / 32;
    for (int it = blk; it < NGRP; it += nblk) {
        const int rbase = it * 32 + wid * 4;
        const bool ismem = rbase >= TT;
        f32x4 xv[4][4];
#pragma unroll
        for (int r = 0; r < 4; ++r) {
            const int row = (ismem ? rbase - TT : rbase) + r;
            const float* xr = ismem ? P->mem_prompt + (size_t)row * 1024 : (row < TP ? P->x_prompt + (size_t)row * 1024 : P->x_sample + (size_t)(row - TP) * 1024);
#pragma unroll
            for (int j = 0; j < 4; ++j) xv[r][j] = __builtin_nontemporal_load((const f32x4*)(xr + j * 256 + lane * 4));
        }
        const float* gg = ismem ? P->norm_memkv : P->norm_mix;
#pragma unroll
        for (int r = 0; r < 4; ++r) {
            const int row = (ismem ? rbase - TT : rbase) + r;
            bf16_t* orow = (bf16_t*)(ws + (ismem ? W_HM : W_H)) + (size_t)row * 1024;
            float ss = 0.f;
#pragma unroll
            for (int j = 0; j < 4; ++j) ss += xv[r][j][0] * xv[r][j][0] + xv[r][j][1] * xv[r][j][1] + xv[r][j][2] * xv[r][j][2] + xv[r][j][3] * xv[r][j][3];
            ss = wave_sum(ss);
            const float rstd = rsqrtf(ss * (1.0f / 1024.0f) + EPS);
#pragma unroll
            for (int j = 0; j < 4; ++j) { const f32x4 g4 = *(const f32x4*)(gg + j * 256 + lane * 4); xv[r][j] = xv[r][j] * rstd * g4;
                u32x2 o; o.x = pk2(xv[r][j][0], xv[r][j][1]); o.y = pk2(xv[r][j][2], xv[r][j][3]); *(u32x2*)(orow + j * 256 + lane * 4) = o; }
        }
        if (!ismem) {
            float vals[64];
#pragma unroll
            for (int hd = 0; hd < 16; ++hd) {
                f32x4 w4[4];
#pragma unroll
                for (int j = 0; j < 4; ++j) w4[j] = *(const f32x4*)(wdt + hd * 1024 + j * 256 + lane * 4);
#pragma unroll
                for (int r = 0; r < 4; ++r) {
                    float a = 0.f;
#pragma unroll
                    for (int j = 0; j < 4; ++j) a += xv[r][j][0] * w4[j][0] + xv[r][j][1] * w4[j][1] + xv[r][j][2] * w4[j][2] + xv[r][j][3] * w4[j][3];
                    vals[r * 16 + hd] = a;
                }
            }
#pragma unroll
            for (int half = 32; half >= 1; half >>= 1) {
                const bool hi = (lane & half) != 0;
#pragma unroll
                for (int i = 0; i < half; ++i) {
                    const float keep = hi ? vals[i + half] : vals[i], send = hi ? vals[i] : vals[i + half];
                    vals[i] = keep + __shfl_xor(send, half);
                }
            }
            const float x = vals[0] + P->dt_bias[lane & 15];
            const float ey = __expf(-fabsf(x)); const float l1p = ey < 0.03f ? ey * (1.0f - ey * (0.5f - ey * (0.33333333f - 0.25f * ey))) : __logf(1.0f + ey);
            ((float*)(ws + W_DT))[(size_t)rbase * 16 + lane] = fmaxf(x, 0.f) + l1p;
        }
    }
    __syncthreads();
    const int kr = tid >> 4, nc = (tid & 15) * 4, tn = tid >> 3, tk8 = (tid & 7) * 8;
    for (int it = blk; it < 4544; it += 4 * nblk) {
        f32x4 v[4][2];
#pragma unroll
        for (int q = 0; q < 4; ++q) {
            const int i = it + q * nblk;
            if (i < 4544) { const TrDesc d = tr_decode(P, i);
#pragma unroll
                for (int h = 0; h < 2; ++h) { const int k = kr + h * 32; f32x4 t = __builtin_nontemporal_load((const f32x4*)(d.src + (size_t)(d.k0 + k) * d.ld_src + d.n0s + nc)); if (d.gain) t *= d.gain[d.k0 + k]; v[q][h] = t; } }
        }
#pragma unroll
        for (int q = 0; q < 4; ++q) {
            if (it + q * nblk < 4544) { float* tile = tiles + q * (64 * 65);
#pragma unroll
                for (int h = 0; h < 2; ++h) { const int k = kr + h * 32; tile[k * 65 + nc + 0] = v[q][h][0]; tile[k * 65 + nc + 1] = v[q][h][1]; tile[k * 65 + nc + 2] = v[q][h][2]; tile[k * 65 + nc + 3] = v[q][h][3]; } }
        }
        __syncthreads();
#pragma unroll
        for (int q = 0; q < 4; ++q) {
            const int i = it + q * nblk;
            if (i < 4544) { const TrDesc d = tr_decode(P, i); const float* tile = tiles + q * (64 * 65); float f[8];
                const int sc = d.perm ? (tn & 32) + perm32(tn & 31) : tn;
#pragma unroll
                for (int e2 = 0; e2 < 8; ++e2) f[e2] = tile[(tk8 + e2) * 65 + sc];
                *(u32x4*)(d.dst + (size_t)(d.n0d + tn) * d.ld_dst + d.k0 + tk8) = pack8(f); }
        }
        __syncthreads();
    }
}

__device__ __forceinline__ u32x4 ld8(const bf16_t* p) { return *(const u32x4*)p; }

__device__ __forceinline__ void phase_convpool(PP P, int gtid, int nthreads) {
    char* ws = P->ws;
    const bf16_t* proj2 = (const bf16_t*)(ws + W_PROJ2);
    bf16_t* xact = (bf16_t*)(ws + W_XACT);
    bf16_t* pooled = (bf16_t*)(ws + W_POOLED);
    for (int idx = gtid; idx < 1152 * 320; idx += nthreads) {
        const int run = idx / 320, cg = idx % 320;
        const bool samp = run >= 1024;
        int t0, len, bidx, tl0;
        if (!samp) { t0 = run * 16; len = 16; bidx = t0 >> 11; tl0 = t0 & 2047; } else { bidx = run - 1024; t0 = TP + bidx * 4; len = 4; tl0 = 0; }
        if (cg < 192) {
            const int c0 = cg * 8;
            float w0[8], w1[8], w2[8], w3[8], bs[8], h0[8], h1[8], h2[8];
#pragma unroll
            for (int e = 0; e < 8; ++e) { w0[e] = P->conv_w[c0 + e]; w1[e] = P->conv_w[1536 + c0 + e]; w2[e] = P->conv_w[3072 + c0 + e]; w3[e] = P->conv_w[4608 + c0 + e]; bs[e] = P->conv_b[c0 + e]; }
            if (samp) {
#pragma unroll
                for (int e = 0; e < 8; ++e) { h0[e] = P->state_conv[(size_t)(bidx * 3 + 0) * 1536 + c0 + e]; h1[e] = P->state_conv[(size_t)(bidx * 3 + 1) * 1536 + c0 + e]; h2[e] = P->state_conv[(size_t)(bidx * 3 + 2) * 1536 + c0 + e]; }
            } else if (tl0 > 0) {
                unpack8(ld8(proj2 + (size_t)(t0 - 3) * 2560 + c0), h0); unpack8(ld8(proj2 + (size_t)(t0 - 2) * 2560 + c0), h1); unpack8(ld8(proj2 + (size_t)(t0 - 1) * 2560 + c0), h2);
            } else {
#pragma unroll
                for (int e = 0; e < 8; ++e) { h0[e] = 0.f; h1[e] = 0.f; h2[e] = 0.f; }
            }
            u32x4 rx[16];
#pragma unroll
            for (int j = 0; j < 16; ++j) { if (j < len) rx[j] = ld8(proj2 + (size_t)(t0 + j) * 2560 + c0); }
#pragma unroll
            for (int j = 0; j < 16; ++j) {
                if (j < len) {
                float x3[8], y[8]; unpack8(rx[j], x3);
#pragma unroll
                for (int e = 0; e < 8; ++e) { const float v = bs[e] + w0[e] * h0[e] + w1[e] * h1[e] + w2[e] * h2[e] + w3[e] * x3[e]; y[e] = silu_f(v); }
                *(u32x4*)(xact + (size_t)(t0 + j) * 1536 + c0) = pack8(y);
                if (samp) { if (j >= 1) { float* o = P->out + O_CONVS + (size_t)(bidx * 3 + j - 1) * 1536 + c0;
#pragma unroll
                        for (int e = 0; e < 8; ++e) o[e] = x3[e]; } }
                else { const int tl = tl0 + j; if (tl >= 2045) { float* o = P->out + O_CONVP + (size_t)(bidx * 3 + tl - 2045) * 1536 + c0;
#pragma unroll
                        for (int e = 0; e < 8; ++e) o[e] = x3[e]; } }
#pragma unroll
                for (int e = 0; e < 8; ++e) { h0[e] = h1[e]; h1[e] = h2[e]; h2[e] = x3[e]; }
                }
            }
        } else {
            const int c0 = (cg - 192) * 8; const int win = 2 << (c0 >> 8);
            const bf16_t* vp = proj2 + 1536 + c0;
            const float* prev = P->state_pool + (size_t)bidx * 15 * 1024 + c0;
            float sum[8];
#pragma unroll
            for (int e = 0; e < 8; ++e) sum[e] = 0.f;
            if (samp) {
                for (int jj = 1; jj < win; ++jj) {
#pragma unroll
                    for (int e = 0; e < 8; ++e) sum[e] += prev[(size_t)(15 - jj) * 1024 + e]; }
                float* o = P->out + O_POOLS + (size_t)bidx * 15 * 1024 + c0;
                for (int i = 0; i < 11; ++i) {
#pragma unroll
                    for (int e = 0; e < 8; ++e) o[(size_t)i * 1024 + e] = prev[(size_t)(i + 4) * 1024 + e]; }
            } else if (tl0 > 0) {
                for (int jj = 1; jj < win; ++jj) { float v[8]; unpack8(ld8(vp + (size_t)(t0 - jj) * 2560), v);
#pragma unroll
                    for (int e = 0; e < 8; ++e) sum[e] += v[e]; }
            }
            u32x4 rp[16];
#pragma unroll
            for (int j = 0; j < 16; ++j) { if (j < len) rp[j] = ld8(vp + (size_t)(t0 + j) * 2560); }
#pragma unroll
            for (int j = 0; j < 16; ++j) {
                if (j >= len) continue;
                float v[8], o8[8]; unpack8(rp[j], v);
                const int tl = tl0 + j;
                const float inv = 1.0f / (float)(samp ? win : (tl + 1 < win ? tl + 1 : win));
#pragma unroll
                for (int e = 0; e < 8; ++e) { sum[e] += v[e]; o8[e] = sum[e] * inv - v[e]; }
                *(u32x4*)((bf16_t*)(ws + W_MIX) + (size_t)(t0 + j) * 2048 + 1024 + c0) = pack8(o8);
                const int to = j - win + 1;
                if (samp) {
                    if (to >= 0) { float q[8]; unpack8(ld8(vp + (size_t)(t0 + to) * 2560), q);
#pragma unroll
                        for (int e = 0; e < 8; ++e) sum[e] -= q[e]; }
                    else {
#pragma unroll
                        for (int e = 0; e < 8; ++e) sum[e] -= prev[(size_t)(15 + to) * 1024 + e]; }
                    float* o = P->out + O_POOLS + (size_t)(bidx * 15 + 11 + j) * 1024 + c0;
#pragma unroll
                    for (int e = 0; e < 8; ++e) o[e] = v[e];
                } else {
                    if (tl0 + to >= 0) { float q[8]; unpack8(ld8(vp + (size_t)(t0 + to) * 2560), q);
#pragma unroll
                        for (int e = 0; e < 8; ++e) sum[e] -= q[e]; }
                    if (tl >= 2033) { float* o = P->out + O_POOLP + (size_t)(bidx * 15 + tl - 2033) * 1024 + c0;
#pragma unroll
                        for (int e = 0; e < 8; ++e) o[e] = v[e]; }
                }
            }
        }
    }
}

constexpr int CS_STR = 136;
constexpr int X_STR = 40;
__device__ __forceinline__ s16x4 tr_read(const bf16_t* p) { return __builtin_bit_cast(s16x4, __builtin_amdgcn_ds_read_tr16_b64_v4i16((LDSB s16x4*)p)); }

#define LDS_BARRIER() asm volatile("s_waitcnt lgkmcnt(0)\n\ts_barrier" ::: "memory")
__device__ __forceinline__ void ssd_prompt(PP P, int item, char* shm, const int tid) {
    const int w = tid >> 6, lane = tid & 63, fr = lane & 15, fq = lane >> 4;
    const int b = item >> 5, hd = (item >> 1) & 15, ph = item & 1, g = hd >> 3;
    const float a = -expf(P->a_log[hd]);
    const float Dh = P->ssm_d[hd];
    char* ws = P->ws;
    const bf16_t* xact = (const bf16_t*)(ws + W_XACT);
    const float* dtb = (const float*)(ws + W_DT);
    bf16_t* ybuf = (bf16_t*)(ws + W_Y);
    bf16_t* Cs = (bf16_t*)(shm);
    bf16_t* Bs = (bf16_t*)(shm + 34816);
    bf16_t* Xd = (bf16_t*)(shm + 69632);
    bf16_t* X2 = (bf16_t*)(shm + 69632 + 10240);
    bf16_t* Ht = (bf16_t*)(shm + 69632 + 20480);
    float* acs = (float*)(shm + 69632 + 30720);
    float* dts = (float*)(shm + 69632 + 31232);
    f32x4 Hacc[2];
    Hacc[0] = (f32x4){0.f, 0.f, 0.f, 0.f}; Hacc[1] = (f32x4){0.f, 0.f, 0.f, 0.f};
    const int q4 = fr >> 2, p4 = fr & 3;
    u32x4 pc[4], pb[4], px; float pd0, pd1;
    const int ls = tid >> 4, ln8 = (tid & 15) * 8;
    const int xs = tid >> 2, xp8 = (tid & 3) * 8;
#define SSD_PREFETCH(cc) do { const int _t0 = b * 2048 + (cc) * 128; \
        _Pragma("unroll") for (int i = 0; i < 4; ++i) { const bf16_t* src = xact + (size_t)(_t0 + ls + i * 32) * 1536 + g * 128 + ln8; pc[i] = *(const u32x4*)(src + 1280); pb[i] = *(const u32x4*)(src + 1024); } \
        px = *(const u32x4*)(xact + (size_t)(_t0 + xs) * 1536 + hd * 64 + ph * 32 + xp8); \
        pd0 = dtb[(size_t)(_t0 + 2 * lane) * 16 + hd]; pd1 = dtb[(size_t)(_t0 + 2 * lane + 1) * 16 + hd]; } while (0)
    SSD_PREFETCH(0);
    for (int c = 0; c < 16; ++c) {
        const int t0 = b * 2048 + c * 128;
        if (w == 0) {
            const float d0 = pd0, d1 = pd1;
            const float s = (d0 + d1) * a; float v = s;
#pragma unroll
            for (int off = 1; off < 64; off <<= 1) { const float t = __shfl_up(v, off); if (lane >= off) v += t; }
            const float excl = v - s;
            acs[2 * lane] = excl + d0 * a; acs[2 * lane + 1] = v; dts[2 * lane] = d0; dts[2 * lane + 1] = d1;
        }
#pragma unroll
        for (int pt = 0; pt < 2; ++pt) { u32x2 o; o.x = pk2(Hacc[pt][0], Hacc[pt][1]); o.y = pk2(Hacc[pt][2], Hacc[pt][3]); *(u32x2*)(Ht + (w * 16 + fr) * X_STR + pt * 16 + fq * 4) = o; }
#pragma unroll
        for (int i = 0; i < 4; ++i) { *(u32x4*)(Cs + (ls + i * 32) * CS_STR + ln8) = pc[i]; *(u32x4*)(Bs + (ls + i * 32) * CS_STR + ln8) = pb[i]; }
        LDS_BARRIER();
        {
            float x[8], xa[8], xb[8]; unpack8(px, x);
            const float dtv = dts[xs], dec = __expf(acs[127] - acs[xs]) * dtv;
#pragma unroll
            for (int e = 0; e < 8; ++e) { xa[e] = x[e] * dtv; xb[e] = x[e] * dec; }
            *(u32x4*)(Xd + xs * X_STR + xp8) = pack8(xa);
            *(u32x4*)(X2 + xs * X_STR + xp8) = pack8(xb);
        }
        if (c < 15) SSD_PREFETCH(c + 1);
        bf16x8 Cf[4];
#pragma unroll
        for (int kk = 0; kk < 4; ++kk) Cf[kk] = *(const bf16x8*)(Cs + (w * 16 + fr) * CS_STR + kk * 32 + fq * 8);
        const int lrow = w * 16 + fr; const float al = acs[lrow];
        bf16x8 Gf[4];
#pragma unroll
        for (int kk = 0; kk < 4; ++kk) {
            u32x2 half[2];
#pragma unroll
            for (int hh = 0; hh < 2; ++hh) {
                const int st = 2 * kk + hh;
                half[hh].x = 0u; half[hh].y = 0u;
                if (st <= w) {
                    f32x4 ga = (f32x4){0.f, 0.f, 0.f, 0.f};
#pragma unroll
                    for (int k2 = 0; k2 < 4; ++k2) { const bf16x8 Bf = *(const bf16x8*)(Bs + (st * 16 + fr) * CS_STR + k2 * 32 + fq * 8); ga = __builtin_amdgcn_mfma_f32_16x16x32_bf16(Bf, Cf[k2], ga, 0, 0, 0); }
                    const int s0 = st * 16 + fq * 4; const f32x4 as4 = *(const f32x4*)(acs + s0);
                    float gv[4];
#pragma unroll
                    for (int j = 0; j < 4; ++j) gv[j] = (s0 + j <= lrow) ? ga[j] * __expf(al - as4[j]) : 0.f;
                    half[hh].x = pk2(gv[0], gv[1]); half[hh].y = pk2(gv[2], gv[3]);
                }
            }
            u32x4 g4; g4.x = half[0].x; g4.y = half[0].y; g4.z = half[1].x; g4.w = half[1].y;
            Gf[kk] = __builtin_bit_cast(bf16x8, g4);
        }
        LDS_BARRIER();
        {
            f32x4 Yd[2], Yo[2];
            Yd[0] = Yd[1] = Yo[0] = Yo[1] = (f32x4){0.f, 0.f, 0.f, 0.f};
            const int nkk = (w >> 1) + 1;
#pragma unroll
            for (int kk = 0; kk < 4; ++kk) {
                if (kk < nkk) {
#pragma unroll
                    for (int pt = 0; pt < 2; ++pt) {
                        const bf16_t* base = Xd + (kk * 32 + fq * 4 + q4) * X_STR + pt * 16 + p4 * 4;
                        bf16x8 Xf; Xf.lo = tr_read(base); Xf.hi = tr_read(base + 16 * X_STR);
                        Yd[pt] = __builtin_amdgcn_mfma_f32_16x16x32_bf16(Xf, Gf[kk], Yd[pt], 0, 0, 0);
                    }
                }
            }
#pragma unroll
            for (int kk = 0; kk < 4; ++kk)
#pragma unroll
                for (int pt = 0; pt < 2; ++pt) {
                    const bf16_t* hbp = Ht + (kk * 32 + fq * 8 + q4) * X_STR + pt * 16 + p4 * 4;
                    bf16x8 Hf; Hf.lo = tr_read(hbp); Hf.hi = tr_read(hbp + 4 * X_STR);
                    Yo[pt] = __builtin_amdgcn_mfma_f32_16x16x32_bf16(Hf, Cf[kk], Yo[pt], 0, 0, 0);
                }
            const float el = __expf(al); const float rdt = Dh / dts[lrow];
#pragma unroll
            for (int pt = 0; pt < 2; ++pt) {
                const u32x2 xr = *(const u32x2*)(Xd + lrow * X_STR + pt * 16 + fq * 4);
                const f32x4 y = Yd[pt] + el * Yo[pt] + rdt * (f32x4){bflo(xr.x), bfhi(xr.x), bflo(xr.y), bfhi(xr.y)};
                u32x2 o; o.x = pk2(y[0], y[1]); o.y = pk2(y[2], y[3]);
                *(u32x2*)(ybuf + (size_t)(t0 + lrow) * 1024 + hd * 64 + ph * 32 + pt * 16 + fq * 4) = o;
            }
        }
        {
            const float dc = __expf(acs[127]);
            Hacc[0] *= dc; Hacc[1] *= dc;
#pragma unroll
            for (int kk = 0; kk < 4; ++kk) {
                const bf16_t* bb = Bs + (kk * 32 + fq * 8 + q4) * CS_STR + w * 16 + p4 * 4;
                bf16x8 Bf; Bf.lo = tr_read(bb); Bf.hi = tr_read(bb + 4 * CS_STR);
#pragma unroll
                for (int pt = 0; pt < 2; ++pt) {
                    const bf16_t* xb = X2 + (kk * 32 + fq * 8 + q4) * X_STR + pt * 16 + p4 * 4;
                    bf16x8 Xf; Xf.lo = tr_read(xb); Xf.hi = tr_read(xb + 4 * X_STR);
                    Hacc[pt] = __builtin_amdgcn_mfma_f32_16x16x32_bf16(Xf, Bf, Hacc[pt], 0, 0, 0);
                }
            }
        }
        LDS_BARRIER();
    }
#undef SSD_PREFETCH
    float* so = P->out + O_SSMP + ((size_t)(b * 16 + hd) * 64 + ph * 32) * 128;
#pragma unroll
    for (int pt = 0; pt < 2; ++pt)
#pragma unroll
        for (int j = 0; j < 4; ++j) so[(size_t)(pt * 16 + fq * 4 + j) * 128 + w * 16 + fr] = Hacc[pt][j];
}

template <int NI>
__device__ __forceinline__ void ssd_sample(PP P, int item0, int istride, const int tid) {
    const int p = tid >> 3, n0 = (tid & 7) * 16;
    char* ws = P->ws;
    const bf16_t* xact = (const bf16_t*)(ws + W_XACT);
    const float* dtb = (const float*)(ws + W_DT);
    bf16_t* ybuf = (bf16_t*)(ws + W_Y);
    f32x4 hs[NI][4]; u32x4 rb[NI][4][2], rc[NI][4][2]; float xv[NI][4], dtv[NI][4];
#pragma unroll
    for (int q = 0; q < NI; ++q) {
        const int item = item0 + q * istride, b = item >> 4, hd = item & 15, g = hd >> 3;
        const size_t sidx = ((size_t)(b * 16 + hd) * 64 + p) * 128 + n0;
#pragma unroll
        for (int i = 0; i < 4; ++i) hs[q][i] = __builtin_nontemporal_load((const f32x4*)(P->state_ssm + sidx + i * 4));
#pragma unroll
        for (int i = 0; i < 4; ++i) {
            const int t = TP + b * 4 + i;
            xv[q][i] = bf2f(xact[(size_t)t * 1536 + hd * 64 + p]);
            dtv[q][i] = dtb[(size_t)t * 16 + hd];
            rb[q][i][0] = ld8(xact + (size_t)t * 1536 + 1024 + g * 128 + n0); rb[q][i][1] = ld8(xact + (size_t)t * 1536 + 1024 + g * 128 + n0 + 8);
            rc[q][i][0] = ld8(xact + (size_t)t * 1536 + 1280 + g * 128 + n0); rc[q][i][1] = ld8(xact + (size_t)t * 1536 + 1280 + g * 128 + n0 + 8);
        }
    }
#pragma unroll
    for (int q = 0; q < NI; ++q) {
        const int item = item0 + q * istride, b = item >> 4, hd = item & 15;
        const float a = -expf(P->a_log[hd]);
        const float Dh = P->ssm_d[hd];
        const size_t sidx = ((size_t)(b * 16 + hd) * 64 + p) * 128 + n0;
        float h[16];
#pragma unroll
        for (int i = 0; i < 4; ++i) { h[i * 4] = hs[q][i][0]; h[i * 4 + 1] = hs[q][i][1]; h[i * 4 + 2] = hs[q][i][2]; h[i * 4 + 3] = hs[q][i][3]; }
#pragma unroll
        for (int i = 0; i < 4; ++i) {
            const int t = TP + b * 4 + i;
            const float dA = __expf(dtv[q][i] * a), dx = dtv[q][i] * xv[q][i];
            float Bv[16], Cv[16];
            { float t8[8]; unpack8(rb[q][i][0], t8);
#pragma unroll
              for (int e = 0; e < 8; ++e) Bv[e] = t8[e];
              unpack8(rb[q][i][1], t8);
#pragma unroll
              for (int e = 0; e < 8; ++e) Bv[8 + e] = t8[e];
              unpack8(rc[q][i][0], t8);
#pragma unroll
              for (int e = 0; e < 8; ++e) Cv[e] = t8[e];
              unpack8(rc[q][i][1], t8);
#pragma unroll
              for (int e = 0; e < 8; ++e) Cv[8 + e] = t8[e]; }
            float part = 0.f;
#pragma unroll
            for (int e = 0; e < 16; ++e) { h[e] = h[e] * dA + dx * Bv[e]; part += h[e] * Cv[e]; }
            part += __shfl_xor(part, 1); part += __shfl_xor(part, 2); part += __shfl_xor(part, 4);
            if ((tid & 7) == 0) ybuf[(size_t)t * 1024 + hd * 64 + p] = f2bf(part + Dh * xv[q][i]);
        }
        float* so = P->out + O_SSMS + sidx;
#pragma unroll
        for (int i = 0; i < 4; ++i) __builtin_nontemporal_store((f32x4){h[i * 4], h[i * 4 + 1], h[i * 4 + 2], h[i * 4 + 3]}, (f32x4*)(so + i * 4));
    }
}

__device__ __forceinline__ void phase_gatednorm(PP P, int gw, int nw, const int tid) {
    const int lane = tid & 63;
    char* ws = P->ws;
    const bf16_t* ybuf = (const bf16_t*)(ws + W_Y); const bf16_t* zbuf = (const bf16_t*)(ws + W_Z);
    bf16_t* mix = (bf16_t*)(ws + W_MIX);
    for (int row0 = gw; row0 < TT; row0 += 4 * nw) {
        u32x2 yv[4][4], zv[4][4];
#pragma unroll
        for (int r = 0; r < 4; ++r) { const int row = row0 + r * nw; if (row < TT) {
#pragma unroll
            for (int j = 0; j < 4; ++j) { yv[r][j] = *(const u32x2*)(ybuf + (size_t)row * 1024 + j * 256 + lane * 4); zv[r][j] = *(const u32x2*)(zbuf + (size_t)row * 1024 + j * 256 + lane * 4); } } }
#pragma unroll
        for (int r = 0; r < 4; ++r) { const int row = row0 + r * nw; if (row < TT) {
            float t[4][4]; float ss0 = 0.f, ss1 = 0.f;
#pragma unroll
            for (int j = 0; j < 4; ++j) {
                const float y0 = bflo(yv[r][j].x), y1 = bfhi(yv[r][j].x), y2 = bflo(yv[r][j].y), y3 = bfhi(yv[r][j].y);
                const float z0 = bflo(zv[r][j].x), z1 = bfhi(zv[r][j].x), z2 = bflo(zv[r][j].y), z3 = bfhi(zv[r][j].y);
                t[j][0] = y0 * silu_f(z0); t[j][1] = y1 * silu_f(z1); t[j][2] = y2 * silu_f(z2); t[j][3] = y3 * silu_f(z3);
                const float q = t[j][0] * t[j][0] + t[j][1] * t[j][1] + t[j][2] * t[j][2] + t[j][3] * t[j][3];
                if (j < 2) ss0 += q; else ss1 += q;
            }
            ss0 = wave_sum(ss0); ss1 = wave_sum(ss1);
            const float r0 = rsqrtf(ss0 * (1.0f / 512.0f) + EPS), r1 = rsqrtf(ss1 * (1.0f / 512.0f) + EPS);
#pragma unroll
            for (int j = 0; j < 4; ++j) {
                const float rr = j < 2 ? r0 : r1;
                const f32x4 g4 = *(const f32x4*)(P->ssm_norm + j * 256 + lane * 4);
                u32x2 o; o.x = pk2(t[j][0] * rr * g4[0], t[j][1] * rr * g4[1]); o.y = pk2(t[j][2] * rr * g4[2], t[j][3] * rr * g4[3]);
                *(u32x2*)(mix + (size_t)row * 2048 + j * 256 + lane * 4) = o;
            }
        } }
    }
}

__device__ __forceinline__ void phase_norm(PP P, const float* gain, bool final_out, int gw, int nw, const int tid) {
    const int lane = tid & 63;
    char* ws = P->ws;
    const bf16_t* hb = (const bf16_t*)(ws + W_H);
    const float* ss3 = (const float*)(ws + W_SS3);
    for (int row0 = gw; row0 < TT; row0 += 4 * nw) {
        u32x2 xv[4][4]; float sq[4];
#pragma unroll
        for (int r = 0; r < 4; ++r) { const int row = row0 + r * nw; if (row < TT) { sq[r] = ss3[row];
#pragma unroll
            for (int j = 0; j < 4; ++j) xv[r][j] = *(const u32x2*)(hb + (size_t)row * 1024 + j * 256 + lane * 4); } }
#pragma unroll
        for (int r = 0; r < 4; ++r) { const int row = row0 + r * nw; if (row < TT) {
            const float rstd = rsqrtf(sq[r] * (1.0f / 1024.0f) + EPS);
#pragma unroll
            for (int j = 0; j < 4; ++j) {
                const f32x4 g4 = *(const f32x4*)(gain + j * 256 + lane * 4);
                const f32x4 x = (f32x4){bflo(xv[r][j].x), bfhi(xv[r][j].x), bflo(xv[r][j].y), bfhi(xv[r][j].y)};
                __builtin_nontemporal_store(x * rstd * g4, (f32x4*)(P->out + O_YP + (size_t)row * 1024 + j * 256 + lane * 4));
            }
        } }
    }
}

__device__ __forceinline__ void attn_sample(PP P, int item0, int item1, char* shm, const int tid) {
    const int w = tid >> 6, lane = tid & 63, fr = lane & 15, fq = lane >> 4;
    const int half = w >> 2, w4 = w & 3;
    const int item = half ? item1 : item0;
    const bool act = item >= 0;
    const int b = act ? item >> 2 : 0, hh = item & 3;
    char* ws = P->ws;
    const bf16_t* qb = (const bf16_t*)(ws + W_Q);
    float* sc = (float*)shm + half * 1024;
    float* part = (float*)(shm + 8192) + half * 4096;
    const float* vp = P->cache_v + ((size_t)(b * 256 + w4 * 64) * 4 + hh) * 256 + lane * 4;
    f32x4 va[16], vb[16];
    if (act) {
#pragma unroll
        for (int mm = 0; mm < 16; ++mm) va[mm] = __builtin_nontemporal_load((const f32x4*)(vp + (size_t)mm * 1024));
    }
    if (act) {
        bf16x8 qf[8];
#pragma unroll
        for (int kk = 0; kk < 8; ++kk) {
            bf16x8 z = {0, 0, 0, 0, 0, 0, 0, 0};
            if (fr < 4) z = *(const bf16x8*)(qb + (size_t)(TP + b * 4 + fr) * 1024 + hh * 256 + kk * 32 + fq * 8);
            qf[kk] = z;
        }
#pragma unroll
        for (int mt = 0; mt < 4; ++mt) {
            const int key = w4 * 64 + mt * 16 + fr;
            const float* kp = P->cache_k + ((size_t)(b * 256 + key) * 4 + hh) * 256 + fq * 8;
            f32x4 k0[8], k1[8];
#pragma unroll
            for (int kk = 0; kk < 8; ++kk) { k0[kk] = __builtin_nontemporal_load((const f32x4*)(kp + kk * 32)); k1[kk] = __builtin_nontemporal_load((const f32x4*)(kp + kk * 32 + 4)); }
            f32x4 acc = (f32x4){0.f, 0.f, 0.f, 0.f};
#pragma unroll
            for (int kk = 0; kk < 8; ++kk) {
                u32x4 pk; pk.x = pk2(k0[kk][0], k0[kk][1]); pk.y = pk2(k0[kk][2], k0[kk][3]); pk.z = pk2(k1[kk][0], k1[kk][1]); pk.w = pk2(k1[kk][2], k1[kk][3]);
                acc = __builtin_amdgcn_mfma_f32_16x16x32_bf16(qf[kk], __builtin_bit_cast(bf16x8, pk), acc, 0, 0, 0);
            }
            if (fq == 0) {
#pragma unroll
                for (int j = 0; j < 4; ++j) sc[j * 256 + w4 * 64 + mt * 16 + fr] = acc[j];
            }
        }
    }
    LDS_BARRIER();
    if (act) {
#pragma unroll
        for (int mm = 0; mm < 16; ++mm) vb[mm] = __builtin_nontemporal_load((const f32x4*)(vp + (size_t)(16 + mm) * 1024));
        f32x4 s = *(const f32x4*)(sc + w4 * 256 + lane * 4);
        float m = fmaxf(fmaxf(s[0], s[1]), fmaxf(s[2], s[3])); m = wave_max(m);
        s[0] = __expf(s[0] - m); s[1] = __expf(s[1] - m); s[2] = __expf(s[2] - m); s[3] = __expf(s[3] - m);
        float su = (s[0] + s[1]) + (s[2] + s[3]); su = wave_sum(su);
        const float inv = 1.0f / su;
        *(f32x4*)(sc + w4 * 256 + lane * 4) = s * inv;
    }
    LDS_BARRIER();
    if (act) {
        f32x4 o[4];
#pragma unroll
        for (int i = 0; i < 4; ++i) o[i] = (f32x4){0.f, 0.f, 0.f, 0.f};
#pragma unroll
        for (int mm = 0; mm < 16; ++mm) {
#pragma unroll
            for (int i = 0; i < 4; ++i) o[i] += sc[i * 256 + w4 * 64 + mm] * va[mm];
        }
#pragma unroll
        for (int mm = 0; mm < 16; ++mm) va[mm] = __builtin_nontemporal_load((const f32x4*)(vp + (size_t)(32 + mm) * 1024));
#pragma unroll
        for (int mm = 0; mm < 16; ++mm) {
#pragma unroll
            for (int i = 0; i < 4; ++i) o[i] += sc[i * 256 + w4 * 64 + 16 + mm] * vb[mm];
        }
#pragma unroll
        for (int mm = 0; mm < 16; ++mm) vb[mm] = __builtin_nontemporal_load((const f32x4*)(vp + (size_t)(48 + mm) * 1024));
#pragma unroll
        for (int mm = 0; mm < 16; ++mm) {
#pragma unroll
            for (int i = 0; i < 4; ++i) o[i] += sc[i * 256 + w4 * 64 + 32 + mm] * va[mm];
        }
#pragma unroll
        for (int mm = 0; mm < 16; ++mm) {
#pragma unroll
            for (int i = 0; i < 4; ++i) o[i] += sc[i * 256 + w4 * 64 + 48 + mm] * vb[mm];
        }
#pragma unroll
        for (int i = 0; i < 4; ++i) *(f32x4*)(part + (w4 * 4 + i) * 256 + lane * 4) = o[i];
    }
    LDS_BARRIER();
    if (act) {
        f32x4 r = *(const f32x4*)(part + (0 * 4 + w4) * 256 + lane * 4);
#pragma unroll
        for (int ww = 1; ww < 4; ++ww) r += *(const f32x4*)(part + (ww * 4 + w4) * 256 + lane * 4);
        u32x2 o; o.x = pk2(r[0], r[1]); o.y = pk2(r[2], r[3]);
        *(u32x2*)((bf16_t*)(ws + W_O) + (size_t)(TP + b * 4 + w4) * 1024 + hh * 256 + lane * 4) = o;
    }
    LDS_BARRIER();
}

__device__ __forceinline__ void phase_ffnconv(PP P, int gtid, int nthreads) {
    char* ws = P->ws;
    const bf16_t* u = (const bf16_t*)(ws + W_U);
    bf16_t* act = (bf16_t*)(ws + W_ACT);
    for (int idx = gtid; idx < 1152 * 352; idx += nthreads) {
        const int run = idx / 352, cg = idx % 352;
        const bool samp = run >= 1024;
        int t0, len, bidx, tl0;
        if (!samp) { t0 = run * 16; len = 16; bidx = t0 >> 11; tl0 = t0 & 2047; } else { bidx = run - 1024; t0 = TP + bidx * 4; len = 4; tl0 = 0; }
        const int cgc = cg * 8, cvc = 2816 + cg * 8;
        float wg0[8], wg1[8], wg2[8], wv0[8], wv1[8], wv2[8], bg[8], bv[8], hg0[8], hg1[8], hv0[8], hv1[8];
#pragma unroll
        for (int e = 0; e < 8; ++e) {
            wg0[e] = P->ffn_w[cgc + e]; wg1[e] = P->ffn_w[5632 + cgc + e]; wg2[e] = P->ffn_w[11264 + cgc + e];
            wv0[e] = P->ffn_w[cvc + e]; wv1[e] = P->ffn_w[5632 + cvc + e]; wv2[e] = P->ffn_w[11264 + cvc + e];
            bg[e] = P->ffn_b[cgc + e]; bv[e] = P->ffn_b[cvc + e];
        }
        if (samp) {
#pragma unroll
            for (int e = 0; e < 8; ++e) {
                hg0[e] = P->state_ffn[(size_t)(bidx * 2 + 0) * 5632 + cgc + e]; hg1[e] = P->state_ffn[(size_t)(bidx * 2 + 1) * 5632 + cgc + e];
                hv0[e] = P->state_ffn[(size_t)(bidx * 2 + 0) * 5632 + cvc + e]; hv1[e] = P->state_ffn[(size_t)(bidx * 2 + 1) * 5632 + cvc + e];
            }
        } else if (tl0 > 0) {
            unpack8(ld8(u + (size_t)(t0 - 2) * 5632 + cgc), hg0); unpack8(ld8(u + (size_t)(t0 - 1) * 5632 + cgc), hg1);
            unpack8(ld8(u + (size_t)(t0 - 2) * 5632 + cvc), hv0); unpack8(ld8(u + (size_t)(t0 - 1) * 5632 + cvc), hv1);
        } else {
#pragma unroll
            for (int e = 0; e < 8; ++e) { hg0[e] = 0.f; hg1[e] = 0.f; hv0[e] = 0.f; hv1[e] = 0.f; }
        }
        for (int jb = 0; jb < len; jb += 8) {
        u32x4 rg[8], rv[8];
        const bf16_t* ub = u + (size_t)(t0 + jb) * 5632 + cgc;
#pragma unroll
        for (int jj = 0; jj < 8; ++jj) { if (jb + jj < len) { rg[jj] = ld8(ub + (size_t)jj * 5632); rv[jj] = ld8(ub + (size_t)jj * 5632 + 2816); } }
#pragma unroll
        for (int jj = 0; jj < 8; ++jj) {
            const int j = jb + jj;
            if (j < len) {
            float ug[8], uv[8], o8[8];
            unpack8(rg[jj], ug); unpack8(rv[jj], uv);
#pragma unroll
            for (int e = 0; e < 8; ++e) {
                const float gc = bg[e] + wg0[e] * hg0[e] + wg1[e] * hg1[e] + wg2[e] * ug[e];
                const float vc = bv[e] + wv0[e] * hv0[e] + wv1[e] * hv1[e] + wv2[e] * uv[e];
                o8[e] = silu_f(gc) * vc;
            }
            *(u32x4*)(act + (size_t)(t0 + j) * 2816 + cgc) = pack8(o8);
            float* o = nullptr;
            if (samp) { if (j >= 2) o = P->out + O_FFNS + (size_t)(bidx * 2 + j - 2) * 5632; }
            else { const int tl = tl0 + j; if (tl >= 2046) o = P->out + O_FFNP + (size_t)(bidx * 2 + tl - 2046) * 5632; }
            if (o) {
#pragma unroll
                for (int e = 0; e < 8; ++e) { o[cgc + e] = ug[e]; o[cvc + e] = uv[e]; }
            }
#pragma unroll
            for (int e = 0; e < 8; ++e) { hg0[e] = hg1[e]; hg1[e] = ug[e]; hv0[e] = hv1[e]; hv1[e] = uv[e]; }
            }
        }
        }
    }
}

#define XB_TMO      128
#define XB_XCNT(j)  (256  + 64 * (j))
#define XB_XSUB(j)  (1280 + 64 * (j))
#define XB_XGEN(j)  (2304 + 64 * (j))
#define XB_TOP      3328
#define XB_TOPGEN   3392
#define XCD_BAR_WORDS 3456
#define XB_SPIN_CAP (1u << 20)
__device__ __forceinline__ unsigned xb_ld(unsigned* p)              { return __hip_atomic_load(p, __ATOMIC_RELAXED, __HIP_MEMORY_SCOPE_AGENT); }
__device__ __forceinline__ unsigned xb_add(unsigned* p, unsigned v) { return __hip_atomic_fetch_add(p, v, __ATOMIC_RELAXED, __HIP_MEMORY_SCOPE_AGENT); }
__device__ __forceinline__ unsigned xb_xcc_id() { return (unsigned)__builtin_amdgcn_s_getreg((3 << 11) | 20) & 0xFu; }
#define XB_SPIN(cond, bar) do { unsigned _sp = 0; while (cond) { \
    if ((++_sp & 255u) == 0u) { if (xb_ld(&(bar)[XB_TMO])) break; if (_sp > XB_SPIN_CAP) { atomicAdd(&(bar)[XB_TMO], 1u); break; } } } } while (0)
__device__ __forceinline__ void xcd_barrier_complete(unsigned* bar, unsigned x, unsigned& nloc, unsigned& nx) {
    const unsigned G = gridDim.x;
    unsigned sum, cnt, mine, sp = 0u;
    for (;;) {
        sum = 0u; cnt = 0u; mine = 0u;
#pragma unroll
        for (unsigned j = 0; j < 16; ++j) { const unsigned c = xb_ld(&bar[XB_XCNT(j)]); sum += c; cnt += (c > 0u) ? 1u : 0u; mine = (j == x) ? c : mine; }
        if (sum == G) break;
        __builtin_amdgcn_s_sleep(1);
        if ((++sp & 255u) == 0u) { if (xb_ld(&bar[XB_TMO])) break; if (sp > XB_SPIN_CAP) { atomicAdd(&bar[XB_TMO], 1u); break; } }
    }
    nloc = mine > 0u ? mine : 1u; nx = cnt > 0u ? cnt : 1u;
}
__device__ __forceinline__ void xcd_barrier(unsigned* bar, volatile LDSB unsigned* st, const int tid) {
    asm volatile("s_waitcnt vmcnt(0)" ::: "memory");
    __syncthreads();
    if (tid == 0) {
        const unsigned x = xb_xcc_id();
        __builtin_amdgcn_s_waitcnt(0);
        unsigned nloc = st[0], nx = st[1];
        if (nloc == 0u) { xcd_barrier_complete(bar, x, nloc, nx); st[0] = nloc; st[1] = nx; }
        const unsigned old = xb_add(&bar[XB_XSUB(x)], 1u);
        const unsigned gen = old / nloc;
        if (old + 1u == (gen + 1u) * nloc) {
            __builtin_amdgcn_fence(__ATOMIC_RELEASE, "agent");
            asm volatile("s_waitcnt vmcnt(0)" ::: "memory");
            const unsigned og = xb_add(&bar[XB_TOP], 1u);
            const unsigned tg = og / nx;
            if (og + 1u == (tg + 1u) * nx) xb_add(&bar[XB_TOPGEN], 1u);
            else XB_SPIN(xb_ld(&bar[XB_TOPGEN]) == tg, bar);
            __builtin_amdgcn_fence(__ATOMIC_ACQUIRE, "agent");
            xb_add(&bar[XB_XGEN(x)], 1u);
            asm volatile("s_waitcnt vmcnt(0)" ::: "memory");
        } else {
            XB_SPIN(xb_ld(&bar[XB_XGEN(x)]) == gen, bar);
            __builtin_amdgcn_fence(__ATOMIC_ACQUIRE, "agent");
            asm volatile("s_waitcnt vmcnt(0)" ::: "memory");
        }
    }
    __syncthreads();
}

extern __shared__ __attribute__((aligned(16))) char smem[];

__global__ void __launch_bounds__(NTHR) hybrid_fwd(Params Pin) {
    char* shm = smem;
    volatile LDSB unsigned* bst = (volatile LDSB unsigned*)(smem + 139264);
    if (threadIdx.x == 0) { bst[0] = 0u; bst[1] = 0u; (void)xb_add((unsigned*)(Pin.ws + W_BAR) + XB_XCNT(xb_xcc_id()), 1u); }
    __syncthreads();
    for (int ph = Pin.ph_lo; ph < Pin.ph_hi; ++ph) {
        if (ph == 6 || ph == 11) continue;
        const int reps = ((REPEAT_MASK >> ph) & 1) ? 2 : 1;
        for (int rep = 0; rep < reps; ++rep) {
        if (rep > 0) xcd_barrier((unsigned*)(Pin.ws + W_BAR), bst, threadIdx.x);
        int tid = threadIdx.x, blk = blockIdx.x, nblk = gridDim.x;
        asm volatile("" : "+v"(tid));
        asm volatile("" : "+s"(blk), "+s"(nblk));
        PP P = (PP)__builtin_amdgcn_kernarg_segment_ptr();
        asm volatile("" : "+s"(P));
        const int lb = (blk & 7) * (nblk >> 3) + (blk >> 3);
        const int gtid = blk * NTHR + tid, nthreads = nblk * NTHR;
        const int gw = blk * 8 + (tid >> 6), nw = nblk * 8;
        switch (ph) {
#if PHASE_MASK & 1
        case 0: phase_prep(P, shm, blk, nblk, tid); break;
#endif
#if PHASE_MASK & 4
        case 2: phase_convpool(P, gtid, nthreads); break;
#endif
#if PHASE_MASK & 8
        case 3:
            if (blk & 1) { int it = blk; for (; it + nblk < 2048; it += 2 * nblk) ssd_sample<2>(P, it, nblk, tid); for (; it < 2048; it += nblk) ssd_sample<1>(P, it, nblk, tid); }
            for (int it = blk; it < 256; it += nblk) ssd_prompt(P, it, shm, tid);
            if (!(blk & 1)) { int it = blk; for (; it + nblk < 2048; it += 2 * nblk) ssd_sample<2>(P, it, nblk, tid); for (; it < 2048; it += nblk) ssd_sample<1>(P, it, nblk, tid); }
            break;
#endif
#if PHASE_MASK & 16
        case 4: phase_gatednorm(P, gw, nw, tid); break;
#endif
#if PHASE_MASK & 64
        case 6: phase_norm(P, P->norm_mem, false, gw, nw, tid); break;
        case 11: phase_norm(P, P->norm_ffn, false, gw, nw, tid); break;
        case 15: phase_norm(P, P->final_norm, true, gw, nw, tid); break;
#endif
#if PHASE_MASK & 8192
        case 13: phase_ffnconv(P, gtid, nthreads); break;
#endif
        default: break;
        }
#if PHASE_MASK & 256
        if (ph == 8 && (blk & 1)) { for (int it = blk; it < 512; it += 2 * nblk) attn_sample(P, it, it + nblk < 512 ? it + nblk : -1, shm, tid); __syncthreads(); }
#endif
#if PHASE_MASK & 2
        if (ph == 1 || ph == 5 || ph == 7 || ph == 8 || ph == 9 || ph == 10 || ph == 12 || ph == 14) gemm_phase(P, ph, shm, lb, blk, nblk, tid);
#endif
#if PHASE_MASK & 256
        if (ph == 9 && !(blk & 1)) { for (int it = blk; it < 512; it += 2 * nblk) attn_sample(P, it, it + nblk < 512 ? it + nblk : -1, shm, tid); }
#endif
        }
        if (ph + 1 < Pin.ph_hi && ph != 8) xcd_barrier((unsigned*)(Pin.ws + W_BAR), bst, threadIdx.x);
        if (ph == 8) { asm volatile("s_waitcnt vmcnt(0)" ::: "memory"); __syncthreads(); }
        if (EXTRA_SYNCS && ph == 0) { for (int i = 0; i < EXTRA_SYNCS; ++i) xcd_barrier((unsigned*)(Pin.ws + W_BAR), bst, threadIdx.x); }
    }
}

extern "C" void kernel_launch(void* const* d_in, const int* in_sizes, int n_in, void* d_out, int out_size, void* d_ws, size_t ws_size, hipStream_t stream) {
    static int grid_blocks = 0;
    if (!grid_blocks) {
        int dev = 0, cus = 0, per_cu = 0;
        hipGetDevice(&dev);
        hipDeviceGetAttribute(&cus, hipDeviceAttributeMultiprocessorCount, dev);
        hipFuncSetAttribute((const void*)hybrid_fwd, hipFuncAttributeMaxDynamicSharedMemorySize, LDS_BYTES);
        hipOccupancyMaxActiveBlocksPerMultiprocessor(&per_cu, hybrid_fwd, NTHR, LDS_BYTES);
        if (per_cu < 1) per_cu = 1;
        grid_blocks = cus * 1;
        grid_blocks &= ~7;
        if (grid_blocks < 8) grid_blocks = 8;
    }
    Params p{};
    const float* const* in = (const float* const*)d_in;
    p.x_prompt = in[0]; p.x_sample = in[1]; p.mem_prompt = in[2]; p.state_ssm = in[3]; p.state_conv = in[4]; p.state_pool = in[5]; p.state_ffn = in[6];
    p.cache_k = in[7]; p.cache_v = in[8]; p.norm_mix = in[9]; p.w_in = in[10]; p.conv_w = in[11]; p.conv_b = in[12]; p.dt_bias = in[13]; p.a_log = in[14];
    p.ssm_d = in[15]; p.ssm_norm = in[16]; p.w_pool = in[17]; p.pool_scale = in[18]; p.w_out = in[19]; p.norm_mem = in[20]; p.norm_memkv = in[21];
    p.w_mq = in[22]; p.w_mk = in[23]; p.w_mv = in[24]; p.w_mo = in[25]; p.norm_ffn = in[26]; p.w_up = in[27]; p.ffn_w = in[28]; p.ffn_b = in[29];
    p.w_down = in[30]; p.final_norm = in[31];
    p.out = (float*)d_out; p.ws = (char*)d_ws; p.ph_lo = 0; p.ph_hi = 16;
    hipMemsetAsync((char*)d_ws + W_BAR, 0, 16384, stream);
    void* args[] = {&p};
    hipError_t e = hipLaunchCooperativeKernel((const void*)hybrid_fwd, dim3(grid_blocks), dim3(NTHR), args, LDS_BYTES, stream);
    if (e != hipSuccess) fprintf(stderr, "cooperative launch failed: %s (grid %d)\n", hipGetErrorString(e), grid_blocks);
}
```

```cpp
#include <hip/hip_runtime.h>
#include <hip/hip_cooperative_groups.h>
#include <cstdio>
namespace cg = cooperative_groups;

typedef unsigned short bf16_t;
typedef short bf16x8 __attribute__((ext_vector_type(8)));
typedef short s16x4 __attribute__((ext_vector_type(4)));
typedef float f32x4 __attribute__((ext_vector_type(4)));
typedef unsigned u32x4 __attribute__((ext_vector_type(4)));
typedef unsigned u32x2 __attribute__((ext_vector_type(2)));
#define LDSB __attribute__((address_space(3)))

constexpr int TP = 16384, TS = 512, TT = TP + TS;
constexpr int NTHR = 512;
constexpr int LDS_BYTES = 139264 + 256;
constexpr float EPS = 1e-6f;
#ifndef PHASE_MASK
#define PHASE_MASK 0xFFFF
#endif
#ifndef REPEAT_MASK
#define REPEAT_MASK 0
#endif
#ifndef PROBE3
#define PROBE3 0
#endif
#ifndef EXTRA_SYNCS
#define EXTRA_SYNCS 0
#endif

constexpr size_t O_YP = 0;
constexpr size_t O_YS = O_YP + (size_t)TP * 1024;
constexpr size_t O_SSMP = O_YS + (size_t)TS * 1024;
constexpr size_t O_SSMS = O_SSMP + (size_t)8 * 16 * 64 * 128;
constexpr size_t O_CONVP = O_SSMS + (size_t)128 * 16 * 64 * 128;
constexpr size_t O_CONVS = O_CONVP + (size_t)8 * 3 * 1536;
constexpr size_t O_POOLP = O_CONVS + (size_t)128 * 3 * 1536;
constexpr size_t O_POOLS = O_POOLP + (size_t)8 * 15 * 1024;
constexpr size_t O_FFNP = O_POOLS + (size_t)128 * 15 * 1024;
constexpr size_t O_FFNS = O_FFNP + (size_t)8 * 2 * 5632;
constexpr size_t O_MK = O_FFNS + (size_t)128 * 2 * 5632;
constexpr size_t O_MV = O_MK + (size_t)8 * 256 * 1024;

constexpr size_t W_WIN = 0;
constexpr size_t W_WPOOL = W_WIN + (size_t)3584 * 1024 * 2;
constexpr size_t W_WOUT = W_WPOOL + (size_t)4 * 256 * 256 * 2;
constexpr size_t W_WMQ = W_WOUT + (size_t)1024 * 2048 * 2;
constexpr size_t W_WMK = W_WMQ + (size_t)1024 * 1024 * 2;
constexpr size_t W_WMV = W_WMK + (size_t)1024 * 1024 * 2;
constexpr size_t W_WMO = W_WMV + (size_t)1024 * 1024 * 2;
constexpr size_t W_WUP = W_WMO + (size_t)1024 * 1024 * 2;
constexpr size_t W_WDOWN = W_WUP + (size_t)5632 * 1024 * 2;
constexpr size_t W_H = W_WDOWN + (size_t)1024 * 2816 * 2;
constexpr size_t W_HM = W_H + (size_t)TT * 1024 * 2;
constexpr size_t W_KB = W_HM + (size_t)2048 * 1024 * 2;
constexpr size_t W_VT = W_KB + (size_t)2048 * 1024 * 2;
constexpr size_t W_DT = W_VT + (size_t)2048 * 1024 * 2;
constexpr size_t W_XRES = W_DT + (size_t)TT * 16 * 4;
constexpr size_t W_ARENA = W_XRES + (size_t)TT * 1024 * 4;
constexpr size_t W_Z = W_ARENA;
constexpr size_t W_PROJ2 = W_Z + (size_t)TT * 1024 * 2;
constexpr size_t W_XACT = W_PROJ2 + (size_t)TT * 2560 * 2;
constexpr size_t W_POOLED = W_XACT + (size_t)TT * 1536 * 2;
constexpr size_t W_Y = W_POOLED + (size_t)TT * 1024 * 2;
constexpr size_t W_MIX = W_Y + (size_t)TT * 1024 * 2;
constexpr size_t W_END_A = W_MIX + (size_t)TT * 2048 * 2;
constexpr size_t W_Q = W_PROJ2;
constexpr size_t W_P = W_Q + (size_t)TT * 1024 * 2;
constexpr size_t W_O = W_P + (size_t)TP * 1024 * 2;
constexpr size_t W_U = W_ARENA;
constexpr size_t W_ACT = W_U + (size_t)TT * 5632 * 2;
constexpr size_t W_END_C = W_ACT + (size_t)TT * 2816 * 2;
constexpr size_t W_BAR = W_END_A;
constexpr size_t W_SS1 = W_BAR + 16384;
constexpr size_t W_SS2 = W_SS1 + (size_t)TT * 4;
constexpr size_t W_SS3 = W_SS2 + (size_t)TT * 4;
constexpr size_t W_WLO = W_SS3 + (size_t)TT * 4;
constexpr size_t W_TOTAL = W_WLO + (size_t)1024 * 1024 * 2;
static_assert(W_O + (size_t)TT * 1024 * 2 <= W_POOLED, "era B overflow");
static_assert(W_END_C <= W_END_A, "era C overflow");

struct Params {
    const float *x_prompt, *x_sample, *mem_prompt, *state_ssm, *state_conv, *state_pool, *state_ffn, *cache_k, *cache_v;
    const float *norm_mix, *w_in, *conv_w, *conv_b, *dt_bias, *a_log, *ssm_d, *ssm_norm, *w_pool, *pool_scale, *w_out;
    const float *norm_mem, *norm_memkv, *w_mq, *w_mk, *w_mv, *w_mo, *norm_ffn, *w_up, *ffn_w, *ffn_b, *w_down, *final_norm;
    float* out;
    char* ws;
    int ph_lo, ph_hi;
};

typedef const __attribute__((address_space(4))) Params* PP;

__device__ __forceinline__ unsigned pk2(float lo, float hi) { unsigned r; asm("v_cvt_pk_bf16_f32 %0, %1, %2" : "=v"(r) : "v"(lo), "v"(hi)); return r; }
__device__ __forceinline__ bf16_t f2bf(float f) { return (bf16_t)(pk2(f, 0.f) & 0xffffu); }
__device__ __forceinline__ float bf2f(bf16_t b) { return __uint_as_float(((unsigned)b) << 16); }
__device__ __forceinline__ float bflo(unsigned u) { return __uint_as_float(u << 16); }
__device__ __forceinline__ float bfhi(unsigned u) { return __uint_as_float(u & 0xffff0000u); }
__device__ __forceinline__ void unpack8(u32x4 v, float (&f)[8]) {
    f[0] = bflo(v.x); f[1] = bfhi(v.x); f[2] = bflo(v.y); f[3] = bfhi(v.y); f[4] = bflo(v.z); f[5] = bfhi(v.z); f[6] = bflo(v.w); f[7] = bfhi(v.w);
}
__device__ __forceinline__ u32x4 pack8(const float (&f)[8]) { u32x4 r; r.x = pk2(f[0], f[1]); r.y = pk2(f[2], f[3]); r.z = pk2(f[4], f[5]); r.w = pk2(f[6], f[7]); return r; }
__device__ __forceinline__ float wave_sum(float v) {
#pragma unroll
    for (int o = 1; o < 64; o <<= 1) v += __shfl_xor(v, o);
    return v;
}
__device__ __forceinline__ float wave_max(float v) {
#pragma unroll
    for (int o = 1; o < 64; o <<= 1) v = fmaxf(v, __shfl_xor(v, o));
    return v;
}
__device__ __forceinline__ float silu_f(float x) { return x * __builtin_amdgcn_rcpf(1.0f + __expf(-x)); }

constexpr int HTB = 128 * 64 * 2;
__device__ __forceinline__ int lds_byte(int r, int c) { const int st = (r >> 4) * 2 + (c >> 5), rr = r & 15, cc = c & 31, ob = rr * 64 + cc * 2; return st * 1024 + (ob ^ (((ob >> 9) & 1) << 5)); }
__device__ __forceinline__ void stage_rc(int b, int& R, int& C) { const int st = b / 1024, sb = b % 1024, swz = sb ^ (((sb >> 9) & 1) << 5); R = (st >> 1) * 16 + swz / 64; C = (st & 1) * 32 + (swz % 64) / 2; }

__device__ __forceinline__ int perm32(int rho) { const int n = rho >> 4, i = rho & 15; return 8 * (i >> 2) + 4 * n + (i & 3); }
__device__ __forceinline__ int invperm32(int c) { return 16 * ((c >> 2) & 1) + 4 * (c >> 3) + (c & 3); }
enum { E_PROJ = 0, E_MEMKV, E_POOL, E_OUT, E_Q, E_QK, E_PV, E_MO, E_UP, E_DOWN, E_FOLD };

template <int EK>
__device__ __forceinline__ float epi_apply(PP P, int row, int col, f32x4 v) {
    char* ws = P->ws;
    if constexpr (EK == E_PROJ) {
        u32x2 o; o.x = pk2(v[0], v[1]); o.y = pk2(v[2], v[3]);
        if (col < 1024) *(u32x2*)((bf16_t*)(ws + W_Z) + (size_t)row * 1024 + col) = o;
        else *(u32x2*)((bf16_t*)(ws + W_PROJ2) + (size_t)row * 2560 + (col - 1024)) = o;
    } else if constexpr (EK == E_MEMKV) {
        if (col < 1024) {
            *(f32x4*)(P->out + O_MK + (size_t)row * 1024 + col) = v;
            u32x2 o; o.x = pk2(v[0], v[1]); o.y = pk2(v[2], v[3]);
            *(u32x2*)((bf16_t*)(ws + W_KB) + (size_t)((row & ~31) + invperm32(row & 31)) * 1024 + col) = o;
        } else {
            const int c = col - 1024;
            *(f32x4*)(P->out + O_MV + (size_t)row * 1024 + c) = v;
            const int b = row >> 8, m = row & 255, hh = c >> 8, d = c & 255;
            bf16_t* vt = (bf16_t*)(ws + W_VT) + ((size_t)(b * 4 + hh) * 256 + (d & ~31) + invperm32(d & 31)) * 256 + m;
#pragma unroll
            for (int j = 0; j < 4; ++j) vt[j * 256] = f2bf(v[j]);
        }
    } else if constexpr (EK == E_POOL) {
        const f32x4 sc = *(const f32x4*)(P->pool_scale + col);
        u32x2 o; o.x = pk2(v[0] * sc[0], v[1] * sc[1]); o.y = pk2(v[2] * sc[2], v[3] * sc[3]);
        *(u32x2*)((bf16_t*)(ws + W_MIX) + (size_t)row * 2048 + 1024 + col) = o;
    } else if constexpr (EK == E_OUT) {
        const float* xin = row < TP ? P->x_prompt + (size_t)row * 1024 : P->x_sample + (size_t)(row - TP) * 1024;
        const f32x4 x = *(const f32x4*)(xin + col) + v;
        u32x2 o; o.x = pk2(x[0], x[1]); o.y = pk2(x[2], x[3]);
        *(u32x2*)((bf16_t*)(ws + W_H) + (size_t)row * 1024 + col) = o;
        return (x[0] * x[0] + x[1] * x[1]) + (x[2] * x[2] + x[3] * x[3]);
    } else if constexpr (EK == E_Q) {
        u32x2 o; o.x = pk2(v[0], v[1]); o.y = pk2(v[2], v[3]);
        *(u32x2*)((bf16_t*)(ws + W_Q) + (size_t)row * 1024 + col) = o;
    } else if constexpr (EK == E_PV) {
        u32x2 o; o.x = pk2(v[0], v[1]); o.y = pk2(v[2], v[3]);
        *(u32x2*)((bf16_t*)(ws + W_O) + (size_t)row * 1024 + col) = o;
    } else if constexpr (EK == E_MO || EK == E_DOWN) {
        u32x2* hp = (u32x2*)((bf16_t*)(ws + W_H) + (size_t)row * 1024 + col);
        const u32x2 hv = *hp;
        const f32x4 x = (f32x4){bflo(hv.x), bfhi(hv.x), bflo(hv.y), bfhi(hv.y)} + v;
        u32x2 o; o.x = pk2(x[0], x[1]); o.y = pk2(x[2], x[3]);
        *hp = o;
        return (x[0] * x[0] + x[1] * x[1]) + (x[2] * x[2] + x[3] * x[3]);
    } else if constexpr (EK == E_UP) {
        u32x2 o; o.x = pk2(v[0], v[1]); o.y = pk2(v[2], v[3]);
        *(u32x2*)((bf16_t*)(ws + W_U) + (size_t)row * 5632 + col) = o;
    }
    return 0.f;
}
template <int EK>
__device__ __forceinline__ float epi_rowscale(PP P, int row) {
    if constexpr (EK == E_Q) return rsqrtf(((const float*)(P->ws + W_SS1))[row] * (1.0f / 1024.0f) + EPS) * 0.0625f;
    else if constexpr (EK == E_UP) return rsqrtf(((const float*)(P->ws + W_SS2))[row] * (1.0f / 1024.0f) + EPS);
    else return 1.0f;
}
__device__ __forceinline__ float epi_apply_rt(PP P, int ekind, int row, int col, f32x4 v) {
    switch (ekind) {
    case E_FOLD: { u32x2 o; o.x = pk2(v[0], v[1]); o.y = pk2(v[2], v[3]); const int prow = (row & ~31) + invperm32(row & 31); *(u32x2*)((bf16_t*)(P->ws + W_WOUT) + (size_t)prow * 2048 + 1024 + col) = o; return 0.f; }
    case E_OUT: return epi_apply<E_OUT>(P, row, col, v);
    case E_Q: return epi_apply<E_Q>(P, row, col, v * epi_rowscale<E_Q>(P, row));
    case E_MO: return epi_apply<E_MO>(P, row, col, v);
    default: return epi_apply<E_DOWN>(P, row, col, v);
    }
}
template <int EK>
__device__ __forceinline__ void epi_loop(PP P, const f32x4 (&acc)[2][2][4][2], int rbase, int cbase, int fq) {
    if constexpr (EK == E_PROJ || EK == E_UP || EK == E_Q || EK == E_PV || EK == E_OUT || EK == E_MO || EK == E_DOWN) {
        const int cb8 = cbase + 4 * fq;
#pragma unroll
        for (int ai = 0; ai < 2; ++ai)
#pragma unroll
            for (int m = 0; m < 4; ++m) {
                const int row = rbase + ai * 128 + m * 16;
                const float rs = epi_rowscale<EK>(P, row);
                float ss = 0.f;
#pragma unroll
                for (int bj = 0; bj < 2; ++bj) {
                    f32x4 v0 = acc[ai][bj][m][0], v1 = acc[ai][bj][m][1];
                    const int col = cb8 + bj * 128;
                    if constexpr (EK == E_PROJ || EK == E_UP || EK == E_Q) { v0 *= rs; v1 *= rs; }
                    if constexpr (EK == E_OUT) {
                        const float* xin = (row < TP ? P->x_prompt + (size_t)row * 1024 : P->x_sample + (size_t)(row - TP) * 1024) + col;
                        v0 += *(const f32x4*)xin; v1 += *(const f32x4*)(xin + 4);
                    }
                    if constexpr (EK == E_MO || EK == E_DOWN) {
                        const u32x4 hv = *(const u32x4*)((const bf16_t*)(P->ws + W_H) + (size_t)row * 1024 + col);
                        v0 += (f32x4){bflo(hv.x), bfhi(hv.x), bflo(hv.y), bfhi(hv.y)}; v1 += (f32x4){bflo(hv.z), bfhi(hv.z), bflo(hv.w), bfhi(hv.w)};
                    }
                    if constexpr (EK == E_OUT || EK == E_MO || EK == E_DOWN) ss += ((v0[0] * v0[0] + v0[1] * v0[1]) + (v0[2] * v0[2] + v0[3] * v0[3])) + ((v1[0] * v1[0] + v1[1] * v1[1]) + (v1[2] * v1[2] + v1[3] * v1[3]));
                    u32x4 o; o.x = pk2(v0[0], v0[1]); o.y = pk2(v0[2], v0[3]); o.z = pk2(v1[0], v1[1]); o.w = pk2(v1[2], v1[3]);
                    if constexpr (EK == E_UP) *(u32x4*)((bf16_t*)(P->ws + W_U) + (size_t)row * 5632 + col) = o;
                    else if constexpr (EK == E_Q) *(u32x4*)((bf16_t*)(P->ws + W_Q) + (size_t)row * 1024 + col) = o;
                    else if constexpr (EK == E_PV) *(u32x4*)((bf16_t*)(P->ws + W_O) + (size_t)row * 1024 + col) = o;
                    else if constexpr (EK == E_PROJ) { if (col < 1024) *(u32x4*)((bf16_t*)(P->ws + W_Z) + (size_t)row * 1024 + col) = o;
                           else *(u32x4*)((bf16_t*)(P->ws + W_PROJ2) + (size_t)row * 2560 + (col - 1024)) = o; }
                    else *(u32x4*)((bf16_t*)(P->ws + W_H) + (size_t)row * 1024 + col) = o;
                }
                if constexpr (EK == E_OUT || EK == E_MO || EK == E_DOWN) {
                    ss += __shfl_xor(ss, 16); ss += __shfl_xor(ss, 32);
                    if (fq == 0) unsafeAtomicAdd((float*)(P->ws + (EK == E_OUT ? W_SS1 : EK == E_MO ? W_SS2 : W_SS3)) + row, ss);
                }
            }
        return;
    }
#pragma unroll
    for (int ai = 0; ai < 2; ++ai)
#pragma unroll
        for (int m = 0; m < 4; ++m) {
            const int row = rbase + ai * 128 + m * 16;
            const float rs = epi_rowscale<EK>(P, row);
            float ss = 0.f;
#pragma unroll
            for (int bj = 0; bj < 2; ++bj)
#pragma unroll
                for (int n = 0; n < 2; ++n) {
                    if constexpr (EK == E_Q || EK == E_UP) ss += epi_apply<EK>(P, row, cbase + bj * 128 + n * 16, acc[ai][bj][m][n] * rs);
                    else ss += epi_apply<EK>(P, row, cbase + bj * 128 + n * 16, acc[ai][bj][m][n]);
                }
            if constexpr (EK == E_OUT || EK == E_MO || EK == E_DOWN) {
                ss += __shfl_xor(ss, 16); ss += __shfl_xor(ss, 32);
                if (fq == 0) unsafeAtomicAdd((float*)(P->ws + (EK == E_OUT ? W_SS1 : EK == E_MO ? W_SS2 : W_SS3)) + row, ss);
            }
        }
}

struct PhaseCfg { const char* A; const char* B; int lda, ldb, K, nbig, nsmall, ncol64, ekind; };
__device__ __forceinline__ PhaseCfg phase_cfg(PP P, int gp) {
    const char* ws = P->ws; PhaseCfg c;
    switch (gp) {
    case 1:  c.A = ws + W_H;      c.B = ws + W_WIN;   c.lda = 1024; c.ldb = 1024; c.K = 1024; c.nbig = 66 * 14 + 64; c.nsmall = 512; c.ncol64 = 16; c.ekind = E_PROJ; break;
    case 3:  c.A = ws + W_POOLED; c.B = ws + W_WPOOL; c.lda = 1024; c.ldb = 256;  c.K = 256;  c.nbig = 256; c.nsmall = 256; c.ncol64 = 16; c.ekind = E_POOL; break;
    case 5:  c.A = ws + W_MIX;    c.B = ws + W_WOUT;  c.lda = 2048; c.ldb = 2048; c.K = 2048; c.nbig = 256; c.nsmall = 256; c.ncol64 = 16; c.ekind = E_OUT; break;
    case 7:  c.A = ws + W_H;      c.B = ws + W_WMQ;   c.lda = 1024; c.ldb = 1024; c.K = 1024; c.nbig = 256; c.nsmall = 256; c.ncol64 = 16; c.ekind = E_Q; break;
    case 8:  c.A = ws + W_Q;      c.B = ws + W_KB;    c.lda = 1024; c.ldb = 1024; c.K = 256;  c.nbig = 256; c.nsmall = 0;   c.ncol64 = 16; c.ekind = E_QK; break;
    case 9:  c.A = ws + W_P;      c.B = ws + W_VT;    c.lda = 1024; c.ldb = 256;  c.K = 256;  c.nbig = 256; c.nsmall = 0;   c.ncol64 = 16; c.ekind = E_PV; break;
    case 10: c.A = ws + W_O;      c.B = ws + W_WMO;   c.lda = 1024; c.ldb = 1024; c.K = 1024; c.nbig = 256; c.nsmall = 256; c.ncol64 = 16; c.ekind = E_MO; break;
    case 12: c.A = ws + W_H;      c.B = ws + W_WUP;   c.lda = 1024; c.ldb = 1024; c.K = 1024; c.nbig = 66 * 22; c.nsmall = 0; c.ncol64 = 88; c.ekind = E_UP; break;
    default: c.A = ws + W_ACT;    c.B = ws + W_WDOWN; c.lda = 2816; c.ldb = 2816; c.K = 2816; c.nbig = 256; c.nsmall = 256; c.ncol64 = 16; c.ekind = E_DOWN; break;
    }
    return c;
}
struct UnitD { const char* A; const char* B; int row0, col0, ekind; };
__device__ __forceinline__ void map_unit(int L, int nM, int nN, int& pm, int& pn) {
    const int nwg = nM * nN, q = nwg >> 3, r = nwg & 7, xcd = L & 7, off = L >> 3;
    const int wgid = (xcd < r ? xcd * (q + 1) : r * (q + 1) + (xcd - r) * q) + off;
    const int nig = 8 * nN, gid = wgid / nig, fm = gid * 8, gsz = (nM - fm) < 8 ? (nM - fm) : 8;
    const int w = wgid - gid * nig;
    pm = fm + w % gsz; pn = w / gsz;
}
__device__ __forceinline__ UnitD unit_decode(PP P, const PhaseCfg& c, int gp, int L) {
    UnitD d; d.ekind = c.ekind;
    int pm, pn;
    switch (gp) {
    case 1:
        if (L < 924) { map_unit(L, 66, 14, pm, pn); d.A = c.A + (size_t)pm * 256 * 2048; d.B = c.B + (size_t)pn * 256 * 2048; }
        else { map_unit(L - 924, 8, 8, pm, pn); d.A = P->ws + W_HM + (size_t)pm * 256 * 2048; d.B = P->ws + W_WMK + (size_t)pn * 256 * 2048; d.ekind = E_MEMKV; }
        break;
    case 3: map_unit(L, 64, 4, pm, pn); d.A = c.A + (size_t)pm * 256 * 2048 + pn * 512; d.B = c.B + (size_t)pn * 131072; break;
    case 8: map_unit(L, 64, 4, pm, pn); d.A = c.A + (size_t)pm * 256 * 2048 + pn * 512; d.B = c.B + (size_t)(pm >> 3) * 256 * 2048 + pn * 512; break;
    case 9: map_unit(L, 64, 4, pm, pn); d.A = c.A + (size_t)pm * 256 * 2048 + pn * 512; d.B = c.B + (size_t)((pm >> 3) * 4 + pn) * 131072; break;
    case 12: map_unit(L, 66, 22, pm, pn); d.A = c.A + (size_t)pm * 256 * 2048; d.B = c.B + (size_t)pn * 256 * 2048; break;
    default: map_unit(L, 64, 4, pm, pn); d.A = c.A + (size_t)pm * 256 * c.lda * 2; d.B = c.B + (size_t)pn * 256 * c.ldb * 2; break;
    }
    d.row0 = pm * 256; d.col0 = pn * 256;
    return d;
}

__device__ __forceinline__ void gemm_phase(PP P, int gp, char* shm_g, int lb, int blk, int nblk, const int tid) {
    LDSB unsigned char* lds = (LDSB unsigned char*)shm_g;
    const int wid = __builtin_amdgcn_readfirstlane(tid >> 6), lane = tid & 63, wr = wid >> 2, wc = wid & 3, fr = lane & 15, fq = lane >> 4;
    const PhaseCfg cfg = phase_cfg(P, gp);
    const int K = cfg.K, nt = K / 64;
    unsigned voffA, voffB;
    { int R, C; stage_rc(tid * 16, R, C); voffA = (unsigned)(R * cfg.lda + C) * 2u; voffB = (unsigned)(R * cfg.ldb + C) * 2u; }
    const size_t qstepvoffA = (size_t)64 * cfg.lda * 2, qstepvoffB = (size_t)64 * cfg.ldb * 2;
    const size_t kstep = 128;
    const size_t hstepA = (size_t)128 * cfg.lda * 2, hstepB = (size_t)128 * cfg.ldb * 2;
    const unsigned ldsw = (unsigned)wid * 1024u;
    const int aoff = lds_byte(wr * 64 + fr, fq * 8), boff = lds_byte(wc * 32 + fr, fq * 8);
    const bool chain = (cfg.ekind != E_QK);
#define G_SA(b, h) (((b) * 2 + (h)) * HTB)
#define G_SB(b, h) ((4 + (b) * 2 + (h)) * HTB)
#define G_STAGE(bufoff, gbase, voff) do { \
        __builtin_amdgcn_global_load_lds((const unsigned*)((const char*)(gbase) + (voff)), (LDSB unsigned*)(lds + (bufoff) + ldsw), 16, 0, 0); \
        __builtin_amdgcn_global_load_lds((const unsigned*)((const char*)(gbase) + qstep##voff + (voff)), (LDSB unsigned*)(lds + (bufoff) + ldsw + 8192), 16, 0, 0); } while (0)
#define G_LDA(dst, b, h) do { _Pragma("unroll") for (int m = 0; m < 4; ++m) _Pragma("unroll") for (int k = 0; k < 2; ++k) dst[m][k] = *(const LDSB bf16x8*)(lds + G_SA(b, h) + aoff + m * 2048 + k * 1024); } while (0)
#define G_LDB(dst, b, h) do { _Pragma("unroll") for (int n = 0; n < 2; ++n) _Pragma("unroll") for (int k = 0; k < 2; ++k) dst[n][k] = *(const LDSB bf16x8*)(lds + G_SB(b, h) + boff + n * 2048 + k * 1024); } while (0)
#define G_MMA(ai, bj, Af, Bf) do { __builtin_amdgcn_s_setprio(1); _Pragma("unroll") for (int m = 0; m < 4; ++m) _Pragma("unroll") for (int n = 0; n < 2; ++n) _Pragma("unroll") for (int k = 0; k < 2; ++k) \
        acc[ai][bj][m][n] = __builtin_amdgcn_mfma_f32_16x16x32_bf16(Bf[n][k], Af[m][k], acc[ai][bj][m][n], 0, 0, 0); __builtin_amdgcn_s_setprio(0); } while (0)
#define G_WAIT_V(n) asm volatile("s_waitcnt vmcnt(" #n ")" ::: "memory")
#define G_WAIT_L(n) asm volatile("s_waitcnt lgkmcnt(" #n ")" ::: "memory")
#define G_BAR __builtin_amdgcn_s_barrier()
#define G_SCHED __builtin_amdgcn_sched_barrier(0)
    int u = blk;
    while (u < cfg.nbig) {
        UnitD cur = unit_decode(P, cfg, gp, u);
        f32x4 acc[2][2][4][2];
#pragma unroll
        for (int a = 0; a < 2; ++a)
#pragma unroll
            for (int b = 0; b < 2; ++b)
#pragma unroll
                for (int m = 0; m < 4; ++m)
#pragma unroll
                    for (int n = 0; n < 2; ++n) acc[a][b][m][n] = (f32x4){0.f, 0.f, 0.f, 0.f};
        bf16x8 At[4][2], B0[2][2], B1[2][2];
        const char* cA = cur.A; const char* cB = cur.B;
        G_STAGE(G_SB(0, 0), cB, voffB); G_STAGE(G_SA(0, 0), cA, voffA); G_STAGE(G_SB(0, 1), cB + hstepB, voffB); G_STAGE(G_SA(0, 1), cA + hstepA, voffA);
        if (wr == 1) G_BAR;
        G_WAIT_V(4); G_BAR;
        G_STAGE(G_SB(1, 0), cB + kstep, voffB); G_STAGE(G_SA(1, 0), cA + kstep, voffA); G_STAGE(G_SB(1, 1), cB + hstepB + kstep, voffB);
        G_WAIT_V(6); G_BAR;
        for (;;) {
            const bool has_next = chain && (u + nblk < cfg.nbig);
            UnitD nxt = cur;
            if (has_next) nxt = unit_decode(P, cfg, gp, u + nblk);
            const char* nA = nxt.A; const char* nB = nxt.B;
            for (int t = 0; t < nt; t += 2) {
                const bool last = (t == nt - 2);
                const char* a1 = cA + (size_t)(t + 1) * kstep;
                const char* a2 = last ? nA : cA + (size_t)(t + 2) * kstep; const char* b2 = last ? nB : cB + (size_t)(t + 2) * kstep;
                const char* a3 = a2 + kstep; const char* b3 = b2 + kstep;
                G_LDB(B0, 0, 0); G_SCHED; G_LDA(At, 0, 0); G_STAGE(G_SA(1, 1), a1 + hstepA, voffA);
                G_WAIT_L(8); G_BAR; G_WAIT_L(0); G_MMA(0, 0, At, B0); G_BAR; G_SCHED;
                G_LDB(B1, 0, 1); G_STAGE(G_SB(0, 0), b2, voffB);
                G_BAR; G_WAIT_L(0); G_MMA(0, 1, At, B1); G_BAR;
                G_LDA(At, 0, 1); G_STAGE(G_SA(0, 0), a2, voffA);
                G_BAR; G_WAIT_L(0); G_MMA(1, 0, At, B0); G_BAR; G_SCHED;
                G_STAGE(G_SB(0, 1), b2 + hstepB, voffB);
                G_WAIT_V(6); G_BAR; G_MMA(1, 1, At, B1); G_BAR;
                G_LDB(B0, 1, 0); G_SCHED; G_LDA(At, 1, 0); G_STAGE(G_SA(0, 1), a2 + hstepA, voffA);
                G_WAIT_L(8); G_BAR; G_WAIT_L(0); G_MMA(0, 0, At, B0); G_BAR; G_SCHED;
                G_LDB(B1, 1, 1); G_STAGE(G_SB(1, 0), b3, voffB);
                G_BAR; G_WAIT_L(0); G_MMA(0, 1, At, B1); G_BAR;
                G_LDA(At, 1, 1); G_STAGE(G_SA(1, 0), a3, voffA);
                G_BAR; G_WAIT_L(0); G_MMA(1, 0, At, B0); G_BAR; G_SCHED;
                G_STAGE(G_SB(1, 1), b3 + hstepB, voffB);
                G_WAIT_V(6); G_BAR; G_MMA(1, 1, At, B1); G_BAR;
            }
            if (chain) {
                const int rbase = cur.row0 + wr * 64 + fr, cbase = cur.col0 + wc * 32 + fq * 4;
                switch (cur.ekind) {
                case E_PROJ: epi_loop<E_PROJ>(P, acc, rbase, cbase, fq); break;
                case E_MEMKV: epi_loop<E_MEMKV>(P, acc, rbase, cbase, fq); break;
                case E_POOL: epi_loop<E_POOL>(P, acc, rbase, cbase, fq); break;
                case E_OUT: epi_loop<E_OUT>(P, acc, rbase, cbase, fq); break;
                case E_Q: epi_loop<E_Q>(P, acc, rbase, cbase, fq); break;
                case E_PV: epi_loop<E_PV>(P, acc, rbase, cbase, fq); break;
                case E_MO: epi_loop<E_MO>(P, acc, rbase, cbase, fq); break;
                case E_UP: epi_loop<E_UP>(P, acc, rbase, cbase, fq); break;
                default: epi_loop<E_DOWN>(P, acc, rbase, cbase, fq); break;
                }
            }
            if (!has_next) break;
#pragma unroll
            for (int a = 0; a < 2; ++a)
#pragma unroll
                for (int b = 0; b < 2; ++b)
#pragma unroll
                    for (int m = 0; m < 4; ++m)
#pragma unroll
                        for (int n = 0; n < 2; ++n) acc[a][b][m][n] = (f32x4){0.f, 0.f, 0.f, 0.f};
            cur = nxt; cA = nA; cB = nB; u += nblk;
        }
        G_WAIT_V(0);
        if (wr == 0) G_BAR;
        G_BAR;
        if (!chain) {
            float* redm = (float*)(shm_g + 131072);
            float* reds = (float*)(shm_g + 135168);
#pragma unroll
            for (int ai = 0; ai < 2; ++ai)
#pragma unroll
                for (int m = 0; m < 4; ++m) {
                    float t = -3.0e38f;
#pragma unroll
                    for (int bj = 0; bj < 2; ++bj)
#pragma unroll
                        for (int n = 0; n < 2; ++n)
#pragma unroll
                            for (int j = 0; j < 4; ++j) t = fmaxf(t, acc[ai][bj][m][n][j]);
                    t = fmaxf(t, __shfl_xor(t, 16)); t = fmaxf(t, __shfl_xor(t, 32));
                    if (fq == 0) redm[(ai * 128 + wr * 64 + m * 16 + fr) * 4 + wc] = t;
                }
            __syncthreads();
#pragma unroll
            for (int ai = 0; ai < 2; ++ai)
#pragma unroll
                for (int m = 0; m < 4; ++m) {
                    const f32x4 r = *(const f32x4*)(redm + (ai * 128 + wr * 64 + m * 16 + fr) * 4);
                    const float M = fmaxf(fmaxf(r[0], r[1]), fmaxf(r[2], r[3]));
                    float s = 0.f;
#pragma unroll
                    for (int bj = 0; bj < 2; ++bj)
#pragma unroll
                        for (int n = 0; n < 2; ++n)
#pragma unroll
                            for (int j = 0; j < 4; ++j) { const float e = __expf(acc[ai][bj][m][n][j] - M); acc[ai][bj][m][n][j] = e; s += e; }
                    s += __shfl_xor(s, 16); s += __shfl_xor(s, 32);
                    if (fq == 0) reds[(ai * 128 + wr * 64 + m * 16 + fr) * 4 + wc] = s;
                }
            __syncthreads();
#pragma unroll
            for (int ai = 0; ai < 2; ++ai)
#pragma unroll
                for (int m = 0; m < 4; ++m) {
                    const int rl = ai * 128 + wr * 64 + m * 16 + fr;
                    const f32x4 r = *(const f32x4*)(reds + rl * 4);
                    const float inv = 1.0f / ((r[0] + r[1]) + (r[2] + r[3]));
                    bf16_t* prow = (bf16_t*)(P->ws + W_P) + (size_t)(cur.row0 + rl) * 1024 + cur.col0;
#pragma unroll
                    for (int bj = 0; bj < 2; ++bj) {
                        const f32x4 v0 = acc[ai][bj][m][0], v1 = acc[ai][bj][m][1];
                        u32x4 o; o.x = pk2(v0[0] * inv, v0[1] * inv); o.y = pk2(v0[2] * inv, v0[3] * inv); o.z = pk2(v1[0] * inv, v1[1] * inv); o.w = pk2(v1[2] * inv, v1[3] * inv);
                        *(u32x4*)(prow + bj * 128 + wc * 32 + fq * 8) = o;
                    }
                }
            __syncthreads();
        }
        u += nblk;
    }
#undef G_SA
#undef G_SB
#undef G_STAGE
#undef G_LDA
#undef G_LDB
#undef G_MMA
    const int rot = cfg.nbig % nblk;
    for (int s0 = (lb - rot + nblk) % nblk; s0 < cfg.nsmall; s0 += nblk) {
        const int pr = s0 / cfg.ncol64, pc = s0 % cfg.ncol64;
        const int row0 = (gp == 1 ? 0 : TP) + pr * 32, col0 = pc * 64;
        int lda_s = cfg.lda, ldb_s = cfg.ldb, K_s = K, ek_s = cfg.ekind;
        const bf16_t* Ab; const bf16_t* Bb;
        if (gp == 1) {
            const int g = pc >> 2; lda_s = 1024; ldb_s = 256; K_s = 256; ek_s = E_FOLD;
            Ab = (const bf16_t*)(P->ws + W_WLO) + (size_t)row0 * 1024 + g * 256; Bb = (const bf16_t*)(P->ws + W_WPOOL) + (size_t)g * 65536 + (size_t)(col0 - g * 256) * 256;
        } else { Ab = (const bf16_t*)cfg.A + (size_t)row0 * cfg.lda; Bb = (const bf16_t*)cfg.B + (size_t)col0 * cfg.ldb; }
        const int kw = K_s >> 3, nks = kw >> 5;
        f32x4 acc[2][4];
#pragma unroll
        for (int mi = 0; mi < 2; ++mi)
#pragma unroll
            for (int ni = 0; ni < 4; ++ni) acc[mi][ni] = (f32x4){0.f, 0.f, 0.f, 0.f};
        const bf16_t* ap = Ab + (size_t)fr * lda_s + wid * kw + fq * 8;
        const bf16_t* bp = Bb + (size_t)fr * ldb_s + wid * kw + fq * 8;
        for (int ks0 = 0; ks0 < nks; ks0 += 4) {
            bf16x8 a[4][2], b[4][4];
#pragma unroll
            for (int q = 0; q < 4; ++q) {
                const bool ok = ks0 + q < nks;
#pragma unroll
                for (int mi = 0; mi < 2; ++mi) { bf16x8 z = {0, 0, 0, 0, 0, 0, 0, 0}; if (ok) z = *(const bf16x8*)(ap + (size_t)mi * 16 * lda_s + (ks0 + q) * 32); a[q][mi] = z; }
#pragma unroll
                for (int ni = 0; ni < 4; ++ni) { bf16x8 z = {0, 0, 0, 0, 0, 0, 0, 0}; if (ok) z = *(const bf16x8*)(bp + (size_t)ni * 16 * ldb_s + (ks0 + q) * 32); b[q][ni] = z; }
            }
#pragma unroll
            for (int q = 0; q < 4; ++q)
#pragma unroll
                for (int mi = 0; mi < 2; ++mi)
#pragma unroll
                    for (int ni = 0; ni < 4; ++ni) acc[mi][ni] = __builtin_amdgcn_mfma_f32_16x16x32_bf16(b[q][ni], a[q][mi], acc[mi][ni], 0, 0, 0);
        }
        float* red = (float*)shm_g;
#pragma unroll
        for (int mi = 0; mi < 2; ++mi)
#pragma unroll
            for (int ni = 0; ni < 4; ++ni) *(f32x4*)(red + wid * 2048 + (mi * 16 + fr) * 64 + ni * 16 + fq * 4) = acc[mi][ni];
        __syncthreads();
        {
            const int r = tid >> 4, c = (tid & 15) * 4;
            f32x4 v = *(const f32x4*)(red + r * 64 + c);
#pragma unroll
            for (int w = 1; w < 8; ++w) v += *(const f32x4*)(red + w * 2048 + r * 64 + c);
            const int cl = (gp == 1) ? c : (c & 32) + perm32(c & 31);
            float ss = epi_apply_rt(P, ek_s, row0 + r, col0 + cl, v);
            if (cfg.ekind == E_OUT || cfg.ekind == E_MO || cfg.ekind == E_DOWN) {
                ss += __shfl_xor(ss, 1); ss += __shfl_xor(ss, 2); ss += __shfl_xor(ss, 4); ss += __shfl_xor(ss, 8);
                if ((tid & 15) == 0) unsafeAtomicAdd((float*)(P->ws + (cfg.ekind == E_OUT ? W_SS1 : cfg.ekind == E_MO ? W_SS2 : W_SS3)) + row0 + r, ss);
            }
        }
        __syncthreads();
    }
}

struct TrDesc { const float* src; bf16_t* dst; const float* gain; int ld_src, ld_dst, k0, n0s, n0d, perm; };
__device__ __forceinline__ TrDesc tr_decode(PP P, int i) {
    char* ws = P->ws; TrDesc d; d.gain = nullptr; d.perm = 0;
    if (i < 896) { const int kt = i / 56, ntl = i % 56; d.n0d = ntl * 64; d.n0s = d.n0d < 2560 ? d.n0d : d.n0d + 16; d.src = P->w_in; d.ld_src = 3600; d.dst = (bf16_t*)(ws + W_WIN); d.ld_dst = 1024; d.k0 = kt * 64; d.perm = 1; return d; }
    i -= 896;
    if (i < 512) { const int kt = i >> 4, ntl = i & 15; d.ld_src = 1024; d.n0s = d.n0d = ntl * 64;
        d.perm = kt < 16 ? 1 : 0;
        if (kt < 16) { d.src = P->w_out; d.dst = (bf16_t*)(ws + W_WOUT); d.ld_dst = 2048; d.k0 = kt * 64; }
        else { d.src = P->w_out + (size_t)1024 * 1024; d.dst = (bf16_t*)(ws + W_WLO); d.ld_dst = 1024; d.k0 = (kt - 16) * 64; }
        return d; }
    i -= 512;
    if (i < 1024) { const int wsel = i >> 8, r = i & 255, kt = r >> 4, ntl = r & 15;
        d.src = wsel == 0 ? P->w_mq : wsel == 1 ? P->w_mk : wsel == 2 ? P->w_mv : P->w_mo;
        d.dst = (bf16_t*)(ws + (wsel == 0 ? W_WMQ : wsel == 1 ? W_WMK : wsel == 2 ? W_WMV : W_WMO));
        d.gain = wsel == 0 ? P->norm_mem : nullptr; d.ld_src = 1024; d.ld_dst = 1024; d.k0 = kt * 64; d.n0s = d.n0d = ntl * 64; d.perm = (wsel == 0 || wsel == 3) ? 1 : 0; return d; }
    i -= 1024;
    if (i < 1408) { const int kt = i / 88, ntl = i % 88; d.src = P->w_up; d.ld_src = 5632; d.dst = (bf16_t*)(ws + W_WUP); d.ld_dst = 1024; d.gain = P->norm_ffn; d.k0 = kt * 64; d.n0s = d.n0d = ntl * 64; d.perm = 1; return d; }
    i -= 1408;
    { const int kt = i >> 4, ntl = i & 15; d.src = P->w_down; d.ld_src = 1024; d.dst = (bf16_t*)(ws + W_WDOWN); d.ld_dst = 2816; d.k0 = kt * 64; d.n0s = d.n0d = ntl * 64; d.perm = 1; return d; }
}

__device__ __forceinline__ void phase_prep(PP P, char* shm, int blk, int nblk, const int tid) {
    const int wid = tid >> 6, lane = tid & 63;
    float* tiles = (float*)shm;
    float* wdt = (float*)(shm + 69632);
    for (int i = blk * NTHR + tid; i < 3 * TT; i += nblk * NTHR) ((float*)(P->ws + W_SS1))[i] = 0.f;
    for (int i = (blk * NTHR + tid) * 4; i < 4 * 65536; i += nblk * NTHR * 4) {
        const f32x4 wv = *(const f32x4*)(P->w_pool + i), sv = *(const f32x4*)(P->pool_scale + (i >> 16) * 256 + (i & 255));
        u32x2 o; o.x = pk2(wv[0] * sv[0], wv[1] * sv[1]); o.y = pk2(wv[2] * sv[2], wv[3] * sv[3]);
        *(u32x2*)((bf16_t*)(P->ws + W_WPOOL) + i) = o;
    }
    for (int i = tid; i < 1024 * 16; i += NTHR) { const int k = i >> 4, hd = i & 15; wdt[hd * 1024 + k] = P->w_in[(size_t)k * 3600 + 2560 + hd]; }
    __syncthreads();
    char* ws = P->ws;
    constexpr int NGRP = (TT + 2048) / 32;
    for (int it = blk; it < NGRP; it += nblk) {
        const int rbase = it * 32 + wid * 4;
        const bool ismem = rbase >= TT;
        f32x4 xv[4][4];
#pragma unroll
        for (int r = 0; r < 4; ++r) {
            const int row = (ismem ? rbase - TT : rbase) + r;
            const float* xr = ismem ? P->mem_prompt + (size_t)row * 1024 : (row < TP ? P->x_prompt + (size_t)row * 1024 : P->x_sample + (size_t)(row - TP) * 1024);
#pragma unroll
            for (int j = 0; j < 4; ++j) xv[r][j] = __builtin_nontemporal_load((const f32x4*)(xr + j * 256 + lane * 4));
        }
        const float* gg = ismem ? P->norm_memkv : P->norm_mix;
#pragma unroll
        for (int r = 0; r < 4; ++r) {
            const int row = (ismem ? rbase - TT : rbase) + r;
            bf16_t* orow = (bf16_t*)(ws + (ismem ? W_HM : W_H)) + (size_t)row * 1024;
            float ss = 0.f;
#pragma unroll
            for (int j = 0; j < 4; ++j) ss += xv[r][j][0] * xv[r][j][0] + xv[r][j][1] * xv[r][j][1] + xv[r][j][2] * xv[r][j][2] + xv[r][j][3] * xv[r][j][3];
            ss = wave_sum(ss);
            const float rstd = rsqrtf(ss * (1.0f / 1024.0f) + EPS);
#pragma unroll
            for (int j = 0; j < 4; ++j) { const f32x4 g4 = *(const f32x4*)(gg + j * 256 + lane * 4); xv[r][j] = xv[r][j] * rstd * g4;
                u32x2 o; o.x = pk2(xv[r][j][0], xv[r][j][1]); o.y = pk2(xv[r][j][2], xv[r][j][3]); *(u32x2*)(orow + j * 256 + lane * 4) = o; }
        }
        if (!ismem) {
            float vals[64];
#pragma unroll
            for (int hd = 0; hd < 16; ++hd) {
                f32x4 w4[4];
#pragma unroll
                for (int j = 0; j < 4; ++j) w4[j] = *(const f32x4*)(wdt + hd * 1024 + j * 256 + lane * 4);
#pragma unroll
                for (int r = 0; r < 4; ++r) {
                    float a = 0.f;
#pragma unroll
                    for (int j = 0; j < 4; ++j) a += xv[r][j][0] * w4[j][0] + xv[r][j][1] * w4[j][1] + xv[r][j][2] * w4[j][2] + xv[r][j][3] * w4[j][3];
                    vals[r * 16 + hd] = a;
                }
            }
#pragma unroll
            for (int half = 32; half >= 1; half >>= 1) {
                const bool hi = (lane & half) != 0;
#pragma unroll
                for (int i = 0; i < half; ++i) {
                    const float keep = hi ? vals[i + half] : vals[i], send = hi ? vals[i] : vals[i + half];
                    vals[i] = keep + __shfl_xor(send, half);
                }
            }
            const float x = vals[0] + P->dt_bias[lane & 15];
            const float ey = __expf(-fabsf(x)); const float l1p = ey < 0.03f ? ey * (1.0f - ey * (0.5f - ey * (0.33333333f - 0.25f * ey))) : __logf(1.0f + ey);
            ((float*)(ws + W_DT))[(size_t)rbase * 16 + lane] = fmaxf(x, 0.f) + l1p;
        }
    }
    __syncthreads();
    const int kr = tid >> 4, nc = (tid & 15) * 4, tn = tid >> 3, tk8 = (tid & 7) * 8;
    for (int it = blk; it < 4544; it += 4 * nblk) {
        f32x4 v[4][2];
#pragma unroll
        for (int q = 0; q < 4; ++q) {
            const int i = it + q * nblk;
            if (i < 4544) { const TrDesc d = tr_decode(P, i);
#pragma unroll
                for (int h = 0; h < 2; ++h) { const int k = kr + h * 32; f32x4 t = __builtin_nontemporal_load((const f32x4*)(d.src + (size_t)(d.k0 + k) * d.ld_src + d.n0s + nc)); if (d.gain) t *= d.gain[d.k0 + k]; v[q][h] = t; } }
        }
#pragma unroll
        for (int q = 0; q < 4; ++q) {
            if (it + q * nblk < 4544) { float* tile = tiles + q * (64 * 65);
#pragma unroll
                for (int h = 0; h < 2; ++h) { const int k = kr + h * 32; tile[k * 65 + nc + 0] = v[q][h][0]; tile[k * 65 + nc + 1] = v[q][h][1]; tile[k * 65 + nc + 2] = v[q][h][2]; tile[k * 65 + nc + 3] = v[q][h][3]; } }
        }
        __syncthreads();
#pragma unroll
        for (int q = 0; q < 4; ++q) {
            const int i = it + q * nblk;
            if (i < 4544) { const TrDesc d = tr_decode(P, i); const float* tile = tiles + q * (64 * 65); float f[8];
                const int sc = d.perm ? (tn & 32) + perm32(tn & 31) : tn;
#pragma unroll
                for (int e2 = 0; e2 < 8; ++e2) f[e2] = tile[(tk8 + e2) * 65 + sc];
                *(u32x4*)(d.dst + (size_t)(d.n0d + tn) * d.ld_dst + d.k0 + tk8) = pack8(f); }
        }
        __syncthreads();
    }
}

__device__ __forceinline__ u32x4 ld8(const bf16_t* p) { return *(const u32x4*)p; }

__device__ __forceinline__ void phase_convpool(PP P, int gtid, int nthreads) {
    char* ws = P->ws;
    const bf16_t* proj2 = (const bf16_t*)(ws + W_PROJ2);
    bf16_t* xact = (bf16_t*)(ws + W_XACT);
    bf16_t* pooled = (bf16_t*)(ws + W_POOLED);
    for (int idx = gtid; idx < 1152 * 320; idx += nthreads) {
        const int run = idx / 320, cg = idx % 320;
        const bool samp = run >= 1024;
        int t0, len, bidx, tl0;
        if (!samp) { t0 = run * 16; len = 16; bidx = t0 >> 11; tl0 = t0 & 2047; } else { bidx = run - 1024; t0 = TP + bidx * 4; len = 4; tl0 = 0; }
        if (cg < 192) {
            const int c0 = cg * 8;
            float w0[8], w1[8], w2[8], w3[8], bs[8], h0[8], h1[8], h2[8];
#pragma unroll
            for (int e = 0; e < 8; ++e) { w0[e] = P->conv_w[c0 + e]; w1[e] = P->conv_w[1536 + c0 + e]; w2[e] = P->conv_w[3072 + c0 + e]; w3[e] = P->conv_w[4608 + c0 + e]; bs[e] = P->conv_b[c0 + e]; }
            if (samp) {
#pragma unroll
                for (int e = 0; e < 8; ++e) { h0[e] = P->state_conv[(size_t)(bidx * 3 + 0) * 1536 + c0 + e]; h1[e] = P->state_conv[(size_t)(bidx * 3 + 1) * 1536 + c0 + e]; h2[e] = P->state_conv[(size_t)(bidx * 3 + 2) * 1536 + c0 + e]; }
            } else if (tl0 > 0) {
                unpack8(ld8(proj2 + (size_t)(t0 - 3) * 2560 + c0), h0); unpack8(ld8(proj2 + (size_t)(t0 - 2) * 2560 + c0), h1); unpack8(ld8(proj2 + (size_t)(t0 - 1) * 2560 + c0), h2);
            } else {
#pragma unroll
                for (int e = 0; e < 8; ++e) { h0[e] = 0.f; h1[e] = 0.f; h2[e] = 0.f; }
            }
            u32x4 rx[16];
#pragma unroll
            for (int j = 0; j < 16; ++j) { if (j < len) rx[j] = __builtin_nontemporal_load((const u32x4*)(proj2 + (size_t)(t0 + j) * 2560 + c0)); }
#pragma unroll
            for (int j = 0; j < 16; ++j) {
                if (j < len) {
                float x3[8], y[8]; unpack8(rx[j], x3);
#pragma unroll
                for (int e = 0; e < 8; ++e) { const float v = bs[e] + w0[e] * h0[e] + w1[e] * h1[e] + w2[e] * h2[e] + w3[e] * x3[e]; y[e] = silu_f(v); }
                *(u32x4*)(xact + (size_t)(t0 + j) * 1536 + c0) = pack8(y);
                if (samp) { if (j >= 1) { float* o = P->out + O_CONVS + (size_t)(bidx * 3 + j - 1) * 1536 + c0;
#pragma unroll
                        for (int e = 0; e < 8; ++e) o[e] = x3[e]; } }
                else { const int tl = tl0 + j; if (tl >= 2045) { float* o = P->out + O_CONVP + (size_t)(bidx * 3 + tl - 2045) * 1536 + c0;
#pragma unroll
                        for (int e = 0; e < 8; ++e) o[e] = x3[e]; } }
#pragma unroll
                for (int e = 0; e < 8; ++e) { h0[e] = h1[e]; h1[e] = h2[e]; h2[e] = x3[e]; }
                }
            }
        } else {
            const int c0 = (cg - 192) * 8; const int win = 2 << (c0 >> 8);
            const bf16_t* vp = proj2 + 1536 + c0;
            const float* prev = P->state_pool + (size_t)bidx * 15 * 1024 + c0;
            float sum[8];
#pragma unroll
            for (int e = 0; e < 8; ++e) sum[e] = 0.f;
            if (samp) {
                for (int jj = 1; jj < win; ++jj) {
#pragma unroll
                    for (int e = 0; e < 8; ++e) sum[e] += prev[(size_t)(15 - jj) * 1024 + e]; }
                float* o = P->out + O_POOLS + (size_t)bidx * 15 * 1024 + c0;
                for (int i = 0; i < 11; ++i) {
#pragma unroll
                    for (int e = 0; e < 8; ++e) o[(size_t)i * 1024 + e] = prev[(size_t)(i + 4) * 1024 + e]; }
            } else if (tl0 > 0) {
                for (int jj = 1; jj < win; ++jj) { float v[8]; unpack8(ld8(vp + (size_t)(t0 - jj) * 2560), v);
#pragma unroll
                    for (int e = 0; e < 8; ++e) sum[e] += v[e]; }
            }
            u32x4 rp[16];
#pragma unroll
            for (int j = 0; j < 16; ++j) { if (j < len) rp[j] = ld8(vp + (size_t)(t0 + j) * 2560); }
#pragma unroll
            for (int j = 0; j < 16; ++j) {
                if (j >= len) continue;
                float v[8], o8[8]; unpack8(rp[j], v);
                const int tl = tl0 + j;
                const float inv = 1.0f / (float)(samp ? win : (tl + 1 < win ? tl + 1 : win));
#pragma unroll
                for (int e = 0; e < 8; ++e) { sum[e] += v[e]; o8[e] = sum[e] * inv - v[e]; }
                *(u32x4*)((bf16_t*)(ws + W_MIX) + (size_t)(t0 + j) * 2048 + 1024 + c0) = pack8(o8);
                const int to = j - win + 1;
                if (samp) {
                    if (to >= 0) { float q[8]; unpack8(ld8(vp + (size_t)(t0 + to) * 2560), q);
#pragma unroll
                        for (int e = 0; e < 8; ++e) sum[e] -= q[e]; }
                    else {
#pragma unroll
                        for (int e = 0; e < 8; ++e) sum[e] -= prev[(size_t)(15 + to) * 1024 + e]; }
                    float* o = P->out + O_POOLS + (size_t)(bidx * 15 + 11 + j) * 1024 + c0;
#pragma unroll
                    for (int e = 0; e < 8; ++e) o[e] = v[e];
                } else {
                    if (tl0 + to >= 0) { float q[8]; unpack8(ld8(vp + (size_t)(t0 + to) * 2560), q);
#pragma unroll
                        for (int e = 0; e < 8; ++e) sum[e] -= q[e]; }
                    if (tl >= 2033) { float* o = P->out + O_POOLP + (size_t)(bidx * 15 + tl - 2033) * 1024 + c0;
#pragma unroll
                        for (int e = 0; e < 8; ++e) o[e] = v[e]; }
                }
            }
        }
    }
}

constexpr int CS_STR = 136;
constexpr int X_STR = 40;
__device__ __forceinline__ s16x4 tr_read(const bf16_t* p) { return __builtin_bit_cast(s16x4, __builtin_amdgcn_ds_read_tr16_b64_v4i16((LDSB s16x4*)p)); }

#define LDS_BARRIER() asm volatile("s_waitcnt lgkmcnt(0)\n\ts_barrier" ::: "memory")
__device__ __forceinline__ void ssd_prompt(PP P, int item, char* shm, const int tid) {
    const int w = tid >> 6, lane = tid & 63, fr = lane & 15, fq = lane >> 4;
    const int b = item >> 5, hd = (item >> 1) & 15, ph = item & 1, g = hd >> 3;
    const float a = -expf(P->a_log[hd]);
    const float Dh = P->ssm_d[hd];
    char* ws = P->ws;
    const bf16_t* xact = (const bf16_t*)(ws + W_XACT);
    const float* dtb = (const float*)(ws + W_DT);
    bf16_t* ybuf = (bf16_t*)(ws + W_Y);
    bf16_t* Cs = (bf16_t*)(shm);
    bf16_t* Bs = (bf16_t*)(shm + 34816);
    bf16_t* Xd = (bf16_t*)(shm + 69632);
    bf16_t* X2 = (bf16_t*)(shm + 69632 + 10240);
    bf16_t* Ht = (bf16_t*)(shm + 69632 + 20480);
    float* acs = (float*)(shm + 69632 + 30720);
    float* dts = (float*)(shm + 69632 + 31232);
    f32x4 Hacc[2];
    Hacc[0] = (f32x4){0.f, 0.f, 0.f, 0.f}; Hacc[1] = (f32x4){0.f, 0.f, 0.f, 0.f};
    const int q4 = fr >> 2, p4 = fr & 3;
    u32x4 pc[4], pb[4], px; float pd0, pd1;
    const int ls = tid >> 4, ln8 = (tid & 15) * 8;
    const int xs = tid >> 2, xp8 = (tid & 3) * 8;
#define SSD_PREFETCH(cc) do { const int _t0 = b * 2048 + (cc) * 128; \
        _Pragma("unroll") for (int i = 0; i < 4; ++i) { const bf16_t* src = xact + (size_t)(_t0 + ls + i * 32) * 1536 + g * 128 + ln8; pc[i] = *(const u32x4*)(src + 1280); pb[i] = *(const u32x4*)(src + 1024); } \
        px = *(const u32x4*)(xact + (size_t)(_t0 + xs) * 1536 + hd * 64 + ph * 32 + xp8); \
        pd0 = dtb[(size_t)(_t0 + 2 * lane) * 16 + hd]; pd1 = dtb[(size_t)(_t0 + 2 * lane + 1) * 16 + hd]; } while (0)
    SSD_PREFETCH(0);
    for (int c = 0; c < 16; ++c) {
        const int t0 = b * 2048 + c * 128;
        if (w == 0) {
            const float d0 = pd0, d1 = pd1;
            const float s = (d0 + d1) * a; float v = s;
#pragma unroll
            for (int off = 1; off < 64; off <<= 1) { const float t = __shfl_up(v, off); if (lane >= off) v += t; }
            const float excl = v - s;
            acs[2 * lane] = excl + d0 * a; acs[2 * lane + 1] = v; dts[2 * lane] = d0; dts[2 * lane + 1] = d1;
        }
#pragma unroll
        for (int pt = 0; pt < 2; ++pt) { u32x2 o; o.x = pk2(Hacc[pt][0], Hacc[pt][1]); o.y = pk2(Hacc[pt][2], Hacc[pt][3]); *(u32x2*)(Ht + (w * 16 + fr) * X_STR + pt * 16 + fq * 4) = o; }
#pragma unroll
        for (int i = 0; i < 4; ++i) { *(u32x4*)(Cs + (ls + i * 32) * CS_STR + ln8) = pc[i]; *(u32x4*)(Bs + (ls + i * 32) * CS_STR + ln8) = pb[i]; }
        LDS_BARRIER();
        {
            float x[8], xa[8], xb[8]; unpack8(px, x);
            const float dtv = dts[xs], dec = __expf(acs[127] - acs[xs]) * dtv;
#pragma unroll
            for (int e = 0; e < 8; ++e) { xa[e] = x[e] * dtv; xb[e] = x[e] * dec; }
            *(u32x4*)(Xd + xs * X_STR + xp8) = pack8(xa);
            *(u32x4*)(X2 + xs * X_STR + xp8) = pack8(xb);
        }
        if (c < 15) SSD_PREFETCH(c + 1);
        bf16x8 Cf[4];
#pragma unroll
        for (int kk = 0; kk < 4; ++kk) Cf[kk] = *(const bf16x8*)(Cs + (w * 16 + fr) * CS_STR + kk * 32 + fq * 8);
        const int lrow = w * 16 + fr; const float al = acs[lrow];
        bf16x8 Gf[4];
#pragma unroll
        for (int kk = 0; kk < 4; ++kk) {
            u32x2 half[2];
#pragma unroll
            for (int hh = 0; hh < 2; ++hh) {
                const int st = 2 * kk + hh;
                half[hh].x = 0u; half[hh].y = 0u;
                if (st <= w) {
                    f32x4 ga = (f32x4){0.f, 0.f, 0.f, 0.f};
#pragma unroll
                    for (int k2 = 0; k2 < 4; ++k2) { const bf16x8 Bf = *(const bf16x8*)(Bs + (st * 16 + fr) * CS_STR + k2 * 32 + fq * 8); ga = __builtin_amdgcn_mfma_f32_16x16x32_bf16(Bf, Cf[k2], ga, 0, 0, 0); }
                    const int s0 = st * 16 + fq * 4; const f32x4 as4 = *(const f32x4*)(acs + s0);
                    float gv[4];
#pragma unroll
                    for (int j = 0; j < 4; ++j) gv[j] = (s0 + j <= lrow) ? ga[j] * __expf(al - as4[j]) : 0.f;
                    half[hh].x = pk2(gv[0], gv[1]); half[hh].y = pk2(gv[2], gv[3]);
                }
            }
            u32x4 g4; g4.x = half[0].x; g4.y = half[0].y; g4.z = half[1].x; g4.w = half[1].y;
            Gf[kk] = __builtin_bit_cast(bf16x8, g4);
        }
        LDS_BARRIER();
        {
            f32x4 Yd[2], Yo[2];
            Yd[0] = Yd[1] = Yo[0] = Yo[1] = (f32x4){0.f, 0.f, 0.f, 0.f};
            const int nkk = (w >> 1) + 1;
#pragma unroll
            for (int kk = 0; kk < 4; ++kk) {
                if (kk < nkk) {
#pragma unroll
                    for (int pt = 0; pt < 2; ++pt) {
                        const bf16_t* base = Xd + (kk * 32 + fq * 4 + q4) * X_STR + pt * 16 + p4 * 4;
                        bf16x8 Xf; Xf.lo = tr_read(base); Xf.hi = tr_read(base + 16 * X_STR);
                        Yd[pt] = __builtin_amdgcn_mfma_f32_16x16x32_bf16(Xf, Gf[kk], Yd[pt], 0, 0, 0);
                    }
                }
            }
#pragma unroll
            for (int kk = 0; kk < 4; ++kk)
#pragma unroll
                for (int pt = 0; pt < 2; ++pt) {
                    const bf16_t* hbp = Ht + (kk * 32 + fq * 8 + q4) * X_STR + pt * 16 + p4 * 4;
                    bf16x8 Hf; Hf.lo = tr_read(hbp); Hf.hi = tr_read(hbp + 4 * X_STR);
                    Yo[pt] = __builtin_amdgcn_mfma_f32_16x16x32_bf16(Hf, Cf[kk], Yo[pt], 0, 0, 0);
                }
            const float el = __expf(al); const float rdt = Dh / dts[lrow];
#pragma unroll
            for (int pt = 0; pt < 2; ++pt) {
                const u32x2 xr = *(const u32x2*)(Xd + lrow * X_STR + pt * 16 + fq * 4);
                const f32x4 y = Yd[pt] + el * Yo[pt] + rdt * (f32x4){bflo(xr.x), bfhi(xr.x), bflo(xr.y), bfhi(xr.y)};
                u32x2 o; o.x = pk2(y[0], y[1]); o.y = pk2(y[2], y[3]);
                *(u32x2*)(ybuf + (size_t)(t0 + lrow) * 1024 + hd * 64 + ph * 32 + pt * 16 + fq * 4) = o;
            }
        }
        {
            const float dc = __expf(acs[127]);
            Hacc[0] *= dc; Hacc[1] *= dc;
#pragma unroll
            for (int kk = 0; kk < 4; ++kk) {
                const bf16_t* bb = Bs + (kk * 32 + fq * 8 + q4) * CS_STR + w * 16 + p4 * 4;
                bf16x8 Bf; Bf.lo = tr_read(bb); Bf.hi = tr_read(bb + 4 * CS_STR);
#pragma unroll
                for (int pt = 0; pt < 2; ++pt) {
                    const bf16_t* xb = X2 + (kk * 32 + fq * 8 + q4) * X_STR + pt * 16 + p4 * 4;
                    bf16x8 Xf; Xf.lo = tr_read(xb); Xf.hi = tr_read(xb + 4 * X_STR);
                    Hacc[pt] = __builtin_amdgcn_mfma_f32_16x16x32_bf16(Xf, Bf, Hacc[pt], 0, 0, 0);
                }
            }
        }
        LDS_BARRIER();
    }
#undef SSD_PREFETCH
    float* so = P->out + O_SSMP + ((size_t)(b * 16 + hd) * 64 + ph * 32) * 128;
#pragma unroll
    for (int pt = 0; pt < 2; ++pt)
#pragma unroll
        for (int j = 0; j < 4; ++j) so[(size_t)(pt * 16 + fq * 4 + j) * 128 + w * 16 + fr] = Hacc[pt][j];
}

template <int NI>
__device__ __forceinline__ void ssd_sample(PP P, int item0, int istride, const int tid) {
    const int p = tid >> 3, n0 = (tid & 7) * 16;
    char* ws = P->ws;
    const bf16_t* xact = (const bf16_t*)(ws + W_XACT);
    const float* dtb = (const float*)(ws + W_DT);
    bf16_t* ybuf = (bf16_t*)(ws + W_Y);
    f32x4 hs[NI][4]; u32x4 rb[NI][4][2], rc[NI][4][2]; float xv[NI][4], dtv[NI][4];
#pragma unroll
    for (int q = 0; q < NI; ++q) {
        const int item = item0 + q * istride, b = item >> 4, hd = item & 15, g = hd >> 3;
        const size_t sidx = ((size_t)(b * 16 + hd) * 64 + p) * 128 + n0;
#pragma unroll
        for (int i = 0; i < 4; ++i) hs[q][i] = __builtin_nontemporal_load((const f32x4*)(P->state_ssm + sidx + i * 4));
#pragma unroll
        for (int i = 0; i < 4; ++i) {
            const int t = TP + b * 4 + i;
            xv[q][i] = bf2f(xact[(size_t)t * 1536 + hd * 64 + p]);
            dtv[q][i] = dtb[(size_t)t * 16 + hd];
            rb[q][i][0] = ld8(xact + (size_t)t * 1536 + 1024 + g * 128 + n0); rb[q][i][1] = ld8(xact + (size_t)t * 1536 + 1024 + g * 128 + n0 + 8);
            rc[q][i][0] = ld8(xact + (size_t)t * 1536 + 1280 + g * 128 + n0); rc[q][i][1] = ld8(xact + (size_t)t * 1536 + 1280 + g * 128 + n0 + 8);
        }
    }
#pragma unroll
    for (int q = 0; q < NI; ++q) {
        const int item = item0 + q * istride, b = item >> 4, hd = item & 15;
        const float a = -expf(P->a_log[hd]);
        const float Dh = P->ssm_d[hd];
        const size_t sidx = ((size_t)(b * 16 + hd) * 64 + p) * 128 + n0;
        float h[16];
#pragma unroll
        for (int i = 0; i < 4; ++i) { h[i * 4] = hs[q][i][0]; h[i * 4 + 1] = hs[q][i][1]; h[i * 4 + 2] = hs[q][i][2]; h[i * 4 + 3] = hs[q][i][3]; }
#pragma unroll
        for (int i = 0; i < 4; ++i) {
            const int t = TP + b * 4 + i;
            const float dA = __expf(dtv[q][i] * a), dx = dtv[q][i] * xv[q][i];
            float Bv[16], Cv[16];
            { float t8[8]; unpack8(rb[q][i][0], t8);
#pragma unroll
              for (int e = 0; e < 8; ++e) Bv[e] = t8[e];
              unpack8(rb[q][i][1], t8);
#pragma unroll
              for (int e = 0; e < 8; ++e) Bv[8 + e] = t8[e];
              unpack8(rc[q][i][0], t8);
#pragma unroll
              for (int e = 0; e < 8; ++e) Cv[e] = t8[e];
              unpack8(rc[q][i][1], t8);
#pragma unroll
              for (int e = 0; e < 8; ++e) Cv[8 + e] = t8[e]; }
            float part = 0.f;
#pragma unroll
            for (int e = 0; e < 16; ++e) { h[e] = h[e] * dA + dx * Bv[e]; part += h[e] * Cv[e]; }
            part += __shfl_xor(part, 1); part += __shfl_xor(part, 2); part += __shfl_xor(part, 4);
            if ((tid & 7) == 0) ybuf[(size_t)t * 1024 + hd * 64 + p] = f2bf(part + Dh * xv[q][i]);
        }
        float* so = P->out + O_SSMS + sidx;
#pragma unroll
        for (int i = 0; i < 4; ++i) __builtin_nontemporal_store((f32x4){h[i * 4], h[i * 4 + 1], h[i * 4 + 2], h[i * 4 + 3]}, (f32x4*)(so + i * 4));
    }
}

__device__ __forceinline__ void phase_gatednorm(PP P, int gw, int nw, const int tid) {
    const int lane = tid & 63;
    char* ws = P->ws;
    const bf16_t* ybuf = (const bf16_t*)(ws + W_Y); const bf16_t* zbuf = (const bf16_t*)(ws + W_Z);
    bf16_t* mix = (bf16_t*)(ws + W_MIX);
    for (int row0 = gw; row0 < TT; row0 += 4 * nw) {
        u32x2 yv[4][4], zv[4][4];
#pragma unroll
        for (int r = 0; r < 4; ++r) { const int row = row0 + r * nw; if (row < TT) {
#pragma unroll
            for (int j = 0; j < 4; ++j) { yv[r][j] = *(const u32x2*)(ybuf + (size_t)row * 1024 + j * 256 + lane * 4); zv[r][j] = *(const u32x2*)(zbuf + (size_t)row * 1024 + j * 256 + lane * 4); } } }
#pragma unroll
        for (int r = 0; r < 4; ++r) { const int row = row0 + r * nw; if (row < TT) {
            float t[4][4]; float ss0 = 0.f, ss1 = 0.f;
#pragma unroll
            for (int j = 0; j < 4; ++j) {
                const float y0 = bflo(yv[r][j].x), y1 = bfhi(yv[r][j].x), y2 = bflo(yv[r][j].y), y3 = bfhi(yv[r][j].y);
                const float z0 = bflo(zv[r][j].x), z1 = bfhi(zv[r][j].x), z2 = bflo(zv[r][j].y), z3 = bfhi(zv[r][j].y);
                t[j][0] = y0 * silu_f(z0); t[j][1] = y1 * silu_f(z1); t[j][2] = y2 * silu_f(z2); t[j][3] = y3 * silu_f(z3);
                const float q = t[j][0] * t[j][0] + t[j][1] * t[j][1] + t[j][2] * t[j][2] + t[j][3] * t[j][3];
                if (j < 2) ss0 += q; else ss1 += q;
            }
            ss0 = wave_sum(ss0); ss1 = wave_sum(ss1);
            const float r0 = rsqrtf(ss0 * (1.0f / 512.0f) + EPS), r1 = rsqrtf(ss1 * (1.0f / 512.0f) + EPS);
#pragma unroll
            for (int j = 0; j < 4; ++j) {
                const float rr = j < 2 ? r0 : r1;
                const f32x4 g4 = *(const f32x4*)(P->ssm_norm + j * 256 + lane * 4);
                u32x2 o; o.x = pk2(t[j][0] * rr * g4[0], t[j][1] * rr * g4[1]); o.y = pk2(t[j][2] * rr * g4[2], t[j][3] * rr * g4[3]);
                *(u32x2*)(mix + (size_t)row * 2048 + j * 256 + lane * 4) = o;
            }
        } }
    }
}

__device__ __forceinline__ void phase_norm(PP P, const float* gain, bool final_out, int gw, int nw, const int tid) {
    const int lane = tid & 63;
    char* ws = P->ws;
    const bf16_t* hb = (const bf16_t*)(ws + W_H);
    const float* ss3 = (const float*)(ws + W_SS3);
    for (int row0 = gw; row0 < TT; row0 += 4 * nw) {
        u32x2 xv[4][4]; float sq[4];
#pragma unroll
        for (int r = 0; r < 4; ++r) { const int row = row0 + r * nw; if (row < TT) { sq[r] = ss3[row];
#pragma unroll
            for (int j = 0; j < 4; ++j) xv[r][j] = *(const u32x2*)(hb + (size_t)row * 1024 + j * 256 + lane * 4); } }
#pragma unroll
        for (int r = 0; r < 4; ++r) { const int row = row0 + r * nw; if (row < TT) {
            const float rstd = rsqrtf(sq[r] * (1.0f / 1024.0f) + EPS);
#pragma unroll
            for (int j = 0; j < 4; ++j) {
                const f32x4 g4 = *(const f32x4*)(gain + j * 256 + lane * 4);
                const f32x4 x = (f32x4){bflo(xv[r][j].x), bfhi(xv[r][j].x), bflo(xv[r][j].y), bfhi(xv[r][j].y)};
                __builtin_nontemporal_store(x * rstd * g4, (f32x4*)(P->out + O_YP + (size_t)row * 1024 + j * 256 + lane * 4));
            }
        } }
    }
}

__device__ __forceinline__ void attn_sample(PP P, int item0, int item1, char* shm, const int tid) {
    const int w = tid >> 6, lane = tid & 63, fr = lane & 15, fq = lane >> 4;
    const int half = w >> 2, w4 = w & 3;
    const int item = half ? item1 : item0;
    const bool act = item >= 0;
    const int b = act ? item >> 2 : 0, hh = item & 3;
    char* ws = P->ws;
    const bf16_t* qb = (const bf16_t*)(ws + W_Q);
    float* sc = (float*)shm + half * 1024;
    float* part = (float*)(shm + 8192) + half * 4096;
    const float* vp = P->cache_v + ((size_t)(b * 256 + w4 * 64) * 4 + hh) * 256 + lane * 4;
    f32x4 va[16], vb[16];
    if (act) {
#pragma unroll
        for (int mm = 0; mm < 16; ++mm) va[mm] = __builtin_nontemporal_load((const f32x4*)(vp + (size_t)mm * 1024));
    }
    if (act) {
        bf16x8 qf[8];
#pragma unroll
        for (int kk = 0; kk < 8; ++kk) {
            bf16x8 z = {0, 0, 0, 0, 0, 0, 0, 0};
            if (fr < 4) z = *(const bf16x8*)(qb + (size_t)(TP + b * 4 + fr) * 1024 + hh * 256 + kk * 32 + fq * 8);
            qf[kk] = z;
        }
#pragma unroll
        for (int mt = 0; mt < 4; ++mt) {
            const int key = w4 * 64 + mt * 16 + fr;
            const float* kp = P->cache_k + ((size_t)(b * 256 + key) * 4 + hh) * 256 + fq * 8;
            f32x4 k0[8], k1[8];
#pragma unroll
            for (int kk = 0; kk < 8; ++kk) { k0[kk] = __builtin_nontemporal_load((const f32x4*)(kp + kk * 32)); k1[kk] = __builtin_nontemporal_load((const f32x4*)(kp + kk * 32 + 4)); }
            f32x4 acc = (f32x4){0.f, 0.f, 0.f, 0.f};
#pragma unroll
            for (int kk = 0; kk < 8; ++kk) {
                u32x4 pk; pk.x = pk2(k0[kk][0], k0[kk][1]); pk.y = pk2(k0[kk][2], k0[kk][3]); pk.z = pk2(k1[kk][0], k1[kk][1]); pk.w = pk2(k1[kk][2], k1[kk][3]);
                acc = __builtin_amdgcn_mfma_f32_16x16x32_bf16(qf[kk], __builtin_bit_cast(bf16x8, pk), acc, 0, 0, 0);
            }
            if (fq == 0) {
#pragma unroll
                for (int j = 0; j < 4; ++j) sc[j * 256 + w4 * 64 + mt * 16 + fr] = acc[j];
            }
        }
    }
    LDS_BARRIER();
    if (act) {
#pragma unroll
        for (int mm = 0; mm < 16; ++mm) vb[mm] = __builtin_nontemporal_load((const f32x4*)(vp + (size_t)(16 + mm) * 1024));
        f32x4 s = *(const f32x4*)(sc + w4 * 256 + lane * 4);
        float m = fmaxf(fmaxf(s[0], s[1]), fmaxf(s[2], s[3])); m = wave_max(m);
        s[0] = __expf(s[0] - m); s[1] = __expf(s[1] - m); s[2] = __expf(s[2] - m); s[3] = __expf(s[3] - m);
        float su = (s[0] + s[1]) + (s[2] + s[3]); su = wave_sum(su);
        const float inv = 1.0f / su;
        *(f32x4*)(sc + w4 * 256 + lane * 4) = s * inv;
    }
    LDS_BARRIER();
    if (act) {
        f32x4 o[4];
#pragma unroll
        for (int i = 0; i < 4; ++i) o[i] = (f32x4){0.f, 0.f, 0.f, 0.f};
#pragma unroll
        for (int mm = 0; mm < 16; ++mm) {
#pragma unroll
            for (int i = 0; i < 4; ++i) o[i] += sc[i * 256 + w4 * 64 + mm] * va[mm];
        }
#pragma unroll
        for (int mm = 0; mm < 16; ++mm) va[mm] = __builtin_nontemporal_load((const f32x4*)(vp + (size_t)(32 + mm) * 1024));
#pragma unroll
        for (int mm = 0; mm < 16; ++mm) {
#pragma unroll
            for (int i = 0; i < 4; ++i) o[i] += sc[i * 256 + w4 * 64 + 16 + mm] * vb[mm];
        }
#pragma unroll
        for (int mm = 0; mm < 16; ++mm) vb[mm] = __builtin_nontemporal_load((const f32x4*)(vp + (size_t)(48 + mm) * 1024));
#pragma unroll
        for (int mm = 0; mm < 16; ++mm) {
#pragma unroll
            for (int i = 0; i < 4; ++i) o[i] += sc[i * 256 + w4 * 64 + 32 + mm] * va[mm];
        }
#pragma unroll
        for (int mm = 0; mm < 16; ++mm) {
#pragma unroll
            for (int i = 0; i < 4; ++i) o[i] += sc[i * 256 + w4 * 64 + 48 + mm] * vb[mm];
        }
#pragma unroll
        for (int i = 0; i < 4; ++i) *(f32x4*)(part + (w4 * 4 + i) * 256 + lane * 4) = o[i];
    }
    LDS_BARRIER();
    if (act) {
        f32x4 r = *(const f32x4*)(part + (0 * 4 + w4) * 256 + lane * 4);
#pragma unroll
        for (int ww = 1; ww < 4; ++ww) r += *(const f32x4*)(part + (ww * 4 + w4) * 256 + lane * 4);
        u32x2 o; o.x = pk2(r[0], r[1]); o.y = pk2(r[2], r[3]);
        *(u32x2*)((bf16_t*)(ws + W_O) + (size_t)(TP + b * 4 + w4) * 1024 + hh * 256 + lane * 4) = o;
    }
    LDS_BARRIER();
}

__device__ __forceinline__ void phase_ffnconv(PP P, int gtid, int nthreads) {
    char* ws = P->ws;
    const bf16_t* u = (const bf16_t*)(ws + W_U);
    bf16_t* act = (bf16_t*)(ws + W_ACT);
    for (int idx = gtid; idx < 1152 * 352; idx += nthreads) {
        const int run = idx / 352, cg = idx % 352;
        const bool samp = run >= 1024;
        int t0, len, bidx, tl0;
        if (!samp) { t0 = run * 16; len = 16; bidx = t0 >> 11; tl0 = t0 & 2047; } else { bidx = run - 1024; t0 = TP + bidx * 4; len = 4; tl0 = 0; }
        const int cgc = cg * 8, cvc = 2816 + cg * 8;
        float wg0[8], wg1[8], wg2[8], wv0[8], wv1[8], wv2[8], bg[8], bv[8], hg0[8], hg1[8], hv0[8], hv1[8];
#pragma unroll
        for (int e = 0; e < 8; ++e) {
            wg0[e] = P->ffn_w[cgc + e]; wg1[e] = P->ffn_w[5632 + cgc + e]; wg2[e] = P->ffn_w[11264 + cgc + e];
            wv0[e] = P->ffn_w[cvc + e]; wv1[e] = P->ffn_w[5632 + cvc + e]; wv2[e] = P->ffn_w[11264 + cvc + e];
            bg[e] = P->ffn_b[cgc + e]; bv[e] = P->ffn_b[cvc + e];
        }
        if (samp) {
#pragma unroll
            for (int e = 0; e < 8; ++e) {
                hg0[e] = P->state_ffn[(size_t)(bidx * 2 + 0) * 5632 + cgc + e]; hg1[e] = P->state_ffn[(size_t)(bidx * 2 + 1) * 5632 + cgc + e];
                hv0[e] = P->state_ffn[(size_t)(bidx * 2 + 0) * 5632 + cvc + e]; hv1[e] = P->state_ffn[(size_t)(bidx * 2 + 1) * 5632 + cvc + e];
            }
        } else if (tl0 > 0) {
            unpack8(ld8(u + (size_t)(t0 - 2) * 5632 + cgc), hg0); unpack8(ld8(u + (size_t)(t0 - 1) * 5632 + cgc), hg1);
            unpack8(ld8(u + (size_t)(t0 - 2) * 5632 + cvc), hv0); unpack8(ld8(u + (size_t)(t0 - 1) * 5632 + cvc), hv1);
        } else {
#pragma unroll
            for (int e = 0; e < 8; ++e) { hg0[e] = 0.f; hg1[e] = 0.f; hv0[e] = 0.f; hv1[e] = 0.f; }
        }
        for (int jb = 0; jb < len; jb += 8) {
        u32x4 rg[8], rv[8];
        const bf16_t* ub = u + (size_t)(t0 + jb) * 5632 + cgc;
#pragma unroll
        for (int jj = 0; jj < 8; ++jj) { if (jb + jj < len) { rg[jj] = __builtin_nontemporal_load((const u32x4*)(ub + (size_t)jj * 5632)); rv[jj] = __builtin_nontemporal_load((const u32x4*)(ub + (size_t)jj * 5632 + 2816)); } }
#pragma unroll
        for (int jj = 0; jj < 8; ++jj) {
            const int j = jb + jj;
            if (j < len) {
            float ug[8], uv[8], o8[8];
            unpack8(rg[jj], ug); unpack8(rv[jj], uv);
#pragma unroll
            for (int e = 0; e < 8; ++e) {
                const float gc = bg[e] + wg0[e] * hg0[e] + wg1[e] * hg1[e] + wg2[e] * ug[e];
                const float vc = bv[e] + wv0[e] * hv0[e] + wv1[e] * hv1[e] + wv2[e] * uv[e];
                o8[e] = silu_f(gc) * vc;
            }
            *(u32x4*)(act + (size_t)(t0 + j) * 2816 + cgc) = pack8(o8);
            float* o = nullptr;
            if (samp) { if (j >= 2) o = P->out + O_FFNS + (size_t)(bidx * 2 + j - 2) * 5632; }
            else { const int tl = tl0 + j; if (tl >= 2046) o = P->out + O_FFNP + (size_t)(bidx * 2 + tl - 2046) * 5632; }
            if (o) {
#pragma unroll
                for (int e = 0; e < 8; ++e) { o[cgc + e] = ug[e]; o[cvc + e] = uv[e]; }
            }
#pragma unroll
            for (int e = 0; e < 8; ++e) { hg0[e] = hg1[e]; hg1[e] = ug[e]; hv0[e] = hv1[e]; hv1[e] = uv[e]; }
            }
        }
        }
    }
}

#define XB_TMO      128
#define XB_XCNT(j)  (256  + 64 * (j))
#define XB_XSUB(j)  (1280 + 64 * (j))
#define XB_XGEN(j)  (2304 + 64 * (j))
#define XB_TOP      3328
#define XB_TOPGEN   3392
#define XCD_BAR_WORDS 3456
#define XB_SPIN_CAP (1u << 20)
__device__ __forceinline__ unsigned xb_ld(unsigned* p)              { return __hip_atomic_load(p, __ATOMIC_RELAXED, __HIP_MEMORY_SCOPE_AGENT); }
__device__ __forceinline__ unsigned xb_add(unsigned* p, unsigned v) { return __hip_atomic_fetch_add(p, v, __ATOMIC_RELAXED, __HIP_MEMORY_SCOPE_AGENT); }
__device__ __forceinline__ unsigned xb_xcc_id() { return (unsigned)__builtin_amdgcn_s_getreg((3 << 11) | 20) & 0xFu; }
#define XB_SPIN(cond, bar) do { unsigned _sp = 0; while (cond) { \
    if ((++_sp & 255u) == 0u) { if (xb_ld(&(bar)[XB_TMO])) break; if (_sp > XB_SPIN_CAP) { atomicAdd(&(bar)[XB_TMO], 1u); break; } } } } while (0)
__device__ __forceinline__ void xcd_barrier_complete(unsigned* bar, unsigned x, unsigned& nloc, unsigned& nx) {
    const unsigned G = gridDim.x;
    unsigned sum, cnt, mine, sp = 0u;
    for (;;) {
        sum = 0u; cnt = 0u; mine = 0u;
#pragma unroll
        for (unsigned j = 0; j < 16; ++j) { const unsigned c = xb_ld(&bar[XB_XCNT(j)]); sum += c; cnt += (c > 0u) ? 1u : 0u; mine = (j == x) ? c : mine; }
        if (sum == G) break;
        __builtin_amdgcn_s_sleep(1);
        if ((++sp & 255u) == 0u) { if (xb_ld(&bar[XB_TMO])) break; if (sp > XB_SPIN_CAP) { atomicAdd(&bar[XB_TMO], 1u); break; } }
    }
    nloc = mine > 0u ? mine : 1u; nx = cnt > 0u ? cnt : 1u;
}
__device__ __forceinline__ void xcd_barrier(unsigned* bar, volatile LDSB unsigned* st, const int tid) {
    asm volatile("s_waitcnt vmcnt(0)" ::: "memory");
    __syncthreads();
    if (tid == 0) {
        const unsigned x = xb_xcc_id();
        __builtin_amdgcn_s_waitcnt(0);
        unsigned nloc = st[0], nx = st[1];
        if (nloc == 0u) { xcd_barrier_complete(bar, x, nloc, nx); st[0] = nloc; st[1] = nx; }
        const unsigned old = xb_add(&bar[XB_XSUB(x)], 1u);
        const unsigned gen = old / nloc;
        if (old + 1u == (gen + 1u) * nloc) {
            __builtin_amdgcn_fence(__ATOMIC_RELEASE, "agent");
            asm volatile("s_waitcnt vmcnt(0)" ::: "memory");
            const unsigned og = xb_add(&bar[XB_TOP], 1u);
            const unsigned tg = og / nx;
            if (og + 1u == (tg + 1u) * nx) xb_add(&bar[XB_TOPGEN], 1u);
            else XB_SPIN(xb_ld(&bar[XB_TOPGEN]) == tg, bar);
            __builtin_amdgcn_fence(__ATOMIC_ACQUIRE, "agent");
            xb_add(&bar[XB_XGEN(x)], 1u);
            asm volatile("s_waitcnt vmcnt(0)" ::: "memory");
        } else {
            XB_SPIN(xb_ld(&bar[XB_XGEN(x)]) == gen, bar);
            __builtin_amdgcn_fence(__ATOMIC_ACQUIRE, "agent");
            asm volatile("s_waitcnt vmcnt(0)" ::: "memory");
        }
    }
    __syncthreads();
}

extern __shared__ __attribute__((aligned(16))) char smem[];

__global__ void __launch_bounds__(NTHR) hybrid_fwd(Params Pin) {
    char* shm = smem;
    volatile LDSB unsigned* bst = (volatile LDSB unsigned*)(smem + 139264);
    if (threadIdx.x == 0) { bst[0] = 0u; bst[1] = 0u; (void)xb_add((unsigned*)(Pin.ws + W_BAR) + XB_XCNT(xb_xcc_id()), 1u); }
    __syncthreads();
    for (int ph = Pin.ph_lo; ph < Pin.ph_hi; ++ph) {
        if (ph == 6 || ph == 11) continue;
        const int reps = ((REPEAT_MASK >> ph) & 1) ? 2 : 1;
        for (int rep = 0; rep < reps; ++rep) {
        if (rep > 0) xcd_barrier((unsigned*)(Pin.ws + W_BAR), bst, threadIdx.x);
        int tid = threadIdx.x, blk = blockIdx.x, nblk = gridDim.x;
        asm volatile("" : "+v"(tid));
        asm volatile("" : "+s"(blk), "+s"(nblk));
        PP P = (PP)__builtin_amdgcn_kernarg_segment_ptr();
        asm volatile("" : "+s"(P));
        const int lb = (blk & 7) * (nblk >> 3) + (blk >> 3);
        const int gtid = blk * NTHR + tid, nthreads = nblk * NTHR;
        const int gw = blk * 8 + (tid >> 6), nw = nblk * 8;
        switch (ph) {
#if PHASE_MASK & 1
        case 0: phase_prep(P, shm, blk, nblk, tid); break;
#endif
#if PHASE_MASK & 4
        case 2: phase_convpool(P, gtid, nthreads); break;
#endif
#if PHASE_MASK & 8
        case 3:
            if (blk & 1) { int it = blk; for (; it + nblk < 2048; it += 2 * nblk) ssd_sample<2>(P, it, nblk, tid); for (; it < 2048; it += nblk) ssd_sample<1>(P, it, nblk, tid); }
            for (int it = blk; it < 256; it += nblk) ssd_prompt(P, it, shm, tid);
            if (!(blk & 1)) { int it = blk; for (; it + nblk < 2048; it += 2 * nblk) ssd_sample<2>(P, it, nblk, tid); for (; it < 2048; it += nblk) ssd_sample<1>(P, it, nblk, tid); }
            break;
#endif
#if PHASE_MASK & 16
        case 4: phase_gatednorm(P, gw, nw, tid); break;
#endif
#if PHASE_MASK & 64
        case 6: phase_norm(P, P->norm_mem, false, gw, nw, tid); break;
        case 11: phase_norm(P, P->norm_ffn, false, gw, nw, tid); break;
        case 15: phase_norm(P, P->final_norm, true, gw, nw, tid); break;
#endif
#if PHASE_MASK & 8192
        case 13: phase_ffnconv(P, gtid, nthreads); break;
#endif
        default: break;
        }
#if PHASE_MASK & 256
        if (ph == 8 && (blk & 1)) { for (int it = blk; it < 512; it += 2 * nblk) attn_sample(P, it, it + nblk < 512 ? it + nblk : -1, shm, tid); __syncthreads(); }
#endif
#if PHASE_MASK & 2
        if (ph == 1 || ph == 5 || ph == 7 || ph == 8 || ph == 9 || ph == 10 || ph == 12 || ph == 14) gemm_phase(P, ph, shm, lb, blk, nblk, tid);
#endif
#if PHASE_MASK & 256
        if (ph == 9 && !(blk & 1)) { for (int it = blk; it < 512; it += 2 * nblk) attn_sample(P, it, it + nblk < 512 ? it + nblk : -1, shm, tid); }
#endif
        }
        if (ph + 1 < Pin.ph_hi && ph != 8) xcd_barrier((unsigned*)(Pin.ws + W_BAR), bst, threadIdx.x);
        if (ph == 8) { asm volatile("s_waitcnt vmcnt(0)" ::: "memory"); __syncthreads(); }
        if (EXTRA_SYNCS && ph == 0) { for (int i = 0; i < EXTRA_SYNCS; ++i) xcd_barrier((unsigned*)(Pin.ws + W_BAR), bst, threadIdx.x); }
    }
}

extern "C" void kernel_launch(void* const* d_in, const int* in_sizes, int n_in, void* d_out, int out_size, void* d_ws, size_t ws_size, hipStream_t stream) {
    static int grid_blocks = 0;
    if (!grid_blocks) {
        int dev = 0, cus = 0, per_cu = 0;
        hipGetDevice(&dev);
        hipDeviceGetAttribute(&cus, hipDeviceAttributeMultiprocessorCount, dev);
        hipFuncSetAttribute((const void*)hybrid_fwd, hipFuncAttributeMaxDynamicSharedMemorySize, LDS_BYTES);
        hipOccupancyMaxActiveBlocksPerMultiprocessor(&per_cu, hybrid_fwd, NTHR, LDS_BYTES);
        if (per_cu < 1) per_cu = 1;
        grid_blocks = cus * 1;
        grid_blocks &= ~7;
        if (grid_blocks < 8) grid_blocks = 8;
    }
    Params p{};
    const float* const* in = (const float* const*)d_in;
    p.x_prompt = in[0]; p.x_sample = in[1]; p.mem_prompt = in[2]; p.state_ssm = in[3]; p.state_conv = in[4]; p.state_pool = in[5]; p.state_ffn = in[6];
    p.cache_k = in[7]; p.cache_v = in[8]; p.norm_mix = in[9]; p.w_in = in[10]; p.conv_w = in[11]; p.conv_b = in[12]; p.dt_bias = in[13]; p.a_log = in[14];
    p.ssm_d = in[15]; p.ssm_norm = in[16]; p.w_pool = in[17]; p.pool_scale = in[18]; p.w_out = in[19]; p.norm_mem = in[20]; p.norm_memkv = in[21];
    p.w_mq = in[22]; p.w_mk = in[23]; p.w_mv = in[24]; p.w_mo = in[25]; p.norm_ffn = in[26]; p.w_up = in[27]; p.ffn_w = in[28]; p.ffn_b = in[29];
    p.w_down = in[30]; p.final_norm = in[31];
    p.out = (float*)d_out; p.ws = (char*)d_ws; p.ph_lo = 0; p.ph_hi = 16;
    hipMemsetAsync((char*)d_ws + W_BAR, 0, 16384, stream);
    void* args[] = {&p};
    hipError_t e = hipLaunchCooperativeKernel((const void*)hybrid_fwd, dim3(grid_blocks), dim3(NTHR), args, LDS_BYTES, stream);
    if (e != hipSuccess) fprintf(stderr, "cooperative launch failed: %s (grid %d)\n", hipGetErrorString(e), grid_blocks);
}
```

```cpp
#include <hip/hip_runtime.h>
#include <hip/hip_cooperative_groups.h>
#include <cstdio>
namespace cg = cooperative_groups;

typedef unsigned short bf16_t;
typedef short bf16x8 __attribute__((ext_vector_type(8)));
typedef short s16x4 __attribute__((ext_vector_type(4)));
typedef float f32x4 __attribute__((ext_vector_type(4)));
typedef unsigned u32x4 __attribute__((ext_vector_type(4)));
typedef unsigned u32x2 __attribute__((ext_vector_type(2)));
#define LDSB __attribute__((address_space(3)))

constexpr int TP = 16384, TS = 512, TT = TP + TS;
constexpr int NTHR = 512;
constexpr int LDS_BYTES = 139264 + 256;
constexpr float EPS = 1e-6f;
#ifndef PHASE_MASK
#define PHASE_MASK 0xFFFF
#endif
#ifndef REPEAT_MASK
#define REPEAT_MASK 0
#endif
#ifndef PROBE3
#define PROBE3 0
#endif
#ifndef EXTRA_SYNCS
#define EXTRA_SYNCS 0
#endif

constexpr size_t O_YP = 0;
constexpr size_t O_YS = O_YP + (size_t)TP * 1024;
constexpr size_t O_SSMP = O_YS + (size_t)TS * 1024;
constexpr size_t O_SSMS = O_SSMP + (size_t)8 * 16 * 64 * 128;
constexpr size_t O_CONVP = O_SSMS + (size_t)128 * 16 * 64 * 128;
constexpr size_t O_CONVS = O_CONVP + (size_t)8 * 3 * 1536;
constexpr size_t O_POOLP = O_CONVS + (size_t)128 * 3 * 1536;
constexpr size_t O_POOLS = O_POOLP + (size_t)8 * 15 * 1024;
constexpr size_t O_FFNP = O_POOLS + (size_t)128 * 15 * 1024;
constexpr size_t O_FFNS = O_FFNP + (size_t)8 * 2 * 5632;
constexpr size_t O_MK = O_FFNS + (size_t)128 * 2 * 5632;
constexpr size_t O_MV = O_MK + (size_t)8 * 256 * 1024;

constexpr size_t W_WIN = 0;
constexpr size_t W_WPOOL = W_WIN + (size_t)3584 * 1024 * 2;
constexpr size_t W_WOUT = W_WPOOL + (size_t)4 * 256 * 256 * 2;
constexpr size_t W_WMQ = W_WOUT + (size_t)1024 * 2048 * 2;
constexpr size_t W_WMK = W_WMQ + (size_t)1024 * 1024 * 2;
constexpr size_t W_WMV = W_WMK + (size_t)1024 * 1024 * 2;
constexpr size_t W_WMO = W_WMV + (size_t)1024 * 1024 * 2;
constexpr size_t W_WUP = W_WMO + (size_t)1024 * 1024 * 2;
constexpr size_t W_WDOWN = W_WUP + (size_t)5632 * 1024 * 2;
constexpr size_t W_H = W_WDOWN + (size_t)1024 * 2816 * 2;
constexpr size_t W_HM = W_H + (size_t)TT * 1024 * 2;
constexpr size_t W_KB = W_HM + (size_t)2048 * 1024 * 2;
constexpr size_t W_VT = W_KB + (size_t)2048 * 1024 * 2;
constexpr size_t W_DT = W_VT + (size_t)2048 * 1024 * 2;
constexpr size_t W_XRES = W_DT + (size_t)TT * 16 * 4;
constexpr size_t W_ARENA = W_XRES + (size_t)TT * 1024 * 4;
constexpr size_t W_Z = W_ARENA;
constexpr size_t W_PROJ2 = W_Z + (size_t)TT * 1024 * 2;
constexpr size_t W_XACT = W_PROJ2 + (size_t)TT * 2560 * 2;
constexpr size_t W_POOLED = W_XACT + (size_t)TT * 1536 * 2;
constexpr size_t W_Y = W_POOLED + (size_t)TT * 1024 * 2;
constexpr size_t W_MIX = W_Y + (size_t)TT * 1024 * 2;
constexpr size_t W_END_A = W_MIX + (size_t)TT * 2048 * 2;
constexpr size_t W_Q = W_PROJ2;
constexpr size_t W_P = W_Q + (size_t)TT * 1024 * 2;
constexpr size_t W_O = W_P + (size_t)TP * 1024 * 2;
constexpr size_t W_U = W_ARENA;
constexpr size_t W_ACT = W_U + (size_t)TT * 5632 * 2;
constexpr size_t W_END_C = W_ACT + (size_t)TT * 2816 * 2;
constexpr size_t W_BAR = W_END_A;
constexpr size_t W_SS1 = W_BAR + 16384;
constexpr size_t W_SS2 = W_SS1 + (size_t)TT * 4;
constexpr size_t W_SS3 = W_SS2 + (size_t)TT * 4;
constexpr size_t W_WLO = W_SS3 + (size_t)TT * 4;
constexpr size_t W_TOTAL = W_WLO + (size_t)1024 * 1024 * 2;
static_assert(W_O + (size_t)TT * 1024 * 2 <= W_POOLED, "era B overflow");
static_assert(W_END_C <= W_END_A, "era C overflow");

struct Params {
    const float *x_prompt, *x_sample, *mem_prompt, *state_ssm, *state_conv, *state_pool, *state_ffn, *cache_k, *cache_v;
    const float *norm_mix, *w_in, *conv_w, *conv_b, *dt_bias, *a_log, *ssm_d, *ssm_norm, *w_pool, *pool_scale, *w_out;
    const float *norm_mem, *norm_memkv, *w_mq, *w_mk, *w_mv, *w_mo, *norm_ffn, *w_up, *ffn_w, *ffn_b, *w_down, *final_norm;
    float* out;
    char* ws;
    int ph_lo, ph_hi;
};

typedef const __attribute__((address_space(4))) Params* PP;

__device__ __forceinline__ unsigned pk2(float lo, float hi) { unsigned r; asm("v_cvt_pk_bf16_f32 %0, %1, %2" : "=v"(r) : "v"(lo), "v"(hi)); return r; }
__device__ __forceinline__ bf16_t f2bf(float f) { return (bf16_t)(pk2(f, 0.f) & 0xffffu); }
__device__ __forceinline__ float bf2f(bf16_t b) { return __uint_as_float(((unsigned)b) << 16); }
__device__ __forceinline__ float bflo(unsigned u) { return __uint_as_float(u << 16); }
__device__ __forceinline__ float bfhi(unsigned u) { return __uint_as_float(u & 0xffff0000u); }
__device__ __forceinline__ void unpack8(u32x4 v, float (&f)[8]) {
    f[0] = bflo(v.x); f[1] = bfhi(v.x); f[2] = bflo(v.y); f[3] = bfhi(v.y); f[4] = bflo(v.z); f[5] = bfhi(v.z); f[6] = bflo(v.w); f[7] = bfhi(v.w);
}
__device__ __forceinline__ u32x4 pack8(const float (&f)[8]) { u32x4 r; r.x = pk2(f[0], f[1]); r.y = pk2(f[2], f[3]); r.z = pk2(f[4], f[5]); r.w = pk2(f[6], f[7]); return r; }
__device__ __forceinline__ float wave_sum(float v) {
#pragma unroll
    for (int o = 1; o < 64; o <<= 1) v += __shfl_xor(v, o);
    return v;
}
__device__ __forceinline__ float wave_max(float v) {
#pragma unroll
    for (int o = 1; o < 64; o <<= 1) v = fmaxf(v, __shfl_xor(v, o));
    return v;
}
__device__ __forceinline__ float silu_f(float x) { return x * __builtin_amdgcn_rcpf(1.0f + __expf(-x)); }

constexpr int HTB = 128 * 64 * 2;
__device__ __forceinline__ int lds_byte(int r, int c) { const int st = (r >> 4) * 2 + (c >> 5), rr = r & 15, cc = c & 31, ob = rr * 64 + cc * 2; return st * 1024 + (ob ^ (((ob >> 9) & 1) << 5)); }
__device__ __forceinline__ void stage_rc(int b, int& R, int& C) { const int st = b / 1024, sb = b % 1024, swz = sb ^ (((sb >> 9) & 1) << 5); R = (st >> 1) * 16 + swz / 64; C = (st & 1) * 32 + (swz % 64) / 2; }

__device__ __forceinline__ int perm32(int rho) { const int n = rho >> 4, i = rho & 15; return 8 * (i >> 2) + 4 * n + (i & 3); }
__device__ __forceinline__ int invperm32(int c) { return 16 * ((c >> 2) & 1) + 4 * (c >> 3) + (c & 3); }
enum { E_PROJ = 0, E_MEMKV, E_POOL, E_OUT, E_Q, E_QK, E_PV, E_MO, E_UP, E_DOWN, E_FOLD };

template <int EK>
__device__ __forceinline__ float epi_apply(PP P, int row, int col, f32x4 v) {
    char* ws = P->ws;
    if constexpr (EK == E_PROJ) {
        u32x2 o; o.x = pk2(v[0], v[1]); o.y = pk2(v[2], v[3]);
        if (col < 1024) *(u32x2*)((bf16_t*)(ws + W_Z) + (size_t)row * 1024 + col) = o;
        else *(u32x2*)((bf16_t*)(ws + W_PROJ2) + (size_t)row * 2560 + (col - 1024)) = o;
    } else if constexpr (EK == E_MEMKV) {
        if (col < 1024) {
            *(f32x4*)(P->out + O_MK + (size_t)row * 1024 + col) = v;
            u32x2 o; o.x = pk2(v[0], v[1]); o.y = pk2(v[2], v[3]);
            *(u32x2*)((bf16_t*)(ws + W_KB) + (size_t)((row & ~31) + invperm32(row & 31)) * 1024 + col) = o;
        } else {
            const int c = col - 1024;
            *(f32x4*)(P->out + O_MV + (size_t)row * 1024 + c) = v;
            const int b = row >> 8, m = row & 255, hh = c >> 8, d = c & 255;
            bf16_t* vt = (bf16_t*)(ws + W_VT) + ((size_t)(b * 4 + hh) * 256 + (d & ~31) + invperm32(d & 31)) * 256 + m;
#pragma unroll
            for (int j = 0; j < 4; ++j) vt[j * 256] = f2bf(v[j]);
        }
    } else if constexpr (EK == E_POOL) {
        const f32x4 sc = *(const f32x4*)(P->pool_scale + col);
        u32x2 o; o.x = pk2(v[0] * sc[0], v[1] * sc[1]); o.y = pk2(v[2] * sc[2], v[3] * sc[3]);
        *(u32x2*)((bf16_t*)(ws + W_MIX) + (size_t)row * 2048 + 1024 + col) = o;
    } else if constexpr (EK == E_OUT) {
        const float* xin = row < TP ? P->x_prompt + (size_t)row * 1024 : P->x_sample + (size_t)(row - TP) * 1024;
        const f32x4 x = *(const f32x4*)(xin + col) + v;
        u32x2 o; o.x = pk2(x[0], x[1]); o.y = pk2(x[2], x[3]);
        *(u32x2*)((bf16_t*)(ws + W_H) + (size_t)row * 1024 + col) = o;
        return (x[0] * x[0] + x[1] * x[1]) + (x[2] * x[2] + x[3] * x[3]);
    } else if constexpr (EK == E_Q) {
        u32x2 o; o.x = pk2(v[0], v[1]); o.y = pk2(v[2], v[3]);
        *(u32x2*)((bf16_t*)(ws + W_Q) + (size_t)row * 1024 + col) = o;
    } else if constexpr (EK == E_PV) {
        u32x2 o; o.x = pk2(v[0], v[1]); o.y = pk2(v[2], v[3]);
        *(u32x2*)((bf16_t*)(ws + W_O) + (size_t)row * 1024 + col) = o;
    } else if constexpr (EK == E_MO || EK == E_DOWN) {
        u32x2* hp = (u32x2*)((bf16_t*)(ws + W_H) + (size_t)row * 1024 + col);
        const u32x2 hv = *hp;
        const f32x4 x = (f32x4){bflo(hv.x), bfhi(hv.x), bflo(hv.y), bfhi(hv.y)} + v;
        u32x2 o; o.x = pk2(x[0], x[1]); o.y = pk2(x[2], x[3]);
        *hp = o;
        return (x[0] * x[0] + x[1] * x[1]) + (x[2] * x[2] + x[3] * x[3]);
    } else if constexpr (EK == E_UP) {
        u32x2 o; o.x = pk2(v[0], v[1]); o.y = pk2(v[2], v[3]);
        *(u32x2*)((bf16_t*)(ws + W_U) + (size_t)row * 5632 + col) = o;
    }
    return 0.f;
}
template <int EK>
__device__ __forceinline__ float epi_rowscale(PP P, int row) {
    if constexpr (EK == E_Q) return rsqrtf(((const float*)(P->ws + W_SS1))[row] * (1.0f / 1024.0f) + EPS) * 0.0625f;
    else if constexpr (EK == E_UP) return rsqrtf(((const float*)(P->ws + W_SS2))[row] * (1.0f / 1024.0f) + EPS);
    else return 1.0f;
}
__device__ __forceinline__ float epi_apply_rt(PP P, int ekind, int row, int col, f32x4 v) {
    switch (ekind) {
    case E_FOLD: { u32x2 o; o.x = pk2(v[0], v[1]); o.y = pk2(v[2], v[3]); const int prow = (row & ~31) + invperm32(row & 31); *(u32x2*)((bf16_t*)(P->ws + W_WOUT) + (size_t)prow * 2048 + 1024 + col) = o; return 0.f; }
    case E_OUT: return epi_apply<E_OUT>(P, row, col, v);
    case E_Q: return epi_apply<E_Q>(P, row, col, v * epi_rowscale<E_Q>(P, row));
    case E_MO: return epi_apply<E_MO>(P, row, col, v);
    default: return epi_apply<E_DOWN>(P, row, col, v);
    }
}
template <int EK>
__device__ __forceinline__ void epi_loop(PP P, const f32x4 (&acc)[2][2][4][2], int rbase, int cbase, int fq) {
    if constexpr (EK == E_PROJ || EK == E_UP || EK == E_Q || EK == E_PV || EK == E_OUT || EK == E_MO || EK == E_DOWN) {
        const int cb8 = cbase + 4 * fq;
#pragma unroll
        for (int ai = 0; ai < 2; ++ai)
#pragma unroll
            for (int m = 0; m < 4; ++m) {
                const int row = rbase + ai * 128 + m * 16;
                const float rs = epi_rowscale<EK>(P, row);
                float ss = 0.f;
#pragma unroll
                for (int bj = 0; bj < 2; ++bj) {
                    f32x4 v0 = acc[ai][bj][m][0], v1 = acc[ai][bj][m][1];
                    const int col = cb8 + bj * 128;
                    if constexpr (EK == E_PROJ || EK == E_UP || EK == E_Q) { v0 *= rs; v1 *= rs; }
                    if constexpr (EK == E_OUT) {
                        const float* xin = (row < TP ? P->x_prompt + (size_t)row * 1024 : P->x_sample + (size_t)(row - TP) * 1024) + col;
                        v0 += __builtin_nontemporal_load((const f32x4*)xin); v1 += __builtin_nontemporal_load((const f32x4*)(xin + 4));
                    }
                    if constexpr (EK == E_MO || EK == E_DOWN) {
                        const u32x4 hv = *(const u32x4*)((const bf16_t*)(P->ws + W_H) + (size_t)row * 1024 + col);
                        v0 += (f32x4){bflo(hv.x), bfhi(hv.x), bflo(hv.y), bfhi(hv.y)}; v1 += (f32x4){bflo(hv.z), bfhi(hv.z), bflo(hv.w), bfhi(hv.w)};
                    }
                    if constexpr (EK == E_OUT || EK == E_MO || EK == E_DOWN) ss += ((v0[0] * v0[0] + v0[1] * v0[1]) + (v0[2] * v0[2] + v0[3] * v0[3])) + ((v1[0] * v1[0] + v1[1] * v1[1]) + (v1[2] * v1[2] + v1[3] * v1[3]));
                    u32x4 o; o.x = pk2(v0[0], v0[1]); o.y = pk2(v0[2], v0[3]); o.z = pk2(v1[0], v1[1]); o.w = pk2(v1[2], v1[3]);
                    if constexpr (EK == E_UP) *(u32x4*)((bf16_t*)(P->ws + W_U) + (size_t)row * 5632 + col) = o;
                    else if constexpr (EK == E_Q) *(u32x4*)((bf16_t*)(P->ws + W_Q) + (size_t)row * 1024 + col) = o;
                    else if constexpr (EK == E_PV) *(u32x4*)((bf16_t*)(P->ws + W_O) + (size_t)row * 1024 + col) = o;
                    else if constexpr (EK == E_PROJ) { if (col < 1024) *(u32x4*)((bf16_t*)(P->ws + W_Z) + (size_t)row * 1024 + col) = o;
                           else *(u32x4*)((bf16_t*)(P->ws + W_PROJ2) + (size_t)row * 2560 + (col - 1024)) = o; }
                    else *(u32x4*)((bf16_t*)(P->ws + W_H) + (size_t)row * 1024 + col) = o;
                }
                if constexpr (EK == E_OUT || EK == E_MO || EK == E_DOWN) {
                    ss += __shfl_xor(ss, 16); ss += __shfl_xor(ss, 32);
                    if (fq == 0) unsafeAtomicAdd((float*)(P->ws + (EK == E_OUT ? W_SS1 : EK == E_MO ? W_SS2 : W_SS3)) + row, ss);
                }
            }
        return;
    }
#pragma unroll
    for (int ai = 0; ai < 2; ++ai)
#pragma unroll
        for (int m = 0; m < 4; ++m) {
            const int row = rbase + ai * 128 + m * 16;
            const float rs = epi_rowscale<EK>(P, row);
            float ss = 0.f;
#pragma unroll
            for (int bj = 0; bj < 2; ++bj)
#pragma unroll
                for (int n = 0; n < 2; ++n) {
                    if constexpr (EK == E_Q || EK == E_UP) ss += epi_apply<EK>(P, row, cbase + bj * 128 + n * 16, acc[ai][bj][m][n] * rs);
                    else ss += epi_apply<EK>(P, row, cbase + bj * 128 + n * 16, acc[ai][bj][m][n]);
                }
            if constexpr (EK == E_OUT || EK == E_MO || EK == E_DOWN) {
                ss += __shfl_xor(ss, 16); ss += __shfl_xor(ss, 32);
                if (fq == 0) unsafeAtomicAdd((float*)(P->ws + (EK == E_OUT ? W_SS1 : EK == E_MO ? W_SS2 : W_SS3)) + row, ss);
            }
        }
}

struct PhaseCfg { const char* A; const char* B; int lda, ldb, K, nbig, nsmall, ncol64, ekind; };
__device__ __forceinline__ PhaseCfg phase_cfg(PP P, int gp) {
    const char* ws = P->ws; PhaseCfg c;
    switch (gp) {
    case 1:  c.A = ws + W_H;      c.B = ws + W_WIN;   c.lda = 1024; c.ldb = 1024; c.K = 1024; c.nbig = 66 * 14 + 64; c.nsmall = 512; c.ncol64 = 16; c.ekind = E_PROJ; break;
    case 3:  c.A = ws + W_POOLED; c.B = ws + W_WPOOL; c.lda = 1024; c.ldb = 256;  c.K = 256;  c.nbig = 256; c.nsmall = 256; c.ncol64 = 16; c.ekind = E_POOL; break;
    case 5:  c.A = ws + W_MIX;    c.B = ws + W_WOUT;  c.lda = 2048; c.ldb = 2048; c.K = 2048; c.nbig = 256; c.nsmall = 256; c.ncol64 = 16; c.ekind = E_OUT; break;
    case 7:  c.A = ws + W_H;      c.B = ws + W_WMQ;   c.lda = 1024; c.ldb = 1024; c.K = 1024; c.nbig = 256; c.nsmall = 256; c.ncol64 = 16; c.ekind = E_Q; break;
    case 8:  c.A = ws + W_Q;      c.B = ws + W_KB;    c.lda = 1024; c.ldb = 1024; c.K = 256;  c.nbig = 256; c.nsmall = 0;   c.ncol64 = 16; c.ekind = E_QK; break;
    case 9:  c.A = ws + W_P;      c.B = ws + W_VT;    c.lda = 1024; c.ldb = 256;  c.K = 256;  c.nbig = 256; c.nsmall = 0;   c.ncol64 = 16; c.ekind = E_PV; break;
    case 10: c.A = ws + W_O;      c.B = ws + W_WMO;   c.lda = 1024; c.ldb = 1024; c.K = 1024; c.nbig = 256; c.nsmall = 256; c.ncol64 = 16; c.ekind = E_MO; break;
    case 12: c.A = ws + W_H;      c.B = ws + W_WUP;   c.lda = 1024; c.ldb = 1024; c.K = 1024; c.nbig = 66 * 22; c.nsmall = 0; c.ncol64 = 88; c.ekind = E_UP; break;
    default: c.A = ws + W_ACT;    c.B = ws + W_WDOWN; c.lda = 2816; c.ldb = 2816; c.K = 2816; c.nbig = 256; c.nsmall = 256; c.ncol64 = 16; c.ekind = E_DOWN; break;
    }
    return c;
}
struct UnitD { const char* A; const char* B; int row0, col0, ekind; };
__device__ __forceinline__ void map_unit(int L, int nM, int nN, int& pm, int& pn) {
    const int nwg = nM * nN, q = nwg >> 3, r = nwg & 7, xcd = L & 7, off = L >> 3;
    const int wgid = (xcd < r ? xcd * (q + 1) : r * (q + 1) + (xcd - r) * q) + off;
    const int nig = 8 * nN, gid = wgid / nig, fm = gid * 8, gsz = (nM - fm) < 8 ? (nM - fm) : 8;
    const int w = wgid - gid * nig;
    pm = fm + w % gsz; pn = w / gsz;
}
__device__ __forceinline__ UnitD unit_decode(PP P, const PhaseCfg& c, int gp, int L) {
    UnitD d; d.ekind = c.ekind;
    int pm, pn;
    switch (gp) {
    case 1:
        if (L < 924) { map_unit(L, 66, 14, pm, pn); d.A = c.A + (size_t)pm * 256 * 2048; d.B = c.B + (size_t)pn * 256 * 2048; }
        else { map_unit(L - 924, 8, 8, pm, pn); d.A = P->ws + W_HM + (size_t)pm * 256 * 2048; d.B = P->ws + W_WMK + (size_t)pn * 256 * 2048; d.ekind = E_MEMKV; }
        break;
    case 3: map_unit(L, 64, 4, pm, pn); d.A = c.A + (size_t)pm * 256 * 2048 + pn * 512; d.B = c.B + (size_t)pn * 131072; break;
    case 8: map_unit(L, 64, 4, pm, pn); d.A = c.A + (size_t)pm * 256 * 2048 + pn * 512; d.B = c.B + (size_t)(pm >> 3) * 256 * 2048 + pn * 512; break;
    case 9: map_unit(L, 64, 4, pm, pn); d.A = c.A + (size_t)pm * 256 * 2048 + pn * 512; d.B = c.B + (size_t)((pm >> 3) * 4 + pn) * 131072; break;
    case 12: map_unit(L, 66, 22, pm, pn); d.A = c.A + (size_t)pm * 256 * 2048; d.B = c.B + (size_t)pn * 256 * 2048; break;
    default: map_unit(L, 64, 4, pm, pn); d.A = c.A + (size_t)pm * 256 * c.lda * 2; d.B = c.B + (size_t)pn * 256 * c.ldb * 2; break;
    }
    d.row0 = pm * 256; d.col0 = pn * 256;
    return d;
}

__device__ __forceinline__ void gemm_phase(PP P, int gp, char* shm_g, int lb, int blk, int nblk, const int tid) {
    LDSB unsigned char* lds = (LDSB unsigned char*)shm_g;
    const int wid = __builtin_amdgcn_readfirstlane(tid >> 6), lane = tid & 63, wr = wid >> 2, wc = wid & 3, fr = lane & 15, fq = lane >> 4;
    const PhaseCfg cfg = phase_cfg(P, gp);
    const int K = cfg.K, nt = K / 64;
    unsigned voffA, voffB;
    { int R, C; stage_rc(tid * 16, R, C); voffA = (unsigned)(R * cfg.lda + C) * 2u; voffB = (unsigned)(R * cfg.ldb + C) * 2u; }
    const size_t qstepvoffA = (size_t)64 * cfg.lda * 2, qstepvoffB = (size_t)64 * cfg.ldb * 2;
    const size_t kstep = 128;
    const size_t hstepA = (size_t)128 * cfg.lda * 2, hstepB = (size_t)128 * cfg.ldb * 2;
    const unsigned ldsw = (unsigned)wid * 1024u;
    const int aoff = lds_byte(wr * 64 + fr, fq * 8), boff = lds_byte(wc * 32 + fr, fq * 8);
    const bool chain = (cfg.ekind != E_QK);
#define G_SA(b, h) (((b) * 2 + (h)) * HTB)
#define G_SB(b, h) ((4 + (b) * 2 + (h)) * HTB)
#define G_STAGE(bufoff, gbase, voff) do { \
        __builtin_amdgcn_global_load_lds((const unsigned*)((const char*)(gbase) + (voff)), (LDSB unsigned*)(lds + (bufoff) + ldsw), 16, 0, 0); \
        __builtin_amdgcn_global_load_lds((const unsigned*)((const char*)(gbase) + qstep##voff + (voff)), (LDSB unsigned*)(lds + (bufoff) + ldsw + 8192), 16, 0, 0); } while (0)
#define G_LDA(dst, b, h) do { _Pragma("unroll") for (int m = 0; m < 4; ++m) _Pragma("unroll") for (int k = 0; k < 2; ++k) dst[m][k] = *(const LDSB bf16x8*)(lds + G_SA(b, h) + aoff + m * 2048 + k * 1024); } while (0)
#define G_LDB(dst, b, h) do { _Pragma("unroll") for (int n = 0; n < 2; ++n) _Pragma("unroll") for (int k = 0; k < 2; ++k) dst[n][k] = *(const LDSB bf16x8*)(lds + G_SB(b, h) + boff + n * 2048 + k * 1024); } while (0)
#define G_MMA(ai, bj, Af, Bf) do { __builtin_amdgcn_s_setprio(1); _Pragma("unroll") for (int m = 0; m < 4; ++m) _Pragma("unroll") for (int n = 0; n < 2; ++n) _Pragma("unroll") for (int k = 0; k < 2; ++k) \
        acc[ai][bj][m][n] = __builtin_amdgcn_mfma_f32_16x16x32_bf16(Bf[n][k], Af[m][k], acc[ai][bj][m][n], 0, 0, 0); __builtin_amdgcn_s_setprio(0); } while (0)
#define G_WAIT_V(n) asm volatile("s_waitcnt vmcnt(" #n ")" ::: "memory")
#define G_WAIT_L(n) asm volatile("s_waitcnt lgkmcnt(" #n ")" ::: "memory")
#define G_BAR __builtin_amdgcn_s_barrier()
#define G_SCHED __builtin_amdgcn_sched_barrier(0)
    int u = blk;
    while (u < cfg.nbig) {
        UnitD cur = unit_decode(P, cfg, gp, u);
        f32x4 acc[2][2][4][2];
#pragma unroll
        for (int a = 0; a < 2; ++a)
#pragma unroll
            for (int b = 0; b < 2; ++b)
#pragma unroll
                for (int m = 0; m < 4; ++m)
#pragma unroll
                    for (int n = 0; n < 2; ++n) acc[a][b][m][n] = (f32x4){0.f, 0.f, 0.f, 0.f};
        bf16x8 At[4][2], B0[2][2], B1[2][2];
        const char* cA = cur.A; const char* cB = cur.B;
        G_STAGE(G_SB(0, 0), cB, voffB); G_STAGE(G_SA(0, 0), cA, voffA); G_STAGE(G_SB(0, 1), cB + hstepB, voffB); G_STAGE(G_SA(0, 1), cA + hstepA, voffA);
        if (wr == 1) G_BAR;
        G_WAIT_V(4); G_BAR;
        G_STAGE(G_SB(1, 0), cB + kstep, voffB); G_STAGE(G_SA(1, 0), cA + kstep, voffA); G_STAGE(G_SB(1, 1), cB + hstepB + kstep, voffB);
        G_WAIT_V(6); G_BAR;
        for (;;) {
            const bool has_next = chain && (u + nblk < cfg.nbig);
            UnitD nxt = cur;
            if (has_next) nxt = unit_decode(P, cfg, gp, u + nblk);
            const char* nA = nxt.A; const char* nB = nxt.B;
            for (int t = 0; t < nt; t += 2) {
                const bool last = (t == nt - 2);
                const char* a1 = cA + (size_t)(t + 1) * kstep;
                const char* a2 = last ? nA : cA + (size_t)(t + 2) * kstep; const char* b2 = last ? nB : cB + (size_t)(t + 2) * kstep;
                const char* a3 = a2 + kstep; const char* b3 = b2 + kstep;
                G_LDB(B0, 0, 0); G_SCHED; G_LDA(At, 0, 0); G_STAGE(G_SA(1, 1), a1 + hstepA, voffA);
                G_WAIT_L(8); G_BAR; G_WAIT_L(0); G_MMA(0, 0, At, B0); G_BAR; G_SCHED;
                G_LDB(B1, 0, 1); G_STAGE(G_SB(0, 0), b2, voffB);
                G_BAR; G_WAIT_L(0); G_MMA(0, 1, At, B1); G_BAR;
                G_LDA(At, 0, 1); G_STAGE(G_SA(0, 0), a2, voffA);
                G_BAR; G_WAIT_L(0); G_MMA(1, 0, At, B0); G_BAR; G_SCHED;
                G_STAGE(G_SB(0, 1), b2 + hstepB, voffB);
                G_WAIT_V(6); G_BAR; G_MMA(1, 1, At, B1); G_BAR;
                G_LDB(B0, 1, 0); G_SCHED; G_LDA(At, 1, 0); G_STAGE(G_SA(0, 1), a2 + hstepA, voffA);
                G_WAIT_L(8); G_BAR; G_WAIT_L(0); G_MMA(0, 0, At, B0); G_BAR; G_SCHED;
                G_LDB(B1, 1, 1); G_STAGE(G_SB(1, 0), b3, voffB);
                G_BAR; G_WAIT_L(0); G_MMA(0, 1, At, B1); G_BAR;
                G_LDA(At, 1, 1); G_STAGE(G_SA(1, 0), a3, voffA);
                G_BAR; G_WAIT_L(0); G_MMA(1, 0, At, B0); G_BAR; G_SCHED;
                G_STAGE(G_SB(1, 1), b3 + hstepB, voffB);
                G_WAIT_V(6); G_BAR; G_MMA(1, 1, At, B1); G_BAR;
            }
            if (chain) {
                const int rbase = cur.row0 + wr * 64 + fr, cbase = cur.col0 + wc * 32 + fq * 4;
                switch (cur.ekind) {
                case E_PROJ: epi_loop<E_PROJ>(P, acc, rbase, cbase, fq); break;
                case E_MEMKV: epi_loop<E_MEMKV>(P, acc, rbase, cbase, fq); break;
                case E_POOL: epi_loop<E_POOL>(P, acc, rbase, cbase, fq); break;
                case E_OUT: epi_loop<E_OUT>(P, acc, rbase, cbase, fq); break;
                case E_Q: epi_loop<E_Q>(P, acc, rbase, cbase, fq); break;
                case E_PV: epi_loop<E_PV>(P, acc, rbase, cbase, fq); break;
                case E_MO: epi_loop<E_MO>(P, acc, rbase, cbase, fq); break;
                case E_UP: epi_loop<E_UP>(P, acc, rbase, cbase, fq); break;
                default: epi_loop<E_DOWN>(P, acc, rbase, cbase, fq); break;
                }
            }
            if (!has_next) break;
#pragma unroll
            for (int a = 0; a < 2; ++a)
#pragma unroll
                for (int b = 0; b < 2; ++b)
#pragma unroll
                    for (int m = 0; m < 4; ++m)
#pragma unroll
                        for (int n = 0; n < 2; ++n) acc[a][b][m][n] = (f32x4){0.f, 0.f, 0.f, 0.f};
            cur = nxt; cA = nA; cB = nB; u += nblk;
        }
        G_WAIT_V(0);
        if (wr == 0) G_BAR;
        G_BAR;
        if (!chain) {
            float* redm = (float*)(shm_g + 131072);
            float* reds = (float*)(shm_g + 135168);
#pragma unroll
            for (int ai = 0; ai < 2; ++ai)
#pragma unroll
                for (int m = 0; m < 4; ++m) {
                    float t = -3.0e38f;
#pragma unroll
                    for (int bj = 0; bj < 2; ++bj)
#pragma unroll
                        for (int n = 0; n < 2; ++n)
#pragma unroll
                            for (int j = 0; j < 4; ++j) t = fmaxf(t, acc[ai][bj][m][n][j]);
                    t = fmaxf(t, __shfl_xor(t, 16)); t = fmaxf(t, __shfl_xor(t, 32));
                    if (fq == 0) redm[(ai * 128 + wr * 64 + m * 16 + fr) * 4 + wc] = t;
                }
            __syncthreads();
#pragma unroll
            for (int ai = 0; ai < 2; ++ai)
#pragma unroll
                for (int m = 0; m < 4; ++m) {
                    const f32x4 r = *(const f32x4*)(redm + (ai * 128 + wr * 64 + m * 16 + fr) * 4);
                    const float M = fmaxf(fmaxf(r[0], r[1]), fmaxf(r[2], r[3]));
                    float s = 0.f;
#pragma unroll
                    for (int bj = 0; bj < 2; ++bj)
#pragma unroll
                        for (int n = 0; n < 2; ++n)
#pragma unroll
                            for (int j = 0; j < 4; ++j) { const float e = __expf(acc[ai][bj][m][n][j] - M); acc[ai][bj][m][n][j] = e; s += e; }
                    s += __shfl_xor(s, 16); s += __shfl_xor(s, 32);
                    if (fq == 0) reds[(ai * 128 + wr * 64 + m * 16 + fr) * 4 + wc] = s;
                }
            __syncthreads();
#pragma unroll
            for (int ai = 0; ai < 2; ++ai)
#pragma unroll
                for (int m = 0; m < 4; ++m) {
                    const int rl = ai * 128 + wr * 64 + m * 16 + fr;
                    const f32x4 r = *(const f32x4*)(reds + rl * 4);
                    const float inv = 1.0f / ((r[0] + r[1]) + (r[2] + r[3]));
                    bf16_t* prow = (bf16_t*)(P->ws + W_P) + (size_t)(cur.row0 + rl) * 1024 + cur.col0;
#pragma unroll
                    for (int bj = 0; bj < 2; ++bj) {
                        const f32x4 v0 = acc[ai][bj][m][0], v1 = acc[ai][bj][m][1];
                        u32x4 o; o.x = pk2(v0[0] * inv, v0[1] * inv); o.y = pk2(v0[2] * inv, v0[3] * inv); o.z = pk2(v1[0] * inv, v1[1] * inv); o.w = pk2(v1[2] * inv, v1[3] * inv);
                        *(u32x4*)(prow + bj * 128 + wc * 32 + fq * 8) = o;
                    }
                }
            __syncthreads();
        }
        u += nblk;
    }
#undef G_SA
#undef G_SB
#undef G_STAGE
#undef G_LDA
#undef G_LDB
#undef G_MMA
    const int rot = cfg.nbig % nblk;
    for (int s0 = (lb - rot + nblk) % nblk; s0 < cfg.nsmall; s0 += nblk) {
        const int pr = s0 / cfg.ncol64, pc = s0 % cfg.ncol64;
        const int row0 = (gp == 1 ? 0 : TP) + pr * 32, col0 = pc * 64;
        int lda_s = cfg.lda, ldb_s = cfg.ldb, K_s = K, ek_s = cfg.ekind;
        const bf16_t* Ab; const bf16_t* Bb;
        if (gp == 1) {
            const int g = pc >> 2; lda_s = 1024; ldb_s = 256; K_s = 256; ek_s = E_FOLD;
            Ab = (const bf16_t*)(P->ws + W_WLO) + (size_t)row0 * 1024 + g * 256; Bb = (const bf16_t*)(P->ws + W_WPOOL) + (size_t)g * 65536 + (size_t)(col0 - g * 256) * 256;
        } else { Ab = (const bf16_t*)cfg.A + (size_t)row0 * cfg.lda; Bb = (const bf16_t*)cfg.B + (size_t)col0 * cfg.ldb; }
        const int kw = K_s >> 3, nks = kw >> 5;
        f32x4 acc[2][4];
#pragma unroll
        for (int mi = 0; mi < 2; ++mi)
#pragma unroll
            for (int ni = 0; ni < 4; ++ni) acc[mi][ni] = (f32x4){0.f, 0.f, 0.f, 0.f};
        const bf16_t* ap = Ab + (size_t)fr * lda_s + wid * kw + fq * 8;
        const bf16_t* bp = Bb + (size_t)fr * ldb_s + wid * kw + fq * 8;
        for (int ks0 = 0; ks0 < nks; ks0 += 4) {
            bf16x8 a[4][2], b[4][4];
#pragma unroll
            for (int q = 0; q < 4; ++q) {
                const bool ok = ks0 + q < nks;
#pragma unroll
                for (int mi = 0; mi < 2; ++mi) { bf16x8 z = {0, 0, 0, 0, 0, 0, 0, 0}; if (ok) z = *(const bf16x8*)(ap + (size_t)mi * 16 * lda_s + (ks0 + q) * 32); a[q][mi] = z; }
#pragma unroll
                for (int ni = 0; ni < 4; ++ni) { bf16x8 z = {0, 0, 0, 0, 0, 0, 0, 0}; if (ok) z = *(const bf16x8*)(bp + (size_t)ni * 16 * ldb_s + (ks0 + q) * 32); b[q][ni] = z; }
            }
#pragma unroll
            for (int q = 0; q < 4; ++q)
#pragma unroll
                for (int mi = 0; mi < 2; ++mi)
#pragma unroll
                    for (int ni = 0; ni < 4; ++ni) acc[mi][ni] = __builtin_amdgcn_mfma_f32_16x16x32_bf16(b[q][ni], a[q][mi], acc[mi][ni], 0, 0, 0);
        }
        float* red = (float*)shm_g;
#pragma unroll
        for (int mi = 0; mi < 2; ++mi)
#pragma unroll
            for (int ni = 0; ni < 4; ++ni) *(f32x4*)(red + wid * 2048 + (mi * 16 + fr) * 64 + ni * 16 + fq * 4) = acc[mi][ni];
        __syncthreads();
        {
            const int r = tid >> 4, c = (tid & 15) * 4;
            f32x4 v = *(const f32x4*)(red + r * 64 + c);
#pragma unroll
            for (int w = 1; w < 8; ++w) v += *(const f32x4*)(red + w * 2048 + r * 64 + c);
            const int cl = (gp == 1) ? c : (c & 32) + perm32(c & 31);
            float ss = epi_apply_rt(P, ek_s, row0 + r, col0 + cl, v);
            if (cfg.ekind == E_OUT || cfg.ekind == E_MO || cfg.ekind == E_DOWN) {
                ss += __shfl_xor(ss, 1); ss += __shfl_xor(ss, 2); ss += __shfl_xor(ss, 4); ss += __shfl_xor(ss, 8);
                if ((tid & 15) == 0) unsafeAtomicAdd((float*)(P->ws + (cfg.ekind == E_OUT ? W_SS1 : cfg.ekind == E_MO ? W_SS2 : W_SS3)) + row0 + r, ss);
            }
        }
        __syncthreads();
    }
}

struct TrDesc { const float* src; bf16_t* dst; const float* gain; int ld_src, ld_dst, k0, n0s, n0d, perm; };
__device__ __forceinline__ TrDesc tr_decode(PP P, int i) {
    char* ws = P->ws; TrDesc d; d.gain = nullptr; d.perm = 0;
    if (i < 896) { const int kt = i / 56, ntl = i % 56; d.n0d = ntl * 64; d.n0s = d.n0d < 2560 ? d.n0d : d.n0d + 16; d.src = P->w_in; d.ld_src = 3600; d.dst = (bf16_t*)(ws + W_WIN); d.ld_dst = 1024; d.k0 = kt * 64; d.perm = 1; return d; }
    i -= 896;
    if (i < 512) { const int kt = i >> 4, ntl = i & 15; d.ld_src = 1024; d.n0s = d.n0d = ntl * 64;
        d.perm = kt < 16 ? 1 : 0;
        if (kt < 16) { d.src = P->w_out; d.dst = (bf16_t*)(ws + W_WOUT); d.ld_dst = 2048; d.k0 = kt * 64; }
        else { d.src = P->w_out + (size_t)1024 * 1024; d.dst = (bf16_t*)(ws + W_WLO); d.ld_dst = 1024; d.k0 = (kt - 16) * 64; }
        return d; }
    i -= 512;
    if (i < 1024) { const int wsel = i >> 8, r = i & 255, kt = r >> 4, ntl = r & 15;
        d.src = wsel == 0 ? P->w_mq : wsel == 1 ? P->w_mk : wsel == 2 ? P->w_mv : P->w_mo;
        d.dst = (bf16_t*)(ws + (wsel == 0 ? W_WMQ : wsel == 1 ? W_WMK : wsel == 2 ? W_WMV : W_WMO));
        d.gain = wsel == 0 ? P->norm_mem : nullptr; d.ld_src = 1024; d.ld_dst = 1024; d.k0 = kt * 64; d.n0s = d.n0d = ntl * 64; d.perm = (wsel == 0 || wsel == 3) ? 1 : 0; return d; }
    i -= 1024;
    if (i < 1408) { const int kt = i / 88, ntl = i % 88; d.src = P->w_up; d.ld_src = 5632; d.dst = (bf16_t*)(ws + W_WUP); d.ld_dst = 1024; d.gain = P->norm_ffn; d.k0 = kt * 64; d.n0s = d.n0d = ntl * 64; d.perm = 1; return d; }
    i -= 1408;
    { const int kt = i >> 4, ntl = i & 15; d.src = P->w_down; d.ld_src = 1024; d.dst = (bf16_t*)(ws + W_WDOWN); d.ld_dst = 2816; d.k0 = kt * 64; d.n0s = d.n0d = ntl * 64; d.perm = 1; return d; }
}

__device__ __forceinline__ void phase_prep(PP P, char* shm, int blk, int nblk, const int tid) {
    const int wid = tid >> 6, lane = tid & 63;
    float* tiles = (float*)shm;
    float* wdt = (float*)(shm + 69632);
    for (int i = blk * NTHR + tid; i < 3 * TT; i += nblk * NTHR) ((float*)(P->ws + W_SS1))[i] = 0.f;
    for (int i = (blk * NTHR + tid) * 4; i < 4 * 65536; i += nblk * NTHR * 4) {
        const f32x4 wv = *(const f32x4*)(P->w_pool + i), sv = *(const f32x4*)(P->pool_scale + (i >> 16) * 256 + (i & 255));
        u32x2 o; o.x = pk2(wv[0] * sv[0], wv[1] * sv[1]); o.y = pk2(wv[2] * sv[2], wv[3] * sv[3]);
        *(u32x2*)((bf16_t*)(P->ws + W_WPOOL) + i) = o;
    }
    for (int i = tid; i < 1024 * 16; i += NTHR) { const int k = i >> 4, hd = i & 15; wdt[hd * 1024 + k] = P->w_in[(size_t)k * 3600 + 2560 + hd]; }
    __syncthreads();
    char* ws = P->ws;
    constexpr int NGRP = (TT + 2048) / 32;
    for (int it = blk; it < NGRP; it += nblk) {
        const int rbase = it * 32 + wid * 4;
        const bool ismem = rbase >= TT;
        f32x4 xv[4][4];
#pragma unroll
        for (int r = 0; r < 4; ++r) {
            const int row = (ismem ? rbase - TT : rbase) + r;
            const float* xr = ismem ? P->mem_prompt + (size_t)row * 1024 : (row < TP ? P->x_prompt + (size_t)row * 1024 : P->x_sample + (size_t)(row - TP) * 1024);
#pragma unroll
            for (int j = 0; j < 4; ++j) xv[r][j] = __builtin_nontemporal_load((const f32x4*)(xr + j * 256 + lane * 4));
        }
        const float* gg = ismem ? P->norm_memkv : P->norm_mix;
#pragma unroll
        for (int r = 0; r < 4; ++r) {
            const int row = (ismem ? rbase - TT : rbase) + r;
            bf16_t* orow = (bf16_t*)(ws + (ismem ? W_HM : W_H)) + (size_t)row * 1024;
            float ss = 0.f;
#pragma unroll
            for (int j = 0; j < 4; ++j) ss += xv[r][j][0] * xv[r][j][0] + xv[r][j][1] * xv[r][j][1] + xv[r][j][2] * xv[r][j][2] + xv[r][j][3] * xv[r][j][3];
            ss = wave_sum(ss);
            const float rstd = rsqrtf(ss * (1.0f / 1024.0f) + EPS);
#pragma unroll
            for (int j = 0; j < 4; ++j) { const f32x4 g4 = *(const f32x4*)(gg + j * 256 + lane * 4); xv[r][j] = xv[r][j] * rstd * g4;
                u32x2 o; o.x = pk2(xv[r][j][0], xv[r][j][1]); o.y = pk2(xv[r][j][2], xv[r][j][3]); *(u32x2*)(orow + j * 256 + lane * 4) = o; }
        }
        if (!ismem) {
            float vals[64];
#pragma unroll
            for (int hd = 0; hd < 16; ++hd) {
                f32x4 w4[4];
#pragma unroll
                for (int j = 0; j < 4; ++j) w4[j] = *(const f32x4*)(wdt + hd * 1024 + j * 256 + lane * 4);
#pragma unroll
                for (int r = 0; r < 4; ++r) {
                    float a = 0.f;
#pragma unroll
                    for (int j = 0; j < 4; ++j) a += xv[r][j][0] * w4[j][0] + xv[r][j][1] * w4[j][1] + xv[r][j][2] * w4[j][2] + xv[r][j][3] * w4[j][3];
                    vals[r * 16 + hd] = a;
                }
            }
#pragma unroll
            for (int half = 32; half >= 1; half >>= 1) {
                const bool hi = (lane & half) != 0;
#pragma unroll
                for (int i = 0; i < half; ++i) {
                    const float keep = hi ? vals[i + half] : vals[i], send = hi ? vals[i] : vals[i + half];
                    vals[i] = keep + __shfl_xor(send, half);
                }
            }
            const float x = vals[0] + P->dt_bias[lane & 15];
            const float ey = __expf(-fabsf(x)); const float l1p = ey < 0.03f ? ey * (1.0f - ey * (0.5f - ey * (0.33333333f - 0.25f * ey))) : __logf(1.0f + ey);
            ((float*)(ws + W_DT))[(size_t)rbase * 16 + lane] = fmaxf(x, 0.f) + l1p;
        }
    }
    __syncthreads();
    const int kr = tid >> 4, nc = (tid & 15) * 4, tn = tid >> 3, tk8 = (tid & 7) * 8;
    for (int it = blk; it < 4544; it += 4 * nblk) {
        f32x4 v[4][2];
#pragma unroll
        for (int q = 0; q < 4; ++q) {
            const int i = it + q * nblk;
            if (i < 4544) { const TrDesc d = tr_decode(P, i);
#pragma unroll
                for (int h = 0; h < 2; ++h) { const int k = kr + h * 32; f32x4 t = __builtin_nontemporal_load((const f32x4*)(d.src + (size_t)(d.k0 + k) * d.ld_src + d.n0s + nc)); if (d.gain) t *= d.gain[d.k0 + k]; v[q][h] = t; } }
        }
#pragma unroll
        for (int q = 0; q < 4; ++q) {
            if (it + q * nblk < 4544) { float* tile = tiles + q * (64 * 65);
#pragma unroll
                for (int h = 0; h < 2; ++h) { const int k = kr + h * 32; tile[k * 65 + nc + 0] = v[q][h][0]; tile[k * 65 + nc + 1] = v[q][h][1]; tile[k * 65 + nc + 2] = v[q][h][2]; tile[k * 65 + nc + 3] = v[q][h][3]; } }
        }
        __syncthreads();
#pragma unroll
        for (int q = 0; q < 4; ++q) {
            const int i = it + q * nblk;
            if (i < 4544) { const TrDesc d = tr_decode(P, i); const float* tile = tiles + q * (64 * 65); float f[8];
                const int sc = d.perm ? (tn & 32) + perm32(tn & 31) : tn;
#pragma unroll
                for (int e2 = 0; e2 < 8; ++e2) f[e2] = tile[(tk8 + e2) * 65 + sc];
                *(u32x4*)(d.dst + (size_t)(d.n0d + tn) * d.ld_dst + d.k0 + tk8) = pack8(f); }
        }
        __syncthreads();
    }
}

__device__ __forceinline__ u32x4 ld8(const bf16_t* p) { return *(const u32x4*)p; }

__device__ __forceinline__ void phase_convpool(PP P, int gtid, int nthreads) {
    char* ws = P->ws;
    const bf16_t* proj2 = (const bf16_t*)(ws + W_PROJ2);
    bf16_t* xact = (bf16_t*)(ws + W_XACT);
    bf16_t* pooled = (bf16_t*)(ws + W_POOLED);
    for (int idx = gtid; idx < 1152 * 320; idx += nthreads) {
        const int run = idx / 320, cg = idx % 320;
        const bool samp = run >= 1024;
        int t0, len, bidx, tl0;
        if (!samp) { t0 = run * 16; len = 16; bidx = t0 >> 11; tl0 = t0 & 2047; } else { bidx = run - 1024; t0 = TP + bidx * 4; len = 4; tl0 = 0; }
        if (cg < 192) {
            const int c0 = cg * 8;
            float w0[8], w1[8], w2[8], w3[8], bs[8], h0[8], h1[8], h2[8];
#pragma unroll
            for (int e = 0; e < 8; ++e) { w0[e] = P->conv_w[c0 + e]; w1[e] = P->conv_w[1536 + c0 + e]; w2[e] = P->conv_w[3072 + c0 + e]; w3[e] = P->conv_w[4608 + c0 + e]; bs[e] = P->conv_b[c0 + e]; }
            if (samp) {
#pragma unroll
                for (int e = 0; e < 8; ++e) { h0[e] = P->state_conv[(size_t)(bidx * 3 + 0) * 1536 + c0 + e]; h1[e] = P->state_conv[(size_t)(bidx * 3 + 1) * 1536 + c0 + e]; h2[e] = P->state_conv[(size_t)(bidx * 3 + 2) * 1536 + c0 + e]; }
            } else if (tl0 > 0) {
                unpack8(ld8(proj2 + (size_t)(t0 - 3) * 2560 + c0), h0); unpack8(ld8(proj2 + (size_t)(t0 - 2) * 2560 + c0), h1); unpack8(ld8(proj2 + (size_t)(t0 - 1) * 2560 + c0), h2);
            } else {
#pragma unroll
                for (int e = 0; e < 8; ++e) { h0[e] = 0.f; h1[e] = 0.f; h2[e] = 0.f; }
            }
            u32x4 rx[16];
#pragma unroll
            for (int j = 0; j < 16; ++j) { if (j < len) rx[j] = __builtin_nontemporal_load((const u32x4*)(proj2 + (size_t)(t0 + j) * 2560 + c0)); }
#pragma unroll
            for (int j = 0; j < 16; ++j) {
                if (j < len) {
                float x3[8], y[8]; unpack8(rx[j], x3);
#pragma unroll
                for (int e = 0; e < 8; ++e) { const float v = bs[e] + w0[e] * h0[e] + w1[e] * h1[e] + w2[e] * h2[e] + w3[e] * x3[e]; y[e] = silu_f(v); }
                *(u32x4*)(xact + (size_t)(t0 + j) * 1536 + c0) = pack8(y);
                if (samp) { if (j >= 1) { float* o = P->out + O_CONVS + (size_t)(bidx * 3 + j - 1) * 1536 + c0;
#pragma unroll
                        for (int e = 0; e < 8; ++e) o[e] = x3[e]; } }
                else { const int tl = tl0 + j; if (tl >= 2045) { float* o = P->out + O_CONVP + (size_t)(bidx * 3 + tl - 2045) * 1536 + c0;
#pragma unroll
                        for (int e = 0; e < 8; ++e) o[e] = x3[e]; } }
#pragma unroll
                for (int e = 0; e < 8; ++e) { h0[e] = h1[e]; h1[e] = h2[e]; h2[e] = x3[e]; }
                }
            }
        } else {
            const int c0 = (cg - 192) * 8; const int win = 2 << (c0 >> 8);
            const bf16_t* vp = proj2 + 1536 + c0;
            const float* prev = P->state_pool + (size_t)bidx * 15 * 1024 + c0;
            float sum[8];
#pragma unroll
            for (int e = 0; e < 8; ++e) sum[e] = 0.f;
            if (samp) {
                for (int jj = 1; jj < win; ++jj) {
#pragma unroll
                    for (int e = 0; e < 8; ++e) sum[e] += prev[(size_t)(15 - jj) * 1024 + e]; }
                float* o = P->out + O_POOLS + (size_t)bidx * 15 * 1024 + c0;
                for (int i = 0; i < 11; ++i) {
#pragma unroll
                    for (int e = 0; e < 8; ++e) o[(size_t)i * 1024 + e] = prev[(size_t)(i + 4) * 1024 + e]; }
            } else if (tl0 > 0) {
                for (int jj = 1; jj < win; ++jj) { float v[8]; unpack8(ld8(vp + (size_t)(t0 - jj) * 2560), v);
#pragma unroll
                    for (int e = 0; e < 8; ++e) sum[e] += v[e]; }
            }
            u32x4 rp[16];
#pragma unroll
            for (int j = 0; j < 16; ++j) { if (j < len) rp[j] = ld8(vp + (size_t)(t0 + j) * 2560); }
#pragma unroll
            for (int j = 0; j < 16; ++j) {
                if (j >= len) continue;
                float v[8], o8[8]; unpack8(rp[j], v);
                const int tl = tl0 + j;
                const float inv = 1.0f / (float)(samp ? win : (tl + 1 < win ? tl + 1 : win));
#pragma unroll
                for (int e = 0; e < 8; ++e) { sum[e] += v[e]; o8[e] = sum[e] * inv - v[e]; }
                *(u32x4*)((bf16_t*)(ws + W_MIX) + (size_t)(t0 + j) * 2048 + 1024 + c0) = pack8(o8);
                const int to = j - win + 1;
                if (samp) {
                    if (to >= 0) { float q[8]; unpack8(ld8(vp + (size_t)(t0 + to) * 2560), q);
#pragma unroll
                        for (int e = 0; e < 8; ++e) sum[e] -= q[e]; }
                    else {
#pragma unroll
                        for (int e = 0; e < 8; ++e) sum[e] -= prev[(size_t)(15 + to) * 1024 + e]; }
                    float* o = P->out + O_POOLS + (size_t)(bidx * 15 + 11 + j) * 1024 + c0;
#pragma unroll
                    for (int e = 0; e < 8; ++e) o[e] = v[e];
                } else {
                    if (tl0 + to >= 0) { float q[8]; unpack8(ld8(vp + (size_t)(t0 + to) * 2560), q);
#pragma unroll
                        for (int e = 0; e < 8; ++e) sum[e] -= q[e]; }
                    if (tl >= 2033) { float* o = P->out + O_POOLP + (size_t)(bidx * 15 + tl - 2033) * 1024 + c0;
#pragma unroll
                        for (int e = 0; e < 8; ++e) o[e] = v[e]; }
                }
            }
        }
    }
}

constexpr int CS_STR = 136;
constexpr int X_STR = 40;
__device__ __forceinline__ s16x4 tr_read(const bf16_t* p) { return __builtin_bit_cast(s16x4, __builtin_amdgcn_ds_read_tr16_b64_v4i16((LDSB s16x4*)p)); }

#define LDS_BARRIER() asm volatile("s_waitcnt lgkmcnt(0)\n\ts_barrier" ::: "memory")
__device__ __forceinline__ void ssd_prompt(PP P, int item, char* shm, const int tid) {
    const int w = tid >> 6, lane = tid & 63, fr = lane & 15, fq = lane >> 4;
    const int b = item >> 5, hd = (item >> 1) & 15, ph = item & 1, g = hd >> 3;
    const float a = -expf(P->a_log[hd]);
    const float Dh = P->ssm_d[hd];
    char* ws = P->ws;
    const bf16_t* xact = (const bf16_t*)(ws + W_XACT);
    const float* dtb = (const float*)(ws + W_DT);
    bf16_t* ybuf = (bf16_t*)(ws + W_Y);
    bf16_t* Cs = (bf16_t*)(shm);
    bf16_t* Bs = (bf16_t*)(shm + 34816);
    bf16_t* Xd = (bf16_t*)(shm + 69632);
    bf16_t* X2 = (bf16_t*)(shm + 69632 + 10240);
    bf16_t* Ht = (bf16_t*)(shm + 69632 + 20480);
    float* acs = (float*)(shm + 69632 + 30720);
    float* dts = (float*)(shm + 69632 + 31232);
    f32x4 Hacc[2];
    Hacc[0] = (f32x4){0.f, 0.f, 0.f, 0.f}; Hacc[1] = (f32x4){0.f, 0.f, 0.f, 0.f};
    const int q4 = fr >> 2, p4 = fr & 3;
    u32x4 pc[4], pb[4], px; float pd0, pd1;
    const int ls = tid >> 4, ln8 = (tid & 15) * 8;
    const int xs = tid >> 2, xp8 = (tid & 3) * 8;
#define SSD_PREFETCH(cc) do { const int _t0 = b * 2048 + (cc) * 128; \
        _Pragma("unroll") for (int i = 0; i < 4; ++i) { const bf16_t* src = xact + (size_t)(_t0 + ls + i * 32) * 1536 + g * 128 + ln8; pc[i] = *(const u32x4*)(src + 1280); pb[i] = *(const u32x4*)(src + 1024); } \
        px = __builtin_nontemporal_load((const u32x4*)(xact + (size_t)(_t0 + xs) * 1536 + hd * 64 + ph * 32 + xp8)); \
        pd0 = dtb[(size_t)(_t0 + 2 * lane) * 16 + hd]; pd1 = dtb[(size_t)(_t0 + 2 * lane + 1) * 16 + hd]; } while (0)
    SSD_PREFETCH(0);
    for (int c = 0; c < 16; ++c) {
        const int t0 = b * 2048 + c * 128;
        if (w == 0) {
            const float d0 = pd0, d1 = pd1;
            const float s = (d0 + d1) * a; float v = s;
#pragma unroll
            for (int off = 1; off < 64; off <<= 1) { const float t = __shfl_up(v, off); if (lane >= off) v += t; }
            const float excl = v - s;
            acs[2 * lane] = excl + d0 * a; acs[2 * lane + 1] = v; dts[2 * lane] = d0; dts[2 * lane + 1] = d1;
        }
#pragma unroll
        for (int pt = 0; pt < 2; ++pt) { u32x2 o; o.x = pk2(Hacc[pt][0], Hacc[pt][1]); o.y = pk2(Hacc[pt][2], Hacc[pt][3]); *(u32x2*)(Ht + (w * 16 + fr) * X_STR + pt * 16 + fq * 4) = o; }
#pragma unroll
        for (int i = 0; i < 4; ++i) { *(u32x4*)(Cs + (ls + i * 32) * CS_STR + ln8) = pc[i]; *(u32x4*)(Bs + (ls + i * 32) * CS_STR + ln8) = pb[i]; }
        LDS_BARRIER();
        {
            float x[8], xa[8], xb[8]; unpack8(px, x);
            const float dtv = dts[xs], dec = __expf(acs[127] - acs[xs]) * dtv;
#pragma unroll
            for (int e = 0; e < 8; ++e) { xa[e] = x[e] * dtv; xb[e] = x[e] * dec; }
            *(u32x4*)(Xd + xs * X_STR + xp8) = pack8(xa);
            *(u32x4*)(X2 + xs * X_STR + xp8) = pack8(xb);
        }
        if (c < 15) SSD_PREFETCH(c + 1);
        bf16x8 Cf[4];
#pragma unroll
        for (int kk = 0; kk < 4; ++kk) Cf[kk] = *(const bf16x8*)(Cs + (w * 16 + fr) * CS_STR + kk * 32 + fq * 8);
        const int lrow = w * 16 + fr; const float al = acs[lrow];
        bf16x8 Gf[4];
#pragma unroll
        for (int kk = 0; kk < 4; ++kk) {
            u32x2 half[2];
#pragma unroll
            for (int hh = 0; hh < 2; ++hh) {
                const int st = 2 * kk + hh;
                half[hh].x = 0u; half[hh].y = 0u;
                if (st <= w) {
                    f32x4 ga = (f32x4){0.f, 0.f, 0.f, 0.f};
#pragma unroll
                    for (int k2 = 0; k2 < 4; ++k2) { const bf16x8 Bf = *(const bf16x8*)(Bs + (st * 16 + fr) * CS_STR + k2 * 32 + fq * 8); ga = __builtin_amdgcn_mfma_f32_16x16x32_bf16(Bf, Cf[k2], ga, 0, 0, 0); }
                    const int s0 = st * 16 + fq * 4; const f32x4 as4 = *(const f32x4*)(acs + s0);
                    float gv[4];
#pragma unroll
                    for (int j = 0; j < 4; ++j) gv[j] = (s0 + j <= lrow) ? ga[j] * __expf(al - as4[j]) : 0.f;
                    half[hh].x = pk2(gv[0], gv[1]); half[hh].y = pk2(gv[2], gv[3]);
                }
            }
            u32x4 g4; g4.x = half[0].x; g4.y = half[0].y; g4.z = half[1].x; g4.w = half[1].y;
            Gf[kk] = __builtin_bit_cast(bf16x8, g4);
        }
        LDS_BARRIER();
        {
            f32x4 Yd[2], Yo[2];
            Yd[0] = Yd[1] = Yo[0] = Yo[1] = (f32x4){0.f, 0.f, 0.f, 0.f};
            const int nkk = (w >> 1) + 1;
#pragma unroll
            for (int kk = 0; kk < 4; ++kk) {
                if (kk < nkk) {
#pragma unroll
                    for (int pt = 0; pt < 2; ++pt) {
                        const bf16_t* base = Xd + (kk * 32 + fq * 4 + q4) * X_STR + pt * 16 + p4 * 4;
                        bf16x8 Xf; Xf.lo = tr_read(base); Xf.hi = tr_read(base + 16 * X_STR);
                        Yd[pt] = __builtin_amdgcn_mfma_f32_16x16x32_bf16(Xf, Gf[kk], Yd[pt], 0, 0, 0);
                    }
                }
            }
#pragma unroll
            for (int kk = 0; kk < 4; ++kk)
#pragma unroll
                for (int pt = 0; pt < 2; ++pt) {
                    const bf16_t* hbp = Ht + (kk * 32 + fq * 8 + q4) * X_STR + pt * 16 + p4 * 4;
                    bf16x8 Hf; Hf.lo = tr_read(hbp); Hf.hi = tr_read(hbp + 4 * X_STR);
                    Yo[pt] = __builtin_amdgcn_mfma_f32_16x16x32_bf16(Hf, Cf[kk], Yo[pt], 0, 0, 0);
                }
            const float el = __expf(al); const float rdt = Dh / dts[lrow];
#pragma unroll
            for (int pt = 0; pt < 2; ++pt) {
                const u32x2 xr = *(const u32x2*)(Xd + lrow * X_STR + pt * 16 + fq * 4);
                const f32x4 y = Yd[pt] + el * Yo[pt] + rdt * (f32x4){bflo(xr.x), bfhi(xr.x), bflo(xr.y), bfhi(xr.y)};
                u32x2 o; o.x = pk2(y[0], y[1]); o.y = pk2(y[2], y[3]);
                *(u32x2*)(ybuf + (size_t)(t0 + lrow) * 1024 + hd * 64 + ph * 32 + pt * 16 + fq * 4) = o;
            }
        }
        {
            const float dc = __expf(acs[127]);
            Hacc[0] *= dc; Hacc[1] *= dc;
#pragma unroll
            for (int kk = 0; kk < 4; ++kk) {
                const bf16_t* bb = Bs + (kk * 32 + fq * 8 + q4) * CS_STR + w * 16 + p4 * 4;
                bf16x8 Bf; Bf.lo = tr_read(bb); Bf.hi = tr_read(bb + 4 * CS_STR);
#pragma unroll
                for (int pt = 0; pt < 2; ++pt) {
                    const bf16_t* xb = X2 + (kk * 32 + fq * 8 + q4) * X_STR + pt * 16 + p4 * 4;
                    bf16x8 Xf; Xf.lo = tr_read(xb); Xf.hi = tr_read(xb + 4 * X_STR);
                    Hacc[pt] = __builtin_amdgcn_mfma_f32_16x16x32_bf16(Xf, Bf, Hacc[pt], 0, 0, 0);
                }
            }
        }
        LDS_BARRIER();
    }
#undef SSD_PREFETCH
    float* so = P->out + O_SSMP + ((size_t)(b * 16 + hd) * 64 + ph * 32) * 128;
#pragma unroll
    for (int pt = 0; pt < 2; ++pt)
#pragma unroll
        for (int j = 0; j < 4; ++j) so[(size_t)(pt * 16 + fq * 4 + j) * 128 + w * 16 + fr] = Hacc[pt][j];
}

template <int NI>
__device__ __forceinline__ void ssd_sample(PP P, int item0, int istride, const int tid) {
    const int p = tid >> 3, n0 = (tid & 7) * 16;
    char* ws = P->ws;
    const bf16_t* xact = (const bf16_t*)(ws + W_XACT);
    const float* dtb = (const float*)(ws + W_DT);
    bf16_t* ybuf = (bf16_t*)(ws + W_Y);
    f32x4 hs[NI][4]; u32x4 rb[NI][4][2], rc[NI][4][2]; float xv[NI][4], dtv[NI][4];
#pragma unroll
    for (int q = 0; q < NI; ++q) {
        const int item = item0 + q * istride, b = item >> 4, hd = item & 15, g = hd >> 3;
        const size_t sidx = ((size_t)(b * 16 + hd) * 64 + p) * 128 + n0;
#pragma unroll
        for (int i = 0; i < 4; ++i) hs[q][i] = __builtin_nontemporal_load((const f32x4*)(P->state_ssm + sidx + i * 4));
#pragma unroll
        for (int i = 0; i < 4; ++i) {
            const int t = TP + b * 4 + i;
            xv[q][i] = bf2f(xact[(size_t)t * 1536 + hd * 64 + p]);
            dtv[q][i] = dtb[(size_t)t * 16 + hd];
            rb[q][i][0] = ld8(xact + (size_t)t * 1536 + 1024 + g * 128 + n0); rb[q][i][1] = ld8(xact + (size_t)t * 1536 + 1024 + g * 128 + n0 + 8);
            rc[q][i][0] = ld8(xact + (size_t)t * 1536 + 1280 + g * 128 + n0); rc[q][i][1] = ld8(xact + (size_t)t * 1536 + 1280 + g * 128 + n0 + 8);
        }
    }
#pragma unroll
    for (int q = 0; q < NI; ++q) {
        const int item = item0 + q * istride, b = item >> 4, hd = item & 15;
        const float a = -expf(P->a_log[hd]);
        const float Dh = P->ssm_d[hd];
        const size_t sidx = ((size_t)(b * 16 + hd) * 64 + p) * 128 + n0;
        float h[16];
#pragma unroll
        for (int i = 0; i < 4; ++i) { h[i * 4] = hs[q][i][0]; h[i * 4 + 1] = hs[q][i][1]; h[i * 4 + 2] = hs[q][i][2]; h[i * 4 + 3] = hs[q][i][3]; }
#pragma unroll
        for (int i = 0; i < 4; ++i) {
            const int t = TP + b * 4 + i;
            const float dA = __expf(dtv[q][i] * a), dx = dtv[q][i] * xv[q][i];
            float Bv[16], Cv[16];
            { float t8[8]; unpack8(rb[q][i][0], t8);
#pragma unroll
              for (int e = 0; e < 8; ++e) Bv[e] = t8[e];
              unpack8(rb[q][i][1], t8);
#pragma unroll
              for (int e = 0; e < 8; ++e) Bv[8 + e] = t8[e];
              unpack8(rc[q][i][0], t8);
#pragma unroll
              for (int e = 0; e < 8; ++e) Cv[e] = t8[e];
              unpack8(rc[q][i][1], t8);
#pragma unroll
              for (int e = 0; e < 8; ++e) Cv[8 + e] = t8[e]; }
            float part = 0.f;
#pragma unroll
            for (int e = 0; e < 16; ++e) { h[e] = h[e] * dA + dx * Bv[e]; part += h[e] * Cv[e]; }
            part += __shfl_xor(part, 1); part += __shfl_xor(part, 2); part += __shfl_xor(part, 4);
            if ((tid & 7) == 0) ybuf[(size_t)t * 1024 + hd * 64 + p] = f2bf(part + Dh * xv[q][i]);
        }
        float* so = P->out + O_SSMS + sidx;
#pragma unroll
        for (int i = 0; i < 4; ++i) __builtin_nontemporal_store((f32x4){h[i * 4], h[i * 4 + 1], h[i * 4 + 2], h[i * 4 + 3]}, (f32x4*)(so + i * 4));
    }
}

__device__ __forceinline__ void phase_gatednorm(PP P, int gw, int nw, const int tid) {
    const int lane = tid & 63;
    char* ws = P->ws;
    const bf16_t* ybuf = (const bf16_t*)(ws + W_Y); const bf16_t* zbuf = (const bf16_t*)(ws + W_Z);
    bf16_t* mix = (bf16_t*)(ws + W_MIX);
    for (int row0 = gw; row0 < TT; row0 += 4 * nw) {
        u32x2 yv[4][4], zv[4][4];
#pragma unroll
        for (int r = 0; r < 4; ++r) { const int row = row0 + r * nw; if (row < TT) {
#pragma unroll
            for (int j = 0; j < 4; ++j) { yv[r][j] = __builtin_nontemporal_load((const u32x2*)(ybuf + (size_t)row * 1024 + j * 256 + lane * 4)); zv[r][j] = __builtin_nontemporal_load((const u32x2*)(zbuf + (size_t)row * 1024 + j * 256 + lane * 4)); } } }
#pragma unroll
        for (int r = 0; r < 4; ++r) { const int row = row0 + r * nw; if (row < TT) {
            float t[4][4]; float ss0 = 0.f, ss1 = 0.f;
#pragma unroll
            for (int j = 0; j < 4; ++j) {
                const float y0 = bflo(yv[r][j].x), y1 = bfhi(yv[r][j].x), y2 = bflo(yv[r][j].y), y3 = bfhi(yv[r][j].y);
                const float z0 = bflo(zv[r][j].x), z1 = bfhi(zv[r][j].x), z2 = bflo(zv[r][j].y), z3 = bfhi(zv[r][j].y);
                t[j][0] = y0 * silu_f(z0); t[j][1] = y1 * silu_f(z1); t[j][2] = y2 * silu_f(z2); t[j][3] = y3 * silu_f(z3);
                const float q = t[j][0] * t[j][0] + t[j][1] * t[j][1] + t[j][2] * t[j][2] + t[j][3] * t[j][3];
                if (j < 2) ss0 += q; else ss1 += q;
            }
            ss0 = wave_sum(ss0); ss1 = wave_sum(ss1);
            const float r0 = rsqrtf(ss0 * (1.0f / 512.0f) + EPS), r1 = rsqrtf(ss1 * (1.0f / 512.0f) + EPS);
#pragma unroll
            for (int j = 0; j < 4; ++j) {
                const float rr = j < 2 ? r0 : r1;
                const f32x4 g4 = *(const f32x4*)(P->ssm_norm + j * 256 + lane * 4);
                u32x2 o; o.x = pk2(t[j][0] * rr * g4[0], t[j][1] * rr * g4[1]); o.y = pk2(t[j][2] * rr * g4[2], t[j][3] * rr * g4[3]);
                *(u32x2*)(mix + (size_t)row * 2048 + j * 256 + lane * 4) = o;
            }
        } }
    }
}

__device__ __forceinline__ void phase_norm(PP P, const float* gain, bool final_out, int gw, int nw, const int tid) {
    const int lane = tid & 63;
    char* ws = P->ws;
    const bf16_t* hb = (const bf16_t*)(ws + W_H);
    const float* ss3 = (const float*)(ws + W_SS3);
    for (int row0 = gw; row0 < TT; row0 += 4 * nw) {
        u32x2 xv[4][4]; float sq[4];
#pragma unroll
        for (int r = 0; r < 4; ++r) { const int row = row0 + r * nw; if (row < TT) { sq[r] = ss3[row];
#pragma unroll
            for (int j = 0; j < 4; ++j) xv[r][j] = __builtin_nontemporal_load((const u32x2*)(hb + (size_t)row * 1024 + j * 256 + lane * 4)); } }
#pragma unroll
        for (int r = 0; r < 4; ++r) { const int row = row0 + r * nw; if (row < TT) {
            const float rstd = rsqrtf(sq[r] * (1.0f / 1024.0f) + EPS);
#pragma unroll
            for (int j = 0; j < 4; ++j) {
                const f32x4 g4 = *(const f32x4*)(gain + j * 256 + lane * 4);
                const f32x4 x = (f32x4){bflo(xv[r][j].x), bfhi(xv[r][j].x), bflo(xv[r][j].y), bfhi(xv[r][j].y)};
                __builtin_nontemporal_store(x * rstd * g4, (f32x4*)(P->out + O_YP + (size_t)row * 1024 + j * 256 + lane * 4));
            }
        } }
    }
}

__device__ __forceinline__ void attn_sample(PP P, int item0, int item1, char* shm, const int tid) {
    const int w = tid >> 6, lane = tid & 63, fr = lane & 15, fq = lane >> 4;
    const int half = w >> 2, w4 = w & 3;
    const int item = half ? item1 : item0;
    const bool act = item >= 0;
    const int b = act ? item >> 2 : 0, hh = item & 3;
    char* ws = P->ws;
    const bf16_t* qb = (const bf16_t*)(ws + W_Q);
    float* sc = (float*)shm + half * 1024;
    float* part = (float*)(shm + 8192) + half * 4096;
    const float* vp = P->cache_v + ((size_t)(b * 256 + w4 * 64) * 4 + hh) * 256 + lane * 4;
    f32x4 va[16], vb[16];
    if (act) {
#pragma unroll
        for (int mm = 0; mm < 16; ++mm) va[mm] = __builtin_nontemporal_load((const f32x4*)(vp + (size_t)mm * 1024));
    }
    if (act) {
        bf16x8 qf[8];
#pragma unroll
        for (int kk = 0; kk < 8; ++kk) {
            bf16x8 z = {0, 0, 0, 0, 0, 0, 0, 0};
            if (fr < 4) z = *(const bf16x8*)(qb + (size_t)(TP + b * 4 + fr) * 1024 + hh * 256 + kk * 32 + fq * 8);
            qf[kk] = z;
        }
#pragma unroll
        for (int mt = 0; mt < 4; ++mt) {
            const int key = w4 * 64 + mt * 16 + fr;
            const float* kp = P->cache_k + ((size_t)(b * 256 + key) * 4 + hh) * 256 + fq * 8;
            f32x4 k0[8], k1[8];
#pragma unroll
            for (int kk = 0; kk < 8; ++kk) { k0[kk] = __builtin_nontemporal_load((const f32x4*)(kp + kk * 32)); k1[kk] = __builtin_nontemporal_load((const f32x4*)(kp + kk * 32 + 4)); }
            f32x4 acc = (f32x4){0.f, 0.f, 0.f, 0.f};
#pragma unroll
            for (int kk = 0; kk < 8; ++kk) {
                u32x4 pk; pk.x = pk2(k0[kk][0], k0[kk][1]); pk.y = pk2(k0[kk][2], k0[kk][3]); pk.z = pk2(k1[kk][0], k1[kk][1]); pk.w = pk2(k1[kk][2], k1[kk][3]);
                acc = __builtin_amdgcn_mfma_f32_16x16x32_bf16(qf[kk], __builtin_bit_cast(bf16x8, pk), acc, 0, 0, 0);
            }
            if (fq == 0) {
#pragma unroll
                for (int j = 0; j < 4; ++j) sc[j * 256 + w4 * 64 + mt * 16 + fr] = acc[j];
            }
        }
    }
    LDS_BARRIER();
    if (act) {
#pragma unroll
        for (int mm = 0; mm < 16; ++mm) vb[mm] = __builtin_nontemporal_load((const f32x4*)(vp + (size_t)(16 + mm) * 1024));
        f32x4 s = *(const f32x4*)(sc + w4 * 256 + lane * 4);
        float m = fmaxf(fmaxf(s[0], s[1]), fmaxf(s[2], s[3])); m = wave_max(m);
        s[0] = __expf(s[0] - m); s[1] = __expf(s[1] - m); s[2] = __expf(s[2] - m); s[3] = __expf(s[3] - m);
        float su = (s[0] + s[1]) + (s[2] + s[3]); su = wave_sum(su);
        const float inv = 1.0f / su;
        *(f32x4*)(sc + w4 * 256 + lane * 4) = s * inv;
    }
    LDS_BARRIER();
    if (act) {
        f32x4 o[4];
#pragma unroll
        for (int i = 0; i < 4; ++i) o[i] = (f32x4){0.f, 0.f, 0.f, 0.f};
#pragma unroll
        for (int mm = 0; mm < 16; ++mm) {
#pragma unroll
            for (int i = 0; i < 4; ++i) o[i] += sc[i * 256 + w4 * 64 + mm] * va[mm];
        }
#pragma unroll
        for (int mm = 0; mm < 16; ++mm) va[mm] = __builtin_nontemporal_load((const f32x4*)(vp + (size_t)(32 + mm) * 1024));
#pragma unroll
        for (int mm = 0; mm < 16; ++mm) {
#pragma unroll
            for (int i = 0; i < 4; ++i) o[i] += sc[i * 256 + w4 * 64 + 16 + mm] * vb[mm];
        }
#pragma unroll
        for (int mm = 0; mm < 16; ++mm) vb[mm] = __builtin_nontemporal_load((const f32x4*)(vp + (size_t)(48 + mm) * 1024));
#pragma unroll
        for (int mm = 0; mm < 16; ++mm) {
#pragma unroll
            for (int i = 0; i < 4; ++i) o[i] += sc[i * 256 + w4 * 64 + 32 + mm] * va[mm];
        }
#pragma unroll
        for (int mm = 0; mm < 16; ++mm) {
#pragma unroll
            for (int i = 0; i < 4; ++i) o[i] += sc[i * 256 + w4 * 64 + 48 + mm] * vb[mm];
        }
#pragma unroll
        for (int i = 0; i < 4; ++i) *(f32x4*)(part + (w4 * 4 + i) * 256 + lane * 4) = o[i];
    }
    LDS_BARRIER();
    if (act) {
        f32x4 r = *(const f32x4*)(part + (0 * 4 + w4) * 256 + lane * 4);
#pragma unroll
        for (int ww = 1; ww < 4; ++ww) r += *(const f32x4*)(part + (ww * 4 + w4) * 256 + lane * 4);
        u32x2 o; o.x = pk2(r[0], r[1]); o.y = pk2(r[2], r[3]);
        *(u32x2*)((bf16_t*)(ws + W_O) + (size_t)(TP + b * 4 + w4) * 1024 + hh * 256 + lane * 4) = o;
    }
    LDS_BARRIER();
}

__device__ __forceinline__ void phase_ffnconv(PP P, int gtid, int nthreads) {
    char* ws = P->ws;
    const bf16_t* u = (const bf16_t*)(ws + W_U);
    bf16_t* act = (bf16_t*)(ws + W_ACT);
    for (int idx = gtid; idx < 1152 * 352; idx += nthreads) {
        const int run = idx / 352, cg = idx % 352;
        const bool samp = run >= 1024;
        int t0, len, bidx, tl0;
        if (!samp) { t0 = run * 16; len = 16; bidx = t0 >> 11; tl0 = t0 & 2047; } else { bidx = run - 1024; t0 = TP + bidx * 4; len = 4; tl0 = 0; }
        const int cgc = cg * 8, cvc = 2816 + cg * 8;
        float wg0[8], wg1[8], wg2[8], wv0[8], wv1[8], wv2[8], bg[8], bv[8], hg0[8], hg1[8], hv0[8], hv1[8];
#pragma unroll
        for (int e = 0; e < 8; ++e) {
            wg0[e] = P->ffn_w[cgc + e]; wg1[e] = P->ffn_w[5632 + cgc + e]; wg2[e] = P->ffn_w[11264 + cgc + e];
            wv0[e] = P->ffn_w[cvc + e]; wv1[e] = P->ffn_w[5632 + cvc + e]; wv2[e] = P->ffn_w[11264 + cvc + e];
            bg[e] = P->ffn_b[cgc + e]; bv[e] = P->ffn_b[cvc + e];
        }
        if (samp) {
#pragma unroll
            for (int e = 0; e < 8; ++e) {
                hg0[e] = P->state_ffn[(size_t)(bidx * 2 + 0) * 5632 + cgc + e]; hg1[e] = P->state_ffn[(size_t)(bidx * 2 + 1) * 5632 + cgc + e];
                hv0[e] = P->state_ffn[(size_t)(bidx * 2 + 0) * 5632 + cvc + e]; hv1[e] = P->state_ffn[(size_t)(bidx * 2 + 1) * 5632 + cvc + e];
            }
        } else if (tl0 > 0) {
            unpack8(ld8(u + (size_t)(t0 - 2) * 5632 + cgc), hg0); unpack8(ld8(u + (size_t)(t0 - 1) * 5632 + cgc), hg1);
            unpack8(ld8(u + (size_t)(t0 - 2) * 5632 + cvc), hv0); unpack8(ld8(u + (size_t)(t0 - 1) * 5632 + cvc), hv1);
        } else {
#pragma unroll
            for (int e = 0; e < 8; ++e) { hg0[e] = 0.f; hg1[e] = 0.f; hv0[e] = 0.f; hv1[e] = 0.f; }
        }
        for (int jb = 0; jb < len; jb += 8) {
        u32x4 rg[8], rv[8];
        const bf16_t* ub = u + (size_t)(t0 + jb) * 5632 + cgc;
#pragma unroll
        for (int jj = 0; jj < 8; ++jj) { if (jb + jj < len) { rg[jj] = __builtin_nontemporal_load((const u32x4*)(ub + (size_t)jj * 5632)); rv[jj] = __builtin_nontemporal_load((const u32x4*)(ub + (size_t)jj * 5632 + 2816)); } }
#pragma unroll
        for (int jj = 0; jj < 8; ++jj) {
            const int j = jb + jj;
            if (j < len) {
            float ug[8], uv[8], o8[8];
            unpack8(rg[jj], ug); unpack8(rv[jj], uv);
#pragma unroll
            for (int e = 0; e < 8; ++e) {
                const float gc = bg[e] + wg0[e] * hg0[e] + wg1[e] * hg1[e] + wg2[e] * ug[e];
                const float vc = bv[e] + wv0[e] * hv0[e] + wv1[e] * hv1[e] + wv2[e] * uv[e];
                o8[e] = silu_f(gc) * vc;
            }
            *(u32x4*)(act + (size_t)(t0 + j) * 2816 + cgc) = pack8(o8);
            float* o = nullptr;
            if (samp) { if (j >= 2) o = P->out + O_FFNS + (size_t)(bidx * 2 + j - 2) * 5632; }
            else { const int tl = tl0 + j; if (tl >= 2046) o = P->out + O_FFNP + (size_t)(bidx * 2 + tl - 2046) * 5632; }
            if (o) {
#pragma unroll
                for (int e = 0; e < 8; ++e) { o[cgc + e] = ug[e]; o[cvc + e] = uv[e]; }
            }
#pragma unroll
            for (int e = 0; e < 8; ++e) { hg0[e] = hg1[e]; hg1[e] = ug[e]; hv0[e] = hv1[e]; hv1[e] = uv[e]; }
            }
        }
        }
    }
}

#define XB_TMO      128
#define XB_XCNT(j)  (256  + 64 * (j))
#define XB_XSUB(j)  (1280 + 64 * (j))
#define XB_XGEN(j)  (2304 + 64 * (j))
#define XB_TOP      3328
#define XB_TOPGEN   3392
#define XCD_BAR_WORDS 3456
#define XB_SPIN_CAP (1u << 20)
__device__ __forceinline__ unsigned xb_ld(unsigned* p)              { return __hip_atomic_load(p, __ATOMIC_RELAXED, __HIP_MEMORY_SCOPE_AGENT); }
__device__ __forceinline__ unsigned xb_add(unsigned* p, unsigned v) { return __hip_atomic_fetch_add(p, v, __ATOMIC_RELAXED, __HIP_MEMORY_SCOPE_AGENT); }
__device__ __forceinline__ unsigned xb_xcc_id() { return (unsigned)__builtin_amdgcn_s_getreg((3 << 11) | 20) & 0xFu; }
#define XB_SPIN(cond, bar) do { unsigned _sp = 0; while (cond) { \
    if ((++_sp & 255u) == 0u) { if (xb_ld(&(bar)[XB_TMO])) break; if (_sp > XB_SPIN_CAP) { atomicAdd(&(bar)[XB_TMO], 1u); break; } } } } while (0)
__device__ __forceinline__ void xcd_barrier_complete(unsigned* bar, unsigned x, unsigned& nloc, unsigned& nx) {
    const unsigned G = gridDim.x;
    unsigned sum, cnt, mine, sp = 0u;
    for (;;) {
        sum = 0u; cnt = 0u; mine = 0u;
#pragma unroll
        for (unsigned j = 0; j < 16; ++j) { const unsigned c = xb_ld(&bar[XB_XCNT(j)]); sum += c; cnt += (c > 0u) ? 1u : 0u; mine = (j == x) ? c : mine; }
        if (sum == G) break;
        __builtin_amdgcn_s_sleep(1);
        if ((++sp & 255u) == 0u) { if (xb_ld(&bar[XB_TMO])) break; if (sp > XB_SPIN_CAP) { atomicAdd(&bar[XB_TMO], 1u); break; } }
    }
    nloc = mine > 0u ? mine : 1u; nx = cnt > 0u ? cnt : 1u;
}
__device__ __forceinline__ void xcd_barrier(unsigned* bar, volatile LDSB unsigned* st, const int tid) {
    asm volatile("s_waitcnt vmcnt(0)" ::: "memory");
    __syncthreads();
    if (tid == 0) {
        const unsigned x = xb_xcc_id();
        __builtin_amdgcn_s_waitcnt(0);
        unsigned nloc = st[0], nx = st[1];
        if (nloc == 0u) { xcd_barrier_complete(bar, x, nloc, nx); st[0] = nloc; st[1] = nx; }
        const unsigned old = xb_add(&bar[XB_XSUB(x)], 1u);
        const unsigned gen = old / nloc;
        if (old + 1u == (gen + 1u) * nloc) {
            __builtin_amdgcn_fence(__ATOMIC_RELEASE, "agent");
            asm volatile("s_waitcnt vmcnt(0)" ::: "memory");
            const unsigned og = xb_add(&bar[XB_TOP], 1u);
            const unsigned tg = og / nx;
            if (og + 1u == (tg + 1u) * nx) xb_add(&bar[XB_TOPGEN], 1u);
            else XB_SPIN(xb_ld(&bar[XB_TOPGEN]) == tg, bar);
            __builtin_amdgcn_fence(__ATOMIC_ACQUIRE, "agent");
            xb_add(&bar[XB_XGEN(x)], 1u);
            asm volatile("s_waitcnt vmcnt(0)" ::: "memory");
        } else {
            XB_SPIN(xb_ld(&bar[XB_XGEN(x)]) == gen, bar);
            __builtin_amdgcn_fence(__ATOMIC_ACQUIRE, "agent");
            asm volatile("s_waitcnt vmcnt(0)" ::: "memory");
        }
    }
    __syncthreads();
}

extern __shared__ __attribute__((aligned(16))) char smem[];

__global__ void __launch_bounds__(NTHR) hybrid_fwd(Params Pin) {
    char* shm = smem;
    volatile LDSB unsigned* bst = (volatile LDSB unsigned*)(smem + 139264);
    if (threadIdx.x == 0) { bst[0] = 0u; bst[1] = 0u; (void)xb_add((unsigned*)(Pin.ws + W_BAR) + XB_XCNT(xb_xcc_id()), 1u); }
    __syncthreads();
    for (int ph = Pin.ph_lo; ph < Pin.ph_hi; ++ph) {
        if (ph == 6 || ph == 11) continue;
        const int reps = ((REPEAT_MASK >> ph) & 1) ? 2 : 1;
        for (int rep = 0; rep < reps; ++rep) {
        if (rep > 0) xcd_barrier((unsigned*)(Pin.ws + W_BAR), bst, threadIdx.x);
        int tid = threadIdx.x, blk = blockIdx.x, nblk = gridDim.x;
        asm volatile("" : "+v"(tid));
        asm volatile("" : "+s"(blk), "+s"(nblk));
        PP P = (PP)__builtin_amdgcn_kernarg_segment_ptr();
        asm volatile("" : "+s"(P));
        const int lb = (blk & 7) * (nblk >> 3) + (blk >> 3);
        const int gtid = blk * NTHR + tid, nthreads = nblk * NTHR;
        const int gw = blk * 8 + (tid >> 6), nw = nblk * 8;
        switch (ph) {
#if PHASE_MASK & 1
        case 0: phase_prep(P, shm, blk, nblk, tid); break;
#endif
#if PHASE_MASK & 4
        case 2: phase_convpool(P, gtid, nthreads); break;
#endif
#if PHASE_MASK & 8
        case 3:
            if (blk & 1) { int it = blk; for (; it + nblk < 2048; it += 2 * nblk) ssd_sample<2>(P, it, nblk, tid); for (; it < 2048; it += nblk) ssd_sample<1>(P, it, nblk, tid); }
            for (int it = blk; it < 256; it += nblk) ssd_prompt(P, it, shm, tid);
            if (!(blk & 1)) { int it = blk; for (; it + nblk < 2048; it += 2 * nblk) ssd_sample<2>(P, it, nblk, tid); for (; it < 2048; it += nblk) ssd_sample<1>(P, it, nblk, tid); }
            break;
#endif
#if PHASE_MASK & 16
        case 4: phase_gatednorm(P, gw, nw, tid); break;
#endif
#if PHASE_MASK & 64
        case 6: phase_norm(P, P->norm_mem, false, gw, nw, tid); break;
        case 11: phase_norm(P, P->norm_ffn, false, gw, nw, tid); break;
        case 15: phase_norm(P, P->final_norm, true, gw, nw, tid); break;
#endif
#if PHASE_MASK & 8192
        case 13: phase_ffnconv(P, gtid, nthreads); break;
#endif
        default: break;
        }
#if PHASE_MASK & 256
        if (ph == 8 && (blk & 1)) { for (int it = blk; it < 512; it += 2 * nblk) attn_sample(P, it, it + nblk < 512 ? it + nblk : -1, shm, tid); __syncthreads(); }
#endif
#if PHASE_MASK & 2
        if (ph == 1 || ph == 5 || ph == 7 || ph == 8 || ph == 9 || ph == 10 || ph == 12 || ph == 14) gemm_phase(P, ph, shm, lb, blk, nblk, tid);
#endif
#if PHASE_MASK & 256
        if (ph == 9 && !(blk & 1)) { for (int it = blk; it < 512; it += 2 * nblk) attn_sample(P, it, it + nblk < 512 ? it + nblk : -1, shm, tid); }
#endif
        }
        if (ph + 1 < Pin.ph_hi && ph != 8) xcd_barrier((unsigned*)(Pin.ws + W_BAR), bst, threadIdx.x);
        if (ph == 8) { asm volatile("s_waitcnt vmcnt(0)" ::: "memory"); __syncthreads(); }
        if (EXTRA_SYNCS && ph == 0) { for (int i = 0; i < EXTRA_SYNCS; ++i) xcd_barrier((unsigned*)(Pin.ws + W_BAR), bst, threadIdx.x); }
    }
}

extern "C" void kernel_launch(void* const* d_in, const int* in_sizes, int n_in, void* d_out, int out_size, void* d_ws, size_t ws_size, hipStream_t stream) {
    static int grid_blocks = 0;
    if (!grid_blocks) {
        int dev = 0, cus = 0, per_cu = 0;
        hipGetDevice(&dev);
        hipDeviceGetAttribute(&cus, hipDeviceAttributeMultiprocessorCount, dev);
        hipFuncSetAttribute((const void*)hybrid_fwd, hipFuncAttributeMaxDynamicSharedMemorySize, LDS_BYTES);
        hipOccupancyMaxActiveBlocksPerMultiprocessor(&per_cu, hybrid_fwd, NTHR, LDS_BYTES);
        if (per_cu < 1) per_cu = 1;
        grid_blocks = cus * 1;
        grid_blocks &= ~7;
        if (grid_blocks < 8) grid_blocks = 8;
    }
    Params p{};
    const float* const* in = (const float* const*)d_in;
    p.x_prompt = in[0]; p.x_sample = in[1]; p.mem_prompt = in[2]; p.state_ssm = in[3]; p.state_conv = in[4]; p.state_pool = in[5]; p.state_ffn = in[6];
    p.cache_k = in[7]; p.cache_v = in[8]; p.norm_mix = in[9]; p.w_in = in[10]; p.conv_w = in[11]; p.conv_b = in[12]; p.dt_bias = in[13]; p.a_log = in[14];
    p.ssm_d = in[15]; p.ssm_norm = in[16]; p.w_pool = in[17]; p.pool_scale = in[18]; p.w_out = in[19]; p.norm_mem = in[20]; p.norm_memkv = in[21];
    p.w_mq = in[22]; p.w_mk = in[23]; p.w_mv = in[24]; p.w_mo = in[25]; p.norm_ffn = in[26]; p.w_up = in[27]; p.ffn_w = in[28]; p.ffn_b = in[29];
    p.w_down = in[30]; p.final_norm = in[31];
    p.out = (float*)d_out; p.ws = (char*)d_ws; p.ph_lo = 0; p.ph_hi = 16;
    hipMemsetAsync((char*)d_ws + W_BAR, 0, 16384, stream);
    void* args[] = {&p};
    hipError_t e = hipLaunchCooperativeKernel((const void*)hybrid_fwd, dim3(grid_blocks), dim3(NTHR), args, LDS_BYTES, stream);
    if (e != hipSuccess) fprintf(stderr, "cooperative launch failed: %s (grid %d)\n", hipGetErrorString(e), grid_blocks);
}
```

```cpp
#include <hip/hip_runtime.h>
#include <hip/hip_cooperative_groups.h>
#include <cstdio>
namespace cg = cooperative_groups;

typedef unsigned short bf16_t;
typedef short bf16x8 __attribute__((ext_vector_type(8)));
typedef short s16x4 __attribute__((ext_vector_type(4)));
typedef float f32x4 __attribute__((ext_vector_type(4)));
typedef unsigned u32x4 __attribute__((ext_vector_type(4)));
typedef unsigned u32x2 __attribute__((ext_vector_type(2)));
#define LDSB __attribute__((address_space(3)))

constexpr int TP = 16384, TS = 512, TT = TP + TS;
constexpr int NTHR = 512;
constexpr int LDS_BYTES = 139264 + 256;
constexpr float EPS = 1e-6f;
#ifndef PHASE_MASK
#define PHASE_MASK 0xFFFF
#endif
#ifndef REPEAT_MASK
#define REPEAT_MASK 0
#endif
#ifndef PROBE3
#define PROBE3 0
#endif
#ifndef EXTRA_SYNCS
#define EXTRA_SYNCS 0
#endif

constexpr size_t O_YP = 0;
constexpr size_t O_YS = O_YP + (size_t)TP * 1024;
constexpr size_t O_SSMP = O_YS + (size_t)TS * 1024;
constexpr size_t O_SSMS = O_SSMP + (size_t)8 * 16 * 64 * 128;
constexpr size_t O_CONVP = O_SSMS + (size_t)128 * 16 * 64 * 128;
constexpr size_t O_CONVS = O_CONVP + (size_t)8 * 3 * 1536;
constexpr size_t O_POOLP = O_CONVS + (size_t)128 * 3 * 1536;
constexpr size_t O_POOLS = O_POOLP + (size_t)8 * 15 * 1024;
constexpr size_t O_FFNP = O_POOLS + (size_t)128 * 15 * 1024;
constexpr size_t O_FFNS = O_FFNP + (size_t)8 * 2 * 5632;
constexpr size_t O_MK = O_FFNS + (size_t)128 * 2 * 5632;
constexpr size_t O_MV = O_MK + (size_t)8 * 256 * 1024;

constexpr size_t W_WIN = 0;
constexpr size_t W_WPOOL = W_WIN + (size_t)3584 * 1024 * 2;
constexpr size_t W_WOUT = W_WPOOL + (size_t)4 * 256 * 256 * 2;
constexpr size_t W_WMQ = W_WOUT + (size_t)1024 * 2048 * 2;
constexpr size_t W_WMK = W_WMQ + (size_t)1024 * 1024 * 2;
constexpr size_t W_WMV = W_WMK + (size_t)1024 * 1024 * 2;
constexpr size_t W_WMO = W_WMV + (size_t)1024 * 1024 * 2;
constexpr size_t W_WUP = W_WMO + (size_t)1024 * 1024 * 2;
constexpr size_t W_WDOWN = W_WUP + (size_t)5632 * 1024 * 2;
constexpr size_t W_H = W_WDOWN + (size_t)1024 * 2816 * 2;
constexpr size_t W_HM = W_H + (size_t)TT * 1024 * 2;
constexpr size_t W_KB = W_HM + (size_t)2048 * 1024 * 2;
constexpr size_t W_VT = W_KB + (size_t)2048 * 1024 * 2;
constexpr size_t W_DT = W_VT + (size_t)2048 * 1024 * 2;
constexpr size_t W_XRES = W_DT + (size_t)TT * 16 * 4;
constexpr size_t W_ARENA = W_XRES + (size_t)TT * 1024 * 4;
constexpr size_t W_Z = W_ARENA;
constexpr size_t W_PROJ2 = W_Z + (size_t)TT * 1024 * 2;
constexpr size_t W_XACT = W_PROJ2 + (size_t)TT * 2560 * 2;
constexpr size_t W_POOLED = W_XACT + (size_t)TT * 1536 * 2;
constexpr size_t W_Y = W_POOLED + (size_t)TT * 1024 * 2;
constexpr size_t W_MIX = W_Y + (size_t)TT * 1024 * 2;
constexpr size_t W_END_A = W_MIX + (size_t)TT * 2048 * 2;
constexpr size_t W_Q = W_PROJ2;
constexpr size_t W_P = W_Q + (size_t)TT * 1024 * 2;
constexpr size_t W_O = W_P + (size_t)TP * 1024 * 2;
constexpr size_t W_U = W_ARENA;
constexpr size_t W_ACT = W_U + (size_t)TT * 5632 * 2;
constexpr size_t W_END_C = W_ACT + (size_t)TT * 2816 * 2;
constexpr size_t W_BAR = W_END_A;
constexpr size_t W_SS1 = W_BAR + 16384;
constexpr size_t W_SS2 = W_SS1 + (size_t)TT * 4;
constexpr size_t W_SS3 = W_SS2 + (size_t)TT * 4;
constexpr size_t W_WLO = W_SS3 + (size_t)TT * 4;
constexpr size_t W_TOTAL = W_WLO + (size_t)1024 * 1024 * 2;
static_assert(W_O + (size_t)TT * 1024 * 2 <= W_POOLED, "era B overflow");
static_assert(W_END_C <= W_END_A, "era C overflow");

struct Params {
    const float *x_prompt, *x_sample, *mem_prompt, *state_ssm, *state_conv, *state_pool, *state_ffn, *cache_k, *cache_v;
    const float *norm_mix, *w_in, *conv_w, *conv_b, *dt_bias, *a_log, *ssm_d, *ssm_norm, *w_pool, *pool_scale, *w_out;
    const float *norm_mem, *norm_memkv, *w_mq, *w_mk, *w_mv, *w_mo, *norm_ffn, *w_up, *ffn_w, *ffn_b, *w_down, *final_norm;
    float* out;
    char* ws;
    int ph_lo, ph_hi;
};

typedef const __attribute__((address_space(4))) Params* PP;

__device__ __forceinline__ unsigned pk2(float lo, float hi) { unsigned r; asm("v_cvt_pk_bf16_f32 %0, %1, %2" : "=v"(r) : "v"(lo), "v"(hi)); return r; }
__device__ __forceinline__ bf16_t f2bf(float f) { return (bf16_t)(pk2(f, 0.f) & 0xffffu); }
__device__ __forceinline__ float bf2f(bf16_t b) { return __uint_as_float(((unsigned)b) << 16); }
__device__ __forceinline__ float bflo(unsigned u) { return __uint_as_float(u << 16); }
__device__ __forceinline__ float bfhi(unsigned u) { return __uint_as_float(u & 0xffff0000u); }
__device__ __forceinline__ void unpack8(u32x4 v, float (&f)[8]) {
    f[0] = bflo(v.x); f[1] = bfhi(v.x); f[2] = bflo(v.y); f[3] = bfhi(v.y); f[4] = bflo(v.z); f[5] = bfhi(v.z); f[6] = bflo(v.w); f[7] = bfhi(v.w);
}
__device__ __forceinline__ u32x4 pack8(const float (&f)[8]) { u32x4 r; r.x = pk2(f[0], f[1]); r.y = pk2(f[2], f[3]); r.z = pk2(f[4], f[5]); r.w = pk2(f[6], f[7]); return r; }
__device__ __forceinline__ float wave_sum(float v) {
#pragma unroll
    for (int o = 1; o < 64; o <<= 1) v += __shfl_xor(v, o);
    return v;
}
__device__ __forceinline__ float wave_max(float v) {
#pragma unroll
    for (int o = 1; o < 64; o <<= 1) v = fmaxf(v, __shfl_xor(v, o));
    return v;
}
__device__ __forceinline__ float silu_f(float x) { return x * __builtin_amdgcn_rcpf(1.0f + __expf(-x)); }

constexpr int HTB = 128 * 64 * 2;
__device__ __forceinline__ int lds_byte(int r, int c) { const int st = (r >> 4) * 2 + (c >> 5), rr = r & 15, cc = c & 31, ob = rr * 64 + cc * 2; return st * 1024 + (ob ^ (((ob >> 9) & 1) << 5)); }
__device__ __forceinline__ void stage_rc(int b, int& R, int& C) { const int st = b / 1024, sb = b % 1024, swz = sb ^ (((sb >> 9) & 1) << 5); R = (st >> 1) * 16 + swz / 64; C = (st & 1) * 32 + (swz % 64) / 2; }

__device__ __forceinline__ int perm32(int rho) { const int n = rho >> 4, i = rho & 15; return 8 * (i >> 2) + 4 * n + (i & 3); }
__device__ __forceinline__ int invperm32(int c) { return 16 * ((c >> 2) & 1) + 4 * (c >> 3) + (c & 3); }
enum { E_PROJ = 0, E_MEMKV, E_POOL, E_OUT, E_Q, E_QK, E_PV, E_MO, E_UP, E_DOWN, E_FOLD };

template <int EK>
__device__ __forceinline__ float epi_apply(PP P, int row, int col, f32x4 v) {
    char* ws = P->ws;
    if constexpr (EK == E_PROJ) {
        u32x2 o; o.x = pk2(v[0], v[1]); o.y = pk2(v[2], v[3]);
        if (col < 1024) *(u32x2*)((bf16_t*)(ws + W_Z) + (size_t)row * 1024 + col) = o;
        else *(u32x2*)((bf16_t*)(ws + W_PROJ2) + (size_t)row * 2560 + (col - 1024)) = o;
    } else if constexpr (EK == E_MEMKV) {
        if (col < 1024) {
            *(f32x4*)(P->out + O_MK + (size_t)row * 1024 + col) = v;
            u32x2 o; o.x = pk2(v[0], v[1]); o.y = pk2(v[2], v[3]);
            *(u32x2*)((bf16_t*)(ws + W_KB) + (size_t)((row & ~31) + invperm32(row & 31)) * 1024 + col) = o;
        } else {
            const int c = col - 1024;
            *(f32x4*)(P->out + O_MV + (size_t)row * 1024 + c) = v;
            const int b = row >> 8, m = row & 255, hh = c >> 8, d = c & 255;
            bf16_t* vt = (bf16_t*)(ws + W_VT) + ((size_t)(b * 4 + hh) * 256 + (d & ~31) + invperm32(d & 31)) * 256 + m;
#pragma unroll
            for (int j = 0; j < 4; ++j) vt[j * 256] = f2bf(v[j]);
        }
    } else if constexpr (EK == E_POOL) {
        const f32x4 sc = *(const f32x4*)(P->pool_scale + col);
        u32x2 o; o.x = pk2(v[0] * sc[0], v[1] * sc[1]); o.y = pk2(v[2] * sc[2], v[3] * sc[3]);
        *(u32x2*)((bf16_t*)(ws + W_MIX) + (size_t)row * 2048 + 1024 + col) = o;
    } else if constexpr (EK == E_OUT) {
        const float* xin = row < TP ? P->x_prompt + (size_t)row * 1024 : P->x_sample + (size_t)(row - TP) * 1024;
        const f32x4 x = *(const f32x4*)(xin + col) + v;
        u32x2 o; o.x = pk2(x[0], x[1]); o.y = pk2(x[2], x[3]);
        *(u32x2*)((bf16_t*)(ws + W_H) + (size_t)row * 1024 + col) = o;
        return (x[0] * x[0] + x[1] * x[1]) + (x[2] * x[2] + x[3] * x[3]);
    } else if constexpr (EK == E_Q) {
        u32x2 o; o.x = pk2(v[0], v[1]); o.y = pk2(v[2], v[3]);
        *(u32x2*)((bf16_t*)(ws + W_Q) + (size_t)row * 1024 + col) = o;
    } else if constexpr (EK == E_PV) {
        u32x2 o; o.x = pk2(v[0], v[1]); o.y = pk2(v[2], v[3]);
        *(u32x2*)((bf16_t*)(ws + W_O) + (size_t)row * 1024 + col) = o;
    } else if constexpr (EK == E_MO || EK == E_DOWN) {
        u32x2* hp = (u32x2*)((bf16_t*)(ws + W_H) + (size_t)row * 1024 + col);
        const u32x2 hv = *hp;
        const f32x4 x = (f32x4){bflo(hv.x), bfhi(hv.x), bflo(hv.y), bfhi(hv.y)} + v;
        u32x2 o; o.x = pk2(x[0], x[1]); o.y = pk2(x[2], x[3]);
        *hp = o;
        return (x[0] * x[0] + x[1] * x[1]) + (x[2] * x[2] + x[3] * x[3]);
    } else if constexpr (EK == E_UP) {
        u32x2 o; o.x = pk2(v[0], v[1]); o.y = pk2(v[2], v[3]);
        *(u32x2*)((bf16_t*)(ws + W_U) + (size_t)row * 5632 + col) = o;
    }
    return 0.f;
}
template <int EK>
__device__ __forceinline__ float epi_rowscale(PP P, int row) {
    if constexpr (EK == E_Q) return rsqrtf(((const float*)(P->ws + W_SS1))[row] * (1.0f / 1024.0f) + EPS) * 0.0625f;
    else if constexpr (EK == E_UP) return rsqrtf(((const float*)(P->ws + W_SS2))[row] * (1.0f / 1024.0f) + EPS);
    else return 1.0f;
}
__device__ __forceinline__ float epi_apply_rt(PP P, int ekind, int row, int col, f32x4 v) {
    switch (ekind) {
    case E_FOLD: { u32x2 o; o.x = pk2(v[0], v[1]); o.y = pk2(v[2], v[3]); const int prow = (row & ~31) + invperm32(row & 31); *(u32x2*)((bf16_t*)(P->ws + W_WOUT) + (size_t)prow * 2048 + 1024 + col) = o; return 0.f; }
    case E_OUT: return epi_apply<E_OUT>(P, row, col, v);
    case E_Q: return epi_apply<E_Q>(P, row, col, v * epi_rowscale<E_Q>(P, row));
    case E_MO: return epi_apply<E_MO>(P, row, col, v);
    default: return epi_apply<E_DOWN>(P, row, col, v);
    }
}
template <int EK>
__device__ __forceinline__ void epi_loop(PP P, const f32x4 (&acc)[2][2][4][2], int rbase, int cbase, int fq) {
    if constexpr (EK == E_PROJ || EK == E_UP || EK == E_Q || EK == E_PV || EK == E_OUT || EK == E_MO || EK == E_DOWN) {
        const int cb8 = cbase + 4 * fq;
#pragma unroll
        for (int ai = 0; ai < 2; ++ai)
#pragma unroll
            for (int m = 0; m < 4; ++m) {
                const int row = rbase + ai * 128 + m * 16;
                const float rs = epi_rowscale<EK>(P, row);
                float ss = 0.f;
#pragma unroll
                for (int bj = 0; bj < 2; ++bj) {
                    f32x4 v0 = acc[ai][bj][m][0], v1 = acc[ai][bj][m][1];
                    const int col = cb8 + bj * 128;
                    if constexpr (EK == E_PROJ || EK == E_UP || EK == E_Q) { v0 *= rs; v1 *= rs; }
                    if constexpr (EK == E_OUT) {
                        const float* xin = (row < TP ? P->x_prompt + (size_t)row * 1024 : P->x_sample + (size_t)(row - TP) * 1024) + col;
                        v0 += __builtin_nontemporal_load((const f32x4*)xin); v1 += __builtin_nontemporal_load((const f32x4*)(xin + 4));
                    }
                    if constexpr (EK == E_MO || EK == E_DOWN) {
                        const u32x4 hv = *(const u32x4*)((const bf16_t*)(P->ws + W_H) + (size_t)row * 1024 + col);
                        v0 += (f32x4){bflo(hv.x), bfhi(hv.x), bflo(hv.y), bfhi(hv.y)}; v1 += (f32x4){bflo(hv.z), bfhi(hv.z), bflo(hv.w), bfhi(hv.w)};
                    }
                    if constexpr (EK == E_OUT || EK == E_MO || EK == E_DOWN) ss += ((v0[0] * v0[0] + v0[1] * v0[1]) + (v0[2] * v0[2] + v0[3] * v0[3])) + ((v1[0] * v1[0] + v1[1] * v1[1]) + (v1[2] * v1[2] + v1[3] * v1[3]));
                    u32x4 o; o.x = pk2(v0[0], v0[1]); o.y = pk2(v0[2], v0[3]); o.z = pk2(v1[0], v1[1]); o.w = pk2(v1[2], v1[3]);
                    if constexpr (EK == E_UP) *(u32x4*)((bf16_t*)(P->ws + W_U) + (size_t)row * 5632 + col) = o;
                    else if constexpr (EK == E_Q) *(u32x4*)((bf16_t*)(P->ws + W_Q) + (size_t)row * 1024 + col) = o;
                    else if constexpr (EK == E_PV) *(u32x4*)((bf16_t*)(P->ws + W_O) + (size_t)row * 1024 + col) = o;
                    else if constexpr (EK == E_PROJ) { if (col < 1024) *(u32x4*)((bf16_t*)(P->ws + W_Z) + (size_t)row * 1024 + col) = o;
                           else *(u32x4*)((bf16_t*)(P->ws + W_PROJ2) + (size_t)row * 2560 + (col - 1024)) = o; }
                    else *(u32x4*)((bf16_t*)(P->ws + W_H) + (size_t)row * 1024 + col) = o;
                }
                if constexpr (EK == E_OUT || EK == E_MO || EK == E_DOWN) {
                    ss += __shfl_xor(ss, 16); ss += __shfl_xor(ss, 32);
                    if (fq == 0) unsafeAtomicAdd((float*)(P->ws + (EK == E_OUT ? W_SS1 : EK == E_MO ? W_SS2 : W_SS3)) + row, ss);
                }
            }
        return;
    }
#pragma unroll
    for (int ai = 0; ai < 2; ++ai)
#pragma unroll
        for (int m = 0; m < 4; ++m) {
            const int row = rbase + ai * 128 + m * 16;
            const float rs = epi_rowscale<EK>(P, row);
            float ss = 0.f;
#pragma unroll
            for (int bj = 0; bj < 2; ++bj)
#pragma unroll
                for (int n = 0; n < 2; ++n) {
                    if constexpr (EK == E_Q || EK == E_UP) ss += epi_apply<EK>(P, row, cbase + bj * 128 + n * 16, acc[ai][bj][m][n] * rs);
                    else ss += epi_apply<EK>(P, row, cbase + bj * 128 + n * 16, acc[ai][bj][m][n]);
                }
            if constexpr (EK == E_OUT || EK == E_MO || EK == E_DOWN) {
                ss += __shfl_xor(ss, 16); ss += __shfl_xor(ss, 32);
                if (fq == 0) unsafeAtomicAdd((float*)(P->ws + (EK == E_OUT ? W_SS1 : EK == E_MO ? W_SS2 : W_SS3)) + row, ss);
            }
        }
}

struct PhaseCfg { const char* A; const char* B; int lda, ldb, K, nbig, nsmall, ncol64, ekind; };
__device__ __forceinline__ PhaseCfg phase_cfg(PP P, int gp) {
    const char* ws = P->ws; PhaseCfg c;
    switch (gp) {
    case 1:  c.A = ws + W_H;      c.B = ws + W_WIN;   c.lda = 1024; c.ldb = 1024; c.K = 1024; c.nbig = 66 * 14 + 64; c.nsmall = 512; c.ncol64 = 16; c.ekind = E_PROJ; break;
    case 3:  c.A = ws + W_POOLED; c.B = ws + W_WPOOL; c.lda = 1024; c.ldb = 256;  c.K = 256;  c.nbig = 256; c.nsmall = 256; c.ncol64 = 16; c.ekind = E_POOL; break;
    case 5:  c.A = ws + W_MIX;    c.B = ws + W_WOUT;  c.lda = 2048; c.ldb = 2048; c.K = 2048; c.nbig = 256; c.nsmall = 256; c.ncol64 = 16; c.ekind = E_OUT; break;
    case 7:  c.A = ws + W_H;      c.B = ws + W_WMQ;   c.lda = 1024; c.ldb = 1024; c.K = 1024; c.nbig = 256; c.nsmall = 256; c.ncol64 = 16; c.ekind = E_Q; break;
    case 8:  c.A = ws + W_Q;      c.B = ws + W_KB;    c.lda = 1024; c.ldb = 1024; c.K = 256;  c.nbig = 256; c.nsmall = 0;   c.ncol64 = 16; c.ekind = E_QK; break;
    case 9:  c.A = ws + W_P;      c.B = ws + W_VT;    c.lda = 1024; c.ldb = 256;  c.K = 256;  c.nbig = 256; c.nsmall = 0;   c.ncol64 = 16; c.ekind = E_PV; break;
    case 10: c.A = ws + W_O;      c.B = ws + W_WMO;   c.lda = 1024; c.ldb = 1024; c.K = 1024; c.nbig = 256; c.nsmall = 256; c.ncol64 = 16; c.ekind = E_MO; break;
    case 12: c.A = ws + W_H;      c.B = ws + W_WUP;   c.lda = 1024; c.ldb = 1024; c.K = 1024; c.nbig = 66 * 22; c.nsmall = 0; c.ncol64 = 88; c.ekind = E_UP; break;
    default: c.A = ws + W_ACT;    c.B = ws + W_WDOWN; c.lda = 2816; c.ldb = 2816; c.K = 2816; c.nbig = 256; c.nsmall = 256; c.ncol64 = 16; c.ekind = E_DOWN; break;
    }
    return c;
}
struct UnitD { const char* A; const char* B; int row0, col0, ekind; };
__device__ __forceinline__ void map_unit(int L, int nM, int nN, int& pm, int& pn) {
    const int nwg = nM * nN, q = nwg >> 3, r = nwg & 7, xcd = L & 7, off = L >> 3;
    const int wgid = (xcd < r ? xcd * (q + 1) : r * (q + 1) + (xcd - r) * q) + off;
    const int nig = 8 * nN, gid = wgid / nig, fm = gid * 8, gsz = (nM - fm) < 8 ? (nM - fm) : 8;
    const int w = wgid - gid * nig;
    pm = fm + w % gsz; pn = w / gsz;
}
__device__ __forceinline__ UnitD unit_decode(PP P, const PhaseCfg& c, int gp, int L) {
    UnitD d; d.ekind = c.ekind;
    int pm, pn;
    switch (gp) {
    case 1:
        if (L < 924) { map_unit(L, 66, 14, pm, pn); d.A = c.A + (size_t)pm * 256 * 2048; d.B = c.B + (size_t)pn * 256 * 2048; }
        else { map_unit(L - 924, 8, 8, pm, pn); d.A = P->ws + W_HM + (size_t)pm * 256 * 2048; d.B = P->ws + W_WMK + (size_t)pn * 256 * 2048; d.ekind = E_MEMKV; }
        break;
    case 3: map_unit(L, 64, 4, pm, pn); d.A = c.A + (size_t)pm * 256 * 2048 + pn * 512; d.B = c.B + (size_t)pn * 131072; break;
    case 8: map_unit(L, 64, 4, pm, pn); d.A = c.A + (size_t)pm * 256 * 2048 + pn * 512; d.B = c.B + (size_t)(pm >> 3) * 256 * 2048 + pn * 512; break;
    case 9: map_unit(L, 64, 4, pm, pn); d.A = c.A + (size_t)pm * 256 * 2048 + pn * 512; d.B = c.B + (size_t)((pm >> 3) * 4 + pn) * 131072; break;
    case 12: map_unit(L, 66, 22, pm, pn); d.A = c.A + (size_t)pm * 256 * 2048; d.B = c.B + (size_t)pn * 256 * 2048; break;
    default: map_unit(L, 64, 4, pm, pn); d.A = c.A + (size_t)pm * 256 * c.lda * 2; d.B = c.B + (size_t)pn * 256 * c.ldb * 2; break;
    }
    d.row0 = pm * 256; d.col0 = pn * 256;
    return d;
}

__device__ __forceinline__ void gemm_phase(PP P, int gp, char* shm_g, int lb, int blk, int nblk, const int tid) {
    LDSB unsigned char* lds = (LDSB unsigned char*)shm_g;
    const int wid = __builtin_amdgcn_readfirstlane(tid >> 6), lane = tid & 63, wr = wid >> 2, wc = wid & 3, fr = lane & 15, fq = lane >> 4;
    const PhaseCfg cfg = phase_cfg(P, gp);
    const int K = cfg.K, nt = K / 64;
    unsigned voffA, voffB;
    { int R, C; stage_rc(tid * 16, R, C); voffA = (unsigned)(R * cfg.lda + C) * 2u; voffB = (unsigned)(R * cfg.ldb + C) * 2u; }
    const size_t qstepvoffA = (size_t)64 * cfg.lda * 2, qstepvoffB = (size_t)64 * cfg.ldb * 2;
    const size_t kstep = 128;
    const size_t hstepA = (size_t)128 * cfg.lda * 2, hstepB = (size_t)128 * cfg.ldb * 2;
    const unsigned ldsw = (unsigned)wid * 1024u;
    const int aoff = lds_byte(wr * 64 + fr, fq * 8), boff = lds_byte(wc * 32 + fr, fq * 8);
    const bool chain = (cfg.ekind != E_QK);
#define G_SA(b, h) (((b) * 2 + (h)) * HTB)
#define G_SB(b, h) ((4 + (b) * 2 + (h)) * HTB)
#define G_STAGE(bufoff, gbase, voff) do { \
        __builtin_amdgcn_global_load_lds((const unsigned*)((const char*)(gbase) + (voff)), (LDSB unsigned*)(lds + (bufoff) + ldsw), 16, 0, 0); \
        __builtin_amdgcn_global_load_lds((const unsigned*)((const char*)(gbase) + qstep##voff + (voff)), (LDSB unsigned*)(lds + (bufoff) + ldsw + 8192), 16, 0, 0); } while (0)
#define G_LDA(dst, b, h) do { _Pragma("unroll") for (int m = 0; m < 4; ++m) _Pragma("unroll") for (int k = 0; k < 2; ++k) dst[m][k] = *(const LDSB bf16x8*)(lds + G_SA(b, h) + aoff + m * 2048 + k * 1024); } while (0)
#define G_LDB(dst, b, h) do { _Pragma("unroll") for (int n = 0; n < 2; ++n) _Pragma("unroll") for (int k = 0; k < 2; ++k) dst[n][k] = *(const LDSB bf16x8*)(lds + G_SB(b, h) + boff + n * 2048 + k * 1024); } while (0)
#define G_MMA(ai, bj, Af, Bf) do { __builtin_amdgcn_s_setprio(1); _Pragma("unroll") for (int m = 0; m < 4; ++m) _Pragma("unroll") for (int n = 0; n < 2; ++n) _Pragma("unroll") for (int k = 0; k < 2; ++k) \
        acc[ai][bj][m][n] = __builtin_amdgcn_mfma_f32_16x16x32_bf16(Bf[n][k], Af[m][k], acc[ai][bj][m][n], 0, 0, 0); __builtin_amdgcn_s_setprio(0); } while (0)
#define G_WAIT_V(n) asm volatile("s_waitcnt vmcnt(" #n ")" ::: "memory")
#define G_WAIT_L(n) asm volatile("s_waitcnt lgkmcnt(" #n ")" ::: "memory")
#define G_BAR __builtin_amdgcn_s_barrier()
#define G_SCHED __builtin_amdgcn_sched_barrier(0)
    int u = blk;
    while (u < cfg.nbig) {
        UnitD cur = unit_decode(P, cfg, gp, u);
        f32x4 acc[2][2][4][2];
#pragma unroll
        for (int a = 0; a < 2; ++a)
#pragma unroll
            for (int b = 0; b < 2; ++b)
#pragma unroll
                for (int m = 0; m < 4; ++m)
#pragma unroll
                    for (int n = 0; n < 2; ++n) acc[a][b][m][n] = (f32x4){0.f, 0.f, 0.f, 0.f};
        bf16x8 At[4][2], B0[2][2], B1[2][2];
        const char* cA = cur.A; const char* cB = cur.B;
        G_STAGE(G_SB(0, 0), cB, voffB); G_STAGE(G_SA(0, 0), cA, voffA); G_STAGE(G_SB(0, 1), cB + hstepB, voffB); G_STAGE(G_SA(0, 1), cA + hstepA, voffA);
        if (wr == 1) G_BAR;
        G_WAIT_V(4); G_BAR;
        G_STAGE(G_SB(1, 0), cB + kstep, voffB); G_STAGE(G_SA(1, 0), cA + kstep, voffA); G_STAGE(G_SB(1, 1), cB + hstepB + kstep, voffB);
        G_WAIT_V(6); G_BAR;
        for (;;) {
            const bool has_next = chain && (u + nblk < cfg.nbig);
            UnitD nxt = cur;
            if (has_next) nxt = unit_decode(P, cfg, gp, u + nblk);
            const char* nA = nxt.A; const char* nB = nxt.B;
            for (int t = 0; t < nt; t += 2) {
                const bool last = (t == nt - 2);
                const char* a1 = cA + (size_t)(t + 1) * kstep;
                const char* a2 = last ? nA : cA + (size_t)(t + 2) * kstep; const char* b2 = last ? nB : cB + (size_t)(t + 2) * kstep;
                const char* a3 = a2 + kstep; const char* b3 = b2 + kstep;
                G_LDB(B0, 0, 0); G_SCHED; G_LDA(At, 0, 0); G_STAGE(G_SA(1, 1), a1 + hstepA, voffA);
                G_WAIT_L(8); G_BAR; G_WAIT_L(0); G_MMA(0, 0, At, B0); G_BAR; G_SCHED;
                G_LDB(B1, 0, 1); G_STAGE(G_SB(0, 0), b2, voffB);
                G_BAR; G_WAIT_L(0); G_MMA(0, 1, At, B1); G_BAR;
                G_LDA(At, 0, 1); G_STAGE(G_SA(0, 0), a2, voffA);
                G_BAR; G_WAIT_L(0); G_MMA(1, 0, At, B0); G_BAR; G_SCHED;
                G_STAGE(G_SB(0, 1), b2 + hstepB, voffB);
                G_WAIT_V(6); G_BAR; G_MMA(1, 1, At, B1); G_BAR;
                G_LDB(B0, 1, 0); G_SCHED; G_LDA(At, 1, 0); G_STAGE(G_SA(0, 1), a2 + hstepA, voffA);
                G_WAIT_L(8); G_BAR; G_WAIT_L(0); G_MMA(0, 0, At, B0); G_BAR; G_SCHED;
                G_LDB(B1, 1, 1); G_STAGE(G_SB(1, 0), b3, voffB);
                G_BAR; G_WAIT_L(0); G_MMA(0, 1, At, B1); G_BAR;
                G_LDA(At, 1, 1); G_STAGE(G_SA(1, 0), a3, voffA);
                G_BAR; G_WAIT_L(0); G_MMA(1, 0, At, B0); G_BAR; G_SCHED;
                G_STAGE(G_SB(1, 1), b3 + hstepB, voffB);
                G_WAIT_V(6); G_BAR; G_MMA(1, 1, At, B1); G_BAR;
            }
            if (chain) {
                const int rbase = cur.row0 + wr * 64 + fr, cbase = cur.col0 + wc * 32 + fq * 4;
                switch (cur.ekind) {
                case E_PROJ: epi_loop<E_PROJ>(P, acc, rbase, cbase, fq); break;
                case E_MEMKV: epi_loop<E_MEMKV>(P, acc, rbase, cbase, fq); break;
                case E_POOL: epi_loop<E_POOL>(P, acc, rbase, cbase, fq); break;
                case E_OUT: epi_loop<E_OUT>(P, acc, rbase, cbase, fq); break;
                case E_Q: epi_loop<E_Q>(P, acc, rbase, cbase, fq); break;
                case E_PV: epi_loop<E_PV>(P, acc, rbase, cbase, fq); break;
                case E_MO: epi_loop<E_MO>(P, acc, rbase, cbase, fq); break;
                case E_UP: epi_loop<E_UP>(P, acc, rbase, cbase, fq); break;
                default: epi_loop<E_DOWN>(P, acc, rbase, cbase, fq); break;
                }
            }
            if (!has_next) break;
#pragma unroll
            for (int a = 0; a < 2; ++a)
#pragma unroll
                for (int b = 0; b < 2; ++b)
#pragma unroll
                    for (int m = 0; m < 4; ++m)
#pragma unroll
                        for (int n = 0; n < 2; ++n) acc[a][b][m][n] = (f32x4){0.f, 0.f, 0.f, 0.f};
            cur = nxt; cA = nA; cB = nB; u += nblk;
        }
        G_WAIT_V(0);
        if (wr == 0) G_BAR;
        G_BAR;
        if (!chain) {
            float* redm = (float*)(shm_g + 131072);
            float* reds = (float*)(shm_g + 135168);
#pragma unroll
            for (int ai = 0; ai < 2; ++ai)
#pragma unroll
                for (int m = 0; m < 4; ++m) {
                    float t = -3.0e38f;
#pragma unroll
                    for (int bj = 0; bj < 2; ++bj)
#pragma unroll
                        for (int n = 0; n < 2; ++n)
#pragma unroll
                            for (int j = 0; j < 4; ++j) t = fmaxf(t, acc[ai][bj][m][n][j]);
                    t = fmaxf(t, __shfl_xor(t, 16)); t = fmaxf(t, __shfl_xor(t, 32));
                    if (fq == 0) redm[(ai * 128 + wr * 64 + m * 16 + fr) * 4 + wc] = t;
                }
            __syncthreads();
#pragma unroll
            for (int ai = 0; ai < 2; ++ai)
#pragma unroll
                for (int m = 0; m < 4; ++m) {
                    const f32x4 r = *(const f32x4*)(redm + (ai * 128 + wr * 64 + m * 16 + fr) * 4);
                    const float M = fmaxf(fmaxf(r[0], r[1]), fmaxf(r[2], r[3]));
                    float s = 0.f;
#pragma unroll
                    for (int bj = 0; bj < 2; ++bj)
#pragma unroll
                        for (int n = 0; n < 2; ++n)
#pragma unroll
                            for (int j = 0; j < 4; ++j) { const float e = __expf(acc[ai][bj][m][n][j] - M); acc[ai][bj][m][n][j] = e; s += e; }
                    s += __shfl_xor(s, 16); s += __shfl_xor(s, 32);
                    if (fq == 0) reds[(ai * 128 + wr * 64 + m * 16 + fr) * 4 + wc] = s;
                }
            __syncthreads();
#pragma unroll
            for (int ai = 0; ai < 2; ++ai)
#pragma unroll
                for (int m = 0; m < 4; ++m) {
                    const int rl = ai * 128 + wr * 64 + m * 16 + fr;
                    const f32x4 r = *(const f32x4*)(reds + rl * 4);
                    const float inv = 1.0f / ((r[0] + r[1]) + (r[2] + r[3]));
                    bf16_t* prow = (bf16_t*)(P->ws + W_P) + (size_t)(cur.row0 + rl) * 1024 + cur.col0;
#pragma unroll
                    for (int bj = 0; bj < 2; ++bj) {
                        const f32x4 v0 = acc[ai][bj][m][0], v1 = acc[ai][bj][m][1];
                        u32x4 o; o.x = pk2(v0[0] * inv, v0[1] * inv); o.y = pk2(v0[2] * inv, v0[3] * inv); o.z = pk2(v1[0] * inv, v1[1] * inv); o.w = pk2(v1[2] * inv, v1[3] * inv);
                        *(u32x4*)(prow + bj * 128 + wc * 32 + fq * 8) = o;
                    }
                }
            __syncthreads();
        }
        u += nblk;
    }
#undef G_SA
#undef G_SB
#undef G_STAGE
#undef G_LDA
#undef G_LDB
#undef G_MMA
    const int rot = cfg.nbig % nblk;
    for (int s0 = (lb - rot + nblk) % nblk; s0 < cfg.nsmall; s0 += nblk) {
        const int pr = s0 / cfg.ncol64, pc = s0 % cfg.ncol64;
        const int row0 = (gp == 1 ? 0 : TP) + pr * 32, col0 = pc * 64;
        int lda_s = cfg.lda, ldb_s = cfg.ldb, K_s = K, ek_s = cfg.ekind;
        const bf16_t* Ab; const bf16_t* Bb;
        if (gp == 1) {
            const int g = pc >> 2; lda_s = 1024; ldb_s = 256; K_s = 256; ek_s = E_FOLD;
            Ab = (const bf16_t*)(P->ws + W_WLO) + (size_t)row0 * 1024 + g * 256; Bb = (const bf16_t*)(P->ws + W_WPOOL) + (size_t)g * 65536 + (size_t)(col0 - g * 256) * 256;
        } else { Ab = (const bf16_t*)cfg.A + (size_t)row0 * cfg.lda; Bb = (const bf16_t*)cfg.B + (size_t)col0 * cfg.ldb; }
        const int kw = K_s >> 3, nks = kw >> 5;
        f32x4 acc[2][4];
#pragma unroll
        for (int mi = 0; mi < 2; ++mi)
#pragma unroll
            for (int ni = 0; ni < 4; ++ni) acc[mi][ni] = (f32x4){0.f, 0.f, 0.f, 0.f};
        const bf16_t* ap = Ab + (size_t)fr * lda_s + wid * kw + fq * 8;
        const bf16_t* bp = Bb + (size_t)fr * ldb_s + wid * kw + fq * 8;
        for (int ks0 = 0; ks0 < nks; ks0 += 4) {
            bf16x8 a[4][2], b[4][4];
#pragma unroll
            for (int q = 0; q < 4; ++q) {
                const bool ok = ks0 + q < nks;
#pragma unroll
                for (int mi = 0; mi < 2; ++mi) { bf16x8 z = {0, 0, 0, 0, 0, 0, 0, 0}; if (ok) z = *(const bf16x8*)(ap + (size_t)mi * 16 * lda_s + (ks0 + q) * 32); a[q][mi] = z; }
#pragma unroll
                for (int ni = 0; ni < 4; ++ni) { bf16x8 z = {0, 0, 0, 0, 0, 0, 0, 0}; if (ok) z = *(const bf16x8*)(bp + (size_t)ni * 16 * ldb_s + (ks0 + q) * 32); b[q][ni] = z; }
            }
#pragma unroll
            for (int q = 0; q < 4; ++q)
#pragma unroll
                for (int mi = 0; mi < 2; ++mi)
#pragma unroll
                    for (int ni = 0; ni < 4; ++ni) acc[mi][ni] = __builtin_amdgcn_mfma_f32_16x16x32_bf16(b[q][ni], a[q][mi], acc[mi][ni], 0, 0, 0);
        }
        float* red = (float*)shm_g;
#pragma unroll
        for (int mi = 0; mi < 2; ++mi)
#pragma unroll
            for (int ni = 0; ni < 4; ++ni) *(f32x4*)(red + wid * 2048 + (mi * 16 + fr) * 64 + ni * 16 + fq * 4) = acc[mi][ni];
        __syncthreads();
        {
            const int r = tid >> 4, c = (tid & 15) * 4;
            f32x4 v = *(const f32x4*)(red + r * 64 + c);
#pragma unroll
            for (int w = 1; w < 8; ++w) v += *(const f32x4*)(red + w * 2048 + r * 64 + c);
            const int cl = (gp == 1) ? c : (c & 32) + perm32(c & 31);
            float ss = epi_apply_rt(P, ek_s, row0 + r, col0 + cl, v);
            if (cfg.ekind == E_OUT || cfg.ekind == E_MO || cfg.ekind == E_DOWN) {
                ss += __shfl_xor(ss, 1); ss += __shfl_xor(ss, 2); ss += __shfl_xor(ss, 4); ss += __shfl_xor(ss, 8);
                if ((tid & 15) == 0) unsafeAtomicAdd((float*)(P->ws + (cfg.ekind == E_OUT ? W_SS1 : cfg.ekind == E_MO ? W_SS2 : W_SS3)) + row0 + r, ss);
            }
        }
        __syncthreads();
    }
}

struct TrDesc { const float* src; bf16_t* dst; const float* gain; int ld_src, ld_dst, k0, n0s, n0d, perm; };
__device__ __forceinline__ TrDesc tr_decode(PP P, int i) {
    char* ws = P->ws; TrDesc d; d.gain = nullptr; d.perm = 0;
    if (i < 896) { const int kt = i / 56, ntl = i % 56; d.n0d = ntl * 64; d.n0s = d.n0d < 2560 ? d.n0d : d.n0d + 16; d.src = P->w_in; d.ld_src = 3600; d.dst = (bf16_t*)(ws + W_WIN); d.ld_dst = 1024; d.k0 = kt * 64; d.perm = 1; return d; }
    i -= 896;
    if (i < 512) { const int kt = i >> 4, ntl = i & 15; d.ld_src = 1024; d.n0s = d.n0d = ntl * 64;
        d.perm = kt < 16 ? 1 : 0;
        if (kt < 16) { d.src = P->w_out; d.dst = (bf16_t*)(ws + W_WOUT); d.ld_dst = 2048; d.k0 = kt * 64; }
        else { d.src = P->w_out + (size_t)1024 * 1024; d.dst = (bf16_t*)(ws + W_WLO); d.ld_dst = 1024; d.k0 = (kt - 16) * 64; }
        return d; }
    i -= 512;
    if (i < 1024) { const int wsel = i >> 8, r = i & 255, kt = r >> 4, ntl = r & 15;
        d.src = wsel == 0 ? P->w_mq : wsel == 1 ? P->w_mk : wsel == 2 ? P->w_mv : P->w_mo;
        d.dst = (bf16_t*)(ws + (wsel == 0 ? W_WMQ : wsel == 1 ? W_WMK : wsel == 2 ? W_WMV : W_WMO));
        d.gain = wsel == 0 ? P->norm_mem : nullptr; d.ld_src = 1024; d.ld_dst = 1024; d.k0 = kt * 64; d.n0s = d.n0d = ntl * 64; d.perm = (wsel == 0 || wsel == 3) ? 1 : 0; return d; }
    i -= 1024;
    if (i < 1408) { const int kt = i / 88, ntl = i % 88; d.src = P->w_up; d.ld_src = 5632; d.dst = (bf16_t*)(ws + W_WUP); d.ld_dst = 1024; d.gain = P->norm_ffn; d.k0 = kt * 64; d.n0s = d.n0d = ntl * 64; d.perm = 1; return d; }
    i -= 1408;
    { const int kt = i >> 4, ntl = i & 15; d.src = P->w_down; d.ld_src = 1024; d.dst = (bf16_t*)(ws + W_WDOWN); d.ld_dst = 2816; d.k0 = kt * 64; d.n0s = d.n0d = ntl * 64; d.perm = 1; return d; }
}

__device__ __forceinline__ void phase_prep(PP P, char* shm, int blk, int nblk, const int tid) {
    const int wid = tid >> 6, lane = tid & 63;
    float* tiles = (float*)shm;
    float* wdt = (float*)(shm + 69632);
    for (int i = blk * NTHR + tid; i < 3 * TT; i += nblk * NTHR) ((float*)(P->ws + W_SS1))[i] = 0.f;
    for (int i = (blk * NTHR + tid) * 4; i < 4 * 65536; i += nblk * NTHR * 4) {
        const f32x4 wv = *(const f32x4*)(P->w_pool + i), sv = *(const f32x4*)(P->pool_scale + (i >> 16) * 256 + (i & 255));
        u32x2 o; o.x = pk2(wv[0] * sv[0], wv[1] * sv[1]); o.y = pk2(wv[2] * sv[2], wv[3] * sv[3]);
        *(u32x2*)((bf16_t*)(P->ws + W_WPOOL) + i) = o;
    }
    for (int i = tid; i < 1024 * 16; i += NTHR) { const int k = i >> 4, hd = i & 15; wdt[hd * 1024 + k] = P->w_in[(size_t)k * 3600 + 2560 + hd]; }
    __syncthreads();
    char* ws = P->ws;
    constexpr int NGRP = (TT + 2048) / 32;
    for (int it = blk; it < NGRP; it += nblk) {
        const int rbase = it * 32 + wid * 4;
        const bool ismem = rbase >= TT;
        f32x4 xv[4][4];
#pragma unroll
        for (int r = 0; r < 4; ++r) {
            const int row = (ismem ? rbase - TT : rbase) + r;
            const float* xr = ismem ? P->mem_prompt + (size_t)row * 1024 : (row < TP ? P->x_prompt + (size_t)row * 1024 : P->x_sample + (size_t)(row - TP) * 1024);
#pragma unroll
            for (int j = 0; j < 4; ++j) xv[r][j] = __builtin_nontemporal_load((const f32x4*)(xr + j * 256 + lane * 4));
        }
        const float* gg = ismem ? P->norm_memkv : P->norm_mix;
#pragma unroll
        for (int r = 0; r < 4; ++r) {
            const int row = (ismem ? rbase - TT : rbase) + r;
            bf16_t* orow = (bf16_t*)(ws + (ismem ? W_HM : W_H)) + (size_t)row * 1024;
            float ss = 0.f;
#pragma unroll
            for (int j = 0; j < 4; ++j) ss += xv[r][j][0] * xv[r][j][0] + xv[r][j][1] * xv[r][j][1] + xv[r][j][2] * xv[r][j][2] + xv[r][j][3] * xv[r][j][3];
            ss = wave_sum(ss);
            const float rstd = rsqrtf(ss * (1.0f / 1024.0f) + EPS);
#pragma unroll
            for (int j = 0; j < 4; ++j) { const f32x4 g4 = *(const f32x4*)(gg + j * 256 + lane * 4); xv[r][j] = xv[r][j] * rstd * g4;
                u32x2 o; o.x = pk2(xv[r][j][0], xv[r][j][1]); o.y = pk2(xv[r][j][2], xv[r][j][3]); *(u32x2*)(orow + j * 256 + lane * 4) = o; }
        }
        if (!ismem) {
            float vals[64];
#pragma unroll
            for (int hd = 0; hd < 16; ++hd) {
                f32x4 w4[4];
#pragma unroll
                for (int j = 0; j < 4; ++j) w4[j] = *(const f32x4*)(wdt + hd * 1024 + j * 256 + lane * 4);
#pragma unroll
                for (int r = 0; r < 4; ++r) {
                    float a = 0.f;
#pragma unroll
                    for (int j = 0; j < 4; ++j) a += xv[r][j][0] * w4[j][0] + xv[r][j][1] * w4[j][1] + xv[r][j][2] * w4[j][2] + xv[r][j][3] * w4[j][3];
                    vals[r * 16 + hd] = a;
                }
            }
#pragma unroll
            for (int half = 32; half >= 1; half >>= 1) {
                const bool hi = (lane & half) != 0;
#pragma unroll
                for (int i = 0; i < half; ++i) {
                    const float keep = hi ? vals[i + half] : vals[i], send = hi ? vals[i] : vals[i + half];
                    vals[i] = keep + __shfl_xor(send, half);
                }
            }
            const float x = vals[0] + P->dt_bias[lane & 15];
            const float ey = __expf(-fabsf(x)); const float l1p = ey < 0.03f ? ey * (1.0f - ey * (0.5f - ey * (0.33333333f - 0.25f * ey))) : __logf(1.0f + ey);
            ((float*)(ws + W_DT))[(size_t)rbase * 16 + lane] = fmaxf(x, 0.f) + l1p;
        }
    }
    __syncthreads();
    const int kr = tid >> 4, nc = (tid & 15) * 4, tn = tid >> 3, tk8 = (tid & 7) * 8;
    for (int it = blk; it < 4544; it += 4 * nblk) {
        f32x4 v[4][2];
#pragma unroll
        for (int q = 0; q < 4; ++q) {
            const int i = it + q * nblk;
            if (i < 4544) { const TrDesc d = tr_decode(P, i);
#pragma unroll
                for (int h = 0; h < 2; ++h) { const int k = kr + h * 32; f32x4 t = __builtin_nontemporal_load((const f32x4*)(d.src + (size_t)(d.k0 + k) * d.ld_src + d.n0s + nc)); if (d.gain) t *= d.gain[d.k0 + k]; v[q][h] = t; } }
        }
#pragma unroll
        for (int q = 0; q < 4; ++q) {
            if (it + q * nblk < 4544) { float* tile = tiles + q * (64 * 65);
#pragma unroll
                for (int h = 0; h < 2; ++h) { const int k = kr + h * 32; tile[k * 65 + nc + 0] = v[q][h][0]; tile[k * 65 + nc + 1] = v[q][h][1]; tile[k * 65 + nc + 2] = v[q][h][2]; tile[k * 65 + nc + 3] = v[q][h][3]; } }
        }
        __syncthreads();
#pragma unroll
        for (int q = 0; q < 4; ++q) {
            const int i = it + q * nblk;
            if (i < 4544) { const TrDesc d = tr_decode(P, i); const float* tile = tiles + q * (64 * 65); float f[8];
                const int sc = d.perm ? (tn & 32) + perm32(tn & 31) : tn;
#pragma unroll
                for (int e2 = 0; e2 < 8; ++e2) f[e2] = tile[(tk8 + e2) * 65 + sc];
                *(u32x4*)(d.dst + (size_t)(d.n0d + tn) * d.ld_dst + d.k0 + tk8) = pack8(f); }
        }
        __syncthreads();
    }
}

__device__ __forceinline__ u32x4 ld8(const bf16_t* p) { return *(const u32x4*)p; }

__device__ __forceinline__ void phase_convpool(PP P, int gtid, int nthreads) {
    char* ws = P->ws;
    const bf16_t* proj2 = (const bf16_t*)(ws + W_PROJ2);
    bf16_t* xact = (bf16_t*)(ws + W_XACT);
    bf16_t* pooled = (bf16_t*)(ws + W_POOLED);
    for (int idx = gtid; idx < 1152 * 320; idx += nthreads) {
        const int run = idx / 320, cg = idx % 320;
        const bool samp = run >= 1024;
        int t0, len, bidx, tl0;
        if (!samp) { t0 = run * 16; len = 16; bidx = t0 >> 11; tl0 = t0 & 2047; } else { bidx = run - 1024; t0 = TP + bidx * 4; len = 4; tl0 = 0; }
        if (cg < 192) {
            const int c0 = cg * 8;
            float w0[8], w1[8], w2[8], w3[8], bs[8], h0[8], h1[8], h2[8];
#pragma unroll
            for (int e = 0; e < 8; ++e) { w0[e] = P->conv_w[c0 + e]; w1[e] = P->conv_w[1536 + c0 + e]; w2[e] = P->conv_w[3072 + c0 + e]; w3[e] = P->conv_w[4608 + c0 + e]; bs[e] = P->conv_b[c0 + e]; }
            if (samp) {
#pragma unroll
                for (int e = 0; e < 8; ++e) { h0[e] = P->state_conv[(size_t)(bidx * 3 + 0) * 1536 + c0 + e]; h1[e] = P->state_conv[(size_t)(bidx * 3 + 1) * 1536 + c0 + e]; h2[e] = P->state_conv[(size_t)(bidx * 3 + 2) * 1536 + c0 + e]; }
            } else if (tl0 > 0) {
                unpack8(ld8(proj2 + (size_t)(t0 - 3) * 2560 + c0), h0); unpack8(ld8(proj2 + (size_t)(t0 - 2) * 2560 + c0), h1); unpack8(ld8(proj2 + (size_t)(t0 - 1) * 2560 + c0), h2);
            } else {
#pragma unroll
                for (int e = 0; e < 8; ++e) { h0[e] = 0.f; h1[e] = 0.f; h2[e] = 0.f; }
            }
            u32x4 rx[16];
#pragma unroll
            for (int j = 0; j < 16; ++j) { if (j < len) rx[j] = __builtin_nontemporal_load((const u32x4*)(proj2 + (size_t)(t0 + j) * 2560 + c0)); }
#pragma unroll
            for (int j = 0; j < 16; ++j) {
                if (j < len) {
                float x3[8], y[8]; unpack8(rx[j], x3);
#pragma unroll
                for (int e = 0; e < 8; ++e) { const float v = bs[e] + w0[e] * h0[e] + w1[e] * h1[e] + w2[e] * h2[e] + w3[e] * x3[e]; y[e] = silu_f(v); }
                *(u32x4*)(xact + (size_t)(t0 + j) * 1536 + c0) = pack8(y);
                if (samp) { if (j >= 1) { float* o = P->out + O_CONVS + (size_t)(bidx * 3 + j - 1) * 1536 + c0;
#pragma unroll
                        for (int e = 0; e < 8; ++e) o[e] = x3[e]; } }
                else { const int tl = tl0 + j; if (tl >= 2045) { float* o = P->out + O_CONVP + (size_t)(bidx * 3 + tl - 2045) * 1536 + c0;
#pragma unroll
                        for (int e = 0; e < 8; ++e) o[e] = x3[e]; } }
#pragma unroll
                for (int e = 0; e < 8; ++e) { h0[e] = h1[e]; h1[e] = h2[e]; h2[e] = x3[e]; }
                }
            }
        } else {
            const int c0 = (cg - 192) * 8; const int win = 2 << (c0 >> 8);
            const bf16_t* vp = proj2 + 1536 + c0;
            const float* prev = P->state_pool + (size_t)bidx * 15 * 1024 + c0;
            float sum[8];
#pragma unroll
            for (int e = 0; e < 8; ++e) sum[e] = 0.f;
            if (samp) {
                for (int jj = 1; jj < win; ++jj) {
#pragma unroll
                    for (int e = 0; e < 8; ++e) sum[e] += prev[(size_t)(15 - jj) * 1024 + e]; }
                float* o = P->out + O_POOLS + (size_t)bidx * 15 * 1024 + c0;
                for (int i = 0; i < 11; ++i) {
#pragma unroll
                    for (int e = 0; e < 8; ++e) o[(size_t)i * 1024 + e] = prev[(size_t)(i + 4) * 1024 + e]; }
            } else if (tl0 > 0) {
                for (int jj = 1; jj < win; ++jj) { float v[8]; unpack8(ld8(vp + (size_t)(t0 - jj) * 2560), v);
#pragma unroll
                    for (int e = 0; e < 8; ++e) sum[e] += v[e]; }
            }
            u32x4 rp[16];
#pragma unroll
            for (int j = 0; j < 16; ++j) { if (j < len) rp[j] = ld8(vp + (size_t)(t0 + j) * 2560); }
#pragma unroll
            for (int j = 0; j < 16; ++j) {
                if (j >= len) continue;
                float v[8], o8[8]; unpack8(rp[j], v);
                const int tl = tl0 + j;
                const float inv = 1.0f / (float)(samp ? win : (tl + 1 < win ? tl + 1 : win));
#pragma unroll
                for (int e = 0; e < 8; ++e) { sum[e] += v[e]; o8[e] = sum[e] * inv - v[e]; }
                *(u32x4*)((bf16_t*)(ws + W_MIX) + (size_t)(t0 + j) * 2048 + 1024 + c0) = pack8(o8);
                const int to = j - win + 1;
                if (samp) {
                    if (to >= 0) { float q[8]; unpack8(ld8(vp + (size_t)(t0 + to) * 2560), q);
#pragma unroll
                        for (int e = 0; e < 8; ++e) sum[e] -= q[e]; }
                    else {
#pragma unroll
                        for (int e = 0; e < 8; ++e) sum[e] -= prev[(size_t)(15 + to) * 1024 + e]; }
                    float* o = P->out + O_POOLS + (size_t)(bidx * 15 + 11 + j) * 1024 + c0;
#pragma unroll
                    for (int e = 0; e < 8; ++e) o[e] = v[e];
                } else {
                    if (tl0 + to >= 0) { float q[8]; unpack8(ld8(vp + (size_t)(t0 + to) * 2560), q);
#pragma unroll
                        for (int e = 0; e < 8; ++e) sum[e] -= q[e]; }
                    if (tl >= 2033) { float* o = P->out + O_POOLP + (size_t)(bidx * 15 + tl - 2033) * 1024 + c0;
#pragma unroll
                        for (int e = 0; e < 8; ++e) o[e] = v[e]; }
                }
            }
        }
    }
}

constexpr int CS_STR = 136;
constexpr int X_STR = 40;
__device__ __forceinline__ s16x4 tr_read(const bf16_t* p) { return __builtin_bit_cast(s16x4, __builtin_amdgcn_ds_read_tr16_b64_v4i16((LDSB s16x4*)p)); }

#define LDS_BARRIER() asm volatile("s_waitcnt lgkmcnt(0)\n\ts_barrier" ::: "memory")
__device__ __forceinline__ void ssd_prompt(PP P, int item, char* shm, const int tid) {
    const int w = tid >> 6, lane = tid & 63, fr = lane & 15, fq = lane >> 4;
    const int b = item >> 5, hd = (item >> 1) & 15, ph = item & 1, g = hd >> 3;
    const float a = -expf(P->a_log[hd]);
    const float Dh = P->ssm_d[hd];
    char* ws = P->ws;
    const bf16_t* xact = (const bf16_t*)(ws + W_XACT);
    const float* dtb = (const float*)(ws + W_DT);
    bf16_t* ybuf = (bf16_t*)(ws + W_Y);
    bf16_t* Cs = (bf16_t*)(shm);
    bf16_t* Bs = (bf16_t*)(shm + 34816);
    bf16_t* Xd = (bf16_t*)(shm + 69632);
    bf16_t* X2 = (bf16_t*)(shm + 69632 + 10240);
    bf16_t* Ht = (bf16_t*)(shm + 69632 + 20480);
    float* acs = (float*)(shm + 69632 + 30720);
    float* dts = (float*)(shm + 69632 + 31232);
    f32x4 Hacc[2];
    Hacc[0] = (f32x4){0.f, 0.f, 0.f, 0.f}; Hacc[1] = (f32x4){0.f, 0.f, 0.f, 0.f};
    const int q4 = fr >> 2, p4 = fr & 3;
    u32x4 pc[4], pb[4], px; float pd0, pd1;
    const int ls = tid >> 4, ln8 = (tid & 15) * 8;
    const int xs = tid >> 2, xp8 = (tid & 3) * 8;
#define SSD_PREFETCH(cc) do { const int _t0 = b * 2048 + (cc) * 128; \
        _Pragma("unroll") for (int i = 0; i < 4; ++i) { const bf16_t* src = xact + (size_t)(_t0 + ls + i * 32) * 1536 + g * 128 + ln8; pc[i] = *(const u32x4*)(src + 1280); pb[i] = *(const u32x4*)(src + 1024); } \
        px = __builtin_nontemporal_load((const u32x4*)(xact + (size_t)(_t0 + xs) * 1536 + hd * 64 + ph * 32 + xp8)); \
        pd0 = dtb[(size_t)(_t0 + 2 * lane) * 16 + hd]; pd1 = dtb[(size_t)(_t0 + 2 * lane + 1) * 16 + hd]; } while (0)
    SSD_PREFETCH(0);
    for (int c = 0; c < 16; ++c) {
        const int t0 = b * 2048 + c * 128;
        if (w == 0) {
            const float d0 = pd0, d1 = pd1;
            const float s = (d0 + d1) * a; float v = s;
#pragma unroll
            for (int off = 1; off < 64; off <<= 1) { const float t = __shfl_up(v, off); if (lane >= off) v += t; }
            const float excl = v - s;
            acs[2 * lane] = excl + d0 * a; acs[2 * lane + 1] = v; dts[2 * lane] = d0; dts[2 * lane + 1] = d1;
        }
#pragma unroll
        for (int pt = 0; pt < 2; ++pt) { u32x2 o; o.x = pk2(Hacc[pt][0], Hacc[pt][1]); o.y = pk2(Hacc[pt][2], Hacc[pt][3]); *(u32x2*)(Ht + (w * 16 + fr) * X_STR + pt * 16 + fq * 4) = o; }
#pragma unroll
        for (int i = 0; i < 4; ++i) { *(u32x4*)(Cs + (ls + i * 32) * CS_STR + ln8) = pc[i]; *(u32x4*)(Bs + (ls + i * 32) * CS_STR + ln8) = pb[i]; }
        LDS_BARRIER();
        {
            float x[8], xa[8], xb[8]; unpack8(px, x);
            const float dtv = dts[xs], dec = __expf(acs[127] - acs[xs]) * dtv;
#pragma unroll
            for (int e = 0; e < 8; ++e) { xa[e] = x[e] * dtv; xb[e] = x[e] * dec; }
            *(u32x4*)(Xd + xs * X_STR + xp8) = pack8(xa);
            *(u32x4*)(X2 + xs * X_STR + xp8) = pack8(xb);
        }
        if (c < 15) SSD_PREFETCH(c + 1);
        bf16x8 Cf[4];
#pragma unroll
        for (int kk = 0; kk < 4; ++kk) Cf[kk] = *(const bf16x8*)(Cs + (w * 16 + fr) * CS_STR + kk * 32 + fq * 8);
        const int lrow = w * 16 + fr; const float al = acs[lrow];
        bf16x8 Gf[4];
#pragma unroll
        for (int kk = 0; kk < 4; ++kk) {
            u32x2 half[2];
#pragma unroll
            for (int hh = 0; hh < 2; ++hh) {
                const int st = 2 * kk + hh;
                half[hh].x = 0u; half[hh].y = 0u;
                if (st <= w) {
                    f32x4 ga = (f32x4){0.f, 0.f, 0.f, 0.f};
#pragma unroll
                    for (int k2 = 0; k2 < 4; ++k2) { const bf16x8 Bf = *(const bf16x8*)(Bs + (st * 16 + fr) * CS_STR + k2 * 32 + fq * 8); ga = __builtin_amdgcn_mfma_f32_16x16x32_bf16(Bf, Cf[k2], ga, 0, 0, 0); }
                    const int s0 = st * 16 + fq * 4; const f32x4 as4 = *(const f32x4*)(acs + s0);
                    float gv[4];
#pragma unroll
                    for (int j = 0; j < 4; ++j) gv[j] = (s0 + j <= lrow) ? ga[j] * __expf(al - as4[j]) : 0.f;
                    half[hh].x = pk2(gv[0], gv[1]); half[hh].y = pk2(gv[2], gv[3]);
                }
            }
            u32x4 g4; g4.x = half[0].x; g4.y = half[0].y; g4.z = half[1].x; g4.w = half[1].y;
            Gf[kk] = __builtin_bit_cast(bf16x8, g4);
        }
        LDS_BARRIER();
        {
            f32x4 Yd[2], Yo[2];
            Yd[0] = Yd[1] = Yo[0] = Yo[1] = (f32x4){0.f, 0.f, 0.f, 0.f};
            const int nkk = (w >> 1) + 1;
#pragma unroll
            for (int kk = 0; kk < 4; ++kk) {
                if (kk < nkk) {
#pragma unroll
                    for (int pt = 0; pt < 2; ++pt) {
                        const bf16_t* base = Xd + (kk * 32 + fq * 4 + q4) * X_STR + pt * 16 + p4 * 4;
                        bf16x8 Xf; Xf.lo = tr_read(base); Xf.hi = tr_read(base + 16 * X_STR);
                        Yd[pt] = __builtin_amdgcn_mfma_f32_16x16x32_bf16(Xf, Gf[kk], Yd[pt], 0, 0, 0);
                    }
                }
            }
#pragma unroll
            for (int kk = 0; kk < 4; ++kk)
#pragma unroll
                for (int pt = 0; pt < 2; ++pt) {
                    const bf16_t* hbp = Ht + (kk * 32 + fq * 8 + q4) * X_STR + pt * 16 + p4 * 4;
                    bf16x8 Hf; Hf.lo = tr_read(hbp); Hf.hi = tr_read(hbp + 4 * X_STR);
                    Yo[pt] = __builtin_amdgcn_mfma_f32_16x16x32_bf16(Hf, Cf[kk], Yo[pt], 0, 0, 0);
                }
            const float el = __expf(al); const float rdt = Dh / dts[lrow];
#pragma unroll
            for (int pt = 0; pt < 2; ++pt) {
                const u32x2 xr = *(const u32x2*)(Xd + lrow * X_STR + pt * 16 + fq * 4);
                const f32x4 y = Yd[pt] + el * Yo[pt] + rdt * (f32x4){bflo(xr.x), bfhi(xr.x), bflo(xr.y), bfhi(xr.y)};
                u32x2 o; o.x = pk2(y[0], y[1]); o.y = pk2(y[2], y[3]);
                *(u32x2*)(ybuf + (size_t)(t0 + lrow) * 1024 + hd * 64 + ph * 32 + pt * 16 + fq * 4) = o;
            }
        }
        {
            const float dc = __expf(acs[127]);
            Hacc[0] *= dc; Hacc[1] *= dc;
#pragma unroll
            for (int kk = 0; kk < 4; ++kk) {
                const bf16_t* bb = Bs + (kk * 32 + fq * 8 + q4) * CS_STR + w * 16 + p4 * 4;
                bf16x8 Bf; Bf.lo = tr_read(bb); Bf.hi = tr_read(bb + 4 * CS_STR);
#pragma unroll
                for (int pt = 0; pt < 2; ++pt) {
                    const bf16_t* xb = X2 + (kk * 32 + fq * 8 + q4) * X_STR + pt * 16 + p4 * 4;
                    bf16x8 Xf; Xf.lo = tr_read(xb); Xf.hi = tr_read(xb + 4 * X_STR);
                    Hacc[pt] = __builtin_amdgcn_mfma_f32_16x16x32_bf16(Xf, Bf, Hacc[pt], 0, 0, 0);
                }
            }
        }
        LDS_BARRIER();
    }
#undef SSD_PREFETCH
    float* so = P->out + O_SSMP + ((size_t)(b * 16 + hd) * 64 + ph * 32) * 128;
#pragma unroll
    for (int pt = 0; pt < 2; ++pt)
#pragma unroll
        for (int j = 0; j < 4; ++j) so[(size_t)(pt * 16 + fq * 4 + j) * 128 + w * 16 + fr] = Hacc[pt][j];
}

template <int NI>
__device__ __forceinline__ void ssd_sample(PP P, int item0, int istride, const int tid) {
    const int p = tid >> 3, n0 = (tid & 7) * 16;
    char* ws = P->ws;
    const bf16_t* xact = (const bf16_t*)(ws + W_XACT);
    const float* dtb = (const float*)(ws + W_DT);
    bf16_t* ybuf = (bf16_t*)(ws + W_Y);
    f32x4 hs[NI][4]; u32x4 rb[NI][4][2], rc[NI][4][2]; float xv[NI][4], dtv[NI][4];
#pragma unroll
    for (int q = 0; q < NI; ++q) {
        const int item = item0 + q * istride, b = item >> 4, hd = item & 15, g = hd >> 3;
        const size_t sidx = ((size_t)(b * 16 + hd) * 64 + p) * 128 + n0;
#pragma unroll
        for (int i = 0; i < 4; ++i) hs[q][i] = __builtin_nontemporal_load((const f32x4*)(P->state_ssm + sidx + i * 4));
#pragma unroll
        for (int i = 0; i < 4; ++i) {
            const int t = TP + b * 4 + i;
            xv[q][i] = bf2f(xact[(size_t)t * 1536 + hd * 64 + p]);
            dtv[q][i] = dtb[(size_t)t * 16 + hd];
            rb[q][i][0] = ld8(xact + (size_t)t * 1536 + 1024 + g * 128 + n0); rb[q][i][1] = ld8(xact + (size_t)t * 1536 + 1024 + g * 128 + n0 + 8);
            rc[q][i][0] = ld8(xact + (size_t)t * 1536 + 1280 + g * 128 + n0); rc[q][i][1] = ld8(xact + (size_t)t * 1536 + 1280 + g * 128 + n0 + 8);
        }
    }
#pragma unroll
    for (int q = 0; q < NI; ++q) {
        const int item = item0 + q * istride, b = item >> 4, hd = item & 15;
        const float a = -expf(P->a_log[hd]);
        const float Dh = P->ssm_d[hd];
        const size_t sidx = ((size_t)(b * 16 + hd) * 64 + p) * 128 + n0;
        float h[16];
#pragma unroll
        for (int i = 0; i < 4; ++i) { h[i * 4] = hs[q][i][0]; h[i * 4 + 1] = hs[q][i][1]; h[i * 4 + 2] = hs[q][i][2]; h[i * 4 + 3] = hs[q][i][3]; }
#pragma unroll
        for (int i = 0; i < 4; ++i) {
            const int t = TP + b * 4 + i;
            const float dA = __expf(dtv[q][i] * a), dx = dtv[q][i] * xv[q][i];
            float Bv[16], Cv[16];
            { float t8[8]; unpack8(rb[q][i][0], t8);
#pragma unroll
              for (int e = 0; e < 8; ++e) Bv[e] = t8[e];
              unpack8(rb[q][i][1], t8);
#pragma unroll
              for (int e = 0; e < 8; ++e) Bv[8 + e] = t8[e];
              unpack8(rc[q][i][0], t8);
#pragma unroll
              for (int e = 0; e < 8; ++e) Cv[e] = t8[e];
              unpack8(rc[q][i][1], t8);
#pragma unroll
              for (int e = 0; e < 8; ++e) Cv[8 + e] = t8[e]; }
            float part = 0.f;
#pragma unroll
            for (int e = 0; e < 16; ++e) { h[e] = h[e] * dA + dx * Bv[e]; part += h[e] * Cv[e]; }
            part += __shfl_xor(part, 1); part += __shfl_xor(part, 2); part += __shfl_xor(part, 4);
            if ((tid & 7) == 0) ybuf[(size_t)t * 1024 + hd * 64 + p] = f2bf(part + Dh * xv[q][i]);
        }
        float* so = P->out + O_SSMS + sidx;
#pragma unroll
        for (int i = 0; i < 4; ++i) __builtin_nontemporal_store((f32x4){h[i * 4], h[i * 4 + 1], h[i * 4 + 2], h[i * 4 + 3]}, (f32x4*)(so + i * 4));
    }
}

__device__ __forceinline__ void phase_gatednorm(PP P, int gw, int nw, const int tid) {
    const int lane = tid & 63;
    char* ws = P->ws;
    const bf16_t* ybuf = (const bf16_t*)(ws + W_Y); const bf16_t* zbuf = (const bf16_t*)(ws + W_Z);
    bf16_t* mix = (bf16_t*)(ws + W_MIX);
    for (int row0 = gw; row0 < TT; row0 += 4 * nw) {
        u32x2 yv[4][4], zv[4][4];
#pragma unroll
        for (int r = 0; r < 4; ++r) { const int row = row0 + r * nw; if (row < TT) {
#pragma unroll
            for (int j = 0; j < 4; ++j) { yv[r][j] = __builtin_nontemporal_load((const u32x2*)(ybuf + (size_t)row * 1024 + j * 256 + lane * 4)); zv[r][j] = __builtin_nontemporal_load((const u32x2*)(zbuf + (size_t)row * 1024 + j * 256 + lane * 4)); } } }
#pragma unroll
        for (int r = 0; r < 4; ++r) { const int row = row0 + r * nw; if (row < TT) {
            float t[4][4]; float ss0 = 0.f, ss1 = 0.f;
#pragma unroll
            for (int j = 0; j < 4; ++j) {
                const float y0 = bflo(yv[r][j].x), y1 = bfhi(yv[r][j].x), y2 = bflo(yv[r][j].y), y3 = bfhi(yv[r][j].y);
                const float z0 = bflo(zv[r][j].x), z1 = bfhi(zv[r][j].x), z2 = bflo(zv[r][j].y), z3 = bfhi(zv[r][j].y);
                t[j][0] = y0 * silu_f(z0); t[j][1] = y1 * silu_f(z1); t[j][2] = y2 * silu_f(z2); t[j][3] = y3 * silu_f(z3);
                const float q = t[j][0] * t[j][0] + t[j][1] * t[j][1] + t[j][2] * t[j][2] + t[j][3] * t[j][3];
                if (j < 2) ss0 += q; else ss1 += q;
            }
            ss0 = wave_sum(ss0); ss1 = wave_sum(ss1);
            const float r0 = rsqrtf(ss0 * (1.0f / 512.0f) + EPS), r1 = rsqrtf(ss1 * (1.0f / 512.0f) + EPS);
#pragma unroll
            for (int j = 0; j < 4; ++j) {
                const float rr = j < 2 ? r0 : r1;
                const f32x4 g4 = *(const f32x4*)(P->ssm_norm + j * 256 + lane * 4);
                u32x2 o; o.x = pk2(t[j][0] * rr * g4[0], t[j][1] * rr * g4[1]); o.y = pk2(t[j][2] * rr * g4[2], t[j][3] * rr * g4[3]);
                *(u32x2*)(mix + (size_t)row * 2048 + j * 256 + lane * 4) = o;
            }
        } }
    }
}

__device__ __forceinline__ void phase_norm(PP P, const float* gain, bool final_out, int gw, int nw, const int tid) {
    const int lane = tid & 63;
    char* ws = P->ws;
    const bf16_t* hb = (const bf16_t*)(ws + W_H);
    const float* ss3 = (const float*)(ws + W_SS3);
    for (int row0 = gw; row0 < TT; row0 += 4 * nw) {
        u32x2 xv[4][4]; float sq[4];
#pragma unroll
        for (int r = 0; r < 4; ++r) { const int row = row0 + r * nw; if (row < TT) { sq[r] = ss3[row];
#pragma unroll
            for (int j = 0; j < 4; ++j) xv[r][j] = __builtin_nontemporal_load((const u32x2*)(hb + (size_t)row * 1024 + j * 256 + lane * 4)); } }
#pragma unroll
        for (int r = 0; r < 4; ++r) { const int row = row0 + r * nw; if (row < TT) {
            const float rstd = rsqrtf(sq[r] * (1.0f / 1024.0f) + EPS);
#pragma unroll
            for (int j = 0; j < 4; ++j) {
                const f32x4 g4 = *(const f32x4*)(gain + j * 256 + lane * 4);
                const f32x4 x = (f32x4){bflo(xv[r][j].x), bfhi(xv[r][j].x), bflo(xv[r][j].y), bfhi(xv[r][j].y)};
                __builtin_nontemporal_store(x * rstd * g4, (f32x4*)(P->out + O_YP + (size_t)row * 1024 + j * 256 + lane * 4));
            }
        } }
    }
}

__device__ __forceinline__ void attn_sample(PP P, int item0, int item1, char* shm, const int tid) {
    const int w = tid >> 6, lane = tid & 63, fr = lane & 15, fq = lane >> 4;
    const int half = w >> 2, w4 = w & 3;
    const int item = half ? item1 : item0;
    const bool act = item >= 0;
    const int b = act ? item >> 2 : 0, hh = item & 3;
    char* ws = P->ws;
    const bf16_t* qb = (const bf16_t*)(ws + W_Q);
    float* sc = (float*)shm + half * 1024;
    float* part = (float*)(shm + 8192) + half * 4096;
    const float* vp = P->cache_v + ((size_t)(b * 256 + w4 * 64) * 4 + hh) * 256 + lane * 4;
    f32x4 va[16], vb[16];
    if (act) {
#pragma unroll
        for (int mm = 0; mm < 16; ++mm) va[mm] = __builtin_nontemporal_load((const f32x4*)(vp + (size_t)mm * 1024));
    }
    if (act) {
        bf16x8 qf[8];
#pragma unroll
        for (int kk = 0; kk < 8; ++kk) {
            bf16x8 z = {0, 0, 0, 0, 0, 0, 0, 0};
            if (fr < 4) z = *(const bf16x8*)(qb + (size_t)(TP + b * 4 + fr) * 1024 + hh * 256 + kk * 32 + fq * 8);
            qf[kk] = z;
        }
#pragma unroll
        for (int mt = 0; mt < 4; ++mt) {
            const int key = w4 * 64 + mt * 16 + fr;
            const float* kp = P->cache_k + ((size_t)(b * 256 + key) * 4 + hh) * 256 + fq * 8;
            f32x4 k0[8], k1[8];
#pragma unroll
            for (int kk = 0; kk < 8; ++kk) { k0[kk] = __builtin_nontemporal_load((const f32x4*)(kp + kk * 32)); k1[kk] = __builtin_nontemporal_load((const f32x4*)(kp + kk * 32 + 4)); }
            f32x4 acc = (f32x4){0.f, 0.f, 0.f, 0.f};
#pragma unroll
            for (int kk = 0; kk < 8; ++kk) {
                u32x4 pk; pk.x = pk2(k0[kk][0], k0[kk][1]); pk.y = pk2(k0[kk][2], k0[kk][3]); pk.z = pk2(k1[kk][0], k1[kk][1]); pk.w = pk2(k1[kk][2], k1[kk][3]);
                acc = __builtin_amdgcn_mfma_f32_16x16x32_bf16(qf[kk], __builtin_bit_cast(bf16x8, pk), acc, 0, 0, 0);
            }
            if (fq == 0) {
#pragma unroll
                for (int j = 0; j < 4; ++j) sc[j * 256 + w4 * 64 + mt * 16 + fr] = acc[j];
            }
        }
    }
    LDS_BARRIER();
    if (act) {
#pragma unroll
        for (int mm = 0; mm < 16; ++mm) vb[mm] = __builtin_nontemporal_load((const f32x4*)(vp + (size_t)(16 + mm) * 1024));
        f32x4 s = *(const f32x4*)(sc + w4 * 256 + lane * 4);
        float m = fmaxf(fmaxf(s[0], s[1]), fmaxf(s[2], s[3])); m = wave_max(m);
        s[0] = __expf(s[0] - m); s[1] = __expf(s[1] - m); s[2] = __expf(s[2] - m); s[3] = __expf(s[3] - m);
        float su = (s[0] + s[1]) + (s[2] + s[3]); su = wave_sum(su);
        const float inv = 1.0f / su;
        *(f32x4*)(sc + w4 * 256 + lane * 4) = s * inv;
    }
    LDS_BARRIER();
    if (act) {
        f32x4 o[4];
#pragma unroll
        for (int i = 0; i < 4; ++i) o[i] = (f32x4){0.f, 0.f, 0.f, 0.f};
#pragma unroll
        for (int mm = 0; mm < 16; ++mm) {
#pragma unroll
            for (int i = 0; i < 4; ++i) o[i] += sc[i * 256 + w4 * 64 + mm] * va[mm];
        }
#pragma unroll
        for (int mm = 0; mm < 16; ++mm) va[mm] = __builtin_nontemporal_load((const f32x4*)(vp + (size_t)(32 + mm) * 1024));
#pragma unroll
        for (int mm = 0; mm < 16; ++mm) {
#pragma unroll
            for (int i = 0; i < 4; ++i) o[i] += sc[i * 256 + w4 * 64 + 16 + mm] * vb[mm];
        }
#pragma unroll
        for (int mm = 0; mm < 16; ++mm) vb[mm] = __builtin_nontemporal_load((const f32x4*)(vp + (size_t)(48 + mm) * 1024));
#pragma unroll
        for (int mm = 0; mm < 16; ++mm) {
#pragma unroll
            for (int i = 0; i < 4; ++i) o[i] += sc[i * 256 + w4 * 64 + 32 + mm] * va[mm];
        }
#pragma unroll
        for (int mm = 0; mm < 16; ++mm) {
#pragma unroll
            for (int i = 0; i < 4; ++i) o[i] += sc[i * 256 + w4 * 64 + 48 + mm] * vb[mm];
        }
#pragma unroll
        for (int i = 0; i < 4; ++i) *(f32x4*)(part + (w4 * 4 + i) * 256 + lane * 4) = o[i];
    }
    LDS_BARRIER();
    if (act) {
        f32x4 r = *(const f32x4*)(part + (0 * 4 + w4) * 256 + lane * 4);
#pragma unroll
        for (int ww = 1; ww < 4; ++ww) r += *(const f32x4*)(part + (ww * 4 + w4) * 256 + lane * 4);
        u32x2 o; o.x = pk2(r[0], r[1]); o.y = pk2(r[2], r[3]);
        *(u32x2*)((bf16_t*)(ws + W_O) + (size_t)(TP + b * 4 + w4) * 1024 + hh * 256 + lane * 4) = o;
    }
    LDS_BARRIER();
}

__device__ __forceinline__ void phase_ffnconv(PP P, int gtid, int nthreads) {
    char* ws = P->ws;
    const bf16_t* u = (const bf16_t*)(ws + W_U);
    bf16_t* act = (bf16_t*)(ws + W_ACT);
    for (int idx = gtid; idx < 1152 * 352; idx += nthreads) {
        const int run = idx / 352, cg = idx % 352;
        const bool samp = run >= 1024;
        int t0, len, bidx, tl0;
        if (!samp) { t0 = run * 16; len = 16; bidx = t0 >> 11; tl0 = t0 & 2047; } else { bidx = run - 1024; t0 = TP + bidx * 4; len = 4; tl0 = 0; }
        const int cgc = cg * 8, cvc = 2816 + cg * 8;
        float wg0[8], wg1[8], wg2[8], wv0[8], wv1[8], wv2[8], bg[8], bv[8], hg0[8], hg1[8], hv0[8], hv1[8];
#pragma unroll
        for (int e = 0; e < 8; ++e) {
            wg0[e] = P->ffn_w[cgc + e]; wg1[e] = P->ffn_w[5632 + cgc + e]; wg2[e] = P->ffn_w[11264 + cgc + e];
            wv0[e] = P->ffn_w[cvc + e]; wv1[e] = P->ffn_w[5632 + cvc + e]; wv2[e] = P->ffn_w[11264 + cvc + e];
            bg[e] = P->ffn_b[cgc + e]; bv[e] = P->ffn_b[cvc + e];
        }
        if (samp) {
#pragma unroll
            for (int e = 0; e < 8; ++e) {
                hg0[e] = P->state_ffn[(size_t)(bidx * 2 + 0) * 5632 + cgc + e]; hg1[e] = P->state_ffn[(size_t)(bidx * 2 + 1) * 5632 + cgc + e];
                hv0[e] = P->state_ffn[(size_t)(bidx * 2 + 0) * 5632 + cvc + e]; hv1[e] = P->state_ffn[(size_t)(bidx * 2 + 1) * 5632 + cvc + e];
            }
        } else if (tl0 > 0) {
            unpack8(ld8(u + (size_t)(t0 - 2) * 5632 + cgc), hg0); unpack8(ld8(u + (size_t)(t0 - 1) * 5632 + cgc), hg1);
            unpack8(ld8(u + (size_t)(t0 - 2) * 5632 + cvc), hv0); unpack8(ld8(u + (size_t)(t0 - 1) * 5632 + cvc), hv1);
        } else {
#pragma unroll
            for (int e = 0; e < 8; ++e) { hg0[e] = 0.f; hg1[e] = 0.f; hv0[e] = 0.f; hv1[e] = 0.f; }
        }
        for (int jb = 0; jb < len; jb += 8) {
        u32x4 rg[8], rv[8];
        const bf16_t* ub = u + (size_t)(t0 + jb) * 5632 + cgc;
#pragma unroll
        for (int jj = 0; jj < 8; ++jj) { if (jb + jj < len) { rg[jj] = __builtin_nontemporal_load((const u32x4*)(ub + (size_t)jj * 5632)); rv[jj] = __builtin_nontemporal_load((const u32x4*)(ub + (size_t)jj * 5632 + 2816)); } }
#pragma unroll
        for (int jj = 0; jj < 8; ++jj) {
            const int j = jb + jj;
            if (j < len) {
            float ug[8], uv[8], o8[8];
            unpack8(rg[jj], ug); unpack8(rv[jj], uv);
#pragma unroll
            for (int e = 0; e < 8; ++e) {
                const float gc = bg[e] + wg0[e] * hg0[e] + wg1[e] * hg1[e] + wg2[e] * ug[e];
                const float vc = bv[e] + wv0[e] * hv0[e] + wv1[e] * hv1[e] + wv2[e] * uv[e];
                o8[e] = silu_f(gc) * vc;
            }
            *(u32x4*)(act + (size_t)(t0 + j) * 2816 + cgc) = pack8(o8);
            float* o = nullptr;
            if (samp) { if (j >= 2) o = P->out + O_FFNS + (size_t)(bidx * 2 + j - 2) * 5632; }
            else { const int tl = tl0 + j; if (tl >= 2046) o = P->out + O_FFNP + (size_t)(bidx * 2 + tl - 2046) * 5632; }
            if (o) {
#pragma unroll
                for (int e = 0; e < 8; ++e) { o[cgc + e] = ug[e]; o[cvc + e] = uv[e]; }
            }
#pragma unroll
            for (int e = 0; e < 8; ++e) { hg0[e] = hg1[e]; hg1[e] = ug[e]; hv0[e] = hv1[e]; hv1[e] = uv[e]; }
            }
        }
        }
    }
}

#define XB_TMO      128
#define XB_XCNT(j)  (256  + 64 * (j))
#define XB_XSUB(j)  (1280 + 64 * (j))
#define XB_XGEN(j)  (2304 + 64 * (j))
#define XB_TOP      3328
#define XB_TOPGEN   3392
#define XCD_BAR_WORDS 3456
#define XB_SPIN_CAP (1u << 20)
__device__ __forceinline__ unsigned xb_ld(unsigned* p)              { return __hip_atomic_load(p, __ATOMIC_RELAXED, __HIP_MEMORY_SCOPE_AGENT); }
__device__ __forceinline__ unsigned xb_add(unsigned* p, unsigned v) { return __hip_atomic_fetch_add(p, v, __ATOMIC_RELAXED, __HIP_MEMORY_SCOPE_AGENT); }
__device__ __forceinline__ unsigned xb_xcc_id() { return (unsigned)__builtin_amdgcn_s_getreg((3 << 11) | 20) & 0xFu; }
#define XB_SPIN(cond, bar) do { unsigned _sp = 0; while (cond) { \
    if ((++_sp & 255u) == 0u) { if (xb_ld(&(bar)[XB_TMO])) break; if (_sp > XB_SPIN_CAP) { atomicAdd(&(bar)[XB_TMO], 1u); break; } } } } while (0)
__device__ __forceinline__ void xcd_barrier_complete(unsigned* bar, unsigned x, unsigned& nloc, unsigned& nx) {
    const unsigned G = gridDim.x;
    unsigned sum, cnt, mine, sp = 0u;
    for (;;) {
        sum = 0u; cnt = 0u; mine = 0u;
#pragma unroll
        for (unsigned j = 0; j < 16; ++j) { const unsigned c = xb_ld(&bar[XB_XCNT(j)]); sum += c; cnt += (c > 0u) ? 1u : 0u; mine = (j == x) ? c : mine; }
        if (sum == G) break;
        __builtin_amdgcn_s_sleep(1);
        if ((++sp & 255u) == 0u) { if (xb_ld(&bar[XB_TMO])) break; if (sp > XB_SPIN_CAP) { atomicAdd(&bar[XB_TMO], 1u); break; } }
    }
    nloc = mine > 0u ? mine : 1u; nx = cnt > 0u ? cnt : 1u;
}
__device__ __forceinline__ void xcd_barrier(unsigned* bar, volatile LDSB unsigned* st, const int tid) {
    asm volatile("s_waitcnt vmcnt(0)" ::: "memory");
    __syncthreads();
    if (tid == 0) {
        const unsigned x = xb_xcc_id();
        __builtin_amdgcn_s_waitcnt(0);
        unsigned nloc = st[0], nx = st[1];
        if (nloc == 0u) { xcd_barrier_complete(bar, x, nloc, nx); st[0] = nloc; st[1] = nx; }
        const unsigned old = xb_add(&bar[XB_XSUB(x)], 1u);
        const unsigned gen = old / nloc;
        if (old + 1u == (gen + 1u) * nloc) {
            __builtin_amdgcn_fence(__ATOMIC_RELEASE, "agent");
            asm volatile("s_waitcnt vmcnt(0)" ::: "memory");
            const unsigned og = xb_add(&bar[XB_TOP], 1u);
            const unsigned tg = og / nx;
            if (og + 1u == (tg + 1u) * nx) xb_add(&bar[XB_TOPGEN], 1u);
            else XB_SPIN(xb_ld(&bar[XB_TOPGEN]) == tg, bar);
            __builtin_amdgcn_fence(__ATOMIC_ACQUIRE, "agent");
            xb_add(&bar[XB_XGEN(x)], 1u);
            asm volatile("s_waitcnt vmcnt(0)" ::: "memory");
        } else {
            XB_SPIN(xb_ld(&bar[XB_XGEN(x)]) == gen, bar);
            __builtin_amdgcn_fence(__ATOMIC_ACQUIRE, "agent");
            asm volatile("s_waitcnt vmcnt(0)" ::: "memory");
        }
    }
    __syncthreads();
}

extern __shared__ __attribute__((aligned(16))) char smem[];

__global__ void __launch_bounds__(NTHR) hybrid_fwd(Params Pin) {
    char* shm = smem;
    volatile LDSB unsigned* bst = (volatile LDSB unsigned*)(smem + 139264);
    if (threadIdx.x == 0) { bst[0] = 0u; bst[1] = 0u; (void)xb_add((unsigned*)(Pin.ws + W_BAR) + XB_XCNT(xb_xcc_id()), 1u); }
    __syncthreads();
    for (int ph = Pin.ph_lo; ph < Pin.ph_hi; ++ph) {
        if (ph == 6 || ph == 11) continue;
        const int reps = ((REPEAT_MASK >> ph) & 1) ? 2 : 1;
        for (int rep = 0; rep < reps; ++rep) {
        if (rep > 0) xcd_barrier((unsigned*)(Pin.ws + W_BAR), bst, threadIdx.x);
        int tid = threadIdx.x, blk = blockIdx.x, nblk = gridDim.x;
        asm volatile("" : "+v"(tid));
        asm volatile("" : "+s"(blk), "+s"(nblk));
        PP P = (PP)__builtin_amdgcn_kernarg_segment_ptr();
        asm volatile("" : "+s"(P));
        const int lb = (blk & 7) * (nblk >> 3) + (blk >> 3);
        const int gtid = blk * NTHR + tid, nthreads = nblk * NTHR;
        const int gw = blk * 8 + (tid >> 6), nw = nblk * 8;
        switch (ph) {
#if PHASE_MASK & 1
        case 0: phase_prep(P, shm, blk, nblk, tid); break;
#endif
#if PHASE_MASK & 4
        case 2: phase_convpool(P, gtid, nthreads); break;
#endif
#if PHASE_MASK & 8
        case 3:
            if (blk & 1) { int it = blk; for (; it + nblk < 2048; it += 2 * nblk) ssd_sample<2>(P, it, nblk, tid); for (; it < 2048; it += nblk) ssd_sample<1>(P, it, nblk, tid); }
            for (int it = lb; it < 256; it += nblk) ssd_prompt(P, it, shm, tid);
            if (!(blk & 1)) { int it = blk; for (; it + nblk < 2048; it += 2 * nblk) ssd_sample<2>(P, it, nblk, tid); for (; it < 2048; it += nblk) ssd_sample<1>(P, it, nblk, tid); }
            break;
#endif
#if PHASE_MASK & 16
        case 4: phase_gatednorm(P, gw, nw, tid); break;
#endif
#if PHASE_MASK & 64
        case 6: phase_norm(P, P->norm_mem, false, gw, nw, tid); break;
        case 11: phase_norm(P, P->norm_ffn, false, gw, nw, tid); break;
        case 15: phase_norm(P, P->final_norm, true, gw, nw, tid); break;
#endif
#if PHASE_MASK & 8192
        case 13: phase_ffnconv(P, gtid, nthreads); break;
#endif
        default: break;
        }
#if PHASE_MASK & 256
        if (ph == 8 && (blk & 1)) { for (int it = blk; it < 512; it += 2 * nblk) attn_sample(P, it, it + nblk < 512 ? it + nblk : -1, shm, tid); __syncthreads(); }
#endif
#if PHASE_MASK & 2
        if (ph == 1 || ph == 5 || ph == 7 || ph == 8 || ph == 9 || ph == 10 || ph == 12 || ph == 14) gemm_phase(P, ph, shm, lb, blk, nblk, tid);
#endif
#if PHASE_MASK & 256
        if (ph == 9 && !(blk & 1)) { for (int it = blk; it < 512; it += 2 * nblk) attn_sample(P, it, it + nblk < 512 ? it + nblk : -1, shm, tid); }
#endif
        }
        if (ph + 1 < Pin.ph_hi && ph != 8) xcd_barrier((unsigned*)(Pin.ws + W_BAR), bst, threadIdx.x);
        if (ph == 8) { asm volatile("s_waitcnt vmcnt(0)" ::: "memory"); __syncthreads(); }
        if (EXTRA_SYNCS && ph == 0) { for (int i = 0; i < EXTRA_SYNCS; ++i) xcd_barrier((unsigned*)(Pin.ws + W_BAR), bst, threadIdx.x); }
    }
}

extern "C" void kernel_launch(void* const* d_in, const int* in_sizes, int n_in, void* d_out, int out_size, void* d_ws, size_t ws_size, hipStream_t stream) {
    static int grid_blocks = 0;
    if (!grid_blocks) {
        int dev = 0, cus = 0, per_cu = 0;
        hipGetDevice(&dev);
        hipDeviceGetAttribute(&cus, hipDeviceAttributeMultiprocessorCount, dev);
        hipFuncSetAttribute((const void*)hybrid_fwd, hipFuncAttributeMaxDynamicSharedMemorySize, LDS_BYTES);
        hipOccupancyMaxActiveBlocksPerMultiprocessor(&per_cu, hybrid_fwd, NTHR, LDS_BYTES);
        if (per_cu < 1) per_cu = 1;
        grid_blocks = cus * 1;
        grid_blocks &= ~7;
        if (grid_blocks < 8) grid_blocks = 8;
    }
    Params p{};
    const float* const* in = (const float* const*)d_in;
    p.x_prompt = in[0]; p.x_sample = in[1]; p.mem_prompt = in[2]; p.state_ssm = in[3]; p.state_conv = in[4]; p.state_pool = in[5]; p.state_ffn = in[6];
    p.cache_k = in[7]; p.cache_v = in[8]; p.norm_mix = in[9]; p.w_in = in[10]; p.conv_w = in[11]; p.conv_b = in[12]; p.dt_bias = in[13]; p.a_log = in[14];
    p.ssm_d = in[15]; p.ssm_norm = in[16]; p.w_pool = in[17]; p.pool_scale = in[18]; p.w_out = in[19]; p.norm_mem = in[20]; p.norm_memkv = in[21];
    p.w_mq = in[22]; p.w_mk = in[23]; p.w_mv = in[24]; p.w_mo = in[25]; p.norm_ffn = in[26]; p.w_up = in[27]; p.ffn_w = in[28]; p.ffn_b = in[29];
    p.w_down = in[30]; p.final_norm = in[31];
    p.out = (float*)d_out; p.ws = (char*)d_ws; p.ph_lo = 0; p.ph_hi = 16;
    hipMemsetAsync((char*)d_ws + W_BAR, 0, 16384, stream);
    void* args[] = {&p};
    hipError_t e = hipLaunchCooperativeKernel((const void*)hybrid_fwd, dim3(grid_blocks), dim3(NTHR), args, LDS_BYTES, stream);
    if (e != hipSuccess) fprintf(stderr, "cooperative launch failed: %s (grid %d)\n", hipGetErrorString(e), grid_blocks);
}
```
